# Optimizing an MI355X kernel written in HIP

```python
import jax
import jax.numpy as jnp
from jax import lax
import numpy as np

D_MODEL = 2048
BATCH = 4
SEQ = 2048
DEPTH = 2

CHUNK = 64
EPS = 1e-6
MIX_WIDTH = D_MODEL
N_MIXERS = 4
GROUP_WIDTH = MIX_WIDTH // N_MIXERS

CONV_A_WIDTH = 3
POOL_WINDOWS = (2, 4, 8, 16)
POOL_GROUP = GROUP_WIDTH // len(POOL_WINDOWS)
GDN_HEADS = 4
GDN_HEAD_DIM = GROUP_WIDTH // GDN_HEADS
GDN_CONV = 4
SSM_HEAD_DIM = 64
SSM_HEADS = GROUP_WIDTH // SSM_HEAD_DIM
SSM_GROUPS = 2
SSM_STATE = 128
SSM_CONV = 4
SSM_XBC = GROUP_WIDTH + 2 * SSM_GROUPS * SSM_STATE

A_COLS = 3 * GROUP_WIDTH
B_COLS = GROUP_WIDTH
C_COLS = 4 * GROUP_WIDTH + 2 * GDN_HEADS
D_COLS = GROUP_WIDTH + SSM_XBC + SSM_HEADS
IN_COLS = A_COLS + B_COLS + C_COLS + D_COLS
IN_SPLITS = (A_COLS, A_COLS + B_COLS, A_COLS + B_COLS + C_COLS)

MEM_LEN = 256
XA_HEADS = 4
XA_HEAD_DIM = D_MODEL // XA_HEADS
D_FF = -(-8 * D_MODEL // (3 * 256)) * 256

MIX_PRE = 0
MIX_POST = 1
XA_PRE = 2
XA_POST = 3
MEM_NORM = 4
FFN_PRE = 5
FFN_POST = 6
N_NORMS = 7

kernel_name = 'hybrid_parallel_mixer_stream_encoder'


def rmsnorm(x, g):
    xf = x.astype(jnp.float32)
    y = xf * lax.rsqrt(jnp.mean(xf * xf, axis=-1, keepdims=True) + EPS)
    return (y * g.astype(jnp.float32)).astype(x.dtype)


def l2norm(x):
    return x * lax.rsqrt(jnp.sum(x * x, axis=-1, keepdims=True) + EPS)


def causal_dwconv(x, w):
    width, ch = w.shape
    return lax.conv_general_dilated(
        x, w[:, None, :], window_strides=(1,), padding=[(width - 1, 0)],
        dimension_numbers=('NWC', 'WIO', 'NWC'), feature_group_count=ch)


def short_conv_mixer(u, conv_w):
    b_gate, c_gate, h = jnp.split(u, 3, axis=-1)
    return b_gate * causal_dwconv(c_gate * h, conv_w)


def multiscale_pool_mixer(u, pool_w, pool_scale):
    bsz, T, _ = u.shape
    uf = u.astype(jnp.float32).reshape(bsz, T, len(POOL_WINDOWS), POOL_GROUP)
    cs = jnp.pad(jnp.cumsum(uf, axis=1), ((0, 0), (1, 0), (0, 0), (0, 0)))
    pos = jnp.arange(1, T + 1, dtype=jnp.float32)
    pooled = []
    for gi, w in enumerate(POOL_WINDOWS):
        cg = cs[:, :, gi]
        lo = jnp.pad(cg, ((0, 0), (w - 1, 0), (0, 0)))[:, :T]
        cnt = jnp.minimum(pos, float(w))
        pooled.append((cg[:, 1:] - lo) / cnt[None, :, None])
    pooled = jnp.stack(pooled, axis=2) - uf
    y = jnp.einsum('btgc,gcd->btgd', pooled, pool_w.astype(jnp.float32))
    y = y.reshape(bsz, T, GROUP_WIDTH) * pool_scale.astype(jnp.float32)
    return y.astype(u.dtype)


def gated_delta_rule_chunked(q, k, v, g, beta):
    bsz, T, H, dk = q.shape
    dv = v.shape[-1]
    n = T // CHUNK

    def to_blocks(t):
        t = t.astype(jnp.float32).reshape((bsz, n, CHUNK, H) + t.shape[3:])
        return jnp.moveaxis(t, 3, 1)

    q, k, v, g, beta = (to_blocks(t) for t in (q, k, v, g, beta))
    G = jnp.cumsum(g, axis=-1)
    incl = jnp.tril(jnp.ones((CHUNK, CHUNK), dtype=bool))
    strict = jnp.tril(jnp.ones((CHUNK, CHUNK), dtype=bool), k=-1)
    diff = G[..., :, None] - G[..., None, :]
    decay = jnp.where(incl, jnp.exp(jnp.where(incl, diff, 0.0)), 0.0)
    kb = k * beta[..., None]
    m_low = jnp.where(strict, jnp.einsum('bhnid,bhnjd->bhnij', kb, k) * decay, 0.0)
    eye = jnp.eye(CHUNK, dtype=jnp.float32)
    rhs = jnp.concatenate([v * beta[..., None], kb * jnp.exp(G)[..., None]], axis=-1)
    sol = lax.linalg.triangular_solve(eye + m_low, rhs, left_side=True, lower=True,
                                      unit_diagonal=True)
    u_blk, w_blk = sol[..., :dv], sol[..., dv:]
    qk = jnp.einsum('bhnid,bhnjd->bhnij', q, k) * decay
    q_dec = q * jnp.exp(G)[..., None]
    k_end = k * jnp.exp(G[..., -1:] - G)[..., None]
    blk_dec = jnp.exp(G[..., -1])
    xs = tuple(jnp.moveaxis(t, 2, 0) for t in (q_dec, qk, u_blk, w_blk, k_end, blk_dec))

    def step(S, inp):
        q_c, qk_c, u_c, w_c, k_c, d_c = inp
        v_new = u_c - jnp.einsum('bhlk,bhkv->bhlv', w_c, S)
        o_c = jnp.einsum('bhlk,bhkv->bhlv', q_c, S) + jnp.einsum('bhlm,bhmv->bhlv', qk_c, v_new)
        S = S * d_c[..., None, None] + jnp.einsum('bhlk,bhlv->bhkv', k_c, v_new)
        return S, o_c

    S0 = jnp.zeros((bsz, H, dk, dv), jnp.float32)
    _, o = lax.scan(step, S0, xs)
    return jnp.transpose(o, (1, 0, 3, 2, 4)).reshape(bsz, T, H, dv)


def gated_deltanet_mixer(u, conv_w, A_log, dt_bias, norm_g):
    bsz, T, _ = u.shape
    qkv, z, a, b = jnp.split(u, (3 * GROUP_WIDTH, 4 * GROUP_WIDTH, 4 * GROUP_WIDTH + GDN_HEADS), axis=-1)
    qkv = jax.nn.silu(causal_dwconv(qkv, conv_w))
    q, k, v = (t.astype(jnp.float32).reshape(bsz, T, GDN_HEADS, GDN_HEAD_DIM)
               for t in jnp.split(qkv, 3, axis=-1))
    q = l2norm(q) * GDN_HEAD_DIM ** -0.5
    k = l2norm(k)
    g = -jnp.exp(A_log.astype(jnp.float32)) * jax.nn.softplus(a.astype(jnp.float32) + dt_bias.astype(jnp.float32))
    beta = jax.nn.sigmoid(b.astype(jnp.float32))
    o = gated_delta_rule_chunked(q, k, v, g, beta)
    gate = jax.nn.silu(z.astype(jnp.float32).reshape(bsz, T, GDN_HEADS, GDN_HEAD_DIM))
    o = rmsnorm(o, norm_g) * gate
    return o.reshape(bsz, T, GROUP_WIDTH).astype(u.dtype)


def ssd_chunked(x, dt, A, Bm, Cm):
    bsz, T, H, P = x.shape
    n = T // CHUNK
    hg = H // SSM_GROUPS
    X = (x.astype(jnp.float32) * dt[..., None]).reshape(bsz, n, CHUNK, SSM_GROUPS, hg, P)
    a = jnp.transpose((dt * A).reshape(bsz, n, CHUNK, SSM_GROUPS, hg), (0, 3, 4, 1, 2))
    Bm = Bm.astype(jnp.float32).reshape(bsz, n, CHUNK, SSM_GROUPS, SSM_STATE)
    Cm = Cm.astype(jnp.float32).reshape(bsz, n, CHUNK, SSM_GROUPS, SSM_STATE)
    Acs = jnp.cumsum(a, axis=-1)
    incl = jnp.tril(jnp.ones((CHUNK, CHUNK), dtype=bool))
    seg = Acs[..., :, None] - Acs[..., None, :]
    Lm = jnp.where(incl, jnp.exp(jnp.where(incl, seg, 0.0)), 0.0)
    CB = jnp.einsum('bnlgs,bnmgs->bgnlm', Cm, Bm)
    y_diag = jnp.einsum('bghnlm,bnmghp->bnlghp', CB[:, :, None] * Lm, X)
    to_end = jnp.exp(Acs[..., -1:] - Acs)
    states = jnp.einsum('bnlgs,bghnl,bnlghp->nbghps', Bm, to_end, X)
    blk_dec = jnp.moveaxis(jnp.exp(Acs[..., -1]), 3, 0)

    def step(h, inp):
        s_c, d_c = inp
        return h * d_c[..., None, None] + s_c, h

    h0 = jnp.zeros((bsz, SSM_GROUPS, hg, P, SSM_STATE), jnp.float32)
    _, h_prev = lax.scan(step, h0, (states, blk_dec))
    y_off = jnp.einsum('bnlgs,nbghps,bghnl->bnlghp', Cm, h_prev, jnp.exp(Acs))
    return (y_diag + y_off).reshape(bsz, T, H, P)


def mamba2_mixer(u, conv_w, conv_b, A_log, dt_bias, D_skip, norm_g):
    bsz, T, _ = u.shape
    z, xBC, dt = jnp.split(u, (GROUP_WIDTH, GROUP_WIDTH + SSM_XBC), axis=-1)
    xBC = jax.nn.silu(causal_dwconv(xBC, conv_w) + conv_b)
    x, Bm, Cm = jnp.split(xBC, (GROUP_WIDTH, GROUP_WIDTH + SSM_GROUPS * SSM_STATE), axis=-1)
    x = x.reshape(bsz, T, SSM_HEADS, SSM_HEAD_DIM)
    Bm = Bm.reshape(bsz, T, SSM_GROUPS, SSM_STATE)
    Cm = Cm.reshape(bsz, T, SSM_GROUPS, SSM_STATE)
    dt = jax.nn.softplus(dt.astype(jnp.float32) + dt_bias.astype(jnp.float32))
    A = -jnp.exp(A_log.astype(jnp.float32))
    y = ssd_chunked(x, dt, A, Bm, Cm) + D_skip.astype(jnp.float32)[:, None] * x.astype(jnp.float32)
    y = y.reshape(bsz, T, GROUP_WIDTH) * jax.nn.silu(z.astype(jnp.float32))
    y = rmsnorm(y.reshape(bsz, T, SSM_GROUPS, -1), norm_g.reshape(SSM_GROUPS, -1))
    return y.reshape(bsz, T, GROUP_WIDTH).astype(u.dtype)


def memory_cross_attention(h, m, wq, wkv, wo):
    bsz, T, _ = h.shape
    q = (h @ wq).reshape(bsz, T, XA_HEADS, XA_HEAD_DIM)
    k, v = jnp.split(m @ wkv, 2, axis=-1)
    k = k.reshape(bsz, m.shape[1], XA_HEADS, XA_HEAD_DIM)
    v = v.reshape(bsz, m.shape[1], XA_HEADS, XA_HEAD_DIM)
    s = jnp.einsum('bthd,bmhd->bhtm', q, k).astype(jnp.float32) * XA_HEAD_DIM ** -0.5
    p = jax.nn.softmax(s, axis=-1).astype(v.dtype)
    o = jnp.einsum('bhtm,bmhd->bthd', p, v).reshape(bsz, T, D_MODEL)
    return o @ wo


def swiglu_ffn(h, w_gu, w_down):
    gate, up = jnp.split(h @ w_gu, 2, axis=-1)
    return (jax.nn.silu(gate) * up) @ w_down


def setup_inputs(seed: int = 0) -> dict:
    key = jax.random.key(seed)
    ks = jax.random.split(key, 24)
    f32 = jnp.float32

    def dense(k, shape, fan_in):
        return jax.random.normal(k, shape, f32) * fan_in ** -0.5

    def gains(k, shape, noise):
        return 1.0 + noise * jax.random.normal(k, shape, f32)

    def log_a(k, n_heads):
        return jnp.log(jax.random.uniform(k, (DEPTH, n_heads), f32, 1.0, 16.0))

    def dt_bias(k, n_heads):
        dt = jnp.exp(jax.random.uniform(k, (DEPTH, n_heads), f32, np.log(1e-3), np.log(1e-1)))
        return dt + jnp.log(-jnp.expm1(-dt))

    return {
        'x': jax.random.normal(ks[0], (BATCH, SEQ, D_MODEL), f32),
        'mem': jax.random.normal(ks[1], (BATCH, MEM_LEN, D_MODEL), f32),
        'norm_g': gains(ks[2], (DEPTH, N_NORMS, D_MODEL), 0.05),
        'w_in': dense(ks[3], (DEPTH, D_MODEL, IN_COLS), D_MODEL),
        'conv_a_w': dense(ks[4], (DEPTH, CONV_A_WIDTH, GROUP_WIDTH), CONV_A_WIDTH),
        'pool_w': dense(ks[5], (DEPTH, len(POOL_WINDOWS), POOL_GROUP, POOL_GROUP), POOL_GROUP),
        'pool_scale': gains(ks[6], (DEPTH, GROUP_WIDTH), 0.1),
        'gdn_conv_w': dense(ks[7], (DEPTH, GDN_CONV, 3 * GROUP_WIDTH), GDN_CONV),
        'gdn_A_log': log_a(ks[8], GDN_HEADS),
        'gdn_dt_bias': dt_bias(ks[9], GDN_HEADS),
        'gdn_norm_g': gains(ks[10], (DEPTH, GDN_HEAD_DIM), 0.05),
        'ssm_conv_w': dense(ks[11], (DEPTH, SSM_CONV, SSM_XBC), SSM_CONV),
        'ssm_conv_b': 0.02 * jax.random.normal(ks[12], (DEPTH, SSM_XBC), f32),
        'ssm_A_log': log_a(ks[13], SSM_HEADS),
        'ssm_dt_bias': dt_bias(ks[14], SSM_HEADS),
        'ssm_D': gains(ks[15], (DEPTH, SSM_HEADS), 0.1),
        'ssm_norm_g': gains(ks[16], (DEPTH, GROUP_WIDTH), 0.05),
        'w_out': dense(ks[17], (DEPTH, MIX_WIDTH, D_MODEL), MIX_WIDTH),
        'xa_wq': dense(ks[18], (DEPTH, D_MODEL, D_MODEL), D_MODEL),
        'xa_wkv': dense(ks[19], (DEPTH, D_MODEL, 2 * D_MODEL), D_MODEL),
        'xa_wo': dense(ks[20], (DEPTH, D_MODEL, D_MODEL), D_MODEL),
        'ffn_w_gu': dense(ks[21], (DEPTH, D_MODEL, 2 * D_FF), D_MODEL),
        'ffn_w_down': dense(ks[22], (DEPTH, D_FF, D_MODEL), D_FF),
    }


def reference(x, mem, norm_g, w_in, conv_a_w, pool_w, pool_scale, gdn_conv_w, gdn_A_log,
              gdn_dt_bias, gdn_norm_g, ssm_conv_w, ssm_conv_b, ssm_A_log, ssm_dt_bias, ssm_D,
              ssm_norm_g, w_out, xa_wq, xa_wkv, xa_wo, ffn_w_gu, ffn_w_down):
    for l in range(DEPTH):
        g = norm_g[l]
        u = rmsnorm(x, g[MIX_PRE]) @ w_in[l]
        u_a, u_b, u_c, u_d = jnp.split(u, IN_SPLITS, axis=-1)
        mixed = jnp.concatenate([
            short_conv_mixer(u_a, conv_a_w[l]),
            multiscale_pool_mixer(u_b, pool_w[l], pool_scale[l]),
            gated_deltanet_mixer(u_c, gdn_conv_w[l], gdn_A_log[l], gdn_dt_bias[l], gdn_norm_g[l]),
            mamba2_mixer(u_d, ssm_conv_w[l], ssm_conv_b[l], ssm_A_log[l], ssm_dt_bias[l],
                         ssm_D[l], ssm_norm_g[l]),
        ], axis=-1).astype(x.dtype)
        x = x + rmsnorm(mixed @ w_out[l], g[MIX_POST])
        xa = memory_cross_attention(rmsnorm(x, g[XA_PRE]), rmsnorm(mem, g[MEM_NORM]),
                                    xa_wq[l], xa_wkv[l], xa_wo[l])
        x = x + rmsnorm(xa, g[XA_POST])
        x = x + rmsnorm(swiglu_ffn(rmsnorm(x, g[FFN_PRE]), ffn_w_gu[l], ffn_w_down[l]), g[FFN_POST])
    return x
```

```cpp
#include <hip/hip_runtime.h>
#include <cstdio>
#include <cstdint>
#define MK_SINGLE 0
namespace pg8 {
#define PG8_LAS __attribute__((address_space(3)))
typedef unsigned short bf16_t;
typedef short bf16x8 __attribute__((ext_vector_type(8)));
typedef float f32x4 __attribute__((ext_vector_type(4)));
typedef unsigned u32x4 __attribute__((ext_vector_type(4)));
constexpr int BM = 256, BK = 64, HALF = 128, HTB = HALF * BK * 2  , STAGE_BYTES = 8 * HTB, NXCD = 8, WGM = 8;

__host__ __device__ __forceinline__ int lds_byte(int r, int c) { const int st = (r >> 4) * 2 + (c >> 5), rr = r & 15, cc = c & 31, ob = rr * 64 + cc * 2; return st * 1024 + (ob ^ (((ob >> 9) & 1) << 5)); }
__host__ __device__ __forceinline__ void stage_rc(int b, int& R, int& C) { const int st = b / 1024, sb = b % 1024, swz = sb ^ (((sb >> 9) & 1) << 5); R = (st >> 1) * 16 + swz / 64; C = (st & 1) * 32 + (swz % 64) / 2; }
__host__ __device__ __forceinline__ int perm32(int rho) { const int n = rho >> 4, i = rho & 15; return 8 * (i >> 2) + 4 * n + (i & 3); }

struct Unit { int pm, pn; };
struct Gemm { const bf16_t* A; const bf16_t* Bt; int M, N, K; };

struct StaticOrder {
    int nM, nN, nwg, G, c;
    __host__ __device__ void init(int M, int N, int G_, int c_) { nM = M / BM; nN = N / BM; nwg = nM * nN; G = G_; c = c_; }
    __host__ __device__ bool next(int i, Unit& u) const {
        const long L = (long)i * G + c; if (L >= nwg) return false;
        int wgid = (int)L; { const int q = nwg / NXCD, r = nwg % NXCD, xcd = wgid % NXCD, off = wgid / NXCD; wgid = (xcd < r ? xcd * (q + 1) : r * (q + 1) + (xcd - r) * q) + off; }
        const int nig = WGM * nN, gid = wgid / nig, fm = gid * WGM, gsz = (nM - fm) < WGM ? (nM - fm) : WGM;
        u.pm = fm + ((wgid % nig) % gsz); u.pn = (wgid % nig) / gsz; return true;
    }
    __device__ __forceinline__ void a_ready(const Unit&) const {}
    __device__ __forceinline__ void done(const Unit&) const {}
};

__device__ __forceinline__ unsigned cvt_pk_bf16(float lo, float hi) { unsigned r; asm volatile("v_cvt_pk_bf16_f32 %0, %1, %2" : "=v"(r) : "v"(lo), "v"(hi)); return r; }
struct EpiF32 {
    static constexpr bool PERM = false, AFTER_DRAIN = false;
    float* C; int ldc;
    __device__ __forceinline__ void operator()(const f32x4 (&acc)[2][2][4][2], const Unit& u, int wr, int wc, int fr, int fq) const {
        const int row0 = u.pm * BM + wr * 64 + fr, col0 = u.pn * BM + wc * 32 + 4 * fq;
#pragma unroll
        for (int ai = 0; ai < 2; ++ai)
#pragma unroll
            for (int m = 0; m < 4; ++m) { float* rowp = C + (size_t)(row0 + ai * HALF + m * 16) * ldc + col0;
#pragma unroll
                for (int bj = 0; bj < 2; ++bj)
#pragma unroll
                    for (int n = 0; n < 2; ++n) *(f32x4*)(rowp + bj * HALF + n * 16) = acc[ai][bj][m][n]; }
    }
};
struct EpiBf16S {
    static constexpr bool PERM = true, AFTER_DRAIN = false;
    bf16_t* O; int ldc; float scale;
    __device__ __forceinline__ void operator()(const f32x4 (&acc)[2][2][4][2], const Unit& u, int wr, int wc, int fr, int fq) const {
        const int row0 = u.pm * BM + wr * 64 + fr, col0 = u.pn * BM + wc * 32 + 8 * fq; const float sc = scale;
#pragma unroll
        for (int ai = 0; ai < 2; ++ai)
#pragma unroll
            for (int m = 0; m < 4; ++m) { bf16_t* rowp = O + (size_t)(row0 + ai * HALF + m * 16) * ldc + col0;
#pragma unroll
                for (int bj = 0; bj < 2; ++bj) { const f32x4 v0 = acc[ai][bj][m][0] * sc, v1 = acc[ai][bj][m][1] * sc;
                    u32x4 w; w.x = cvt_pk_bf16(v0[0], v0[1]); w.y = cvt_pk_bf16(v0[2], v0[3]); w.z = cvt_pk_bf16(v1[0], v1[1]); w.w = cvt_pk_bf16(v1[2], v1[3]);
                    *(u32x4*)(rowp + bj * HALF) = w; } }
    }
};
__device__ __forceinline__ float silu_f(float v) { return v / (1.0f + __expf(-v)); }
struct EpiSwiGLU {
    static constexpr bool PERM = true, AFTER_DRAIN = false;
    bf16_t* O; int ldc;
    __device__ __forceinline__ void operator()(const f32x4 (&acc)[2][2][4][2], const Unit& u, int wr, int wc, int fr, int fq) const {
        const int row0 = u.pm * BM + wr * 64 + fr, col0 = u.pn * HALF + wc * 32 + 8 * fq;
#pragma unroll
        for (int ai = 0; ai < 2; ++ai)
#pragma unroll
            for (int m = 0; m < 4; ++m) { bf16_t* rowp = O + (size_t)(row0 + ai * HALF + m * 16) * ldc + col0;
                const f32x4 g0 = acc[ai][0][m][0], g1 = acc[ai][0][m][1], u0 = acc[ai][1][m][0], u1 = acc[ai][1][m][1];
                u32x4 w; w.x = cvt_pk_bf16(silu_f(g0[0]) * u0[0], silu_f(g0[1]) * u0[1]); w.y = cvt_pk_bf16(silu_f(g0[2]) * u0[2], silu_f(g0[3]) * u0[3]);
                w.z = cvt_pk_bf16(silu_f(g1[0]) * u1[0], silu_f(g1[1]) * u1[1]); w.w = cvt_pk_bf16(silu_f(g1[2]) * u1[2], silu_f(g1[3]) * u1[3]);
                *(u32x4*)rowp = w; }
    }
};
struct EpiAny {
    static constexpr bool PERM = false, AFTER_DRAIN = false, RT_PERM = true;
    void* C; int ldc; int mode; float scale;
    __device__ __forceinline__ bool perm() const { return mode != 0; }
    __device__ __forceinline__ void operator()(const f32x4 (&acc)[2][2][4][2], const Unit& u, int wr, int wc, int fr, int fq) const {
        if (mode == 0) { EpiF32 e{(float*)C, ldc}; e(acc, u, wr, wc, fr, fq); }
        else if (mode == 1) { EpiBf16S e{(bf16_t*)C, ldc, scale}; e(acc, u, wr, wc, fr, fq); }
        else { EpiSwiGLU e{(bf16_t*)C, ldc}; e(acc, u, wr, wc, fr, fq); }
    }
};
template <class Epi, class Sched, bool ALIGN_EPI = false, bool SP2 = false>
__device__ __forceinline__ void gemm_phase(PG8_LAS unsigned char* lds, const Gemm g, const Sched& S, const Epi& E) {
    const int tid = threadIdx.x, wid = __builtin_amdgcn_readfirstlane(tid >> 6), lane = tid & 63, wr = wid >> 2, wc = wid & 3, fr = lane & 15, fq = lane >> 4;
    const int K = g.K, nt = K / BK;
    unsigned voffA[2], voffB[2];
#pragma unroll
    for (int i = 0; i < 2; ++i) { int R, C; stage_rc(tid * 16 + i * 8192, R, C); const int Rb = E.perm() ? ((R & ~31) + perm32(R & 31)) : R;
        voffA[i] = (unsigned)(R * K + C) * 2u; voffB[i] = (unsigned)(Rb * K + C) * 2u; }
    const size_t kstep = (size_t)(BK * 2);
    const size_t hstep = (size_t)HALF * K * 2;
    const size_t tstep = 2 * hstep;
    const unsigned ldsw = (unsigned)wid * 1024u;
    const int aoff = lds_byte(wr * 64 + fr, fq * 8), boff = lds_byte(wc * 32 + fr, fq * 8);
#define PG8_SA(b, h) (((b) * 2 + (h)) * HTB)
#define PG8_SB(b, h) ((4 + (b) * 2 + (h)) * HTB)
#define PG8_STAGE(bufoff, gbase, voff) do { _Pragma("unroll") for (int _i = 0; _i < 2; ++_i) \
        __builtin_amdgcn_global_load_lds((const unsigned*)((const char*)(gbase) + (voff)[_i]), (PG8_LAS unsigned*)(lds + (bufoff) + ldsw + _i * 8192), 16, 0, 0); } while (0)
#define PG8_LDA(dst, b, h) do { _Pragma("unroll") for (int m = 0; m < 4; ++m) _Pragma("unroll") for (int k = 0; k < 2; ++k) dst[m][k] = *(const PG8_LAS bf16x8*)(lds + PG8_SA(b, h) + aoff + m * 2048 + k * 1024); } while (0)
#define PG8_LDB(dst, b, h) do { _Pragma("unroll") for (int n = 0; n < 2; ++n) _Pragma("unroll") for (int k = 0; k < 2; ++k) dst[n][k] = *(const PG8_LAS bf16x8*)(lds + PG8_SB(b, h) + boff + n * 2048 + k * 1024); } while (0)
#define PG8_MMA(ai, bj, At, Bt) do { __builtin_amdgcn_s_setprio(1); _Pragma("unroll") for (int m = 0; m < 4; ++m) _Pragma("unroll") for (int n = 0; n < 2; ++n) _Pragma("unroll") for (int k = 0; k < 2; ++k) \
        acc[ai][bj][m][n] = __builtin_amdgcn_mfma_f32_16x16x32_bf16(Bt[n][k], At[m][k], acc[ai][bj][m][n], 0, 0, 0); __builtin_amdgcn_s_setprio(0); } while (0)
#define PG8_WAIT_V(n) asm volatile("s_waitcnt vmcnt(" #n ")" ::: "memory")
#define PG8_WAIT_L(n) asm volatile("s_waitcnt lgkmcnt(" #n ")" ::: "memory")
#define PG8_BAR __builtin_amdgcn_s_barrier()
#define PG8_SCHED __builtin_amdgcn_sched_barrier(0)
    Unit cur, nxt; int ui = 0;
    if (!S.next(0, cur)) return;
    f32x4 acc[2][2][4][2];
#pragma unroll
    for (int a = 0; a < 2; ++a)
#pragma unroll
        for (int b = 0; b < 2; ++b)
#pragma unroll
            for (int m = 0; m < 4; ++m)
#pragma unroll
                for (int n = 0; n < 2; ++n) acc[a][b][m][n] = (f32x4){0.f, 0.f, 0.f, 0.f};
    bf16x8 At[4][2], B0[2][2], B1[2][2];
    const char* cA = (const char*)g.A + (size_t)cur.pm * tstep; const char* cB = (const char*)g.Bt + (size_t)cur.pn * tstep;
    S.a_ready(cur);
    if constexpr (SP2) {
        PG8_STAGE(PG8_SB(0, 0), cB, voffB); PG8_STAGE(PG8_SB(0, 1), cB + hstep, voffB); PG8_STAGE(PG8_SA(0, 0), cA, voffA); PG8_STAGE(PG8_SA(0, 1), cA + hstep, voffA);
        if (wr == 1) PG8_BAR;
        PG8_WAIT_V(2); PG8_BAR;
        PG8_STAGE(PG8_SB(1, 0), cB + kstep, voffB); PG8_STAGE(PG8_SA(1, 0), cA + kstep, voffA); PG8_STAGE(PG8_SB(1, 1), cB + hstep + kstep, voffB);
        PG8_WAIT_V(6); PG8_BAR;
    } else {
        PG8_STAGE(PG8_SB(0, 0), cB, voffB); PG8_STAGE(PG8_SA(0, 0), cA, voffA); PG8_STAGE(PG8_SB(0, 1), cB + hstep, voffB); PG8_STAGE(PG8_SA(0, 1), cA + hstep, voffA);
        if (wr == 1) PG8_BAR;
        PG8_WAIT_V(4); PG8_BAR;
        PG8_STAGE(PG8_SB(1, 0), cB + kstep, voffB); PG8_STAGE(PG8_SA(1, 0), cA + kstep, voffA); PG8_STAGE(PG8_SB(1, 1), cB + hstep + kstep, voffB);
        PG8_WAIT_V(6); PG8_BAR;
    }
    for (;;) {
        const bool has_next = S.next(ui + 1, nxt);
        const char* nA = has_next ? (const char*)g.A + (size_t)nxt.pm * tstep : cA; const char* nB = has_next ? (const char*)g.Bt + (size_t)nxt.pn * tstep : cB;
        for (int t = 0; t < nt; t += 2) {
            const bool last = (t == nt - 2);
            const char* a1 = cA + (size_t)(t + 1) * kstep;
            const char* a2 = last ? nA : cA + (size_t)(t + 2) * kstep; const char* b2 = last ? nB : cB + (size_t)(t + 2) * kstep;
            const char* a3 = a2 + kstep; const char* b3 = b2 + kstep;
            if (last && has_next) S.a_ready(nxt);
            if constexpr (SP2) {
            PG8_LDB(B0, 0, 0); PG8_LDB(B1, 0, 1); PG8_SCHED; PG8_LDA(At, 0, 0); PG8_STAGE(PG8_SA(1, 1), a1 + hstep, voffA);
            PG8_WAIT_V(8); PG8_WAIT_L(0); PG8_BAR; PG8_MMA(0, 0, At, B0); PG8_MMA(0, 1, At, B1); PG8_BAR; PG8_SCHED;
            PG8_LDA(At, 0, 1); PG8_STAGE(PG8_SB(0, 0), b2, voffB); PG8_STAGE(PG8_SB(0, 1), b2 + hstep, voffB); PG8_STAGE(PG8_SA(0, 0), a2, voffA);
            PG8_WAIT_V(8); PG8_WAIT_L(0); PG8_BAR; PG8_MMA(1, 0, At, B0); PG8_MMA(1, 1, At, B1); PG8_BAR; PG8_SCHED;
            PG8_LDB(B0, 1, 0); PG8_LDB(B1, 1, 1); PG8_SCHED; PG8_LDA(At, 1, 0); PG8_STAGE(PG8_SA(0, 1), a2 + hstep, voffA);
            PG8_WAIT_V(8); PG8_WAIT_L(0); PG8_BAR; PG8_MMA(0, 0, At, B0); PG8_MMA(0, 1, At, B1); PG8_BAR; PG8_SCHED;
            PG8_LDA(At, 1, 1); PG8_STAGE(PG8_SB(1, 0), b3, voffB); PG8_STAGE(PG8_SB(1, 1), b3 + hstep, voffB); PG8_STAGE(PG8_SA(1, 0), a3, voffA);
            PG8_WAIT_V(8); PG8_WAIT_L(0); PG8_BAR; PG8_MMA(1, 0, At, B0); PG8_MMA(1, 1, At, B1); PG8_BAR; PG8_SCHED;
            } else {
            PG8_LDB(B0, 0, 0); PG8_SCHED; PG8_LDA(At, 0, 0); PG8_STAGE(PG8_SA(1, 1), a1 + hstep, voffA);
            PG8_WAIT_L(8); PG8_BAR; PG8_WAIT_L(0); PG8_MMA(0, 0, At, B0); PG8_BAR; PG8_SCHED;
            PG8_LDB(B1, 0, 1); PG8_STAGE(PG8_SB(0, 0), b2, voffB);
            PG8_BAR; PG8_WAIT_L(0); PG8_MMA(0, 1, At, B1); PG8_BAR;
            PG8_LDA(At, 0, 1); PG8_STAGE(PG8_SA(0, 0), a2, voffA);
            PG8_BAR; PG8_WAIT_L(0); PG8_MMA(1, 0, At, B0); PG8_BAR; PG8_SCHED;
            PG8_STAGE(PG8_SB(0, 1), b2 + hstep, voffB);
            PG8_WAIT_V(6); PG8_BAR; PG8_MMA(1, 1, At, B1); PG8_BAR;
            PG8_LDB(B0, 1, 0); PG8_SCHED; PG8_LDA(At, 1, 0); PG8_STAGE(PG8_SA(0, 1), a2 + hstep, voffA);
            PG8_WAIT_L(8); PG8_BAR; PG8_WAIT_L(0); PG8_MMA(0, 0, At, B0); PG8_BAR; PG8_SCHED;
            PG8_LDB(B1, 1, 1); PG8_STAGE(PG8_SB(1, 0), b3, voffB);
            PG8_BAR; PG8_WAIT_L(0); PG8_MMA(0, 1, At, B1); PG8_BAR;
            PG8_LDA(At, 1, 1); PG8_STAGE(PG8_SA(1, 0), a3, voffA);
            PG8_BAR; PG8_WAIT_L(0); PG8_MMA(1, 0, At, B0); PG8_BAR; PG8_SCHED;
            PG8_STAGE(PG8_SB(1, 1), b3 + hstep, voffB);
            PG8_WAIT_V(6); PG8_BAR; PG8_MMA(1, 1, At, B1); PG8_BAR;
            }
        }
        if constexpr (ALIGN_EPI) { if (wr == 0) PG8_BAR; }
        if constexpr (!Epi::AFTER_DRAIN) { E(acc, cur, wr, wc, fr, fq); S.done(cur); }
        if (!has_next) break;
#pragma unroll
        for (int a = 0; a < 2; ++a)
#pragma unroll
            for (int b = 0; b < 2; ++b)
#pragma unroll
                for (int m = 0; m < 4; ++m)
#pragma unroll
                    for (int n = 0; n < 2; ++n) acc[a][b][m][n] = (f32x4){0.f, 0.f, 0.f, 0.f};
        cur = nxt; cA = nA; cB = nB; ++ui;
        if constexpr (ALIGN_EPI) { if (wr == 1) PG8_BAR; }
    }
    PG8_WAIT_V(0);
    if constexpr (!ALIGN_EPI) { if (wr == 0) PG8_BAR; }
    PG8_BAR;
    if constexpr (Epi::AFTER_DRAIN) { E.fused(acc, cur, wr, wc, fr, fq, lds, wid, lane); S.done(cur); }
#undef PG8_SA
#undef PG8_SB
#undef PG8_STAGE
#undef PG8_LDA
#undef PG8_LDB
#undef PG8_MMA
#undef PG8_WAIT_V
#undef PG8_WAIT_L
#undef PG8_BAR
#undef PG8_SCHED
}
}
constexpr int NWAVES = 8;
constexpr int BATCH = 4, SEQ = 2048, DM = 2048, DEPTH = 2;
constexpr int M = BATCH * SEQ;
constexpr int GW = 512;
constexpr int IN_COLS = 5648, IN_PAD = 5888;
constexpr int DFF = 5632, MEML = 256, XH = 4, XHD = 512;
constexpr int MROWS = BATCH * MEML;
constexpr float EPS = 1e-6f;
constexpr int UA_B = 0, UA_C = 512, UA_H = 1024, UB = 1536, UC_Q = 2048, UC_Z = 3584, UC_A = 4096, UC_B = 4100, UD_Z = 4104, UD_X = 4616, UD_DT = 5640;
constexpr int MIX_PRE = 0, MIX_POST = 1, XA_PRE = 2, XA_POST = 3, MEM_NORM = 4, FFN_PRE = 5, FFN_POST = 6, N_NORMS = 7;
enum { I_X = 0, I_MEM, I_NORMG, I_WIN, I_CONVA, I_POOLW, I_POOLS, I_GCONV, I_GALOG, I_GDTB, I_GNG, I_SCONVW, I_SCONVB, I_SALOG, I_SDTB, I_SD, I_SNG, I_WOUT, I_WQ, I_WKV, I_WO, I_WGU, I_WD, N_IN };

constexpr size_t MiB = 1u << 20;
constexpr size_t WS_CTL = 0, CTL_ZERO_BYTES = 1 * MiB;
constexpr size_t WSZ_WIN = (size_t)IN_PAD * DM * 2, WSZ_SQ = (size_t)DM * DM * 2, WSZ_KV = (size_t)2 * DM * DM * 2, WSZ_GU = (size_t)2 * DFF * DM * 2, WSZ_D = (size_t)DM * DFF * 2;
constexpr size_t WO_WIN = 0, WO_WOUT = WO_WIN + WSZ_WIN, WO_WQ = WO_WOUT + WSZ_SQ, WO_WKV = WO_WQ + WSZ_SQ, WO_WO = WO_WKV + WSZ_KV, WO_WGU = WO_WO + WSZ_SQ, WO_WD = WO_WGU + WSZ_GU, W_LAYER = WO_WD + WSZ_D;
constexpr size_t WS_W = 1 * MiB;
constexpr size_t WS_XN = WS_W + 2 * W_LAYER;
constexpr size_t WS_MIX = WS_XN + (size_t)M * DM * 2;
constexpr size_t WS_MEMN = WS_MIX + (size_t)M * DM * 2;
constexpr size_t WS_KB = WS_MEMN + (size_t)2 * MROWS * DM * 2;
constexpr size_t WS_VT = WS_KB + (size_t)2 * MROWS * DM * 2;
constexpr size_t WS_U = WS_VT + (size_t)2 * MROWS * DM * 2;
constexpr size_t WS_Q = WS_U, WS_HID = WS_U + (size_t)M * DM * 2;
constexpr size_t WS_SCR = WS_U + (size_t)M * IN_PAD * 4;
constexpr size_t WS_Y = WS_SCR;
constexpr size_t SZ512 = (size_t)M * 512 * 4, SZ256 = (size_t)M * 256 * 4, SZ8 = (size_t)M * 8 * 4;
constexpr size_t WS_QN = WS_SCR, WS_KN = WS_QN + SZ512, WS_VV = WS_KN + SZ512, WS_OG = WS_VV + SZ512, WS_XS = WS_OG + SZ512, WS_YS = WS_XS + SZ512,
                 WS_BS = WS_YS + SZ512, WS_CS = WS_BS + SZ256, WS_GB = WS_CS + SZ256, WS_DT = WS_GB + SZ8, WS_END = WS_DT + SZ8;
static_assert(WS_Y + (size_t)M * DM * 4 <= WS_END, "Y inside the scan region");
static_assert(WS_HID + (size_t)M * DFF * 2 <= WS_SCR, "HID inside U");
static_assert(WS_END <= (size_t)704 * MiB, "d_ws map fits 4 x the largest input");

constexpr int RING_OFF = 0, RING_BYTES = 131072;
constexpr int LDSCTL_OFF = RING_BYTES, MISC_OFF = LDSCTL_OFF + 320;
constexpr int LDS_BYTES = 147456;
constexpr int CW_BAR = 4096;

#define GAS __attribute__((address_space(1)))
#define LAS __attribute__((address_space(3)))
typedef unsigned short bf16;
typedef unsigned v4u __attribute__((ext_vector_type(4)));
typedef unsigned v2u __attribute__((ext_vector_type(2)));
typedef float f32x4 __attribute__((ext_vector_type(4)));
typedef short bf16x8 __attribute__((ext_vector_type(8)));
#define LDS_WAIT() asm volatile("s_waitcnt lgkmcnt(0)" ::: "memory")
#define VM_WAIT() asm volatile("s_waitcnt vmcnt(0)" ::: "memory")
__device__ __forceinline__ unsigned f2bf(float f) { unsigned u = __builtin_bit_cast(unsigned, f); return (u + 0x7fffu + ((u >> 16) & 1u)) >> 16; }
__device__ __forceinline__ unsigned pk2(float lo, float hi) { return f2bf(lo) | (f2bf(hi) << 16); }
__device__ __forceinline__ float siluf(float v) { return v / (1.0f + __expf(-v)); }
__device__ __forceinline__ float softplusf(float v) { return fmaxf(v, 0.f) + log1pf(__expf(-fabsf(v))); }
__device__ __forceinline__ float sigmoidf(float v) { return 1.0f / (1.0f + __expf(-v)); }
template <int CTRL> __device__ __forceinline__ float dppf(float v) { return __builtin_bit_cast(float, __builtin_amdgcn_update_dpp(0, __builtin_bit_cast(int, v), CTRL, 0xF, 0xF, true)); }
__device__ __forceinline__ float row16_sum(float v) { v += dppf<0xB1>(v); v += dppf<0x4E>(v); v += dppf<0x141>(v); v += dppf<0x140>(v); return v; }
__device__ __forceinline__ int opq(int v) { asm volatile("" : "+v"(v)); return v; }
__device__ __forceinline__ float wave_sum(float v) {
#pragma unroll
    for (int o = 1; o < 64; o <<= 1) v += __shfl_xor(v, o);
    return v;
}

#define XB_TMO      128
#define XB_XCNT(j)  (256  + 64 * (j))
#define XB_XSUB(j)  (1280 + 64 * (j))
#define XB_XGEN(j)  (2304 + 64 * (j))
#define XB_TOP      3328
#define XB_TOPGEN   3392
#define XCD_BAR_WORDS 3456
#define XB_SPIN_CAP (1u << 18)

__device__ __forceinline__ unsigned xb_ld(unsigned* p)              { return __hip_atomic_load(p, __ATOMIC_RELAXED, __HIP_MEMORY_SCOPE_AGENT); }
__device__ __forceinline__ unsigned xb_add(unsigned* p, unsigned v) { return __hip_atomic_fetch_add(p, v, __ATOMIC_RELAXED, __HIP_MEMORY_SCOPE_AGENT); }
__device__ __forceinline__ unsigned xb_xcc_id() { return (unsigned)__builtin_amdgcn_s_getreg((3 << 11) | 20) & 0xFu; }
#define XB_SPIN(cond, bar) do { unsigned _sp = 0; while (cond) { __builtin_amdgcn_s_sleep(1); \
    if ((++_sp & 255u) == 0u) { if (xb_ld(&(bar)[XB_TMO])) break; if (_sp > XB_SPIN_CAP) { atomicAdd(&(bar)[XB_TMO], 1u); break; } } } } while (0)

struct XcdBarrier {
    unsigned* bar; unsigned x;
    volatile LAS unsigned* st;
};

__device__ __forceinline__ XcdBarrier xcd_barrier_post(unsigned* bar, volatile LAS unsigned* st) {
    XcdBarrier b; b.bar = bar; b.x = xb_xcc_id(); b.st = st;
    if (threadIdx.x == 0) (void)xb_add(&bar[XB_XCNT(b.x)], 1u);
    return b;
}
__device__ __forceinline__ void xcd_barrier_complete(unsigned* bar, unsigned x, unsigned& nloc, unsigned& nx) {
    const unsigned G = gridDim.x * gridDim.y * gridDim.z;
    unsigned sum, cnt, mine, sp = 0u;
    for (;;) {
        sum = 0u; cnt = 0u; mine = 0u;
#pragma unroll
        for (unsigned j = 0; j < 16; ++j) { const unsigned c = xb_ld(&bar[XB_XCNT(j)]); sum += c; cnt += (c > 0u) ? 1u : 0u; mine = (j == x) ? c : mine; }
        if (sum == G) break;
        __builtin_amdgcn_s_sleep(1);
        if ((++sp & 255u) == 0u) { if (xb_ld(&bar[XB_TMO])) break; if (sp > XB_SPIN_CAP) { atomicAdd(&bar[XB_TMO], 1u); break; } }
    }
    nloc = mine > 0u ? mine : 1u; nx = cnt > 0u ? cnt : 1u;
}

__device__ __forceinline__ void xcd_barrier(const XcdBarrier& b) {
    asm volatile("s_waitcnt vmcnt(0)" ::: "memory");
    __syncthreads();
    if (threadIdx.x == 0) {
        unsigned* bar = b.bar;
        __builtin_amdgcn_s_waitcnt(0);
        unsigned nloc = b.st[0], nx = b.st[1];
        if (nloc == 0u) { xcd_barrier_complete(bar, b.x, nloc, nx); b.st[0] = nloc; b.st[1] = nx; }
        const unsigned old = xb_add(&bar[XB_XSUB(b.x)], 1u);
        const unsigned gen = old / nloc;
        if (old + 1u == (gen + 1u) * nloc) {
            __builtin_amdgcn_fence(__ATOMIC_RELEASE, "agent");
            asm volatile("s_waitcnt vmcnt(0)" ::: "memory");
            const unsigned og = xb_add(&bar[XB_TOP], 1u);
            const unsigned tg = og / nx;
            if (og + 1u == (tg + 1u) * nx) xb_add(&bar[XB_TOPGEN], 1u);
            else XB_SPIN(xb_ld(&bar[XB_TOPGEN]) == tg, bar);
            __builtin_amdgcn_fence(__ATOMIC_ACQUIRE, "agent");
            xb_add(&bar[XB_XGEN(b.x)], 1u);
            asm volatile("s_waitcnt vmcnt(0)" ::: "memory");
        } else {
            XB_SPIN(xb_ld(&bar[XB_XGEN(b.x)]) == gen, bar);
            __builtin_amdgcn_fence(__ATOMIC_ACQUIRE, "agent");
            asm volatile("s_waitcnt vmcnt(0)" ::: "memory");
        }
    }
    __syncthreads();
}
struct Frame {
    LAS unsigned char* lds;
    volatile LAS unsigned* MISC;
    unsigned* ctl;
    int tid, lane, wave;
    int vcu, G;
    float* out; unsigned char* ws;
};
__device__ __forceinline__ const float* inp(int i) { const float* __attribute__((address_space(4))) const* tab = (const float* __attribute__((address_space(4))) const*)__builtin_amdgcn_kernarg_segment_ptr(); asm volatile("" : "+s"(tab)); return tab[i]; }
__device__ __forceinline__ bf16* wsb(const Frame& F, size_t off) { return (bf16*)(F.ws + off); }
__device__ __forceinline__ float* wsf(const Frame& F, size_t off) { return (float*)(F.ws + off); }

__device__ __forceinline__ void p0_transpose_item(const float* W, int K, int N, bf16* WT, int drow0, int k0, int n0, LAS float* scr, int lane) {
    const int nn = n0 + (lane & 31); const bool ok = nn < N;
#pragma unroll 8
    for (int i = 0; i < 32; ++i) { const int kk = 2 * i + (lane >> 5); scr[kk * 33 + (lane & 31)] = ok ? W[(size_t)(k0 + kk) * N + nn] : 0.f; }
    LDS_WAIT(); asm volatile("" ::: "memory");
    const int c = lane & 7;
#pragma unroll
    for (int j = 0; j < 4; ++j) { const int n = (lane >> 3) + 8 * j; const LAS float* s = scr + (8 * c) * 33 + n;
        v4u o; o.x = pk2(s[0 * 33], s[1 * 33]); o.y = pk2(s[2 * 33], s[3 * 33]); o.z = pk2(s[4 * 33], s[5 * 33]); o.w = pk2(s[6 * 33], s[7 * 33]);
        *(v4u*)(WT + (size_t)(drow0 + n) * K + k0 + 8 * c) = o; }
    LDS_WAIT(); asm volatile("" ::: "memory");
}
__device__ __forceinline__ void norm_row_to_bf16(const float* xrow, const float* g, bf16* orow, int lane) {
    const f32x4* xr = (const f32x4*)xrow + lane; const f32x4* gr = (const f32x4*)g + lane;
    f32x4 v[8]; float s = 0.f;
#pragma unroll
    for (int j = 0; j < 8; ++j) { v[j] = xr[64 * j]; s += (v[j].x * v[j].x + v[j].y * v[j].y) + (v[j].z * v[j].z + v[j].w * v[j].w); }
    const float rstd = 1.0f / sqrtf(wave_sum(s) * (1.0f / DM) + EPS);
    v2u* o8 = (v2u*)orow + lane;
#pragma unroll
    for (int j = 0; j < 8; ++j) { const f32x4 gg = gr[64 * j]; v2u w; w.x = pk2(v[j].x * rstd * gg.x, v[j].y * rstd * gg.y); w.y = pk2(v[j].z * rstd * gg.z, v[j].w * rstd * gg.w); o8[64 * j] = w; }
}
__device__ __forceinline__ void p0_prologue(Frame& F) {
    LAS float* scr = (LAS float*)(F.lds + RING_OFF + F.wave * 16384);
    const int gw = F.vcu * NWAVES + F.wave, NGW = F.G * NWAVES; const int lane = opq(F.lane), tid = opq(F.tid);
    constexpr int NB_IN = (IN_COLS + 31) / 32;
    constexpr int I_IN = (DM / 64) * NB_IN, I_SQ = (DM / 64) * (DM / 32), I_KV = (DM / 64) * (2 * DM / 32), I_GU = (DM / 64) * (2 * DFF / 32), I_D = (DFF / 64) * (DM / 32);
    constexpr int I_LAYER = I_IN + 3 * I_SQ + I_KV + I_GU + I_D;
    for (int it = gw; it < DEPTH * I_LAYER; it += NGW) {
        const int l = it / I_LAYER; int r = it % I_LAYER;
        bf16* wl = wsb(F, WS_W + (size_t)l * W_LAYER);
        if (r < I_IN) { const int kb = r / NB_IN, nb = r % NB_IN; p0_transpose_item(inp(I_WIN) + (size_t)l * DM * IN_COLS, DM, IN_COLS, (bf16*)((char*)wl + WO_WIN), 32 * nb, 64 * kb, 32 * nb, scr, lane); continue; } r -= I_IN;
        if (r < I_SQ) { const int kb = r / (DM / 32), nb = r % (DM / 32); p0_transpose_item(inp(I_WOUT) + (size_t)l * DM * DM, DM, DM, (bf16*)((char*)wl + WO_WOUT), 32 * nb, 64 * kb, 32 * nb, scr, lane); continue; } r -= I_SQ;
        if (r < I_SQ) { const int kb = r / (DM / 32), nb = r % (DM / 32); p0_transpose_item(inp(I_WQ) + (size_t)l * DM * DM, DM, DM, (bf16*)((char*)wl + WO_WQ), 32 * nb, 64 * kb, 32 * nb, scr, lane); continue; } r -= I_SQ;
        if (r < I_SQ) { const int kb = r / (DM / 32), nb = r % (DM / 32); p0_transpose_item(inp(I_WO) + (size_t)l * DM * DM, DM, DM, (bf16*)((char*)wl + WO_WO), 32 * nb, 64 * kb, 32 * nb, scr, lane); continue; } r -= I_SQ;
        if (r < I_KV) { const int kb = r / (2 * DM / 32), nb = r % (2 * DM / 32); p0_transpose_item(inp(I_WKV) + (size_t)l * DM * 2 * DM, DM, 2 * DM, (bf16*)((char*)wl + WO_WKV), 32 * nb, 64 * kb, 32 * nb, scr, lane); continue; } r -= I_KV;
        if (r < I_GU) { const int kb = r / (2 * DFF / 32), nb = r % (2 * DFF / 32); const int n0 = 32 * nb; const int up = n0 >= DFF ? 1 : 0, j0 = n0 - up * DFF;
            const int drow = (j0 >> 7) * 256 + up * 128 + (j0 & 127);
            p0_transpose_item(inp(I_WGU) + (size_t)l * DM * 2 * DFF, DM, 2 * DFF, (bf16*)((char*)wl + WO_WGU), drow, 64 * kb, n0, scr, lane); continue; } r -= I_GU;
        { const int kb = r / (DM / 32), nb = r % (DM / 32); p0_transpose_item(inp(I_WD) + (size_t)l * DFF * DM, DFF, DM, (bf16*)((char*)wl + WO_WD), 32 * nb, 64 * kb, 32 * nb, scr, lane); }
    }
    { constexpr int ZR0 = 32 * NB_IN, ZN = (IN_PAD - ZR0) * DM / 8;
      for (int i = (F.vcu * NWAVES * 64) + tid; i < DEPTH * ZN; i += F.G * NWAVES * 64) { const int l = i / ZN, k = i % ZN;
          ((v4u*)(F.ws + WS_W + (size_t)l * W_LAYER + WO_WIN + (size_t)ZR0 * DM * 2))[k] = (v4u){0u, 0u, 0u, 0u}; } }
    for (int m = gw; m < DEPTH * MROWS; m += NGW) { const int l = m / MROWS, r = m % MROWS;
        norm_row_to_bf16(inp(I_MEM) + (size_t)r * DM, inp(I_NORMG) + (size_t)(l * N_NORMS + MEM_NORM) * DM, wsb(F, WS_MEMN) + (size_t)m * DM, lane); }
    for (int m = gw; m < M; m += NGW) norm_row_to_bf16(inp(I_X) + (size_t)m * DM, inp(I_NORMG) + (size_t)(0 * N_NORMS + MIX_PRE) * DM, wsb(F, WS_XN) + (size_t)m * DM, lane);
}

__device__ __forceinline__ void resnorm_phase(Frame& F, const float* xin, const float* gpost, const float* gpre  ) {
    const int gw = F.vcu * NWAVES + F.wave, NGW = F.G * NWAVES, lane = opq(F.lane);
    const float* Y = wsf(F, WS_Y); bf16* XN = wsb(F, WS_XN);
    for (int m = gw; m < M; m += NGW) {
        const f32x4* yr = (const f32x4*)(Y + (size_t)m * DM) + lane; const f32x4* xr = (const f32x4*)(xin + (size_t)m * DM) + lane;
        f32x4* xo = (f32x4*)(F.out + (size_t)m * DM) + lane;
        f32x4 y[8], x[8]; float s = 0.f;
#pragma unroll
        for (int j = 0; j < 8; ++j) { y[j] = yr[64 * j]; x[j] = xr[64 * j]; s += (y[j].x * y[j].x + y[j].y * y[j].y) + (y[j].z * y[j].z + y[j].w * y[j].w); }
        const float rstd = 1.0f / sqrtf(wave_sum(s) * (1.0f / DM) + EPS);
        float s2 = 0.f;
#pragma unroll
        for (int j = 0; j < 8; ++j) { const f32x4 gg = ((const f32x4*)gpost)[lane + 64 * j]; x[j] = x[j] + y[j] * rstd * gg; xo[64 * j] = x[j];
            s2 += (x[j].x * x[j].x + x[j].y * x[j].y) + (x[j].z * x[j].z + x[j].w * x[j].w); }
        if (gpre) {
            const float r2 = 1.0f / sqrtf(wave_sum(s2) * (1.0f / DM) + EPS);
            v2u* o8 = (v2u*)(XN + (size_t)m * DM) + lane;
#pragma unroll
            for (int j = 0; j < 8; ++j) { const f32x4 gg = ((const f32x4*)gpre)[lane + 64 * j]; v2u w; w.x = pk2(x[j].x * r2 * gg.x, x[j].y * r2 * gg.y); w.y = pk2(x[j].z * r2 * gg.z, x[j].w * r2 * gg.w); o8[64 * j] = w; }
        }
    }
}

__device__ __forceinline__ f32x4 ld4(const float* p) { return *(const f32x4*)p; }
__device__ __forceinline__ f32x4 silu4(f32x4 v) { return (f32x4){siluf(v.x), siluf(v.y), siluf(v.z), siluf(v.w)}; }
__device__ __forceinline__ void mixer_prep_phase(Frame& F, int l) {
    const int gw = F.vcu * NWAVES + F.wave, NGW = F.G * NWAVES, lane = opq(F.lane), tid = opq(F.tid);
    const float* U = wsf(F, WS_U);
    bf16* MIX = wsb(F, WS_MIX);
    constexpr int NSTRIP = M / 16;
    for (int it = gw; it < 16 * NSTRIP; it += NGW) {
        const int type = it & 15, strip = it >> 4, r0 = strip * 16, pos0 = r0 & (SEQ - 1);
        if (type < 2) {
            const int c = type * 256 + lane * 4;
            const float* cw = inp(I_CONVA) + (size_t)l * 3 * GW + c;
            const f32x4 w0 = ld4(cw), w1 = ld4(cw + GW), w2 = ld4(cw + 2 * GW);
            f32x4 p2 = (f32x4){0.f, 0.f, 0.f, 0.f}, p1 = p2;
            if (pos0 >= 2) { const float* u2 = U + (size_t)(r0 - 2) * IN_PAD; const float* u1 = U + (size_t)(r0 - 1) * IN_PAD;
                p2 = ld4(u2 + UA_C + c) * ld4(u2 + UA_H + c); p1 = ld4(u1 + UA_C + c) * ld4(u1 + UA_H + c); }
#pragma unroll 4
            for (int i = 0; i < 16; ++i) { const float* ur = U + (size_t)(r0 + i) * IN_PAD;
                const f32x4 p0 = ld4(ur + UA_C + c) * ld4(ur + UA_H + c);
                const f32x4 y = ld4(ur + UA_B + c) * (w0 * p2 + w1 * p1 + w2 * p0);
                v2u o; o.x = pk2(y.x, y.y); o.y = pk2(y.z, y.w); *(v2u*)(MIX + (size_t)(r0 + i) * DM + c) = o;
                p2 = p1; p1 = p0; }
        } else if (type < 8) {
            const int gi = type - 2, c = gi * 256 + lane * 4;
            const float* cw = inp(I_GCONV) + (size_t)l * 4 * 3 * GW + c;
            const f32x4 w0 = ld4(cw), w1 = ld4(cw + 3 * GW), w2 = ld4(cw + 6 * GW), w3 = ld4(cw + 9 * GW);
            f32x4 x3 = (f32x4){0.f, 0.f, 0.f, 0.f}, x2 = x3, x1 = x3;
            if (pos0 >= 3) { x3 = ld4(U + (size_t)(r0 - 3) * IN_PAD + UC_Q + c); x2 = ld4(U + (size_t)(r0 - 2) * IN_PAD + UC_Q + c); x1 = ld4(U + (size_t)(r0 - 1) * IN_PAD + UC_Q + c); }
            float* dst = (gi < 2) ? wsf(F, WS_QN) + gi * 256 : (gi < 4) ? wsf(F, WS_KN) + (gi - 2) * 256 : wsf(F, WS_VV) + (gi - 4) * 256;
            const float qs = (gi < 2) ? 0.08838834764831845f : 1.0f;
#pragma unroll 4
            for (int i = 0; i < 16; ++i) { const f32x4 x0 = ld4(U + (size_t)(r0 + i) * IN_PAD + UC_Q + c);
                f32x4 y = silu4(w0 * x3 + w1 * x2 + w2 * x1 + w3 * x0);
                if (gi < 4) { float ss = (y.x * y.x + y.y * y.y) + (y.z * y.z + y.w * y.w);
                    ss += __shfl_xor(ss, 1); ss += __shfl_xor(ss, 2); ss += __shfl_xor(ss, 4); ss += __shfl_xor(ss, 8); ss += __shfl_xor(ss, 16);
                    y = y * (qs / sqrtf(ss + EPS)); }
                *(f32x4*)(dst + (size_t)(r0 + i) * GW + lane * 4) = y;
                x3 = x2; x2 = x1; x1 = x0; }
        } else if (type < 12) {
            const int gi = type - 8, c = gi * 256 + lane * 4;
            const float* cw = inp(I_SCONVW) + (size_t)l * 4 * 1024 + c;
            const f32x4 w0 = ld4(cw), w1 = ld4(cw + 1024), w2 = ld4(cw + 2048), w3 = ld4(cw + 3072), bb = ld4(inp(I_SCONVB) + (size_t)l * 1024 + c);
            f32x4 x3 = (f32x4){0.f, 0.f, 0.f, 0.f}, x2 = x3, x1 = x3;
            if (pos0 >= 3) { x3 = ld4(U + (size_t)(r0 - 3) * IN_PAD + UD_X + c); x2 = ld4(U + (size_t)(r0 - 2) * IN_PAD + UD_X + c); x1 = ld4(U + (size_t)(r0 - 1) * IN_PAD + UD_X + c); }
            float* dst; int ld;
            if (gi < 2) { dst = wsf(F, WS_XS) + gi * 256; ld = 512; } else if (gi == 2) { dst = wsf(F, WS_BS); ld = 256; } else { dst = wsf(F, WS_CS); ld = 256; }
#pragma unroll 4
            for (int i = 0; i < 16; ++i) { const f32x4 x0 = ld4(U + (size_t)(r0 + i) * IN_PAD + UD_X + c);
                const f32x4 y = silu4(w0 * x3 + w1 * x2 + w2 * x1 + w3 * x0 + bb);
                *(f32x4*)(dst + (size_t)(r0 + i) * ld + lane * 4) = y;
                x3 = x2; x2 = x1; x1 = x0; }
        } else {
            const int gi = type - 12, w = 2 << gi;
            LAS float* scr = (LAS float*)(F.lds + RING_OFF + F.wave * 16384);
            const int c0 = UB + gi * 128 + lane * 2;
            float r0s = 0.f, r1s = 0.f;
            if (pos0 > 0) { for (int s = 1; s < w; ++s) { const float* up = U + (size_t)(r0 - s) * IN_PAD + c0; r0s += up[0]; r1s += up[1]; } }
            for (int i = 0; i < 16; ++i) { const int pos = pos0 + i; const float* ur = U + (size_t)(r0 + i) * IN_PAD + c0;
                const float a0 = ur[0], a1 = ur[1];
                r0s += a0; r1s += a1;
                const float cnt = (float)((pos + 1 < w) ? pos + 1 : w);
                scr[i * 128 + lane * 2] = r0s / cnt - a0; scr[i * 128 + lane * 2 + 1] = r1s / cnt - a1;
                if (pos - w + 1 >= 0) { const float* ud = U + (size_t)(r0 + i - w + 1) * IN_PAD + c0; r0s -= ud[0]; r1s -= ud[1]; } }
            LDS_WAIT(); asm volatile("" ::: "memory");
            float acc0[16], acc1[16];
#pragma unroll
            for (int i = 0; i < 16; ++i) { acc0[i] = 0.f; acc1[i] = 0.f; }
            const float* pw = inp(I_POOLW) + ((size_t)l * 4 + gi) * 128 * 128;
            for (int cc = 0; cc < 128; cc += 4) {
                float wa[4], wb[4];
#pragma unroll
                for (int q = 0; q < 4; ++q) { wa[q] = pw[(size_t)(cc + q) * 128 + lane]; wb[q] = pw[(size_t)(cc + q) * 128 + 64 + lane]; }
#pragma unroll
                for (int i = 0; i < 16; ++i) { const f32x4 p = *(const LAS f32x4*)(scr + i * 128 + cc);
                    acc0[i] += p.x * wa[0] + p.y * wa[1] + p.z * wa[2] + p.w * wa[3]; acc1[i] += p.x * wb[0] + p.y * wb[1] + p.z * wb[2] + p.w * wb[3]; }
            }
            const float s0 = inp(I_POOLS)[(size_t)l * GW + gi * 128 + lane], s1 = inp(I_POOLS)[(size_t)l * GW + gi * 128 + 64 + lane];
#pragma unroll
            for (int i = 0; i < 16; ++i) { bf16* o = MIX + (size_t)(r0 + i) * DM + GW + gi * 128; o[lane] = (bf16)f2bf(acc0[i] * s0); o[64 + lane] = (bf16)f2bf(acc1[i] * s1); }
            LDS_WAIT(); asm volatile("" ::: "memory");
        }
    }
    for (int i = (F.vcu * NWAVES * 64) + tid; i < M * 16; i += F.G * NWAVES * 64) { const int t = i >> 4, j = i & 15; const float* ur = U + (size_t)t * IN_PAD;
        if (j < 4) { wsf(F, WS_GB)[(size_t)t * 8 + j] = -__expf(inp(I_GALOG)[l * 4 + j]) * softplusf(ur[UC_A + j] + inp(I_GDTB)[l * 4 + j]); }
        else if (j < 8) { wsf(F, WS_GB)[(size_t)t * 8 + j] = sigmoidf(ur[UC_B + (j - 4)]); }
        else { wsf(F, WS_DT)[(size_t)t * 8 + (j - 8)] = softplusf(ur[UD_DT + (j - 8)] + inp(I_SDTB)[l * 8 + (j - 8)]); } }
}

__device__ __forceinline__ void scan_phase(Frame& F, int l) {
    const int lane = opq(F.lane), sub = lane & 15, grp = lane >> 4;
    if (F.wave >= 4) return;
    for (int item = F.vcu * 4 + F.wave; item < 1024; item += F.G * 4) {
    if (item < 512) {
        const int b = item >> 7, h = (item >> 5) & 3, j = (item & 31) * 4 + grp;
        const float* KN = wsf(F, WS_KN) + (size_t)b * SEQ * GW + h * 128 + sub * 8;
        const float* QN = wsf(F, WS_QN) + (size_t)b * SEQ * GW + h * 128 + sub * 8;
        const float* VV = wsf(F, WS_VV) + (size_t)b * SEQ * GW + h * 128 + j;
        const float* GB = wsf(F, WS_GB) + (size_t)b * SEQ * 8 + h;
        float* OG = wsf(F, WS_OG) + (size_t)b * SEQ * GW + h * 128 + j;
        float S[8];
#pragma unroll
        for (int i = 0; i < 8; ++i) S[i] = 0.f;
        f32x4 ka = ld4(KN), kb = ld4(KN + 4), qa = ld4(QN), qb = ld4(QN + 4); float v = VV[0], g = GB[0], be = GB[4];
        for (int t = 0; t < SEQ; ++t) {
            const int tn = (t + 1 < SEQ) ? t + 1 : t;
            const f32x4 nka = ld4(KN + (size_t)tn * GW), nkb = ld4(KN + (size_t)tn * GW + 4), nqa = ld4(QN + (size_t)tn * GW), nqb = ld4(QN + (size_t)tn * GW + 4);
            const float nv = VV[(size_t)tn * GW], ng = GB[(size_t)tn * 8], nbe = GB[(size_t)tn * 8 + 4];
            const float k[8] = {ka.x, ka.y, ka.z, ka.w, kb.x, kb.y, kb.z, kb.w}, q[8] = {qa.x, qa.y, qa.z, qa.w, qb.x, qb.y, qb.z, qb.w};
            float ks = 0.f;
#pragma unroll
            for (int i = 0; i < 8; ++i) ks += k[i] * S[i];
            ks = row16_sum(ks);
            const float eg = __expf(g), delta = be * (v - eg * ks);
            float o = 0.f;
#pragma unroll
            for (int i = 0; i < 8; ++i) { S[i] = eg * S[i] + k[i] * delta; o += q[i] * S[i]; }
            o = row16_sum(o);
            if (sub == 0) OG[(size_t)t * GW] = o;
            ka = nka; kb = nkb; qa = nqa; qb = nqb; v = nv; g = ng; be = nbe;
        }
    } else {
        const int it2 = item - 512, b = it2 >> 7, hh = (it2 >> 4) & 7, p = (it2 & 15) * 4 + grp, gq = hh >> 2;
        const float* BS = wsf(F, WS_BS) + (size_t)b * SEQ * 256 + gq * 128 + sub * 8;
        const float* CS = wsf(F, WS_CS) + (size_t)b * SEQ * 256 + gq * 128 + sub * 8;
        const float* XS = wsf(F, WS_XS) + (size_t)b * SEQ * GW + hh * 64 + p;
        const float* DT = wsf(F, WS_DT) + (size_t)b * SEQ * 8 + hh;
        float* YS = wsf(F, WS_YS) + (size_t)b * SEQ * GW + hh * 64 + p;
        const float A = -__expf(inp(I_SALOG)[l * 8 + hh]), Dk = inp(I_SD)[l * 8 + hh];
        float hs[8];
#pragma unroll
        for (int i = 0; i < 8; ++i) hs[i] = 0.f;
        f32x4 ba = ld4(BS), bb = ld4(BS + 4), ca = ld4(CS), cb = ld4(CS + 4); float x = XS[0], dt = DT[0];
        for (int t = 0; t < SEQ; ++t) {
            const int tn = (t + 1 < SEQ) ? t + 1 : t;
            const f32x4 nba = ld4(BS + (size_t)tn * 256), nbb = ld4(BS + (size_t)tn * 256 + 4), nca = ld4(CS + (size_t)tn * 256), ncb = ld4(CS + (size_t)tn * 256 + 4);
            const float nx = XS[(size_t)tn * GW], ndt = DT[(size_t)tn * 8];
            const float Bv[8] = {ba.x, ba.y, ba.z, ba.w, bb.x, bb.y, bb.z, bb.w}, Cv[8] = {ca.x, ca.y, ca.z, ca.w, cb.x, cb.y, cb.z, cb.w};
            const float dA = __expf(dt * A), xd = x * dt;
            float y = 0.f;
#pragma unroll
            for (int i = 0; i < 8; ++i) { hs[i] = dA * hs[i] + xd * Bv[i]; y += hs[i] * Cv[i]; }
            y = row16_sum(y);
            if (sub == 0) YS[(size_t)t * GW] = y + Dk * x;
            ba = nba; bb = nbb; ca = nca; cb = ncb; x = nx; dt = ndt;
        }
    }
    }
}

__device__ __forceinline__ void mixer_post_phase(Frame& F, int l) {
    const int gw = F.vcu * NWAVES + F.wave, NGW = F.G * NWAVES, lane = opq(F.lane), c = lane * 8;
    const float* U = wsf(F, WS_U); bf16* MIX = wsb(F, WS_MIX);
    const float* gng = inp(I_GNG) + (size_t)l * 128 + (c & 127); const float* sng = inp(I_SNG) + (size_t)l * GW + c;
    const f32x4 g0 = ld4(gng), g1 = ld4(gng + 4), n0 = ld4(sng), n1 = ld4(sng + 4);
    for (int m = gw; m < M; m += NGW) {
        {
            const float* og = wsf(F, WS_OG) + (size_t)m * GW + c; const float* z = U + (size_t)m * IN_PAD + UC_Z + c;
            const f32x4 o0 = ld4(og), o1 = ld4(og + 4), z0 = ld4(z), z1 = ld4(z + 4);
            float ss = (o0.x * o0.x + o0.y * o0.y) + (o0.z * o0.z + o0.w * o0.w) + (o1.x * o1.x + o1.y * o1.y) + (o1.z * o1.z + o1.w * o1.w);
            ss += __shfl_xor(ss, 1); ss += __shfl_xor(ss, 2); ss += __shfl_xor(ss, 4); ss += __shfl_xor(ss, 8);
            const float rstd = 1.0f / sqrtf(ss * (1.0f / 128.0f) + EPS);
            const f32x4 y0 = o0 * rstd * g0 * silu4(z0), y1 = o1 * rstd * g1 * silu4(z1);
            v4u w; w.x = pk2(y0.x, y0.y); w.y = pk2(y0.z, y0.w); w.z = pk2(y1.x, y1.y); w.w = pk2(y1.z, y1.w);
            *(v4u*)(MIX + (size_t)m * DM + 2 * GW + c) = w;
        }
        {
            const float* ys = wsf(F, WS_YS) + (size_t)m * GW + c; const float* z = U + (size_t)m * IN_PAD + UD_Z + c;
            const f32x4 a0 = ld4(ys) * silu4(ld4(z)), a1 = ld4(ys + 4) * silu4(ld4(z + 4));
            float ss = (a0.x * a0.x + a0.y * a0.y) + (a0.z * a0.z + a0.w * a0.w) + (a1.x * a1.x + a1.y * a1.y) + (a1.z * a1.z + a1.w * a1.w);
            ss += __shfl_xor(ss, 1); ss += __shfl_xor(ss, 2); ss += __shfl_xor(ss, 4); ss += __shfl_xor(ss, 8); ss += __shfl_xor(ss, 16);
            const float rstd = 1.0f / sqrtf(ss * (1.0f / 256.0f) + EPS);
            const f32x4 y0 = a0 * rstd * n0, y1 = a1 * rstd * n1;
            v4u w; w.x = pk2(y0.x, y0.y); w.y = pk2(y0.z, y0.w); w.z = pk2(y1.x, y1.y); w.w = pk2(y1.z, y1.w);
            *(v4u*)(MIX + (size_t)m * DM + 3 * GW + c) = w;
        }
    }
}

__device__ __forceinline__ void attn_phase(Frame& F, int l) {
    const int lane = opq(F.lane), fr = lane & 15, fq = lane >> 4;
    const bf16* Q = wsb(F, WS_Q); const bf16* KB = wsb(F, WS_KB) + (size_t)l * MROWS * DM; const bf16* VT = wsb(F, WS_VT) + (size_t)l * DM * MROWS; bf16* O = wsb(F, WS_MIX);
    for (int unit = F.vcu; unit < BATCH * XH * (SEQ / 128); unit += F.G) {
        const int b = unit >> 6, h = (unit >> 4) & 3, qt = unit & 15;
        const int qrow0 = b * SEQ + qt * 128 + F.wave * 16;
        const bf16* qp = Q + (size_t)(qrow0 + fr) * DM + h * XHD + fq * 8;
        const bf16* kp = KB + (size_t)(b * MEML + fr) * DM + h * XHD + fq * 8;
        f32x4 acc[16];
#pragma unroll
        for (int n = 0; n < 16; ++n) acc[n] = (f32x4){0.f, 0.f, 0.f, 0.f};
        for (int ks = 0; ks < 16; ++ks) {
            const bf16x8 qf = *(const bf16x8*)(qp + ks * 32);
#pragma unroll
            for (int n = 0; n < 16; ++n) { const bf16x8 kf = *(const bf16x8*)(kp + (size_t)n * 16 * DM + ks * 32);
                acc[n] = __builtin_amdgcn_mfma_f32_16x16x32_bf16(kf, qf, acc[n], 0, 0, 0); }
        }
        float mx = -3.0e38f;
#pragma unroll
        for (int n = 0; n < 16; ++n) mx = fmaxf(fmaxf(fmaxf(acc[n].x, acc[n].y), fmaxf(acc[n].z, acc[n].w)), mx);
        mx = fmaxf(mx, __shfl_xor(mx, 16)); mx = fmaxf(mx, __shfl_xor(mx, 32));
        float sum = 0.f;
#pragma unroll
        for (int n = 0; n < 16; ++n) { acc[n].x = __expf(acc[n].x - mx); acc[n].y = __expf(acc[n].y - mx); acc[n].z = __expf(acc[n].z - mx); acc[n].w = __expf(acc[n].w - mx);
            sum += (acc[n].x + acc[n].y) + (acc[n].z + acc[n].w); }
        sum += __shfl_xor(sum, 16); sum += __shfl_xor(sum, 32);
        const float linv = 1.0f / sum;
        bf16x8 pf[8];
#pragma unroll
        for (int s = 0; s < 8; ++s) { v4u w; w.x = pk2(acc[2 * s].x, acc[2 * s].y); w.y = pk2(acc[2 * s].z, acc[2 * s].w); w.z = pk2(acc[2 * s + 1].x, acc[2 * s + 1].y); w.w = pk2(acc[2 * s + 1].z, acc[2 * s + 1].w);
            pf[s] = __builtin_bit_cast(bf16x8, w); }
        float lv[4];
#pragma unroll
        for (int r = 0; r < 4; ++r) lv[r] = __shfl(linv, 4 * fq + r);
        const bf16* vp = VT + (size_t)(h * XHD + fr) * MROWS + b * MEML + 4 * fq;
        bf16* op = O + (size_t)(qrow0 + 4 * fq) * DM + h * XHD + fr;
#pragma unroll 2
        for (int dt = 0; dt < 32; ++dt) {
            f32x4 oa = (f32x4){0.f, 0.f, 0.f, 0.f};
#pragma unroll
            for (int s = 0; s < 8; ++s) { const bf16* vv = vp + (size_t)dt * 16 * MROWS + s * 32;
                v4u w; const v2u lo = *(const v2u*)vv, hi = *(const v2u*)(vv + 16); w.x = lo.x; w.y = lo.y; w.z = hi.x; w.w = hi.y;
                oa = __builtin_amdgcn_mfma_f32_16x16x32_bf16(pf[s], __builtin_bit_cast(bf16x8, w), oa, 0, 0, 0); }
            op[(size_t)0 * DM + dt * 16] = (bf16)f2bf(oa.x * lv[0]); op[(size_t)1 * DM + dt * 16] = (bf16)f2bf(oa.y * lv[1]);
            op[(size_t)2 * DM + dt * 16] = (bf16)f2bf(oa.z * lv[2]); op[(size_t)3 * DM + dt * 16] = (bf16)f2bf(oa.w * lv[3]);
        }
    }
}

#ifndef SKIPM
#define SKIPM 0
#endif
constexpr int PH_PER_LAYER = 13, N_PHASES = 2 + DEPTH * PH_PER_LAYER;
struct Args { const float* in[N_IN]; float* out; unsigned char* ws; int ph_lo, ph_hi; };
static_assert(sizeof(Args) == (N_IN + 2) * 8 + 8, "Args has no padding");
struct GemmDesc { const bf16* A; const bf16* Bt; void* C; int M, N, K, ldc, mode, corder; float scale; };
__device__ __forceinline__ void gemm_desc(const Frame& F, int ph, int sub, GemmDesc& d) {
    const int bx = (int)blockIdx.x;
    d.scale = 1.0f; d.corder = bx;
    if (ph == 1) {
        const int l = sub >> 1; const bf16* wkv = (const bf16*)(F.ws + WS_W + (size_t)l * W_LAYER + WO_WKV); const bf16* memn = wsb(F, WS_MEMN) + (size_t)l * MROWS * DM;
        d.corder = (bx + F.G - 32 * sub) % F.G; d.mode = 1; d.K = DM;
        if ((sub & 1) == 0) { d.A = memn; d.Bt = wkv; d.M = MROWS; d.N = DM; d.C = wsb(F, WS_KB) + (size_t)l * MROWS * DM; d.ldc = DM; }
        else { d.A = wkv + (size_t)DM * DM; d.Bt = memn; d.M = DM; d.N = MROWS; d.C = wsb(F, WS_VT) + (size_t)l * DM * MROWS; d.ldc = MROWS; }
        return;
    }
    const int l = (ph - 2) / PH_PER_LAYER, k = (ph - 2) % PH_PER_LAYER;
    const unsigned char* wl = F.ws + WS_W + (size_t)l * W_LAYER;
    d.M = M; d.K = DM; d.N = DM; d.ldc = DM; d.mode = 0; d.A = wsb(F, WS_XN); d.C = wsf(F, WS_Y);
    if (k == 0) { d.Bt = (const bf16*)(wl + WO_WIN); d.N = IN_PAD; d.C = wsf(F, WS_U); d.ldc = IN_PAD; }
    else if (k == 4) { d.A = wsb(F, WS_MIX); d.Bt = (const bf16*)(wl + WO_WOUT); }
    else if (k == 6) { d.Bt = (const bf16*)(wl + WO_WQ); d.mode = 1; d.C = wsb(F, WS_Q); d.scale = 0.044194173824159216f; }
    else if (k == 8) { d.A = wsb(F, WS_MIX); d.Bt = (const bf16*)(wl + WO_WO); }
    else if (k == 10) { d.Bt = (const bf16*)(wl + WO_WGU); d.N = 2 * DFF; d.mode = 2; d.C = wsb(F, WS_HID); d.ldc = DFF; }
    else { d.A = wsb(F, WS_HID); d.Bt = (const bf16*)(wl + WO_WD); d.K = DFF; }
}

__global__ void __launch_bounds__(NWAVES * 64, 2) fwd_kernel(Args args) {
    extern __shared__ __attribute__((aligned(16))) unsigned char lds[];
    Frame F;
    F.lds = (LAS unsigned char*)lds;
    F.MISC = (volatile LAS unsigned*)(F.lds + MISC_OFF);
    F.tid = threadIdx.x; F.lane = F.tid & 63; F.wave = __builtin_amdgcn_readfirstlane(F.tid >> 6);
    F.G = gridDim.x; { const int bx = blockIdx.x; F.vcu = (F.G % 8 == 0) ? (bx % 8) * (F.G / 8) + bx / 8 : bx; }
    F.ws = args.ws; F.out = args.out; F.ctl = (unsigned*)(args.ws + WS_CTL);
    for (int u = F.tid; u < (LDS_BYTES - LDSCTL_OFF) / 4; u += NWAVES * 64) ((LAS unsigned*)(F.lds + LDSCTL_OFF))[u] = 0u;
    __syncthreads();
    const int lo = args.ph_lo, hi = args.ph_hi;
    XcdBarrier bar; bar.bar = F.ctl + CW_BAR; bar.x = 0; bar.st = nullptr;
    if (hi - lo > 1) bar = xcd_barrier_post(F.ctl + CW_BAR, F.MISC + 8);
    LAS unsigned char* ring = F.lds + RING_OFF;
#pragma unroll 1
    for (int ph = lo; ph < hi; ++ph) {
        const int l = ph >= 2 ? (ph - 2) / PH_PER_LAYER : 0, k = ph >= 2 ? (ph - 2) % PH_PER_LAYER : -1;
        const bool is_gemm = (ph == 1) || k == 0 || k == 4 || k == 6 || k == 8 || k == 10 || k == 11;
        if (is_gemm) {
            if (!(SKIPM & 2)) {
            const int nsub = (ph == 1) ? 2 * DEPTH : 1;
#pragma unroll 1
            for (int sub = 0; sub < nsub; ++sub) {
                GemmDesc d; gemm_desc(F, ph, sub, d);
                pg8::Gemm g{d.A, d.Bt, d.M, d.N, d.K}; pg8::StaticOrder S; S.init(d.M, d.N, F.G, d.corder);
                pg8::EpiAny E{d.C, d.ldc, d.mode, d.scale};
                pg8::gemm_phase<pg8::EpiAny, pg8::StaticOrder, false, false>(ring, g, S, E);
            } }
        } else if (ph == 0) { if (!(SKIPM & 1)) p0_prologue(F); }
        else {
            const float* ng = inp(I_NORMG) + (size_t)l * N_NORMS * DM;
            if (k == 1) { if (!(SKIPM & 8)) mixer_prep_phase(F, l); }
            else if (k == 2) { if (!(SKIPM & 16)) scan_phase(F, l); }
            else if (k == 3) { if (!(SKIPM & 32)) mixer_post_phase(F, l); }
            else if (k == 7) { if (!(SKIPM & 512)) attn_phase(F, l); }
            else if (!(SKIPM & 128)) {
                if (k == 5) resnorm_phase(F, l == 0 ? inp(I_X) : F.out, ng + MIX_POST * DM, ng + XA_PRE * DM);
                else if (k == 9) resnorm_phase(F, F.out, ng + XA_POST * DM, ng + FFN_PRE * DM);
                else resnorm_phase(F, F.out, ng + FFN_POST * DM, (l + 1 < DEPTH) ? ng + (N_NORMS + MIX_PRE) * DM : nullptr);
            }
        }
        if (ph + 1 < hi) xcd_barrier(bar);
    }
}

#ifndef MK_SINGLE
#define MK_SINGLE 0
#endif
extern "C" void kernel_launch(void* const* d_in, const int* in_sizes, int n_in, void* d_out, int out_size, void* d_ws, size_t ws_size, hipStream_t stream) {
    static int grid = 0;
    if (grid == 0) {
        if (n_in != N_IN || in_sizes[0] != M * DM || out_size != M * DM || ws_size < WS_END) { fprintf(stderr, "kernel_launch: unexpected problem (n_in %d, in0 %d, out %d, ws %zu < %zu)\n", n_in, n_in > 0 ? in_sizes[0] : -1, out_size, ws_size, (size_t)WS_END); grid = -1; return; }
        int dev = 0, cus = 0, per_cu = 0;
        if (hipGetDevice(&dev) != hipSuccess || hipDeviceGetAttribute(&cus, hipDeviceAttributeMultiprocessorCount, dev) != hipSuccess) { grid = -1; return; }
        if (hipFuncSetAttribute((const void*)fwd_kernel, hipFuncAttributeMaxDynamicSharedMemorySize, LDS_BYTES) != hipSuccess) { fprintf(stderr, "kernel_launch: hipFuncSetAttribute failed\n"); grid = -1; return; }
        if (hipOccupancyMaxActiveBlocksPerMultiprocessor(&per_cu, (const void*)fwd_kernel, NWAVES * 64, LDS_BYTES) != hipSuccess || per_cu < 1) { fprintf(stderr, "kernel_launch: occupancy query says %d blocks per CU\n", per_cu); per_cu = 1; }
        (void)hipGetLastError();
        grid = cus * (per_cu < 1 ? 1 : 1);
        if (grid != 256) fprintf(stderr, "kernel_launch: note: grid %d (expected 256)\n", grid);
    }
    if (grid < 0) return;
    if (hipMemsetAsync((char*)d_ws + WS_CTL, 0, CTL_ZERO_BYTES, stream) != hipSuccess) { fprintf(stderr, "kernel_launch: memset failed\n"); return; }
    Args a{};
    for (int i = 0; i < N_IN; ++i) a.in[i] = (const float*)d_in[i];
    a.out = (float*)d_out; a.ws = (unsigned char*)d_ws;
#if MK_SINGLE
    a.ph_lo = 0; a.ph_hi = N_PHASES;
    void* kargs[] = {&a};
    hipError_t e = hipLaunchCooperativeKernel((const void*)fwd_kernel, dim3(grid), dim3(NWAVES * 64), kargs, LDS_BYTES, stream);
    if (e != hipSuccess) fprintf(stderr, "kernel_launch: cooperative launch failed: %s (grid %d)\n", hipGetErrorString(e), grid);
#else
    for (int p = 0; p < N_PHASES; ++p) { a.ph_lo = p; a.ph_hi = p + 1;
        hipLaunchKernelGGL(fwd_kernel, dim3(grid), dim3(NWAVES * 64), LDS_BYTES, stream, a);
        const hipError_t le = hipPeekAtLastError(); if (le != hipSuccess) { fprintf(stderr, "kernel_launch: launch %d failed: %s\n", p, hipGetErrorName(le)); break; } }
#endif
}
```

```cpp
#include <hip/hip_runtime.h>
#include <cstdio>
#include <cstdint>
#define MK_SINGLE 1
namespace pg8 {
#define PG8_LAS __attribute__((address_space(3)))
typedef unsigned short bf16_t;
typedef short bf16x8 __attribute__((ext_vector_type(8)));
typedef float f32x4 __attribute__((ext_vector_type(4)));
typedef unsigned u32x4 __attribute__((ext_vector_type(4)));
constexpr int BM = 256, BK = 64, HALF = 128, HTB = HALF * BK * 2  , STAGE_BYTES = 8 * HTB, NXCD = 8, WGM = 8;

__host__ __device__ __forceinline__ int lds_byte(int r, int c) { const int st = (r >> 4) * 2 + (c >> 5), rr = r & 15, cc = c & 31, ob = rr * 64 + cc * 2; return st * 1024 + (ob ^ (((ob >> 9) & 1) << 5)); }
__host__ __device__ __forceinline__ void stage_rc(int b, int& R, int& C) { const int st = b / 1024, sb = b % 1024, swz = sb ^ (((sb >> 9) & 1) << 5); R = (st >> 1) * 16 + swz / 64; C = (st & 1) * 32 + (swz % 64) / 2; }
__host__ __device__ __forceinline__ int perm32(int rho) { const int n = rho >> 4, i = rho & 15; return 8 * (i >> 2) + 4 * n + (i & 3); }

struct Unit { int pm, pn; };
struct Gemm { const bf16_t* A; const bf16_t* Bt; int M, N, K; };

struct StaticOrder {
    int nM, nN, nwg, G, c;
    __host__ __device__ void init(int M, int N, int G_, int c_) { nM = M / BM; nN = N / BM; nwg = nM * nN; G = G_; c = c_; }
    __host__ __device__ bool next(int i, Unit& u) const {
        const long L = (long)i * G + c; if (L >= nwg) return false;
        int wgid = (int)L; { const int q = nwg / NXCD, r = nwg % NXCD, xcd = wgid % NXCD, off = wgid / NXCD; wgid = (xcd < r ? xcd * (q + 1) : r * (q + 1) + (xcd - r) * q) + off; }
        const int nig = WGM * nN, gid = wgid / nig, fm = gid * WGM, gsz = (nM - fm) < WGM ? (nM - fm) : WGM;
        u.pm = fm + ((wgid % nig) % gsz); u.pn = (wgid % nig) / gsz; return true;
    }
    __device__ __forceinline__ void a_ready(const Unit&) const {}
    __device__ __forceinline__ void done(const Unit&) const {}
};

__device__ __forceinline__ unsigned cvt_pk_bf16(float lo, float hi) { unsigned r; asm volatile("v_cvt_pk_bf16_f32 %0, %1, %2" : "=v"(r) : "v"(lo), "v"(hi)); return r; }
struct EpiF32 {
    static constexpr bool PERM = false, AFTER_DRAIN = false;
    float* C; int ldc;
    __device__ __forceinline__ void operator()(const f32x4 (&acc)[2][2][4][2], const Unit& u, int wr, int wc, int fr, int fq) const {
        const int row0 = u.pm * BM + wr * 64 + fr, col0 = u.pn * BM + wc * 32 + 4 * fq;
#pragma unroll
        for (int ai = 0; ai < 2; ++ai)
#pragma unroll
            for (int m = 0; m < 4; ++m) { float* rowp = C + (size_t)(row0 + ai * HALF + m * 16) * ldc + col0;
#pragma unroll
                for (int bj = 0; bj < 2; ++bj)
#pragma unroll
                    for (int n = 0; n < 2; ++n) *(f32x4*)(rowp + bj * HALF + n * 16) = acc[ai][bj][m][n]; }
    }
};
struct EpiBf16S {
    static constexpr bool PERM = true, AFTER_DRAIN = false;
    bf16_t* O; int ldc; float scale;
    __device__ __forceinline__ void operator()(const f32x4 (&acc)[2][2][4][2], const Unit& u, int wr, int wc, int fr, int fq) const {
        const int row0 = u.pm * BM + wr * 64 + fr, col0 = u.pn * BM + wc * 32 + 8 * fq; const float sc = scale;
#pragma unroll
        for (int ai = 0; ai < 2; ++ai)
#pragma unroll
            for (int m = 0; m < 4; ++m) { bf16_t* rowp = O + (size_t)(row0 + ai * HALF + m * 16) * ldc + col0;
#pragma unroll
                for (int bj = 0; bj < 2; ++bj) { const f32x4 v0 = acc[ai][bj][m][0] * sc, v1 = acc[ai][bj][m][1] * sc;
                    u32x4 w; w.x = cvt_pk_bf16(v0[0], v0[1]); w.y = cvt_pk_bf16(v0[2], v0[3]); w.z = cvt_pk_bf16(v1[0], v1[1]); w.w = cvt_pk_bf16(v1[2], v1[3]);
                    *(u32x4*)(rowp + bj * HALF) = w; } }
    }
};
__device__ __forceinline__ float silu_f(float v) { return v / (1.0f + __expf(-v)); }
struct EpiSwiGLU {
    static constexpr bool PERM = true, AFTER_DRAIN = false;
    bf16_t* O; int ldc;
    __device__ __forceinline__ void operator()(const f32x4 (&acc)[2][2][4][2], const Unit& u, int wr, int wc, int fr, int fq) const {
        const int row0 = u.pm * BM + wr * 64 + fr, col0 = u.pn * HALF + wc * 32 + 8 * fq;
#pragma unroll
        for (int ai = 0; ai < 2; ++ai)
#pragma unroll
            for (int m = 0; m < 4; ++m) { bf16_t* rowp = O + (size_t)(row0 + ai * HALF + m * 16) * ldc + col0;
                const f32x4 g0 = acc[ai][0][m][0], g1 = acc[ai][0][m][1], u0 = acc[ai][1][m][0], u1 = acc[ai][1][m][1];
                u32x4 w; w.x = cvt_pk_bf16(silu_f(g0[0]) * u0[0], silu_f(g0[1]) * u0[1]); w.y = cvt_pk_bf16(silu_f(g0[2]) * u0[2], silu_f(g0[3]) * u0[3]);
                w.z = cvt_pk_bf16(silu_f(g1[0]) * u1[0], silu_f(g1[1]) * u1[1]); w.w = cvt_pk_bf16(silu_f(g1[2]) * u1[2], silu_f(g1[3]) * u1[3]);
                *(u32x4*)rowp = w; }
    }
};
struct EpiAny {
    static constexpr bool PERM = false, AFTER_DRAIN = false, RT_PERM = true;
    void* C; int ldc; int mode; float scale;
    __device__ __forceinline__ bool perm() const { return mode != 0; }
    __device__ __forceinline__ void operator()(const f32x4 (&acc)[2][2][4][2], const Unit& u, int wr, int wc, int fr, int fq) const {
        if (mode == 0) { EpiF32 e{(float*)C, ldc}; e(acc, u, wr, wc, fr, fq); }
        else if (mode == 1) { EpiBf16S e{(bf16_t*)C, ldc, scale}; e(acc, u, wr, wc, fr, fq); }
        else { EpiSwiGLU e{(bf16_t*)C, ldc}; e(acc, u, wr, wc, fr, fq); }
    }
};
template <class Epi, class Sched, bool ALIGN_EPI = false, bool SP2 = false>
__device__ __forceinline__ void gemm_phase(PG8_LAS unsigned char* lds, const Gemm g, const Sched& S, const Epi& E) {
    const int tid = threadIdx.x, wid = __builtin_amdgcn_readfirstlane(tid >> 6), lane = tid & 63, wr = wid >> 2, wc = wid & 3, fr = lane & 15, fq = lane >> 4;
    const int K = g.K, nt = K / BK;
    unsigned voffA[2], voffB[2];
#pragma unroll
    for (int i = 0; i < 2; ++i) { int R, C; stage_rc(tid * 16 + i * 8192, R, C); const int Rb = E.perm() ? ((R & ~31) + perm32(R & 31)) : R;
        voffA[i] = (unsigned)(R * K + C) * 2u; voffB[i] = (unsigned)(Rb * K + C) * 2u; }
    const size_t kstep = (size_t)(BK * 2);
    const size_t hstep = (size_t)HALF * K * 2;
    const size_t tstep = 2 * hstep;
    const unsigned ldsw = (unsigned)wid * 1024u;
    const int aoff = lds_byte(wr * 64 + fr, fq * 8), boff = lds_byte(wc * 32 + fr, fq * 8);
#define PG8_SA(b, h) (((b) * 2 + (h)) * HTB)
#define PG8_SB(b, h) ((4 + (b) * 2 + (h)) * HTB)
#define PG8_STAGE(bufoff, gbase, voff) do { _Pragma("unroll") for (int _i = 0; _i < 2; ++_i) \
        __builtin_amdgcn_global_load_lds((const unsigned*)((const char*)(gbase) + (voff)[_i]), (PG8_LAS unsigned*)(lds + (bufoff) + ldsw + _i * 8192), 16, 0, 0); } while (0)
#define PG8_LDA(dst, b, h) do { _Pragma("unroll") for (int m = 0; m < 4; ++m) _Pragma("unroll") for (int k = 0; k < 2; ++k) dst[m][k] = *(const PG8_LAS bf16x8*)(lds + PG8_SA(b, h) + aoff + m * 2048 + k * 1024); } while (0)
#define PG8_LDB(dst, b, h) do { _Pragma("unroll") for (int n = 0; n < 2; ++n) _Pragma("unroll") for (int k = 0; k < 2; ++k) dst[n][k] = *(const PG8_LAS bf16x8*)(lds + PG8_SB(b, h) + boff + n * 2048 + k * 1024); } while (0)
#define PG8_MMA(ai, bj, At, Bt) do { __builtin_amdgcn_s_setprio(1); _Pragma("unroll") for (int m = 0; m < 4; ++m) _Pragma("unroll") for (int n = 0; n < 2; ++n) _Pragma("unroll") for (int k = 0; k < 2; ++k) \
        acc[ai][bj][m][n] = __builtin_amdgcn_mfma_f32_16x16x32_bf16(Bt[n][k], At[m][k], acc[ai][bj][m][n], 0, 0, 0); __builtin_amdgcn_s_setprio(0); } while (0)
#define PG8_WAIT_V(n) asm volatile("s_waitcnt vmcnt(" #n ")" ::: "memory")
#define PG8_WAIT_L(n) asm volatile("s_waitcnt lgkmcnt(" #n ")" ::: "memory")
#define PG8_BAR __builtin_amdgcn_s_barrier()
#define PG8_SCHED __builtin_amdgcn_sched_barrier(0)
    Unit cur, nxt; int ui = 0;
    if (!S.next(0, cur)) return;
    f32x4 acc[2][2][4][2];
#pragma unroll
    for (int a = 0; a < 2; ++a)
#pragma unroll
        for (int b = 0; b < 2; ++b)
#pragma unroll
            for (int m = 0; m < 4; ++m)
#pragma unroll
                for (int n = 0; n < 2; ++n) acc[a][b][m][n] = (f32x4){0.f, 0.f, 0.f, 0.f};
    bf16x8 At[4][2], B0[2][2], B1[2][2];
    const char* cA = (const char*)g.A + (size_t)cur.pm * tstep; const char* cB = (const char*)g.Bt + (size_t)cur.pn * tstep;
    S.a_ready(cur);
    if constexpr (SP2) {
        PG8_STAGE(PG8_SB(0, 0), cB, voffB); PG8_STAGE(PG8_SB(0, 1), cB + hstep, voffB); PG8_STAGE(PG8_SA(0, 0), cA, voffA); PG8_STAGE(PG8_SA(0, 1), cA + hstep, voffA);
        if (wr == 1) PG8_BAR;
        PG8_WAIT_V(2); PG8_BAR;
        PG8_STAGE(PG8_SB(1, 0), cB + kstep, voffB); PG8_STAGE(PG8_SA(1, 0), cA + kstep, voffA); PG8_STAGE(PG8_SB(1, 1), cB + hstep + kstep, voffB);
        PG8_WAIT_V(6); PG8_BAR;
    } else {
        PG8_STAGE(PG8_SB(0, 0), cB, voffB); PG8_STAGE(PG8_SA(0, 0), cA, voffA); PG8_STAGE(PG8_SB(0, 1), cB + hstep, voffB); PG8_STAGE(PG8_SA(0, 1), cA + hstep, voffA);
        if (wr == 1) PG8_BAR;
        PG8_WAIT_V(4); PG8_BAR;
        PG8_STAGE(PG8_SB(1, 0), cB + kstep, voffB); PG8_STAGE(PG8_SA(1, 0), cA + kstep, voffA); PG8_STAGE(PG8_SB(1, 1), cB + hstep + kstep, voffB);
        PG8_WAIT_V(6); PG8_BAR;
    }
    for (;;) {
        const bool has_next = S.next(ui + 1, nxt);
        const char* nA = has_next ? (const char*)g.A + (size_t)nxt.pm * tstep : cA; const char* nB = has_next ? (const char*)g.Bt + (size_t)nxt.pn * tstep : cB;
        for (int t = 0; t < nt; t += 2) {
            const bool last = (t == nt - 2);
            const char* a1 = cA + (size_t)(t + 1) * kstep;
            const char* a2 = last ? nA : cA + (size_t)(t + 2) * kstep; const char* b2 = last ? nB : cB + (size_t)(t + 2) * kstep;
            const char* a3 = a2 + kstep; const char* b3 = b2 + kstep;
            if (last && has_next) S.a_ready(nxt);
            if constexpr (SP2) {
            PG8_LDB(B0, 0, 0); PG8_LDB(B1, 0, 1); PG8_SCHED; PG8_LDA(At, 0, 0); PG8_STAGE(PG8_SA(1, 1), a1 + hstep, voffA);
            PG8_WAIT_V(8); PG8_WAIT_L(0); PG8_BAR; PG8_MMA(0, 0, At, B0); PG8_MMA(0, 1, At, B1); PG8_BAR; PG8_SCHED;
            PG8_LDA(At, 0, 1); PG8_STAGE(PG8_SB(0, 0), b2, voffB); PG8_STAGE(PG8_SB(0, 1), b2 + hstep, voffB); PG8_STAGE(PG8_SA(0, 0), a2, voffA);
            PG8_WAIT_V(8); PG8_WAIT_L(0); PG8_BAR; PG8_MMA(1, 0, At, B0); PG8_MMA(1, 1, At, B1); PG8_BAR; PG8_SCHED;
            PG8_LDB(B0, 1, 0); PG8_LDB(B1, 1, 1); PG8_SCHED; PG8_LDA(At, 1, 0); PG8_STAGE(PG8_SA(0, 1), a2 + hstep, voffA);
            PG8_WAIT_V(8); PG8_WAIT_L(0); PG8_BAR; PG8_MMA(0, 0, At, B0); PG8_MMA(0, 1, At, B1); PG8_BAR; PG8_SCHED;
            PG8_LDA(At, 1, 1); PG8_STAGE(PG8_SB(1, 0), b3, voffB); PG8_STAGE(PG8_SB(1, 1), b3 + hstep, voffB); PG8_STAGE(PG8_SA(1, 0), a3, voffA);
            PG8_WAIT_V(8); PG8_WAIT_L(0); PG8_BAR; PG8_MMA(1, 0, At, B0); PG8_MMA(1, 1, At, B1); PG8_BAR; PG8_SCHED;
            } else {
            PG8_LDB(B0, 0, 0); PG8_SCHED; PG8_LDA(At, 0, 0); PG8_STAGE(PG8_SA(1, 1), a1 + hstep, voffA);
            PG8_WAIT_L(8); PG8_BAR; PG8_WAIT_L(0); PG8_MMA(0, 0, At, B0); PG8_BAR; PG8_SCHED;
            PG8_LDB(B1, 0, 1); PG8_STAGE(PG8_SB(0, 0), b2, voffB);
            PG8_BAR; PG8_WAIT_L(0); PG8_MMA(0, 1, At, B1); PG8_BAR;
            PG8_LDA(At, 0, 1); PG8_STAGE(PG8_SA(0, 0), a2, voffA);
            PG8_BAR; PG8_WAIT_L(0); PG8_MMA(1, 0, At, B0); PG8_BAR; PG8_SCHED;
            PG8_STAGE(PG8_SB(0, 1), b2 + hstep, voffB);
            PG8_WAIT_V(6); PG8_BAR; PG8_MMA(1, 1, At, B1); PG8_BAR;
            PG8_LDB(B0, 1, 0); PG8_SCHED; PG8_LDA(At, 1, 0); PG8_STAGE(PG8_SA(0, 1), a2 + hstep, voffA);
            PG8_WAIT_L(8); PG8_BAR; PG8_WAIT_L(0); PG8_MMA(0, 0, At, B0); PG8_BAR; PG8_SCHED;
            PG8_LDB(B1, 1, 1); PG8_STAGE(PG8_SB(1, 0), b3, voffB);
            PG8_BAR; PG8_WAIT_L(0); PG8_MMA(0, 1, At, B1); PG8_BAR;
            PG8_LDA(At, 1, 1); PG8_STAGE(PG8_SA(1, 0), a3, voffA);
            PG8_BAR; PG8_WAIT_L(0); PG8_MMA(1, 0, At, B0); PG8_BAR; PG8_SCHED;
            PG8_STAGE(PG8_SB(1, 1), b3 + hstep, voffB);
            PG8_WAIT_V(6); PG8_BAR; PG8_MMA(1, 1, At, B1); PG8_BAR;
            }
        }
        if constexpr (ALIGN_EPI) { if (wr == 0) PG8_BAR; }
        if constexpr (!Epi::AFTER_DRAIN) { E(acc, cur, wr, wc, fr, fq); S.done(cur); }
        if (!has_next) break;
#pragma unroll
        for (int a = 0; a < 2; ++a)
#pragma unroll
            for (int b = 0; b < 2; ++b)
#pragma unroll
                for (int m = 0; m < 4; ++m)
#pragma unroll
                    for (int n = 0; n < 2; ++n) acc[a][b][m][n] = (f32x4){0.f, 0.f, 0.f, 0.f};
        cur = nxt; cA = nA; cB = nB; ++ui;
        if constexpr (ALIGN_EPI) { if (wr == 1) PG8_BAR; }
    }
    PG8_WAIT_V(0);
    if constexpr (!ALIGN_EPI) { if (wr == 0) PG8_BAR; }
    PG8_BAR;
    if constexpr (Epi::AFTER_DRAIN) { E.fused(acc, cur, wr, wc, fr, fq, lds, wid, lane); S.done(cur); }
#undef PG8_SA
#undef PG8_SB
#undef PG8_STAGE
#undef PG8_LDA
#undef PG8_LDB
#undef PG8_MMA
#undef PG8_WAIT_V
#undef PG8_WAIT_L
#undef PG8_BAR
#undef PG8_SCHED
}
}
constexpr int NWAVES = 8;
constexpr int BATCH = 4, SEQ = 2048, DM = 2048, DEPTH = 2;
constexpr int M = BATCH * SEQ;
constexpr int GW = 512;
constexpr int IN_COLS = 5648, IN_PAD = 5888;
constexpr int DFF = 5632, MEML = 256, XH = 4, XHD = 512;
constexpr int MROWS = BATCH * MEML;
constexpr float EPS = 1e-6f;
constexpr int UA_B = 0, UA_C = 512, UA_H = 1024, UB = 1536, UC_Q = 2048, UC_Z = 3584, UC_A = 4096, UC_B = 4100, UD_Z = 4104, UD_X = 4616, UD_DT = 5640;
constexpr int MIX_PRE = 0, MIX_POST = 1, XA_PRE = 2, XA_POST = 3, MEM_NORM = 4, FFN_PRE = 5, FFN_POST = 6, N_NORMS = 7;
enum { I_X = 0, I_MEM, I_NORMG, I_WIN, I_CONVA, I_POOLW, I_POOLS, I_GCONV, I_GALOG, I_GDTB, I_GNG, I_SCONVW, I_SCONVB, I_SALOG, I_SDTB, I_SD, I_SNG, I_WOUT, I_WQ, I_WKV, I_WO, I_WGU, I_WD, N_IN };

constexpr size_t MiB = 1u << 20;
constexpr size_t WS_CTL = 0, CTL_ZERO_BYTES = 1 * MiB;
constexpr size_t WSZ_WIN = (size_t)IN_PAD * DM * 2, WSZ_SQ = (size_t)DM * DM * 2, WSZ_KV = (size_t)2 * DM * DM * 2, WSZ_GU = (size_t)2 * DFF * DM * 2, WSZ_D = (size_t)DM * DFF * 2;
constexpr size_t WO_WIN = 0, WO_WOUT = WO_WIN + WSZ_WIN, WO_WQ = WO_WOUT + WSZ_SQ, WO_WKV = WO_WQ + WSZ_SQ, WO_WO = WO_WKV + WSZ_KV, WO_WGU = WO_WO + WSZ_SQ, WO_WD = WO_WGU + WSZ_GU, W_LAYER = WO_WD + WSZ_D;
constexpr size_t WS_W = 1 * MiB;
constexpr size_t WS_XN = WS_W + 2 * W_LAYER;
constexpr size_t WS_MIX = WS_XN + (size_t)M * DM * 2;
constexpr size_t WS_MEMN = WS_MIX + (size_t)M * DM * 2;
constexpr size_t WS_KB = WS_MEMN + (size_t)2 * MROWS * DM * 2;
constexpr size_t WS_VT = WS_KB + (size_t)2 * MROWS * DM * 2;
constexpr size_t WS_U = WS_VT + (size_t)2 * MROWS * DM * 2;
constexpr size_t WS_Q = WS_U, WS_HID = WS_U + (size_t)M * DM * 2;
constexpr size_t WS_SCR = WS_U + (size_t)M * IN_PAD * 4;
constexpr size_t WS_Y = WS_SCR;
constexpr size_t SZ512 = (size_t)M * 512 * 4, SZ256 = (size_t)M * 256 * 4, SZ8 = (size_t)M * 8 * 4;
constexpr size_t WS_QN = WS_SCR, WS_KN = WS_QN + SZ512, WS_VV = WS_KN + SZ512, WS_OG = WS_VV + SZ512, WS_XS = WS_OG + SZ512, WS_YS = WS_XS + SZ512,
                 WS_BS = WS_YS + SZ512, WS_CS = WS_BS + SZ256, WS_GB = WS_CS + SZ256, WS_DT = WS_GB + SZ8, WS_END = WS_DT + SZ8;
static_assert(WS_Y + (size_t)M * DM * 4 <= WS_END, "Y inside the scan region");
static_assert(WS_HID + (size_t)M * DFF * 2 <= WS_SCR, "HID inside U");
static_assert(WS_END <= (size_t)704 * MiB, "d_ws map fits 4 x the largest input");

constexpr int RING_OFF = 0, RING_BYTES = 131072;
constexpr int LDSCTL_OFF = RING_BYTES, MISC_OFF = LDSCTL_OFF + 320;
constexpr int LDS_BYTES = 147456;
constexpr int CW_BAR = 4096;

#define GAS __attribute__((address_space(1)))
#define LAS __attribute__((address_space(3)))
typedef unsigned short bf16;
typedef unsigned v4u __attribute__((ext_vector_type(4)));
typedef unsigned v2u __attribute__((ext_vector_type(2)));
typedef float f32x4 __attribute__((ext_vector_type(4)));
typedef short bf16x8 __attribute__((ext_vector_type(8)));
#define LDS_WAIT() asm volatile("s_waitcnt lgkmcnt(0)" ::: "memory")
#define VM_WAIT() asm volatile("s_waitcnt vmcnt(0)" ::: "memory")
__device__ __forceinline__ unsigned f2bf(float f) { unsigned u = __builtin_bit_cast(unsigned, f); return (u + 0x7fffu + ((u >> 16) & 1u)) >> 16; }
__device__ __forceinline__ unsigned pk2(float lo, float hi) { return f2bf(lo) | (f2bf(hi) << 16); }
__device__ __forceinline__ float siluf(float v) { return v / (1.0f + __expf(-v)); }
__device__ __forceinline__ float softplusf(float v) { return fmaxf(v, 0.f) + log1pf(__expf(-fabsf(v))); }
__device__ __forceinline__ float sigmoidf(float v) { return 1.0f / (1.0f + __expf(-v)); }
template <int CTRL> __device__ __forceinline__ float dppf(float v) { return __builtin_bit_cast(float, __builtin_amdgcn_update_dpp(0, __builtin_bit_cast(int, v), CTRL, 0xF, 0xF, true)); }
__device__ __forceinline__ float row16_sum(float v) { v += dppf<0xB1>(v); v += dppf<0x4E>(v); v += dppf<0x141>(v); v += dppf<0x140>(v); return v; }
__device__ __forceinline__ int opq(int v) { asm volatile("" : "+v"(v)); return v; }
__device__ __forceinline__ float wave_sum(float v) {
#pragma unroll
    for (int o = 1; o < 64; o <<= 1) v += __shfl_xor(v, o);
    return v;
}

#define XB_TMO      128
#define XB_XCNT(j)  (256  + 64 * (j))
#define XB_XSUB(j)  (1280 + 64 * (j))
#define XB_XGEN(j)  (2304 + 64 * (j))
#define XB_TOP      3328
#define XB_TOPGEN   3392
#define XCD_BAR_WORDS 3456
#define XB_SPIN_CAP (1u << 18)

__device__ __forceinline__ unsigned xb_ld(unsigned* p)              { return __hip_atomic_load(p, __ATOMIC_RELAXED, __HIP_MEMORY_SCOPE_AGENT); }
__device__ __forceinline__ unsigned xb_add(unsigned* p, unsigned v) { return __hip_atomic_fetch_add(p, v, __ATOMIC_RELAXED, __HIP_MEMORY_SCOPE_AGENT); }
__device__ __forceinline__ unsigned xb_xcc_id() { return (unsigned)__builtin_amdgcn_s_getreg((3 << 11) | 20) & 0xFu; }
#define XB_SPIN(cond, bar) do { unsigned _sp = 0; while (cond) { __builtin_amdgcn_s_sleep(1); \
    if ((++_sp & 255u) == 0u) { if (xb_ld(&(bar)[XB_TMO])) break; if (_sp > XB_SPIN_CAP) { atomicAdd(&(bar)[XB_TMO], 1u); break; } } } } while (0)

struct XcdBarrier {
    unsigned* bar; unsigned x;
    volatile LAS unsigned* st;
};

__device__ __forceinline__ XcdBarrier xcd_barrier_post(unsigned* bar, volatile LAS unsigned* st) {
    XcdBarrier b; b.bar = bar; b.x = xb_xcc_id(); b.st = st;
    if (threadIdx.x == 0) (void)xb_add(&bar[XB_XCNT(b.x)], 1u);
    return b;
}
__device__ __forceinline__ void xcd_barrier_complete(unsigned* bar, unsigned x, unsigned& nloc, unsigned& nx) {
    const unsigned G = gridDim.x * gridDim.y * gridDim.z;
    unsigned sum, cnt, mine, sp = 0u;
    for (;;) {
        sum = 0u; cnt = 0u; mine = 0u;
#pragma unroll
        for (unsigned j = 0; j < 16; ++j) { const unsigned c = xb_ld(&bar[XB_XCNT(j)]); sum += c; cnt += (c > 0u) ? 1u : 0u; mine = (j == x) ? c : mine; }
        if (sum == G) break;
        __builtin_amdgcn_s_sleep(1);
        if ((++sp & 255u) == 0u) { if (xb_ld(&bar[XB_TMO])) break; if (sp > XB_SPIN_CAP) { atomicAdd(&bar[XB_TMO], 1u); break; } }
    }
    nloc = mine > 0u ? mine : 1u; nx = cnt > 0u ? cnt : 1u;
}

__device__ __forceinline__ void xcd_barrier(const XcdBarrier& b) {
    asm volatile("s_waitcnt vmcnt(0)" ::: "memory");
    __syncthreads();
    if (threadIdx.x == 0) {
        unsigned* bar = b.bar;
        __builtin_amdgcn_s_waitcnt(0);
        unsigned nloc = b.st[0], nx = b.st[1];
        if (nloc == 0u) { xcd_barrier_complete(bar, b.x, nloc, nx); b.st[0] = nloc; b.st[1] = nx; }
        const unsigned old = xb_add(&bar[XB_XSUB(b.x)], 1u);
        const unsigned gen = old / nloc;
        if (old + 1u == (gen + 1u) * nloc) {
            __builtin_amdgcn_fence(__ATOMIC_RELEASE, "agent");
            asm volatile("s_waitcnt vmcnt(0)" ::: "memory");
            const unsigned og = xb_add(&bar[XB_TOP], 1u);
            const unsigned tg = og / nx;
            if (og + 1u == (tg + 1u) * nx) xb_add(&bar[XB_TOPGEN], 1u);
            else XB_SPIN(xb_ld(&bar[XB_TOPGEN]) == tg, bar);
            __builtin_amdgcn_fence(__ATOMIC_ACQUIRE, "agent");
            xb_add(&bar[XB_XGEN(b.x)], 1u);
            asm volatile("s_waitcnt vmcnt(0)" ::: "memory");
        } else {
            XB_SPIN(xb_ld(&bar[XB_XGEN(b.x)]) == gen, bar);
            __builtin_amdgcn_fence(__ATOMIC_ACQUIRE, "agent");
            asm volatile("s_waitcnt vmcnt(0)" ::: "memory");
        }
    }
    __syncthreads();
}
struct Frame {
    LAS unsigned char* lds;
    volatile LAS unsigned* MISC;
    unsigned* ctl;
    int tid, lane, wave;
    int vcu, G;
    float* out; unsigned char* ws;
};
__device__ __forceinline__ const float* inp(int i) { const float* __attribute__((address_space(4))) const* tab = (const float* __attribute__((address_space(4))) const*)__builtin_amdgcn_kernarg_segment_ptr(); asm volatile("" : "+s"(tab)); return tab[i]; }
__device__ __forceinline__ bf16* wsb(const Frame& F, size_t off) { return (bf16*)(F.ws + off); }
__device__ __forceinline__ float* wsf(const Frame& F, size_t off) { return (float*)(F.ws + off); }

__device__ __forceinline__ void p0_transpose_item(const float* W, int K, int N, bf16* WT, int drow0, int k0, int n0, LAS float* scr, int lane) {
    const int nn = n0 + (lane & 31); const bool ok = nn < N;
#pragma unroll 8
    for (int i = 0; i < 32; ++i) { const int kk = 2 * i + (lane >> 5); scr[kk * 33 + (lane & 31)] = ok ? W[(size_t)(k0 + kk) * N + nn] : 0.f; }
    LDS_WAIT(); asm volatile("" ::: "memory");
    const int c = lane & 7;
#pragma unroll
    for (int j = 0; j < 4; ++j) { const int n = (lane >> 3) + 8 * j; const LAS float* s = scr + (8 * c) * 33 + n;
        v4u o; o.x = pk2(s[0 * 33], s[1 * 33]); o.y = pk2(s[2 * 33], s[3 * 33]); o.z = pk2(s[4 * 33], s[5 * 33]); o.w = pk2(s[6 * 33], s[7 * 33]);
        *(v4u*)(WT + (size_t)(drow0 + n) * K + k0 + 8 * c) = o; }
    LDS_WAIT(); asm volatile("" ::: "memory");
}
__device__ __forceinline__ void norm_row_to_bf16(const float* xrow, const float* g, bf16* orow, int lane) {
    const f32x4* xr = (const f32x4*)xrow + lane; const f32x4* gr = (const f32x4*)g + lane;
    f32x4 v[8]; float s = 0.f;
#pragma unroll
    for (int j = 0; j < 8; ++j) { v[j] = xr[64 * j]; s += (v[j].x * v[j].x + v[j].y * v[j].y) + (v[j].z * v[j].z + v[j].w * v[j].w); }
    const float rstd = 1.0f / sqrtf(wave_sum(s) * (1.0f / DM) + EPS);
    v2u* o8 = (v2u*)orow + lane;
#pragma unroll
    for (int j = 0; j < 8; ++j) { const f32x4 gg = gr[64 * j]; v2u w; w.x = pk2(v[j].x * rstd * gg.x, v[j].y * rstd * gg.y); w.y = pk2(v[j].z * rstd * gg.z, v[j].w * rstd * gg.w); o8[64 * j] = w; }
}
__device__ __forceinline__ void p0_prologue(Frame& F) {
    LAS float* scr = (LAS float*)(F.lds + RING_OFF + F.wave * 16384);
    const int gw = F.vcu * NWAVES + F.wave, NGW = F.G * NWAVES; const int lane = opq(F.lane), tid = opq(F.tid);
    constexpr int NB_IN = (IN_COLS + 31) / 32;
    constexpr int I_IN = (DM / 64) * NB_IN, I_SQ = (DM / 64) * (DM / 32), I_KV = (DM / 64) * (2 * DM / 32), I_GU = (DM / 64) * (2 * DFF / 32), I_D = (DFF / 64) * (DM / 32);
    constexpr int I_LAYER = I_IN + 3 * I_SQ + I_KV + I_GU + I_D;
    for (int it = gw; it < DEPTH * I_LAYER; it += NGW) {
        const int l = it / I_LAYER; int r = it % I_LAYER;
        bf16* wl = wsb(F, WS_W + (size_t)l * W_LAYER);
        if (r < I_IN) { const int kb = r / NB_IN, nb = r % NB_IN; p0_transpose_item(inp(I_WIN) + (size_t)l * DM * IN_COLS, DM, IN_COLS, (bf16*)((char*)wl + WO_WIN), 32 * nb, 64 * kb, 32 * nb, scr, lane); continue; } r -= I_IN;
        if (r < I_SQ) { const int kb = r / (DM / 32), nb = r % (DM / 32); p0_transpose_item(inp(I_WOUT) + (size_t)l * DM * DM, DM, DM, (bf16*)((char*)wl + WO_WOUT), 32 * nb, 64 * kb, 32 * nb, scr, lane); continue; } r -= I_SQ;
        if (r < I_SQ) { const int kb = r / (DM / 32), nb = r % (DM / 32); p0_transpose_item(inp(I_WQ) + (size_t)l * DM * DM, DM, DM, (bf16*)((char*)wl + WO_WQ), 32 * nb, 64 * kb, 32 * nb, scr, lane); continue; } r -= I_SQ;
        if (r < I_SQ) { const int kb = r / (DM / 32), nb = r % (DM / 32); p0_transpose_item(inp(I_WO) + (size_t)l * DM * DM, DM, DM, (bf16*)((char*)wl + WO_WO), 32 * nb, 64 * kb, 32 * nb, scr, lane); continue; } r -= I_SQ;
        if (r < I_KV) { const int kb = r / (2 * DM / 32), nb = r % (2 * DM / 32); p0_transpose_item(inp(I_WKV) + (size_t)l * DM * 2 * DM, DM, 2 * DM, (bf16*)((char*)wl + WO_WKV), 32 * nb, 64 * kb, 32 * nb, scr, lane); continue; } r -= I_KV;
        if (r < I_GU) { const int kb = r / (2 * DFF / 32), nb = r % (2 * DFF / 32); const int n0 = 32 * nb; const int up = n0 >= DFF ? 1 : 0, j0 = n0 - up * DFF;
            const int drow = (j0 >> 7) * 256 + up * 128 + (j0 & 127);
            p0_transpose_item(inp(I_WGU) + (size_t)l * DM * 2 * DFF, DM, 2 * DFF, (bf16*)((char*)wl + WO_WGU), drow, 64 * kb, n0, scr, lane); continue; } r -= I_GU;
        { const int kb = r / (DM / 32), nb = r % (DM / 32); p0_transpose_item(inp(I_WD) + (size_t)l * DFF * DM, DFF, DM, (bf16*)((char*)wl + WO_WD), 32 * nb, 64 * kb, 32 * nb, scr, lane); }
    }
    { constexpr int ZR0 = 32 * NB_IN, ZN = (IN_PAD - ZR0) * DM / 8;
      for (int i = (F.vcu * NWAVES * 64) + tid; i < DEPTH * ZN; i += F.G * NWAVES * 64) { const int l = i / ZN, k = i % ZN;
          ((v4u*)(F.ws + WS_W + (size_t)l * W_LAYER + WO_WIN + (size_t)ZR0 * DM * 2))[k] = (v4u){0u, 0u, 0u, 0u}; } }
    for (int m = gw; m < DEPTH * MROWS; m += NGW) { const int l = m / MROWS, r = m % MROWS;
        norm_row_to_bf16(inp(I_MEM) + (size_t)r * DM, inp(I_NORMG) + (size_t)(l * N_NORMS + MEM_NORM) * DM, wsb(F, WS_MEMN) + (size_t)m * DM, lane); }
    for (int m = gw; m < M; m += NGW) norm_row_to_bf16(inp(I_X) + (size_t)m * DM, inp(I_NORMG) + (size_t)(0 * N_NORMS + MIX_PRE) * DM, wsb(F, WS_XN) + (size_t)m * DM, lane);
}

__device__ __forceinline__ void resnorm_phase(Frame& F, const float* xin, const float* gpost, const float* gpre  ) {
    const int gw = F.vcu * NWAVES + F.wave, NGW = F.G * NWAVES, lane = opq(F.lane);
    const float* Y = wsf(F, WS_Y); bf16* XN = wsb(F, WS_XN);
    for (int m = gw; m < M; m += NGW) {
        const f32x4* yr = (const f32x4*)(Y + (size_t)m * DM) + lane; const f32x4* xr = (const f32x4*)(xin + (size_t)m * DM) + lane;
        f32x4* xo = (f32x4*)(F.out + (size_t)m * DM) + lane;
        f32x4 y[8], x[8]; float s = 0.f;
#pragma unroll
        for (int j = 0; j < 8; ++j) { y[j] = yr[64 * j]; x[j] = xr[64 * j]; s += (y[j].x * y[j].x + y[j].y * y[j].y) + (y[j].z * y[j].z + y[j].w * y[j].w); }
        const float rstd = 1.0f / sqrtf(wave_sum(s) * (1.0f / DM) + EPS);
        float s2 = 0.f;
#pragma unroll
        for (int j = 0; j < 8; ++j) { const f32x4 gg = ((const f32x4*)gpost)[lane + 64 * j]; x[j] = x[j] + y[j] * rstd * gg; xo[64 * j] = x[j];
            s2 += (x[j].x * x[j].x + x[j].y * x[j].y) + (x[j].z * x[j].z + x[j].w * x[j].w); }
        if (gpre) {
            const float r2 = 1.0f / sqrtf(wave_sum(s2) * (1.0f / DM) + EPS);
            v2u* o8 = (v2u*)(XN + (size_t)m * DM) + lane;
#pragma unroll
            for (int j = 0; j < 8; ++j) { const f32x4 gg = ((const f32x4*)gpre)[lane + 64 * j]; v2u w; w.x = pk2(x[j].x * r2 * gg.x, x[j].y * r2 * gg.y); w.y = pk2(x[j].z * r2 * gg.z, x[j].w * r2 * gg.w); o8[64 * j] = w; }
        }
    }
}

__device__ __forceinline__ f32x4 ld4(const float* p) { return *(const f32x4*)p; }
__device__ __forceinline__ f32x4 silu4(f32x4 v) { return (f32x4){siluf(v.x), siluf(v.y), siluf(v.z), siluf(v.w)}; }
__device__ __forceinline__ void mixer_prep_phase(Frame& F, int l) {
    const int gw = F.vcu * NWAVES + F.wave, NGW = F.G * NWAVES, lane = opq(F.lane), tid = opq(F.tid);
    const float* U = wsf(F, WS_U);
    bf16* MIX = wsb(F, WS_MIX);
    constexpr int NSTRIP = M / 16;
    for (int it = gw; it < 16 * NSTRIP; it += NGW) {
        const int type = it & 15, strip = it >> 4, r0 = strip * 16, pos0 = r0 & (SEQ - 1);
        if (type < 2) {
            const int c = type * 256 + lane * 4;
            const float* cw = inp(I_CONVA) + (size_t)l * 3 * GW + c;
            const f32x4 w0 = ld4(cw), w1 = ld4(cw + GW), w2 = ld4(cw + 2 * GW);
            f32x4 p2 = (f32x4){0.f, 0.f, 0.f, 0.f}, p1 = p2;
            if (pos0 >= 2) { const float* u2 = U + (size_t)(r0 - 2) * IN_PAD; const float* u1 = U + (size_t)(r0 - 1) * IN_PAD;
                p2 = ld4(u2 + UA_C + c) * ld4(u2 + UA_H + c); p1 = ld4(u1 + UA_C + c) * ld4(u1 + UA_H + c); }
#pragma unroll 4
            for (int i = 0; i < 16; ++i) { const float* ur = U + (size_t)(r0 + i) * IN_PAD;
                const f32x4 p0 = ld4(ur + UA_C + c) * ld4(ur + UA_H + c);
                const f32x4 y = ld4(ur + UA_B + c) * (w0 * p2 + w1 * p1 + w2 * p0);
                v2u o; o.x = pk2(y.x, y.y); o.y = pk2(y.z, y.w); *(v2u*)(MIX + (size_t)(r0 + i) * DM + c) = o;
                p2 = p1; p1 = p0; }
        } else if (type < 8) {
            const int gi = type - 2, c = gi * 256 + lane * 4;
            const float* cw = inp(I_GCONV) + (size_t)l * 4 * 3 * GW + c;
            const f32x4 w0 = ld4(cw), w1 = ld4(cw + 3 * GW), w2 = ld4(cw + 6 * GW), w3 = ld4(cw + 9 * GW);
            f32x4 x3 = (f32x4){0.f, 0.f, 0.f, 0.f}, x2 = x3, x1 = x3;
            if (pos0 >= 3) { x3 = ld4(U + (size_t)(r0 - 3) * IN_PAD + UC_Q + c); x2 = ld4(U + (size_t)(r0 - 2) * IN_PAD + UC_Q + c); x1 = ld4(U + (size_t)(r0 - 1) * IN_PAD + UC_Q + c); }
            float* dst = (gi < 2) ? wsf(F, WS_QN) + gi * 256 : (gi < 4) ? wsf(F, WS_KN) + (gi - 2) * 256 : wsf(F, WS_VV) + (gi - 4) * 256;
            const float qs = (gi < 2) ? 0.08838834764831845f : 1.0f;
#pragma unroll 4
            for (int i = 0; i < 16; ++i) { const f32x4 x0 = ld4(U + (size_t)(r0 + i) * IN_PAD + UC_Q + c);
                f32x4 y = silu4(w0 * x3 + w1 * x2 + w2 * x1 + w3 * x0);
                if (gi < 4) { float ss = (y.x * y.x + y.y * y.y) + (y.z * y.z + y.w * y.w);
                    ss += __shfl_xor(ss, 1); ss += __shfl_xor(ss, 2); ss += __shfl_xor(ss, 4); ss += __shfl_xor(ss, 8); ss += __shfl_xor(ss, 16);
                    y = y * (qs / sqrtf(ss + EPS)); }
                *(f32x4*)(dst + (size_t)(r0 + i) * GW + lane * 4) = y;
                x3 = x2; x2 = x1; x1 = x0; }
        } else if (type < 12) {
            const int gi = type - 8, c = gi * 256 + lane * 4;
            const float* cw = inp(I_SCONVW) + (size_t)l * 4 * 1024 + c;
            const f32x4 w0 = ld4(cw), w1 = ld4(cw + 1024), w2 = ld4(cw + 2048), w3 = ld4(cw + 3072), bb = ld4(inp(I_SCONVB) + (size_t)l * 1024 + c);
            f32x4 x3 = (f32x4){0.f, 0.f, 0.f, 0.f}, x2 = x3, x1 = x3;
            if (pos0 >= 3) { x3 = ld4(U + (size_t)(r0 - 3) * IN_PAD + UD_X + c); x2 = ld4(U + (size_t)(r0 - 2) * IN_PAD + UD_X + c); x1 = ld4(U + (size_t)(r0 - 1) * IN_PAD + UD_X + c); }
            float* dst; int ld;
            if (gi < 2) { dst = wsf(F, WS_XS) + gi * 256; ld = 512; } else if (gi == 2) { dst = wsf(F, WS_BS); ld = 256; } else { dst = wsf(F, WS_CS); ld = 256; }
#pragma unroll 4
            for (int i = 0; i < 16; ++i) { const f32x4 x0 = ld4(U + (size_t)(r0 + i) * IN_PAD + UD_X + c);
                const f32x4 y = silu4(w0 * x3 + w1 * x2 + w2 * x1 + w3 * x0 + bb);
                *(f32x4*)(dst + (size_t)(r0 + i) * ld + lane * 4) = y;
                x3 = x2; x2 = x1; x1 = x0; }
        } else {
            const int gi = type - 12, w = 2 << gi;
            LAS float* scr = (LAS float*)(F.lds + RING_OFF + F.wave * 16384);
            const int c0 = UB + gi * 128 + lane * 2;
            float r0s = 0.f, r1s = 0.f;
            if (pos0 > 0) { for (int s = 1; s < w; ++s) { const float* up = U + (size_t)(r0 - s) * IN_PAD + c0; r0s += up[0]; r1s += up[1]; } }
            for (int i = 0; i < 16; ++i) { const int pos = pos0 + i; const float* ur = U + (size_t)(r0 + i) * IN_PAD + c0;
                const float a0 = ur[0], a1 = ur[1];
                r0s += a0; r1s += a1;
                const float cnt = (float)((pos + 1 < w) ? pos + 1 : w);
                scr[i * 128 + lane * 2] = r0s / cnt - a0; scr[i * 128 + lane * 2 + 1] = r1s / cnt - a1;
                if (pos - w + 1 >= 0) { const float* ud = U + (size_t)(r0 + i - w + 1) * IN_PAD + c0; r0s -= ud[0]; r1s -= ud[1]; } }
            LDS_WAIT(); asm volatile("" ::: "memory");
            float acc0[16], acc1[16];
#pragma unroll
            for (int i = 0; i < 16; ++i) { acc0[i] = 0.f; acc1[i] = 0.f; }
            const float* pw = inp(I_POOLW) + ((size_t)l * 4 + gi) * 128 * 128;
            for (int cc = 0; cc < 128; cc += 4) {
                float wa[4], wb[4];
#pragma unroll
                for (int q = 0; q < 4; ++q) { wa[q] = pw[(size_t)(cc + q) * 128 + lane]; wb[q] = pw[(size_t)(cc + q) * 128 + 64 + lane]; }
#pragma unroll
                for (int i = 0; i < 16; ++i) { const f32x4 p = *(const LAS f32x4*)(scr + i * 128 + cc);
                    acc0[i] += p.x * wa[0] + p.y * wa[1] + p.z * wa[2] + p.w * wa[3]; acc1[i] += p.x * wb[0] + p.y * wb[1] + p.z * wb[2] + p.w * wb[3]; }
            }
            const float s0 = inp(I_POOLS)[(size_t)l * GW + gi * 128 + lane], s1 = inp(I_POOLS)[(size_t)l * GW + gi * 128 + 64 + lane];
#pragma unroll
            for (int i = 0; i < 16; ++i) { bf16* o = MIX + (size_t)(r0 + i) * DM + GW + gi * 128; o[lane] = (bf16)f2bf(acc0[i] * s0); o[64 + lane] = (bf16)f2bf(acc1[i] * s1); }
            LDS_WAIT(); asm volatile("" ::: "memory");
        }
    }
    for (int i = (F.vcu * NWAVES * 64) + tid; i < M * 16; i += F.G * NWAVES * 64) { const int t = i >> 4, j = i & 15; const float* ur = U + (size_t)t * IN_PAD;
        if (j < 4) { wsf(F, WS_GB)[(size_t)t * 8 + j] = -__expf(inp(I_GALOG)[l * 4 + j]) * softplusf(ur[UC_A + j] + inp(I_GDTB)[l * 4 + j]); }
        else if (j < 8) { wsf(F, WS_GB)[(size_t)t * 8 + j] = sigmoidf(ur[UC_B + (j - 4)]); }
        else { wsf(F, WS_DT)[(size_t)t * 8 + (j - 8)] = softplusf(ur[UD_DT + (j - 8)] + inp(I_SDTB)[l * 8 + (j - 8)]); } }
}

__device__ __forceinline__ void scan_phase(Frame& F, int l) {
    const int lane = opq(F.lane), sub = lane & 15, grp = lane >> 4;
    if (F.wave >= 4) return;
    for (int item = F.vcu * 4 + F.wave; item < 1024; item += F.G * 4) {
    if (item < 512) {
        const int b = item >> 7, h = (item >> 5) & 3, j = (item & 31) * 4 + grp;
        const float* KN = wsf(F, WS_KN) + (size_t)b * SEQ * GW + h * 128 + sub * 8;
        const float* QN = wsf(F, WS_QN) + (size_t)b * SEQ * GW + h * 128 + sub * 8;
        const float* VV = wsf(F, WS_VV) + (size_t)b * SEQ * GW + h * 128 + j;
        const float* GB = wsf(F, WS_GB) + (size_t)b * SEQ * 8 + h;
        float* OG = wsf(F, WS_OG) + (size_t)b * SEQ * GW + h * 128 + j;
        float S[8];
#pragma unroll
        for (int i = 0; i < 8; ++i) S[i] = 0.f;
        f32x4 ka = ld4(KN), kb = ld4(KN + 4), qa = ld4(QN), qb = ld4(QN + 4); float v = VV[0], g = GB[0], be = GB[4];
        for (int t = 0; t < SEQ; ++t) {
            const int tn = (t + 1 < SEQ) ? t + 1 : t;
            const f32x4 nka = ld4(KN + (size_t)tn * GW), nkb = ld4(KN + (size_t)tn * GW + 4), nqa = ld4(QN + (size_t)tn * GW), nqb = ld4(QN + (size_t)tn * GW + 4);
            const float nv = VV[(size_t)tn * GW], ng = GB[(size_t)tn * 8], nbe = GB[(size_t)tn * 8 + 4];
            const float k[8] = {ka.x, ka.y, ka.z, ka.w, kb.x, kb.y, kb.z, kb.w}, q[8] = {qa.x, qa.y, qa.z, qa.w, qb.x, qb.y, qb.z, qb.w};
            float ks = 0.f;
#pragma unroll
            for (int i = 0; i < 8; ++i) ks += k[i] * S[i];
            ks = row16_sum(ks);
            const float eg = __expf(g), delta = be * (v - eg * ks);
            float o = 0.f;
#pragma unroll
            for (int i = 0; i < 8; ++i) { S[i] = eg * S[i] + k[i] * delta; o += q[i] * S[i]; }
            o = row16_sum(o);
            if (sub == 0) OG[(size_t)t * GW] = o;
            ka = nka; kb = nkb; qa = nqa; qb = nqb; v = nv; g = ng; be = nbe;
        }
    } else {
        const int it2 = item - 512, b = it2 >> 7, hh = (it2 >> 4) & 7, p = (it2 & 15) * 4 + grp, gq = hh >> 2;
        const float* BS = wsf(F, WS_BS) + (size_t)b * SEQ * 256 + gq * 128 + sub * 8;
        const float* CS = wsf(F, WS_CS) + (size_t)b * SEQ * 256 + gq * 128 + sub * 8;
        const float* XS = wsf(F, WS_XS) + (size_t)b * SEQ * GW + hh * 64 + p;
        const float* DT = wsf(F, WS_DT) + (size_t)b * SEQ * 8 + hh;
        float* YS = wsf(F, WS_YS) + (size_t)b * SEQ * GW + hh * 64 + p;
        const float A = -__expf(inp(I_SALOG)[l * 8 + hh]), Dk = inp(I_SD)[l * 8 + hh];
        float hs[8];
#pragma unroll
        for (int i = 0; i < 8; ++i) hs[i] = 0.f;
        f32x4 ba = ld4(BS), bb = ld4(BS + 4), ca = ld4(CS), cb = ld4(CS + 4); float x = XS[0], dt = DT[0];
        for (int t = 0; t < SEQ; ++t) {
            const int tn = (t + 1 < SEQ) ? t + 1 : t;
            const f32x4 nba = ld4(BS + (size_t)tn * 256), nbb = ld4(BS + (size_t)tn * 256 + 4), nca = ld4(CS + (size_t)tn * 256), ncb = ld4(CS + (size_t)tn * 256 + 4);
            const float nx = XS[(size_t)tn * GW], ndt = DT[(size_t)tn * 8];
            const float Bv[8] = {ba.x, ba.y, ba.z, ba.w, bb.x, bb.y, bb.z, bb.w}, Cv[8] = {ca.x, ca.y, ca.z, ca.w, cb.x, cb.y, cb.z, cb.w};
            const float dA = __expf(dt * A), xd = x * dt;
            float y = 0.f;
#pragma unroll
            for (int i = 0; i < 8; ++i) { hs[i] = dA * hs[i] + xd * Bv[i]; y += hs[i] * Cv[i]; }
            y = row16_sum(y);
            if (sub == 0) YS[(size_t)t * GW] = y + Dk * x;
            ba = nba; bb = nbb; ca = nca; cb = ncb; x = nx; dt = ndt;
        }
    }
    }
}

__device__ __forceinline__ void mixer_post_phase(Frame& F, int l) {
    const int gw = F.vcu * NWAVES + F.wave, NGW = F.G * NWAVES, lane = opq(F.lane), c = lane * 8;
    const float* U = wsf(F, WS_U); bf16* MIX = wsb(F, WS_MIX);
    const float* gng = inp(I_GNG) + (size_t)l * 128 + (c & 127); const float* sng = inp(I_SNG) + (size_t)l * GW + c;
    const f32x4 g0 = ld4(gng), g1 = ld4(gng + 4), n0 = ld4(sng), n1 = ld4(sng + 4);
    for (int m = gw; m < M; m += NGW) {
        {
            const float* og = wsf(F, WS_OG) + (size_t)m * GW + c; const float* z = U + (size_t)m * IN_PAD + UC_Z + c;
            const f32x4 o0 = ld4(og), o1 = ld4(og + 4), z0 = ld4(z), z1 = ld4(z + 4);
            float ss = (o0.x * o0.x + o0.y * o0.y) + (o0.z * o0.z + o0.w * o0.w) + (o1.x * o1.x + o1.y * o1.y) + (o1.z * o1.z + o1.w * o1.w);
            ss += __shfl_xor(ss, 1); ss += __shfl_xor(ss, 2); ss += __shfl_xor(ss, 4); ss += __shfl_xor(ss, 8);
            const float rstd = 1.0f / sqrtf(ss * (1.0f / 128.0f) + EPS);
            const f32x4 y0 = o0 * rstd * g0 * silu4(z0), y1 = o1 * rstd * g1 * silu4(z1);
            v4u w; w.x = pk2(y0.x, y0.y); w.y = pk2(y0.z, y0.w); w.z = pk2(y1.x, y1.y); w.w = pk2(y1.z, y1.w);
            *(v4u*)(MIX + (size_t)m * DM + 2 * GW + c) = w;
        }
        {
            const float* ys = wsf(F, WS_YS) + (size_t)m * GW + c; const float* z = U + (size_t)m * IN_PAD + UD_Z + c;
            const f32x4 a0 = ld4(ys) * silu4(ld4(z)), a1 = ld4(ys + 4) * silu4(ld4(z + 4));
            float ss = (a0.x * a0.x + a0.y * a0.y) + (a0.z * a0.z + a0.w * a0.w) + (a1.x * a1.x + a1.y * a1.y) + (a1.z * a1.z + a1.w * a1.w);
            ss += __shfl_xor(ss, 1); ss += __shfl_xor(ss, 2); ss += __shfl_xor(ss, 4); ss += __shfl_xor(ss, 8); ss += __shfl_xor(ss, 16);
            const float rstd = 1.0f / sqrtf(ss * (1.0f / 256.0f) + EPS);
            const f32x4 y0 = a0 * rstd * n0, y1 = a1 * rstd * n1;
            v4u w; w.x = pk2(y0.x, y0.y); w.y = pk2(y0.z, y0.w); w.z = pk2(y1.x, y1.y); w.w = pk2(y1.z, y1.w);
            *(v4u*)(MIX + (size_t)m * DM + 3 * GW + c) = w;
        }
    }
}

__device__ __forceinline__ void attn_phase(Frame& F, int l) {
    const int lane = opq(F.lane), fr = lane & 15, fq = lane >> 4;
    const bf16* Q = wsb(F, WS_Q); const bf16* KB = wsb(F, WS_KB) + (size_t)l * MROWS * DM; const bf16* VT = wsb(F, WS_VT) + (size_t)l * DM * MROWS; bf16* O = wsb(F, WS_MIX);
    for (int unit = F.vcu; unit < BATCH * XH * (SEQ / 128); unit += F.G) {
        const int b = unit >> 6, h = (unit >> 4) & 3, qt = unit & 15;
        const int qrow0 = b * SEQ + qt * 128 + F.wave * 16;
        const bf16* qp = Q + (size_t)(qrow0 + fr) * DM + h * XHD + fq * 8;
        const bf16* kp = KB + (size_t)(b * MEML + fr) * DM + h * XHD + fq * 8;
        f32x4 acc[16];
#pragma unroll
        for (int n = 0; n < 16; ++n) acc[n] = (f32x4){0.f, 0.f, 0.f, 0.f};
        for (int ks = 0; ks < 16; ++ks) {
            const bf16x8 qf = *(const bf16x8*)(qp + ks * 32);
#pragma unroll
            for (int n = 0; n < 16; ++n) { const bf16x8 kf = *(const bf16x8*)(kp + (size_t)n * 16 * DM + ks * 32);
                acc[n] = __builtin_amdgcn_mfma_f32_16x16x32_bf16(kf, qf, acc[n], 0, 0, 0); }
        }
        float mx = -3.0e38f;
#pragma unroll
        for (int n = 0; n < 16; ++n) mx = fmaxf(fmaxf(fmaxf(acc[n].x, acc[n].y), fmaxf(acc[n].z, acc[n].w)), mx);
        mx = fmaxf(mx, __shfl_xor(mx, 16)); mx = fmaxf(mx, __shfl_xor(mx, 32));
        float sum = 0.f;
#pragma unroll
        for (int n = 0; n < 16; ++n) { acc[n].x = __expf(acc[n].x - mx); acc[n].y = __expf(acc[n].y - mx); acc[n].z = __expf(acc[n].z - mx); acc[n].w = __expf(acc[n].w - mx);
            sum += (acc[n].x + acc[n].y) + (acc[n].z + acc[n].w); }
        sum += __shfl_xor(sum, 16); sum += __shfl_xor(sum, 32);
        const float linv = 1.0f / sum;
        bf16x8 pf[8];
#pragma unroll
        for (int s = 0; s < 8; ++s) { v4u w; w.x = pk2(acc[2 * s].x, acc[2 * s].y); w.y = pk2(acc[2 * s].z, acc[2 * s].w); w.z = pk2(acc[2 * s + 1].x, acc[2 * s + 1].y); w.w = pk2(acc[2 * s + 1].z, acc[2 * s + 1].w);
            pf[s] = __builtin_bit_cast(bf16x8, w); }
        float lv[4];
#pragma unroll
        for (int r = 0; r < 4; ++r) lv[r] = __shfl(linv, 4 * fq + r);
        const bf16* vp = VT + (size_t)(h * XHD + fr) * MROWS + b * MEML + 4 * fq;
        bf16* op = O + (size_t)(qrow0 + 4 * fq) * DM + h * XHD + fr;
#pragma unroll 2
        for (int dt = 0; dt < 32; ++dt) {
            f32x4 oa = (f32x4){0.f, 0.f, 0.f, 0.f};
#pragma unroll
            for (int s = 0; s < 8; ++s) { const bf16* vv = vp + (size_t)dt * 16 * MROWS + s * 32;
                v4u w; const v2u lo = *(const v2u*)vv, hi = *(const v2u*)(vv + 16); w.x = lo.x; w.y = lo.y; w.z = hi.x; w.w = hi.y;
                oa = __builtin_amdgcn_mfma_f32_16x16x32_bf16(pf[s], __builtin_bit_cast(bf16x8, w), oa, 0, 0, 0); }
            op[(size_t)0 * DM + dt * 16] = (bf16)f2bf(oa.x * lv[0]); op[(size_t)1 * DM + dt * 16] = (bf16)f2bf(oa.y * lv[1]);
            op[(size_t)2 * DM + dt * 16] = (bf16)f2bf(oa.z * lv[2]); op[(size_t)3 * DM + dt * 16] = (bf16)f2bf(oa.w * lv[3]);
        }
    }
}

#ifndef SKIPM
#define SKIPM 0
#endif
constexpr int PH_PER_LAYER = 13, N_PHASES = 2 + DEPTH * PH_PER_LAYER;
struct Args { const float* in[N_IN]; float* out; unsigned char* ws; int ph_lo, ph_hi; };
static_assert(sizeof(Args) == (N_IN + 2) * 8 + 8, "Args has no padding");
struct GemmDesc { const bf16* A; const bf16* Bt; void* C; int M, N, K, ldc, mode, corder; float scale; };
__device__ __forceinline__ void gemm_desc(const Frame& F, int ph, int sub, GemmDesc& d) {
    const int bx = (int)blockIdx.x;
    d.scale = 1.0f; d.corder = bx;
    if (ph == 1) {
        const int l = sub >> 1; const bf16* wkv = (const bf16*)(F.ws + WS_W + (size_t)l * W_LAYER + WO_WKV); const bf16* memn = wsb(F, WS_MEMN) + (size_t)l * MROWS * DM;
        d.corder = (bx + F.G - 32 * sub) % F.G; d.mode = 1; d.K = DM;
        if ((sub & 1) == 0) { d.A = memn; d.Bt = wkv; d.M = MROWS; d.N = DM; d.C = wsb(F, WS_KB) + (size_t)l * MROWS * DM; d.ldc = DM; }
        else { d.A = wkv + (size_t)DM * DM; d.Bt = memn; d.M = DM; d.N = MROWS; d.C = wsb(F, WS_VT) + (size_t)l * DM * MROWS; d.ldc = MROWS; }
        return;
    }
    const int l = (ph - 2) / PH_PER_LAYER, k = (ph - 2) % PH_PER_LAYER;
    const unsigned char* wl = F.ws + WS_W + (size_t)l * W_LAYER;
    d.M = M; d.K = DM; d.N = DM; d.ldc = DM; d.mode = 0; d.A = wsb(F, WS_XN); d.C = wsf(F, WS_Y);
    if (k == 0) { d.Bt = (const bf16*)(wl + WO_WIN); d.N = IN_PAD; d.C = wsf(F, WS_U); d.ldc = IN_PAD; }
    else if (k == 4) { d.A = wsb(F, WS_MIX); d.Bt = (const bf16*)(wl + WO_WOUT); }
    else if (k == 6) { d.Bt = (const bf16*)(wl + WO_WQ); d.mode = 1; d.C = wsb(F, WS_Q); d.scale = 0.044194173824159216f; }
    else if (k == 8) { d.A = wsb(F, WS_MIX); d.Bt = (const bf16*)(wl + WO_WO); }
    else if (k == 10) { d.Bt = (const bf16*)(wl + WO_WGU); d.N = 2 * DFF; d.mode = 2; d.C = wsb(F, WS_HID); d.ldc = DFF; }
    else { d.A = wsb(F, WS_HID); d.Bt = (const bf16*)(wl + WO_WD); d.K = DFF; }
}

__global__ void __launch_bounds__(NWAVES * 64, 2) fwd_kernel(Args args) {
    extern __shared__ __attribute__((aligned(16))) unsigned char lds[];
    Frame F;
    F.lds = (LAS unsigned char*)lds;
    F.MISC = (volatile LAS unsigned*)(F.lds + MISC_OFF);
    F.tid = threadIdx.x; F.lane = F.tid & 63; F.wave = __builtin_amdgcn_readfirstlane(F.tid >> 6);
    F.G = gridDim.x; { const int bx = blockIdx.x; F.vcu = (F.G % 8 == 0) ? (bx % 8) * (F.G / 8) + bx / 8 : bx; }
    F.ws = args.ws; F.out = args.out; F.ctl = (unsigned*)(args.ws + WS_CTL);
    for (int u = F.tid; u < (LDS_BYTES - LDSCTL_OFF) / 4; u += NWAVES * 64) ((LAS unsigned*)(F.lds + LDSCTL_OFF))[u] = 0u;
    __syncthreads();
    const int lo = args.ph_lo, hi = args.ph_hi;
    XcdBarrier bar; bar.bar = F.ctl + CW_BAR; bar.x = 0; bar.st = nullptr;
    if (hi - lo > 1) bar = xcd_barrier_post(F.ctl + CW_BAR, F.MISC + 8);
    LAS unsigned char* ring = F.lds + RING_OFF;
#pragma unroll 1
    for (int ph = lo; ph < hi; ++ph) {
        const int l = ph >= 2 ? (ph - 2) / PH_PER_LAYER : 0, k = ph >= 2 ? (ph - 2) % PH_PER_LAYER : -1;
        const bool is_gemm = (ph == 1) || k == 0 || k == 4 || k == 6 || k == 8 || k == 10 || k == 11;
        if (is_gemm) {
            if (!(SKIPM & 2)) {
            const int nsub = (ph == 1) ? 2 * DEPTH : 1;
#pragma unroll 1
            for (int sub = 0; sub < nsub; ++sub) {
                GemmDesc d; gemm_desc(F, ph, sub, d);
                pg8::Gemm g{d.A, d.Bt, d.M, d.N, d.K}; pg8::StaticOrder S; S.init(d.M, d.N, F.G, d.corder);
                pg8::EpiAny E{d.C, d.ldc, d.mode, d.scale};
                pg8::gemm_phase<pg8::EpiAny, pg8::StaticOrder, false, false>(ring, g, S, E);
            } }
        } else if (ph == 0) { if (!(SKIPM & 1)) p0_prologue(F); }
        else {
            const float* ng = inp(I_NORMG) + (size_t)l * N_NORMS * DM;
            if (k == 1) { if (!(SKIPM & 8)) mixer_prep_phase(F, l); }
            else if (k == 2) { if (!(SKIPM & 16)) scan_phase(F, l); }
            else if (k == 3) { if (!(SKIPM & 32)) mixer_post_phase(F, l); }
            else if (k == 7) { if (!(SKIPM & 512)) attn_phase(F, l); }
            else if (!(SKIPM & 128)) {
                if (k == 5) resnorm_phase(F, l == 0 ? inp(I_X) : F.out, ng + MIX_POST * DM, ng + XA_PRE * DM);
                else if (k == 9) resnorm_phase(F, F.out, ng + XA_POST * DM, ng + FFN_PRE * DM);
                else resnorm_phase(F, F.out, ng + FFN_POST * DM, (l + 1 < DEPTH) ? ng + (N_NORMS + MIX_PRE) * DM : nullptr);
            }
        }
        if (ph + 1 < hi) xcd_barrier(bar);
    }
}

#ifndef MK_SINGLE
#define MK_SINGLE 0
#endif
extern "C" void kernel_launch(void* const* d_in, const int* in_sizes, int n_in, void* d_out, int out_size, void* d_ws, size_t ws_size, hipStream_t stream) {
    static int grid = 0;
    if (grid == 0) {
        if (n_in != N_IN || in_sizes[0] != M * DM || out_size != M * DM || ws_size < WS_END) { fprintf(stderr, "kernel_launch: unexpected problem (n_in %d, in0 %d, out %d, ws %zu < %zu)\n", n_in, n_in > 0 ? in_sizes[0] : -1, out_size, ws_size, (size_t)WS_END); grid = -1; return; }
        int dev = 0, cus = 0, per_cu = 0;
        if (hipGetDevice(&dev) != hipSuccess || hipDeviceGetAttribute(&cus, hipDeviceAttributeMultiprocessorCount, dev) != hipSuccess) { grid = -1; return; }
        if (hipFuncSetAttribute((const void*)fwd_kernel, hipFuncAttributeMaxDynamicSharedMemorySize, LDS_BYTES) != hipSuccess) { fprintf(stderr, "kernel_launch: hipFuncSetAttribute failed\n"); grid = -1; return; }
        if (hipOccupancyMaxActiveBlocksPerMultiprocessor(&per_cu, (const void*)fwd_kernel, NWAVES * 64, LDS_BYTES) != hipSuccess || per_cu < 1) { fprintf(stderr, "kernel_launch: occupancy query says %d blocks per CU\n", per_cu); per_cu = 1; }
        (void)hipGetLastError();
        grid = cus * (per_cu < 1 ? 1 : 1);
        if (grid != 256) fprintf(stderr, "kernel_launch: note: grid %d (expected 256)\n", grid);
    }
    if (grid < 0) return;
    if (hipMemsetAsync((char*)d_ws + WS_CTL, 0, CTL_ZERO_BYTES, stream) != hipSuccess) { fprintf(stderr, "kernel_launch: memset failed\n"); return; }
    Args a{};
    for (int i = 0; i < N_IN; ++i) a.in[i] = (const float*)d_in[i];
    a.out = (float*)d_out; a.ws = (unsigned char*)d_ws;
#if MK_SINGLE
    a.ph_lo = 0; a.ph_hi = N_PHASES;
    void* kargs[] = {&a};
    hipError_t e = hipLaunchCooperativeKernel((const void*)fwd_kernel, dim3(grid), dim3(NWAVES * 64), kargs, LDS_BYTES, stream);
    if (e != hipSuccess) fprintf(stderr, "kernel_launch: cooperative launch failed: %s (grid %d)\n", hipGetErrorString(e), grid);
#else
    for (int p = 0; p < N_PHASES; ++p) { a.ph_lo = p; a.ph_hi = p + 1;
        hipLaunchKernelGGL(fwd_kernel, dim3(grid), dim3(NWAVES * 64), LDS_BYTES, stream, a);
        const hipError_t le = hipPeekAtLastError(); if (le != hipSuccess) { fprintf(stderr, "kernel_launch: launch %d failed: %s\n", p, hipGetErrorName(le)); break; } }
#endif
}
```

```cpp
#include <hip/hip_runtime.h>
#include <cstdio>
#include <cstdint>
#define MK_SINGLE 1
namespace pg8 {
#define PG8_LAS __attribute__((address_space(3)))
typedef unsigned short bf16_t;
typedef short bf16x8 __attribute__((ext_vector_type(8)));
typedef float f32x4 __attribute__((ext_vector_type(4)));
typedef unsigned u32x4 __attribute__((ext_vector_type(4)));
constexpr int BM = 256, BK = 64, HALF = 128, HTB = HALF * BK * 2  , STAGE_BYTES = 8 * HTB, NXCD = 8, WGM = 8;

__host__ __device__ __forceinline__ int lds_byte(int r, int c) { const int st = (r >> 4) * 2 + (c >> 5), rr = r & 15, cc = c & 31, ob = rr * 64 + cc * 2; return st * 1024 + (ob ^ (((ob >> 9) & 1) << 5)); }
__host__ __device__ __forceinline__ void stage_rc(int b, int& R, int& C) { const int st = b / 1024, sb = b % 1024, swz = sb ^ (((sb >> 9) & 1) << 5); R = (st >> 1) * 16 + swz / 64; C = (st & 1) * 32 + (swz % 64) / 2; }
__host__ __device__ __forceinline__ int perm32(int rho) { const int n = rho >> 4, i = rho & 15; return 8 * (i >> 2) + 4 * n + (i & 3); }

struct Unit { int pm, pn; };
struct Gemm { const bf16_t* A; const bf16_t* Bt; int M, N, K; };

struct StaticOrder {
    int nM, nN, nwg, G, c;
    __host__ __device__ void init(int M, int N, int G_, int c_) { nM = M / BM; nN = N / BM; nwg = nM * nN; G = G_; c = c_; }
    __host__ __device__ bool next(int i, Unit& u) const {
        const long L = (long)i * G + c; if (L >= nwg) return false;
        int wgid = (int)L; { const int q = nwg / NXCD, r = nwg % NXCD, xcd = wgid % NXCD, off = wgid / NXCD; wgid = (xcd < r ? xcd * (q + 1) : r * (q + 1) + (xcd - r) * q) + off; }
        const int nig = WGM * nN, gid = wgid / nig, fm = gid * WGM, gsz = (nM - fm) < WGM ? (nM - fm) : WGM;
        u.pm = fm + ((wgid % nig) % gsz); u.pn = (wgid % nig) / gsz; return true;
    }
    __device__ __forceinline__ void a_ready(const Unit&) const {}
    __device__ __forceinline__ void done(const Unit&) const {}
};

__device__ __forceinline__ unsigned cvt_pk_bf16(float lo, float hi) { unsigned r; asm volatile("v_cvt_pk_bf16_f32 %0, %1, %2" : "=v"(r) : "v"(lo), "v"(hi)); return r; }
struct EpiF32 {
    static constexpr bool PERM = false, AFTER_DRAIN = false;
    float* C; int ldc;
    __device__ __forceinline__ void operator()(const f32x4 (&acc)[2][2][4][2], const Unit& u, int wr, int wc, int fr, int fq) const {
        const int row0 = u.pm * BM + wr * 64 + fr, col0 = u.pn * BM + wc * 32 + 4 * fq;
#pragma unroll
        for (int ai = 0; ai < 2; ++ai)
#pragma unroll
            for (int m = 0; m < 4; ++m) { float* rowp = C + (size_t)(row0 + ai * HALF + m * 16) * ldc + col0;
#pragma unroll
                for (int bj = 0; bj < 2; ++bj)
#pragma unroll
                    for (int n = 0; n < 2; ++n) *(f32x4*)(rowp + bj * HALF + n * 16) = acc[ai][bj][m][n]; }
    }
};
struct EpiBf16S {
    static constexpr bool PERM = true, AFTER_DRAIN = false;
    bf16_t* O; int ldc; float scale;
    __device__ __forceinline__ void operator()(const f32x4 (&acc)[2][2][4][2], const Unit& u, int wr, int wc, int fr, int fq) const {
        const int row0 = u.pm * BM + wr * 64 + fr, col0 = u.pn * BM + wc * 32 + 8 * fq; const float sc = scale;
#pragma unroll
        for (int ai = 0; ai < 2; ++ai)
#pragma unroll
            for (int m = 0; m < 4; ++m) { bf16_t* rowp = O + (size_t)(row0 + ai * HALF + m * 16) * ldc + col0;
#pragma unroll
                for (int bj = 0; bj < 2; ++bj) { const f32x4 v0 = acc[ai][bj][m][0] * sc, v1 = acc[ai][bj][m][1] * sc;
                    u32x4 w; w.x = cvt_pk_bf16(v0[0], v0[1]); w.y = cvt_pk_bf16(v0[2], v0[3]); w.z = cvt_pk_bf16(v1[0], v1[1]); w.w = cvt_pk_bf16(v1[2], v1[3]);
                    *(u32x4*)(rowp + bj * HALF) = w; } }
    }
};
__device__ __forceinline__ float silu_f(float v) { return v / (1.0f + __expf(-v)); }
struct EpiSwiGLU {
    static constexpr bool PERM = true, AFTER_DRAIN = false;
    bf16_t* O; int ldc;
    __device__ __forceinline__ void operator()(const f32x4 (&acc)[2][2][4][2], const Unit& u, int wr, int wc, int fr, int fq) const {
        const int row0 = u.pm * BM + wr * 64 + fr, col0 = u.pn * HALF + wc * 32 + 8 * fq;
#pragma unroll
        for (int ai = 0; ai < 2; ++ai)
#pragma unroll
            for (int m = 0; m < 4; ++m) { bf16_t* rowp = O + (size_t)(row0 + ai * HALF + m * 16) * ldc + col0;
                const f32x4 g0 = acc[ai][0][m][0], g1 = acc[ai][0][m][1], u0 = acc[ai][1][m][0], u1 = acc[ai][1][m][1];
                u32x4 w; w.x = cvt_pk_bf16(silu_f(g0[0]) * u0[0], silu_f(g0[1]) * u0[1]); w.y = cvt_pk_bf16(silu_f(g0[2]) * u0[2], silu_f(g0[3]) * u0[3]);
                w.z = cvt_pk_bf16(silu_f(g1[0]) * u1[0], silu_f(g1[1]) * u1[1]); w.w = cvt_pk_bf16(silu_f(g1[2]) * u1[2], silu_f(g1[3]) * u1[3]);
                *(u32x4*)rowp = w; }
    }
};
struct EpiAny {
    static constexpr bool PERM = false, AFTER_DRAIN = false, RT_PERM = true;
    void* C; int ldc; int mode; float scale;
    __device__ __forceinline__ bool perm() const { return mode != 0; }
    __device__ __forceinline__ void operator()(const f32x4 (&acc)[2][2][4][2], const Unit& u, int wr, int wc, int fr, int fq) const {
        if (mode == 0) { EpiF32 e{(float*)C, ldc}; e(acc, u, wr, wc, fr, fq); }
        else if (mode == 1) { EpiBf16S e{(bf16_t*)C, ldc, scale}; e(acc, u, wr, wc, fr, fq); }
        else { EpiSwiGLU e{(bf16_t*)C, ldc}; e(acc, u, wr, wc, fr, fq); }
    }
};
template <class Epi, class Sched, bool ALIGN_EPI = false, bool SP2 = false>
__device__ __forceinline__ void gemm_phase(PG8_LAS unsigned char* lds, const Gemm g, const Sched& S, const Epi& E) {
    const int tid = threadIdx.x, wid = __builtin_amdgcn_readfirstlane(tid >> 6), lane = tid & 63, wr = wid >> 2, wc = wid & 3, fr = lane & 15, fq = lane >> 4;
    const int K = g.K, nt = K / BK;
    unsigned voffA[2], voffB[2];
#pragma unroll
    for (int i = 0; i < 2; ++i) { int R, C; stage_rc(tid * 16 + i * 8192, R, C); const int Rb = E.perm() ? ((R & ~31) + perm32(R & 31)) : R;
        voffA[i] = (unsigned)(R * K + C) * 2u; voffB[i] = (unsigned)(Rb * K + C) * 2u; }
    const size_t kstep = (size_t)(BK * 2);
    const size_t hstep = (size_t)HALF * K * 2;
    const size_t tstep = 2 * hstep;
    const unsigned ldsw = (unsigned)wid * 1024u;
    const int aoff = lds_byte(wr * 64 + fr, fq * 8), boff = lds_byte(wc * 32 + fr, fq * 8);
#define PG8_SA(b, h) (((b) * 2 + (h)) * HTB)
#define PG8_SB(b, h) ((4 + (b) * 2 + (h)) * HTB)
#define PG8_STAGE(bufoff, gbase, voff) do { _Pragma("unroll") for (int _i = 0; _i < 2; ++_i) \
        __builtin_amdgcn_global_load_lds((const unsigned*)((const char*)(gbase) + (voff)[_i]), (PG8_LAS unsigned*)(lds + (bufoff) + ldsw + _i * 8192), 16, 0, 0); } while (0)
#define PG8_LDA(dst, b, h) do { _Pragma("unroll") for (int m = 0; m < 4; ++m) _Pragma("unroll") for (int k = 0; k < 2; ++k) dst[m][k] = *(const PG8_LAS bf16x8*)(lds + PG8_SA(b, h) + aoff + m * 2048 + k * 1024); } while (0)
#define PG8_LDB(dst, b, h) do { _Pragma("unroll") for (int n = 0; n < 2; ++n) _Pragma("unroll") for (int k = 0; k < 2; ++k) dst[n][k] = *(const PG8_LAS bf16x8*)(lds + PG8_SB(b, h) + boff + n * 2048 + k * 1024); } while (0)
#define PG8_MMA(ai, bj, At, Bt) do { __builtin_amdgcn_s_setprio(1); _Pragma("unroll") for (int m = 0; m < 4; ++m) _Pragma("unroll") for (int n = 0; n < 2; ++n) _Pragma("unroll") for (int k = 0; k < 2; ++k) \
        acc[ai][bj][m][n] = __builtin_amdgcn_mfma_f32_16x16x32_bf16(Bt[n][k], At[m][k], acc[ai][bj][m][n], 0, 0, 0); __builtin_amdgcn_s_setprio(0); } while (0)
#define PG8_WAIT_V(n) asm volatile("s_waitcnt vmcnt(" #n ")" ::: "memory")
#define PG8_WAIT_L(n) asm volatile("s_waitcnt lgkmcnt(" #n ")" ::: "memory")
#define PG8_BAR __builtin_amdgcn_s_barrier()
#define PG8_SCHED __builtin_amdgcn_sched_barrier(0)
    Unit cur, nxt; int ui = 0;
    if (!S.next(0, cur)) return;
    f32x4 acc[2][2][4][2];
#pragma unroll
    for (int a = 0; a < 2; ++a)
#pragma unroll
        for (int b = 0; b < 2; ++b)
#pragma unroll
            for (int m = 0; m < 4; ++m)
#pragma unroll
                for (int n = 0; n < 2; ++n) acc[a][b][m][n] = (f32x4){0.f, 0.f, 0.f, 0.f};
    bf16x8 At[4][2], B0[2][2], B1[2][2];
    const char* cA = (const char*)g.A + (size_t)cur.pm * tstep; const char* cB = (const char*)g.Bt + (size_t)cur.pn * tstep;
    S.a_ready(cur);
    if constexpr (SP2) {
        PG8_STAGE(PG8_SB(0, 0), cB, voffB); PG8_STAGE(PG8_SB(0, 1), cB + hstep, voffB); PG8_STAGE(PG8_SA(0, 0), cA, voffA); PG8_STAGE(PG8_SA(0, 1), cA + hstep, voffA);
        if (wr == 1) PG8_BAR;
        PG8_WAIT_V(2); PG8_BAR;
        PG8_STAGE(PG8_SB(1, 0), cB + kstep, voffB); PG8_STAGE(PG8_SA(1, 0), cA + kstep, voffA); PG8_STAGE(PG8_SB(1, 1), cB + hstep + kstep, voffB);
        PG8_WAIT_V(6); PG8_BAR;
    } else {
        PG8_STAGE(PG8_SB(0, 0), cB, voffB); PG8_STAGE(PG8_SA(0, 0), cA, voffA); PG8_STAGE(PG8_SB(0, 1), cB + hstep, voffB); PG8_STAGE(PG8_SA(0, 1), cA + hstep, voffA);
        if (wr == 1) PG8_BAR;
        PG8_WAIT_V(4); PG8_BAR;
        PG8_STAGE(PG8_SB(1, 0), cB + kstep, voffB); PG8_STAGE(PG8_SA(1, 0), cA + kstep, voffA); PG8_STAGE(PG8_SB(1, 1), cB + hstep + kstep, voffB);
        PG8_WAIT_V(6); PG8_BAR;
    }
    for (;;) {
        const bool has_next = S.next(ui + 1, nxt);
        const char* nA = has_next ? (const char*)g.A + (size_t)nxt.pm * tstep : cA; const char* nB = has_next ? (const char*)g.Bt + (size_t)nxt.pn * tstep : cB;
        for (int t = 0; t < nt; t += 2) {
            const bool last = (t == nt - 2);
            const char* a1 = cA + (size_t)(t + 1) * kstep;
            const char* a2 = last ? nA : cA + (size_t)(t + 2) * kstep; const char* b2 = last ? nB : cB + (size_t)(t + 2) * kstep;
            const char* a3 = a2 + kstep; const char* b3 = b2 + kstep;
            if (last && has_next) S.a_ready(nxt);
            if constexpr (SP2) {
            PG8_LDB(B0, 0, 0); PG8_LDB(B1, 0, 1); PG8_SCHED; PG8_LDA(At, 0, 0); PG8_STAGE(PG8_SA(1, 1), a1 + hstep, voffA);
            PG8_WAIT_V(8); PG8_WAIT_L(0); PG8_BAR; PG8_MMA(0, 0, At, B0); PG8_MMA(0, 1, At, B1); PG8_BAR; PG8_SCHED;
            PG8_LDA(At, 0, 1); PG8_STAGE(PG8_SB(0, 0), b2, voffB); PG8_STAGE(PG8_SB(0, 1), b2 + hstep, voffB); PG8_STAGE(PG8_SA(0, 0), a2, voffA);
            PG8_WAIT_V(8); PG8_WAIT_L(0); PG8_BAR; PG8_MMA(1, 0, At, B0); PG8_MMA(1, 1, At, B1); PG8_BAR; PG8_SCHED;
            PG8_LDB(B0, 1, 0); PG8_LDB(B1, 1, 1); PG8_SCHED; PG8_LDA(At, 1, 0); PG8_STAGE(PG8_SA(0, 1), a2 + hstep, voffA);
            PG8_WAIT_V(8); PG8_WAIT_L(0); PG8_BAR; PG8_MMA(0, 0, At, B0); PG8_MMA(0, 1, At, B1); PG8_BAR; PG8_SCHED;
            PG8_LDA(At, 1, 1); PG8_STAGE(PG8_SB(1, 0), b3, voffB); PG8_STAGE(PG8_SB(1, 1), b3 + hstep, voffB); PG8_STAGE(PG8_SA(1, 0), a3, voffA);
            PG8_WAIT_V(8); PG8_WAIT_L(0); PG8_BAR; PG8_MMA(1, 0, At, B0); PG8_MMA(1, 1, At, B1); PG8_BAR; PG8_SCHED;
            } else {
            PG8_LDB(B0, 0, 0); PG8_SCHED; PG8_LDA(At, 0, 0); PG8_STAGE(PG8_SA(1, 1), a1 + hstep, voffA);
            PG8_WAIT_L(8); PG8_BAR; PG8_WAIT_L(0); PG8_MMA(0, 0, At, B0); PG8_BAR; PG8_SCHED;
            PG8_LDB(B1, 0, 1); PG8_STAGE(PG8_SB(0, 0), b2, voffB);
            PG8_BAR; PG8_WAIT_L(0); PG8_MMA(0, 1, At, B1); PG8_BAR;
            PG8_LDA(At, 0, 1); PG8_STAGE(PG8_SA(0, 0), a2, voffA);
            PG8_BAR; PG8_WAIT_L(0); PG8_MMA(1, 0, At, B0); PG8_BAR; PG8_SCHED;
            PG8_STAGE(PG8_SB(0, 1), b2 + hstep, voffB);
            PG8_WAIT_V(6); PG8_BAR; PG8_MMA(1, 1, At, B1); PG8_BAR;
            PG8_LDB(B0, 1, 0); PG8_SCHED; PG8_LDA(At, 1, 0); PG8_STAGE(PG8_SA(0, 1), a2 + hstep, voffA);
            PG8_WAIT_L(8); PG8_BAR; PG8_WAIT_L(0); PG8_MMA(0, 0, At, B0); PG8_BAR; PG8_SCHED;
            PG8_LDB(B1, 1, 1); PG8_STAGE(PG8_SB(1, 0), b3, voffB);
            PG8_BAR; PG8_WAIT_L(0); PG8_MMA(0, 1, At, B1); PG8_BAR;
            PG8_LDA(At, 1, 1); PG8_STAGE(PG8_SA(1, 0), a3, voffA);
            PG8_BAR; PG8_WAIT_L(0); PG8_MMA(1, 0, At, B0); PG8_BAR; PG8_SCHED;
            PG8_STAGE(PG8_SB(1, 1), b3 + hstep, voffB);
            PG8_WAIT_V(6); PG8_BAR; PG8_MMA(1, 1, At, B1); PG8_BAR;
            }
        }
        if constexpr (ALIGN_EPI) { if (wr == 0) PG8_BAR; }
        if constexpr (!Epi::AFTER_DRAIN) { E(acc, cur, wr, wc, fr, fq); S.done(cur); }
        if (!has_next) break;
#pragma unroll
        for (int a = 0; a < 2; ++a)
#pragma unroll
            for (int b = 0; b < 2; ++b)
#pragma unroll
                for (int m = 0; m < 4; ++m)
#pragma unroll
                    for (int n = 0; n < 2; ++n) acc[a][b][m][n] = (f32x4){0.f, 0.f, 0.f, 0.f};
        cur = nxt; cA = nA; cB = nB; ++ui;
        if constexpr (ALIGN_EPI) { if (wr == 1) PG8_BAR; }
    }
    PG8_WAIT_V(0);
    if constexpr (!ALIGN_EPI) { if (wr == 0) PG8_BAR; }
    PG8_BAR;
    if constexpr (Epi::AFTER_DRAIN) { E.fused(acc, cur, wr, wc, fr, fq, lds, wid, lane); S.done(cur); }
#undef PG8_SA
#undef PG8_SB
#undef PG8_STAGE
#undef PG8_LDA
#undef PG8_LDB
#undef PG8_MMA
#undef PG8_WAIT_V
#undef PG8_WAIT_L
#undef PG8_BAR
#undef PG8_SCHED
}
}
constexpr int NWAVES = 8;
constexpr int BATCH = 4, SEQ = 2048, DM = 2048, DEPTH = 2;
constexpr int M = BATCH * SEQ;
constexpr int GW = 512;
constexpr int IN_COLS = 5648, IN_PAD = 5888;
constexpr int DFF = 5632, MEML = 256, XH = 4, XHD = 512;
constexpr int MROWS = BATCH * MEML;
constexpr float EPS = 1e-6f;
constexpr int UA_B = 0, UA_C = 512, UA_H = 1024, UB = 1536, UC_Q = 2048, UC_Z = 3584, UC_A = 4096, UC_B = 4100, UD_Z = 4104, UD_X = 4616, UD_DT = 5640;
constexpr int MIX_PRE = 0, MIX_POST = 1, XA_PRE = 2, XA_POST = 3, MEM_NORM = 4, FFN_PRE = 5, FFN_POST = 6, N_NORMS = 7;
enum { I_X = 0, I_MEM, I_NORMG, I_WIN, I_CONVA, I_POOLW, I_POOLS, I_GCONV, I_GALOG, I_GDTB, I_GNG, I_SCONVW, I_SCONVB, I_SALOG, I_SDTB, I_SD, I_SNG, I_WOUT, I_WQ, I_WKV, I_WO, I_WGU, I_WD, N_IN };

constexpr size_t MiB = 1u << 20;
constexpr size_t WS_CTL = 0, CTL_ZERO_BYTES = 1 * MiB;
constexpr size_t WSZ_WIN = (size_t)IN_PAD * DM * 2, WSZ_SQ = (size_t)DM * DM * 2, WSZ_KV = (size_t)2 * DM * DM * 2, WSZ_GU = (size_t)2 * DFF * DM * 2, WSZ_D = (size_t)DM * DFF * 2;
constexpr size_t WO_WIN = 0, WO_WOUT = WO_WIN + WSZ_WIN, WO_WQ = WO_WOUT + WSZ_SQ, WO_WKV = WO_WQ + WSZ_SQ, WO_WO = WO_WKV + WSZ_KV, WO_WGU = WO_WO + WSZ_SQ, WO_WD = WO_WGU + WSZ_GU, W_LAYER = WO_WD + WSZ_D;
constexpr size_t WS_W = 1 * MiB;
constexpr size_t WS_XN = WS_W + 2 * W_LAYER;
constexpr size_t WS_MIX = WS_XN + (size_t)M * DM * 2;
constexpr size_t WS_MEMN = WS_MIX + (size_t)M * DM * 2;
constexpr size_t WS_KB = WS_MEMN + (size_t)2 * MROWS * DM * 2;
constexpr size_t WS_VT = WS_KB + (size_t)2 * MROWS * DM * 2;
constexpr size_t WS_U = WS_VT + (size_t)2 * MROWS * DM * 2;
constexpr size_t WS_Q = WS_U, WS_HID = WS_U + (size_t)M * DM * 2;
constexpr size_t WS_SCR = WS_U + (size_t)M * IN_PAD * 4;
constexpr size_t WS_Y = WS_SCR;
constexpr size_t SZ512 = (size_t)M * 512 * 4, SZ256 = (size_t)M * 256 * 4, SZ8 = (size_t)M * 8 * 4;
constexpr size_t WS_QN = WS_SCR, WS_KN = WS_QN + SZ512, WS_VV = WS_KN + SZ512, WS_OG = WS_VV + SZ512, WS_XS = WS_OG + SZ512, WS_YS = WS_XS + SZ512,
                 WS_BS = WS_YS + SZ512, WS_CS = WS_BS + SZ256, WS_GB = WS_CS + SZ256, WS_DT = WS_GB + SZ8, WS_END = WS_DT + 2 * SZ8;
static_assert(WS_Y + (size_t)M * DM * 4 <= WS_END, "Y inside the scan region");
static_assert(WS_HID + (size_t)M * DFF * 2 <= WS_SCR, "HID inside U");
static_assert(WS_END <= (size_t)704 * MiB, "d_ws map fits 4 x the largest input");

constexpr int RING_OFF = 0, RING_BYTES = 131072;
constexpr int LDSCTL_OFF = RING_BYTES, MISC_OFF = LDSCTL_OFF + 320;
constexpr int LDS_BYTES = 147456;
constexpr int CW_BAR = 4096;

#define GAS __attribute__((address_space(1)))
#define LAS __attribute__((address_space(3)))
typedef unsigned short bf16;
typedef unsigned v4u __attribute__((ext_vector_type(4)));
typedef unsigned v2u __attribute__((ext_vector_type(2)));
typedef float f32x4 __attribute__((ext_vector_type(4)));
typedef short bf16x8 __attribute__((ext_vector_type(8)));
#define LDS_WAIT() asm volatile("s_waitcnt lgkmcnt(0)" ::: "memory")
#define VM_WAIT() asm volatile("s_waitcnt vmcnt(0)" ::: "memory")
__device__ __forceinline__ unsigned f2bf(float f) { unsigned u = __builtin_bit_cast(unsigned, f); return (u + 0x7fffu + ((u >> 16) & 1u)) >> 16; }
__device__ __forceinline__ unsigned pk2(float lo, float hi) { return f2bf(lo) | (f2bf(hi) << 16); }
__device__ __forceinline__ float siluf(float v) { return v / (1.0f + __expf(-v)); }
__device__ __forceinline__ float softplusf(float v) { return fmaxf(v, 0.f) + log1pf(__expf(-fabsf(v))); }
__device__ __forceinline__ float sigmoidf(float v) { return 1.0f / (1.0f + __expf(-v)); }
template <int CTRL> __device__ __forceinline__ float dppf(float v) { return __builtin_bit_cast(float, __builtin_amdgcn_update_dpp(0, __builtin_bit_cast(int, v), CTRL, 0xF, 0xF, true)); }
__device__ __forceinline__ float row16_sum(float v) { v += dppf<0xB1>(v); v += dppf<0x4E>(v); v += dppf<0x141>(v); v += dppf<0x140>(v); return v; }
__device__ __forceinline__ int opq(int v) { asm volatile("" : "+v"(v)); return v; }
__device__ __forceinline__ float wave_sum(float v) {
#pragma unroll
    for (int o = 1; o < 64; o <<= 1) v += __shfl_xor(v, o);
    return v;
}

#define XB_TMO      128
#define XB_XCNT(j)  (256  + 64 * (j))
#define XB_XSUB(j)  (1280 + 64 * (j))
#define XB_XGEN(j)  (2304 + 64 * (j))
#define XB_TOP      3328
#define XB_TOPGEN   3392
#define XCD_BAR_WORDS 3456
#define XB_SPIN_CAP (1u << 18)

__device__ __forceinline__ unsigned xb_ld(unsigned* p)              { return __hip_atomic_load(p, __ATOMIC_RELAXED, __HIP_MEMORY_SCOPE_AGENT); }
__device__ __forceinline__ unsigned xb_add(unsigned* p, unsigned v) { return __hip_atomic_fetch_add(p, v, __ATOMIC_RELAXED, __HIP_MEMORY_SCOPE_AGENT); }
__device__ __forceinline__ unsigned xb_xcc_id() { return (unsigned)__builtin_amdgcn_s_getreg((3 << 11) | 20) & 0xFu; }
#define XB_SPIN(cond, bar) do { unsigned _sp = 0; while (cond) { __builtin_amdgcn_s_sleep(1); \
    if ((++_sp & 255u) == 0u) { if (xb_ld(&(bar)[XB_TMO])) break; if (_sp > XB_SPIN_CAP) { atomicAdd(&(bar)[XB_TMO], 1u); break; } } } } while (0)

struct XcdBarrier {
    unsigned* bar; unsigned x;
    volatile LAS unsigned* st;
};

__device__ __forceinline__ XcdBarrier xcd_barrier_post(unsigned* bar, volatile LAS unsigned* st) {
    XcdBarrier b; b.bar = bar; b.x = xb_xcc_id(); b.st = st;
    if (threadIdx.x == 0) (void)xb_add(&bar[XB_XCNT(b.x)], 1u);
    return b;
}
__device__ __forceinline__ void xcd_barrier_complete(unsigned* bar, unsigned x, unsigned& nloc, unsigned& nx) {
    const unsigned G = gridDim.x * gridDim.y * gridDim.z;
    unsigned sum, cnt, mine, sp = 0u;
    for (;;) {
        sum = 0u; cnt = 0u; mine = 0u;
#pragma unroll
        for (unsigned j = 0; j < 16; ++j) { const unsigned c = xb_ld(&bar[XB_XCNT(j)]); sum += c; cnt += (c > 0u) ? 1u : 0u; mine = (j == x) ? c : mine; }
        if (sum == G) break;
        __builtin_amdgcn_s_sleep(1);
        if ((++sp & 255u) == 0u) { if (xb_ld(&bar[XB_TMO])) break; if (sp > XB_SPIN_CAP) { atomicAdd(&bar[XB_TMO], 1u); break; } }
    }
    nloc = mine > 0u ? mine : 1u; nx = cnt > 0u ? cnt : 1u;
}

__device__ __forceinline__ void xcd_barrier(const XcdBarrier& b) {
    asm volatile("s_waitcnt vmcnt(0)" ::: "memory");
    __syncthreads();
    if (threadIdx.x == 0) {
        unsigned* bar = b.bar;
        __builtin_amdgcn_s_waitcnt(0);
        unsigned nloc = b.st[0], nx = b.st[1];
        if (nloc == 0u) { xcd_barrier_complete(bar, b.x, nloc, nx); b.st[0] = nloc; b.st[1] = nx; }
        const unsigned old = xb_add(&bar[XB_XSUB(b.x)], 1u);
        const unsigned gen = old / nloc;
        if (old + 1u == (gen + 1u) * nloc) {
            __builtin_amdgcn_fence(__ATOMIC_RELEASE, "agent");
            asm volatile("s_waitcnt vmcnt(0)" ::: "memory");
            const unsigned og = xb_add(&bar[XB_TOP], 1u);
            const unsigned tg = og / nx;
            if (og + 1u == (tg + 1u) * nx) xb_add(&bar[XB_TOPGEN], 1u);
            else XB_SPIN(xb_ld(&bar[XB_TOPGEN]) == tg, bar);
            __builtin_amdgcn_fence(__ATOMIC_ACQUIRE, "agent");
            xb_add(&bar[XB_XGEN(b.x)], 1u);
            asm volatile("s_waitcnt vmcnt(0)" ::: "memory");
        } else {
            XB_SPIN(xb_ld(&bar[XB_XGEN(b.x)]) == gen, bar);
            __builtin_amdgcn_fence(__ATOMIC_ACQUIRE, "agent");
            asm volatile("s_waitcnt vmcnt(0)" ::: "memory");
        }
    }
    __syncthreads();
}
struct Frame {
    LAS unsigned char* lds;
    volatile LAS unsigned* MISC;
    unsigned* ctl;
    int tid, lane, wave;
    int vcu, G;
    float* out; unsigned char* ws;
};
__device__ __forceinline__ const float* inp(int i) { const float* __attribute__((address_space(4))) const* tab = (const float* __attribute__((address_space(4))) const*)__builtin_amdgcn_kernarg_segment_ptr(); asm volatile("" : "+s"(tab)); return tab[i]; }
__device__ __forceinline__ bf16* wsb(const Frame& F, size_t off) { return (bf16*)(F.ws + off); }
__device__ __forceinline__ float* wsf(const Frame& F, size_t off) { return (float*)(F.ws + off); }

__device__ __forceinline__ void p0_transpose_item(const float* W, int K, int N, bf16* WT, int drow0, int k0, int n0, LAS float* scr, int lane) {
    const int nn = n0 + (lane & 31); const bool ok = nn < N;
#pragma unroll 8
    for (int i = 0; i < 32; ++i) { const int kk = 2 * i + (lane >> 5); scr[kk * 33 + (lane & 31)] = ok ? W[(size_t)(k0 + kk) * N + nn] : 0.f; }
    LDS_WAIT(); asm volatile("" ::: "memory");
    const int c = lane & 7;
#pragma unroll
    for (int j = 0; j < 4; ++j) { const int n = (lane >> 3) + 8 * j; const LAS float* s = scr + (8 * c) * 33 + n;
        v4u o; o.x = pk2(s[0 * 33], s[1 * 33]); o.y = pk2(s[2 * 33], s[3 * 33]); o.z = pk2(s[4 * 33], s[5 * 33]); o.w = pk2(s[6 * 33], s[7 * 33]);
        *(v4u*)(WT + (size_t)(drow0 + n) * K + k0 + 8 * c) = o; }
    LDS_WAIT(); asm volatile("" ::: "memory");
}
__device__ __forceinline__ void norm_row_to_bf16(const float* xrow, const float* g, bf16* orow, int lane) {
    const f32x4* xr = (const f32x4*)xrow + lane; const f32x4* gr = (const f32x4*)g + lane;
    f32x4 v[8]; float s = 0.f;
#pragma unroll
    for (int j = 0; j < 8; ++j) { v[j] = xr[64 * j]; s += (v[j].x * v[j].x + v[j].y * v[j].y) + (v[j].z * v[j].z + v[j].w * v[j].w); }
    const float rstd = 1.0f / sqrtf(wave_sum(s) * (1.0f / DM) + EPS);
    v2u* o8 = (v2u*)orow + lane;
#pragma unroll
    for (int j = 0; j < 8; ++j) { const f32x4 gg = gr[64 * j]; v2u w; w.x = pk2(v[j].x * rstd * gg.x, v[j].y * rstd * gg.y); w.y = pk2(v[j].z * rstd * gg.z, v[j].w * rstd * gg.w); o8[64 * j] = w; }
}
__device__ __forceinline__ void p0_prologue(Frame& F) {
    LAS float* scr = (LAS float*)(F.lds + RING_OFF + F.wave * 16384);
    const int gw = F.vcu * NWAVES + F.wave, NGW = F.G * NWAVES; const int lane = opq(F.lane), tid = opq(F.tid);
    constexpr int NB_IN = (IN_COLS + 31) / 32;
    constexpr int I_IN = (DM / 64) * NB_IN, I_SQ = (DM / 64) * (DM / 32), I_KV = (DM / 64) * (2 * DM / 32), I_GU = (DM / 64) * (2 * DFF / 32), I_D = (DFF / 64) * (DM / 32);
    constexpr int I_LAYER = I_IN + 3 * I_SQ + I_KV + I_GU + I_D;
    for (int it = gw; it < DEPTH * I_LAYER; it += NGW) {
        const int l = it / I_LAYER; int r = it % I_LAYER;
        bf16* wl = wsb(F, WS_W + (size_t)l * W_LAYER);
        if (r < I_IN) { const int kb = r / NB_IN, nb = r % NB_IN; p0_transpose_item(inp(I_WIN) + (size_t)l * DM * IN_COLS, DM, IN_COLS, (bf16*)((char*)wl + WO_WIN), 32 * nb, 64 * kb, 32 * nb, scr, lane); continue; } r -= I_IN;
        if (r < I_SQ) { const int kb = r / (DM / 32), nb = r % (DM / 32); p0_transpose_item(inp(I_WOUT) + (size_t)l * DM * DM, DM, DM, (bf16*)((char*)wl + WO_WOUT), 32 * nb, 64 * kb, 32 * nb, scr, lane); continue; } r -= I_SQ;
        if (r < I_SQ) { const int kb = r / (DM / 32), nb = r % (DM / 32); p0_transpose_item(inp(I_WQ) + (size_t)l * DM * DM, DM, DM, (bf16*)((char*)wl + WO_WQ), 32 * nb, 64 * kb, 32 * nb, scr, lane); continue; } r -= I_SQ;
        if (r < I_SQ) { const int kb = r / (DM / 32), nb = r % (DM / 32); p0_transpose_item(inp(I_WO) + (size_t)l * DM * DM, DM, DM, (bf16*)((char*)wl + WO_WO), 32 * nb, 64 * kb, 32 * nb, scr, lane); continue; } r -= I_SQ;
        if (r < I_KV) { const int kb = r / (2 * DM / 32), nb = r % (2 * DM / 32); p0_transpose_item(inp(I_WKV) + (size_t)l * DM * 2 * DM, DM, 2 * DM, (bf16*)((char*)wl + WO_WKV), 32 * nb, 64 * kb, 32 * nb, scr, lane); continue; } r -= I_KV;
        if (r < I_GU) { const int kb = r / (2 * DFF / 32), nb = r % (2 * DFF / 32); const int n0 = 32 * nb; const int up = n0 >= DFF ? 1 : 0, j0 = n0 - up * DFF;
            const int drow = (j0 >> 7) * 256 + up * 128 + (j0 & 127);
            p0_transpose_item(inp(I_WGU) + (size_t)l * DM * 2 * DFF, DM, 2 * DFF, (bf16*)((char*)wl + WO_WGU), drow, 64 * kb, n0, scr, lane); continue; } r -= I_GU;
        { const int kb = r / (DM / 32), nb = r % (DM / 32); p0_transpose_item(inp(I_WD) + (size_t)l * DFF * DM, DFF, DM, (bf16*)((char*)wl + WO_WD), 32 * nb, 64 * kb, 32 * nb, scr, lane); }
    }
    { constexpr int ZR0 = 32 * NB_IN, ZN = (IN_PAD - ZR0) * DM / 8;
      for (int i = (F.vcu * NWAVES * 64) + tid; i < DEPTH * ZN; i += F.G * NWAVES * 64) { const int l = i / ZN, k = i % ZN;
          ((v4u*)(F.ws + WS_W + (size_t)l * W_LAYER + WO_WIN + (size_t)ZR0 * DM * 2))[k] = (v4u){0u, 0u, 0u, 0u}; } }
    for (int m = gw; m < DEPTH * MROWS; m += NGW) { const int l = m / MROWS, r = m % MROWS;
        norm_row_to_bf16(inp(I_MEM) + (size_t)r * DM, inp(I_NORMG) + (size_t)(l * N_NORMS + MEM_NORM) * DM, wsb(F, WS_MEMN) + (size_t)m * DM, lane); }
    for (int m = gw; m < M; m += NGW) norm_row_to_bf16(inp(I_X) + (size_t)m * DM, inp(I_NORMG) + (size_t)(0 * N_NORMS + MIX_PRE) * DM, wsb(F, WS_XN) + (size_t)m * DM, lane);
}

__device__ __forceinline__ void resnorm_phase(Frame& F, const float* xin, const float* gpost, const float* gpre  ) {
    const int gw = F.vcu * NWAVES + F.wave, NGW = F.G * NWAVES, lane = opq(F.lane);
    const float* Y = wsf(F, WS_Y); bf16* XN = wsb(F, WS_XN);
    for (int m = gw; m < M; m += NGW) {
        const f32x4* yr = (const f32x4*)(Y + (size_t)m * DM) + lane; const f32x4* xr = (const f32x4*)(xin + (size_t)m * DM) + lane;
        f32x4* xo = (f32x4*)(F.out + (size_t)m * DM) + lane;
        f32x4 y[8], x[8]; float s = 0.f;
#pragma unroll
        for (int j = 0; j < 8; ++j) { y[j] = yr[64 * j]; x[j] = xr[64 * j]; s += (y[j].x * y[j].x + y[j].y * y[j].y) + (y[j].z * y[j].z + y[j].w * y[j].w); }
        const float rstd = 1.0f / sqrtf(wave_sum(s) * (1.0f / DM) + EPS);
        float s2 = 0.f;
#pragma unroll
        for (int j = 0; j < 8; ++j) { const f32x4 gg = ((const f32x4*)gpost)[lane + 64 * j]; x[j] = x[j] + y[j] * rstd * gg; xo[64 * j] = x[j];
            s2 += (x[j].x * x[j].x + x[j].y * x[j].y) + (x[j].z * x[j].z + x[j].w * x[j].w); }
        if (gpre) {
            const float r2 = 1.0f / sqrtf(wave_sum(s2) * (1.0f / DM) + EPS);
            v2u* o8 = (v2u*)(XN + (size_t)m * DM) + lane;
#pragma unroll
            for (int j = 0; j < 8; ++j) { const f32x4 gg = ((const f32x4*)gpre)[lane + 64 * j]; v2u w; w.x = pk2(x[j].x * r2 * gg.x, x[j].y * r2 * gg.y); w.y = pk2(x[j].z * r2 * gg.z, x[j].w * r2 * gg.w); o8[64 * j] = w; }
        }
    }
}

__device__ __forceinline__ f32x4 ld4(const float* p) { return *(const f32x4*)p; }
__device__ __forceinline__ f32x4 silu4(f32x4 v) { return (f32x4){siluf(v.x), siluf(v.y), siluf(v.z), siluf(v.w)}; }
__device__ __forceinline__ void mixer_prep_phase(Frame& F, int l) {
    const int gw = F.vcu * NWAVES + F.wave, NGW = F.G * NWAVES, lane = opq(F.lane), tid = opq(F.tid);
    const float* U = wsf(F, WS_U);
    bf16* MIX = wsb(F, WS_MIX);
    constexpr int NSTRIP = M / 16;
    for (int it = gw; it < 16 * NSTRIP; it += NGW) {
        const int type = it & 15, strip = it >> 4, r0 = strip * 16, pos0 = r0 & (SEQ - 1);
        if (type < 2) {
            const int c = type * 256 + lane * 4;
            const float* cw = inp(I_CONVA) + (size_t)l * 3 * GW + c;
            const f32x4 w0 = ld4(cw), w1 = ld4(cw + GW), w2 = ld4(cw + 2 * GW);
            f32x4 p2 = (f32x4){0.f, 0.f, 0.f, 0.f}, p1 = p2;
            if (pos0 >= 2) { const float* u2 = U + (size_t)(r0 - 2) * IN_PAD; const float* u1 = U + (size_t)(r0 - 1) * IN_PAD;
                p2 = ld4(u2 + UA_C + c) * ld4(u2 + UA_H + c); p1 = ld4(u1 + UA_C + c) * ld4(u1 + UA_H + c); }
#pragma unroll 4
            for (int i = 0; i < 16; ++i) { const float* ur = U + (size_t)(r0 + i) * IN_PAD;
                const f32x4 p0 = ld4(ur + UA_C + c) * ld4(ur + UA_H + c);
                const f32x4 y = ld4(ur + UA_B + c) * (w0 * p2 + w1 * p1 + w2 * p0);
                v2u o; o.x = pk2(y.x, y.y); o.y = pk2(y.z, y.w); *(v2u*)(MIX + (size_t)(r0 + i) * DM + c) = o;
                p2 = p1; p1 = p0; }
        } else if (type < 8) {
            const int gi = type - 2, c = gi * 256 + lane * 4;
            const float* cw = inp(I_GCONV) + (size_t)l * 4 * 3 * GW + c;
            const f32x4 w0 = ld4(cw), w1 = ld4(cw + 3 * GW), w2 = ld4(cw + 6 * GW), w3 = ld4(cw + 9 * GW);
            f32x4 x3 = (f32x4){0.f, 0.f, 0.f, 0.f}, x2 = x3, x1 = x3;
            if (pos0 >= 3) { x3 = ld4(U + (size_t)(r0 - 3) * IN_PAD + UC_Q + c); x2 = ld4(U + (size_t)(r0 - 2) * IN_PAD + UC_Q + c); x1 = ld4(U + (size_t)(r0 - 1) * IN_PAD + UC_Q + c); }
            float* dst = (gi < 2) ? wsf(F, WS_QN) + gi * 256 : (gi < 4) ? wsf(F, WS_KN) + (gi - 2) * 256 : wsf(F, WS_VV) + (gi - 4) * 256;
            const float qs = (gi < 2) ? 0.08838834764831845f : 1.0f;
#pragma unroll 4
            for (int i = 0; i < 16; ++i) { const f32x4 x0 = ld4(U + (size_t)(r0 + i) * IN_PAD + UC_Q + c);
                f32x4 y = silu4(w0 * x3 + w1 * x2 + w2 * x1 + w3 * x0);
                if (gi < 4) { float ss = (y.x * y.x + y.y * y.y) + (y.z * y.z + y.w * y.w);
                    ss += __shfl_xor(ss, 1); ss += __shfl_xor(ss, 2); ss += __shfl_xor(ss, 4); ss += __shfl_xor(ss, 8); ss += __shfl_xor(ss, 16);
                    y = y * (qs / sqrtf(ss + EPS)); }
                *(f32x4*)(dst + (size_t)(r0 + i) * GW + lane * 4) = y;
                x3 = x2; x2 = x1; x1 = x0; }
        } else if (type < 12) {
            const int gi = type - 8, c = gi * 256 + lane * 4;
            const float* cw = inp(I_SCONVW) + (size_t)l * 4 * 1024 + c;
            const f32x4 w0 = ld4(cw), w1 = ld4(cw + 1024), w2 = ld4(cw + 2048), w3 = ld4(cw + 3072), bb = ld4(inp(I_SCONVB) + (size_t)l * 1024 + c);
            f32x4 x3 = (f32x4){0.f, 0.f, 0.f, 0.f}, x2 = x3, x1 = x3;
            if (pos0 >= 3) { x3 = ld4(U + (size_t)(r0 - 3) * IN_PAD + UD_X + c); x2 = ld4(U + (size_t)(r0 - 2) * IN_PAD + UD_X + c); x1 = ld4(U + (size_t)(r0 - 1) * IN_PAD + UD_X + c); }
            float* dst; int ld;
            if (gi < 2) { dst = wsf(F, WS_XS) + gi * 256; ld = 512; } else if (gi == 2) { dst = wsf(F, WS_BS); ld = 256; } else { dst = wsf(F, WS_CS); ld = 256; }
#pragma unroll 4
            for (int i = 0; i < 16; ++i) { const f32x4 x0 = ld4(U + (size_t)(r0 + i) * IN_PAD + UD_X + c);
                const f32x4 y = silu4(w0 * x3 + w1 * x2 + w2 * x1 + w3 * x0 + bb);
                *(f32x4*)(dst + (size_t)(r0 + i) * ld + lane * 4) = y;
                x3 = x2; x2 = x1; x1 = x0; }
        } else {
            const int gi = type - 12, w = 2 << gi;
            LAS float* scr = (LAS float*)(F.lds + RING_OFF + F.wave * 16384);
            const int c0 = UB + gi * 128 + lane * 2;
            float r0s = 0.f, r1s = 0.f;
            if (pos0 > 0) { for (int s = 1; s < w; ++s) { const float* up = U + (size_t)(r0 - s) * IN_PAD + c0; r0s += up[0]; r1s += up[1]; } }
            for (int i = 0; i < 16; ++i) { const int pos = pos0 + i; const float* ur = U + (size_t)(r0 + i) * IN_PAD + c0;
                const float a0 = ur[0], a1 = ur[1];
                r0s += a0; r1s += a1;
                const float cnt = (float)((pos + 1 < w) ? pos + 1 : w);
                scr[i * 128 + lane * 2] = r0s / cnt - a0; scr[i * 128 + lane * 2 + 1] = r1s / cnt - a1;
                if (pos - w + 1 >= 0) { const float* ud = U + (size_t)(r0 + i - w + 1) * IN_PAD + c0; r0s -= ud[0]; r1s -= ud[1]; } }
            LDS_WAIT(); asm volatile("" ::: "memory");
            float acc0[16], acc1[16];
#pragma unroll
            for (int i = 0; i < 16; ++i) { acc0[i] = 0.f; acc1[i] = 0.f; }
            const float* pw = inp(I_POOLW) + ((size_t)l * 4 + gi) * 128 * 128;
            for (int cc = 0; cc < 128; cc += 4) {
                float wa[4], wb[4];
#pragma unroll
                for (int q = 0; q < 4; ++q) { wa[q] = pw[(size_t)(cc + q) * 128 + lane]; wb[q] = pw[(size_t)(cc + q) * 128 + 64 + lane]; }
#pragma unroll
                for (int i = 0; i < 16; ++i) { const f32x4 p = *(const LAS f32x4*)(scr + i * 128 + cc);
                    acc0[i] += p.x * wa[0] + p.y * wa[1] + p.z * wa[2] + p.w * wa[3]; acc1[i] += p.x * wb[0] + p.y * wb[1] + p.z * wb[2] + p.w * wb[3]; }
            }
            const float s0 = inp(I_POOLS)[(size_t)l * GW + gi * 128 + lane], s1 = inp(I_POOLS)[(size_t)l * GW + gi * 128 + 64 + lane];
#pragma unroll
            for (int i = 0; i < 16; ++i) { bf16* o = MIX + (size_t)(r0 + i) * DM + GW + gi * 128; o[lane] = (bf16)f2bf(acc0[i] * s0); o[64 + lane] = (bf16)f2bf(acc1[i] * s1); }
            LDS_WAIT(); asm volatile("" ::: "memory");
        }
    }
    for (int i = (F.vcu * NWAVES * 64) + tid; i < M * 16; i += F.G * NWAVES * 64) { const int t = i >> 4, j = i & 15; const float* ur = U + (size_t)t * IN_PAD;
        if (j < 4) { wsf(F, WS_GB)[(size_t)t * 8 + 2 * j] = __expf(-__expf(inp(I_GALOG)[l * 4 + j]) * softplusf(ur[UC_A + j] + inp(I_GDTB)[l * 4 + j])); }
        else if (j < 8) { wsf(F, WS_GB)[(size_t)t * 8 + 2 * (j - 4) + 1] = sigmoidf(ur[UC_B + (j - 4)]); }
        else { const int hh = j - 8; const float dt = softplusf(ur[UD_DT + hh] + inp(I_SDTB)[l * 8 + hh]);
            wsf(F, WS_DT)[(size_t)t * 16 + 2 * hh] = __expf(-__expf(inp(I_SALOG)[l * 8 + hh]) * dt); wsf(F, WS_DT)[(size_t)t * 16 + 2 * hh + 1] = dt; } }
}

typedef float f32x2v __attribute__((ext_vector_type(2)));
constexpr int SCAN_PD = 4;
__device__ __forceinline__ void scan_phase(Frame& F, int l) {
    const int lane = opq(F.lane), sub = lane & 15, grp = lane >> 4;
    if (F.wave >= 4) return;
    for (int item = F.vcu * 4 + F.wave; item < 1024; item += F.G * 4) {
    if (item < 512) {
        const int b = item >> 7, h = (item >> 5) & 3, j = (item & 31) * 4 + grp;
        const float* KN = wsf(F, WS_KN) + (size_t)b * SEQ * GW + h * 128 + sub * 8;
        const float* QN = wsf(F, WS_QN) + (size_t)b * SEQ * GW + h * 128 + sub * 8;
        const float* VV = wsf(F, WS_VV) + (size_t)b * SEQ * GW + h * 128 + j;
        const float* GB = wsf(F, WS_GB) + (size_t)b * SEQ * 8 + 2 * h;
        float* OG = wsf(F, WS_OG) + (size_t)b * SEQ * GW + h * 128 + j;
        float S[8];
#pragma unroll
        for (int i = 0; i < 8; ++i) S[i] = 0.f;
        f32x4 rka[SCAN_PD], rkb[SCAN_PD], rqa[SCAN_PD], rqb[SCAN_PD]; float rv[SCAN_PD]; f32x2v rg[SCAN_PD];
#pragma unroll
        for (int u = 0; u < SCAN_PD; ++u) { rka[u] = ld4(KN + (size_t)u * GW); rkb[u] = ld4(KN + (size_t)u * GW + 4); rqa[u] = ld4(QN + (size_t)u * GW); rqb[u] = ld4(QN + (size_t)u * GW + 4);
            rv[u] = VV[(size_t)u * GW]; rg[u] = *(const f32x2v*)(GB + (size_t)u * 8); }
        for (int t0 = 0; t0 < SEQ; t0 += SCAN_PD) {
#pragma unroll
            for (int u = 0; u < SCAN_PD; ++u) {
                const f32x4 ka = rka[u], kb = rkb[u], qa = rqa[u], qb = rqb[u]; const float v = rv[u], eg = rg[u].x, be = rg[u].y;
                const int tn = (t0 + u + SCAN_PD < SEQ) ? t0 + u + SCAN_PD : SEQ - 1;
                rka[u] = ld4(KN + (size_t)tn * GW); rkb[u] = ld4(KN + (size_t)tn * GW + 4); rqa[u] = ld4(QN + (size_t)tn * GW); rqb[u] = ld4(QN + (size_t)tn * GW + 4);
                rv[u] = VV[(size_t)tn * GW]; rg[u] = *(const f32x2v*)(GB + (size_t)tn * 8);
                const float k[8] = {ka.x, ka.y, ka.z, ka.w, kb.x, kb.y, kb.z, kb.w}, q[8] = {qa.x, qa.y, qa.z, qa.w, qb.x, qb.y, qb.z, qb.w};
                float ks0 = 0.f, ks1 = 0.f, qs0 = 0.f, qs1 = 0.f, qk0 = 0.f, qk1 = 0.f;
#pragma unroll
                for (int i = 0; i < 4; ++i) { ks0 += k[i] * S[i]; ks1 += k[i + 4] * S[i + 4]; qs0 += q[i] * S[i]; qs1 += q[i + 4] * S[i + 4]; qk0 += q[i] * k[i]; qk1 += q[i + 4] * k[i + 4]; }
                const float ks = row16_sum(ks0 + ks1), qs = row16_sum(qs0 + qs1), qk = row16_sum(qk0 + qk1);
                const float delta = be * (v - eg * ks);
#pragma unroll
                for (int i = 0; i < 8; ++i) S[i] = eg * S[i] + k[i] * delta;
                if (sub == 0) OG[(size_t)(t0 + u) * GW] = eg * qs + qk * delta;
            }
        }
    } else {
        const int it2 = item - 512, b = it2 >> 7, hh = (it2 >> 4) & 7, p = (it2 & 15) * 4 + grp, gq = hh >> 2;
        const float* BS = wsf(F, WS_BS) + (size_t)b * SEQ * 256 + gq * 128 + sub * 8;
        const float* CS = wsf(F, WS_CS) + (size_t)b * SEQ * 256 + gq * 128 + sub * 8;
        const float* XS = wsf(F, WS_XS) + (size_t)b * SEQ * GW + hh * 64 + p;
        const float* DT = wsf(F, WS_DT) + (size_t)b * SEQ * 16 + 2 * hh;
        float* YS = wsf(F, WS_YS) + (size_t)b * SEQ * GW + hh * 64 + p;
        const float Dk = inp(I_SD)[l * 8 + hh];
        float hs[8];
#pragma unroll
        for (int i = 0; i < 8; ++i) hs[i] = 0.f;
        f32x4 rba[SCAN_PD], rbb[SCAN_PD], rca[SCAN_PD], rcb[SCAN_PD]; float rx[SCAN_PD]; f32x2v rd[SCAN_PD];
#pragma unroll
        for (int u = 0; u < SCAN_PD; ++u) { rba[u] = ld4(BS + (size_t)u * 256); rbb[u] = ld4(BS + (size_t)u * 256 + 4); rca[u] = ld4(CS + (size_t)u * 256); rcb[u] = ld4(CS + (size_t)u * 256 + 4);
            rx[u] = XS[(size_t)u * GW]; rd[u] = *(const f32x2v*)(DT + (size_t)u * 16); }
        for (int t0 = 0; t0 < SEQ; t0 += SCAN_PD) {
#pragma unroll
            for (int u = 0; u < SCAN_PD; ++u) {
                const f32x4 ba = rba[u], bb = rbb[u], ca = rca[u], cb = rcb[u]; const float x = rx[u], dA = rd[u].x, dt = rd[u].y;
                const int tn = (t0 + u + SCAN_PD < SEQ) ? t0 + u + SCAN_PD : SEQ - 1;
                rba[u] = ld4(BS + (size_t)tn * 256); rbb[u] = ld4(BS + (size_t)tn * 256 + 4); rca[u] = ld4(CS + (size_t)tn * 256); rcb[u] = ld4(CS + (size_t)tn * 256 + 4);
                rx[u] = XS[(size_t)tn * GW]; rd[u] = *(const f32x2v*)(DT + (size_t)tn * 16);
                const float Bv[8] = {ba.x, ba.y, ba.z, ba.w, bb.x, bb.y, bb.z, bb.w}, Cv[8] = {ca.x, ca.y, ca.z, ca.w, cb.x, cb.y, cb.z, cb.w};
                const float xd = x * dt;
                float y0 = 0.f, y1 = 0.f;
#pragma unroll
                for (int i = 0; i < 4; ++i) { hs[i] = dA * hs[i] + xd * Bv[i]; hs[i + 4] = dA * hs[i + 4] + xd * Bv[i + 4]; y0 += hs[i] * Cv[i]; y1 += hs[i + 4] * Cv[i + 4]; }
                const float y = row16_sum(y0 + y1);
                if (sub == 0) YS[(size_t)(t0 + u) * GW] = y + Dk * x;
            }
        }
    }
    }
}

__device__ __forceinline__ void mixer_post_phase(Frame& F, int l) {
    const int gw = F.vcu * NWAVES + F.wave, NGW = F.G * NWAVES, lane = opq(F.lane), c = lane * 8;
    const float* U = wsf(F, WS_U); bf16* MIX = wsb(F, WS_MIX);
    const float* gng = inp(I_GNG) + (size_t)l * 128 + (c & 127); const float* sng = inp(I_SNG) + (size_t)l * GW + c;
    const f32x4 g0 = ld4(gng), g1 = ld4(gng + 4), n0 = ld4(sng), n1 = ld4(sng + 4);
    for (int m = gw; m < M; m += NGW) {
        {
            const float* og = wsf(F, WS_OG) + (size_t)m * GW + c; const float* z = U + (size_t)m * IN_PAD + UC_Z + c;
            const f32x4 o0 = ld4(og), o1 = ld4(og + 4), z0 = ld4(z), z1 = ld4(z + 4);
            float ss = (o0.x * o0.x + o0.y * o0.y) + (o0.z * o0.z + o0.w * o0.w) + (o1.x * o1.x + o1.y * o1.y) + (o1.z * o1.z + o1.w * o1.w);
            ss += __shfl_xor(ss, 1); ss += __shfl_xor(ss, 2); ss += __shfl_xor(ss, 4); ss += __shfl_xor(ss, 8);
            const float rstd = 1.0f / sqrtf(ss * (1.0f / 128.0f) + EPS);
            const f32x4 y0 = o0 * rstd * g0 * silu4(z0), y1 = o1 * rstd * g1 * silu4(z1);
            v4u w; w.x = pk2(y0.x, y0.y); w.y = pk2(y0.z, y0.w); w.z = pk2(y1.x, y1.y); w.w = pk2(y1.z, y1.w);
            *(v4u*)(MIX + (size_t)m * DM + 2 * GW + c) = w;
        }
        {
            const float* ys = wsf(F, WS_YS) + (size_t)m * GW + c; const float* z = U + (size_t)m * IN_PAD + UD_Z + c;
            const f32x4 a0 = ld4(ys) * silu4(ld4(z)), a1 = ld4(ys + 4) * silu4(ld4(z + 4));
            float ss = (a0.x * a0.x + a0.y * a0.y) + (a0.z * a0.z + a0.w * a0.w) + (a1.x * a1.x + a1.y * a1.y) + (a1.z * a1.z + a1.w * a1.w);
            ss += __shfl_xor(ss, 1); ss += __shfl_xor(ss, 2); ss += __shfl_xor(ss, 4); ss += __shfl_xor(ss, 8); ss += __shfl_xor(ss, 16);
            const float rstd = 1.0f / sqrtf(ss * (1.0f / 256.0f) + EPS);
            const f32x4 y0 = a0 * rstd * n0, y1 = a1 * rstd * n1;
            v4u w; w.x = pk2(y0.x, y0.y); w.y = pk2(y0.z, y0.w); w.z = pk2(y1.x, y1.y); w.w = pk2(y1.z, y1.w);
            *(v4u*)(MIX + (size_t)m * DM + 3 * GW + c) = w;
        }
    }
}

__device__ __forceinline__ void attn_phase(Frame& F, int l) {
    const int lane = opq(F.lane), fr = lane & 15, fq = lane >> 4;
    const bf16* Q = wsb(F, WS_Q); const bf16* KB = wsb(F, WS_KB) + (size_t)l * MROWS * DM; const bf16* VT = wsb(F, WS_VT) + (size_t)l * DM * MROWS; bf16* O = wsb(F, WS_MIX);
    for (int unit = F.vcu; unit < BATCH * XH * (SEQ / 128); unit += F.G) {
        const int b = unit >> 6, h = (unit >> 4) & 3, qt = unit & 15;
        const int qrow0 = b * SEQ + qt * 128 + F.wave * 16;
        const bf16* qp = Q + (size_t)(qrow0 + fr) * DM + h * XHD + fq * 8;
        const bf16* kp = KB + (size_t)(b * MEML + fr) * DM + h * XHD + fq * 8;
        f32x4 acc[16];
#pragma unroll
        for (int n = 0; n < 16; ++n) acc[n] = (f32x4){0.f, 0.f, 0.f, 0.f};
        for (int ks = 0; ks < 16; ++ks) {
            const bf16x8 qf = *(const bf16x8*)(qp + ks * 32);
#pragma unroll
            for (int n = 0; n < 16; ++n) { const bf16x8 kf = *(const bf16x8*)(kp + (size_t)n * 16 * DM + ks * 32);
                acc[n] = __builtin_amdgcn_mfma_f32_16x16x32_bf16(kf, qf, acc[n], 0, 0, 0); }
        }
        float mx = -3.0e38f;
#pragma unroll
        for (int n = 0; n < 16; ++n) mx = fmaxf(fmaxf(fmaxf(acc[n].x, acc[n].y), fmaxf(acc[n].z, acc[n].w)), mx);
        mx = fmaxf(mx, __shfl_xor(mx, 16)); mx = fmaxf(mx, __shfl_xor(mx, 32));
        float sum = 0.f;
#pragma unroll
        for (int n = 0; n < 16; ++n) { acc[n].x = __expf(acc[n].x - mx); acc[n].y = __expf(acc[n].y - mx); acc[n].z = __expf(acc[n].z - mx); acc[n].w = __expf(acc[n].w - mx);
            sum += (acc[n].x + acc[n].y) + (acc[n].z + acc[n].w); }
        sum += __shfl_xor(sum, 16); sum += __shfl_xor(sum, 32);
        const float linv = 1.0f / sum;
        bf16x8 pf[8];
#pragma unroll
        for (int s = 0; s < 8; ++s) { v4u w; w.x = pk2(acc[2 * s].x, acc[2 * s].y); w.y = pk2(acc[2 * s].z, acc[2 * s].w); w.z = pk2(acc[2 * s + 1].x, acc[2 * s + 1].y); w.w = pk2(acc[2 * s + 1].z, acc[2 * s + 1].w);
            pf[s] = __builtin_bit_cast(bf16x8, w); }
        float lv[4];
#pragma unroll
        for (int r = 0; r < 4; ++r) lv[r] = __shfl(linv, 4 * fq + r);
        const bf16* vp = VT + (size_t)(h * XHD + fr) * MROWS + b * MEML + 4 * fq;
        bf16* op = O + (size_t)(qrow0 + 4 * fq) * DM + h * XHD + fr;
#pragma unroll 2
        for (int dt = 0; dt < 32; ++dt) {
            f32x4 oa = (f32x4){0.f, 0.f, 0.f, 0.f};
#pragma unroll
            for (int s = 0; s < 8; ++s) { const bf16* vv = vp + (size_t)dt * 16 * MROWS + s * 32;
                v4u w; const v2u lo = *(const v2u*)vv, hi = *(const v2u*)(vv + 16); w.x = lo.x; w.y = lo.y; w.z = hi.x; w.w = hi.y;
                oa = __builtin_amdgcn_mfma_f32_16x16x32_bf16(pf[s], __builtin_bit_cast(bf16x8, w), oa, 0, 0, 0); }
            op[(size_t)0 * DM + dt * 16] = (bf16)f2bf(oa.x * lv[0]); op[(size_t)1 * DM + dt * 16] = (bf16)f2bf(oa.y * lv[1]);
            op[(size_t)2 * DM + dt * 16] = (bf16)f2bf(oa.z * lv[2]); op[(size_t)3 * DM + dt * 16] = (bf16)f2bf(oa.w * lv[3]);
        }
    }
}

#ifndef SKIPM
#define SKIPM 0
#endif
#ifndef REPM
#define REPM 0
#endif
#ifndef PROBE_PH
#define PROBE_PH -1
#endif
constexpr int PH_PER_LAYER = 13, N_PHASES = 2 + DEPTH * PH_PER_LAYER;
struct Args { const float* in[N_IN]; float* out; unsigned char* ws; int ph_lo, ph_hi; };
static_assert(sizeof(Args) == (N_IN + 2) * 8 + 8, "Args has no padding");
struct GemmDesc { const bf16* A; const bf16* Bt; void* C; int M, N, K, ldc, mode, corder; float scale; };
__device__ __forceinline__ void gemm_desc(const Frame& F, int ph, int sub, GemmDesc& d) {
    const int bx = (int)blockIdx.x;
    d.scale = 1.0f; d.corder = bx;
    if (ph == 1) {
        const int l = sub >> 1; const bf16* wkv = (const bf16*)(F.ws + WS_W + (size_t)l * W_LAYER + WO_WKV); const bf16* memn = wsb(F, WS_MEMN) + (size_t)l * MROWS * DM;
        d.corder = (bx + F.G - 32 * sub) % F.G; d.mode = 1; d.K = DM;
        if ((sub & 1) == 0) { d.A = memn; d.Bt = wkv; d.M = MROWS; d.N = DM; d.C = wsb(F, WS_KB) + (size_t)l * MROWS * DM; d.ldc = DM; }
        else { d.A = wkv + (size_t)DM * DM; d.Bt = memn; d.M = DM; d.N = MROWS; d.C = wsb(F, WS_VT) + (size_t)l * DM * MROWS; d.ldc = MROWS; }
        return;
    }
    const int l = (ph - 2) / PH_PER_LAYER, k = (ph - 2) % PH_PER_LAYER;
    const unsigned char* wl = F.ws + WS_W + (size_t)l * W_LAYER;
    d.M = M; d.K = DM; d.N = DM; d.ldc = DM; d.mode = 0; d.A = wsb(F, WS_XN); d.C = wsf(F, WS_Y);
    if (k == 0) { d.Bt = (const bf16*)(wl + WO_WIN); d.N = IN_PAD; d.C = wsf(F, WS_U); d.ldc = IN_PAD; }
    else if (k == 4) { d.A = wsb(F, WS_MIX); d.Bt = (const bf16*)(wl + WO_WOUT); }
    else if (k == 6) { d.Bt = (const bf16*)(wl + WO_WQ); d.mode = 1; d.C = wsb(F, WS_Q); d.scale = 0.044194173824159216f; }
    else if (k == 8) { d.A = wsb(F, WS_MIX); d.Bt = (const bf16*)(wl + WO_WO); }
    else if (k == 10) { d.Bt = (const bf16*)(wl + WO_WGU); d.N = 2 * DFF; d.mode = 2; d.C = wsb(F, WS_HID); d.ldc = DFF; }
    else { d.A = wsb(F, WS_HID); d.Bt = (const bf16*)(wl + WO_WD); d.K = DFF; }
}

__global__ void __launch_bounds__(NWAVES * 64, 2) fwd_kernel(Args args) {
    extern __shared__ __attribute__((aligned(16))) unsigned char lds[];
    Frame F;
    F.lds = (LAS unsigned char*)lds;
    F.MISC = (volatile LAS unsigned*)(F.lds + MISC_OFF);
    F.tid = threadIdx.x; F.lane = F.tid & 63; F.wave = __builtin_amdgcn_readfirstlane(F.tid >> 6);
    F.G = gridDim.x; { const int bx = blockIdx.x; F.vcu = (F.G % 8 == 0) ? (bx % 8) * (F.G / 8) + bx / 8 : bx; }
    F.ws = args.ws; F.out = args.out; F.ctl = (unsigned*)(args.ws + WS_CTL);
    for (int u = F.tid; u < (LDS_BYTES - LDSCTL_OFF) / 4; u += NWAVES * 64) ((LAS unsigned*)(F.lds + LDSCTL_OFF))[u] = 0u;
    __syncthreads();
    const int lo = args.ph_lo, hi = args.ph_hi;
    XcdBarrier bar; bar.bar = F.ctl + CW_BAR; bar.x = 0; bar.st = nullptr;
    if (hi - lo > 1) bar = xcd_barrier_post(F.ctl + CW_BAR, F.MISC + 8);
    LAS unsigned char* ring = F.lds + RING_OFF;
    unsigned long long t_start = 0, t_probe = 0;
    if (PROBE_PH >= 0) t_start = __builtin_amdgcn_s_memrealtime();
#pragma unroll 1
    for (int ph = lo; ph < hi; ++ph) {
        const int l = ph >= 2 ? (ph - 2) / PH_PER_LAYER : 0, k = ph >= 2 ? (ph - 2) % PH_PER_LAYER : -1;
        const bool is_gemm = (ph == 1) || k == 0 || k == 4 || k == 6 || k == 8 || k == 10 || k == 11;
        const int kbit = (ph < 2) ? ph : (k + 2);
        const int reps = 1 + ((REPM >> kbit) & 1);
#pragma unroll 1
        for (int rep = 0; rep < reps; ++rep) {
        if (is_gemm) {
            const int nsub = (ph == 1) ? 2 * DEPTH : 1;
#pragma unroll 1
            for (int sub = 0; sub < nsub; ++sub) {
                GemmDesc d; gemm_desc(F, ph, sub, d);
                pg8::Gemm g{d.A, d.Bt, d.M, d.N, d.K}; pg8::StaticOrder S; S.init(d.M, d.N, F.G, d.corder);
                pg8::EpiAny E{d.C, d.ldc, d.mode, d.scale};
                pg8::gemm_phase<pg8::EpiAny, pg8::StaticOrder, false, false>(ring, g, S, E);
            }
        } else if (ph == 0) { p0_prologue(F); }
        else {
            const float* ng = inp(I_NORMG) + (size_t)l * N_NORMS * DM;
            if (k == 1) mixer_prep_phase(F, l);
            else if (k == 2) scan_phase(F, l);
            else if (k == 3) mixer_post_phase(F, l);
            else if (k == 7) attn_phase(F, l);
            else if (rep == 0) {
                if (k == 5) resnorm_phase(F, l == 0 ? inp(I_X) : F.out, ng + MIX_POST * DM, ng + XA_PRE * DM);
                else if (k == 9) resnorm_phase(F, F.out, ng + XA_POST * DM, ng + FFN_PRE * DM);
                else resnorm_phase(F, F.out, ng + FFN_POST * DM, (l + 1 < DEPTH) ? ng + (N_NORMS + MIX_PRE) * DM : nullptr);
            }
        }
        if (REPM >> 20) { if (rep + 1 < reps) __syncthreads(); }
        }
        if ((REPM >> 21) & 1) xcd_barrier(bar);
        if (ph + 1 < hi) xcd_barrier(bar);
        if (PROBE_PH >= 0 && ph == PROBE_PH) t_probe = __builtin_amdgcn_s_memrealtime();
    }
    if (PROBE_PH >= 0 && blockIdx.x == 0) {
        const unsigned long long t_end = __builtin_amdgcn_s_memrealtime();
        while (__builtin_amdgcn_s_memrealtime() - t_end < t_probe - t_start) __builtin_amdgcn_s_sleep(8);
    }
}

#ifndef MK_SINGLE
#define MK_SINGLE 0
#endif
extern "C" void kernel_launch(void* const* d_in, const int* in_sizes, int n_in, void* d_out, int out_size, void* d_ws, size_t ws_size, hipStream_t stream) {
    static int grid = 0;
    if (grid == 0) {
        if (n_in != N_IN || in_sizes[0] != M * DM || out_size != M * DM || ws_size < WS_END) { fprintf(stderr, "kernel_launch: unexpected problem (n_in %d, in0 %d, out %d, ws %zu < %zu)\n", n_in, n_in > 0 ? in_sizes[0] : -1, out_size, ws_size, (size_t)WS_END); grid = -1; return; }
        int dev = 0, cus = 0, per_cu = 0;
        if (hipGetDevice(&dev) != hipSuccess || hipDeviceGetAttribute(&cus, hipDeviceAttributeMultiprocessorCount, dev) != hipSuccess) { grid = -1; return; }
        if (hipFuncSetAttribute((const void*)fwd_kernel, hipFuncAttributeMaxDynamicSharedMemorySize, LDS_BYTES) != hipSuccess) { fprintf(stderr, "kernel_launch: hipFuncSetAttribute failed\n"); grid = -1; return; }
        if (hipOccupancyMaxActiveBlocksPerMultiprocessor(&per_cu, (const void*)fwd_kernel, NWAVES * 64, LDS_BYTES) != hipSuccess || per_cu < 1) { fprintf(stderr, "kernel_launch: occupancy query says %d blocks per CU\n", per_cu); per_cu = 1; }
        (void)hipGetLastError();
        grid = cus * (per_cu < 1 ? 1 : 1);
        if (grid != 256) fprintf(stderr, "kernel_launch: note: grid %d (expected 256)\n", grid);
    }
    if (grid < 0) return;
    if (hipMemsetAsync((char*)d_ws + WS_CTL, 0, CTL_ZERO_BYTES, stream) != hipSuccess) { fprintf(stderr, "kernel_launch: memset failed\n"); return; }
    Args a{};
    for (int i = 0; i < N_IN; ++i) a.in[i] = (const float*)d_in[i];
    a.out = (float*)d_out; a.ws = (unsigned char*)d_ws;
#if MK_SINGLE
    a.ph_lo = 0; a.ph_hi = N_PHASES;
    void* kargs[] = {&a};
    hipError_t e = hipLaunchCooperativeKernel((const void*)fwd_kernel, dim3(grid), dim3(NWAVES * 64), kargs, LDS_BYTES, stream);
    if (e != hipSuccess) fprintf(stderr, "kernel_launch: cooperative launch failed: %s (grid %d)\n", hipGetErrorString(e), grid);
#else
    for (int p = 0; p < N_PHASES; ++p) { a.ph_lo = p; a.ph_hi = p + 1;
        hipLaunchKernelGGL(fwd_kernel, dim3(grid), dim3(NWAVES * 64), LDS_BYTES, stream, a);
        const hipError_t le = hipPeekAtLastError(); if (le != hipSuccess) { fprintf(stderr, "kernel_launch: launch %d failed: %s\n", p, hipGetErrorName(le)); break; } }
#endif
}
```

```cpp
#include <hip/hip_runtime.h>
#include <cstdio>
#include <cstdint>
#define MK_SINGLE 1
namespace pg8 {
#define PG8_LAS __attribute__((address_space(3)))
typedef unsigned short bf16_t;
typedef short bf16x8 __attribute__((ext_vector_type(8)));
typedef float f32x4 __attribute__((ext_vector_type(4)));
typedef unsigned u32x4 __attribute__((ext_vector_type(4)));
constexpr int BM = 256, BK = 64, HALF = 128, HTB = HALF * BK * 2  , STAGE_BYTES = 8 * HTB, NXCD = 8, WGM = 8;

__host__ __device__ __forceinline__ int lds_byte(int r, int c) { const int st = (r >> 4) * 2 + (c >> 5), rr = r & 15, cc = c & 31, ob = rr * 64 + cc * 2; return st * 1024 + (ob ^ (((ob >> 9) & 1) << 5)); }
__host__ __device__ __forceinline__ void stage_rc(int b, int& R, int& C) { const int st = b / 1024, sb = b % 1024, swz = sb ^ (((sb >> 9) & 1) << 5); R = (st >> 1) * 16 + swz / 64; C = (st & 1) * 32 + (swz % 64) / 2; }
__host__ __device__ __forceinline__ int perm32(int rho) { const int n = rho >> 4, i = rho & 15; return 8 * (i >> 2) + 4 * n + (i & 3); }

struct Unit { int pm, pn; };
struct Gemm { const bf16_t* A; const bf16_t* Bt; int M, N, K; };

struct StaticOrder {
    int nM, nN, nwg, G, c;
    __host__ __device__ void init(int M, int N, int G_, int c_) { nM = M / BM; nN = N / BM; nwg = nM * nN; G = G_; c = c_; }
    __host__ __device__ bool next(int i, Unit& u) const {
        const long L = (long)i * G + c; if (L >= nwg) return false;
        int wgid = (int)L; { const int q = nwg / NXCD, r = nwg % NXCD, xcd = wgid % NXCD, off = wgid / NXCD; wgid = (xcd < r ? xcd * (q + 1) : r * (q + 1) + (xcd - r) * q) + off; }
        const int nig = WGM * nN, gid = wgid / nig, fm = gid * WGM, gsz = (nM - fm) < WGM ? (nM - fm) : WGM;
        u.pm = fm + ((wgid % nig) % gsz); u.pn = (wgid % nig) / gsz; return true;
    }
    __device__ __forceinline__ void a_ready(const Unit&) const {}
    __device__ __forceinline__ void done(const Unit&) const {}
};

__device__ __forceinline__ unsigned cvt_pk_bf16(float lo, float hi) { unsigned r; asm volatile("v_cvt_pk_bf16_f32 %0, %1, %2" : "=v"(r) : "v"(lo), "v"(hi)); return r; }
struct EpiF32 {
    static constexpr bool PERM = false, AFTER_DRAIN = false;
    float* C; int ldc;
    __device__ __forceinline__ void operator()(const f32x4 (&acc)[2][2][4][2], const Unit& u, int wr, int wc, int fr, int fq) const {
        const int row0 = u.pm * BM + wr * 64 + fr, col0 = u.pn * BM + wc * 32 + 4 * fq;
#pragma unroll
        for (int ai = 0; ai < 2; ++ai)
#pragma unroll
            for (int m = 0; m < 4; ++m) { float* rowp = C + (size_t)(row0 + ai * HALF + m * 16) * ldc + col0;
#pragma unroll
                for (int bj = 0; bj < 2; ++bj)
#pragma unroll
                    for (int n = 0; n < 2; ++n) *(f32x4*)(rowp + bj * HALF + n * 16) = acc[ai][bj][m][n]; }
    }
};
struct EpiBf16S {
    static constexpr bool PERM = true, AFTER_DRAIN = false;
    bf16_t* O; int ldc; float scale;
    __device__ __forceinline__ void operator()(const f32x4 (&acc)[2][2][4][2], const Unit& u, int wr, int wc, int fr, int fq) const {
        const int row0 = u.pm * BM + wr * 64 + fr, col0 = u.pn * BM + wc * 32 + 8 * fq; const float sc = scale;
#pragma unroll
        for (int ai = 0; ai < 2; ++ai)
#pragma unroll
            for (int m = 0; m < 4; ++m) { bf16_t* rowp = O + (size_t)(row0 + ai * HALF + m * 16) * ldc + col0;
#pragma unroll
                for (int bj = 0; bj < 2; ++bj) { const f32x4 v0 = acc[ai][bj][m][0] * sc, v1 = acc[ai][bj][m][1] * sc;
                    u32x4 w; w.x = cvt_pk_bf16(v0[0], v0[1]); w.y = cvt_pk_bf16(v0[2], v0[3]); w.z = cvt_pk_bf16(v1[0], v1[1]); w.w = cvt_pk_bf16(v1[2], v1[3]);
                    *(u32x4*)(rowp + bj * HALF) = w; } }
    }
};
__device__ __forceinline__ float silu_f(float v) { return v / (1.0f + __expf(-v)); }
struct EpiSwiGLU {
    static constexpr bool PERM = true, AFTER_DRAIN = false;
    bf16_t* O; int ldc;
    __device__ __forceinline__ void operator()(const f32x4 (&acc)[2][2][4][2], const Unit& u, int wr, int wc, int fr, int fq) const {
        const int row0 = u.pm * BM + wr * 64 + fr, col0 = u.pn * HALF + wc * 32 + 8 * fq;
#pragma unroll
        for (int ai = 0; ai < 2; ++ai)
#pragma unroll
            for (int m = 0; m < 4; ++m) { bf16_t* rowp = O + (size_t)(row0 + ai * HALF + m * 16) * ldc + col0;
                const f32x4 g0 = acc[ai][0][m][0], g1 = acc[ai][0][m][1], u0 = acc[ai][1][m][0], u1 = acc[ai][1][m][1];
                u32x4 w; w.x = cvt_pk_bf16(silu_f(g0[0]) * u0[0], silu_f(g0[1]) * u0[1]); w.y = cvt_pk_bf16(silu_f(g0[2]) * u0[2], silu_f(g0[3]) * u0[3]);
                w.z = cvt_pk_bf16(silu_f(g1[0]) * u1[0], silu_f(g1[1]) * u1[1]); w.w = cvt_pk_bf16(silu_f(g1[2]) * u1[2], silu_f(g1[3]) * u1[3]);
                *(u32x4*)rowp = w; }
    }
};
struct EpiAny {
    static constexpr bool PERM = false, AFTER_DRAIN = false, RT_PERM = true;
    void* C; int ldc; int mode; float scale;
    __device__ __forceinline__ bool perm() const { return mode != 0; }
    __device__ __forceinline__ void operator()(const f32x4 (&acc)[2][2][4][2], const Unit& u, int wr, int wc, int fr, int fq) const {
        if (mode == 0) { EpiF32 e{(float*)C, ldc}; e(acc, u, wr, wc, fr, fq); }
        else if (mode == 1) { EpiBf16S e{(bf16_t*)C, ldc, scale}; e(acc, u, wr, wc, fr, fq); }
        else { EpiSwiGLU e{(bf16_t*)C, ldc}; e(acc, u, wr, wc, fr, fq); }
    }
};
template <class Epi, class Sched, bool ALIGN_EPI = false, bool SP2 = false>
__device__ __forceinline__ void gemm_phase(PG8_LAS unsigned char* lds, const Gemm g, const Sched& S, const Epi& E) {
    int tid_ = threadIdx.x; asm volatile("" : "+v"(tid_));
    const int tid = tid_, wid = __builtin_amdgcn_readfirstlane(tid >> 6), lane = tid & 63, wr = wid >> 2, wc = wid & 3, fr = lane & 15, fq = lane >> 4;
    const int K = g.K, nt = K / BK;
    unsigned voffA[2], voffB[2];
#pragma unroll
    for (int i = 0; i < 2; ++i) { int R, C; stage_rc(tid * 16 + i * 8192, R, C); const int Rb = E.perm() ? ((R & ~31) + perm32(R & 31)) : R;
        voffA[i] = (unsigned)(R * K + C) * 2u; voffB[i] = (unsigned)(Rb * K + C) * 2u; }
    const size_t kstep = (size_t)(BK * 2);
    const size_t hstep = (size_t)HALF * K * 2;
    const size_t tstep = 2 * hstep;
    const unsigned ldsw = (unsigned)wid * 1024u;
    const int aoff = lds_byte(wr * 64 + fr, fq * 8), boff = lds_byte(wc * 32 + fr, fq * 8);
#define PG8_SA(b, h) (((b) * 2 + (h)) * HTB)
#define PG8_SB(b, h) ((4 + (b) * 2 + (h)) * HTB)
#define PG8_STAGE(bufoff, gbase, voff) do { _Pragma("unroll") for (int _i = 0; _i < 2; ++_i) \
        __builtin_amdgcn_global_load_lds((const unsigned*)((const char*)(gbase) + (voff)[_i]), (PG8_LAS unsigned*)(lds + (bufoff) + ldsw + _i * 8192), 16, 0, 0); } while (0)
#define PG8_LDA(dst, b, h) do { _Pragma("unroll") for (int m = 0; m < 4; ++m) _Pragma("unroll") for (int k = 0; k < 2; ++k) dst[m][k] = *(const PG8_LAS bf16x8*)(lds + PG8_SA(b, h) + aoff + m * 2048 + k * 1024); } while (0)
#define PG8_LDB(dst, b, h) do { _Pragma("unroll") for (int n = 0; n < 2; ++n) _Pragma("unroll") for (int k = 0; k < 2; ++k) dst[n][k] = *(const PG8_LAS bf16x8*)(lds + PG8_SB(b, h) + boff + n * 2048 + k * 1024); } while (0)
#define PG8_MMA(ai, bj, At, Bt) do { __builtin_amdgcn_s_setprio(1); _Pragma("unroll") for (int m = 0; m < 4; ++m) _Pragma("unroll") for (int n = 0; n < 2; ++n) _Pragma("unroll") for (int k = 0; k < 2; ++k) \
        acc[ai][bj][m][n] = __builtin_amdgcn_mfma_f32_16x16x32_bf16(Bt[n][k], At[m][k], acc[ai][bj][m][n], 0, 0, 0); __builtin_amdgcn_s_setprio(0); } while (0)
#define PG8_WAIT_V(n) asm volatile("s_waitcnt vmcnt(" #n ")" ::: "memory")
#define PG8_WAIT_L(n) asm volatile("s_waitcnt lgkmcnt(" #n ")" ::: "memory")
#define PG8_BAR __builtin_amdgcn_s_barrier()
#define PG8_SCHED __builtin_amdgcn_sched_barrier(0)
    Unit cur, nxt; int ui = 0;
    if (!S.next(0, cur)) return;
    f32x4 acc[2][2][4][2];
#pragma unroll
    for (int a = 0; a < 2; ++a)
#pragma unroll
        for (int b = 0; b < 2; ++b)
#pragma unroll
            for (int m = 0; m < 4; ++m)
#pragma unroll
                for (int n = 0; n < 2; ++n) acc[a][b][m][n] = (f32x4){0.f, 0.f, 0.f, 0.f};
    bf16x8 At[4][2], B0[2][2], B1[2][2];
    const char* cA = (const char*)g.A + (size_t)cur.pm * tstep; const char* cB = (const char*)g.Bt + (size_t)cur.pn * tstep;
    S.a_ready(cur);
    if constexpr (SP2) {
        PG8_STAGE(PG8_SB(0, 0), cB, voffB); PG8_STAGE(PG8_SB(0, 1), cB + hstep, voffB); PG8_STAGE(PG8_SA(0, 0), cA, voffA); PG8_STAGE(PG8_SA(0, 1), cA + hstep, voffA);
        if (wr == 1) PG8_BAR;
        PG8_WAIT_V(2); PG8_BAR;
        PG8_STAGE(PG8_SB(1, 0), cB + kstep, voffB); PG8_STAGE(PG8_SA(1, 0), cA + kstep, voffA); PG8_STAGE(PG8_SB(1, 1), cB + hstep + kstep, voffB);
        PG8_WAIT_V(6); PG8_BAR;
    } else {
        PG8_STAGE(PG8_SB(0, 0), cB, voffB); PG8_STAGE(PG8_SA(0, 0), cA, voffA); PG8_STAGE(PG8_SB(0, 1), cB + hstep, voffB); PG8_STAGE(PG8_SA(0, 1), cA + hstep, voffA);
        if (wr == 1) PG8_BAR;
        PG8_WAIT_V(4); PG8_BAR;
        PG8_STAGE(PG8_SB(1, 0), cB + kstep, voffB); PG8_STAGE(PG8_SA(1, 0), cA + kstep, voffA); PG8_STAGE(PG8_SB(1, 1), cB + hstep + kstep, voffB);
        PG8_WAIT_V(6); PG8_BAR;
    }
    for (;;) {
        const bool has_next = S.next(ui + 1, nxt);
        const char* nA = has_next ? (const char*)g.A + (size_t)nxt.pm * tstep : cA; const char* nB = has_next ? (const char*)g.Bt + (size_t)nxt.pn * tstep : cB;
        for (int t = 0; t < nt; t += 2) {
            const bool last = (t == nt - 2);
            const char* a1 = cA + (size_t)(t + 1) * kstep;
            const char* a2 = last ? nA : cA + (size_t)(t + 2) * kstep; const char* b2 = last ? nB : cB + (size_t)(t + 2) * kstep;
            const char* a3 = a2 + kstep; const char* b3 = b2 + kstep;
            if (last && has_next) S.a_ready(nxt);
            if constexpr (SP2) {
            PG8_LDB(B0, 0, 0); PG8_LDB(B1, 0, 1); PG8_SCHED; PG8_LDA(At, 0, 0); PG8_STAGE(PG8_SA(1, 1), a1 + hstep, voffA);
            PG8_WAIT_V(8); PG8_WAIT_L(0); PG8_BAR; PG8_MMA(0, 0, At, B0); PG8_MMA(0, 1, At, B1); PG8_BAR; PG8_SCHED;
            PG8_LDA(At, 0, 1); PG8_STAGE(PG8_SB(0, 0), b2, voffB); PG8_STAGE(PG8_SB(0, 1), b2 + hstep, voffB); PG8_STAGE(PG8_SA(0, 0), a2, voffA);
            PG8_WAIT_V(8); PG8_WAIT_L(0); PG8_BAR; PG8_MMA(1, 0, At, B0); PG8_MMA(1, 1, At, B1); PG8_BAR; PG8_SCHED;
            PG8_LDB(B0, 1, 0); PG8_LDB(B1, 1, 1); PG8_SCHED; PG8_LDA(At, 1, 0); PG8_STAGE(PG8_SA(0, 1), a2 + hstep, voffA);
            PG8_WAIT_V(8); PG8_WAIT_L(0); PG8_BAR; PG8_MMA(0, 0, At, B0); PG8_MMA(0, 1, At, B1); PG8_BAR; PG8_SCHED;
            PG8_LDA(At, 1, 1); PG8_STAGE(PG8_SB(1, 0), b3, voffB); PG8_STAGE(PG8_SB(1, 1), b3 + hstep, voffB); PG8_STAGE(PG8_SA(1, 0), a3, voffA);
            PG8_WAIT_V(8); PG8_WAIT_L(0); PG8_BAR; PG8_MMA(1, 0, At, B0); PG8_MMA(1, 1, At, B1); PG8_BAR; PG8_SCHED;
            } else {
            PG8_LDB(B0, 0, 0); PG8_SCHED; PG8_LDA(At, 0, 0); PG8_STAGE(PG8_SA(1, 1), a1 + hstep, voffA);
            PG8_WAIT_L(8); PG8_BAR; PG8_WAIT_L(0); PG8_MMA(0, 0, At, B0); PG8_BAR; PG8_SCHED;
            PG8_LDB(B1, 0, 1); PG8_STAGE(PG8_SB(0, 0), b2, voffB);
            PG8_BAR; PG8_WAIT_L(0); PG8_MMA(0, 1, At, B1); PG8_BAR;
            PG8_LDA(At, 0, 1); PG8_STAGE(PG8_SA(0, 0), a2, voffA);
            PG8_BAR; PG8_WAIT_L(0); PG8_MMA(1, 0, At, B0); PG8_BAR; PG8_SCHED;
            PG8_STAGE(PG8_SB(0, 1), b2 + hstep, voffB);
            PG8_WAIT_V(6); PG8_BAR; PG8_MMA(1, 1, At, B1); PG8_BAR;
            PG8_LDB(B0, 1, 0); PG8_SCHED; PG8_LDA(At, 1, 0); PG8_STAGE(PG8_SA(0, 1), a2 + hstep, voffA);
            PG8_WAIT_L(8); PG8_BAR; PG8_WAIT_L(0); PG8_MMA(0, 0, At, B0); PG8_BAR; PG8_SCHED;
            PG8_LDB(B1, 1, 1); PG8_STAGE(PG8_SB(1, 0), b3, voffB);
            PG8_BAR; PG8_WAIT_L(0); PG8_MMA(0, 1, At, B1); PG8_BAR;
            PG8_LDA(At, 1, 1); PG8_STAGE(PG8_SA(1, 0), a3, voffA);
            PG8_BAR; PG8_WAIT_L(0); PG8_MMA(1, 0, At, B0); PG8_BAR; PG8_SCHED;
            PG8_STAGE(PG8_SB(1, 1), b3 + hstep, voffB);
            PG8_WAIT_V(6); PG8_BAR; PG8_MMA(1, 1, At, B1); PG8_BAR;
            }
        }
        if constexpr (ALIGN_EPI) { if (wr == 0) PG8_BAR; }
        if constexpr (!Epi::AFTER_DRAIN) { E(acc, cur, wr, wc, fr, fq); S.done(cur); }
        if (!has_next) break;
#pragma unroll
        for (int a = 0; a < 2; ++a)
#pragma unroll
            for (int b = 0; b < 2; ++b)
#pragma unroll
                for (int m = 0; m < 4; ++m)
#pragma unroll
                    for (int n = 0; n < 2; ++n) acc[a][b][m][n] = (f32x4){0.f, 0.f, 0.f, 0.f};
        cur = nxt; cA = nA; cB = nB; ++ui;
        if constexpr (ALIGN_EPI) { if (wr == 1) PG8_BAR; }
    }
    PG8_WAIT_V(0);
    if constexpr (!ALIGN_EPI) { if (wr == 0) PG8_BAR; }
    PG8_BAR;
    if constexpr (Epi::AFTER_DRAIN) { E.fused(acc, cur, wr, wc, fr, fq, lds, wid, lane); S.done(cur); }
#undef PG8_SA
#undef PG8_SB
#undef PG8_STAGE
#undef PG8_LDA
#undef PG8_LDB
#undef PG8_MMA
#undef PG8_WAIT_V
#undef PG8_WAIT_L
#undef PG8_BAR
#undef PG8_SCHED
}
}
constexpr int NWAVES = 8;
constexpr int BATCH = 4, SEQ = 2048, DM = 2048, DEPTH = 2;
constexpr int M = BATCH * SEQ;
constexpr int GW = 512;
constexpr int IN_COLS = 5648, IN_PAD = 5888;
constexpr int DFF = 5632, MEML = 256, XH = 4, XHD = 512;
constexpr int MROWS = BATCH * MEML;
constexpr float EPS = 1e-6f;
constexpr int UA_B = 0, UA_C = 512, UA_H = 1024, UB = 1536, UC_Q = 2048, UC_Z = 3584, UC_A = 4096, UC_B = 4100, UD_Z = 4104, UD_X = 4616, UD_DT = 5640;
constexpr int MIX_PRE = 0, MIX_POST = 1, XA_PRE = 2, XA_POST = 3, MEM_NORM = 4, FFN_PRE = 5, FFN_POST = 6, N_NORMS = 7;
enum { I_X = 0, I_MEM, I_NORMG, I_WIN, I_CONVA, I_POOLW, I_POOLS, I_GCONV, I_GALOG, I_GDTB, I_GNG, I_SCONVW, I_SCONVB, I_SALOG, I_SDTB, I_SD, I_SNG, I_WOUT, I_WQ, I_WKV, I_WO, I_WGU, I_WD, N_IN };

constexpr size_t MiB = 1u << 20;
constexpr size_t WS_CTL = 0, CTL_ZERO_BYTES = 1 * MiB;
constexpr size_t WSZ_WIN = (size_t)IN_PAD * DM * 2, WSZ_SQ = (size_t)DM * DM * 2, WSZ_KV = (size_t)2 * DM * DM * 2, WSZ_GU = (size_t)2 * DFF * DM * 2, WSZ_D = (size_t)DM * DFF * 2;
constexpr size_t WO_WIN = 0, WO_WOUT = WO_WIN + WSZ_WIN, WO_WQ = WO_WOUT + WSZ_SQ, WO_WKV = WO_WQ + WSZ_SQ, WO_WO = WO_WKV + WSZ_KV, WO_WGU = WO_WO + WSZ_SQ, WO_WD = WO_WGU + WSZ_GU, W_LAYER = WO_WD + WSZ_D;
constexpr size_t WS_W = 1 * MiB;
constexpr size_t WS_XN = WS_W + 2 * W_LAYER;
constexpr size_t WS_MIX = WS_XN + (size_t)M * DM * 2;
constexpr size_t WS_MEMN = WS_MIX + (size_t)M * DM * 2;
constexpr size_t WS_KB = WS_MEMN + (size_t)2 * MROWS * DM * 2;
constexpr size_t WS_VT = WS_KB + (size_t)2 * MROWS * DM * 2;
constexpr size_t WS_U = WS_VT + (size_t)2 * MROWS * DM * 2;
constexpr size_t WS_Q = WS_U, WS_HID = WS_U + (size_t)M * DM * 2;
constexpr size_t WS_SCR = WS_U + (size_t)M * IN_PAD * 4;
constexpr size_t WS_Y = WS_SCR;
constexpr size_t SZ512 = (size_t)M * 512 * 4, SZ256 = (size_t)M * 256 * 4, SZ8 = (size_t)M * 8 * 4;
constexpr size_t WS_QN = WS_SCR, WS_KN = WS_QN + SZ512, WS_VV = WS_KN + SZ512, WS_OG = WS_VV + SZ512, WS_XS = WS_OG + SZ512, WS_YS = WS_XS + SZ512,
                 WS_BS = WS_YS + SZ512, WS_CS = WS_BS + SZ256, WS_GB = WS_CS + SZ256, WS_DT = WS_GB + SZ8, WS_ZG = WS_DT + 2 * SZ8, WS_ZS = WS_ZG + SZ512, WS_END = WS_ZS + SZ512;
constexpr int LA_QD = 0, LA_QK = 16384, LA_KE = 24576, LA_NW = 40960, LA_UCG = 57344, LA_RECG = 90112;
constexpr int LA_UCS = 40960, LA_RECS = 57344;
constexpr size_t WS_FG = WS_U, WS_FS = WS_FG + (size_t)512 * LA_RECG, WS_DLG = WS_FS + (size_t)1024 * LA_RECS, WS_DLS = WS_DLG + 512 * 4, WS_FEND = WS_DLS + 1024 * 4;
static_assert(WS_FEND <= WS_SCR, "records inside U");
static_assert(WS_Y + (size_t)M * DM * 4 <= WS_END, "Y inside the scan region");
static_assert(WS_HID + (size_t)M * DFF * 2 <= WS_SCR, "HID inside U");
static_assert(WS_END <= (size_t)704 * MiB, "d_ws map fits 4 x the largest input");

constexpr int RING_OFF = 0, RING_BYTES = 131072;
constexpr int LDSCTL_OFF = RING_BYTES, MISC_OFF = LDSCTL_OFF + 320;
constexpr int LDS_BYTES = 147456;
constexpr int CW_BAR = 4096;

#define GAS __attribute__((address_space(1)))
#define LAS __attribute__((address_space(3)))
typedef unsigned short bf16;
typedef unsigned v4u __attribute__((ext_vector_type(4)));
typedef unsigned v2u __attribute__((ext_vector_type(2)));
typedef float f32x4 __attribute__((ext_vector_type(4)));
typedef short bf16x8 __attribute__((ext_vector_type(8)));
#define LDS_WAIT() asm volatile("s_waitcnt lgkmcnt(0)" ::: "memory")
#define VM_WAIT() asm volatile("s_waitcnt vmcnt(0)" ::: "memory")
__device__ __forceinline__ unsigned f2bf(float f) { unsigned u = __builtin_bit_cast(unsigned, f); return (u + 0x7fffu + ((u >> 16) & 1u)) >> 16; }
__device__ __forceinline__ unsigned pk2(float lo, float hi) { return f2bf(lo) | (f2bf(hi) << 16); }
__device__ __forceinline__ float siluf(float v) { return v / (1.0f + __expf(-v)); }
__device__ __forceinline__ float softplusf(float v) { return fmaxf(v, 0.f) + log1pf(__expf(-fabsf(v))); }
__device__ __forceinline__ float sigmoidf(float v) { return 1.0f / (1.0f + __expf(-v)); }
template <int CTRL> __device__ __forceinline__ float dppf(float v) { return __builtin_bit_cast(float, __builtin_amdgcn_update_dpp(0, __builtin_bit_cast(int, v), CTRL, 0xF, 0xF, true)); }
__device__ __forceinline__ float row16_sum(float v) { v += dppf<0xB1>(v); v += dppf<0x4E>(v); v += dppf<0x141>(v); v += dppf<0x140>(v); return v; }
__device__ __forceinline__ int opq(int v) { asm volatile("" : "+v"(v)); return v; }
__device__ __forceinline__ float wave_sum(float v) {
#pragma unroll
    for (int o = 1; o < 64; o <<= 1) v += __shfl_xor(v, o);
    return v;
}

#define XB_TMO      128
#define XB_XCNT(j)  (256  + 64 * (j))
#define XB_XSUB(j)  (1280 + 64 * (j))
#define XB_XGEN(j)  (2304 + 64 * (j))
#define XB_TOP      3328
#define XB_TOPGEN   3392
#define XCD_BAR_WORDS 3456
#define XB_SPIN_CAP (1u << 18)

__device__ __forceinline__ unsigned xb_ld(unsigned* p)              { return __hip_atomic_load(p, __ATOMIC_RELAXED, __HIP_MEMORY_SCOPE_AGENT); }
__device__ __forceinline__ unsigned xb_add(unsigned* p, unsigned v) { return __hip_atomic_fetch_add(p, v, __ATOMIC_RELAXED, __HIP_MEMORY_SCOPE_AGENT); }
__device__ __forceinline__ unsigned xb_xcc_id() { return (unsigned)__builtin_amdgcn_s_getreg((3 << 11) | 20) & 0xFu; }
#define XB_SPIN(cond, bar) do { unsigned _sp = 0; while (cond) { __builtin_amdgcn_s_sleep(1); \
    if ((++_sp & 255u) == 0u) { if (xb_ld(&(bar)[XB_TMO])) break; if (_sp > XB_SPIN_CAP) { atomicAdd(&(bar)[XB_TMO], 1u); break; } } } } while (0)

struct XcdBarrier {
    unsigned* bar; unsigned x;
    volatile LAS unsigned* st;
};

__device__ __forceinline__ XcdBarrier xcd_barrier_post(unsigned* bar, volatile LAS unsigned* st) {
    XcdBarrier b; b.bar = bar; b.x = xb_xcc_id(); b.st = st;
    if (threadIdx.x == 0) (void)xb_add(&bar[XB_XCNT(b.x)], 1u);
    return b;
}
__device__ __forceinline__ void xcd_barrier_complete(unsigned* bar, unsigned x, unsigned& nloc, unsigned& nx) {
    const unsigned G = gridDim.x * gridDim.y * gridDim.z;
    unsigned sum, cnt, mine, sp = 0u;
    for (;;) {
        sum = 0u; cnt = 0u; mine = 0u;
#pragma unroll
        for (unsigned j = 0; j < 16; ++j) { const unsigned c = xb_ld(&bar[XB_XCNT(j)]); sum += c; cnt += (c > 0u) ? 1u : 0u; mine = (j == x) ? c : mine; }
        if (sum == G) break;
        __builtin_amdgcn_s_sleep(1);
        if ((++sp & 255u) == 0u) { if (xb_ld(&bar[XB_TMO])) break; if (sp > XB_SPIN_CAP) { atomicAdd(&bar[XB_TMO], 1u); break; } }
    }
    nloc = mine > 0u ? mine : 1u; nx = cnt > 0u ? cnt : 1u;
}

__device__ __forceinline__ void xcd_barrier(const XcdBarrier& b) {
    asm volatile("s_waitcnt vmcnt(0)" ::: "memory");
    __syncthreads();
    if (threadIdx.x == 0) {
        unsigned* bar = b.bar;
        __builtin_amdgcn_s_waitcnt(0);
        unsigned nloc = b.st[0], nx = b.st[1];
        if (nloc == 0u) { xcd_barrier_complete(bar, b.x, nloc, nx); b.st[0] = nloc; b.st[1] = nx; }
        const unsigned old = xb_add(&bar[XB_XSUB(b.x)], 1u);
        const unsigned gen = old / nloc;
        if (old + 1u == (gen + 1u) * nloc) {
            __builtin_amdgcn_fence(__ATOMIC_RELEASE, "agent");
            asm volatile("s_waitcnt vmcnt(0)" ::: "memory");
            const unsigned og = xb_add(&bar[XB_TOP], 1u);
            const unsigned tg = og / nx;
            if (og + 1u == (tg + 1u) * nx) xb_add(&bar[XB_TOPGEN], 1u);
            else XB_SPIN(xb_ld(&bar[XB_TOPGEN]) == tg, bar);
            __builtin_amdgcn_fence(__ATOMIC_ACQUIRE, "agent");
            xb_add(&bar[XB_XGEN(b.x)], 1u);
            asm volatile("s_waitcnt vmcnt(0)" ::: "memory");
        } else {
            XB_SPIN(xb_ld(&bar[XB_XGEN(b.x)]) == gen, bar);
            __builtin_amdgcn_fence(__ATOMIC_ACQUIRE, "agent");
            asm volatile("s_waitcnt vmcnt(0)" ::: "memory");
        }
    }
    __syncthreads();
}
struct Frame {
    LAS unsigned char* lds;
    volatile LAS unsigned* MISC;
    unsigned* ctl;
    int tid, lane, wave;
    int vcu, G;
    float* out; unsigned char* ws;
};
__device__ __forceinline__ const float* inp(int i) { const float* __attribute__((address_space(4))) const* tab = (const float* __attribute__((address_space(4))) const*)__builtin_amdgcn_kernarg_segment_ptr(); asm volatile("" : "+s"(tab)); return tab[i]; }
__device__ __forceinline__ bf16* wsb(const Frame& F, size_t off) { return (bf16*)(F.ws + off); }
__device__ __forceinline__ float* wsf(const Frame& F, size_t off) { return (float*)(F.ws + off); }

__device__ __forceinline__ void p0_transpose_item(const float* W, int K, int N, bf16* WT, int drow0, int k0, int n0, LAS float* scr, int lane) {
    const int nn = n0 + (lane & 31); const bool ok = nn < N;
#pragma unroll 8
    for (int i = 0; i < 32; ++i) { const int kk = 2 * i + (lane >> 5); scr[kk * 33 + (lane & 31)] = ok ? W[(size_t)(k0 + kk) * N + nn] : 0.f; }
    LDS_WAIT(); asm volatile("" ::: "memory");
    const int c = lane & 7;
#pragma unroll
    for (int j = 0; j < 4; ++j) { const int n = (lane >> 3) + 8 * j; const LAS float* s = scr + (8 * c) * 33 + n;
        v4u o; o.x = pk2(s[0 * 33], s[1 * 33]); o.y = pk2(s[2 * 33], s[3 * 33]); o.z = pk2(s[4 * 33], s[5 * 33]); o.w = pk2(s[6 * 33], s[7 * 33]);
        *(v4u*)(WT + (size_t)(drow0 + n) * K + k0 + 8 * c) = o; }
    LDS_WAIT(); asm volatile("" ::: "memory");
}
__device__ __forceinline__ void norm_row_to_bf16(const float* xrow, const float* g, bf16* orow, int lane) {
    const f32x4* xr = (const f32x4*)xrow + lane; const f32x4* gr = (const f32x4*)g + lane;
    f32x4 v[8]; float s = 0.f;
#pragma unroll
    for (int j = 0; j < 8; ++j) { v[j] = xr[64 * j]; s += (v[j].x * v[j].x + v[j].y * v[j].y) + (v[j].z * v[j].z + v[j].w * v[j].w); }
    const float rstd = 1.0f / sqrtf(wave_sum(s) * (1.0f / DM) + EPS);
    v2u* o8 = (v2u*)orow + lane;
#pragma unroll
    for (int j = 0; j < 8; ++j) { const f32x4 gg = gr[64 * j]; v2u w; w.x = pk2(v[j].x * rstd * gg.x, v[j].y * rstd * gg.y); w.y = pk2(v[j].z * rstd * gg.z, v[j].w * rstd * gg.w); o8[64 * j] = w; }
}
__device__ __forceinline__ void p0_prologue(Frame& F) {
    LAS float* scr = (LAS float*)(F.lds + RING_OFF + F.wave * 16384);
    const int gw = F.vcu * NWAVES + F.wave, NGW = F.G * NWAVES; const int lane = opq(F.lane), tid = opq(F.tid);
    constexpr int NB_IN = (IN_COLS + 31) / 32;
    constexpr int I_IN = (DM / 64) * NB_IN, I_SQ = (DM / 64) * (DM / 32), I_KV = (DM / 64) * (2 * DM / 32), I_GU = (DM / 64) * (2 * DFF / 32), I_D = (DFF / 64) * (DM / 32);
    constexpr int I_LAYER = I_IN + 3 * I_SQ + I_KV + I_GU + I_D;
    for (int it = gw; it < DEPTH * I_LAYER; it += NGW) {
        const int l = it / I_LAYER; int r = it % I_LAYER;
        bf16* wl = wsb(F, WS_W + (size_t)l * W_LAYER);
        if (r < I_IN) { const int kb = r / NB_IN, nb = r % NB_IN; p0_transpose_item(inp(I_WIN) + (size_t)l * DM * IN_COLS, DM, IN_COLS, (bf16*)((char*)wl + WO_WIN), 32 * nb, 64 * kb, 32 * nb, scr, lane); continue; } r -= I_IN;
        if (r < I_SQ) { const int kb = r / (DM / 32), nb = r % (DM / 32); p0_transpose_item(inp(I_WOUT) + (size_t)l * DM * DM, DM, DM, (bf16*)((char*)wl + WO_WOUT), 32 * nb, 64 * kb, 32 * nb, scr, lane); continue; } r -= I_SQ;
        if (r < I_SQ) { const int kb = r / (DM / 32), nb = r % (DM / 32); p0_transpose_item(inp(I_WQ) + (size_t)l * DM * DM, DM, DM, (bf16*)((char*)wl + WO_WQ), 32 * nb, 64 * kb, 32 * nb, scr, lane); continue; } r -= I_SQ;
        if (r < I_SQ) { const int kb = r / (DM / 32), nb = r % (DM / 32); p0_transpose_item(inp(I_WO) + (size_t)l * DM * DM, DM, DM, (bf16*)((char*)wl + WO_WO), 32 * nb, 64 * kb, 32 * nb, scr, lane); continue; } r -= I_SQ;
        if (r < I_KV) { const int kb = r / (2 * DM / 32), nb = r % (2 * DM / 32); p0_transpose_item(inp(I_WKV) + (size_t)l * DM * 2 * DM, DM, 2 * DM, (bf16*)((char*)wl + WO_WKV), 32 * nb, 64 * kb, 32 * nb, scr, lane); continue; } r -= I_KV;
        if (r < I_GU) { const int kb = r / (2 * DFF / 32), nb = r % (2 * DFF / 32); const int n0 = 32 * nb; const int up = n0 >= DFF ? 1 : 0, j0 = n0 - up * DFF;
            const int drow = (j0 >> 7) * 256 + up * 128 + (j0 & 127);
            p0_transpose_item(inp(I_WGU) + (size_t)l * DM * 2 * DFF, DM, 2 * DFF, (bf16*)((char*)wl + WO_WGU), drow, 64 * kb, n0, scr, lane); continue; } r -= I_GU;
        { const int kb = r / (DM / 32), nb = r % (DM / 32); p0_transpose_item(inp(I_WD) + (size_t)l * DFF * DM, DFF, DM, (bf16*)((char*)wl + WO_WD), 32 * nb, 64 * kb, 32 * nb, scr, lane); }
    }
    { constexpr int ZR0 = 32 * NB_IN, ZN = (IN_PAD - ZR0) * DM / 8;
      for (int i = (F.vcu * NWAVES * 64) + tid; i < DEPTH * ZN; i += F.G * NWAVES * 64) { const int l = i / ZN, k = i % ZN;
          ((v4u*)(F.ws + WS_W + (size_t)l * W_LAYER + WO_WIN + (size_t)ZR0 * DM * 2))[k] = (v4u){0u, 0u, 0u, 0u}; } }
    for (int m = gw; m < DEPTH * MROWS; m += NGW) { const int l = m / MROWS, r = m % MROWS;
        norm_row_to_bf16(inp(I_MEM) + (size_t)r * DM, inp(I_NORMG) + (size_t)(l * N_NORMS + MEM_NORM) * DM, wsb(F, WS_MEMN) + (size_t)m * DM, lane); }
    for (int m = gw; m < M; m += NGW) norm_row_to_bf16(inp(I_X) + (size_t)m * DM, inp(I_NORMG) + (size_t)(0 * N_NORMS + MIX_PRE) * DM, wsb(F, WS_XN) + (size_t)m * DM, lane);
}

__device__ __forceinline__ void resnorm_phase(Frame& F, const float* xin, const float* gpost, const float* gpre  ) {
    const int gw = F.vcu * NWAVES + F.wave, NGW = F.G * NWAVES, lane = opq(F.lane);
    const float* Y = wsf(F, WS_Y); bf16* XN = wsb(F, WS_XN);
    for (int m = gw; m < M; m += NGW) {
        const f32x4* yr = (const f32x4*)(Y + (size_t)m * DM) + lane; const f32x4* xr = (const f32x4*)(xin + (size_t)m * DM) + lane;
        f32x4* xo = (f32x4*)(F.out + (size_t)m * DM) + lane;
        f32x4 y[8], x[8]; float s = 0.f;
#pragma unroll
        for (int j = 0; j < 8; ++j) { y[j] = yr[64 * j]; x[j] = xr[64 * j]; s += (y[j].x * y[j].x + y[j].y * y[j].y) + (y[j].z * y[j].z + y[j].w * y[j].w); }
        const float rstd = 1.0f / sqrtf(wave_sum(s) * (1.0f / DM) + EPS);
        float s2 = 0.f;
#pragma unroll
        for (int j = 0; j < 8; ++j) { const f32x4 gg = ((const f32x4*)gpost)[lane + 64 * j]; x[j] = x[j] + y[j] * rstd * gg; xo[64 * j] = x[j];
            s2 += (x[j].x * x[j].x + x[j].y * x[j].y) + (x[j].z * x[j].z + x[j].w * x[j].w); }
        if (gpre) {
            const float r2 = 1.0f / sqrtf(wave_sum(s2) * (1.0f / DM) + EPS);
            v2u* o8 = (v2u*)(XN + (size_t)m * DM) + lane;
#pragma unroll
            for (int j = 0; j < 8; ++j) { const f32x4 gg = ((const f32x4*)gpre)[lane + 64 * j]; v2u w; w.x = pk2(x[j].x * r2 * gg.x, x[j].y * r2 * gg.y); w.y = pk2(x[j].z * r2 * gg.z, x[j].w * r2 * gg.w); o8[64 * j] = w; }
        }
    }
}

__device__ __forceinline__ f32x4 ld4(const float* p) { return *(const f32x4*)p; }
__device__ __forceinline__ f32x4 silu4(f32x4 v) { return (f32x4){siluf(v.x), siluf(v.y), siluf(v.z), siluf(v.w)}; }
__device__ __forceinline__ void mixer_prep_phase(Frame& F, int l) {
    const int gw = F.vcu * NWAVES + F.wave, NGW = F.G * NWAVES, lane = opq(F.lane), tid = opq(F.tid);
    const float* U = wsf(F, WS_U);
    bf16* MIX = wsb(F, WS_MIX);
    constexpr int NSTRIP = M / 16;
    for (int it = gw; it < 16 * NSTRIP; it += NGW) {
        const int type = it & 15, strip = it >> 4, r0 = strip * 16, pos0 = r0 & (SEQ - 1);
        if (type < 2) {
            const int c = type * 256 + lane * 4;
            const float* cw = inp(I_CONVA) + (size_t)l * 3 * GW + c;
            const f32x4 w0 = ld4(cw), w1 = ld4(cw + GW), w2 = ld4(cw + 2 * GW);
            f32x4 p2 = (f32x4){0.f, 0.f, 0.f, 0.f}, p1 = p2;
            if (pos0 >= 2) { const float* u2 = U + (size_t)(r0 - 2) * IN_PAD; const float* u1 = U + (size_t)(r0 - 1) * IN_PAD;
                p2 = ld4(u2 + UA_C + c) * ld4(u2 + UA_H + c); p1 = ld4(u1 + UA_C + c) * ld4(u1 + UA_H + c); }
#pragma unroll 4
            for (int i = 0; i < 16; ++i) { const float* ur = U + (size_t)(r0 + i) * IN_PAD;
                const f32x4 p0 = ld4(ur + UA_C + c) * ld4(ur + UA_H + c);
                const f32x4 y = ld4(ur + UA_B + c) * (w0 * p2 + w1 * p1 + w2 * p0);
                v2u o; o.x = pk2(y.x, y.y); o.y = pk2(y.z, y.w); *(v2u*)(MIX + (size_t)(r0 + i) * DM + c) = o;
                p2 = p1; p1 = p0; }
        } else if (type < 8) {
            const int gi = type - 2, c = gi * 256 + lane * 4;
            const float* cw = inp(I_GCONV) + (size_t)l * 4 * 3 * GW + c;
            const f32x4 w0 = ld4(cw), w1 = ld4(cw + 3 * GW), w2 = ld4(cw + 6 * GW), w3 = ld4(cw + 9 * GW);
            f32x4 x3 = (f32x4){0.f, 0.f, 0.f, 0.f}, x2 = x3, x1 = x3;
            if (pos0 >= 3) { x3 = ld4(U + (size_t)(r0 - 3) * IN_PAD + UC_Q + c); x2 = ld4(U + (size_t)(r0 - 2) * IN_PAD + UC_Q + c); x1 = ld4(U + (size_t)(r0 - 1) * IN_PAD + UC_Q + c); }
            float* dst = (gi < 2) ? wsf(F, WS_QN) + gi * 256 : (gi < 4) ? wsf(F, WS_KN) + (gi - 2) * 256 : wsf(F, WS_VV) + (gi - 4) * 256;
            const float qs = (gi < 2) ? 0.08838834764831845f : 1.0f;
#pragma unroll 4
            for (int i = 0; i < 16; ++i) { const f32x4 x0 = ld4(U + (size_t)(r0 + i) * IN_PAD + UC_Q + c);
                f32x4 y = silu4(w0 * x3 + w1 * x2 + w2 * x1 + w3 * x0);
                if (gi < 4) { float ss = (y.x * y.x + y.y * y.y) + (y.z * y.z + y.w * y.w);
                    ss += __shfl_xor(ss, 1); ss += __shfl_xor(ss, 2); ss += __shfl_xor(ss, 4); ss += __shfl_xor(ss, 8); ss += __shfl_xor(ss, 16);
                    y = y * (qs / sqrtf(ss + EPS)); }
                *(f32x4*)(dst + (size_t)(r0 + i) * GW + lane * 4) = y;
                x3 = x2; x2 = x1; x1 = x0; }
        } else if (type < 12) {
            const int gi = type - 8, c = gi * 256 + lane * 4;
            const float* cw = inp(I_SCONVW) + (size_t)l * 4 * 1024 + c;
            const f32x4 w0 = ld4(cw), w1 = ld4(cw + 1024), w2 = ld4(cw + 2048), w3 = ld4(cw + 3072), bb = ld4(inp(I_SCONVB) + (size_t)l * 1024 + c);
            f32x4 x3 = (f32x4){0.f, 0.f, 0.f, 0.f}, x2 = x3, x1 = x3;
            if (pos0 >= 3) { x3 = ld4(U + (size_t)(r0 - 3) * IN_PAD + UD_X + c); x2 = ld4(U + (size_t)(r0 - 2) * IN_PAD + UD_X + c); x1 = ld4(U + (size_t)(r0 - 1) * IN_PAD + UD_X + c); }
            float* dst; int ld;
            if (gi < 2) { dst = wsf(F, WS_XS) + gi * 256; ld = 512; } else if (gi == 2) { dst = wsf(F, WS_BS); ld = 256; } else { dst = wsf(F, WS_CS); ld = 256; }
#pragma unroll 4
            for (int i = 0; i < 16; ++i) { const f32x4 x0 = ld4(U + (size_t)(r0 + i) * IN_PAD + UD_X + c);
                const f32x4 y = silu4(w0 * x3 + w1 * x2 + w2 * x1 + w3 * x0 + bb);
                *(f32x4*)(dst + (size_t)(r0 + i) * ld + lane * 4) = y;
                x3 = x2; x2 = x1; x1 = x0; }
        } else {
            const int gi = type - 12, w = 2 << gi;
            LAS float* scr = (LAS float*)(F.lds + RING_OFF + F.wave * 16384);
            const int c0 = UB + gi * 128 + lane * 2;
            float r0s = 0.f, r1s = 0.f;
            if (pos0 > 0) { for (int s = 1; s < w; ++s) { const float* up = U + (size_t)(r0 - s) * IN_PAD + c0; r0s += up[0]; r1s += up[1]; } }
            for (int i = 0; i < 16; ++i) { const int pos = pos0 + i; const float* ur = U + (size_t)(r0 + i) * IN_PAD + c0;
                const float a0 = ur[0], a1 = ur[1];
                r0s += a0; r1s += a1;
                const float cnt = (float)((pos + 1 < w) ? pos + 1 : w);
                scr[i * 128 + lane * 2] = r0s / cnt - a0; scr[i * 128 + lane * 2 + 1] = r1s / cnt - a1;
                if (pos - w + 1 >= 0) { const float* ud = U + (size_t)(r0 + i - w + 1) * IN_PAD + c0; r0s -= ud[0]; r1s -= ud[1]; } }
            LDS_WAIT(); asm volatile("" ::: "memory");
            float acc0[16], acc1[16];
#pragma unroll
            for (int i = 0; i < 16; ++i) { acc0[i] = 0.f; acc1[i] = 0.f; }
            const float* pw = inp(I_POOLW) + ((size_t)l * 4 + gi) * 128 * 128;
            for (int cc = 0; cc < 128; cc += 4) {
                float wa[4], wb[4];
#pragma unroll
                for (int q = 0; q < 4; ++q) { wa[q] = pw[(size_t)(cc + q) * 128 + lane]; wb[q] = pw[(size_t)(cc + q) * 128 + 64 + lane]; }
#pragma unroll
                for (int i = 0; i < 16; ++i) { const f32x4 p = *(const LAS f32x4*)(scr + i * 128 + cc);
                    acc0[i] += p.x * wa[0] + p.y * wa[1] + p.z * wa[2] + p.w * wa[3]; acc1[i] += p.x * wb[0] + p.y * wb[1] + p.z * wb[2] + p.w * wb[3]; }
            }
            const float s0 = inp(I_POOLS)[(size_t)l * GW + gi * 128 + lane], s1 = inp(I_POOLS)[(size_t)l * GW + gi * 128 + 64 + lane];
#pragma unroll
            for (int i = 0; i < 16; ++i) { bf16* o = MIX + (size_t)(r0 + i) * DM + GW + gi * 128; o[lane] = (bf16)f2bf(acc0[i] * s0); o[64 + lane] = (bf16)f2bf(acc1[i] * s1); }
            LDS_WAIT(); asm volatile("" ::: "memory");
        }
    }
    for (int i = (F.vcu * NWAVES * 64) + tid; i < M * 16; i += F.G * NWAVES * 64) { const int t = i >> 4, j = i & 15; const float* ur = U + (size_t)t * IN_PAD;
        if (j < 4) { wsf(F, WS_GB)[(size_t)t * 8 + 2 * j] = -__expf(inp(I_GALOG)[l * 4 + j]) * softplusf(ur[UC_A + j] + inp(I_GDTB)[l * 4 + j]); }
        else if (j < 8) { wsf(F, WS_GB)[(size_t)t * 8 + 2 * (j - 4) + 1] = sigmoidf(ur[UC_B + (j - 4)]); }
        else { const int hh = j - 8; const float dt = softplusf(ur[UD_DT + hh] + inp(I_SDTB)[l * 8 + hh]);
            wsf(F, WS_DT)[(size_t)t * 16 + 2 * hh] = -__expf(inp(I_SALOG)[l * 8 + hh]) * dt; wsf(F, WS_DT)[(size_t)t * 16 + 2 * hh + 1] = dt; } }
    for (int i = (F.vcu * NWAVES * 64) + tid; i < M * 256; i += F.G * NWAVES * 64) { const int t = i >> 8, c = (i & 255) * 4;
        if (c < 512) *(f32x4*)(wsf(F, WS_ZG) + (size_t)t * GW + c) = ld4(U + (size_t)t * IN_PAD + UC_Z + c);
        else *(f32x4*)(wsf(F, WS_ZS) + (size_t)t * GW + (c - 512)) = ld4(U + (size_t)t * IN_PAD + UD_Z + (c - 512)); }
}

typedef float f32x16 __attribute__((ext_vector_type(16)));
typedef float f32x2v __attribute__((ext_vector_type(2)));
typedef __bf16 bf16x2_t __attribute__((ext_vector_type(2)));
__device__ __forceinline__ unsigned cvtpk(float lo, float hi) { const f32x2v v = {lo, hi}; return __builtin_bit_cast(unsigned, __builtin_convertvector(v, bf16x2_t)); }
__device__ __forceinline__ bf16x8 pack8(float a0, float a1, float a2, float a3, float a4, float a5, float a6, float a7) { v4u w; w.x = cvtpk(a0, a1); w.y = cvtpk(a2, a3); w.z = cvtpk(a4, a5); w.w = cvtpk(a6, a7); return __builtin_bit_cast(bf16x8, w); }
#define PACK_STEP(x, s) pack8((x)[8 * (s)], (x)[8 * (s) + 1], (x)[8 * (s) + 2], (x)[8 * (s) + 3], (x)[8 * (s) + 4], (x)[8 * (s) + 5], (x)[8 * (s) + 6], (x)[8 * (s) + 7])
#define MFMA32(a, b, c) __builtin_amdgcn_mfma_f32_32x32x16_bf16((a), (b), (c), 0, 0, 0)
__device__ __forceinline__ int crow(int reg, int h) { return (reg & 3) + 8 * (reg >> 2) + 4 * h; }
constexpr int LA_KB = 0;
constexpr int LA_QB = LA_KB + 64 * 136 * 2;
constexpr int LA_KGT = LA_QB + 64 * 136 * 2;
constexpr int LA_VBT = LA_KGT + 128 * 72 * 2;
constexpr int LA_KET = LA_VBT + 128 * 72 * 2;
constexpr int LA_M = LA_KET + 128 * 72 * 2;
constexpr int LA_TB = LA_M + 64 * 68 * 4;
constexpr int LA_VEC = LA_TB + 64 * 72 * 2;
static_assert(LA_VEC + 1024 <= RING_BYTES, "la LDS map");
__device__ __forceinline__ bf16x8 lds_frag(const LAS unsigned char* base, int row, int stride_el, int col) { return *(const LAS bf16x8*)(base + ((size_t)row * stride_el + col) * 2); }
__device__ __forceinline__ float wave_incl_scan(float v, int lane) {
#pragma unroll
    for (int d = 1; d < 64; d <<= 1) { const float o = __shfl_up(v, d); if (lane >= d) v += o; }
    return v;
}
__device__ __forceinline__ void store_qk_frag(const f32x16& acc, const LAS float* Gv, int mt, int rt, int r, int h, int lane, bf16* qkf) {
    const int l = 32 * rt + r; const float Gl = Gv[l];
    float v[16];
#pragma unroll
    for (int q = 0; q < 16; ++q) { const int m = 32 * mt + crow(q, h); v[q] = (m <= l) ? acc[q] * __expf(Gl - Gv[m]) : 0.f; }
    *(bf16x8*)(qkf + ((size_t)(rt * 4 + 2 * mt + 0) * 64 + lane) * 8) = pack8(v[0], v[1], v[2], v[3], v[4], v[5], v[6], v[7]);
    *(bf16x8*)(qkf + ((size_t)(rt * 4 + 2 * mt + 1) * 64 + lane) * 8) = pack8(v[8], v[9], v[10], v[11], v[12], v[13], v[14], v[15]);
}
__device__ __forceinline__ void qd_frag_task(const float* qrows, int ldq, const LAS float* Gv, int task, int r, int h, int lane, bf16* qdf) {
    const int rt = task >> 3, ks = task & 7, l = 32 * rt + r, k0 = 16 * ks + 4 * h; const float e = __expf(Gv[l]);
    const f32x4 a = ld4(qrows + (size_t)l * ldq + k0), b = ld4(qrows + (size_t)l * ldq + k0 + 8);
    *(bf16x8*)(qdf + ((size_t)task * 64 + lane) * 8) = pack8(a.x * e, a.y * e, a.z * e, a.w * e, b.x * e, b.y * e, b.z * e, b.w * e);
}
__device__ __forceinline__ void ke_frag_task(const LAS unsigned char* ket, int task, int r, int h, int lane, bf16* kef) {
    const int it = task >> 2, ks = task & 3, dk = 32 * it + r, l0 = 16 * ks + 4 * h;
    const v2u lo = *(const LAS v2u*)(ket + ((size_t)dk * 72 + l0) * 2), hi = *(const LAS v2u*)(ket + ((size_t)dk * 72 + l0 + 8) * 2);
    v4u w; w.x = lo.x; w.y = lo.y; w.z = hi.x; w.w = hi.y;
    *(v4u*)(kef + ((size_t)task * 64 + lane) * 8) = w;
}

__device__ __forceinline__ void la_prep_phase(Frame& F, int l_unused) {
    const int tid0 = opq(F.tid), wv = F.wave;
    LAS unsigned char* L = F.lds + RING_OFF; asm volatile("" : "+v"(L));
    LAS float* Gv = (LAS float*)(L + LA_VEC); LAS float* Bv = Gv + 64;
    LAS float* Mf = (LAS float*)(L + LA_M);
    const f32x16 zero16 = {0.f, 0.f, 0.f, 0.f, 0.f, 0.f, 0.f, 0.f, 0.f, 0.f, 0.f, 0.f, 0.f, 0.f, 0.f, 0.f};
    for (int item = F.vcu; item < 512; item += F.G) {
        const int tid = opq(tid0), lane = tid & 63, r = lane & 31, h = lane >> 5;
        const int seq = item >> 5, ch = item & 31, b = seq >> 2, hd = seq & 3;
        const size_t t0 = (size_t)b * SEQ + ch * 64;
        const float* KN = wsf(F, WS_KN) + t0 * GW + hd * 128; const float* QN = wsf(F, WS_QN) + t0 * GW + hd * 128; const float* VV = wsf(F, WS_VV) + t0 * GW + hd * 128;
        unsigned char* rec = F.ws + WS_FG + (size_t)item * LA_RECG;
        if (wv == 0) { const f32x2v gb = *(const f32x2v*)(wsf(F, WS_GB) + (t0 + lane) * 8 + 2 * hd); Gv[lane] = wave_incl_scan(gb.x, lane); Bv[lane] = gb.y; }
        __syncthreads();
        const float G63 = Gv[63];
        { const int c = tid & 127, lg = tid >> 7;
#pragma unroll 4
          for (int i = 0; i < 16; ++i) { const int l = lg * 16 + i; const float kv = KN[(size_t)l * GW + c], qv = QN[(size_t)l * GW + c], vv = VV[(size_t)l * GW + c];
              const float Gl = Gv[l], bl = Bv[l];
              ((LAS bf16*)(L + LA_KB))[l * 136 + c] = (bf16)f2bf(kv); ((LAS bf16*)(L + LA_QB))[l * 136 + c] = (bf16)f2bf(qv);
              ((LAS bf16*)(L + LA_KGT))[c * 72 + l] = (bf16)f2bf(-kv * bl * __expf(Gl)); ((LAS bf16*)(L + LA_VBT))[c * 72 + l] = (bf16)f2bf(vv * bl);
              ((LAS bf16*)(L + LA_KET))[c * 72 + l] = (bf16)f2bf(kv * __expf(G63 - Gl)); } }
        __syncthreads();
        if (wv < 4) { const int it = wv >> 1, jt = wv & 1; f32x16 acc = zero16;
            if (!(it == 0 && jt == 1)) {
#pragma unroll
                for (int ks = 0; ks < 8; ++ks) acc = MFMA32(lds_frag(L + LA_KB, 32 * it + r, 136, 16 * ks + 8 * h), lds_frag(L + LA_KB, 32 * jt + r, 136, 16 * ks + 8 * h), acc); }
            const int j = 32 * jt + r; const float Gj = Gv[j];
#pragma unroll
            for (int q = 0; q < 16; ++q) { const int i = 32 * it + crow(q, h); Mf[i * 68 + j] = (j < i) ? Bv[i] * acc[q] * __expf(Gv[i] - Gj) : 0.f; }
        } else { const int mt = (wv - 4) >> 1, rt = (wv - 4) & 1; f32x16 acc = zero16;
            if (!(mt == 1 && rt == 0)) {
#pragma unroll
                for (int ks = 0; ks < 8; ++ks) acc = MFMA32(lds_frag(L + LA_KB, 32 * mt + r, 136, 16 * ks + 8 * h), lds_frag(L + LA_QB, 32 * rt + r, 136, 16 * ks + 8 * h), acc); }
            store_qk_frag(acc, Gv, mt, rt, r, h, lane, (bf16*)(rec + LA_QK)); }
        __syncthreads();
#ifndef DBG_NOINV
        if (wv == 0) {
            const int ln = opq(lane);
            float Tc[64];
#pragma unroll
            for (int i = 0; i < 64; ++i) {
                float a0 = (i == ln) ? 1.f : 0.f, a1 = 0.f, a2 = 0.f, a3 = 0.f;
#pragma unroll
                for (int j4 = 0; j4 < (i + 3) / 4; ++j4) { const f32x4 m = *(const LAS f32x4*)(Mf + i * 68 + 4 * j4);
                    a0 -= m.x * Tc[4 * j4]; if (4 * j4 + 1 < i) a1 -= m.y * Tc[4 * j4 + 1]; if (4 * j4 + 2 < i) a2 -= m.z * Tc[4 * j4 + 2]; if (4 * j4 + 3 < i) a3 -= m.w * Tc[4 * j4 + 3]; }
                Tc[i] = (a0 + a1) + (a2 + a3);
                ((LAS bf16*)(L + LA_TB))[i * 72 + ln] = (bf16)f2bf(Tc[i]);
                if ((i & 3) == 3) asm volatile("" ::: "memory");
            }
            if (lane == 0) wsf(F, WS_DLG)[item] = __expf(G63);
        } else
#endif
        {
            for (int task = wv - 1; task < 32; task += 7) {
                if (task < 16) qd_frag_task(QN, GW, Gv, task, r, h, lane, (bf16*)(rec + LA_QD));
                else ke_frag_task(L + LA_KET, task - 16, r, h, lane, (bf16*)(rec + LA_KE)); }
        }
        __syncthreads();
#pragma unroll 1
        for (int tile = wv; tile < 16; tile += 8) {
            f32x16 acc = zero16;
            if (tile < 8) { const int it = tile >> 1, rt = tile & 1;
#pragma unroll
                for (int ks = 0; ks < 4; ++ks) acc = MFMA32(lds_frag(L + LA_KGT, 32 * it + r, 72, 16 * ks + 8 * h), lds_frag(L + LA_TB, 32 * rt + r, 72, 16 * ks + 8 * h), acc);
                bf16* nw = (bf16*)(rec + LA_NW);
                *(bf16x8*)(nw + ((size_t)(rt * 8 + 2 * it + 0) * 64 + lane) * 8) = PACK_STEP(acc, 0);
                *(bf16x8*)(nw + ((size_t)(rt * 8 + 2 * it + 1) * 64 + lane) * 8) = PACK_STEP(acc, 1);
            } else { const int rt = (tile - 8) >> 2, dvt = (tile - 8) & 3;
#pragma unroll
                for (int ks = 0; ks < 4; ++ks) acc = MFMA32(lds_frag(L + LA_TB, 32 * rt + r, 72, 16 * ks + 8 * h), lds_frag(L + LA_VBT, 32 * dvt + r, 72, 16 * ks + 8 * h), acc);
                float* uc = (float*)(rec + LA_UCG) + ((size_t)(dvt * 2 + rt) * 4 * 64 + lane) * 4;
#pragma unroll
                for (int q4 = 0; q4 < 4; ++q4) *(f32x4*)(uc + (size_t)q4 * 256) = (f32x4){acc[4 * q4], acc[4 * q4 + 1], acc[4 * q4 + 2], acc[4 * q4 + 3]};
            }
        }
        __syncthreads();
    }
    for (int item = F.vcu; item < 256; item += F.G) {
        const int tid = opq(tid0), lane = tid & 63, r = lane & 31, h = lane >> 5;
        const int b = item >> 6, ch = (item >> 1) & 31, g = item & 1;
        const size_t t0 = (size_t)b * SEQ + ch * 64;
        const float* BS = wsf(F, WS_BS) + t0 * 256 + g * 128; const float* CS = wsf(F, WS_CS) + t0 * 256 + g * 128;
        { const int c = tid & 127, lg = tid >> 7;
#pragma unroll 4
          for (int i = 0; i < 16; ++i) { const int l = lg * 16 + i;
              ((LAS bf16*)(L + LA_KB))[l * 136 + c] = (bf16)f2bf(BS[(size_t)l * 256 + c]); ((LAS bf16*)(L + LA_QB))[l * 136 + c] = (bf16)f2bf(CS[(size_t)l * 256 + c]); } }
        __syncthreads();
        f32x16 raw = zero16;
        const int mt = (wv >> 1) & 1, rt = wv & 1;
        if (wv < 4 && !(mt == 1 && rt == 0)) {
#pragma unroll
            for (int ks = 0; ks < 8; ++ks) raw = MFMA32(lds_frag(L + LA_KB, 32 * mt + r, 136, 16 * ks + 8 * h), lds_frag(L + LA_QB, 32 * rt + r, 136, 16 * ks + 8 * h), raw); }
#pragma unroll 1
        for (int hi = 0; hi < 4; ++hi) {
            const int hh = 4 * g + hi, seq = b * 8 + hh;
            unsigned char* rec = F.ws + WS_FS + ((size_t)seq * 32 + ch) * LA_RECS;
            if (wv == 0) { const f32x2v ad = *(const f32x2v*)(wsf(F, WS_DT) + (t0 + lane) * 16 + 2 * hh); Gv[lane] = wave_incl_scan(ad.x, lane); Bv[lane] = ad.y; }
            __syncthreads();
            const float G63 = Gv[63];
            { const int c = tid & 127, lg = tid >> 7;
#pragma unroll 4
              for (int i = 0; i < 16; ++i) { const int l = lg * 16 + i; ((LAS bf16*)(L + LA_KET))[c * 72 + l] = (bf16)f2bf(BS[(size_t)l * 256 + c] * __expf(G63 - Gv[l])); } }
            if (wv < 4) store_qk_frag(raw, Gv, mt, rt, r, h, lane, (bf16*)(rec + LA_QK));
            __syncthreads();
            for (int task = wv; task < 36; task += 8) {
                if (task < 16) qd_frag_task(CS, 256, Gv, task, r, h, lane, (bf16*)(rec + LA_QD));
                else if (task < 32) ke_frag_task(L + LA_KET, task - 16, r, h, lane, (bf16*)(rec + LA_KE));
                else { const int sl = (task - 32) >> 1, rt2 = (task - 32) & 1;
                    const float* xs = wsf(F, WS_XS) + t0 * GW + hh * 64 + 32 * sl + r;
                    float* uc = (float*)(rec + LA_UCS) + ((size_t)(sl * 2 + rt2) * 4 * 64 + lane) * 4;
#pragma unroll
                    for (int q4 = 0; q4 < 4; ++q4) { f32x4 v;
#pragma unroll
                        for (int e = 0; e < 4; ++e) { const int l = 32 * rt2 + crow(4 * q4 + e, h); v[e] = xs[(size_t)l * GW] * Bv[l]; }
                        *(f32x4*)(uc + (size_t)q4 * 256) = v; } }
            }
            if (tid == 0) wsf(F, WS_DLS)[seq * 32 + ch] = __expf(G63);
            __syncthreads();
        }
    }
}

template <bool HAS_W> __device__ __forceinline__ void la_seq_wave(LAS unsigned char* ring  , const unsigned char* recs, int recsz, int uc_off, const float* dls, float* outp  , int slice, int lane) {
    constexpr int NFR = HAS_W ? 56 : 40;
    constexpr int SLOT = (NFR + 8) * 1024;
    const int r = lane & 31, h = lane >> 5;
    const float dlv = (lane < 32) ? dls[lane] : 0.f;
    f32x16 S[4];
#pragma unroll
    for (int it = 0; it < 4; ++it)
#pragma unroll
        for (int q = 0; q < 16; ++q) S[it][q] = 0.f;
#define LA_DMA(c_, slot_) do { const unsigned char* rec_ = recs + (size_t)(c_) * recsz + lane * 16; LAS unsigned char* dst_ = ring + (slot_) * SLOT; \
        _Pragma("unroll") for (int i_ = 0; i_ < NFR; ++i_) __builtin_amdgcn_global_load_lds((const unsigned*)(rec_ + i_ * 1024), (LAS unsigned*)(dst_ + i_ * 1024), 16, 0, 0); \
        _Pragma("unroll") for (int i_ = 0; i_ < 8; ++i_) __builtin_amdgcn_global_load_lds((const unsigned*)(rec_ + uc_off + slice * 8192 + i_ * 1024), (LAS unsigned*)(dst_ + (NFR + i_) * 1024), 16, 0, 0); } while (0)
    LA_DMA(0, 0);
#pragma unroll 1
    for (int c = 0; c < 32; ++c) {
        asm volatile("s_waitcnt vmcnt(0) lgkmcnt(0)" ::: "memory");
        if (c + 1 < 32) LA_DMA(c + 1, (c + 1) & 1);
        const LAS unsigned char* B = ring + (c & 1) * SLOT + lane * 16;
#define FRAG(off, idx) (*(const LAS bf16x8*)(B + (off) + (idx) * 1024))
        bf16x8 sb[8];
#pragma unroll
        for (int it = 0; it < 4; ++it) { sb[2 * it] = PACK_STEP(S[it], 0); sb[2 * it + 1] = PACK_STEP(S[it], 1); }
        f32x16 Vn[2];
#pragma unroll
        for (int rt = 0; rt < 2; ++rt)
#pragma unroll
            for (int q4 = 0; q4 < 4; ++q4) { const f32x4 v = *(const LAS f32x4*)(B + NFR * 1024 + (rt * 4 + q4) * 1024); Vn[rt][4 * q4] = v.x; Vn[rt][4 * q4 + 1] = v.y; Vn[rt][4 * q4 + 2] = v.z; Vn[rt][4 * q4 + 3] = v.w; }
        if (HAS_W) {
#pragma unroll
            for (int ks = 0; ks < 8; ++ks) { Vn[0] = MFMA32(FRAG(LA_NW, 0 * 8 + ks), sb[ks], Vn[0]); Vn[1] = MFMA32(FRAG(LA_NW, 1 * 8 + ks), sb[ks], Vn[1]); } }
        bf16x8 vb[4];
#pragma unroll
        for (int rt = 0; rt < 2; ++rt) { vb[2 * rt] = PACK_STEP(Vn[rt], 0); vb[2 * rt + 1] = PACK_STEP(Vn[rt], 1); }
        f32x16 O[2];
#pragma unroll
        for (int rt = 0; rt < 2; ++rt)
#pragma unroll
            for (int q = 0; q < 16; ++q) O[rt][q] = 0.f;
#pragma unroll
        for (int ks = 0; ks < 8; ++ks) { O[0] = MFMA32(FRAG(LA_QD, 0 * 8 + ks), sb[ks], O[0]); O[1] = MFMA32(FRAG(LA_QD, 1 * 8 + ks), sb[ks], O[1]); }
#pragma unroll
        for (int ks = 0; ks < 4; ++ks) { O[0] = MFMA32(FRAG(LA_QK, 0 * 4 + ks), vb[ks], O[0]); O[1] = MFMA32(FRAG(LA_QK, 1 * 4 + ks), vb[ks], O[1]); }
        float* op = outp + (size_t)c * 64 * GW + r;
#pragma unroll
        for (int rt = 0; rt < 2; ++rt)
#pragma unroll
            for (int q = 0; q < 16; ++q) op[(size_t)(32 * rt + crow(q, h)) * GW] = O[rt][q];
        const float dl = __builtin_bit_cast(float, __builtin_amdgcn_readlane(__builtin_bit_cast(int, dlv), c));
#pragma unroll
        for (int it = 0; it < 4; ++it) {
#pragma unroll
            for (int q = 0; q < 16; ++q) S[it][q] *= dl;
#pragma unroll
            for (int ks = 0; ks < 4; ++ks) S[it] = MFMA32(FRAG(LA_KE, it * 4 + ks), vb[ks], S[it]);
        }
#undef FRAG
    }
#undef LA_DMA
    asm volatile("s_waitcnt vmcnt(0) lgkmcnt(0)" ::: "memory");
}
__device__ __forceinline__ void la_seq_phase(Frame& F, int l_unused) {
    const int lane = opq(F.lane);
    if (F.wave != 0) return;
#ifndef DBG_NOSEQ
    for (int item = F.vcu; item < 128; item += F.G) {
        if (item < 64) { const int seq = item >> 2, slice = item & 3, b = seq >> 2, hd = seq & 3;
            la_seq_wave<true>(F.lds + RING_OFF, F.ws + WS_FG + (size_t)seq * 32 * LA_RECG, LA_RECG, LA_UCG, wsf(F, WS_DLG) + seq * 32, wsf(F, WS_OG) + (size_t)b * SEQ * GW + hd * 128 + slice * 32, slice, lane);
        } else { const int j = item - 64, seq = j >> 1, slice = j & 1, b = seq >> 3, hh = seq & 7;
            la_seq_wave<false>(F.lds + RING_OFF, F.ws + WS_FS + (size_t)seq * 32 * LA_RECS, LA_RECS, LA_UCS, wsf(F, WS_DLS) + seq * 32, wsf(F, WS_YS) + (size_t)b * SEQ * GW + hh * 64 + slice * 32, slice, lane);
        }
    }
#endif
}

__device__ __forceinline__ void mixer_post_phase(Frame& F, int l) {
    const int gw = F.vcu * NWAVES + F.wave, NGW = F.G * NWAVES, lane = opq(F.lane), c = lane * 8;
    bf16* MIX = wsb(F, WS_MIX);
    const float* gng = inp(I_GNG) + (size_t)l * 128 + (c & 127); const float* sng = inp(I_SNG) + (size_t)l * GW + c;
    const f32x4 g0 = ld4(gng), g1 = ld4(gng + 4), n0 = ld4(sng), n1 = ld4(sng + 4);
    const float Dk = inp(I_SD)[l * 8 + (c >> 6)];
    for (int m = gw; m < M; m += NGW) {
        {
            const float* og = wsf(F, WS_OG) + (size_t)m * GW + c; const float* z = wsf(F, WS_ZG) + (size_t)m * GW + c;
            const f32x4 o0 = ld4(og), o1 = ld4(og + 4), z0 = ld4(z), z1 = ld4(z + 4);
            float ss = (o0.x * o0.x + o0.y * o0.y) + (o0.z * o0.z + o0.w * o0.w) + (o1.x * o1.x + o1.y * o1.y) + (o1.z * o1.z + o1.w * o1.w);
            ss += __shfl_xor(ss, 1); ss += __shfl_xor(ss, 2); ss += __shfl_xor(ss, 4); ss += __shfl_xor(ss, 8);
            const float rstd = 1.0f / sqrtf(ss * (1.0f / 128.0f) + EPS);
            const f32x4 y0 = o0 * rstd * g0 * silu4(z0), y1 = o1 * rstd * g1 * silu4(z1);
            v4u w; w.x = pk2(y0.x, y0.y); w.y = pk2(y0.z, y0.w); w.z = pk2(y1.x, y1.y); w.w = pk2(y1.z, y1.w);
            *(v4u*)(MIX + (size_t)m * DM + 2 * GW + c) = w;
        }
        {
            const float* ys = wsf(F, WS_YS) + (size_t)m * GW + c; const float* xs = wsf(F, WS_XS) + (size_t)m * GW + c; const float* z = wsf(F, WS_ZS) + (size_t)m * GW + c;
            const f32x4 a0 = (ld4(ys) + ld4(xs) * Dk) * silu4(ld4(z)), a1 = (ld4(ys + 4) + ld4(xs + 4) * Dk) * silu4(ld4(z + 4));
            float ss = (a0.x * a0.x + a0.y * a0.y) + (a0.z * a0.z + a0.w * a0.w) + (a1.x * a1.x + a1.y * a1.y) + (a1.z * a1.z + a1.w * a1.w);
            ss += __shfl_xor(ss, 1); ss += __shfl_xor(ss, 2); ss += __shfl_xor(ss, 4); ss += __shfl_xor(ss, 8); ss += __shfl_xor(ss, 16);
            const float rstd = 1.0f / sqrtf(ss * (1.0f / 256.0f) + EPS);
            const f32x4 y0 = a0 * rstd * n0, y1 = a1 * rstd * n1;
            v4u w; w.x = pk2(y0.x, y0.y); w.y = pk2(y0.z, y0.w); w.z = pk2(y1.x, y1.y); w.w = pk2(y1.z, y1.w);
            *(v4u*)(MIX + (size_t)m * DM + 3 * GW + c) = w;
        }
    }
}

__device__ __forceinline__ void attn_phase(Frame& F, int l) {
    const int lane = opq(F.lane), fr = lane & 15, fq = lane >> 4;
    const bf16* Q = wsb(F, WS_Q); const bf16* KB = wsb(F, WS_KB) + (size_t)l * MROWS * DM; const bf16* VT = wsb(F, WS_VT) + (size_t)l * DM * MROWS; bf16* O = wsb(F, WS_MIX);
    for (int unit = F.vcu; unit < BATCH * XH * (SEQ / 128); unit += F.G) {
        const int b = unit >> 6, h = (unit >> 4) & 3, qt = unit & 15;
        const int qrow0 = b * SEQ + qt * 128 + F.wave * 16;
        const bf16* qp = Q + (size_t)(qrow0 + fr) * DM + h * XHD + fq * 8;
        const bf16* kp = KB + (size_t)(b * MEML + fr) * DM + h * XHD + fq * 8;
        f32x4 acc[16];
#pragma unroll
        for (int n = 0; n < 16; ++n) acc[n] = (f32x4){0.f, 0.f, 0.f, 0.f};
        for (int ks = 0; ks < 16; ++ks) {
            const bf16x8 qf = *(const bf16x8*)(qp + ks * 32);
#pragma unroll
            for (int n = 0; n < 16; ++n) { const bf16x8 kf = *(const bf16x8*)(kp + (size_t)n * 16 * DM + ks * 32);
                acc[n] = __builtin_amdgcn_mfma_f32_16x16x32_bf16(kf, qf, acc[n], 0, 0, 0); }
        }
        float mx = -3.0e38f;
#pragma unroll
        for (int n = 0; n < 16; ++n) mx = fmaxf(fmaxf(fmaxf(acc[n].x, acc[n].y), fmaxf(acc[n].z, acc[n].w)), mx);
        mx = fmaxf(mx, __shfl_xor(mx, 16)); mx = fmaxf(mx, __shfl_xor(mx, 32));
        float sum = 0.f;
#pragma unroll
        for (int n = 0; n < 16; ++n) { acc[n].x = __expf(acc[n].x - mx); acc[n].y = __expf(acc[n].y - mx); acc[n].z = __expf(acc[n].z - mx); acc[n].w = __expf(acc[n].w - mx);
            sum += (acc[n].x + acc[n].y) + (acc[n].z + acc[n].w); }
        sum += __shfl_xor(sum, 16); sum += __shfl_xor(sum, 32);
        const float linv = 1.0f / sum;
        bf16x8 pf[8];
#pragma unroll
        for (int s = 0; s < 8; ++s) { v4u w; w.x = pk2(acc[2 * s].x, acc[2 * s].y); w.y = pk2(acc[2 * s].z, acc[2 * s].w); w.z = pk2(acc[2 * s + 1].x, acc[2 * s + 1].y); w.w = pk2(acc[2 * s + 1].z, acc[2 * s + 1].w);
            pf[s] = __builtin_bit_cast(bf16x8, w); }
        float lv[4];
#pragma unroll
        for (int r = 0; r < 4; ++r) lv[r] = __shfl(linv, 4 * fq + r);
        const bf16* vp = VT + (size_t)(h * XHD + fr) * MROWS + b * MEML + 4 * fq;
        bf16* op = O + (size_t)(qrow0 + 4 * fq) * DM + h * XHD + fr;
#pragma unroll 2
        for (int dt = 0; dt < 32; ++dt) {
            f32x4 oa = (f32x4){0.f, 0.f, 0.f, 0.f};
#pragma unroll
            for (int s = 0; s < 8; ++s) { const bf16* vv = vp + (size_t)dt * 16 * MROWS + s * 32;
                v4u w; const v2u lo = *(const v2u*)vv, hi = *(const v2u*)(vv + 16); w.x = lo.x; w.y = lo.y; w.z = hi.x; w.w = hi.y;
                oa = __builtin_amdgcn_mfma_f32_16x16x32_bf16(pf[s], __builtin_bit_cast(bf16x8, w), oa, 0, 0, 0); }
            op[(size_t)0 * DM + dt * 16] = (bf16)f2bf(oa.x * lv[0]); op[(size_t)1 * DM + dt * 16] = (bf16)f2bf(oa.y * lv[1]);
            op[(size_t)2 * DM + dt * 16] = (bf16)f2bf(oa.z * lv[2]); op[(size_t)3 * DM + dt * 16] = (bf16)f2bf(oa.w * lv[3]);
        }
    }
}

#ifndef SKIPM
#define SKIPM 0
#endif
#ifndef REPM
#define REPM 0
#endif
#ifndef PROBE_PH
#define PROBE_PH -1
#endif
constexpr int PH_PER_LAYER = 14, N_PHASES = 2 + DEPTH * PH_PER_LAYER;
struct Args { const float* in[N_IN]; float* out; unsigned char* ws; int ph_lo, ph_hi; };
static_assert(sizeof(Args) == (N_IN + 2) * 8 + 8, "Args has no padding");
struct GemmDesc { const bf16* A; const bf16* Bt; void* C; int M, N, K, ldc, mode, corder; float scale; };
__device__ __forceinline__ void gemm_desc(const Frame& F, int ph, int sub, GemmDesc& d) {
    const int bx = (int)blockIdx.x;
    d.scale = 1.0f; d.corder = bx;
    if (ph == 1) {
        const int l = sub >> 1; const bf16* wkv = (const bf16*)(F.ws + WS_W + (size_t)l * W_LAYER + WO_WKV); const bf16* memn = wsb(F, WS_MEMN) + (size_t)l * MROWS * DM;
        d.corder = (bx + F.G - 32 * sub) % F.G; d.mode = 1; d.K = DM;
        if ((sub & 1) == 0) { d.A = memn; d.Bt = wkv; d.M = MROWS; d.N = DM; d.C = wsb(F, WS_KB) + (size_t)l * MROWS * DM; d.ldc = DM; }
        else { d.A = wkv + (size_t)DM * DM; d.Bt = memn; d.M = DM; d.N = MROWS; d.C = wsb(F, WS_VT) + (size_t)l * DM * MROWS; d.ldc = MROWS; }
        return;
    }
    const int l = (ph - 2) / PH_PER_LAYER, k = (ph - 2) % PH_PER_LAYER;
    const unsigned char* wl = F.ws + WS_W + (size_t)l * W_LAYER;
    d.M = M; d.K = DM; d.N = DM; d.ldc = DM; d.mode = 0; d.A = wsb(F, WS_XN); d.C = wsf(F, WS_Y);
    if (k == 0) { d.Bt = (const bf16*)(wl + WO_WIN); d.N = IN_PAD; d.C = wsf(F, WS_U); d.ldc = IN_PAD; }
    else if (k == 5) { d.A = wsb(F, WS_MIX); d.Bt = (const bf16*)(wl + WO_WOUT); }
    else if (k == 7) { d.Bt = (const bf16*)(wl + WO_WQ); d.mode = 1; d.C = wsb(F, WS_Q); d.scale = 0.044194173824159216f; }
    else if (k == 9) { d.A = wsb(F, WS_MIX); d.Bt = (const bf16*)(wl + WO_WO); }
    else if (k == 11) { d.Bt = (const bf16*)(wl + WO_WGU); d.N = 2 * DFF; d.mode = 2; d.C = wsb(F, WS_HID); d.ldc = DFF; }
    else { d.A = wsb(F, WS_HID); d.Bt = (const bf16*)(wl + WO_WD); d.K = DFF; }
}

__global__ void __launch_bounds__(NWAVES * 64, 2) fwd_kernel(Args args) {
    extern __shared__ __attribute__((aligned(16))) unsigned char lds[];
    Frame F;
    F.lds = (LAS unsigned char*)lds;
    F.MISC = (volatile LAS unsigned*)(F.lds + MISC_OFF);
    F.tid = threadIdx.x; F.lane = F.tid & 63; F.wave = __builtin_amdgcn_readfirstlane(F.tid >> 6);
    F.G = gridDim.x; { const int bx = blockIdx.x; F.vcu = (F.G % 8 == 0) ? (bx % 8) * (F.G / 8) + bx / 8 : bx; }
    F.ws = args.ws; F.out = args.out; F.ctl = (unsigned*)(args.ws + WS_CTL);
    for (int u = F.tid; u < (LDS_BYTES - LDSCTL_OFF) / 4; u += NWAVES * 64) ((LAS unsigned*)(F.lds + LDSCTL_OFF))[u] = 0u;
    __syncthreads();
    const int lo = args.ph_lo, hi = args.ph_hi;
    XcdBarrier bar; bar.bar = F.ctl + CW_BAR; bar.x = 0; bar.st = nullptr;
    if (hi - lo > 1) bar = xcd_barrier_post(F.ctl + CW_BAR, F.MISC + 8);
    LAS unsigned char* ring = F.lds + RING_OFF;
    unsigned long long t_start = 0, t_probe = 0;
    if (PROBE_PH >= 0) t_start = __builtin_amdgcn_s_memrealtime();
#pragma unroll 1
    for (int ph = lo; ph < hi; ++ph) {
        const int l = ph >= 2 ? (ph - 2) / PH_PER_LAYER : 0, k = ph >= 2 ? (ph - 2) % PH_PER_LAYER : -1;
        const bool is_gemm = (ph == 1) || k == 0 || k == 5 || k == 7 || k == 9 || k == 11 || k == 12;
        const int kbit = (ph < 2) ? ph : (k + 2);
        const int reps = 1 + ((REPM >> kbit) & 1);
#pragma unroll 1
        for (int rep = 0; rep < reps; ++rep) {
        if (is_gemm) {
            const int nsub = (ph == 1) ? 2 * DEPTH : 1;
#pragma unroll 1
            for (int sub = 0; sub < nsub; ++sub) {
                GemmDesc d; gemm_desc(F, ph, sub, d);
                pg8::Gemm g{d.A, d.Bt, d.M, d.N, d.K}; pg8::StaticOrder S; S.init(d.M, d.N, F.G, d.corder);
                pg8::EpiAny E{d.C, d.ldc, d.mode, d.scale};
                pg8::gemm_phase<pg8::EpiAny, pg8::StaticOrder, false, false>(ring, g, S, E);
            }
        } else if (ph == 0) { p0_prologue(F); }
        else {
            const float* ng = inp(I_NORMG) + (size_t)l * N_NORMS * DM;
            if (k == 1) mixer_prep_phase(F, l);
            else if (k == 2) la_prep_phase(F, l);
            else if (k == 3) la_seq_phase(F, l);
            else if (k == 4) mixer_post_phase(F, l);
            else if (k == 8) attn_phase(F, l);
            else if (rep == 0) {
                if (k == 6) resnorm_phase(F, l == 0 ? inp(I_X) : F.out, ng + MIX_POST * DM, ng + XA_PRE * DM);
                else if (k == 10) resnorm_phase(F, F.out, ng + XA_POST * DM, ng + FFN_PRE * DM);
                else resnorm_phase(F, F.out, ng + FFN_POST * DM, (l + 1 < DEPTH) ? ng + (N_NORMS + MIX_PRE) * DM : nullptr);
            }
        }
        if (REPM >> 20) { if (rep + 1 < reps) __syncthreads(); }
        }
        if ((REPM >> 21) & 1) xcd_barrier(bar);
        if (ph + 1 < hi) xcd_barrier(bar);
        if (PROBE_PH >= 0 && ph == PROBE_PH) t_probe = __builtin_amdgcn_s_memrealtime();
    }
    if (PROBE_PH >= 0 && blockIdx.x == 0) {
        const unsigned long long t_end = __builtin_amdgcn_s_memrealtime();
        while (__builtin_amdgcn_s_memrealtime() - t_end < t_probe - t_start) __builtin_amdgcn_s_sleep(8);
    }
}

#ifndef MK_SINGLE
#define MK_SINGLE 0
#endif
extern "C" void kernel_launch(void* const* d_in, const int* in_sizes, int n_in, void* d_out, int out_size, void* d_ws, size_t ws_size, hipStream_t stream) {
    static int grid = 0;
    if (grid == 0) {
        if (n_in != N_IN || in_sizes[0] != M * DM || out_size != M * DM || ws_size < WS_END) { fprintf(stderr, "kernel_launch: unexpected problem (n_in %d, in0 %d, out %d, ws %zu < %zu)\n", n_in, n_in > 0 ? in_sizes[0] : -1, out_size, ws_size, (size_t)WS_END); grid = -1; return; }
        int dev = 0, cus = 0, per_cu = 0;
        if (hipGetDevice(&dev) != hipSuccess || hipDeviceGetAttribute(&cus, hipDeviceAttributeMultiprocessorCount, dev) != hipSuccess) { grid = -1; return; }
        if (hipFuncSetAttribute((const void*)fwd_kernel, hipFuncAttributeMaxDynamicSharedMemorySize, LDS_BYTES) != hipSuccess) { fprintf(stderr, "kernel_launch: hipFuncSetAttribute failed\n"); grid = -1; return; }
        if (hipOccupancyMaxActiveBlocksPerMultiprocessor(&per_cu, (const void*)fwd_kernel, NWAVES * 64, LDS_BYTES) != hipSuccess || per_cu < 1) { fprintf(stderr, "kernel_launch: occupancy query says %d blocks per CU\n", per_cu); per_cu = 1; }
        (void)hipGetLastError();
        grid = cus * (per_cu < 1 ? 1 : 1);
        if (grid != 256) fprintf(stderr, "kernel_launch: note: grid %d (expected 256)\n", grid);
    }
    if (grid < 0) return;
    if (hipMemsetAsync((char*)d_ws + WS_CTL, 0, CTL_ZERO_BYTES, stream) != hipSuccess) { fprintf(stderr, "kernel_launch: memset failed\n"); return; }
    Args a{};
    for (int i = 0; i < N_IN; ++i) a.in[i] = (const float*)d_in[i];
    a.out = (float*)d_out; a.ws = (unsigned char*)d_ws;
#if MK_SINGLE
    a.ph_lo = 0; a.ph_hi = N_PHASES;
    void* kargs[] = {&a};
    hipError_t e = hipLaunchCooperativeKernel((const void*)fwd_kernel, dim3(grid), dim3(NWAVES * 64), kargs, LDS_BYTES, stream);
    if (e != hipSuccess) fprintf(stderr, "kernel_launch: cooperative launch failed: %s (grid %d)\n", hipGetErrorString(e), grid);
#else
    for (int p = 0; p < N_PHASES; ++p) { a.ph_lo = p; a.ph_hi = p + 1;
        hipLaunchKernelGGL(fwd_kernel, dim3(grid), dim3(NWAVES * 64), LDS_BYTES, stream, a);
        const hipError_t le = hipPeekAtLastError(); if (le != hipSuccess) { fprintf(stderr, "kernel_launch: launch %d failed: %s\n", p, hipGetErrorName(le)); break; } }
#endif
}
```

```cpp
#include <hip/hip_runtime.h>
#include <cstdio>
#include <cstdint>
#define MK_SINGLE 1
namespace pg8 {
#define PG8_LAS __attribute__((address_space(3)))
typedef unsigned short bf16_t;
typedef short bf16x8 __attribute__((ext_vector_type(8)));
typedef float f32x4 __attribute__((ext_vector_type(4)));
typedef unsigned u32x4 __attribute__((ext_vector_type(4)));
constexpr int BM = 256, BK = 64, HALF = 128, HTB = HALF * BK * 2  , STAGE_BYTES = 8 * HTB, NXCD = 8, WGM = 8;

__host__ __device__ __forceinline__ int lds_byte(int r, int c) { const int st = (r >> 4) * 2 + (c >> 5), rr = r & 15, cc = c & 31, ob = rr * 64 + cc * 2; return st * 1024 + (ob ^ (((ob >> 9) & 1) << 5)); }
__host__ __device__ __forceinline__ void stage_rc(int b, int& R, int& C) { const int st = b / 1024, sb = b % 1024, swz = sb ^ (((sb >> 9) & 1) << 5); R = (st >> 1) * 16 + swz / 64; C = (st & 1) * 32 + (swz % 64) / 2; }
__host__ __device__ __forceinline__ int perm32(int rho) { const int n = rho >> 4, i = rho & 15; return 8 * (i >> 2) + 4 * n + (i & 3); }

struct Unit { int pm, pn; };
struct Gemm { const bf16_t* A; const bf16_t* Bt; int M, N, K, lda, ldb; };

struct StaticOrder {
    int nM, nN, nwg, G, c;
    __host__ __device__ void init(int M, int N, int G_, int c_) { nM = M / BM; nN = N / BM; nwg = nM * nN; G = G_; c = c_; }
    __host__ __device__ bool next(int i, Unit& u) const {
        const long L = (long)i * G + c; if (L >= nwg) return false;
        int wgid = (int)L; { const int q = nwg / NXCD, r = nwg % NXCD, xcd = wgid % NXCD, off = wgid / NXCD; wgid = (xcd < r ? xcd * (q + 1) : r * (q + 1) + (xcd - r) * q) + off; }
        const int nig = WGM * nN, gid = wgid / nig, fm = gid * WGM, gsz = (nM - fm) < WGM ? (nM - fm) : WGM;
        u.pm = fm + ((wgid % nig) % gsz); u.pn = (wgid % nig) / gsz; return true;
    }
    __device__ __forceinline__ void a_ready(const Unit&) const {}
    __device__ __forceinline__ void done(const Unit&) const {}
};

__device__ __forceinline__ unsigned cvt_pk_bf16(float lo, float hi) { unsigned r; asm volatile("v_cvt_pk_bf16_f32 %0, %1, %2" : "=v"(r) : "v"(lo), "v"(hi)); return r; }
struct EpiF32 {
    static constexpr bool PERM = false, AFTER_DRAIN = false;
    float* C; int ldc;
    __device__ __forceinline__ void operator()(const f32x4 (&acc)[2][2][4][2], const Unit& u, int wr, int wc, int fr, int fq) const {
        const int row0 = u.pm * BM + wr * 64 + fr, col0 = u.pn * BM + wc * 32 + 4 * fq;
#pragma unroll
        for (int ai = 0; ai < 2; ++ai)
#pragma unroll
            for (int m = 0; m < 4; ++m) { float* rowp = C + (size_t)(row0 + ai * HALF + m * 16) * ldc + col0;
#pragma unroll
                for (int bj = 0; bj < 2; ++bj)
#pragma unroll
                    for (int n = 0; n < 2; ++n) *(f32x4*)(rowp + bj * HALF + n * 16) = acc[ai][bj][m][n]; }
    }
};
struct EpiBf16S {
    static constexpr bool PERM = true, AFTER_DRAIN = false;
    bf16_t* O; int ldc; float scale;
    __device__ __forceinline__ void operator()(const f32x4 (&acc)[2][2][4][2], const Unit& u, int wr, int wc, int fr, int fq) const {
        const int row0 = u.pm * BM + wr * 64 + fr, col0 = u.pn * BM + wc * 32 + 8 * fq; const float sc = scale;
#pragma unroll
        for (int ai = 0; ai < 2; ++ai)
#pragma unroll
            for (int m = 0; m < 4; ++m) { bf16_t* rowp = O + (size_t)(row0 + ai * HALF + m * 16) * ldc + col0;
#pragma unroll
                for (int bj = 0; bj < 2; ++bj) { const f32x4 v0 = acc[ai][bj][m][0] * sc, v1 = acc[ai][bj][m][1] * sc;
                    u32x4 w; w.x = cvt_pk_bf16(v0[0], v0[1]); w.y = cvt_pk_bf16(v0[2], v0[3]); w.z = cvt_pk_bf16(v1[0], v1[1]); w.w = cvt_pk_bf16(v1[2], v1[3]);
                    *(u32x4*)(rowp + bj * HALF) = w; } }
    }
};
__device__ __forceinline__ float silu_f(float v) { return v / (1.0f + __expf(-v)); }
struct EpiSwiGLU {
    static constexpr bool PERM = true, AFTER_DRAIN = false;
    bf16_t* O; int ldc;
    __device__ __forceinline__ void operator()(const f32x4 (&acc)[2][2][4][2], const Unit& u, int wr, int wc, int fr, int fq) const {
        const int row0 = u.pm * BM + wr * 64 + fr, col0 = u.pn * HALF + wc * 32 + 8 * fq;
#pragma unroll
        for (int ai = 0; ai < 2; ++ai)
#pragma unroll
            for (int m = 0; m < 4; ++m) { bf16_t* rowp = O + (size_t)(row0 + ai * HALF + m * 16) * ldc + col0;
                const f32x4 g0 = acc[ai][0][m][0], g1 = acc[ai][0][m][1], u0 = acc[ai][1][m][0], u1 = acc[ai][1][m][1];
                u32x4 w; w.x = cvt_pk_bf16(silu_f(g0[0]) * u0[0], silu_f(g0[1]) * u0[1]); w.y = cvt_pk_bf16(silu_f(g0[2]) * u0[2], silu_f(g0[3]) * u0[3]);
                w.z = cvt_pk_bf16(silu_f(g1[0]) * u1[0], silu_f(g1[1]) * u1[1]); w.w = cvt_pk_bf16(silu_f(g1[2]) * u1[2], silu_f(g1[3]) * u1[3]);
                *(u32x4*)rowp = w; }
    }
};
struct EpiAny {
    static constexpr bool PERM = false, AFTER_DRAIN = false, RT_DRAIN = true;
    void* C; int ldc; int mode; float scale;
    __device__ __forceinline__ bool perm() const { return mode != 0; }
    __device__ __forceinline__ bool drain() const { return mode == 3; }
    __device__ __forceinline__ void operator()(const f32x4 (&acc)[2][2][4][2], const Unit& u, int wr, int wc, int fr, int fq) const {
        if (mode == 0) { EpiF32 e{(float*)C, ldc}; e(acc, u, wr, wc, fr, fq); }
        else if (mode == 1) { EpiBf16S e{(bf16_t*)C, ldc, scale}; e(acc, u, wr, wc, fr, fq); }
        else if (mode == 2) { EpiSwiGLU e{(bf16_t*)C, ldc}; e(acc, u, wr, wc, fr, fq); }
    }
    __device__ __forceinline__ void fused(f32x4 (&acc)[2][2][4][2], const Unit& u, int wr, int wc, int fr, int fq, PG8_LAS unsigned char* lds, int wid, int lane) const {
        PG8_LAS float* Pm = (PG8_LAS float*)lds;
        PG8_LAS float* Ps = (PG8_LAS float*)(lds + 4096);
#pragma unroll
        for (int ai = 0; ai < 2; ++ai)
#pragma unroll
            for (int m = 0; m < 4; ++m) { float mx = -3.0e38f;
#pragma unroll
                for (int bj = 0; bj < 2; ++bj)
#pragma unroll
                    for (int n = 0; n < 2; ++n) { const f32x4 x = acc[ai][bj][m][n]; mx = fmaxf(mx, fmaxf(fmaxf(x[0], x[1]), fmaxf(x[2], x[3]))); }
                mx = fmaxf(mx, __shfl_xor(mx, 16)); mx = fmaxf(mx, __shfl_xor(mx, 32));
                if (fq == 0) Pm[(ai * HALF + wr * 64 + m * 16 + fr) * 4 + wc] = mx; }
        asm volatile("s_waitcnt lgkmcnt(0)" ::: "memory"); __builtin_amdgcn_s_barrier(); asm volatile("" ::: "memory");
#pragma unroll
        for (int ai = 0; ai < 2; ++ai)
#pragma unroll
            for (int m = 0; m < 4; ++m) { const int row = ai * HALF + wr * 64 + m * 16 + fr; const f32x4 pm = *(const PG8_LAS f32x4*)(Pm + row * 4);
                const float mx = fmaxf(fmaxf(pm[0], pm[1]), fmaxf(pm[2], pm[3])); float sm = 0.f;
#pragma unroll
                for (int bj = 0; bj < 2; ++bj)
#pragma unroll
                    for (int n = 0; n < 2; ++n) { f32x4 x = acc[ai][bj][m][n]; x[0] = __expf(x[0] - mx); x[1] = __expf(x[1] - mx); x[2] = __expf(x[2] - mx); x[3] = __expf(x[3] - mx);
                        acc[ai][bj][m][n] = x; sm += (x[0] + x[1]) + (x[2] + x[3]); }
                sm += __shfl_xor(sm, 16); sm += __shfl_xor(sm, 32);
                if (fq == 0) Ps[row * 4 + wc] = sm; }
        asm volatile("s_waitcnt lgkmcnt(0)" ::: "memory"); __builtin_amdgcn_s_barrier(); asm volatile("" ::: "memory");
        const int row0 = u.pm * BM + wr * 64 + fr, col0 = u.pn * BM + wc * 32 + 8 * fq;
#pragma unroll
        for (int ai = 0; ai < 2; ++ai)
#pragma unroll
            for (int m = 0; m < 4; ++m) { const int row = ai * HALF + wr * 64 + m * 16 + fr; const f32x4 ps = *(const PG8_LAS f32x4*)(Ps + row * 4);
                const float inv = 1.0f / ((ps[0] + ps[1]) + (ps[2] + ps[3]));
                bf16_t* rowp = (bf16_t*)C + (size_t)(row0 + ai * HALF + m * 16) * ldc + col0;
#pragma unroll
                for (int bj = 0; bj < 2; ++bj) { const f32x4 v0 = acc[ai][bj][m][0] * inv, v1 = acc[ai][bj][m][1] * inv;
                    u32x4 w; w.x = cvt_pk_bf16(v0[0], v0[1]); w.y = cvt_pk_bf16(v0[2], v0[3]); w.z = cvt_pk_bf16(v1[0], v1[1]); w.w = cvt_pk_bf16(v1[2], v1[3]);
                    *(u32x4*)(rowp + bj * HALF) = w; } }
    }
};
template <class Epi, class Sched, bool ALIGN_EPI = false, bool SP2 = false>
__device__ __forceinline__ void gemm_phase(PG8_LAS unsigned char* lds, const Gemm g, const Sched& S, const Epi& E) {
    int tid_ = threadIdx.x; asm volatile("" : "+v"(tid_));
    const int tid = tid_, wid = __builtin_amdgcn_readfirstlane(tid >> 6), lane = tid & 63, wr = wid >> 2, wc = wid & 3, fr = lane & 15, fq = lane >> 4;
    const int K = g.K, nt = K / BK;
    unsigned voffA[2], voffB[2];
#pragma unroll
    for (int i = 0; i < 2; ++i) { int R, C; stage_rc(tid * 16 + i * 8192, R, C); const int Rb = E.perm() ? ((R & ~31) + perm32(R & 31)) : R;
        voffA[i] = (unsigned)(R * g.lda + C) * 2u; voffB[i] = (unsigned)(Rb * g.ldb + C) * 2u; }
    const size_t kstep = (size_t)(BK * 2);
    const size_t hstepA = (size_t)HALF * g.lda * 2, hstepB = (size_t)HALF * g.ldb * 2;
    const size_t tstepA = 2 * hstepA, tstepB = 2 * hstepB;
    const unsigned ldsw = (unsigned)wid * 1024u;
    const int aoff = lds_byte(wr * 64 + fr, fq * 8), boff = lds_byte(wc * 32 + fr, fq * 8);
#define PG8_SA(b, h) (((b) * 2 + (h)) * HTB)
#define PG8_SB(b, h) ((4 + (b) * 2 + (h)) * HTB)
#define PG8_STAGE(bufoff, gbase, voff) do { _Pragma("unroll") for (int _i = 0; _i < 2; ++_i) \
        __builtin_amdgcn_global_load_lds((const unsigned*)((const char*)(gbase) + (voff)[_i]), (PG8_LAS unsigned*)(lds + (bufoff) + ldsw + _i * 8192), 16, 0, 0); } while (0)
#define PG8_LDA(dst, b, h) do { _Pragma("unroll") for (int m = 0; m < 4; ++m) _Pragma("unroll") for (int k = 0; k < 2; ++k) dst[m][k] = *(const PG8_LAS bf16x8*)(lds + PG8_SA(b, h) + aoff + m * 2048 + k * 1024); } while (0)
#define PG8_LDB(dst, b, h) do { _Pragma("unroll") for (int n = 0; n < 2; ++n) _Pragma("unroll") for (int k = 0; k < 2; ++k) dst[n][k] = *(const PG8_LAS bf16x8*)(lds + PG8_SB(b, h) + boff + n * 2048 + k * 1024); } while (0)
#define PG8_MMA(ai, bj, At, Bt) do { __builtin_amdgcn_s_setprio(1); _Pragma("unroll") for (int m = 0; m < 4; ++m) _Pragma("unroll") for (int n = 0; n < 2; ++n) _Pragma("unroll") for (int k = 0; k < 2; ++k) \
        acc[ai][bj][m][n] = __builtin_amdgcn_mfma_f32_16x16x32_bf16(Bt[n][k], At[m][k], acc[ai][bj][m][n], 0, 0, 0); __builtin_amdgcn_s_setprio(0); } while (0)
#define PG8_WAIT_V(n) asm volatile("s_waitcnt vmcnt(" #n ")" ::: "memory")
#define PG8_WAIT_L(n) asm volatile("s_waitcnt lgkmcnt(" #n ")" ::: "memory")
#define PG8_BAR __builtin_amdgcn_s_barrier()
#define PG8_SCHED __builtin_amdgcn_sched_barrier(0)
    Unit cur, nxt; int ui = 0;
    if (!S.next(0, cur)) return;
    f32x4 acc[2][2][4][2];
#pragma unroll
    for (int a = 0; a < 2; ++a)
#pragma unroll
        for (int b = 0; b < 2; ++b)
#pragma unroll
            for (int m = 0; m < 4; ++m)
#pragma unroll
                for (int n = 0; n < 2; ++n) acc[a][b][m][n] = (f32x4){0.f, 0.f, 0.f, 0.f};
    bf16x8 At[4][2], B0[2][2], B1[2][2];
    const char* cA = (const char*)g.A + (size_t)cur.pm * tstepA; const char* cB = (const char*)g.Bt + (size_t)cur.pn * tstepB;
    S.a_ready(cur);
    if constexpr (SP2) {
        PG8_STAGE(PG8_SB(0, 0), cB, voffB); PG8_STAGE(PG8_SB(0, 1), cB + hstepB, voffB); PG8_STAGE(PG8_SA(0, 0), cA, voffA); PG8_STAGE(PG8_SA(0, 1), cA + hstepA, voffA);
        if (wr == 1) PG8_BAR;
        PG8_WAIT_V(2); PG8_BAR;
        PG8_STAGE(PG8_SB(1, 0), cB + kstep, voffB); PG8_STAGE(PG8_SA(1, 0), cA + kstep, voffA); PG8_STAGE(PG8_SB(1, 1), cB + hstepB + kstep, voffB);
        PG8_WAIT_V(6); PG8_BAR;
    } else {
        PG8_STAGE(PG8_SB(0, 0), cB, voffB); PG8_STAGE(PG8_SA(0, 0), cA, voffA); PG8_STAGE(PG8_SB(0, 1), cB + hstepB, voffB); PG8_STAGE(PG8_SA(0, 1), cA + hstepA, voffA);
        if (wr == 1) PG8_BAR;
        PG8_WAIT_V(4); PG8_BAR;
        PG8_STAGE(PG8_SB(1, 0), cB + kstep, voffB); PG8_STAGE(PG8_SA(1, 0), cA + kstep, voffA); PG8_STAGE(PG8_SB(1, 1), cB + hstepB + kstep, voffB);
        PG8_WAIT_V(6); PG8_BAR;
    }
    for (;;) {
        const bool has_next = S.next(ui + 1, nxt);
        const char* nA = has_next ? (const char*)g.A + (size_t)nxt.pm * tstepA : cA; const char* nB = has_next ? (const char*)g.Bt + (size_t)nxt.pn * tstepB : cB;
        for (int t = 0; t < nt; t += 2) {
            const bool last = (t == nt - 2);
            const char* a1 = cA + (size_t)(t + 1) * kstep;
            const char* a2 = last ? nA : cA + (size_t)(t + 2) * kstep; const char* b2 = last ? nB : cB + (size_t)(t + 2) * kstep;
            const char* a3 = a2 + kstep; const char* b3 = b2 + kstep;
            if (last && has_next) S.a_ready(nxt);
            if constexpr (SP2) {
            PG8_LDB(B0, 0, 0); PG8_LDB(B1, 0, 1); PG8_SCHED; PG8_LDA(At, 0, 0); PG8_STAGE(PG8_SA(1, 1), a1 + hstepA, voffA);
            PG8_WAIT_V(8); PG8_WAIT_L(0); PG8_BAR; PG8_MMA(0, 0, At, B0); PG8_MMA(0, 1, At, B1); PG8_BAR; PG8_SCHED;
            PG8_LDA(At, 0, 1); PG8_STAGE(PG8_SB(0, 0), b2, voffB); PG8_STAGE(PG8_SB(0, 1), b2 + hstepB, voffB); PG8_STAGE(PG8_SA(0, 0), a2, voffA);
            PG8_WAIT_V(8); PG8_WAIT_L(0); PG8_BAR; PG8_MMA(1, 0, At, B0); PG8_MMA(1, 1, At, B1); PG8_BAR; PG8_SCHED;
            PG8_LDB(B0, 1, 0); PG8_LDB(B1, 1, 1); PG8_SCHED; PG8_LDA(At, 1, 0); PG8_STAGE(PG8_SA(0, 1), a2 + hstepA, voffA);
            PG8_WAIT_V(8); PG8_WAIT_L(0); PG8_BAR; PG8_MMA(0, 0, At, B0); PG8_MMA(0, 1, At, B1); PG8_BAR; PG8_SCHED;
            PG8_LDA(At, 1, 1); PG8_STAGE(PG8_SB(1, 0), b3, voffB); PG8_STAGE(PG8_SB(1, 1), b3 + hstepB, voffB); PG8_STAGE(PG8_SA(1, 0), a3, voffA);
            PG8_WAIT_V(8); PG8_WAIT_L(0); PG8_BAR; PG8_MMA(1, 0, At, B0); PG8_MMA(1, 1, At, B1); PG8_BAR; PG8_SCHED;
            } else {
            PG8_LDB(B0, 0, 0); PG8_SCHED; PG8_LDA(At, 0, 0); PG8_STAGE(PG8_SA(1, 1), a1 + hstepA, voffA);
            PG8_WAIT_L(8); PG8_BAR; PG8_WAIT_L(0); PG8_MMA(0, 0, At, B0); PG8_BAR; PG8_SCHED;
            PG8_LDB(B1, 0, 1); PG8_STAGE(PG8_SB(0, 0), b2, voffB);
            PG8_BAR; PG8_WAIT_L(0); PG8_MMA(0, 1, At, B1); PG8_BAR;
            PG8_LDA(At, 0, 1); PG8_STAGE(PG8_SA(0, 0), a2, voffA);
            PG8_BAR; PG8_WAIT_L(0); PG8_MMA(1, 0, At, B0); PG8_BAR; PG8_SCHED;
            PG8_STAGE(PG8_SB(0, 1), b2 + hstepB, voffB);
            PG8_WAIT_V(6); PG8_BAR; PG8_MMA(1, 1, At, B1); PG8_BAR;
            PG8_LDB(B0, 1, 0); PG8_SCHED; PG8_LDA(At, 1, 0); PG8_STAGE(PG8_SA(0, 1), a2 + hstepA, voffA);
            PG8_WAIT_L(8); PG8_BAR; PG8_WAIT_L(0); PG8_MMA(0, 0, At, B0); PG8_BAR; PG8_SCHED;
            PG8_LDB(B1, 1, 1); PG8_STAGE(PG8_SB(1, 0), b3, voffB);
            PG8_BAR; PG8_WAIT_L(0); PG8_MMA(0, 1, At, B1); PG8_BAR;
            PG8_LDA(At, 1, 1); PG8_STAGE(PG8_SA(1, 0), a3, voffA);
            PG8_BAR; PG8_WAIT_L(0); PG8_MMA(1, 0, At, B0); PG8_BAR; PG8_SCHED;
            PG8_STAGE(PG8_SB(1, 1), b3 + hstepB, voffB);
            PG8_WAIT_V(6); PG8_BAR; PG8_MMA(1, 1, At, B1); PG8_BAR;
            }
        }
        if constexpr (ALIGN_EPI) { if (wr == 0) PG8_BAR; }
        if constexpr (!Epi::AFTER_DRAIN) { E(acc, cur, wr, wc, fr, fq); S.done(cur); }
        if (!has_next) break;
#pragma unroll
        for (int a = 0; a < 2; ++a)
#pragma unroll
            for (int b = 0; b < 2; ++b)
#pragma unroll
                for (int m = 0; m < 4; ++m)
#pragma unroll
                    for (int n = 0; n < 2; ++n) acc[a][b][m][n] = (f32x4){0.f, 0.f, 0.f, 0.f};
        cur = nxt; cA = nA; cB = nB; ++ui;
        if constexpr (ALIGN_EPI) { if (wr == 1) PG8_BAR; }
    }
    PG8_WAIT_V(0);
    if constexpr (!ALIGN_EPI) { if (wr == 0) PG8_BAR; }
    PG8_BAR;
    if constexpr (Epi::AFTER_DRAIN) { E.fused(acc, cur, wr, wc, fr, fq, lds, wid, lane); S.done(cur); }
    if constexpr (Epi::RT_DRAIN) { if (E.drain()) E.fused(acc, cur, wr, wc, fr, fq, lds, wid, lane); }
#undef PG8_SA
#undef PG8_SB
#undef PG8_STAGE
#undef PG8_LDA
#undef PG8_LDB
#undef PG8_MMA
#undef PG8_WAIT_V
#undef PG8_WAIT_L
#undef PG8_BAR
#undef PG8_SCHED
}
}
constexpr int NWAVES = 8;
constexpr int BATCH = 4, SEQ = 2048, DM = 2048, DEPTH = 2;
constexpr int M = BATCH * SEQ;
constexpr int GW = 512;
constexpr int IN_COLS = 5648, IN_PAD = 5888;
constexpr int DFF = 5632, MEML = 256, XH = 4, XHD = 512;
constexpr int MROWS = BATCH * MEML;
constexpr float EPS = 1e-6f;
constexpr int UA_B = 0, UA_C = 512, UA_H = 1024, UB = 1536, UC_Q = 2048, UC_Z = 3584, UC_A = 4096, UC_B = 4100, UD_Z = 4104, UD_X = 4616, UD_DT = 5640;
constexpr int MIX_PRE = 0, MIX_POST = 1, XA_PRE = 2, XA_POST = 3, MEM_NORM = 4, FFN_PRE = 5, FFN_POST = 6, N_NORMS = 7;
enum { I_X = 0, I_MEM, I_NORMG, I_WIN, I_CONVA, I_POOLW, I_POOLS, I_GCONV, I_GALOG, I_GDTB, I_GNG, I_SCONVW, I_SCONVB, I_SALOG, I_SDTB, I_SD, I_SNG, I_WOUT, I_WQ, I_WKV, I_WO, I_WGU, I_WD, N_IN };

constexpr size_t MiB = 1u << 20;
constexpr size_t WS_CTL = 0, CTL_ZERO_BYTES = 1 * MiB;
constexpr size_t WSZ_WIN = (size_t)IN_PAD * DM * 2, WSZ_SQ = (size_t)DM * DM * 2, WSZ_KV = (size_t)2 * DM * DM * 2, WSZ_GU = (size_t)2 * DFF * DM * 2, WSZ_D = (size_t)DM * DFF * 2;
constexpr size_t WO_WIN = 0, WO_WOUT = WO_WIN + WSZ_WIN, WO_WQ = WO_WOUT + WSZ_SQ, WO_WKV = WO_WQ + WSZ_SQ, WO_WO = WO_WKV + WSZ_KV, WO_WGU = WO_WO + WSZ_SQ, WO_WD = WO_WGU + WSZ_GU, W_LAYER = WO_WD + WSZ_D;
constexpr size_t WS_W = 1 * MiB;
constexpr size_t WS_XN = WS_W + 2 * W_LAYER;
constexpr size_t WS_MIX = WS_XN + (size_t)M * DM * 2;
constexpr size_t WS_MEMN = WS_MIX + (size_t)M * DM * 2;
constexpr size_t WS_KV = WS_MEMN + (size_t)2 * MROWS * DM * 2;
constexpr size_t WS_U = WS_KV + (size_t)2 * MROWS * 2 * DM * 2;
constexpr size_t WS_P = WS_U, WS_HID = WS_U + (size_t)M * DM * 2;
constexpr size_t WS_SCR = WS_U + (size_t)M * IN_PAD * 4;
constexpr size_t WS_Y = WS_SCR;
constexpr size_t SZ512 = (size_t)M * 512 * 4, SZ256 = (size_t)M * 256 * 4, SZ8 = (size_t)M * 8 * 4;
constexpr size_t WS_QN = WS_SCR, WS_KN = WS_QN + SZ512, WS_VV = WS_KN + SZ512, WS_OG = WS_VV + SZ512, WS_XS = WS_OG + SZ512, WS_YS = WS_XS + SZ512,
                 WS_GB = WS_YS + SZ512, WS_DT = WS_GB + SZ8, WS_SCR_END = WS_DT + 2 * SZ8;
constexpr size_t WS_AT = WS_SCR_END, WS_VWT = WS_AT + (size_t)DEPTH * BATCH * 1024 * DM * 2, WS_END = WS_VWT + (size_t)DEPTH * BATCH * DM * 1024 * 2;
constexpr size_t WS_ZG = WS_W + WO_WQ, WS_ZS = WS_ZG + SZ512;
constexpr size_t WS_BS = WS_W + W_LAYER + WO_WQ, WS_CS = WS_BS + SZ256;
static_assert(2 * SZ512 <= WSZ_SQ + WSZ_KV + WSZ_SQ && 2 * SZ256 <= WSZ_SQ + WSZ_KV + WSZ_SQ && WO_WKV == WO_WQ + WSZ_SQ && WO_WO == WO_WKV + WSZ_KV, "overlays fit the dead weight block");
constexpr int LA_QD = 0, LA_QK = 16384, LA_KE = 24576, LA_NW = 40960, LA_UCG = 57344, LA_RECG = 90112;
constexpr int LA_UCS = 40960, LA_RECS = 57344;
constexpr size_t WS_FG = WS_U, WS_FS = WS_FG + (size_t)512 * LA_RECG, WS_DLG = WS_FS + (size_t)1024 * LA_RECS, WS_DLS = WS_DLG + 512 * 4, WS_FEND = WS_DLS + 1024 * 4;
static_assert(WS_FEND <= WS_SCR, "records inside U");
static_assert(WS_Y + (size_t)M * DM * 4 <= WS_SCR_END, "Y inside the scan region");
static_assert(WS_HID + (size_t)M * DFF * 2 <= WS_SCR, "HID inside U");
static_assert(WS_END <= (size_t)704 * MiB, "d_ws map fits 4 x the largest input");

constexpr int RING_OFF = 0, RING_BYTES = 131072;
constexpr int LDSCTL_OFF = RING_BYTES, MISC_OFF = LDSCTL_OFF + 320;
constexpr int LDS_BYTES = 147456;
constexpr int CW_BAR = 4096;

#define GAS __attribute__((address_space(1)))
#define LAS __attribute__((address_space(3)))
typedef unsigned short bf16;
typedef unsigned v4u __attribute__((ext_vector_type(4)));
typedef unsigned v2u __attribute__((ext_vector_type(2)));
typedef float f32x4 __attribute__((ext_vector_type(4)));
typedef short bf16x8 __attribute__((ext_vector_type(8)));
#define LDS_WAIT() asm volatile("s_waitcnt lgkmcnt(0)" ::: "memory")
#define VM_WAIT() asm volatile("s_waitcnt vmcnt(0)" ::: "memory")
__device__ __forceinline__ unsigned f2bf(float f) { unsigned u = __builtin_bit_cast(unsigned, f); return (u + 0x7fffu + ((u >> 16) & 1u)) >> 16; }
__device__ __forceinline__ unsigned pk2(float lo, float hi) { return f2bf(lo) | (f2bf(hi) << 16); }
__device__ __forceinline__ float siluf(float v) { return v / (1.0f + __expf(-v)); }
__device__ __forceinline__ float softplusf(float v) { return fmaxf(v, 0.f) + log1pf(__expf(-fabsf(v))); }
__device__ __forceinline__ float sigmoidf(float v) { return 1.0f / (1.0f + __expf(-v)); }
__device__ __forceinline__ f32x4 ld4(const float* p) { return *(const f32x4*)p; }
__device__ __forceinline__ f32x4 silu4(f32x4 v) { return (f32x4){siluf(v.x), siluf(v.y), siluf(v.z), siluf(v.w)}; }
template <int CTRL> __device__ __forceinline__ float dppf(float v) { return __builtin_bit_cast(float, __builtin_amdgcn_update_dpp(0, __builtin_bit_cast(int, v), CTRL, 0xF, 0xF, true)); }
__device__ __forceinline__ float row16_sum(float v) { v += dppf<0xB1>(v); v += dppf<0x4E>(v); v += dppf<0x141>(v); v += dppf<0x140>(v); return v; }
__device__ __forceinline__ int opq(int v) { asm volatile("" : "+v"(v)); return v; }
__device__ __forceinline__ float wave_sum(float v) {
#pragma unroll
    for (int o = 1; o < 64; o <<= 1) v += __shfl_xor(v, o);
    return v;
}

#define XB_TMO      128
#define XB_XCNT(j)  (256  + 64 * (j))
#define XB_XSUB(j)  (1280 + 64 * (j))
#define XB_XGEN(j)  (2304 + 64 * (j))
#define XB_TOP      3328
#define XB_TOPGEN   3392
#define XCD_BAR_WORDS 3456
#define XB_SPIN_CAP (1u << 18)

__device__ __forceinline__ unsigned xb_ld(unsigned* p)              { return __hip_atomic_load(p, __ATOMIC_RELAXED, __HIP_MEMORY_SCOPE_AGENT); }
__device__ __forceinline__ unsigned xb_add(unsigned* p, unsigned v) { return __hip_atomic_fetch_add(p, v, __ATOMIC_RELAXED, __HIP_MEMORY_SCOPE_AGENT); }
__device__ __forceinline__ unsigned xb_xcc_id() { return (unsigned)__builtin_amdgcn_s_getreg((3 << 11) | 20) & 0xFu; }
#define XB_SPIN(cond, bar) do { unsigned _sp = 0; while (cond) { __builtin_amdgcn_s_sleep(1); \
    if ((++_sp & 255u) == 0u) { if (xb_ld(&(bar)[XB_TMO])) break; if (_sp > XB_SPIN_CAP) { atomicAdd(&(bar)[XB_TMO], 1u); break; } } } } while (0)

struct XcdBarrier {
    unsigned* bar; unsigned x;
    volatile LAS unsigned* st;
};

__device__ __forceinline__ XcdBarrier xcd_barrier_post(unsigned* bar, volatile LAS unsigned* st) {
    XcdBarrier b; b.bar = bar; b.x = xb_xcc_id(); b.st = st;
    if (threadIdx.x == 0) (void)xb_add(&bar[XB_XCNT(b.x)], 1u);
    return b;
}
__device__ __forceinline__ void xcd_barrier_complete(unsigned* bar, unsigned x, unsigned& nloc, unsigned& nx) {
    const unsigned G = gridDim.x * gridDim.y * gridDim.z;
    unsigned sum, cnt, mine, sp = 0u;
    for (;;) {
        sum = 0u; cnt = 0u; mine = 0u;
#pragma unroll
        for (unsigned j = 0; j < 16; ++j) { const unsigned c = xb_ld(&bar[XB_XCNT(j)]); sum += c; cnt += (c > 0u) ? 1u : 0u; mine = (j == x) ? c : mine; }
        if (sum == G) break;
        __builtin_amdgcn_s_sleep(1);
        if ((++sp & 255u) == 0u) { if (xb_ld(&bar[XB_TMO])) break; if (sp > XB_SPIN_CAP) { atomicAdd(&bar[XB_TMO], 1u); break; } }
    }
    nloc = mine > 0u ? mine : 1u; nx = cnt > 0u ? cnt : 1u;
}

__device__ __forceinline__ void xcd_barrier(const XcdBarrier& b) {
    asm volatile("s_waitcnt vmcnt(0)" ::: "memory");
    __syncthreads();
    if (threadIdx.x == 0) {
        unsigned* bar = b.bar;
        __builtin_amdgcn_s_waitcnt(0);
        unsigned nloc = b.st[0], nx = b.st[1];
        if (nloc == 0u) { xcd_barrier_complete(bar, b.x, nloc, nx); b.st[0] = nloc; b.st[1] = nx; }
        const unsigned old = xb_add(&bar[XB_XSUB(b.x)], 1u);
        const unsigned gen = old / nloc;
        if (old + 1u == (gen + 1u) * nloc) {
            __builtin_amdgcn_fence(__ATOMIC_RELEASE, "agent");
            asm volatile("s_waitcnt vmcnt(0)" ::: "memory");
            const unsigned og = xb_add(&bar[XB_TOP], 1u);
            const unsigned tg = og / nx;
            if (og + 1u == (tg + 1u) * nx) xb_add(&bar[XB_TOPGEN], 1u);
            else XB_SPIN(xb_ld(&bar[XB_TOPGEN]) == tg, bar);
            __builtin_amdgcn_fence(__ATOMIC_ACQUIRE, "agent");
            xb_add(&bar[XB_XGEN(b.x)], 1u);
            asm volatile("s_waitcnt vmcnt(0)" ::: "memory");
        } else {
            XB_SPIN(xb_ld(&bar[XB_XGEN(b.x)]) == gen, bar);
            __builtin_amdgcn_fence(__ATOMIC_ACQUIRE, "agent");
            asm volatile("s_waitcnt vmcnt(0)" ::: "memory");
        }
    }
    __syncthreads();
}
struct Frame {
    LAS unsigned char* lds;
    volatile LAS unsigned* MISC;
    unsigned* ctl;
    int tid, lane, wave;
    int vcu, G;
    float* out; unsigned char* ws;
};
__device__ __forceinline__ const float* inp(int i) { const float* __attribute__((address_space(4))) const* tab = (const float* __attribute__((address_space(4))) const*)__builtin_amdgcn_kernarg_segment_ptr(); asm volatile("" : "+s"(tab)); return tab[i]; }
__device__ __forceinline__ bf16* wsb(const Frame& F, size_t off) { return (bf16*)(F.ws + off); }
__device__ __forceinline__ float* wsf(const Frame& F, size_t off) { return (float*)(F.ws + off); }

__device__ __forceinline__ void p0_transpose_item(const float* W, int K, int N, bf16* WT, int drow0, int k0, int n0, LAS float* scr, int lane) {
    const int nn = n0 + (lane & 31); const bool ok = nn < N;
    float wv_[32];
#pragma unroll
    for (int i = 0; i < 32; ++i) { const int kk = 2 * i + (lane >> 5); wv_[i] = ok ? W[(size_t)(k0 + kk) * N + nn] : 0.f; }
#pragma unroll
    for (int i = 0; i < 32; ++i) { const int kk = 2 * i + (lane >> 5); scr[kk * 33 + (lane & 31)] = wv_[i]; }
    LDS_WAIT(); asm volatile("" ::: "memory");
    const int c = lane & 7;
#pragma unroll
    for (int j = 0; j < 4; ++j) { const int n = (lane >> 3) + 8 * j; const LAS float* s = scr + (8 * c) * 33 + n;
        v4u o; o.x = pk2(s[0 * 33], s[1 * 33]); o.y = pk2(s[2 * 33], s[3 * 33]); o.z = pk2(s[4 * 33], s[5 * 33]); o.w = pk2(s[6 * 33], s[7 * 33]);
        *(v4u*)(WT + (size_t)(drow0 + n) * K + k0 + 8 * c) = o; }
    LDS_WAIT(); asm volatile("" ::: "memory");
}
__device__ __forceinline__ void norm_row_to_bf16(const float* xrow, const float* g, bf16* orow, int lane) {
    const f32x4* xr = (const f32x4*)xrow + lane; const f32x4* gr = (const f32x4*)g + lane;
    f32x4 v[8]; float s = 0.f;
#pragma unroll
    for (int j = 0; j < 8; ++j) { v[j] = xr[64 * j]; s += (v[j].x * v[j].x + v[j].y * v[j].y) + (v[j].z * v[j].z + v[j].w * v[j].w); }
    const float rstd = 1.0f / sqrtf(wave_sum(s) * (1.0f / DM) + EPS);
    v2u* o8 = (v2u*)orow + lane;
#pragma unroll
    for (int j = 0; j < 8; ++j) { const f32x4 gg = gr[64 * j]; v2u w; w.x = pk2(v[j].x * rstd * gg.x, v[j].y * rstd * gg.y); w.y = pk2(v[j].z * rstd * gg.z, v[j].w * rstd * gg.w); o8[64 * j] = w; }
}
__device__ __forceinline__ void p0_prologue(Frame& F) {
    LAS float* scr = (LAS float*)(F.lds + RING_OFF + F.wave * 16384);
    const int gw = F.vcu * NWAVES + F.wave, NGW = F.G * NWAVES; const int lane = opq(F.lane), tid = opq(F.tid);
    constexpr int NB_IN = (IN_COLS + 31) / 32;
    constexpr int I_IN = (DM / 64) * NB_IN, I_SQ = (DM / 64) * (DM / 32), I_KV = (DM / 64) * (2 * DM / 32), I_GU = (DM / 64) * (2 * DFF / 32), I_D = (DFF / 64) * (DM / 32);
    constexpr int I_LAYER = I_IN + 2 * I_SQ + I_KV + I_GU + I_D;
    for (int it = gw; it < DEPTH * I_LAYER; it += NGW) {
        const int l = it / I_LAYER; int r = it % I_LAYER;
        bf16* wl = wsb(F, WS_W + (size_t)l * W_LAYER);
        if (r < I_IN) { const int kb = r / NB_IN, nb = r % NB_IN; p0_transpose_item(inp(I_WIN) + (size_t)l * DM * IN_COLS, DM, IN_COLS, (bf16*)((char*)wl + WO_WIN), 32 * nb, 64 * kb, 32 * nb, scr, lane); continue; } r -= I_IN;
        if (r < I_SQ) { const int kb = r / (DM / 32), nb = r % (DM / 32); p0_transpose_item(inp(I_WOUT) + (size_t)l * DM * DM, DM, DM, (bf16*)((char*)wl + WO_WOUT), 32 * nb, 64 * kb, 32 * nb, scr, lane); continue; } r -= I_SQ;
        if (r < I_SQ) { const int kb = r / (DM / 32), nb = r % (DM / 32); p0_transpose_item(inp(I_WO) + (size_t)l * DM * DM, DM, DM, (bf16*)((char*)wl + WO_WO), 32 * nb, 64 * kb, 32 * nb, scr, lane); continue; } r -= I_SQ;
        if (r < I_KV) { const int kb = r / (2 * DM / 32), nb = r % (2 * DM / 32); p0_transpose_item(inp(I_WKV) + (size_t)l * DM * 2 * DM, DM, 2 * DM, (bf16*)((char*)wl + WO_WKV), 32 * nb, 64 * kb, 32 * nb, scr, lane); continue; } r -= I_KV;
        if (r < I_GU) { const int kb = r / (2 * DFF / 32), nb = r % (2 * DFF / 32); const int n0 = 32 * nb; const int up = n0 >= DFF ? 1 : 0, j0 = n0 - up * DFF;
            const int drow = (j0 >> 7) * 256 + up * 128 + (j0 & 127);
            p0_transpose_item(inp(I_WGU) + (size_t)l * DM * 2 * DFF, DM, 2 * DFF, (bf16*)((char*)wl + WO_WGU), drow, 64 * kb, n0, scr, lane); continue; } r -= I_GU;
        { const int kb = r / (DM / 32), nb = r % (DM / 32); p0_transpose_item(inp(I_WD) + (size_t)l * DFF * DM, DFF, DM, (bf16*)((char*)wl + WO_WD), 32 * nb, 64 * kb, 32 * nb, scr, lane); }
    }
    for (int i = (F.vcu * NWAVES * 64) + tid; i < DEPTH * DM * DM / 8; i += F.G * NWAVES * 64) { const int l = i / (DM * DM / 8), k = i % (DM * DM / 8);
        const float* src = inp(I_WQ) + (size_t)l * DM * DM + (size_t)k * 8; const f32x4 a = ld4(src), b = ld4(src + 4);
        v4u o; o.x = pk2(a.x, a.y); o.y = pk2(a.z, a.w); o.z = pk2(b.x, b.y); o.w = pk2(b.z, b.w);
        ((v4u*)(F.ws + WS_W + (size_t)l * W_LAYER + WO_WQ))[k] = o; }
    { constexpr int ZR0 = 32 * NB_IN, ZN = (IN_PAD - ZR0) * DM / 8;
      for (int i = (F.vcu * NWAVES * 64) + tid; i < DEPTH * ZN; i += F.G * NWAVES * 64) { const int l = i / ZN, k = i % ZN;
          ((v4u*)(F.ws + WS_W + (size_t)l * W_LAYER + WO_WIN + (size_t)ZR0 * DM * 2))[k] = (v4u){0u, 0u, 0u, 0u}; } }
    for (int m = gw; m < DEPTH * MROWS; m += NGW) { const int l = m / MROWS, r = m % MROWS;
        norm_row_to_bf16(inp(I_MEM) + (size_t)r * DM, inp(I_NORMG) + (size_t)(l * N_NORMS + MEM_NORM) * DM, wsb(F, WS_MEMN) + (size_t)m * DM, lane); }
    for (int m = gw; m < M; m += NGW) norm_row_to_bf16(inp(I_X) + (size_t)m * DM, inp(I_NORMG) + (size_t)(0 * N_NORMS + MIX_PRE) * DM, wsb(F, WS_XN) + (size_t)m * DM, lane);
}

__device__ __forceinline__ void resnorm_phase(Frame& F, const float* xin, const float* gpost, const float* gpre  ) {
    const int gw = F.vcu * NWAVES + F.wave, NGW = F.G * NWAVES, lane = opq(F.lane);
    const float* Y = wsf(F, WS_Y); bf16* XN = wsb(F, WS_XN);
    for (int m = gw; m < M; m += NGW) {
        const f32x4* yr = (const f32x4*)(Y + (size_t)m * DM) + lane; const f32x4* xr = (const f32x4*)(xin + (size_t)m * DM) + lane;
        f32x4* xo = (f32x4*)(F.out + (size_t)m * DM) + lane;
        f32x4 y[8], x[8]; float s = 0.f;
#pragma unroll
        for (int j = 0; j < 8; ++j) { y[j] = yr[64 * j]; x[j] = xr[64 * j]; s += (y[j].x * y[j].x + y[j].y * y[j].y) + (y[j].z * y[j].z + y[j].w * y[j].w); }
        const float rstd = 1.0f / sqrtf(wave_sum(s) * (1.0f / DM) + EPS);
        float s2 = 0.f;
#pragma unroll
        for (int j = 0; j < 8; ++j) { const f32x4 gg = ((const f32x4*)gpost)[lane + 64 * j]; x[j] = x[j] + y[j] * rstd * gg; xo[64 * j] = x[j];
            s2 += (x[j].x * x[j].x + x[j].y * x[j].y) + (x[j].z * x[j].z + x[j].w * x[j].w); }
        if (gpre) {
            const float r2 = 1.0f / sqrtf(wave_sum(s2) * (1.0f / DM) + EPS);
            v2u* o8 = (v2u*)(XN + (size_t)m * DM) + lane;
#pragma unroll
            for (int j = 0; j < 8; ++j) { const f32x4 gg = ((const f32x4*)gpre)[lane + 64 * j]; v2u w; w.x = pk2(x[j].x * r2 * gg.x, x[j].y * r2 * gg.y); w.y = pk2(x[j].z * r2 * gg.z, x[j].w * r2 * gg.w); o8[64 * j] = w; }
        }
    }
}

__device__ __forceinline__ void mixer_prep_phase(Frame& F, int l) {
    const int gw = F.vcu * NWAVES + F.wave, NGW = F.G * NWAVES, lane = opq(F.lane), tid = opq(F.tid);
    const float* U = wsf(F, WS_U);
    bf16* MIX = wsb(F, WS_MIX);
    constexpr int NSTRIP = M / 16;
    for (int it = gw; it < 16 * NSTRIP; it += NGW) {
        const int type = it & 15, strip = it >> 4, r0 = strip * 16, pos0 = r0 & (SEQ - 1);
        if (type < 2) {
            const int c = type * 256 + lane * 4;
            const float* cw = inp(I_CONVA) + (size_t)l * 3 * GW + c;
            const f32x4 w0 = ld4(cw), w1 = ld4(cw + GW), w2 = ld4(cw + 2 * GW);
            f32x4 p2 = (f32x4){0.f, 0.f, 0.f, 0.f}, p1 = p2;
            if (pos0 >= 2) { const float* u2 = U + (size_t)(r0 - 2) * IN_PAD; const float* u1 = U + (size_t)(r0 - 1) * IN_PAD;
                p2 = ld4(u2 + UA_C + c) * ld4(u2 + UA_H + c); p1 = ld4(u1 + UA_C + c) * ld4(u1 + UA_H + c); }
#pragma unroll 4
            for (int i = 0; i < 16; ++i) { const float* ur = U + (size_t)(r0 + i) * IN_PAD;
                const f32x4 p0 = ld4(ur + UA_C + c) * ld4(ur + UA_H + c);
                const f32x4 y = ld4(ur + UA_B + c) * (w0 * p2 + w1 * p1 + w2 * p0);
                v2u o; o.x = pk2(y.x, y.y); o.y = pk2(y.z, y.w); *(v2u*)(MIX + (size_t)(r0 + i) * DM + c) = o;
                p2 = p1; p1 = p0; }
        } else if (type < 8) {
            const int gi = type - 2, c = gi * 256 + lane * 4;
            const float* cw = inp(I_GCONV) + (size_t)l * 4 * 3 * GW + c;
            const f32x4 w0 = ld4(cw), w1 = ld4(cw + 3 * GW), w2 = ld4(cw + 6 * GW), w3 = ld4(cw + 9 * GW);
            f32x4 x3 = (f32x4){0.f, 0.f, 0.f, 0.f}, x2 = x3, x1 = x3;
            if (pos0 >= 3) { x3 = ld4(U + (size_t)(r0 - 3) * IN_PAD + UC_Q + c); x2 = ld4(U + (size_t)(r0 - 2) * IN_PAD + UC_Q + c); x1 = ld4(U + (size_t)(r0 - 1) * IN_PAD + UC_Q + c); }
            float* dst = (gi < 2) ? wsf(F, WS_QN) + gi * 256 : (gi < 4) ? wsf(F, WS_KN) + (gi - 2) * 256 : wsf(F, WS_VV) + (gi - 4) * 256;
            const float qs = (gi < 2) ? 0.08838834764831845f : 1.0f;
#pragma unroll 4
            for (int i = 0; i < 16; ++i) { const f32x4 x0 = ld4(U + (size_t)(r0 + i) * IN_PAD + UC_Q + c);
                f32x4 y = silu4(w0 * x3 + w1 * x2 + w2 * x1 + w3 * x0);
                if (gi < 4) { float ss = (y.x * y.x + y.y * y.y) + (y.z * y.z + y.w * y.w);
                    ss += __shfl_xor(ss, 1); ss += __shfl_xor(ss, 2); ss += __shfl_xor(ss, 4); ss += __shfl_xor(ss, 8); ss += __shfl_xor(ss, 16);
                    y = y * (qs / sqrtf(ss + EPS)); }
                *(f32x4*)(dst + (size_t)(r0 + i) * GW + lane * 4) = y;
                x3 = x2; x2 = x1; x1 = x0; }
        } else if (type < 12) {
            const int gi = type - 8, c = gi * 256 + lane * 4;
            const float* cw = inp(I_SCONVW) + (size_t)l * 4 * 1024 + c;
            const f32x4 w0 = ld4(cw), w1 = ld4(cw + 1024), w2 = ld4(cw + 2048), w3 = ld4(cw + 3072), bb = ld4(inp(I_SCONVB) + (size_t)l * 1024 + c);
            f32x4 x3 = (f32x4){0.f, 0.f, 0.f, 0.f}, x2 = x3, x1 = x3;
            if (pos0 >= 3) { x3 = ld4(U + (size_t)(r0 - 3) * IN_PAD + UD_X + c); x2 = ld4(U + (size_t)(r0 - 2) * IN_PAD + UD_X + c); x1 = ld4(U + (size_t)(r0 - 1) * IN_PAD + UD_X + c); }
            float* dst; int ld;
            if (gi < 2) { dst = wsf(F, WS_XS) + gi * 256; ld = 512; } else if (gi == 2) { dst = wsf(F, WS_BS); ld = 256; } else { dst = wsf(F, WS_CS); ld = 256; }
#pragma unroll 4
            for (int i = 0; i < 16; ++i) { const f32x4 x0 = ld4(U + (size_t)(r0 + i) * IN_PAD + UD_X + c);
                const f32x4 y = silu4(w0 * x3 + w1 * x2 + w2 * x1 + w3 * x0 + bb);
                *(f32x4*)(dst + (size_t)(r0 + i) * ld + lane * 4) = y;
                x3 = x2; x2 = x1; x1 = x0; }
        } else {
            const int gi = type - 12, w = 2 << gi;
            LAS float* scr = (LAS float*)(F.lds + RING_OFF + F.wave * 16384);
            const int c0 = UB + gi * 128 + lane * 2;
            float r0s = 0.f, r1s = 0.f;
            if (pos0 > 0) { for (int s = 1; s < w; ++s) { const float* up = U + (size_t)(r0 - s) * IN_PAD + c0; r0s += up[0]; r1s += up[1]; } }
            for (int i = 0; i < 16; ++i) { const int pos = pos0 + i; const float* ur = U + (size_t)(r0 + i) * IN_PAD + c0;
                const float a0 = ur[0], a1 = ur[1];
                r0s += a0; r1s += a1;
                const float cnt = (float)((pos + 1 < w) ? pos + 1 : w);
                scr[i * 128 + lane * 2] = r0s / cnt - a0; scr[i * 128 + lane * 2 + 1] = r1s / cnt - a1;
                if (pos - w + 1 >= 0) { const float* ud = U + (size_t)(r0 + i - w + 1) * IN_PAD + c0; r0s -= ud[0]; r1s -= ud[1]; } }
            LDS_WAIT(); asm volatile("" ::: "memory");
            float acc0[16], acc1[16];
#pragma unroll
            for (int i = 0; i < 16; ++i) { acc0[i] = 0.f; acc1[i] = 0.f; }
            const float* pw = inp(I_POOLW) + ((size_t)l * 4 + gi) * 128 * 128;
            for (int cc = 0; cc < 128; cc += 4) {
                float wa[4], wb[4];
#pragma unroll
                for (int q = 0; q < 4; ++q) { wa[q] = pw[(size_t)(cc + q) * 128 + lane]; wb[q] = pw[(size_t)(cc + q) * 128 + 64 + lane]; }
#pragma unroll
                for (int i = 0; i < 16; ++i) { const f32x4 p = *(const LAS f32x4*)(scr + i * 128 + cc);
                    acc0[i] += p.x * wa[0] + p.y * wa[1] + p.z * wa[2] + p.w * wa[3]; acc1[i] += p.x * wb[0] + p.y * wb[1] + p.z * wb[2] + p.w * wb[3]; }
            }
            const float s0 = inp(I_POOLS)[(size_t)l * GW + gi * 128 + lane], s1 = inp(I_POOLS)[(size_t)l * GW + gi * 128 + 64 + lane];
#pragma unroll
            for (int i = 0; i < 16; ++i) { bf16* o = MIX + (size_t)(r0 + i) * DM + GW + gi * 128; o[lane] = (bf16)f2bf(acc0[i] * s0); o[64 + lane] = (bf16)f2bf(acc1[i] * s1); }
            LDS_WAIT(); asm volatile("" ::: "memory");
        }
    }
    for (int i = (F.vcu * NWAVES * 64) + tid; i < M * 16; i += F.G * NWAVES * 64) { const int t = i >> 4, j = i & 15; const float* ur = U + (size_t)t * IN_PAD;
        if (j < 4) { wsf(F, WS_GB)[(size_t)t * 8 + 2 * j] = -__expf(inp(I_GALOG)[l * 4 + j]) * softplusf(ur[UC_A + j] + inp(I_GDTB)[l * 4 + j]); }
        else if (j < 8) { wsf(F, WS_GB)[(size_t)t * 8 + 2 * (j - 4) + 1] = sigmoidf(ur[UC_B + (j - 4)]); }
        else { const int hh = j - 8; const float dt = softplusf(ur[UD_DT + hh] + inp(I_SDTB)[l * 8 + hh]);
            wsf(F, WS_DT)[(size_t)t * 16 + 2 * hh] = -__expf(inp(I_SALOG)[l * 8 + hh]) * dt; wsf(F, WS_DT)[(size_t)t * 16 + 2 * hh + 1] = dt; } }
    for (int i = (F.vcu * NWAVES * 64) + tid; i < M * 256; i += F.G * NWAVES * 64) { const int t = i >> 8, c = (i & 255) * 4;
        if (c < 512) *(f32x4*)(wsf(F, WS_ZG) + (size_t)t * GW + c) = ld4(U + (size_t)t * IN_PAD + UC_Z + c);
        else *(f32x4*)(wsf(F, WS_ZS) + (size_t)t * GW + (c - 512)) = ld4(U + (size_t)t * IN_PAD + UD_Z + (c - 512)); }
}

typedef float f32x16 __attribute__((ext_vector_type(16)));
typedef float f32x2v __attribute__((ext_vector_type(2)));
typedef __bf16 bf16x2_t __attribute__((ext_vector_type(2)));
__device__ __forceinline__ unsigned cvtpk(float lo, float hi) { const f32x2v v = {lo, hi}; return __builtin_bit_cast(unsigned, __builtin_convertvector(v, bf16x2_t)); }
__device__ __forceinline__ bf16x8 pack8(float a0, float a1, float a2, float a3, float a4, float a5, float a6, float a7) { v4u w; w.x = cvtpk(a0, a1); w.y = cvtpk(a2, a3); w.z = cvtpk(a4, a5); w.w = cvtpk(a6, a7); return __builtin_bit_cast(bf16x8, w); }
#define PACK_STEP(x, s) pack8((x)[8 * (s)], (x)[8 * (s) + 1], (x)[8 * (s) + 2], (x)[8 * (s) + 3], (x)[8 * (s) + 4], (x)[8 * (s) + 5], (x)[8 * (s) + 6], (x)[8 * (s) + 7])
#define MFMA32(a, b, c) __builtin_amdgcn_mfma_f32_32x32x16_bf16((a), (b), (c), 0, 0, 0)
__device__ __forceinline__ int crow(int reg, int h) { return (reg & 3) + 8 * (reg >> 2) + 4 * h; }
constexpr int LA_KB = 0;
constexpr int LA_QB = LA_KB + 64 * 136 * 2;
constexpr int LA_KGT = LA_QB + 64 * 136 * 2;
constexpr int LA_VBT = LA_KGT + 128 * 72 * 2;
constexpr int LA_KET = LA_VBT + 128 * 72 * 2;
constexpr int LA_M = LA_KET + 128 * 72 * 2;
constexpr int LA_TB = LA_M + 64 * 68 * 4;
constexpr int LA_VEC = LA_TB + 64 * 72 * 2;
static_assert(LA_VEC + 1024 <= RING_BYTES, "la LDS map");
__device__ __forceinline__ bf16x8 lds_frag(const LAS unsigned char* base, int row, int stride_el, int col) { return *(const LAS bf16x8*)(base + ((size_t)row * stride_el + col) * 2); }
__device__ __forceinline__ float wave_incl_scan(float v, int lane) {
#pragma unroll
    for (int d = 1; d < 64; d <<= 1) { const float o = __shfl_up(v, d); if (lane >= d) v += o; }
    return v;
}
__device__ __forceinline__ void store_qk_frag(const f32x16& acc, const LAS float* Gv, int mt, int rt, int r, int h, int lane, bf16* qkf) {
    const int l = 32 * rt + r; const float Gl = Gv[l];
    float v[16];
#pragma unroll
    for (int q = 0; q < 16; ++q) { const int m = 32 * mt + crow(q, h); v[q] = (m <= l) ? acc[q] * __expf(Gl - Gv[m]) : 0.f; }
    *(bf16x8*)(qkf + ((size_t)(rt * 4 + 2 * mt + 0) * 64 + lane) * 8) = pack8(v[0], v[1], v[2], v[3], v[4], v[5], v[6], v[7]);
    *(bf16x8*)(qkf + ((size_t)(rt * 4 + 2 * mt + 1) * 64 + lane) * 8) = pack8(v[8], v[9], v[10], v[11], v[12], v[13], v[14], v[15]);
}
__device__ __forceinline__ void qd_frag_task(const float* qrows, int ldq, const LAS float* Gv, int task, int r, int h, int lane, bf16* qdf) {
    const int rt = task >> 3, ks = task & 7, l = 32 * rt + r, k0 = 16 * ks + 4 * h; const float e = __expf(Gv[l]);
    const f32x4 a = ld4(qrows + (size_t)l * ldq + k0), b = ld4(qrows + (size_t)l * ldq + k0 + 8);
    *(bf16x8*)(qdf + ((size_t)task * 64 + lane) * 8) = pack8(a.x * e, a.y * e, a.z * e, a.w * e, b.x * e, b.y * e, b.z * e, b.w * e);
}
__device__ __forceinline__ void ke_frag_task(const LAS unsigned char* ket, int task, int r, int h, int lane, bf16* kef) {
    const int it = task >> 2, ks = task & 3, dk = 32 * it + r, l0 = 16 * ks + 4 * h;
    const v2u lo = *(const LAS v2u*)(ket + ((size_t)dk * 72 + l0) * 2), hi = *(const LAS v2u*)(ket + ((size_t)dk * 72 + l0 + 8) * 2);
    v4u w; w.x = lo.x; w.y = lo.y; w.z = hi.x; w.w = hi.y;
    *(v4u*)(kef + ((size_t)task * 64 + lane) * 8) = w;
}

__device__ __forceinline__ void la_prep_phase(Frame& F, int l_unused) {
    const int tid0 = opq(F.tid), wv = F.wave;
    LAS unsigned char* L = F.lds + RING_OFF; asm volatile("" : "+v"(L));
    LAS float* Gv = (LAS float*)(L + LA_VEC); LAS float* Bv = Gv + 64;
    LAS float* Mf = (LAS float*)(L + LA_M);
    const f32x16 zero16 = {0.f, 0.f, 0.f, 0.f, 0.f, 0.f, 0.f, 0.f, 0.f, 0.f, 0.f, 0.f, 0.f, 0.f, 0.f, 0.f};
    for (int item = F.vcu; item < 512; item += F.G) {
        const int tid = opq(tid0), lane = tid & 63, r = lane & 31, h = lane >> 5;
        const int seq = item >> 5, ch = item & 31, b = seq >> 2, hd = seq & 3;
        const size_t t0 = (size_t)b * SEQ + ch * 64;
        const float* KN = wsf(F, WS_KN) + t0 * GW + hd * 128; const float* QN = wsf(F, WS_QN) + t0 * GW + hd * 128; const float* VV = wsf(F, WS_VV) + t0 * GW + hd * 128;
        unsigned char* rec = F.ws + WS_FG + (size_t)item * LA_RECG;
        if (wv == 0) { const f32x2v gb = *(const f32x2v*)(wsf(F, WS_GB) + (t0 + lane) * 8 + 2 * hd); Gv[lane] = wave_incl_scan(gb.x, lane); Bv[lane] = gb.y; }
        __syncthreads();
        const float G63 = Gv[63];
        { const int c = tid & 127, lg = tid >> 7;
#pragma unroll 4
          for (int i = 0; i < 16; ++i) { const int l = lg * 16 + i; const float kv = KN[(size_t)l * GW + c], qv = QN[(size_t)l * GW + c], vv = VV[(size_t)l * GW + c];
              const float Gl = Gv[l], bl = Bv[l];
              ((LAS bf16*)(L + LA_KB))[l * 136 + c] = (bf16)f2bf(kv); ((LAS bf16*)(L + LA_QB))[l * 136 + c] = (bf16)f2bf(qv);
              ((LAS bf16*)(L + LA_KGT))[c * 72 + l] = (bf16)f2bf(-kv * bl * __expf(Gl)); ((LAS bf16*)(L + LA_VBT))[c * 72 + l] = (bf16)f2bf(vv * bl);
              ((LAS bf16*)(L + LA_KET))[c * 72 + l] = (bf16)f2bf(kv * __expf(G63 - Gl)); } }
        __syncthreads();
        if (wv < 4) { const int it = wv >> 1, jt = wv & 1; f32x16 acc = zero16;
            if (!(it == 0 && jt == 1)) {
#pragma unroll
                for (int ks = 0; ks < 8; ++ks) acc = MFMA32(lds_frag(L + LA_KB, 32 * it + r, 136, 16 * ks + 8 * h), lds_frag(L + LA_KB, 32 * jt + r, 136, 16 * ks + 8 * h), acc); }
            const int j = 32 * jt + r; const float Gj = Gv[j];
#pragma unroll
            for (int q = 0; q < 16; ++q) { const int i = 32 * it + crow(q, h); Mf[i * 68 + j] = (j < i) ? Bv[i] * acc[q] * __expf(Gv[i] - Gj) : 0.f; }
        } else { const int mt = (wv - 4) >> 1, rt = (wv - 4) & 1; f32x16 acc = zero16;
            if (!(mt == 1 && rt == 0)) {
#pragma unroll
                for (int ks = 0; ks < 8; ++ks) acc = MFMA32(lds_frag(L + LA_KB, 32 * mt + r, 136, 16 * ks + 8 * h), lds_frag(L + LA_QB, 32 * rt + r, 136, 16 * ks + 8 * h), acc); }
            store_qk_frag(acc, Gv, mt, rt, r, h, lane, (bf16*)(rec + LA_QK)); }
        __syncthreads();
#ifndef DBG_NOINV
        if (wv == 0) {
            const int ln = opq(lane);
            float Tc[64];
#pragma unroll
            for (int i = 0; i < 64; ++i) {
                float a0 = (i == ln) ? 1.f : 0.f, a1 = 0.f, a2 = 0.f, a3 = 0.f;
#pragma unroll
                for (int j4 = 0; j4 < (i + 3) / 4; ++j4) { const f32x4 m = *(const LAS f32x4*)(Mf + i * 68 + 4 * j4);
                    a0 -= m.x * Tc[4 * j4]; if (4 * j4 + 1 < i) a1 -= m.y * Tc[4 * j4 + 1]; if (4 * j4 + 2 < i) a2 -= m.z * Tc[4 * j4 + 2]; if (4 * j4 + 3 < i) a3 -= m.w * Tc[4 * j4 + 3]; }
                Tc[i] = (a0 + a1) + (a2 + a3);
                ((LAS bf16*)(L + LA_TB))[i * 72 + ln] = (bf16)f2bf(Tc[i]);
                if ((i & 3) == 3) asm volatile("" ::: "memory");
            }
            if (lane == 0) wsf(F, WS_DLG)[item] = __expf(G63);
        } else
#endif
        {
            for (int task = wv - 1; task < 32; task += 7) {
                if (task < 16) qd_frag_task(QN, GW, Gv, task, r, h, lane, (bf16*)(rec + LA_QD));
                else ke_frag_task(L + LA_KET, task - 16, r, h, lane, (bf16*)(rec + LA_KE)); }
        }
        __syncthreads();
#pragma unroll 1
        for (int tile = wv; tile < 16; tile += 8) {
            f32x16 acc = zero16;
            if (tile < 8) { const int it = tile >> 1, rt = tile & 1;
#pragma unroll
                for (int ks = 0; ks < 4; ++ks) acc = MFMA32(lds_frag(L + LA_KGT, 32 * it + r, 72, 16 * ks + 8 * h), lds_frag(L + LA_TB, 32 * rt + r, 72, 16 * ks + 8 * h), acc);
                bf16* nw = (bf16*)(rec + LA_NW);
                *(bf16x8*)(nw + ((size_t)(rt * 8 + 2 * it + 0) * 64 + lane) * 8) = PACK_STEP(acc, 0);
                *(bf16x8*)(nw + ((size_t)(rt * 8 + 2 * it + 1) * 64 + lane) * 8) = PACK_STEP(acc, 1);
            } else { const int rt = (tile - 8) >> 2, dvt = (tile - 8) & 3;
#pragma unroll
                for (int ks = 0; ks < 4; ++ks) acc = MFMA32(lds_frag(L + LA_TB, 32 * rt + r, 72, 16 * ks + 8 * h), lds_frag(L + LA_VBT, 32 * dvt + r, 72, 16 * ks + 8 * h), acc);
                float* uc = (float*)(rec + LA_UCG) + ((size_t)(dvt * 2 + rt) * 4 * 64 + lane) * 4;
#pragma unroll
                for (int q4 = 0; q4 < 4; ++q4) *(f32x4*)(uc + (size_t)q4 * 256) = (f32x4){acc[4 * q4], acc[4 * q4 + 1], acc[4 * q4 + 2], acc[4 * q4 + 3]};
            }
        }
        __syncthreads();
    }
    for (int item = F.vcu; item < 256; item += F.G) {
        const int tid = opq(tid0), lane = tid & 63, r = lane & 31, h = lane >> 5;
        const int b = item >> 6, ch = (item >> 1) & 31, g = item & 1;
        const size_t t0 = (size_t)b * SEQ + ch * 64;
        const float* BS = wsf(F, WS_BS) + t0 * 256 + g * 128; const float* CS = wsf(F, WS_CS) + t0 * 256 + g * 128;
        { const int c = tid & 127, lg = tid >> 7;
#pragma unroll 4
          for (int i = 0; i < 16; ++i) { const int l = lg * 16 + i;
              ((LAS bf16*)(L + LA_KB))[l * 136 + c] = (bf16)f2bf(BS[(size_t)l * 256 + c]); ((LAS bf16*)(L + LA_QB))[l * 136 + c] = (bf16)f2bf(CS[(size_t)l * 256 + c]); } }
        __syncthreads();
        f32x16 raw = zero16;
        const int mt = (wv >> 1) & 1, rt = wv & 1;
        if (wv < 4 && !(mt == 1 && rt == 0)) {
#pragma unroll
            for (int ks = 0; ks < 8; ++ks) raw = MFMA32(lds_frag(L + LA_KB, 32 * mt + r, 136, 16 * ks + 8 * h), lds_frag(L + LA_QB, 32 * rt + r, 136, 16 * ks + 8 * h), raw); }
#pragma unroll 1
        for (int hi = 0; hi < 4; ++hi) {
            const int hh = 4 * g + hi, seq = b * 8 + hh;
            unsigned char* rec = F.ws + WS_FS + ((size_t)seq * 32 + ch) * LA_RECS;
            if (wv == 0) { const f32x2v ad = *(const f32x2v*)(wsf(F, WS_DT) + (t0 + lane) * 16 + 2 * hh); Gv[lane] = wave_incl_scan(ad.x, lane); Bv[lane] = ad.y; }
            __syncthreads();
            const float G63 = Gv[63];
            { const int c = tid & 127, lg = tid >> 7;
#pragma unroll 4
              for (int i = 0; i < 16; ++i) { const int l = lg * 16 + i; ((LAS bf16*)(L + LA_KET))[c * 72 + l] = (bf16)f2bf(BS[(size_t)l * 256 + c] * __expf(G63 - Gv[l])); } }
            if (wv < 4) store_qk_frag(raw, Gv, mt, rt, r, h, lane, (bf16*)(rec + LA_QK));
            __syncthreads();
            for (int task = wv; task < 36; task += 8) {
                if (task < 16) qd_frag_task(CS, 256, Gv, task, r, h, lane, (bf16*)(rec + LA_QD));
                else if (task < 32) ke_frag_task(L + LA_KET, task - 16, r, h, lane, (bf16*)(rec + LA_KE));
                else { const int sl = (task - 32) >> 1, rt2 = (task - 32) & 1;
                    const float* xs = wsf(F, WS_XS) + t0 * GW + hh * 64 + 32 * sl + r;
                    float* uc = (float*)(rec + LA_UCS) + ((size_t)(sl * 2 + rt2) * 4 * 64 + lane) * 4;
#pragma unroll
                    for (int q4 = 0; q4 < 4; ++q4) { f32x4 v;
#pragma unroll
                        for (int e = 0; e < 4; ++e) { const int l = 32 * rt2 + crow(4 * q4 + e, h); v[e] = xs[(size_t)l * GW] * Bv[l]; }
                        *(f32x4*)(uc + (size_t)q4 * 256) = v; } }
            }
            if (tid == 0) wsf(F, WS_DLS)[seq * 32 + ch] = __expf(G63);
            __syncthreads();
        }
    }
}

template <bool HAS_W> __device__ __forceinline__ void la_seq_wave(LAS unsigned char* ring  , const unsigned char* recs, int recsz, int uc_off, const float* dls, float* outp  , int slice, int lane) {
    constexpr int NFR = HAS_W ? 56 : 40;
    constexpr int SLOT = (NFR + 8) * 1024;
    const int r = lane & 31, h = lane >> 5;
    const float dlv = (lane < 32) ? dls[lane] : 0.f;
    f32x16 S[4];
#pragma unroll
    for (int it = 0; it < 4; ++it)
#pragma unroll
        for (int q = 0; q < 16; ++q) S[it][q] = 0.f;
#define LA_DMA(c_, slot_) do { const unsigned char* rec_ = recs + (size_t)(c_) * recsz + lane * 16; LAS unsigned char* dst_ = ring + (slot_) * SLOT; \
        _Pragma("unroll") for (int i_ = 0; i_ < NFR; ++i_) __builtin_amdgcn_global_load_lds((const unsigned*)(rec_ + i_ * 1024), (LAS unsigned*)(dst_ + i_ * 1024), 16, 0, 0); \
        _Pragma("unroll") for (int i_ = 0; i_ < 8; ++i_) __builtin_amdgcn_global_load_lds((const unsigned*)(rec_ + uc_off + slice * 8192 + i_ * 1024), (LAS unsigned*)(dst_ + (NFR + i_) * 1024), 16, 0, 0); } while (0)
    LA_DMA(0, 0);
#pragma unroll 1
    for (int c = 0; c < 32; ++c) {
        asm volatile("s_waitcnt vmcnt(0) lgkmcnt(0)" ::: "memory");
        if (c + 1 < 32) LA_DMA(c + 1, (c + 1) & 1);
        const LAS unsigned char* B = ring + (c & 1) * SLOT + lane * 16;
#define FRAG(off, idx) (*(const LAS bf16x8*)(B + (off) + (idx) * 1024))
        bf16x8 sb[8];
#pragma unroll
        for (int it = 0; it < 4; ++it) { sb[2 * it] = PACK_STEP(S[it], 0); sb[2 * it + 1] = PACK_STEP(S[it], 1); }
        f32x16 Vn[2];
#pragma unroll
        for (int rt = 0; rt < 2; ++rt)
#pragma unroll
            for (int q4 = 0; q4 < 4; ++q4) { const f32x4 v = *(const LAS f32x4*)(B + NFR * 1024 + (rt * 4 + q4) * 1024); Vn[rt][4 * q4] = v.x; Vn[rt][4 * q4 + 1] = v.y; Vn[rt][4 * q4 + 2] = v.z; Vn[rt][4 * q4 + 3] = v.w; }
        if (HAS_W) {
#pragma unroll
            for (int ks = 0; ks < 8; ++ks) { Vn[0] = MFMA32(FRAG(LA_NW, 0 * 8 + ks), sb[ks], Vn[0]); Vn[1] = MFMA32(FRAG(LA_NW, 1 * 8 + ks), sb[ks], Vn[1]); } }
        bf16x8 vb[4];
#pragma unroll
        for (int rt = 0; rt < 2; ++rt) { vb[2 * rt] = PACK_STEP(Vn[rt], 0); vb[2 * rt + 1] = PACK_STEP(Vn[rt], 1); }
        f32x16 O[2];
#pragma unroll
        for (int rt = 0; rt < 2; ++rt)
#pragma unroll
            for (int q = 0; q < 16; ++q) O[rt][q] = 0.f;
#pragma unroll
        for (int ks = 0; ks < 8; ++ks) { O[0] = MFMA32(FRAG(LA_QD, 0 * 8 + ks), sb[ks], O[0]); O[1] = MFMA32(FRAG(LA_QD, 1 * 8 + ks), sb[ks], O[1]); }
#pragma unroll
        for (int ks = 0; ks < 4; ++ks) { O[0] = MFMA32(FRAG(LA_QK, 0 * 4 + ks), vb[ks], O[0]); O[1] = MFMA32(FRAG(LA_QK, 1 * 4 + ks), vb[ks], O[1]); }
        float* op = outp + (size_t)c * 64 * GW + r;
#pragma unroll
        for (int rt = 0; rt < 2; ++rt)
#pragma unroll
            for (int q = 0; q < 16; ++q) op[(size_t)(32 * rt + crow(q, h)) * GW] = O[rt][q];
        const float dl = __builtin_bit_cast(float, __builtin_amdgcn_readlane(__builtin_bit_cast(int, dlv), c));
#pragma unroll
        for (int it = 0; it < 4; ++it) {
#pragma unroll
            for (int q = 0; q < 16; ++q) S[it][q] *= dl;
#pragma unroll
            for (int ks = 0; ks < 4; ++ks) S[it] = MFMA32(FRAG(LA_KE, it * 4 + ks), vb[ks], S[it]);
        }
#undef FRAG
    }
#undef LA_DMA
    asm volatile("s_waitcnt vmcnt(0) lgkmcnt(0)" ::: "memory");
}
__device__ __forceinline__ void la_seq_phase(Frame& F, int l_unused) {
    const int lane = opq(F.lane);
    if (F.wave != 0) return;
#ifndef DBG_NOSEQ
    for (int item = F.vcu; item < 128; item += F.G) {
        if (item < 64) { const int seq = item >> 2, slice = item & 3, b = seq >> 2, hd = seq & 3;
            la_seq_wave<true>(F.lds + RING_OFF, F.ws + WS_FG + (size_t)seq * 32 * LA_RECG, LA_RECG, LA_UCG, wsf(F, WS_DLG) + seq * 32, wsf(F, WS_OG) + (size_t)b * SEQ * GW + hd * 128 + slice * 32, slice, lane);
        } else { const int j = item - 64, seq = j >> 1, slice = j & 1, b = seq >> 3, hh = seq & 7;
            la_seq_wave<false>(F.lds + RING_OFF, F.ws + WS_FS + (size_t)seq * 32 * LA_RECS, LA_RECS, LA_UCS, wsf(F, WS_DLS) + seq * 32, wsf(F, WS_YS) + (size_t)b * SEQ * GW + hh * 64 + slice * 32, slice, lane);
        }
    }
#endif
}

__device__ __forceinline__ void mixer_post_phase(Frame& F, int l) {
    const int gw = F.vcu * NWAVES + F.wave, NGW = F.G * NWAVES, lane = opq(F.lane), c = lane * 8;
    bf16* MIX = wsb(F, WS_MIX);
    const float* gng = inp(I_GNG) + (size_t)l * 128 + (c & 127); const float* sng = inp(I_SNG) + (size_t)l * GW + c;
    const f32x4 g0 = ld4(gng), g1 = ld4(gng + 4), n0 = ld4(sng), n1 = ld4(sng + 4);
    const float Dk = inp(I_SD)[l * 8 + (c >> 6)];
    for (int m = gw; m < M; m += NGW) {
        {
            const float* og = wsf(F, WS_OG) + (size_t)m * GW + c; const float* z = wsf(F, WS_ZG) + (size_t)m * GW + c;
            const f32x4 o0 = ld4(og), o1 = ld4(og + 4), z0 = ld4(z), z1 = ld4(z + 4);
            float ss = (o0.x * o0.x + o0.y * o0.y) + (o0.z * o0.z + o0.w * o0.w) + (o1.x * o1.x + o1.y * o1.y) + (o1.z * o1.z + o1.w * o1.w);
            ss += __shfl_xor(ss, 1); ss += __shfl_xor(ss, 2); ss += __shfl_xor(ss, 4); ss += __shfl_xor(ss, 8);
            const float rstd = 1.0f / sqrtf(ss * (1.0f / 128.0f) + EPS);
            const f32x4 y0 = o0 * rstd * g0 * silu4(z0), y1 = o1 * rstd * g1 * silu4(z1);
            v4u w; w.x = pk2(y0.x, y0.y); w.y = pk2(y0.z, y0.w); w.z = pk2(y1.x, y1.y); w.w = pk2(y1.z, y1.w);
            *(v4u*)(MIX + (size_t)m * DM + 2 * GW + c) = w;
        }
        {
            const float* ys = wsf(F, WS_YS) + (size_t)m * GW + c; const float* xs = wsf(F, WS_XS) + (size_t)m * GW + c; const float* z = wsf(F, WS_ZS) + (size_t)m * GW + c;
            const f32x4 a0 = (ld4(ys) + ld4(xs) * Dk) * silu4(ld4(z)), a1 = (ld4(ys + 4) + ld4(xs + 4) * Dk) * silu4(ld4(z + 4));
            float ss = (a0.x * a0.x + a0.y * a0.y) + (a0.z * a0.z + a0.w * a0.w) + (a1.x * a1.x + a1.y * a1.y) + (a1.z * a1.z + a1.w * a1.w);
            ss += __shfl_xor(ss, 1); ss += __shfl_xor(ss, 2); ss += __shfl_xor(ss, 4); ss += __shfl_xor(ss, 8); ss += __shfl_xor(ss, 16);
            const float rstd = 1.0f / sqrtf(ss * (1.0f / 256.0f) + EPS);
            const f32x4 y0 = a0 * rstd * n0, y1 = a1 * rstd * n1;
            v4u w; w.x = pk2(y0.x, y0.y); w.y = pk2(y0.z, y0.w); w.z = pk2(y1.x, y1.y); w.w = pk2(y1.z, y1.w);
            *(v4u*)(MIX + (size_t)m * DM + 3 * GW + c) = w;
        }
    }
}

#ifndef SKIPM
#define SKIPM 0
#endif
#ifndef REPM
#define REPM 0
#endif
#ifndef GEMM_SP2
#define GEMM_SP2 true
#endif
#ifndef GEMM_ALIGN
#define GEMM_ALIGN true
#endif
#ifndef PROBE_PH
#define PROBE_PH -1
#endif
constexpr int PH_PER_LAYER = 13, PH0 = 3, N_PHASES = PH0 + DEPTH * PH_PER_LAYER;
struct Args { const float* in[N_IN]; float* out; unsigned char* ws; int ph_lo, ph_hi; };
static_assert(sizeof(Args) == (N_IN + 2) * 8 + 8, "Args has no padding");
struct GemmDesc { const bf16* A; const bf16* Bt; void* C; int M, N, K, lda, ldb, ldc, mode, corder; float scale; };
__device__ __forceinline__ int gemm_nsub(int ph, int k) { return ph == 1 ? DEPTH : ph == 2 ? DEPTH * BATCH * XH * 2 : (k == 7 || k == 8) ? BATCH : 1; }
__device__ __forceinline__ void gemm_desc(const Frame& F, int ph, int sub, GemmDesc& d) {
    const int bx = (int)blockIdx.x;
    d.scale = 1.0f; d.corder = bx;
    if (ph == 1) {
        const int l = sub;
        d.A = wsb(F, WS_MEMN) + (size_t)l * MROWS * DM; d.Bt = (const bf16*)(F.ws + WS_W + (size_t)l * W_LAYER + WO_WKV); d.C = wsb(F, WS_KV) + (size_t)l * MROWS * 2 * DM;
        d.M = MROWS; d.N = 2 * DM; d.K = DM; d.lda = DM; d.ldb = DM; d.ldc = 2 * DM; d.mode = 1; d.corder = (bx + F.G - 64 * sub) % F.G; return;
    }
    if (ph == 2) {
        const int which = sub & 1, h = (sub >> 1) & 3, b = (sub >> 3) & 3, l = sub >> 5;
        const unsigned char* wl = F.ws + WS_W + (size_t)l * W_LAYER;
        const bf16* kv = wsb(F, WS_KV) + (size_t)l * MROWS * 2 * DM + (size_t)(b * MEML) * 2 * DM + h * XHD;
        d.K = XHD; d.mode = 1; d.corder = (bx + 64 * F.G - 8 * sub) % F.G;
        if (which == 0) {
            d.A = kv; d.lda = 2 * DM; d.Bt = (const bf16*)(wl + WO_WQ) + h * XHD; d.ldb = DM; d.M = MEML; d.N = DM;
            d.C = wsb(F, WS_AT) + ((size_t)(l * BATCH + b) * 1024 + h * MEML) * DM; d.ldc = DM; d.scale = 0.044194173824159216f;
        } else {
            d.A = (const bf16*)(wl + WO_WO) + h * XHD; d.lda = DM; d.Bt = kv + DM; d.ldb = 2 * DM; d.M = DM; d.N = MEML;
            d.C = wsb(F, WS_VWT) + (size_t)(l * BATCH + b) * DM * 1024 + h * MEML; d.ldc = 1024;
        }
        return;
    }
    const int l = (ph - PH0) / PH_PER_LAYER, k = (ph - PH0) % PH_PER_LAYER;
    const unsigned char* wl = F.ws + WS_W + (size_t)l * W_LAYER;
    d.M = M; d.K = DM; d.N = DM; d.lda = DM; d.ldb = DM; d.ldc = DM; d.mode = 0; d.A = wsb(F, WS_XN); d.C = wsf(F, WS_Y);
    if (k == 0) { d.Bt = (const bf16*)(wl + WO_WIN); d.N = IN_PAD; d.C = wsf(F, WS_U); d.ldc = IN_PAD; }
    else if (k == 5) { d.A = wsb(F, WS_MIX); d.Bt = (const bf16*)(wl + WO_WOUT); }
    else if (k == 7) {
        const int b = sub; d.A = wsb(F, WS_XN) + (size_t)b * SEQ * DM; d.Bt = wsb(F, WS_AT) + (size_t)(l * BATCH + b) * 1024 * DM; d.M = SEQ; d.N = 1024;
        d.C = wsb(F, WS_P) + (size_t)b * SEQ * 1024; d.ldc = 1024; d.mode = 3; d.corder = (bx + F.G - 32 * sub) % F.G; }
    else if (k == 8) {
        const int b = sub; d.A = wsb(F, WS_P) + (size_t)b * SEQ * 1024; d.lda = 1024; d.Bt = wsb(F, WS_VWT) + (size_t)(l * BATCH + b) * DM * 1024; d.ldb = 1024; d.M = SEQ; d.K = 1024;
        d.C = wsf(F, WS_Y) + (size_t)b * SEQ * DM; d.corder = (bx + F.G - 64 * sub) % F.G; }
    else if (k == 10) { d.Bt = (const bf16*)(wl + WO_WGU); d.N = 2 * DFF; d.mode = 2; d.C = wsb(F, WS_HID); d.ldc = DFF; }
    else { d.A = wsb(F, WS_HID); d.Bt = (const bf16*)(wl + WO_WD); d.K = DFF; d.lda = DFF; d.ldb = DFF; }
}

__global__ void __launch_bounds__(NWAVES * 64, 2) fwd_kernel(Args args) {
    extern __shared__ __attribute__((aligned(16))) unsigned char lds[];
    Frame F;
    F.lds = (LAS unsigned char*)lds;
    F.MISC = (volatile LAS unsigned*)(F.lds + MISC_OFF);
    F.tid = threadIdx.x; F.lane = F.tid & 63; F.wave = __builtin_amdgcn_readfirstlane(F.tid >> 6);
    F.G = gridDim.x; { const int bx = blockIdx.x; F.vcu = (F.G % 8 == 0) ? (bx % 8) * (F.G / 8) + bx / 8 : bx; }
    F.ws = args.ws; F.out = args.out; F.ctl = (unsigned*)(args.ws + WS_CTL);
    for (int u = F.tid; u < (LDS_BYTES - LDSCTL_OFF) / 4; u += NWAVES * 64) ((LAS unsigned*)(F.lds + LDSCTL_OFF))[u] = 0u;
    __syncthreads();
    const int lo = args.ph_lo, hi = args.ph_hi;
    XcdBarrier bar; bar.bar = F.ctl + CW_BAR; bar.x = 0; bar.st = nullptr;
    if (hi - lo > 1) bar = xcd_barrier_post(F.ctl + CW_BAR, F.MISC + 8);
    LAS unsigned char* ring = F.lds + RING_OFF;
    unsigned long long t_start = 0, t_probe = 0;
    if (PROBE_PH >= 0) t_start = __builtin_amdgcn_s_memrealtime();
#pragma unroll 1
    for (int ph = lo; ph < hi; ++ph) {
        const int l = ph >= PH0 ? (ph - PH0) / PH_PER_LAYER : 0, k = ph >= PH0 ? (ph - PH0) % PH_PER_LAYER : -1;
        const bool is_gemm = (ph == 1) || (ph == 2) || k == 0 || k == 5 || k == 7 || k == 8 || k == 10 || k == 11;
        const int kbit = (ph < PH0) ? ph : (k + PH0);
        const int reps = 1 + ((REPM >> kbit) & 1);
#pragma unroll 1
        for (int rep = 0; rep < reps; ++rep) {
        if (is_gemm) {
            const int nsub = gemm_nsub(ph, k);
#pragma unroll 1
            for (int sub = 0; sub < nsub; ++sub) {
                GemmDesc d; gemm_desc(F, ph, sub, d);
                pg8::Gemm g{d.A, d.Bt, d.M, d.N, d.K, d.lda, d.ldb}; pg8::StaticOrder S; S.init(d.M, d.N, F.G, d.corder);
                pg8::EpiAny E{d.C, d.ldc, d.mode, d.scale};
                pg8::gemm_phase<pg8::EpiAny, pg8::StaticOrder, GEMM_ALIGN, GEMM_SP2>(ring, g, S, E);
            }
        } else if (ph == 0) { p0_prologue(F); }
        else {
            const float* ng = inp(I_NORMG) + (size_t)l * N_NORMS * DM;
            if (k == 1) mixer_prep_phase(F, l);
            else if (k == 2) la_prep_phase(F, l);
            else if (k == 3) la_seq_phase(F, l);
            else if (k == 4) mixer_post_phase(F, l);
            else if (rep == 0) {
                if (k == 6) resnorm_phase(F, l == 0 ? inp(I_X) : F.out, ng + MIX_POST * DM, ng + XA_PRE * DM);
                else if (k == 9) resnorm_phase(F, F.out, ng + XA_POST * DM, ng + FFN_PRE * DM);
                else resnorm_phase(F, F.out, ng + FFN_POST * DM, (l + 1 < DEPTH) ? ng + (N_NORMS + MIX_PRE) * DM : nullptr);
            }
        }
        if (REPM >> 20) { if (rep + 1 < reps) __syncthreads(); }
        }
        if ((REPM >> 21) & 1) xcd_barrier(bar);
        if (ph + 1 < hi) xcd_barrier(bar);
        if (PROBE_PH >= 0 && ph == PROBE_PH) t_probe = __builtin_amdgcn_s_memrealtime();
    }
    if (PROBE_PH >= 0 && blockIdx.x == 0) {
        const unsigned long long t_end = __builtin_amdgcn_s_memrealtime();
        while (__builtin_amdgcn_s_memrealtime() - t_end < t_probe - t_start) __builtin_amdgcn_s_sleep(8);
    }
}

#ifndef MK_SINGLE
#define MK_SINGLE 0
#endif
extern "C" void kernel_launch(void* const* d_in, const int* in_sizes, int n_in, void* d_out, int out_size, void* d_ws, size_t ws_size, hipStream_t stream) {
    static int grid = 0;
    if (grid == 0) {
        if (n_in != N_IN || in_sizes[0] != M * DM || out_size != M * DM || ws_size < WS_END) { fprintf(stderr, "kernel_launch: unexpected problem (n_in %d, in0 %d, out %d, ws %zu < %zu)\n", n_in, n_in > 0 ? in_sizes[0] : -1, out_size, ws_size, (size_t)WS_END); grid = -1; return; }
        int dev = 0, cus = 0, per_cu = 0;
        if (hipGetDevice(&dev) != hipSuccess || hipDeviceGetAttribute(&cus, hipDeviceAttributeMultiprocessorCount, dev) != hipSuccess) { grid = -1; return; }
        if (hipFuncSetAttribute((const void*)fwd_kernel, hipFuncAttributeMaxDynamicSharedMemorySize, LDS_BYTES) != hipSuccess) { fprintf(stderr, "kernel_launch: hipFuncSetAttribute failed\n"); grid = -1; return; }
        if (hipOccupancyMaxActiveBlocksPerMultiprocessor(&per_cu, (const void*)fwd_kernel, NWAVES * 64, LDS_BYTES) != hipSuccess || per_cu < 1) { fprintf(stderr, "kernel_launch: occupancy query says %d blocks per CU\n", per_cu); per_cu = 1; }
        (void)hipGetLastError();
        grid = cus * (per_cu < 1 ? 1 : 1);
        if (grid != 256) fprintf(stderr, "kernel_launch: note: grid %d (expected 256)\n", grid);
    }
    if (grid < 0) return;
    if (hipMemsetAsync((char*)d_ws + WS_CTL, 0, CTL_ZERO_BYTES, stream) != hipSuccess) { fprintf(stderr, "kernel_launch: memset failed\n"); return; }
    Args a{};
    for (int i = 0; i < N_IN; ++i) a.in[i] = (const float*)d_in[i];
    a.out = (float*)d_out; a.ws = (unsigned char*)d_ws;
#if MK_SINGLE
    a.ph_lo = 0; a.ph_hi = N_PHASES;
    void* kargs[] = {&a};
    hipError_t e = hipLaunchCooperativeKernel((const void*)fwd_kernel, dim3(grid), dim3(NWAVES * 64), kargs, LDS_BYTES, stream);
    if (e != hipSuccess) fprintf(stderr, "kernel_launch: cooperative launch failed: %s (grid %d)\n", hipGetErrorString(e), grid);
#else
    for (int p = 0; p < N_PHASES; ++p) { a.ph_lo = p; a.ph_hi = p + 1;
        hipLaunchKernelGGL(fwd_kernel, dim3(grid), dim3(NWAVES * 64), LDS_BYTES, stream, a);
        const hipError_t le = hipPeekAtLastError(); if (le != hipSuccess) { fprintf(stderr, "kernel_launch: launch %d failed: %s\n", p, hipGetErrorName(le)); break; } }
#endif
}
```

```cpp
#include <hip/hip_runtime.h>
#include <cstdio>
#include <cstdint>
#define MK_SINGLE 1
namespace pg8 {
#define PG8_LAS __attribute__((address_space(3)))
typedef unsigned short bf16_t;
typedef short bf16x8 __attribute__((ext_vector_type(8)));
typedef float f32x4 __attribute__((ext_vector_type(4)));
typedef unsigned u32x4 __attribute__((ext_vector_type(4)));
constexpr int BM = 256, BK = 64, HALF = 128, HTB = HALF * BK * 2  , STAGE_BYTES = 8 * HTB, NXCD = 8, WGM = 8;

__host__ __device__ __forceinline__ int lds_byte(int r, int c) { const int st = (r >> 4) * 2 + (c >> 5), rr = r & 15, cc = c & 31, ob = rr * 64 + cc * 2; return st * 1024 + (ob ^ (((ob >> 9) & 1) << 5)); }
__host__ __device__ __forceinline__ void stage_rc(int b, int& R, int& C) { const int st = b / 1024, sb = b % 1024, swz = sb ^ (((sb >> 9) & 1) << 5); R = (st >> 1) * 16 + swz / 64; C = (st & 1) * 32 + (swz % 64) / 2; }
__host__ __device__ __forceinline__ int perm32(int rho) { const int n = rho >> 4, i = rho & 15; return 8 * (i >> 2) + 4 * n + (i & 3); }

struct Unit { int pm, pn; };
struct Gemm { const bf16_t* A; const bf16_t* Bt; int M, N, K, lda, ldb; };

struct StaticOrder {
    int nM, nN, nwg, G, c;
    __host__ __device__ void init(int M, int N, int G_, int c_) { nM = M / BM; nN = N / BM; nwg = nM * nN; G = G_; c = c_; }
    __host__ __device__ bool next(int i, Unit& u) const {
        const long L = (long)i * G + c; if (L >= nwg) return false;
        int wgid = (int)L; { const int q = nwg / NXCD, r = nwg % NXCD, xcd = wgid % NXCD, off = wgid / NXCD; wgid = (xcd < r ? xcd * (q + 1) : r * (q + 1) + (xcd - r) * q) + off; }
        const int nig = WGM * nN, gid = wgid / nig, fm = gid * WGM, gsz = (nM - fm) < WGM ? (nM - fm) : WGM;
        u.pm = fm + ((wgid % nig) % gsz); u.pn = (wgid % nig) / gsz; return true;
    }
    __device__ __forceinline__ void a_ready(const Unit&) const {}
    __device__ __forceinline__ void done(const Unit&) const {}
};

__device__ __forceinline__ unsigned cvt_pk_bf16(float lo, float hi) { unsigned r; asm volatile("v_cvt_pk_bf16_f32 %0, %1, %2" : "=v"(r) : "v"(lo), "v"(hi)); return r; }
struct EpiF32 {
    static constexpr bool PERM = false, AFTER_DRAIN = false;
    float* C; int ldc;
    __device__ __forceinline__ void operator()(const f32x4 (&acc)[2][2][4][2], const Unit& u, int wr, int wc, int fr, int fq) const {
        const int row0 = u.pm * BM + wr * 64 + fr, col0 = u.pn * BM + wc * 32 + 4 * fq;
#pragma unroll
        for (int ai = 0; ai < 2; ++ai)
#pragma unroll
            for (int m = 0; m < 4; ++m) { float* rowp = C + (size_t)(row0 + ai * HALF + m * 16) * ldc + col0;
#pragma unroll
                for (int bj = 0; bj < 2; ++bj)
#pragma unroll
                    for (int n = 0; n < 2; ++n) *(f32x4*)(rowp + bj * HALF + n * 16) = acc[ai][bj][m][n]; }
    }
};
struct EpiBf16S {
    static constexpr bool PERM = true, AFTER_DRAIN = false;
    bf16_t* O; int ldc; float scale;
    __device__ __forceinline__ void operator()(const f32x4 (&acc)[2][2][4][2], const Unit& u, int wr, int wc, int fr, int fq) const {
        const int row0 = u.pm * BM + wr * 64 + fr, col0 = u.pn * BM + wc * 32 + 8 * fq; const float sc = scale;
#pragma unroll
        for (int ai = 0; ai < 2; ++ai)
#pragma unroll
            for (int m = 0; m < 4; ++m) { bf16_t* rowp = O + (size_t)(row0 + ai * HALF + m * 16) * ldc + col0;
#pragma unroll
                for (int bj = 0; bj < 2; ++bj) { const f32x4 v0 = acc[ai][bj][m][0] * sc, v1 = acc[ai][bj][m][1] * sc;
                    u32x4 w; w.x = cvt_pk_bf16(v0[0], v0[1]); w.y = cvt_pk_bf16(v0[2], v0[3]); w.z = cvt_pk_bf16(v1[0], v1[1]); w.w = cvt_pk_bf16(v1[2], v1[3]);
                    *(u32x4*)(rowp + bj * HALF) = w; } }
    }
};
__device__ __forceinline__ float silu_f(float v) { return v / (1.0f + __expf(-v)); }
struct EpiSwiGLU {
    static constexpr bool PERM = true, AFTER_DRAIN = false;
    bf16_t* O; int ldc;
    __device__ __forceinline__ void operator()(const f32x4 (&acc)[2][2][4][2], const Unit& u, int wr, int wc, int fr, int fq) const {
        const int row0 = u.pm * BM + wr * 64 + fr, col0 = u.pn * HALF + wc * 32 + 8 * fq;
#pragma unroll
        for (int ai = 0; ai < 2; ++ai)
#pragma unroll
            for (int m = 0; m < 4; ++m) { bf16_t* rowp = O + (size_t)(row0 + ai * HALF + m * 16) * ldc + col0;
                const f32x4 g0 = acc[ai][0][m][0], g1 = acc[ai][0][m][1], u0 = acc[ai][1][m][0], u1 = acc[ai][1][m][1];
                u32x4 w; w.x = cvt_pk_bf16(silu_f(g0[0]) * u0[0], silu_f(g0[1]) * u0[1]); w.y = cvt_pk_bf16(silu_f(g0[2]) * u0[2], silu_f(g0[3]) * u0[3]);
                w.z = cvt_pk_bf16(silu_f(g1[0]) * u1[0], silu_f(g1[1]) * u1[1]); w.w = cvt_pk_bf16(silu_f(g1[2]) * u1[2], silu_f(g1[3]) * u1[3]);
                *(u32x4*)rowp = w; }
    }
};
template <class Epi, class Sched, bool ALIGN_EPI = false, bool SP2 = false>
__device__ __forceinline__ void gemm_phase(PG8_LAS unsigned char* lds, const Gemm g, const Sched& S, const Epi& E) {
    int tid_ = threadIdx.x; asm volatile("" : "+v"(tid_));
    const int tid = tid_, wid = __builtin_amdgcn_readfirstlane(tid >> 6), lane = tid & 63, wr = wid >> 2, wc = wid & 3, fr = lane & 15, fq = lane >> 4;
    const int K = g.K, nt = K / BK;
    unsigned voffA[2], voffB[2];
#pragma unroll
    for (int i = 0; i < 2; ++i) { int R, C; stage_rc(tid * 16 + i * 8192, R, C); const int Rb = E.perm() ? ((R & ~31) + perm32(R & 31)) : R;
        voffA[i] = (unsigned)(R * g.lda + C) * 2u; voffB[i] = (unsigned)(Rb * g.ldb + C) * 2u; }
    const size_t kstep = (size_t)(BK * 2);
    const size_t hstepA = (size_t)HALF * g.lda * 2, hstepB = (size_t)HALF * g.ldb * 2;
    const size_t tstepA = 2 * hstepA, tstepB = 2 * hstepB;
    const unsigned ldsw = (unsigned)wid * 1024u;
    const int aoff = lds_byte(wr * 64 + fr, fq * 8), boff = lds_byte(wc * 32 + fr, fq * 8);
#define PG8_SA(b, h) (((b) * 2 + (h)) * HTB)
#define PG8_SB(b, h) ((4 + (b) * 2 + (h)) * HTB)
#define PG8_STAGE(bufoff, gbase, voff) do { _Pragma("unroll") for (int _i = 0; _i < 2; ++_i) \
        __builtin_amdgcn_global_load_lds((const unsigned*)((const char*)(gbase) + (voff)[_i]), (PG8_LAS unsigned*)(lds + (bufoff) + ldsw + _i * 8192), 16, 0, 0); } while (0)
#define PG8_LDA(dst, b, h) do { _Pragma("unroll") for (int m = 0; m < 4; ++m) _Pragma("unroll") for (int k = 0; k < 2; ++k) dst[m][k] = *(const PG8_LAS bf16x8*)(lds + PG8_SA(b, h) + aoff + m * 2048 + k * 1024); } while (0)
#define PG8_LDB(dst, b, h) do { _Pragma("unroll") for (int n = 0; n < 2; ++n) _Pragma("unroll") for (int k = 0; k < 2; ++k) dst[n][k] = *(const PG8_LAS bf16x8*)(lds + PG8_SB(b, h) + boff + n * 2048 + k * 1024); } while (0)
#define PG8_MMA(ai, bj, At, Bt) do { __builtin_amdgcn_s_setprio(1); _Pragma("unroll") for (int m = 0; m < 4; ++m) _Pragma("unroll") for (int n = 0; n < 2; ++n) _Pragma("unroll") for (int k = 0; k < 2; ++k) \
        acc[ai][bj][m][n] = __builtin_amdgcn_mfma_f32_16x16x32_bf16(Bt[n][k], At[m][k], acc[ai][bj][m][n], 0, 0, 0); __builtin_amdgcn_s_setprio(0); } while (0)
#define PG8_WAIT_V(n) asm volatile("s_waitcnt vmcnt(" #n ")" ::: "memory")
#define PG8_WAIT_L(n) asm volatile("s_waitcnt lgkmcnt(" #n ")" ::: "memory")
#define PG8_BAR __builtin_amdgcn_s_barrier()
#define PG8_SCHED __builtin_amdgcn_sched_barrier(0)
    Unit cur, nxt; int ui = 0;
    if (!S.next(0, cur)) return;
    f32x4 acc[2][2][4][2];
#pragma unroll
    for (int a = 0; a < 2; ++a)
#pragma unroll
        for (int b = 0; b < 2; ++b)
#pragma unroll
            for (int m = 0; m < 4; ++m)
#pragma unroll
                for (int n = 0; n < 2; ++n) acc[a][b][m][n] = (f32x4){0.f, 0.f, 0.f, 0.f};
    bf16x8 At[4][2], B0[2][2], B1[2][2];
#pragma unroll
    for (int m = 0; m < 4; ++m)
#pragma unroll
        for (int k = 0; k < 2; ++k) asm volatile("" : "=v"(At[m][k]));
#pragma unroll
    for (int n = 0; n < 2; ++n)
#pragma unroll
        for (int k = 0; k < 2; ++k) { asm volatile("" : "=v"(B0[n][k])); asm volatile("" : "=v"(B1[n][k])); }
    const char* cA = (const char*)g.A + (size_t)cur.pm * tstepA; const char* cB = (const char*)g.Bt + (size_t)cur.pn * tstepB;
    S.a_ready(cur);
    if constexpr (SP2) {
        PG8_STAGE(PG8_SB(0, 0), cB, voffB); PG8_STAGE(PG8_SB(0, 1), cB + hstepB, voffB); PG8_STAGE(PG8_SA(0, 0), cA, voffA); PG8_STAGE(PG8_SA(0, 1), cA + hstepA, voffA);
        if (wr == 1) PG8_BAR;
        PG8_WAIT_V(2); PG8_BAR;
        PG8_STAGE(PG8_SB(1, 0), cB + kstep, voffB); PG8_STAGE(PG8_SA(1, 0), cA + kstep, voffA); PG8_STAGE(PG8_SB(1, 1), cB + hstepB + kstep, voffB);
        PG8_WAIT_V(6); PG8_BAR;
    } else {
        PG8_STAGE(PG8_SB(0, 0), cB, voffB); PG8_STAGE(PG8_SA(0, 0), cA, voffA); PG8_STAGE(PG8_SB(0, 1), cB + hstepB, voffB); PG8_STAGE(PG8_SA(0, 1), cA + hstepA, voffA);
        if (wr == 1) PG8_BAR;
        PG8_WAIT_V(4); PG8_BAR;
        PG8_STAGE(PG8_SB(1, 0), cB + kstep, voffB); PG8_STAGE(PG8_SA(1, 0), cA + kstep, voffA); PG8_STAGE(PG8_SB(1, 1), cB + hstepB + kstep, voffB);
        PG8_WAIT_V(6); PG8_BAR;
    }
    for (;;) {
        const bool has_next = S.next(ui + 1, nxt);
        const char* nA = has_next ? (const char*)g.A + (size_t)nxt.pm * tstepA : cA; const char* nB = has_next ? (const char*)g.Bt + (size_t)nxt.pn * tstepB : cB;
        for (int t = 0; t < nt; t += 2) {
            const bool last = (t == nt - 2);
            const char* a1 = cA + (size_t)(t + 1) * kstep;
            const char* a2 = last ? nA : cA + (size_t)(t + 2) * kstep; const char* b2 = last ? nB : cB + (size_t)(t + 2) * kstep;
            const char* a3 = a2 + kstep; const char* b3 = b2 + kstep;
            if (last && has_next) S.a_ready(nxt);
            if constexpr (SP2) {
            PG8_LDB(B0, 0, 0); PG8_LDB(B1, 0, 1); PG8_SCHED; PG8_LDA(At, 0, 0); PG8_STAGE(PG8_SA(1, 1), a1 + hstepA, voffA);
            PG8_WAIT_V(8); PG8_WAIT_L(0); PG8_BAR; PG8_MMA(0, 0, At, B0); PG8_MMA(0, 1, At, B1); PG8_BAR; PG8_SCHED;
            PG8_LDA(At, 0, 1); PG8_STAGE(PG8_SB(0, 0), b2, voffB); PG8_STAGE(PG8_SB(0, 1), b2 + hstepB, voffB); PG8_STAGE(PG8_SA(0, 0), a2, voffA);
            PG8_WAIT_V(8); PG8_WAIT_L(0); PG8_BAR; PG8_MMA(1, 0, At, B0); PG8_MMA(1, 1, At, B1); PG8_BAR; PG8_SCHED;
            PG8_LDB(B0, 1, 0); PG8_LDB(B1, 1, 1); PG8_SCHED; PG8_LDA(At, 1, 0); PG8_STAGE(PG8_SA(0, 1), a2 + hstepA, voffA);
            PG8_WAIT_V(8); PG8_WAIT_L(0); PG8_BAR; PG8_MMA(0, 0, At, B0); PG8_MMA(0, 1, At, B1); PG8_BAR; PG8_SCHED;
            PG8_LDA(At, 1, 1); PG8_STAGE(PG8_SB(1, 0), b3, voffB); PG8_STAGE(PG8_SB(1, 1), b3 + hstepB, voffB); PG8_STAGE(PG8_SA(1, 0), a3, voffA);
            PG8_WAIT_V(8); PG8_WAIT_L(0); PG8_BAR; PG8_MMA(1, 0, At, B0); PG8_MMA(1, 1, At, B1); PG8_BAR; PG8_SCHED;
            } else {
            PG8_LDB(B0, 0, 0); PG8_SCHED; PG8_LDA(At, 0, 0); PG8_STAGE(PG8_SA(1, 1), a1 + hstepA, voffA);
            PG8_WAIT_L(8); PG8_BAR; PG8_WAIT_L(0); PG8_MMA(0, 0, At, B0); PG8_BAR; PG8_SCHED;
            PG8_LDB(B1, 0, 1); PG8_STAGE(PG8_SB(0, 0), b2, voffB);
            PG8_BAR; PG8_WAIT_L(0); PG8_MMA(0, 1, At, B1); PG8_BAR;
            PG8_LDA(At, 0, 1); PG8_STAGE(PG8_SA(0, 0), a2, voffA);
            PG8_BAR; PG8_WAIT_L(0); PG8_MMA(1, 0, At, B0); PG8_BAR; PG8_SCHED;
            PG8_STAGE(PG8_SB(0, 1), b2 + hstepB, voffB);
            PG8_WAIT_V(6); PG8_BAR; PG8_MMA(1, 1, At, B1); PG8_BAR;
            PG8_LDB(B0, 1, 0); PG8_SCHED; PG8_LDA(At, 1, 0); PG8_STAGE(PG8_SA(0, 1), a2 + hstepA, voffA);
            PG8_WAIT_L(8); PG8_BAR; PG8_WAIT_L(0); PG8_MMA(0, 0, At, B0); PG8_BAR; PG8_SCHED;
            PG8_LDB(B1, 1, 1); PG8_STAGE(PG8_SB(1, 0), b3, voffB);
            PG8_BAR; PG8_WAIT_L(0); PG8_MMA(0, 1, At, B1); PG8_BAR;
            PG8_LDA(At, 1, 1); PG8_STAGE(PG8_SA(1, 0), a3, voffA);
            PG8_BAR; PG8_WAIT_L(0); PG8_MMA(1, 0, At, B0); PG8_BAR; PG8_SCHED;
            PG8_STAGE(PG8_SB(1, 1), b3 + hstepB, voffB);
            PG8_WAIT_V(6); PG8_BAR; PG8_MMA(1, 1, At, B1); PG8_BAR;
            }
        }
        if constexpr (ALIGN_EPI) { if (wr == 0) PG8_BAR; }
        if constexpr (!Epi::AFTER_DRAIN) { E(acc, cur, wr, wc, fr, fq); S.done(cur); }
        if (!has_next) break;
#pragma unroll
        for (int a = 0; a < 2; ++a)
#pragma unroll
            for (int b = 0; b < 2; ++b)
#pragma unroll
                for (int m = 0; m < 4; ++m)
#pragma unroll
                    for (int n = 0; n < 2; ++n) acc[a][b][m][n] = (f32x4){0.f, 0.f, 0.f, 0.f};
        cur = nxt; cA = nA; cB = nB; ++ui;
        if constexpr (ALIGN_EPI) { if (wr == 1) PG8_BAR; }
    }
    PG8_WAIT_V(0);
    if constexpr (!ALIGN_EPI) { if (wr == 0) PG8_BAR; }
    PG8_BAR;
    if constexpr (Epi::AFTER_DRAIN) { E.fused(acc, cur, wr, wc, fr, fq, lds, wid, lane); S.done(cur); }
    if constexpr (Epi::RT_DRAIN) { if (E.drain()) E.fused(acc, cur, wr, wc, fr, fq, lds, wid, lane); }
#undef PG8_SA
#undef PG8_SB
#undef PG8_STAGE
#undef PG8_LDA
#undef PG8_LDB
#undef PG8_MMA
#undef PG8_WAIT_V
#undef PG8_WAIT_L
#undef PG8_BAR
#undef PG8_SCHED
}
}
constexpr int NWAVES = 8;
constexpr int BATCH = 4, SEQ = 2048, DM = 2048, DEPTH = 2;
constexpr int M = BATCH * SEQ;
constexpr int GW = 512;
constexpr int IN_COLS = 5648, IN_PAD = 5888;
constexpr int DFF = 5632, MEML = 256, XH = 4, XHD = 512;
constexpr int MROWS = BATCH * MEML;
constexpr float EPS = 1e-6f;
constexpr int UA_B = 0, UA_C = 512, UA_H = 1024, UB = 1536, UC_Q = 2048, UC_Z = 3584, UC_A = 4096, UC_B = 4100, UD_Z = 4104, UD_X = 4616, UD_DT = 5640;
constexpr int MIX_PRE = 0, MIX_POST = 1, XA_PRE = 2, XA_POST = 3, MEM_NORM = 4, FFN_PRE = 5, FFN_POST = 6, N_NORMS = 7;
enum { I_X = 0, I_MEM, I_NORMG, I_WIN, I_CONVA, I_POOLW, I_POOLS, I_GCONV, I_GALOG, I_GDTB, I_GNG, I_SCONVW, I_SCONVB, I_SALOG, I_SDTB, I_SD, I_SNG, I_WOUT, I_WQ, I_WKV, I_WO, I_WGU, I_WD, N_IN };

constexpr size_t MiB = 1u << 20;
constexpr size_t WS_CTL = 0, CTL_ZERO_BYTES = 1 * MiB;
constexpr size_t WSZ_WIN = (size_t)IN_PAD * DM * 2, WSZ_SQ = (size_t)DM * DM * 2, WSZ_KV = (size_t)2 * DM * DM * 2, WSZ_GU = (size_t)2 * DFF * DM * 2, WSZ_D = (size_t)DM * DFF * 2;
constexpr size_t WO_WIN = 0, WO_WOUT = WO_WIN + WSZ_WIN, WO_WQ = WO_WOUT + WSZ_SQ, WO_WKV = WO_WQ + WSZ_SQ, WO_WO = WO_WKV + WSZ_KV, WO_WGU = WO_WO + WSZ_SQ, WO_WD = WO_WGU + WSZ_GU, W_LAYER = WO_WD + WSZ_D;
constexpr size_t WS_W = 1 * MiB;
constexpr size_t WS_XN = WS_W + 2 * W_LAYER;
constexpr size_t WS_MIX = WS_XN + (size_t)M * DM * 2;
constexpr size_t WS_MEMN = WS_MIX + (size_t)M * DM * 2;
constexpr size_t WS_KV = WS_MEMN + (size_t)2 * MROWS * DM * 2;
constexpr size_t WS_U = WS_KV + (size_t)2 * MROWS * 2 * DM * 2;
constexpr size_t WS_P = WS_U, WS_HID = WS_U + (size_t)M * DM * 2;
constexpr size_t WS_UEND = WS_U + (size_t)120 * MiB;
constexpr size_t WS_ZG = WS_UEND, WS_ZS = WS_ZG + (size_t)M * 512 * 2, WS_BS = WS_ZS + (size_t)M * 512 * 2, WS_CS = WS_BS + (size_t)M * 256 * 4;
constexpr size_t WS_SCR = WS_CS + (size_t)M * 256 * 4;
constexpr size_t WS_Y = WS_SCR;
constexpr size_t SZ512 = (size_t)M * 512 * 4, SZ256 = (size_t)M * 256 * 4, SZ8 = (size_t)M * 8 * 4;
constexpr size_t WS_QN = WS_SCR, WS_KN = WS_QN + SZ512, WS_VV = WS_KN + SZ512, WS_OG = WS_VV + SZ512, WS_XS = WS_OG + SZ512, WS_YS = WS_XS + SZ512,
                 WS_GB = WS_YS + SZ512, WS_DT = WS_GB + SZ8, WS_SCR_END = WS_DT + 2 * SZ8;
constexpr size_t WS_AT = WS_SCR_END, WS_VWT = WS_AT + (size_t)DEPTH * BATCH * 1024 * DM * 2, WS_END = WS_VWT + (size_t)DEPTH * BATCH * DM * 1024 * 2;
constexpr int LA_QD = 0, LA_QK = 16384, LA_KE = 24576, LA_NW = 40960, LA_UCG = 57344, LA_RECG = 90112;
constexpr int LA_UCS = 40960, LA_RECS = 57344;
constexpr size_t WS_FG = WS_U, WS_FS = WS_FG + (size_t)512 * LA_RECG, WS_DLG = WS_FS + (size_t)1024 * LA_RECS, WS_DLS = WS_DLG + 512 * 4, WS_FEND = WS_DLS + 1024 * 4;
static_assert(WS_FEND <= WS_UEND, "records inside U");
static_assert(WS_Y + (size_t)M * DM * 4 <= WS_SCR_END, "Y inside the scan region");
static_assert(WS_HID + (size_t)M * DFF * 2 <= WS_UEND && (size_t)M * IN_PAD * 2 <= (size_t)120 * MiB, "HID and U inside the U region");
static_assert(WS_END <= (size_t)704 * MiB, "d_ws map fits 4 x the largest input");

constexpr int RING_OFF = 0, RING_BYTES = 131072;
constexpr int LDSCTL_OFF = RING_BYTES, MISC_OFF = LDSCTL_OFF + 320;
constexpr int LDS_BYTES = 147456;
constexpr int CW_BAR = 4096;

#define GAS __attribute__((address_space(1)))
#define LAS __attribute__((address_space(3)))
typedef unsigned short bf16;
typedef unsigned v4u __attribute__((ext_vector_type(4)));
typedef unsigned v2u __attribute__((ext_vector_type(2)));
typedef float f32x4 __attribute__((ext_vector_type(4)));
typedef short bf16x8 __attribute__((ext_vector_type(8)));
#define LDS_WAIT() asm volatile("s_waitcnt lgkmcnt(0)" ::: "memory")
#define VM_WAIT() asm volatile("s_waitcnt vmcnt(0)" ::: "memory")
__device__ __forceinline__ unsigned f2bf(float f) { unsigned u = __builtin_bit_cast(unsigned, f); return (u + 0x7fffu + ((u >> 16) & 1u)) >> 16; }
__device__ __forceinline__ unsigned pk2(float lo, float hi) { return f2bf(lo) | (f2bf(hi) << 16); }
__device__ __forceinline__ float siluf(float v) { return v / (1.0f + __expf(-v)); }
__device__ __forceinline__ float softplusf(float v) { return fmaxf(v, 0.f) + __logf(1.0f + __expf(-fabsf(v))); }
__device__ __forceinline__ float sigmoidf(float v) { return 1.0f / (1.0f + __expf(-v)); }
__device__ __forceinline__ f32x4 ld4(const float* p) { return *(const f32x4*)p; }
__device__ __forceinline__ f32x4 silu4(f32x4 v) { return (f32x4){siluf(v.x), siluf(v.y), siluf(v.z), siluf(v.w)}; }
template <int CTRL> __device__ __forceinline__ float dppf(float v) { return __builtin_bit_cast(float, __builtin_amdgcn_update_dpp(0, __builtin_bit_cast(int, v), CTRL, 0xF, 0xF, true)); }
__device__ __forceinline__ float row16_sum(float v) { v += dppf<0xB1>(v); v += dppf<0x4E>(v); v += dppf<0x141>(v); v += dppf<0x140>(v); return v; }
__device__ __forceinline__ int opq(int v) { asm volatile("" : "+v"(v)); return v; }
__device__ __forceinline__ float shx(float v, int m, int lane) { return __builtin_bit_cast(float, __builtin_amdgcn_ds_bpermute((lane ^ m) << 2, __builtin_bit_cast(int, v))); }
__device__ __forceinline__ float wave_sum(float v) {
    v = row16_sum(v);
    const int iv = __builtin_bit_cast(int, v);
    return (__builtin_bit_cast(float, __builtin_amdgcn_readlane(iv, 0)) + __builtin_bit_cast(float, __builtin_amdgcn_readlane(iv, 16))) + (__builtin_bit_cast(float, __builtin_amdgcn_readlane(iv, 32)) + __builtin_bit_cast(float, __builtin_amdgcn_readlane(iv, 48)));
}

#define XB_TMO      128
#define XB_XCNT(j)  (256  + 64 * (j))
#define XB_XSUB(j)  (1280 + 64 * (j))
#define XB_XGEN(j)  (2304 + 64 * (j))
#define XB_TOP      3328
#define XB_TOPGEN   3392
#define XCD_BAR_WORDS 3456
#define XB_SPIN_CAP (1u << 18)

__device__ __forceinline__ unsigned xb_ld(unsigned* p)              { return __hip_atomic_load(p, __ATOMIC_RELAXED, __HIP_MEMORY_SCOPE_AGENT); }
__device__ __forceinline__ unsigned xb_add(unsigned* p, unsigned v) { return __hip_atomic_fetch_add(p, v, __ATOMIC_RELAXED, __HIP_MEMORY_SCOPE_AGENT); }
__device__ __forceinline__ unsigned xb_xcc_id() { return (unsigned)__builtin_amdgcn_s_getreg((3 << 11) | 20) & 0xFu; }
#define XB_SPIN(cond, bar) do { unsigned _sp = 0; while (cond) { __builtin_amdgcn_s_sleep(1); \
    if ((++_sp & 255u) == 0u) { if (xb_ld(&(bar)[XB_TMO])) break; if (_sp > XB_SPIN_CAP) { atomicAdd(&(bar)[XB_TMO], 1u); break; } } } } while (0)

struct XcdBarrier {
    unsigned* bar; unsigned x;
    volatile LAS unsigned* st;
};

__device__ __forceinline__ XcdBarrier xcd_barrier_post(unsigned* bar, volatile LAS unsigned* st) {
    XcdBarrier b; b.bar = bar; b.x = xb_xcc_id(); b.st = st;
    if (threadIdx.x == 0) (void)xb_add(&bar[XB_XCNT(b.x)], 1u);
    return b;
}
__device__ __forceinline__ void xcd_barrier_complete(unsigned* bar, unsigned x, unsigned& nloc, unsigned& nx) {
    const unsigned G = gridDim.x * gridDim.y * gridDim.z;
    unsigned sum, cnt, mine, sp = 0u;
    for (;;) {
        sum = 0u; cnt = 0u; mine = 0u;
#pragma unroll
        for (unsigned j = 0; j < 16; ++j) { const unsigned c = xb_ld(&bar[XB_XCNT(j)]); sum += c; cnt += (c > 0u) ? 1u : 0u; mine = (j == x) ? c : mine; }
        if (sum == G) break;
        __builtin_amdgcn_s_sleep(1);
        if ((++sp & 255u) == 0u) { if (xb_ld(&bar[XB_TMO])) break; if (sp > XB_SPIN_CAP) { atomicAdd(&bar[XB_TMO], 1u); break; } }
    }
    nloc = mine > 0u ? mine : 1u; nx = cnt > 0u ? cnt : 1u;
}

__device__ __forceinline__ void xcd_barrier(const XcdBarrier& b) {
    asm volatile("s_waitcnt vmcnt(0)" ::: "memory");
    __syncthreads();
    if (threadIdx.x == 0) {
        unsigned* bar = b.bar;
        __builtin_amdgcn_s_waitcnt(0);
        unsigned nloc = b.st[0], nx = b.st[1];
        if (nloc == 0u) { xcd_barrier_complete(bar, b.x, nloc, nx); b.st[0] = nloc; b.st[1] = nx; }
        const unsigned old = xb_add(&bar[XB_XSUB(b.x)], 1u);
        const unsigned gen = old / nloc;
        if (old + 1u == (gen + 1u) * nloc) {
            __builtin_amdgcn_fence(__ATOMIC_RELEASE, "agent");
            asm volatile("s_waitcnt vmcnt(0)" ::: "memory");
            const unsigned og = xb_add(&bar[XB_TOP], 1u);
            const unsigned tg = og / nx;
            if (og + 1u == (tg + 1u) * nx) xb_add(&bar[XB_TOPGEN], 1u);
            else XB_SPIN(xb_ld(&bar[XB_TOPGEN]) == tg, bar);
            __builtin_amdgcn_fence(__ATOMIC_ACQUIRE, "agent");
            xb_add(&bar[XB_XGEN(b.x)], 1u);
            asm volatile("s_waitcnt vmcnt(0)" ::: "memory");
        } else {
            XB_SPIN(xb_ld(&bar[XB_XGEN(b.x)]) == gen, bar);
            __builtin_amdgcn_fence(__ATOMIC_ACQUIRE, "agent");
            asm volatile("s_waitcnt vmcnt(0)" ::: "memory");
        }
    }
    __syncthreads();
}
struct Frame {
    LAS unsigned char* lds;
    volatile LAS unsigned* MISC;
    unsigned* ctl;
    int tid, lane, wave;
    int vcu, G;
    float* out; unsigned char* ws;
};
__device__ __forceinline__ const float* inp(int i) { const float* __attribute__((address_space(4))) const* tab = (const float* __attribute__((address_space(4))) const*)__builtin_amdgcn_kernarg_segment_ptr(); asm volatile("" : "+s"(tab)); return tab[i]; }
__device__ __forceinline__ bf16* wsb(const Frame& F, size_t off) { return (bf16*)(F.ws + off); }
__device__ __forceinline__ float* wsf(const Frame& F, size_t off) { return (float*)(F.ws + off); }

__device__ __forceinline__ void p0_transpose_item(const float* W, int K, int N, bf16* WT, int drow0, int k0, int n0, LAS float* scr, int lane) {
    const int nn = n0 + (lane & 31); const bool ok = nn < N;
    float wv_[32];
#pragma unroll
    for (int i = 0; i < 32; ++i) { const int kk = 2 * i + (lane >> 5); wv_[i] = ok ? W[(size_t)(k0 + kk) * N + nn] : 0.f; }
#pragma unroll
    for (int i = 0; i < 32; ++i) { const int kk = 2 * i + (lane >> 5); scr[kk * 33 + (lane & 31)] = wv_[i]; }
    LDS_WAIT(); asm volatile("" ::: "memory");
    const int c = lane & 7;
#pragma unroll
    for (int j = 0; j < 4; ++j) { const int n = (lane >> 3) + 8 * j; const LAS float* s = scr + (8 * c) * 33 + n;
        v4u o; o.x = pk2(s[0 * 33], s[1 * 33]); o.y = pk2(s[2 * 33], s[3 * 33]); o.z = pk2(s[4 * 33], s[5 * 33]); o.w = pk2(s[6 * 33], s[7 * 33]);
        *(v4u*)(WT + (size_t)(drow0 + n) * K + k0 + 8 * c) = o; }
    LDS_WAIT(); asm volatile("" ::: "memory");
}
__device__ __forceinline__ void norm_row_to_bf16(const float* xrow, const float* g, bf16* orow, int lane) {
    const f32x4* xr = (const f32x4*)xrow + lane; const f32x4* gr = (const f32x4*)g + lane;
    f32x4 v[8]; float s = 0.f;
#pragma unroll
    for (int j = 0; j < 8; ++j) { v[j] = xr[64 * j]; s += (v[j].x * v[j].x + v[j].y * v[j].y) + (v[j].z * v[j].z + v[j].w * v[j].w); }
    const float rstd = 1.0f / sqrtf(wave_sum(s) * (1.0f / DM) + EPS);
    v2u* o8 = (v2u*)orow + lane;
#pragma unroll
    for (int j = 0; j < 8; ++j) { const f32x4 gg = gr[64 * j]; v2u w; w.x = pk2(v[j].x * rstd * gg.x, v[j].y * rstd * gg.y); w.y = pk2(v[j].z * rstd * gg.z, v[j].w * rstd * gg.w); o8[64 * j] = w; }
}
__device__ __forceinline__ void p0_prologue(Frame& F, int part) {
    LAS float* scr = (LAS float*)(F.lds + RING_OFF + F.wave * 16384);
    const int vb = part ? 64 : 0;
    if (F.vcu < vb) return;
    const int gw = (F.vcu - vb) * NWAVES + F.wave, NGW = (F.G - vb) * NWAVES; const int lane = opq(F.lane), tid = opq(F.tid);
    const int gt = (F.vcu - vb) * NWAVES * 64 + tid, NGT = NGW * 64;
    constexpr int NB_IN = (IN_COLS + 31) / 32;
    constexpr int I_IN = (DM / 64) * NB_IN, I_SQ = (DM / 64) * (DM / 32), I_KV = (DM / 64) * (2 * DM / 32), I_GU = (DM / 64) * (2 * DFF / 32), I_D = (DFF / 64) * (DM / 32);
    constexpr int I_LAYER = I_IN + 2 * I_SQ + I_KV + I_GU + I_D;
    for (int it = gw; it < I_LAYER; it += NGW) {
        const int l = part; int r = it;
        bf16* wl = wsb(F, WS_W + (size_t)l * W_LAYER);
        if (r < I_IN) { const int kb = r / NB_IN, nb = r % NB_IN; p0_transpose_item(inp(I_WIN) + (size_t)l * DM * IN_COLS, DM, IN_COLS, (bf16*)((char*)wl + WO_WIN), 32 * nb, 64 * kb, 32 * nb, scr, lane); continue; } r -= I_IN;
        if (r < I_SQ) { const int kb = r / (DM / 32), nb = r % (DM / 32); p0_transpose_item(inp(I_WOUT) + (size_t)l * DM * DM, DM, DM, (bf16*)((char*)wl + WO_WOUT), 32 * nb, 64 * kb, 32 * nb, scr, lane); continue; } r -= I_SQ;
        if (r < I_SQ) { const int kb = r / (DM / 32), nb = r % (DM / 32); p0_transpose_item(inp(I_WO) + (size_t)l * DM * DM, DM, DM, (bf16*)((char*)wl + WO_WO), 32 * nb, 64 * kb, 32 * nb, scr, lane); continue; } r -= I_SQ;
        if (r < I_KV) { const int kb = r / (2 * DM / 32), nb = r % (2 * DM / 32); p0_transpose_item(inp(I_WKV) + (size_t)l * DM * 2 * DM, DM, 2 * DM, (bf16*)((char*)wl + WO_WKV), 32 * nb, 64 * kb, 32 * nb, scr, lane); continue; } r -= I_KV;
        if (r < I_GU) { const int kb = r / (2 * DFF / 32), nb = r % (2 * DFF / 32); const int n0 = 32 * nb; const int up = n0 >= DFF ? 1 : 0, j0 = n0 - up * DFF;
            const int drow = (j0 >> 7) * 256 + up * 128 + (j0 & 127);
            p0_transpose_item(inp(I_WGU) + (size_t)l * DM * 2 * DFF, DM, 2 * DFF, (bf16*)((char*)wl + WO_WGU), drow, 64 * kb, n0, scr, lane); continue; } r -= I_GU;
        { const int kb = r / (DM / 32), nb = r % (DM / 32); p0_transpose_item(inp(I_WD) + (size_t)l * DFF * DM, DFF, DM, (bf16*)((char*)wl + WO_WD), 32 * nb, 64 * kb, 32 * nb, scr, lane); }
    }
    for (int i = gt; i < DM * DM / 8; i += NGT) { const int l = part, k = i;
        const float* src = inp(I_WQ) + (size_t)l * DM * DM + (size_t)k * 8; const f32x4 a = ld4(src), b = ld4(src + 4);
        v4u o; o.x = pk2(a.x, a.y); o.y = pk2(a.z, a.w); o.z = pk2(b.x, b.y); o.w = pk2(b.z, b.w);
        ((v4u*)(F.ws + WS_W + (size_t)l * W_LAYER + WO_WQ))[k] = o; }
    { constexpr int ZR0 = 32 * NB_IN, ZN = (IN_PAD - ZR0) * DM / 8;
      const unsigned z0 = (unsigned)opq(0); const v4u zz = {z0, z0, z0, z0};
      for (int i = gt; i < ZN; i += NGT) { const int l = part, k = i;
          ((v4u*)(F.ws + WS_W + (size_t)l * W_LAYER + WO_WIN + (size_t)ZR0 * DM * 2))[k] = zz; } }
    if (part) return;
    for (int m = gw; m < DEPTH * MROWS; m += NGW) { const int l = m / MROWS, r = m % MROWS;
        norm_row_to_bf16(inp(I_MEM) + (size_t)r * DM, inp(I_NORMG) + (size_t)(l * N_NORMS + MEM_NORM) * DM, wsb(F, WS_MEMN) + (size_t)m * DM, lane); }
    for (int m = gw; m < M; m += NGW) norm_row_to_bf16(inp(I_X) + (size_t)m * DM, inp(I_NORMG) + (size_t)(0 * N_NORMS + MIX_PRE) * DM, wsb(F, WS_XN) + (size_t)m * DM, lane);
}

struct f32x8 { f32x4 lo, hi; };
__device__ __forceinline__ f32x8 ldu8(const bf16* p) { const v4u w = *(const v4u*)p; f32x8 r;
    r.lo = (f32x4){__builtin_bit_cast(float, w.x << 16), __builtin_bit_cast(float, w.x & 0xffff0000u), __builtin_bit_cast(float, w.y << 16), __builtin_bit_cast(float, w.y & 0xffff0000u)};
    r.hi = (f32x4){__builtin_bit_cast(float, w.z << 16), __builtin_bit_cast(float, w.z & 0xffff0000u), __builtin_bit_cast(float, w.w << 16), __builtin_bit_cast(float, w.w & 0xffff0000u)}; return r; }
__device__ __forceinline__ f32x8 cvt8(const v4u w) { f32x8 r;
    r.lo = (f32x4){__builtin_bit_cast(float, w.x << 16), __builtin_bit_cast(float, w.x & 0xffff0000u), __builtin_bit_cast(float, w.y << 16), __builtin_bit_cast(float, w.y & 0xffff0000u)};
    r.hi = (f32x4){__builtin_bit_cast(float, w.z << 16), __builtin_bit_cast(float, w.z & 0xffff0000u), __builtin_bit_cast(float, w.w << 16), __builtin_bit_cast(float, w.w & 0xffff0000u)}; return r; }
__device__ __forceinline__ f32x8 ld8f(const float* p) { f32x8 r; r.lo = ld4(p); r.hi = ld4(p + 4); return r; }
__device__ __forceinline__ f32x8 operator*(const f32x8& a, const f32x8& b) { return f32x8{a.lo * b.lo, a.hi * b.hi}; }
__device__ __forceinline__ f32x8 operator+(const f32x8& a, const f32x8& b) { return f32x8{a.lo + b.lo, a.hi + b.hi}; }
__device__ __forceinline__ f32x8 silu8(const f32x8& a) { return f32x8{silu4(a.lo), silu4(a.hi)}; }
__device__ __forceinline__ float sumsq8(const f32x8& y) { return ((y.lo.x * y.lo.x + y.lo.y * y.lo.y) + (y.lo.z * y.lo.z + y.lo.w * y.lo.w)) + ((y.hi.x * y.hi.x + y.hi.y * y.hi.y) + (y.hi.z * y.hi.z + y.hi.w * y.hi.w)); }
__device__ __forceinline__ v4u pack8u(const f32x8& y) { v4u o; o.x = pk2(y.lo.x, y.lo.y); o.y = pk2(y.lo.z, y.lo.w); o.z = pk2(y.hi.x, y.hi.y); o.w = pk2(y.hi.z, y.hi.w); return o; }
__device__ __forceinline__ void mixer_prep_phase(Frame& F, int l) {
    const int gw = F.vcu * NWAVES + F.wave, NGW = F.G * NWAVES, lane = opq(F.lane), tid = opq(F.tid);
    const bf16* U = wsb(F, WS_U);
    bf16* MIX = wsb(F, WS_MIX);
    constexpr int NSTRIP = M / 16, NTYPE = 12;
    for (int it = gw; it < NTYPE * NSTRIP; it += NGW) {
        const int type = it % NTYPE, strip = it / NTYPE, r0 = strip * 16, pos0 = r0 & (SEQ - 1), c = lane * 8;
        const bf16* ur0 = U + (size_t)r0 * IN_PAD;
        if (type == 0) {
            const float* cw = inp(I_CONVA) + (size_t)l * 3 * GW + c;
            const f32x8 w0 = ld8f(cw), w1 = ld8f(cw + GW), w2 = ld8f(cw + 2 * GW);
            const v4u z4 = {0u, 0u, 0u, 0u};
#pragma unroll 1
            for (int hf = 0; hf < 2; ++hf) {
                const bf16* ub = ur0 + (size_t)(8 * hf) * IN_PAD;
                v4u rc[10], rh[10], rb[8];
#pragma unroll
                for (int i = 0; i < 10; ++i) { const int ri = i - 2; if (ri >= 0 || pos0 > 0 || hf > 0) { rc[i] = *(const v4u*)(ub + (ptrdiff_t)ri * IN_PAD + UA_C + c); rh[i] = *(const v4u*)(ub + (ptrdiff_t)ri * IN_PAD + UA_H + c); } else { rc[i] = z4; rh[i] = z4; } }
#pragma unroll
                for (int i = 0; i < 8; ++i) rb[i] = *(const v4u*)(ub + (size_t)i * IN_PAD + UA_B + c);
                f32x8 p2 = cvt8(rc[0]) * cvt8(rh[0]), p1 = cvt8(rc[1]) * cvt8(rh[1]);
#pragma unroll
                for (int i = 0; i < 8; ++i) { const f32x8 p0 = cvt8(rc[i + 2]) * cvt8(rh[i + 2]); const f32x8 y = cvt8(rb[i]) * (w0 * p2 + w1 * p1 + w2 * p0);
                    *(v4u*)(MIX + (size_t)(r0 + 8 * hf + i) * DM + c) = pack8u(y); p2 = p1; p1 = p0; }
            }
        } else if (type < 4) {
            const int gi = type - 1, cc = gi * GW + c;
            const float* cw = inp(I_GCONV) + (size_t)l * 4 * 3 * GW + cc;
            const f32x8 w0 = ld8f(cw), w1 = ld8f(cw + 3 * GW), w2 = ld8f(cw + 6 * GW), w3 = ld8f(cw + 9 * GW);
            v4u xr[19];
#pragma unroll
            for (int i = 0; i < 19; ++i) { const int ri = i - 3; if (ri >= 0 || pos0 > 0) xr[i] = *(const v4u*)(ur0 + (ptrdiff_t)ri * IN_PAD + UC_Q + cc); else xr[i] = (v4u){0u, 0u, 0u, 0u}; }
            float* dst = (gi == 0) ? wsf(F, WS_QN) : (gi == 1) ? wsf(F, WS_KN) : wsf(F, WS_VV);
            const float qs = (gi == 0) ? 0.08838834764831845f : 1.0f;
            f32x8 x3 = cvt8(xr[0]), x2 = cvt8(xr[1]), x1 = cvt8(xr[2]);
#pragma unroll
            for (int i = 0; i < 16; ++i) { const f32x8 x0 = cvt8(xr[i + 3]); f32x8 y = silu8(w0 * x3 + w1 * x2 + w2 * x1 + w3 * x0); x3 = x2; x2 = x1; x1 = x0;
                if (gi < 2) { float ss = row16_sum(sumsq8(y));
                    const float sc = qs / sqrtf(ss + EPS); y.lo = y.lo * sc; y.hi = y.hi * sc; }
                float* d = dst + (size_t)(r0 + i) * GW + c; *(f32x4*)d = y.lo; *(f32x4*)(d + 4) = y.hi; }
        } else if (type < 6) {
            const int gi = type - 4, cc = gi * GW + c;
            const float* cw = inp(I_SCONVW) + (size_t)l * 4 * 1024 + cc;
            const f32x8 w0 = ld8f(cw), w1 = ld8f(cw + 1024), w2 = ld8f(cw + 2048), w3 = ld8f(cw + 3072), bb = ld8f(inp(I_SCONVB) + (size_t)l * 1024 + cc);
            v4u xr[19];
#pragma unroll
            for (int i = 0; i < 19; ++i) { const int ri = i - 3; if (ri >= 0 || pos0 > 0) xr[i] = *(const v4u*)(ur0 + (ptrdiff_t)ri * IN_PAD + UD_X + cc); else xr[i] = (v4u){0u, 0u, 0u, 0u}; }
            f32x8 x3 = cvt8(xr[0]), x2 = cvt8(xr[1]), x1 = cvt8(xr[2]);
            float* dst; int ld, co;
            if (gi == 0) { dst = wsf(F, WS_XS); ld = 512; co = c; } else if (c < 256) { dst = wsf(F, WS_BS); ld = 256; co = c; } else { dst = wsf(F, WS_CS); ld = 256; co = c - 256; }
#pragma unroll
            for (int i = 0; i < 16; ++i) { const f32x8 x0 = cvt8(xr[i + 3]); const f32x8 y = silu8(w0 * x3 + w1 * x2 + w2 * x1 + w3 * x0 + bb); x3 = x2; x2 = x1; x1 = x0;
                float* d = dst + (size_t)(r0 + i) * ld + co; *(f32x4*)d = y.lo; *(f32x4*)(d + 4) = y.hi; }
        } else if (type < 8) {
            const int zo = (type == 6) ? UC_Z : UD_Z; bf16* dst = wsb(F, (type == 6) ? WS_ZG : WS_ZS);
            v4u z[16];
#pragma unroll
            for (int i = 0; i < 16; ++i) z[i] = *(const v4u*)(ur0 + (size_t)i * IN_PAD + zo + c);
#pragma unroll
            for (int i = 0; i < 16; ++i) *(v4u*)(dst + (size_t)(r0 + i) * GW + c) = z[i];
        } else {
            const int gi = type - 8, w = 2 << gi;
            LAS float* scr = (LAS float*)(F.lds + RING_OFF + F.wave * 16384);
            const int c0 = UB + gi * 128 + lane * 2;
            float uv0[31], uv1[31];
#pragma unroll
            for (int i = 0; i < 31; ++i) { const int ri = i - 15; float a0 = 0.f, a1 = 0.f;
                if (ri >= 0 || pos0 > 0) { const unsigned wd = *(const unsigned*)(ur0 + (ptrdiff_t)ri * IN_PAD + c0); a0 = __builtin_bit_cast(float, wd << 16); a1 = __builtin_bit_cast(float, wd & 0xffff0000u); }
                uv0[i] = a0; uv1[i] = a1; }
            float r0s = 0.f, r1s = 0.f;
#pragma unroll
            for (int s = 1; s < 16; ++s) if (s < w) { r0s += uv0[15 - s]; r1s += uv1[15 - s]; }
#pragma unroll
            for (int i = 0; i < 16; ++i) { const int pos = pos0 + i; const float a0 = uv0[15 + i], a1 = uv1[15 + i];
                r0s += a0; r1s += a1;
                const float cnt = (float)((pos + 1 < w) ? pos + 1 : w);
                scr[i * 128 + lane * 2] = r0s / cnt - a0; scr[i * 128 + lane * 2 + 1] = r1s / cnt - a1;
                float d0 = 0.f, d1 = 0.f;
#pragma unroll
                for (int g2 = 0; g2 < 4; ++g2) if (gi == g2) { d0 = uv0[15 + i - (2 << g2) + 1]; d1 = uv1[15 + i - (2 << g2) + 1]; }
                r0s -= d0; r1s -= d1; }
            LDS_WAIT(); asm volatile("" ::: "memory");
            float acc0[16], acc1[16];
#pragma unroll
            for (int i = 0; i < 16; ++i) { acc0[i] = 0.f; acc1[i] = 0.f; }
            const float* pw = inp(I_POOLW) + ((size_t)l * 4 + gi) * 128 * 128;
            for (int cc = 0; cc < 128; cc += 4) {
                float wa[4], wb[4];
#pragma unroll
                for (int q = 0; q < 4; ++q) { wa[q] = pw[(size_t)(cc + q) * 128 + lane]; wb[q] = pw[(size_t)(cc + q) * 128 + 64 + lane]; }
#pragma unroll
                for (int i = 0; i < 16; ++i) { const f32x4 p = *(const LAS f32x4*)(scr + i * 128 + cc);
                    acc0[i] += p.x * wa[0] + p.y * wa[1] + p.z * wa[2] + p.w * wa[3]; acc1[i] += p.x * wb[0] + p.y * wb[1] + p.z * wb[2] + p.w * wb[3]; }
            }
            const float s0 = inp(I_POOLS)[(size_t)l * GW + gi * 128 + lane], s1 = inp(I_POOLS)[(size_t)l * GW + gi * 128 + 64 + lane];
#pragma unroll
            for (int i = 0; i < 16; ++i) { bf16* o = MIX + (size_t)(r0 + i) * DM + GW + gi * 128; o[lane] = (bf16)f2bf(acc0[i] * s0); o[64 + lane] = (bf16)f2bf(acc1[i] * s1); }
            LDS_WAIT(); asm volatile("" ::: "memory");
        }
    }
    for (int i = (F.vcu * NWAVES * 64) + tid; i < M * 16; i += F.G * NWAVES * 64) { const int t = i >> 4, j = i & 15; const bf16* ur = U + (size_t)t * IN_PAD;
#define UF(col) __builtin_bit_cast(float, (unsigned)ur[col] << 16)
        if (j < 4) { wsf(F, WS_GB)[(size_t)t * 8 + 2 * j] = -__expf(inp(I_GALOG)[l * 4 + j]) * softplusf(UF(UC_A + j) + inp(I_GDTB)[l * 4 + j]); }
        else if (j < 8) { wsf(F, WS_GB)[(size_t)t * 8 + 2 * (j - 4) + 1] = sigmoidf(UF(UC_B + (j - 4))); }
        else { const int hh = j - 8; const float dt = softplusf(UF(UD_DT + hh) + inp(I_SDTB)[l * 8 + hh]);
            wsf(F, WS_DT)[(size_t)t * 16 + 2 * hh] = -__expf(inp(I_SALOG)[l * 8 + hh]) * dt; wsf(F, WS_DT)[(size_t)t * 16 + 2 * hh + 1] = dt; }
#undef UF
    }
}

typedef float f32x16 __attribute__((ext_vector_type(16)));
typedef float f32x2v __attribute__((ext_vector_type(2)));
typedef __bf16 bf16x2_t __attribute__((ext_vector_type(2)));
__device__ __forceinline__ unsigned cvtpk(float lo, float hi) { const f32x2v v = {lo, hi}; return __builtin_bit_cast(unsigned, __builtin_convertvector(v, bf16x2_t)); }
__device__ __forceinline__ bf16x8 pack8(float a0, float a1, float a2, float a3, float a4, float a5, float a6, float a7) { v4u w; w.x = cvtpk(a0, a1); w.y = cvtpk(a2, a3); w.z = cvtpk(a4, a5); w.w = cvtpk(a6, a7); return __builtin_bit_cast(bf16x8, w); }
#define PACK_STEP(x, s) pack8((x)[8 * (s)], (x)[8 * (s) + 1], (x)[8 * (s) + 2], (x)[8 * (s) + 3], (x)[8 * (s) + 4], (x)[8 * (s) + 5], (x)[8 * (s) + 6], (x)[8 * (s) + 7])
#define MFMA32(a, b, c) __builtin_amdgcn_mfma_f32_32x32x16_bf16((a), (b), (c), 0, 0, 0)
__device__ __forceinline__ int crow(int reg, int h) { return (reg & 3) + 8 * (reg >> 2) + 4 * h; }
constexpr int LA_KB = 0;
constexpr int LA_QB = LA_KB + 64 * 136 * 2;
constexpr int LA_KGT = LA_QB + 64 * 136 * 2;
constexpr int LA_VBT = LA_KGT + 128 * 72 * 2;
constexpr int LA_KET = LA_VBT + 128 * 72 * 2;
constexpr int LA_M = LA_KET + 128 * 72 * 2;
constexpr int LA_TB = LA_M + 64 * 68 * 4;
constexpr int LA_VEC = LA_TB + 64 * 72 * 2;
static_assert(LA_VEC + 1024 <= RING_BYTES, "la LDS map");
__device__ __forceinline__ bf16x8 lds_frag(const LAS unsigned char* base, int row, int stride_el, int col) { return *(const LAS bf16x8*)(base + ((size_t)row * stride_el + col) * 2); }
__device__ __forceinline__ float wave_incl_scan(float v, int lane) {
#pragma unroll
    for (int d = 1; d < 64; d <<= 1) { const float o = __builtin_bit_cast(float, __builtin_amdgcn_ds_bpermute((lane - d) << 2, __builtin_bit_cast(int, v))); if (lane >= d) v += o; }
    return v;
}
__device__ __forceinline__ void store_qk_frag(const f32x16& acc, const LAS float* Gv, int mt, int rt, int r, int h, int lane, bf16* qkf) {
    const int l = 32 * rt + r; const float Gl = Gv[l];
    float v[16];
#pragma unroll
    for (int q = 0; q < 16; ++q) { const int m = 32 * mt + crow(q, h); v[q] = (m <= l) ? acc[q] * __expf(Gl - Gv[m]) : 0.f; }
    *(bf16x8*)(qkf + ((size_t)(rt * 4 + 2 * mt + 0) * 64 + lane) * 8) = pack8(v[0], v[1], v[2], v[3], v[4], v[5], v[6], v[7]);
    *(bf16x8*)(qkf + ((size_t)(rt * 4 + 2 * mt + 1) * 64 + lane) * 8) = pack8(v[8], v[9], v[10], v[11], v[12], v[13], v[14], v[15]);
}
__device__ __forceinline__ void qd_frag_task(const float* qrows, int ldq, const LAS float* Gv, int task, int r, int h, int lane, bf16* qdf) {
    const int rt = task >> 3, ks = task & 7, l = 32 * rt + r, k0 = 16 * ks + 4 * h; const float e = __expf(Gv[l]);
    const f32x4 a = ld4(qrows + (size_t)l * ldq + k0), b = ld4(qrows + (size_t)l * ldq + k0 + 8);
    *(bf16x8*)(qdf + ((size_t)task * 64 + lane) * 8) = pack8(a.x * e, a.y * e, a.z * e, a.w * e, b.x * e, b.y * e, b.z * e, b.w * e);
}
__device__ __forceinline__ void qd_frag_task4(const float* qrows, int ldq, const LAS float* Gv, int task0, int r, int h, int lane, bf16* qdf) {
    f32x4 a[4], b[4]; float e[4];
#pragma unroll
    for (int t = 0; t < 4; ++t) { const int task = task0 + t, rt = task >> 3, ks = task & 7, l = 32 * rt + r, k0 = 16 * ks + 4 * h;
        a[t] = ld4(qrows + (size_t)l * ldq + k0); b[t] = ld4(qrows + (size_t)l * ldq + k0 + 8); e[t] = __expf(Gv[l]); }
#pragma unroll
    for (int t = 0; t < 4; ++t) *(bf16x8*)(qdf + ((size_t)(task0 + t) * 64 + lane) * 8) = pack8(a[t].x * e[t], a[t].y * e[t], a[t].z * e[t], a[t].w * e[t], b[t].x * e[t], b[t].y * e[t], b[t].z * e[t], b[t].w * e[t]);
}
__device__ __forceinline__ void ke_frag_task(const LAS unsigned char* ket, int task, int r, int h, int lane, bf16* kef) {
    const int it = task >> 2, ks = task & 3, dk = 32 * it + r, l0 = 16 * ks + 4 * h;
    const v2u lo = *(const LAS v2u*)(ket + ((size_t)dk * 72 + l0) * 2), hi = *(const LAS v2u*)(ket + ((size_t)dk * 72 + l0 + 8) * 2);
    v4u w; w.x = lo.x; w.y = lo.y; w.z = hi.x; w.w = hi.y;
    *(v4u*)(kef + ((size_t)task * 64 + lane) * 8) = w;
}

#ifndef LAREP
#define LAREP 0
#endif
#define LDS_SYNC() do { asm volatile("s_waitcnt lgkmcnt(0)" ::: "memory"); __builtin_amdgcn_s_barrier(); asm volatile("" ::: "memory"); } while (0)
__device__ __forceinline__ void la_prep_phase(Frame& F, int l_unused) {
    const int tid0 = opq(F.tid), wv = F.wave;
    LAS unsigned char* L = F.lds + RING_OFF; asm volatile("" : "+v"(L));
    LAS float* Gv = (LAS float*)(L + LA_VEC); LAS float* Bv = Gv + 64;
    LAS float* Mf = (LAS float*)(L + LA_M);
    const f32x16 zero16 = {0.f, 0.f, 0.f, 0.f, 0.f, 0.f, 0.f, 0.f, 0.f, 0.f, 0.f, 0.f, 0.f, 0.f, 0.f, 0.f};
    for (int item = F.vcu; item < 512; item += F.G) {
        const int tid = opq(tid0), lane = tid & 63, r = lane & 31, h = lane >> 5;
        const int seq = item >> 5, ch = item & 31, b = seq >> 2, hd = seq & 3;
        const size_t t0 = (size_t)b * SEQ + ch * 64;
        const float* KN = wsf(F, WS_KN) + t0 * GW + hd * 128; const float* QN = wsf(F, WS_QN) + t0 * GW + hd * 128; const float* VV = wsf(F, WS_VV) + t0 * GW + hd * 128;
        unsigned char* rec = F.ws + WS_FG + (size_t)item * LA_RECG;
        const int c = tid & 127, lg = tid >> 7;
        const f32x2v gb = *(const f32x2v*)(wsf(F, WS_GB) + (t0 + lane) * 8 + 2 * hd);
        float kr[16], qr[16], vr[16];
#pragma unroll
        for (int i = 0; i < 16; ++i) { const int l = lg * 16 + i; kr[i] = KN[(size_t)l * GW + c]; qr[i] = QN[(size_t)l * GW + c]; vr[i] = VV[(size_t)l * GW + c]; }
        f32x4 qa[4], qb[4];
        { const int qw = (wv >= 2 && wv <= 5) ? wv - 2 : 0;
#pragma unroll
            for (int t = 0; t < 4; ++t) { const int task = 4 * qw + t, rt = task >> 3, ks = task & 7, l = 32 * rt + r, k0 = 16 * ks + 4 * h; qa[t] = ld4(QN + (size_t)l * GW + k0); qb[t] = ld4(QN + (size_t)l * GW + k0 + 8); } }
        if (wv == 0) { Gv[lane] = wave_incl_scan(gb.x, lane); Bv[lane] = gb.y; }
        LDS_SYNC();
        const float G63 = Gv[63];
#pragma unroll
        for (int i = 0; i < 16; ++i) { const int l = lg * 16 + i; const float kv = kr[i], qv = qr[i], vv = vr[i];
            const float Gl = Gv[l], bl = Bv[l];
            ((LAS bf16*)(L + LA_KB))[l * 136 + c] = (bf16)f2bf(kv); ((LAS bf16*)(L + LA_QB))[l * 136 + c] = (bf16)f2bf(qv);
            ((LAS bf16*)(L + LA_KGT))[c * 72 + l] = (bf16)f2bf(-kv * bl * __expf(Gl)); ((LAS bf16*)(L + LA_VBT))[c * 72 + l] = (bf16)f2bf(vv * bl);
            ((LAS bf16*)(L + LA_KET))[c * 72 + l] = (bf16)f2bf(kv * __expf(G63 - Gl)); }
        LDS_SYNC();
        if (wv < 4) { const int it = wv >> 1, jt = wv & 1; f32x16 acc = zero16;
            if (!(it == 0 && jt == 1)) {
#pragma unroll
                for (int ks = 0; ks < 8; ++ks) acc = MFMA32(lds_frag(L + LA_KB, 32 * it + r, 136, 16 * ks + 8 * h), lds_frag(L + LA_KB, 32 * jt + r, 136, 16 * ks + 8 * h), acc); }
            const int j = 32 * jt + r; const float Gj = Gv[j];
#pragma unroll
            for (int q = 0; q < 16; ++q) { const int i = 32 * it + crow(q, h); Mf[i * 68 + j] = (j < i) ? Bv[i] * acc[q] * __expf(Gv[i] - Gj) : 0.f; }
        } else { const int mt = (wv - 4) >> 1, rt = (wv - 4) & 1; f32x16 acc = zero16;
            if (!(mt == 1 && rt == 0)) {
#pragma unroll
                for (int ks = 0; ks < 8; ++ks) acc = MFMA32(lds_frag(L + LA_KB, 32 * mt + r, 136, 16 * ks + 8 * h), lds_frag(L + LA_QB, 32 * rt + r, 136, 16 * ks + 8 * h), acc); }
            store_qk_frag(acc, Gv, mt, rt, r, h, lane, (bf16*)(rec + LA_QK)); }
        LDS_SYNC();
        f32x16 Pacc = zero16;
        if (wv < 2) {
            const int ln = opq(lane), cc = ln & 31, bo = 32 * wv;
            float Tc[32];
#pragma unroll
            for (int i = 0; i < 32; ++i) {
                float a0 = (i == cc) ? 1.f : 0.f, a1 = 0.f, a2 = 0.f, a3 = 0.f;
#pragma unroll
                for (int j4 = 0; j4 < (i + 3) / 4; ++j4) { const f32x4 m = *(const LAS f32x4*)(Mf + (bo + i) * 68 + bo + 4 * j4);
                    a0 -= m.x * Tc[4 * j4]; if (4 * j4 + 1 < i) a1 -= m.y * Tc[4 * j4 + 1]; if (4 * j4 + 2 < i) a2 -= m.z * Tc[4 * j4 + 2]; if (4 * j4 + 3 < i) a3 -= m.w * Tc[4 * j4 + 3]; }
                Tc[i] = (a0 + a1) + (a2 + a3);
                ((LAS bf16*)(L + LA_TB))[(bo + i) * 72 + bo + cc] = (bf16)f2bf(Tc[i]);
                if (wv == 0) ((LAS bf16*)(L + LA_TB))[i * 72 + 32 + cc] = (bf16)0;
                if ((i & 7) == 7) asm volatile("" ::: "memory");
            }
            if (wv == 0) {
#pragma unroll
                for (int s2 = 0; s2 < 2; ++s2) {
                    const LAS float* mr = Mf + (32 + r) * 68 + 16 * s2 + 8 * h; const f32x4 m0 = *(const LAS f32x4*)mr, m1 = *(const LAS f32x4*)(mr + 4);
                    const bf16x8 af = pack8(m0.x, m0.y, m0.z, m0.w, m1.x, m1.y, m1.z, m1.w);
                    const bf16x8 bfr = h ? pack8(Tc[16 * s2 + 8], Tc[16 * s2 + 9], Tc[16 * s2 + 10], Tc[16 * s2 + 11], Tc[16 * s2 + 12], Tc[16 * s2 + 13], Tc[16 * s2 + 14], Tc[16 * s2 + 15])
                                          : pack8(Tc[16 * s2 + 0], Tc[16 * s2 + 1], Tc[16 * s2 + 2], Tc[16 * s2 + 3], Tc[16 * s2 + 4], Tc[16 * s2 + 5], Tc[16 * s2 + 6], Tc[16 * s2 + 7]);
                    Pacc = MFMA32(af, bfr, Pacc); }
                if (lane == 0) wsf(F, WS_DLG)[item] = __expf(G63);
            }
        } else if (wv <= 5) {
#pragma unroll
            for (int t = 0; t < 4; ++t) { const int task = 4 * (wv - 2) + t, rt = task >> 3; const float e = __expf(Gv[32 * rt + r]);
                *(bf16x8*)((bf16*)(rec + LA_QD) + ((size_t)task * 64 + lane) * 8) = pack8(qa[t].x * e, qa[t].y * e, qa[t].z * e, qa[t].w * e, qb[t].x * e, qb[t].y * e, qb[t].z * e, qb[t].w * e); }
        } else {
#pragma unroll
            for (int t = 0; t < 8; ++t) ke_frag_task(L + LA_KET, 8 * (wv - 6) + t, r, h, lane, (bf16*)(rec + LA_KE)); }
        LDS_SYNC();
        if (wv == 0) {
            f32x16 t21 = zero16;
#pragma unroll
            for (int s2 = 0; s2 < 2; ++s2) {
                const LAS unsigned char* tr = L + LA_TB + ((size_t)(32 + r) * 72 + 32 + 16 * s2 + 4 * h) * 2;
                const v2u lo = *(const LAS v2u*)tr, hi = *(const LAS v2u*)(tr + 16); v4u w; w.x = lo.x; w.y = lo.y; w.z = hi.x; w.w = hi.y;
                t21 = MFMA32(__builtin_bit_cast(bf16x8, w), PACK_STEP(Pacc, s2), t21); }
#pragma unroll
            for (int q = 0; q < 16; ++q) ((LAS bf16*)(L + LA_TB))[(32 + crow(q, h)) * 72 + r] = (bf16)f2bf(-t21[q]);
        }
        LDS_SYNC();
#pragma unroll 1
        for (int tile = wv; tile < 16; tile += 8) {
            f32x16 acc = zero16;
            if (tile < 8) { const int it = tile >> 1, rt = tile & 1;
#pragma unroll
                for (int ks = 0; ks < 4; ++ks) acc = MFMA32(lds_frag(L + LA_KGT, 32 * it + r, 72, 16 * ks + 8 * h), lds_frag(L + LA_TB, 32 * rt + r, 72, 16 * ks + 8 * h), acc);
                bf16* nw = (bf16*)(rec + LA_NW);
                *(bf16x8*)(nw + ((size_t)(rt * 8 + 2 * it + 0) * 64 + lane) * 8) = PACK_STEP(acc, 0);
                *(bf16x8*)(nw + ((size_t)(rt * 8 + 2 * it + 1) * 64 + lane) * 8) = PACK_STEP(acc, 1);
            } else { const int rt = (tile - 8) >> 2, dvt = (tile - 8) & 3;
#pragma unroll
                for (int ks = 0; ks < 4; ++ks) acc = MFMA32(lds_frag(L + LA_TB, 32 * rt + r, 72, 16 * ks + 8 * h), lds_frag(L + LA_VBT, 32 * dvt + r, 72, 16 * ks + 8 * h), acc);
                float* uc = (float*)(rec + LA_UCG) + ((size_t)(dvt * 2 + rt) * 4 * 64 + lane) * 4;
#pragma unroll
                for (int q4 = 0; q4 < 4; ++q4) *(f32x4*)(uc + (size_t)q4 * 256) = (f32x4){acc[4 * q4], acc[4 * q4 + 1], acc[4 * q4 + 2], acc[4 * q4 + 3]};
            }
        }
        LDS_SYNC();
    }
    for (int item = F.vcu; item < 256; item += F.G) {
        const int tid = opq(tid0), lane = tid & 63, r = lane & 31, h = lane >> 5;
        const int b = item >> 6, ch = (item >> 1) & 31, g = item & 1;
        const size_t t0 = (size_t)b * SEQ + ch * 64;
        const float* BS = wsf(F, WS_BS) + t0 * 256 + g * 128; const float* CS = wsf(F, WS_CS) + t0 * 256 + g * 128;
        const int c = tid & 127, lg = tid >> 7;
        float br[16], cr[16];
#pragma unroll
        for (int i = 0; i < 16; ++i) { const int l = lg * 16 + i; br[i] = BS[(size_t)l * 256 + c]; cr[i] = CS[(size_t)l * 256 + c]; }
        f32x2v ad[4];
#pragma unroll
        for (int hi = 0; hi < 4; ++hi) ad[hi] = *(const f32x2v*)(wsf(F, WS_DT) + (t0 + lane) * 16 + 2 * (4 * g + hi));
        f32x4 ca[4], cb[4]; float xv[4][16];
        const int sl = (wv >> 1) & 1, rt2 = wv & 1;
        {
#pragma unroll
            for (int t = 0; t < 4; ++t) { const int task = 4 * (wv & 3) + t, rt = task >> 3, ks = task & 7, l = 32 * rt + r, k0 = 16 * ks + 4 * h; ca[t] = ld4(CS + (size_t)l * 256 + k0); cb[t] = ld4(CS + (size_t)l * 256 + k0 + 8); }
#pragma unroll
            for (int hi = 0; hi < 4; ++hi)
#pragma unroll
                for (int q = 0; q < 16; ++q) xv[hi][q] = wsf(F, WS_XS)[(t0 + 32 * rt2 + crow(q, h)) * GW + (4 * g + hi) * 64 + 32 * sl + r]; }
#pragma unroll
        for (int i = 0; i < 16; ++i) { const int l = lg * 16 + i;
            ((LAS bf16*)(L + LA_KB))[l * 136 + c] = (bf16)f2bf(br[i]); ((LAS bf16*)(L + LA_QB))[l * 136 + c] = (bf16)f2bf(cr[i]); }
        if (wv == 0) {
#pragma unroll
            for (int hi = 0; hi < 4; ++hi) { Gv[hi * 64 + lane] = wave_incl_scan(ad[hi].x, lane); Gv[256 + hi * 64 + lane] = ad[hi].y; } }
        LDS_SYNC();
        f32x16 raw = zero16;
        const int mt = (wv >> 1) & 1, rt = wv & 1;
        if (wv < 4 && !(mt == 1 && rt == 0)) {
#pragma unroll
            for (int ks = 0; ks < 8; ++ks) raw = MFMA32(lds_frag(L + LA_KB, 32 * mt + r, 136, 16 * ks + 8 * h), lds_frag(L + LA_QB, 32 * rt + r, 136, 16 * ks + 8 * h), raw); }
#pragma unroll
        for (int hi = 0; hi < 4; ++hi) {
            const int hh = 4 * g + hi, seq = b * 8 + hh;
            unsigned char* rec = F.ws + WS_FS + ((size_t)seq * 32 + ch) * LA_RECS;
            const LAS float* Gh = Gv + hi * 64; const LAS float* Dh = Gv + 256 + hi * 64;
            const float G63 = Gh[63];
#pragma unroll
            for (int i = 0; i < 16; ++i) { const int l = lg * 16 + i; ((LAS bf16*)(L + LA_KET))[c * 72 + l] = (bf16)f2bf(br[i] * __expf(G63 - Gh[l])); }
            if (wv < 4) {
                store_qk_frag(raw, Gh, mt, rt, r, h, lane, (bf16*)(rec + LA_QK));
#pragma unroll
                for (int t = 0; t < 4; ++t) { const int task = 4 * wv + t, rtq = task >> 3; const float e = __expf(Gh[32 * rtq + r]);
                    *(bf16x8*)((bf16*)(rec + LA_QD) + ((size_t)task * 64 + lane) * 8) = pack8(ca[t].x * e, ca[t].y * e, ca[t].z * e, ca[t].w * e, cb[t].x * e, cb[t].y * e, cb[t].z * e, cb[t].w * e); }
            } else {
                float* uc = (float*)(rec + LA_UCS) + ((size_t)(sl * 2 + rt2) * 4 * 64 + lane) * 4;
#pragma unroll
                for (int q4 = 0; q4 < 4; ++q4) { f32x4 v;
#pragma unroll
                    for (int e = 0; e < 4; ++e) v[e] = xv[hi][4 * q4 + e] * Dh[32 * rt2 + crow(4 * q4 + e, h)];
                    *(f32x4*)(uc + (size_t)q4 * 256) = v; }
            }
            if (tid == 0) wsf(F, WS_DLS)[seq * 32 + ch] = __expf(G63);
            LDS_SYNC();
            if (wv >= 4) {
#pragma unroll
                for (int t = 0; t < 4; ++t) ke_frag_task(L + LA_KET, 4 * (wv - 4) + t, r, h, lane, (bf16*)(rec + LA_KE)); }
            LDS_SYNC();
        }
    }
}

template <bool HAS_W> __device__ __forceinline__ void la_seq_wg(LAS unsigned char* ring  , const unsigned char* recs, int recsz, int uc_off, const float* dls, float* outp  , int slice, int lane, int wv) {
    constexpr int NFR = HAS_W ? 56 : 40;
    constexpr int SLOT = (NFR + 8) * 1024;
    const int r = lane & 31, h = lane >> 5;
    const bool loader = (wv >= 1 && wv <= 4);
    float dlv = 0.f;
    f32x16 S[4];
    if (wv == 0) { dlv = (lane < 32) ? dls[lane] : 0.f;
#pragma unroll
        for (int it = 0; it < 4; ++it)
#pragma unroll
            for (int q = 0; q < 16; ++q) S[it][q] = 0.f; }
#define LA_DMA(c_, slot_) do { const unsigned char* rec_ = recs + (size_t)(c_) * recsz + lane * 16; LAS unsigned char* dst_ = ring + (slot_) * SLOT; \
        for (int f_ = wv - 1; f_ < NFR + 8; f_ += 4) { const unsigned char* src_ = (f_ < NFR) ? rec_ + f_ * 1024 : rec_ + uc_off + slice * 8192 + (f_ - NFR) * 1024; \
            __builtin_amdgcn_global_load_lds((const unsigned*)src_, (LAS unsigned*)(dst_ + f_ * 1024), 16, 0, 0); } } while (0)
    if (loader) { LA_DMA(0, 0); asm volatile("s_waitcnt vmcnt(0)" ::: "memory"); }
    __builtin_amdgcn_s_barrier(); asm volatile("" ::: "memory");
#pragma unroll 1
    for (int c = 0; c < 32; ++c) {
        if (loader) { if (c + 1 < 32) { LA_DMA(c + 1, (c + 1) & 1); asm volatile("s_waitcnt vmcnt(0)" ::: "memory"); } }
        else if (wv == 0) {
        const LAS unsigned char* B = ring + (c & 1) * SLOT + lane * 16;
#define FRAG(off, idx) (*(const LAS bf16x8*)(B + (off) + (idx) * 1024))
        bf16x8 sb[8];
#pragma unroll
        for (int it = 0; it < 4; ++it) { sb[2 * it] = PACK_STEP(S[it], 0); sb[2 * it + 1] = PACK_STEP(S[it], 1); }
        f32x16 Vn[2];
#pragma unroll
        for (int rt = 0; rt < 2; ++rt)
#pragma unroll
            for (int q4 = 0; q4 < 4; ++q4) { const f32x4 v = *(const LAS f32x4*)(B + NFR * 1024 + (rt * 4 + q4) * 1024); Vn[rt][4 * q4] = v.x; Vn[rt][4 * q4 + 1] = v.y; Vn[rt][4 * q4 + 2] = v.z; Vn[rt][4 * q4 + 3] = v.w; }
        if (HAS_W) {
#pragma unroll
            for (int ks = 0; ks < 8; ++ks) { Vn[0] = MFMA32(FRAG(LA_NW, 0 * 8 + ks), sb[ks], Vn[0]); Vn[1] = MFMA32(FRAG(LA_NW, 1 * 8 + ks), sb[ks], Vn[1]); } }
        bf16x8 vb[4];
#pragma unroll
        for (int rt = 0; rt < 2; ++rt) { vb[2 * rt] = PACK_STEP(Vn[rt], 0); vb[2 * rt + 1] = PACK_STEP(Vn[rt], 1); }
        f32x16 O[2];
#pragma unroll
        for (int rt = 0; rt < 2; ++rt)
#pragma unroll
            for (int q = 0; q < 16; ++q) O[rt][q] = 0.f;
#pragma unroll
        for (int ks = 0; ks < 8; ++ks) { O[0] = MFMA32(FRAG(LA_QD, 0 * 8 + ks), sb[ks], O[0]); O[1] = MFMA32(FRAG(LA_QD, 1 * 8 + ks), sb[ks], O[1]); }
#pragma unroll
        for (int ks = 0; ks < 4; ++ks) { O[0] = MFMA32(FRAG(LA_QK, 0 * 4 + ks), vb[ks], O[0]); O[1] = MFMA32(FRAG(LA_QK, 1 * 4 + ks), vb[ks], O[1]); }
        float* op = outp + (size_t)c * 64 * GW + r;
#pragma unroll
        for (int rt = 0; rt < 2; ++rt)
#pragma unroll
            for (int q = 0; q < 16; ++q) op[(size_t)(32 * rt + crow(q, h)) * GW] = O[rt][q];
        const float dl = __builtin_bit_cast(float, __builtin_amdgcn_readlane(__builtin_bit_cast(int, dlv), c));
#pragma unroll
        for (int it = 0; it < 4; ++it) {
#pragma unroll
            for (int q = 0; q < 16; ++q) S[it][q] *= dl;
#pragma unroll
            for (int ks = 0; ks < 4; ++ks) S[it] = MFMA32(FRAG(LA_KE, it * 4 + ks), vb[ks], S[it]);
        }
#undef FRAG
        asm volatile("s_waitcnt lgkmcnt(0)" ::: "memory");
        }
        __builtin_amdgcn_s_barrier(); asm volatile("" ::: "memory");
    }
#undef LA_DMA
}
__device__ __forceinline__ void la_seq_phase(Frame& F, int l_unused) {
    const int lane = opq(F.lane);
    for (int item = F.vcu; item < 128; item += F.G) {
        if (item < 64) { const int seq = item >> 2, slice = item & 3, b = seq >> 2, hd = seq & 3;
            la_seq_wg<true>(F.lds + RING_OFF, F.ws + WS_FG + (size_t)seq * 32 * LA_RECG, LA_RECG, LA_UCG, wsf(F, WS_DLG) + seq * 32, wsf(F, WS_OG) + (size_t)b * SEQ * GW + hd * 128 + slice * 32, slice, lane, F.wave);
        } else { const int j = item - 64, seq = j >> 1, slice = j & 1, b = seq >> 3, hh = seq & 7;
            la_seq_wg<false>(F.lds + RING_OFF, F.ws + WS_FS + (size_t)seq * 32 * LA_RECS, LA_RECS, LA_UCS, wsf(F, WS_DLS) + seq * 32, wsf(F, WS_YS) + (size_t)b * SEQ * GW + hh * 64 + slice * 32, slice, lane, F.wave);
        }
    }
}

__device__ __forceinline__ void mixer_post_phase(Frame& F, int l) {
    const int gw = F.vcu * NWAVES + F.wave, NGW = F.G * NWAVES, lane = opq(F.lane), c = lane * 8;
    bf16* MIX = wsb(F, WS_MIX);
    const float* gng = inp(I_GNG) + (size_t)l * 128 + (c & 127); const float* sng = inp(I_SNG) + (size_t)l * GW + c;
    const f32x4 g0 = ld4(gng), g1 = ld4(gng + 4), n0 = ld4(sng), n1 = ld4(sng + 4);
    const float Dk = inp(I_SD)[l * 8 + (c >> 6)];
    for (int m = gw; m < M; m += NGW) {
        {
            const float* og = wsf(F, WS_OG) + (size_t)m * GW + c; const f32x8 zz = ldu8(wsb(F, WS_ZG) + (size_t)m * GW + c);
            const f32x4 o0 = ld4(og), o1 = ld4(og + 4), z0 = zz.lo, z1 = zz.hi;
            float ss = (o0.x * o0.x + o0.y * o0.y) + (o0.z * o0.z + o0.w * o0.w) + (o1.x * o1.x + o1.y * o1.y) + (o1.z * o1.z + o1.w * o1.w);
            ss = row16_sum(ss);
            const float rstd = 1.0f / sqrtf(ss * (1.0f / 128.0f) + EPS);
            const f32x4 y0 = o0 * rstd * g0 * silu4(z0), y1 = o1 * rstd * g1 * silu4(z1);
            v4u w; w.x = pk2(y0.x, y0.y); w.y = pk2(y0.z, y0.w); w.z = pk2(y1.x, y1.y); w.w = pk2(y1.z, y1.w);
            *(v4u*)(MIX + (size_t)m * DM + 2 * GW + c) = w;
        }
        {
            const float* ys = wsf(F, WS_YS) + (size_t)m * GW + c; const float* xs = wsf(F, WS_XS) + (size_t)m * GW + c; const f32x8 zz = ldu8(wsb(F, WS_ZS) + (size_t)m * GW + c);
            const f32x4 a0 = (ld4(ys) + ld4(xs) * Dk) * silu4(zz.lo), a1 = (ld4(ys + 4) + ld4(xs + 4) * Dk) * silu4(zz.hi);
            float ss = (a0.x * a0.x + a0.y * a0.y) + (a0.z * a0.z + a0.w * a0.w) + (a1.x * a1.x + a1.y * a1.y) + (a1.z * a1.z + a1.w * a1.w);
            ss = row16_sum(ss); ss += shx(ss, 16, lane);
            const float rstd = 1.0f / sqrtf(ss * (1.0f / 256.0f) + EPS);
            const f32x4 y0 = a0 * rstd * n0, y1 = a1 * rstd * n1;
            v4u w; w.x = pk2(y0.x, y0.y); w.y = pk2(y0.z, y0.w); w.z = pk2(y1.x, y1.y); w.w = pk2(y1.z, y1.w);
            *(v4u*)(MIX + (size_t)m * DM + 3 * GW + c) = w;
        }
    }
}

constexpr int CW_PANEL = 8192;
static_assert((CW_PANEL + DEPTH * 3 * 32 * 64) * 4 <= (int)CTL_ZERO_BYTES && CW_BAR + XCD_BAR_WORDS <= CW_PANEL, "control words inside the memset region");
namespace pg8 {
struct EpiAny {
    static constexpr bool PERM = false, AFTER_DRAIN = false, RT_DRAIN = true;
    void* C; int ldc; int mode; float scale;
    unsigned char* ws; float* out; int lq, prow0;
    __device__ __forceinline__ bool perm() const { return mode != 0; }
    __device__ __forceinline__ bool drain() const { return mode >= 3; }
    __device__ __forceinline__ void operator()(const f32x4 (&acc)[2][2][4][2], const Unit& u, int wr, int wc, int fr, int fq) const {
        if (mode == 0) { EpiF32 e{(float*)C, ldc}; e(acc, u, wr, wc, fr, fq); }
        else if (mode == 1) { EpiBf16S e{(bf16_t*)C, ldc, scale}; e(acc, u, wr, wc, fr, fq); }
        else if (mode == 2) { EpiSwiGLU e{(bf16_t*)C, ldc}; e(acc, u, wr, wc, fr, fq); }
    }
    __device__ __forceinline__ void fused(f32x4 (&acc)[2][2][4][2], const Unit& u, int wr, int wc, int fr, int fq, PG8_LAS unsigned char* lds, int wid, int lane) const {
        if (mode == 3) fused_softmax(acc, u, wr, wc, fr, fq, lds, wid, lane); else fused_resnorm(acc, u, wr, wc, fr, fq, lds, wid, lane);
    }
    __device__ __forceinline__ void fused_resnorm(f32x4 (&acc)[2][2][4][2], const Unit& u, int wr, int wc, int fr, int fq, PG8_LAS unsigned char* lds, int wid, int lane) const {
        const int D = 2048;
        {   bf16_t* Yw = (bf16_t*)(ws + WS_Y);
            const int row0 = prow0 + u.pm * BM + wr * 64 + fr, col0 = u.pn * BM + wc * 32 + 8 * fq;
#pragma unroll
            for (int ai = 0; ai < 2; ++ai)
#pragma unroll
                for (int m = 0; m < 4; ++m)
#pragma unroll
                    for (int bj = 0; bj < 2; ++bj) { const f32x4 v0 = acc[ai][bj][m][0], v1 = acc[ai][bj][m][1];
                        u32x4 w; w.x = cvt_pk_bf16(v0[0], v0[1]); w.y = cvt_pk_bf16(v0[2], v0[3]); w.z = cvt_pk_bf16(v1[0], v1[1]); w.w = cvt_pk_bf16(v1[2], v1[3]);
                        bf16_t* dst = Yw + (size_t)(row0 + ai * HALF + m * 16) * D + col0 + bj * HALF;
                        asm volatile("global_store_dwordx4 %0, %1, off sc1\n\ts_nop 1" :: "v"(dst), "v"(w) : "memory"); } }
        asm volatile("s_waitcnt vmcnt(0)" ::: "memory");
        __builtin_amdgcn_s_barrier(); asm volatile("" ::: "memory");
        const int l = lq / 3, rn = lq % 3;
        unsigned* pc = (unsigned*)(ws + WS_CTL) + CW_PANEL + (lq * 32 + (prow0 >> 8) + u.pm) * 64;
        const float* ng = inp(I_NORMG) + (size_t)l * N_NORMS * D;
        const float* gpost = ng + (rn == 0 ? MIX_POST : rn == 1 ? XA_POST : FFN_POST) * D;
        const float* gpre = rn == 0 ? ng + XA_PRE * D : rn == 1 ? ng + FFN_PRE * D : (l + 1 < DEPTH) ? ng + (N_NORMS + MIX_PRE) * D : nullptr;
        const float* xin = (lq == 0) ? inp(I_X) : out; float* xout = out; bf16_t* xn = (bf16_t*)(ws + WS_XN);
        if (wid == 0) {
            if (lane == 0) __hip_atomic_fetch_add(pc, 1u, __ATOMIC_RELAXED, __HIP_MEMORY_SCOPE_AGENT);
            unsigned spins = 0;
            while ((unsigned)__builtin_amdgcn_readfirstlane(__hip_atomic_load(pc, __ATOMIC_RELAXED, __HIP_MEMORY_SCOPE_AGENT)) < 8u) { __builtin_amdgcn_s_sleep(2); if (++spins > (1u << 22)) break; }
            __builtin_amdgcn_fence(__ATOMIC_ACQUIRE, "agent");
            asm volatile("s_waitcnt vmcnt(0)" ::: "memory");
        }
        __builtin_amdgcn_s_barrier(); asm volatile("" ::: "memory");
        const bf16_t* Y = (const bf16_t*)(ws + WS_Y);
#define BFLO(wd) __builtin_bit_cast(float, (wd) << 16)
#define BFHI(wd) __builtin_bit_cast(float, (wd) & 0xffff0000u)
#pragma unroll 1
        for (int i = 0; i < 4; ++i) {
            const size_t mrow = (size_t)prow0 + u.pm * BM + u.pn * 32 + wid * 4 + i;
            f32x4 x[8]; u32x4 yw[4];
            { const u32x4* yr = (const u32x4*)(Y + mrow * D) + lane; const f32x4* xr = (const f32x4*)(xin + mrow * D) + 2 * lane;
#pragma unroll
              for (int j = 0; j < 4; ++j) { yw[j] = yr[64 * j]; x[2 * j] = xr[128 * j]; x[2 * j + 1] = xr[128 * j + 1]; } }
            float s = 0.f;
#pragma unroll
            for (int j = 0; j < 4; ++j) { const u32x4 w = yw[j]; const float a0 = BFLO(w.x), a1 = BFHI(w.x), a2 = BFLO(w.y), a3 = BFHI(w.y), a4 = BFLO(w.z), a5 = BFHI(w.z), a6 = BFLO(w.w), a7 = BFHI(w.w);
                s += ((a0 * a0 + a1 * a1) + (a2 * a2 + a3 * a3)) + ((a4 * a4 + a5 * a5) + (a6 * a6 + a7 * a7)); }
            s = wave_sum(s);
            const float rstd = 1.0f / sqrtf(s * (1.0f / 2048.0f) + 1e-6f);
            f32x4* xo = (f32x4*)(xout + mrow * D) + 2 * lane;
            float s2 = 0.f;
#pragma unroll
            for (int j = 0; j < 4; ++j) { const u32x4 w = yw[j];
                const f32x4 y0 = (f32x4){BFLO(w.x), BFHI(w.x), BFLO(w.y), BFHI(w.y)}, y1 = (f32x4){BFLO(w.z), BFHI(w.z), BFLO(w.w), BFHI(w.w)};
                const f32x4 g0 = ((const f32x4*)gpost)[2 * lane + 128 * j], g1 = ((const f32x4*)gpost)[2 * lane + 128 * j + 1];
                const f32x4 v0 = x[2 * j] + y0 * rstd * g0, v1 = x[2 * j + 1] + y1 * rstd * g1; x[2 * j] = v0; x[2 * j + 1] = v1; xo[128 * j] = v0; xo[128 * j + 1] = v1;
                s2 += ((v0[0] * v0[0] + v0[1] * v0[1]) + (v0[2] * v0[2] + v0[3] * v0[3])) + ((v1[0] * v1[0] + v1[1] * v1[1]) + (v1[2] * v1[2] + v1[3] * v1[3])); }
            if (gpre) {
                s2 = wave_sum(s2);
                const float r2 = 1.0f / sqrtf(s2 * (1.0f / 2048.0f) + 1e-6f);
                u32x4* o8 = (u32x4*)(xn + mrow * D) + lane;
#pragma unroll
                for (int j = 0; j < 4; ++j) { const f32x4 g0 = ((const f32x4*)gpre)[2 * lane + 128 * j], g1 = ((const f32x4*)gpre)[2 * lane + 128 * j + 1]; const f32x4 a = x[2 * j] * r2 * g0, b = x[2 * j + 1] * r2 * g1;
                    u32x4 w; w.x = cvt_pk_bf16(a[0], a[1]); w.y = cvt_pk_bf16(a[2], a[3]); w.z = cvt_pk_bf16(b[0], b[1]); w.w = cvt_pk_bf16(b[2], b[3]); o8[64 * j] = w; }
            }
        }
#undef BFLO
#undef BFHI
    }
    __device__ __forceinline__ void fused_softmax(f32x4 (&acc)[2][2][4][2], const Unit& u, int wr, int wc, int fr, int fq, PG8_LAS unsigned char* lds, int wid, int lane) const {
        PG8_LAS float* Pm = (PG8_LAS float*)lds;
        PG8_LAS float* Ps = (PG8_LAS float*)(lds + 4096);
#pragma unroll
        for (int ai = 0; ai < 2; ++ai)
#pragma unroll
            for (int m = 0; m < 4; ++m) { float mx = -3.0e38f;
#pragma unroll
                for (int bj = 0; bj < 2; ++bj)
#pragma unroll
                    for (int n = 0; n < 2; ++n) { const f32x4 x = acc[ai][bj][m][n]; mx = fmaxf(mx, fmaxf(fmaxf(x[0], x[1]), fmaxf(x[2], x[3]))); }
                mx = fmaxf(mx, shx(mx, 16, lane)); mx = fmaxf(mx, shx(mx, 32, lane));
                if (fq == 0) Pm[(ai * HALF + wr * 64 + m * 16 + fr) * 4 + wc] = mx; }
        asm volatile("s_waitcnt lgkmcnt(0)" ::: "memory"); __builtin_amdgcn_s_barrier(); asm volatile("" ::: "memory");
#pragma unroll
        for (int ai = 0; ai < 2; ++ai)
#pragma unroll
            for (int m = 0; m < 4; ++m) { const int row = ai * HALF + wr * 64 + m * 16 + fr; const f32x4 pm = *(const PG8_LAS f32x4*)(Pm + row * 4);
                const float mx = fmaxf(fmaxf(pm[0], pm[1]), fmaxf(pm[2], pm[3])); float sm = 0.f;
#pragma unroll
                for (int bj = 0; bj < 2; ++bj)
#pragma unroll
                    for (int n = 0; n < 2; ++n) { f32x4 x = acc[ai][bj][m][n]; x[0] = __expf(x[0] - mx); x[1] = __expf(x[1] - mx); x[2] = __expf(x[2] - mx); x[3] = __expf(x[3] - mx);
                        acc[ai][bj][m][n] = x; sm += (x[0] + x[1]) + (x[2] + x[3]); }
                sm += shx(sm, 16, lane); sm += shx(sm, 32, lane);
                if (fq == 0) Ps[row * 4 + wc] = sm; }
        asm volatile("s_waitcnt lgkmcnt(0)" ::: "memory"); __builtin_amdgcn_s_barrier(); asm volatile("" ::: "memory");
        const int row0 = u.pm * BM + wr * 64 + fr, col0 = u.pn * BM + wc * 32 + 8 * fq;
#pragma unroll
        for (int ai = 0; ai < 2; ++ai)
#pragma unroll
            for (int m = 0; m < 4; ++m) { const int row = ai * HALF + wr * 64 + m * 16 + fr; const f32x4 ps = *(const PG8_LAS f32x4*)(Ps + row * 4);
                const float inv = 1.0f / ((ps[0] + ps[1]) + (ps[2] + ps[3]));
                bf16_t* rowp = (bf16_t*)C + (size_t)(row0 + ai * HALF + m * 16) * ldc + col0;
#pragma unroll
                for (int bj = 0; bj < 2; ++bj) { const f32x4 v0 = acc[ai][bj][m][0] * inv, v1 = acc[ai][bj][m][1] * inv;
                    u32x4 w; w.x = cvt_pk_bf16(v0[0], v0[1]); w.y = cvt_pk_bf16(v0[2], v0[3]); w.z = cvt_pk_bf16(v1[0], v1[1]); w.w = cvt_pk_bf16(v1[2], v1[3]);
                    *(u32x4*)(rowp + bj * HALF) = w; } }
    }
};
}

#ifndef SKIPM
#define SKIPM 0
#endif
#ifndef REPM
#define REPM 0
#endif
#ifndef GEMM_SP2
#define GEMM_SP2 true
#endif
#ifndef GEMM_ALIGN
#define GEMM_ALIGN true
#endif
#ifndef PROBE_PH
#define PROBE_PH -1
#endif
constexpr int PH_PER_LAYER = 10, PH0 = 2, N_PHASES = PH0 + DEPTH * PH_PER_LAYER;
struct Args { const float* in[N_IN]; float* out; unsigned char* ws; int ph_lo, ph_hi; };
static_assert(sizeof(Args) == (N_IN + 2) * 8 + 8, "Args has no padding");
struct GemmDesc { const bf16* A; const bf16* Bt; void* C; int M, N, K, lda, ldb, ldc, mode, corder, rn, prow0; float scale; };
constexpr int NOUNIT = 1 << 24;
__device__ __forceinline__ int gemm_nsub(int ph, int k, int l) { return ph == 0 ? 0 : ph == 1 ? 1 : (k == 1 || k == 2 || k == 4) ? 0 : k == 3 ? (l == 0 ? 33 : 32) : (k == 6 || k == 7) ? BATCH : 1; }
__device__ __forceinline__ int pmod(int x, int m) { const int r = x % m; return r < 0 ? r + m : r; }
__device__ __forceinline__ void kv_desc(const Frame& F, int l, int v0, GemmDesc& d) {
    d.A = wsb(F, WS_MEMN) + (size_t)l * MROWS * DM; d.Bt = (const bf16*)(F.ws + WS_W + (size_t)l * W_LAYER + WO_WKV); d.C = wsb(F, WS_KV) + (size_t)l * MROWS * 2 * DM;
    d.M = MROWS; d.N = 2 * DM; d.K = DM; d.lda = DM; d.ldb = DM; d.ldc = 2 * DM; d.mode = 1; d.corder = (F.vcu >= v0 && F.vcu < v0 + 64) ? F.vcu - v0 : NOUNIT;
}
__device__ __forceinline__ void gemm_desc(const Frame& F, int ph, int sub, GemmDesc& d) {
    const int bx = (int)blockIdx.x;
    d.scale = 1.0f; d.corder = bx; d.rn = -1; d.prow0 = 0;
    if (ph == 1) { kv_desc(F, 0, 0, d); return; }
    const int l = (ph - PH0) / PH_PER_LAYER, k = (ph - PH0) % PH_PER_LAYER;
    if (k == 3) {
        if (sub == 32) { kv_desc(F, 1, 192, d); return; }
        const int which = sub & 1, h = (sub >> 1) & 3, b = (sub >> 3) & 3;
        const unsigned char* wl = F.ws + WS_W + (size_t)l * W_LAYER;
        const bf16* kv = wsb(F, WS_KV) + (size_t)l * MROWS * 2 * DM + (size_t)(b * MEML) * 2 * DM + h * XHD;
        const int nb = (l == 0) ? 64 : 128;
        d.K = XHD; d.mode = 1; d.corder = (F.vcu >= 128 && F.vcu < 128 + nb) ? pmod(F.vcu - 128 - 8 * sub, nb) : NOUNIT;
        if (which == 0) {
            d.A = kv; d.lda = 2 * DM; d.Bt = (const bf16*)(wl + WO_WQ) + h * XHD; d.ldb = DM; d.M = MEML; d.N = DM;
            d.C = wsb(F, WS_AT) + ((size_t)(l * BATCH + b) * 1024 + h * MEML) * DM; d.ldc = DM; d.scale = 0.044194173824159216f;
        } else {
            d.A = (const bf16*)(wl + WO_WO) + h * XHD; d.lda = DM; d.Bt = kv + DM; d.ldb = 2 * DM; d.M = DM; d.N = MEML;
            d.C = wsb(F, WS_VWT) + (size_t)(l * BATCH + b) * DM * 1024 + h * MEML; d.ldc = 1024;
        }
        return;
    }
    const unsigned char* wl = F.ws + WS_W + (size_t)l * W_LAYER;
    d.M = M; d.K = DM; d.N = DM; d.lda = DM; d.ldb = DM; d.ldc = DM; d.mode = 1; d.A = wsb(F, WS_XN); d.C = wsb(F, WS_Y);
    if (k == 0) { d.Bt = (const bf16*)(wl + WO_WIN); d.N = IN_PAD; d.C = wsb(F, WS_U); d.ldc = IN_PAD; d.mode = 1; }
    else if (k == 5) { d.A = wsb(F, WS_MIX); d.Bt = (const bf16*)(wl + WO_WOUT); d.mode = 4; d.rn = 0; }
    else if (k == 6) {
        const int b = sub; d.A = wsb(F, WS_XN) + (size_t)b * SEQ * DM; d.Bt = wsb(F, WS_AT) + (size_t)(l * BATCH + b) * 1024 * DM; d.M = SEQ; d.N = 1024;
        d.C = wsb(F, WS_P) + (size_t)b * SEQ * 1024; d.ldc = 1024; d.mode = 3; d.corder = (bx + F.G - 32 * sub) % F.G; }
    else if (k == 7) {
        const int b = sub; d.A = wsb(F, WS_P) + (size_t)b * SEQ * 1024; d.lda = 1024; d.Bt = wsb(F, WS_VWT) + (size_t)(l * BATCH + b) * DM * 1024; d.ldb = 1024; d.M = SEQ; d.K = 1024;
        d.mode = 4; d.rn = 1; d.prow0 = b * SEQ; d.corder = (bx + F.G - 64 * sub) % F.G; }
    else if (k == 8) { d.Bt = (const bf16*)(wl + WO_WGU); d.N = 2 * DFF; d.mode = 2; d.C = wsb(F, WS_HID); d.ldc = DFF; }
    else { d.A = wsb(F, WS_HID); d.Bt = (const bf16*)(wl + WO_WD); d.K = DFF; d.lda = DFF; d.ldb = DFF; d.mode = 4; d.rn = 2; }
}

__global__ void __launch_bounds__(NWAVES * 64, 2) fwd_kernel(Args args) {
    extern __shared__ __attribute__((aligned(16))) unsigned char lds[];
    Frame F;
    F.lds = (LAS unsigned char*)lds;
    F.MISC = (volatile LAS unsigned*)(F.lds + MISC_OFF);
    F.tid = threadIdx.x; F.lane = F.tid & 63; F.wave = __builtin_amdgcn_readfirstlane(F.tid >> 6);
    F.G = gridDim.x; { const int bx = blockIdx.x; F.vcu = (F.G % 8 == 0) ? (bx % 8) * (F.G / 8) + bx / 8 : bx; }
    F.ws = args.ws; F.out = args.out; F.ctl = (unsigned*)(args.ws + WS_CTL);
    for (int u = F.tid; u < (LDS_BYTES - LDSCTL_OFF) / 4; u += NWAVES * 64) ((LAS unsigned*)(F.lds + LDSCTL_OFF))[u] = 0u;
    __syncthreads();
    const int lo = args.ph_lo, hi = args.ph_hi;
    if (hi - lo > 1) (void)xcd_barrier_post(F.ctl + CW_BAR, F.MISC + 8);
#define GRID_BARRIER() do { XcdBarrier b_; b_.bar = F.ctl + CW_BAR; b_.x = xb_xcc_id(); b_.st = F.MISC + 8; xcd_barrier(b_); } while (0)
    LAS unsigned char* ring = F.lds + RING_OFF;
#if PROBE_PH >= 0
    unsigned long long t_start = __builtin_amdgcn_s_memrealtime(), t_probe = 0;
#endif
#pragma unroll 1
    for (int ph = lo; ph < hi; ++ph) {
        const int l = ph >= PH0 ? (ph - PH0) / PH_PER_LAYER : 0, k = ph >= PH0 ? (ph - PH0) % PH_PER_LAYER : -1;
        const int kbit = (ph < PH0) ? ph : (k + PH0);
        const int reps = 1 + ((REPM >> kbit) & 1);
#pragma unroll 1
        for (int rep = 0; rep < reps; ++rep) {
        if (ph < PH0) p0_prologue(F, ph);
        else if (k == 1) mixer_prep_phase(F, l);
        else if (k == 2) la_prep_phase(F, l);
        else if (k == 3) la_seq_phase(F, l);
        else if (k == 4) mixer_post_phase(F, l);
        const int nsub = gemm_nsub(ph, k, l);
#pragma unroll 1
        for (int sub = 0; sub < nsub; ++sub) {
            GemmDesc d; gemm_desc(F, ph, sub, d);
            pg8::Gemm g{d.A, d.Bt, d.M, d.N, d.K, d.lda, d.ldb}; pg8::StaticOrder S; S.init(d.M, d.N, F.G, d.corder);
            pg8::EpiAny E{d.C, d.ldc, d.mode, d.scale, F.ws, F.out, l * 3 + d.rn, d.prow0};
            pg8::gemm_phase<pg8::EpiAny, pg8::StaticOrder, GEMM_ALIGN, GEMM_SP2>(ring, g, S, E);
        }
        if (REPM >> 20) { if (rep + 1 < reps) __syncthreads(); }
        }
        if ((REPM >> 21) & 1) GRID_BARRIER();
        if (ph + 1 < hi) GRID_BARRIER();
#if PROBE_PH >= 0
        if (ph == PROBE_PH) t_probe = __builtin_amdgcn_s_memrealtime();
#endif
    }
#if PROBE_PH >= 0
    if (blockIdx.x == 0) {
        const unsigned long long t_end = __builtin_amdgcn_s_memrealtime();
        while (__builtin_amdgcn_s_memrealtime() - t_end < t_probe - t_start) __builtin_amdgcn_s_sleep(8);
    }
#endif
}

#ifndef MK_SINGLE
#define MK_SINGLE 0
#endif
extern "C" void kernel_launch(void* const* d_in, const int* in_sizes, int n_in, void* d_out, int out_size, void* d_ws, size_t ws_size, hipStream_t stream) {
    static int grid = 0;
    if (grid == 0) {
        if (n_in != N_IN || in_sizes[0] != M * DM || out_size != M * DM || ws_size < WS_END) { fprintf(stderr, "kernel_launch: unexpected problem (n_in %d, in0 %d, out %d, ws %zu < %zu)\n", n_in, n_in > 0 ? in_sizes[0] : -1, out_size, ws_size, (size_t)WS_END); grid = -1; return; }
        int dev = 0, cus = 0, per_cu = 0;
        if (hipGetDevice(&dev) != hipSuccess || hipDeviceGetAttribute(&cus, hipDeviceAttributeMultiprocessorCount, dev) != hipSuccess) { grid = -1; return; }
        if (hipFuncSetAttribute((const void*)fwd_kernel, hipFuncAttributeMaxDynamicSharedMemorySize, LDS_BYTES) != hipSuccess) { fprintf(stderr, "kernel_launch: hipFuncSetAttribute failed\n"); grid = -1; return; }
        if (hipOccupancyMaxActiveBlocksPerMultiprocessor(&per_cu, (const void*)fwd_kernel, NWAVES * 64, LDS_BYTES) != hipSuccess || per_cu < 1) { fprintf(stderr, "kernel_launch: occupancy query says %d blocks per CU\n", per_cu); per_cu = 1; }
        (void)hipGetLastError();
        grid = cus * (per_cu < 1 ? 1 : 1);
        if (grid != 256) fprintf(stderr, "kernel_launch: note: grid %d (expected 256)\n", grid);
    }
    if (grid < 0) return;
    if (hipMemsetAsync((char*)d_ws + WS_CTL, 0, CTL_ZERO_BYTES, stream) != hipSuccess) { fprintf(stderr, "kernel_launch: memset failed\n"); return; }
    Args a{};
    for (int i = 0; i < N_IN; ++i) a.in[i] = (const float*)d_in[i];
    a.out = (float*)d_out; a.ws = (unsigned char*)d_ws;
#if MK_SINGLE
    a.ph_lo = 0; a.ph_hi = N_PHASES;
    void* kargs[] = {&a};
    hipError_t e = hipLaunchCooperativeKernel((const void*)fwd_kernel, dim3(grid), dim3(NWAVES * 64), kargs, LDS_BYTES, stream);
    if (e != hipSuccess) fprintf(stderr, "kernel_launch: cooperative launch failed: %s (grid %d)\n", hipGetErrorString(e), grid);
#else
    for (int p = 0; p < N_PHASES; ++p) { a.ph_lo = p; a.ph_hi = p + 1;
        hipLaunchKernelGGL(fwd_kernel, dim3(grid), dim3(NWAVES * 64), LDS_BYTES, stream, a);
        const hipError_t le = hipPeekAtLastError(); if (le != hipSuccess) { fprintf(stderr, "kernel_launch: launch %d failed: %s\n", p, hipGetErrorName(le)); break; } }
#endif
}
```

```cpp
#include <hip/hip_runtime.h>
#include <cstdio>
#include <cstdint>
#define MK_SINGLE 1
namespace pg8 {
#define PG8_LAS __attribute__((address_space(3)))
typedef unsigned short bf16_t;
typedef short bf16x8 __attribute__((ext_vector_type(8)));
typedef float f32x4 __attribute__((ext_vector_type(4)));
typedef unsigned u32x4 __attribute__((ext_vector_type(4)));
constexpr int BM = 256, BK = 64, HALF = 128, HTB = HALF * BK * 2  , STAGE_BYTES = 8 * HTB, NXCD = 8, WGM = 8;

__host__ __device__ __forceinline__ int lds_byte(int r, int c) { const int st = (r >> 4) * 2 + (c >> 5), rr = r & 15, cc = c & 31, ob = rr * 64 + cc * 2; return st * 1024 + (ob ^ (((ob >> 9) & 1) << 5)); }
__host__ __device__ __forceinline__ void stage_rc(int b, int& R, int& C) { const int st = b / 1024, sb = b % 1024, swz = sb ^ (((sb >> 9) & 1) << 5); R = (st >> 1) * 16 + swz / 64; C = (st & 1) * 32 + (swz % 64) / 2; }
__host__ __device__ __forceinline__ int perm32(int rho) { const int n = rho >> 4, i = rho & 15; return 8 * (i >> 2) + 4 * n + (i & 3); }

struct Unit { int pm, pn; };
struct Gemm { const bf16_t* A; const bf16_t* Bt; int M, N, K, lda, ldb; };

struct StaticOrder {
    int nM, nN, nwg, G, c;
    __host__ __device__ void init(int M, int N, int G_, int c_) { nM = M / BM; nN = N / BM; nwg = nM * nN; G = G_; c = c_; }
    __host__ __device__ bool next(int i, Unit& u) const {
        const long L = (long)i * G + c; if (L >= nwg) return false;
        int wgid = (int)L; { const int q = nwg / NXCD, r = nwg % NXCD, xcd = wgid % NXCD, off = wgid / NXCD; wgid = (xcd < r ? xcd * (q + 1) : r * (q + 1) + (xcd - r) * q) + off; }
        const int nig = WGM * nN, gid = wgid / nig, fm = gid * WGM, gsz = (nM - fm) < WGM ? (nM - fm) : WGM;
        u.pm = fm + ((wgid % nig) % gsz); u.pn = (wgid % nig) / gsz; return true;
    }
    __device__ __forceinline__ void a_ready(const Unit&) const {}
    __device__ __forceinline__ void done(const Unit&) const {}
};

__device__ __forceinline__ unsigned cvt_pk_bf16(float lo, float hi) { unsigned r; asm volatile("v_cvt_pk_bf16_f32 %0, %1, %2" : "=v"(r) : "v"(lo), "v"(hi)); return r; }
struct EpiF32 {
    static constexpr bool PERM = false, AFTER_DRAIN = false;
    float* C; int ldc;
    __device__ __forceinline__ void operator()(const f32x4 (&acc)[2][2][4][2], const Unit& u, int wr, int wc, int fr, int fq) const {
        const int row0 = u.pm * BM + wr * 64 + fr, col0 = u.pn * BM + wc * 32 + 4 * fq;
#pragma unroll
        for (int ai = 0; ai < 2; ++ai)
#pragma unroll
            for (int m = 0; m < 4; ++m) { float* rowp = C + (size_t)(row0 + ai * HALF + m * 16) * ldc + col0;
#pragma unroll
                for (int bj = 0; bj < 2; ++bj)
#pragma unroll
                    for (int n = 0; n < 2; ++n) *(f32x4*)(rowp + bj * HALF + n * 16) = acc[ai][bj][m][n]; }
    }
};
struct EpiBf16S {
    static constexpr bool PERM = true, AFTER_DRAIN = false;
    bf16_t* O; int ldc; float scale;
    __device__ __forceinline__ void operator()(const f32x4 (&acc)[2][2][4][2], const Unit& u, int wr, int wc, int fr, int fq) const {
        const int row0 = u.pm * BM + wr * 64 + fr, col0 = u.pn * BM + wc * 32 + 8 * fq; const float sc = scale;
#pragma unroll
        for (int ai = 0; ai < 2; ++ai)
#pragma unroll
            for (int m = 0; m < 4; ++m) { bf16_t* rowp = O + (size_t)(row0 + ai * HALF + m * 16) * ldc + col0;
#pragma unroll
                for (int bj = 0; bj < 2; ++bj) { const f32x4 v0 = acc[ai][bj][m][0] * sc, v1 = acc[ai][bj][m][1] * sc;
                    u32x4 w; w.x = cvt_pk_bf16(v0[0], v0[1]); w.y = cvt_pk_bf16(v0[2], v0[3]); w.z = cvt_pk_bf16(v1[0], v1[1]); w.w = cvt_pk_bf16(v1[2], v1[3]);
                    *(u32x4*)(rowp + bj * HALF) = w; } }
    }
};
__device__ __forceinline__ float silu_f(float v) { return v / (1.0f + __expf(-v)); }
struct EpiSwiGLU {
    static constexpr bool PERM = true, AFTER_DRAIN = false;
    bf16_t* O; int ldc;
    __device__ __forceinline__ void operator()(const f32x4 (&acc)[2][2][4][2], const Unit& u, int wr, int wc, int fr, int fq) const {
        const int row0 = u.pm * BM + wr * 64 + fr, col0 = u.pn * HALF + wc * 32 + 8 * fq;
#pragma unroll
        for (int ai = 0; ai < 2; ++ai)
#pragma unroll
            for (int m = 0; m < 4; ++m) { bf16_t* rowp = O + (size_t)(row0 + ai * HALF + m * 16) * ldc + col0;
                const f32x4 g0 = acc[ai][0][m][0], g1 = acc[ai][0][m][1], u0 = acc[ai][1][m][0], u1 = acc[ai][1][m][1];
                u32x4 w; w.x = cvt_pk_bf16(silu_f(g0[0]) * u0[0], silu_f(g0[1]) * u0[1]); w.y = cvt_pk_bf16(silu_f(g0[2]) * u0[2], silu_f(g0[3]) * u0[3]);
                w.z = cvt_pk_bf16(silu_f(g1[0]) * u1[0], silu_f(g1[1]) * u1[1]); w.w = cvt_pk_bf16(silu_f(g1[2]) * u1[2], silu_f(g1[3]) * u1[3]);
                *(u32x4*)rowp = w; }
    }
};
template <class Epi, class Sched, bool ALIGN_EPI = false, bool SP2 = false>
__device__ __forceinline__ void gemm_phase(PG8_LAS unsigned char* lds, const Gemm g, const Sched& S, const Epi& E) {
    int tid_ = threadIdx.x; asm volatile("" : "+v"(tid_));
    const int tid = tid_, wid = __builtin_amdgcn_readfirstlane(tid >> 6), lane = tid & 63, wr = wid >> 2, wc = wid & 3, fr = lane & 15, fq = lane >> 4;
    const int K = g.K, nt = K / BK;
    unsigned voffA[2], voffB[2];
#pragma unroll
    for (int i = 0; i < 2; ++i) { int R, C; stage_rc(tid * 16 + i * 8192, R, C); const int Rb = E.perm() ? ((R & ~31) + perm32(R & 31)) : R;
        voffA[i] = (unsigned)(R * g.lda + C) * 2u; voffB[i] = (unsigned)(Rb * g.ldb + C) * 2u; }
    const size_t kstep = (size_t)(BK * 2);
    const size_t hstepA = (size_t)HALF * g.lda * 2, hstepB = (size_t)HALF * g.ldb * 2;
    const size_t tstepA = 2 * hstepA, tstepB = 2 * hstepB;
    const unsigned ldsw = (unsigned)wid * 1024u;
    const int aoff = lds_byte(wr * 64 + fr, fq * 8), boff = lds_byte(wc * 32 + fr, fq * 8);
#define PG8_SA(b, h) (((b) * 2 + (h)) * HTB)
#define PG8_SB(b, h) ((4 + (b) * 2 + (h)) * HTB)
#define PG8_STAGE(bufoff, gbase, voff) do { _Pragma("unroll") for (int _i = 0; _i < 2; ++_i) \
        __builtin_amdgcn_global_load_lds((const unsigned*)((const char*)(gbase) + (voff)[_i]), (PG8_LAS unsigned*)(lds + (bufoff) + ldsw + _i * 8192), 16, 0, 0); } while (0)
#define PG8_LDA(dst, b, h) do { _Pragma("unroll") for (int m = 0; m < 4; ++m) _Pragma("unroll") for (int k = 0; k < 2; ++k) dst[m][k] = *(const PG8_LAS bf16x8*)(lds + PG8_SA(b, h) + aoff + m * 2048 + k * 1024); } while (0)
#define PG8_LDB(dst, b, h) do { _Pragma("unroll") for (int n = 0; n < 2; ++n) _Pragma("unroll") for (int k = 0; k < 2; ++k) dst[n][k] = *(const PG8_LAS bf16x8*)(lds + PG8_SB(b, h) + boff + n * 2048 + k * 1024); } while (0)
#define PG8_MMA(ai, bj, At, Bt) do { __builtin_amdgcn_s_setprio(1); _Pragma("unroll") for (int m = 0; m < 4; ++m) _Pragma("unroll") for (int n = 0; n < 2; ++n) _Pragma("unroll") for (int k = 0; k < 2; ++k) \
        acc[ai][bj][m][n] = __builtin_amdgcn_mfma_f32_16x16x32_bf16(Bt[n][k], At[m][k], acc[ai][bj][m][n], 0, 0, 0); __builtin_amdgcn_s_setprio(0); } while (0)
#define PG8_WAIT_V(n) asm volatile("s_waitcnt vmcnt(" #n ")" ::: "memory")
#define PG8_WAIT_L(n) asm volatile("s_waitcnt lgkmcnt(" #n ")" ::: "memory")
#define PG8_BAR __builtin_amdgcn_s_barrier()
#define PG8_SCHED __builtin_amdgcn_sched_barrier(0)
    Unit cur, nxt; int ui = 0;
    if (!S.next(0, cur)) return;
    f32x4 acc[2][2][4][2];
#pragma unroll
    for (int a = 0; a < 2; ++a)
#pragma unroll
        for (int b = 0; b < 2; ++b)
#pragma unroll
            for (int m = 0; m < 4; ++m)
#pragma unroll
                for (int n = 0; n < 2; ++n) acc[a][b][m][n] = (f32x4){0.f, 0.f, 0.f, 0.f};
    bf16x8 At[4][2], B0[2][2], B1[2][2];
#pragma unroll
    for (int m = 0; m < 4; ++m)
#pragma unroll
        for (int k = 0; k < 2; ++k) asm volatile("" : "=v"(At[m][k]));
#pragma unroll
    for (int n = 0; n < 2; ++n)
#pragma unroll
        for (int k = 0; k < 2; ++k) { asm volatile("" : "=v"(B0[n][k])); asm volatile("" : "=v"(B1[n][k])); }
    const char* cA = (const char*)g.A + (size_t)cur.pm * tstepA; const char* cB = (const char*)g.Bt + (size_t)cur.pn * tstepB;
    S.a_ready(cur);
    if constexpr (SP2) {
        PG8_STAGE(PG8_SB(0, 0), cB, voffB); PG8_STAGE(PG8_SB(0, 1), cB + hstepB, voffB); PG8_STAGE(PG8_SA(0, 0), cA, voffA); PG8_STAGE(PG8_SA(0, 1), cA + hstepA, voffA);
        if (wr == 1) PG8_BAR;
        PG8_WAIT_V(2); PG8_BAR;
        PG8_STAGE(PG8_SB(1, 0), cB + kstep, voffB); PG8_STAGE(PG8_SA(1, 0), cA + kstep, voffA); PG8_STAGE(PG8_SB(1, 1), cB + hstepB + kstep, voffB);
        PG8_WAIT_V(6); PG8_BAR;
    } else {
        PG8_STAGE(PG8_SB(0, 0), cB, voffB); PG8_STAGE(PG8_SA(0, 0), cA, voffA); PG8_STAGE(PG8_SB(0, 1), cB + hstepB, voffB); PG8_STAGE(PG8_SA(0, 1), cA + hstepA, voffA);
        if (wr == 1) PG8_BAR;
        PG8_WAIT_V(4); PG8_BAR;
        PG8_STAGE(PG8_SB(1, 0), cB + kstep, voffB); PG8_STAGE(PG8_SA(1, 0), cA + kstep, voffA); PG8_STAGE(PG8_SB(1, 1), cB + hstepB + kstep, voffB);
        PG8_WAIT_V(6); PG8_BAR;
    }
    for (;;) {
        const bool has_next = S.next(ui + 1, nxt);
        const char* nA = has_next ? (const char*)g.A + (size_t)nxt.pm * tstepA : cA; const char* nB = has_next ? (const char*)g.Bt + (size_t)nxt.pn * tstepB : cB;
        for (int t = 0; t < nt; t += 2) {
            const bool last = (t == nt - 2);
            const char* a1 = cA + (size_t)(t + 1) * kstep;
            const char* a2 = last ? nA : cA + (size_t)(t + 2) * kstep; const char* b2 = last ? nB : cB + (size_t)(t + 2) * kstep;
            const char* a3 = a2 + kstep; const char* b3 = b2 + kstep;
            if (last && has_next) S.a_ready(nxt);
            if constexpr (SP2) {
            PG8_LDB(B0, 0, 0); PG8_LDB(B1, 0, 1); PG8_SCHED; PG8_LDA(At, 0, 0); PG8_STAGE(PG8_SA(1, 1), a1 + hstepA, voffA);
            PG8_WAIT_V(8); PG8_WAIT_L(0); PG8_BAR; PG8_MMA(0, 0, At, B0); PG8_MMA(0, 1, At, B1); PG8_BAR; PG8_SCHED;
            PG8_LDA(At, 0, 1); PG8_STAGE(PG8_SB(0, 0), b2, voffB); PG8_STAGE(PG8_SB(0, 1), b2 + hstepB, voffB); PG8_STAGE(PG8_SA(0, 0), a2, voffA);
            PG8_WAIT_V(8); PG8_WAIT_L(0); PG8_BAR; PG8_MMA(1, 0, At, B0); PG8_MMA(1, 1, At, B1); PG8_BAR; PG8_SCHED;
            PG8_LDB(B0, 1, 0); PG8_LDB(B1, 1, 1); PG8_SCHED; PG8_LDA(At, 1, 0); PG8_STAGE(PG8_SA(0, 1), a2 + hstepA, voffA);
            PG8_WAIT_V(8); PG8_WAIT_L(0); PG8_BAR; PG8_MMA(0, 0, At, B0); PG8_MMA(0, 1, At, B1); PG8_BAR; PG8_SCHED;
            PG8_LDA(At, 1, 1); PG8_STAGE(PG8_SB(1, 0), b3, voffB); PG8_STAGE(PG8_SB(1, 1), b3 + hstepB, voffB); PG8_STAGE(PG8_SA(1, 0), a3, voffA);
            PG8_WAIT_V(8); PG8_WAIT_L(0); PG8_BAR; PG8_MMA(1, 0, At, B0); PG8_MMA(1, 1, At, B1); PG8_BAR; PG8_SCHED;
            } else {
            PG8_LDB(B0, 0, 0); PG8_SCHED; PG8_LDA(At, 0, 0); PG8_STAGE(PG8_SA(1, 1), a1 + hstepA, voffA);
            PG8_WAIT_L(8); PG8_BAR; PG8_WAIT_L(0); PG8_MMA(0, 0, At, B0); PG8_BAR; PG8_SCHED;
            PG8_LDB(B1, 0, 1); PG8_STAGE(PG8_SB(0, 0), b2, voffB);
            PG8_BAR; PG8_WAIT_L(0); PG8_MMA(0, 1, At, B1); PG8_BAR;
            PG8_LDA(At, 0, 1); PG8_STAGE(PG8_SA(0, 0), a2, voffA);
            PG8_BAR; PG8_WAIT_L(0); PG8_MMA(1, 0, At, B0); PG8_BAR; PG8_SCHED;
            PG8_STAGE(PG8_SB(0, 1), b2 + hstepB, voffB);
            PG8_WAIT_V(6); PG8_BAR; PG8_MMA(1, 1, At, B1); PG8_BAR;
            PG8_LDB(B0, 1, 0); PG8_SCHED; PG8_LDA(At, 1, 0); PG8_STAGE(PG8_SA(0, 1), a2 + hstepA, voffA);
            PG8_WAIT_L(8); PG8_BAR; PG8_WAIT_L(0); PG8_MMA(0, 0, At, B0); PG8_BAR; PG8_SCHED;
            PG8_LDB(B1, 1, 1); PG8_STAGE(PG8_SB(1, 0), b3, voffB);
            PG8_BAR; PG8_WAIT_L(0); PG8_MMA(0, 1, At, B1); PG8_BAR;
            PG8_LDA(At, 1, 1); PG8_STAGE(PG8_SA(1, 0), a3, voffA);
            PG8_BAR; PG8_WAIT_L(0); PG8_MMA(1, 0, At, B0); PG8_BAR; PG8_SCHED;
            PG8_STAGE(PG8_SB(1, 1), b3 + hstepB, voffB);
            PG8_WAIT_V(6); PG8_BAR; PG8_MMA(1, 1, At, B1); PG8_BAR;
            }
        }
        if constexpr (ALIGN_EPI) { if (wr == 0) PG8_BAR; }
        if constexpr (!Epi::AFTER_DRAIN) { E(acc, cur, wr, wc, fr, fq); S.done(cur); }
        if (!has_next) break;
#pragma unroll
        for (int a = 0; a < 2; ++a)
#pragma unroll
            for (int b = 0; b < 2; ++b)
#pragma unroll
                for (int m = 0; m < 4; ++m)
#pragma unroll
                    for (int n = 0; n < 2; ++n) acc[a][b][m][n] = (f32x4){0.f, 0.f, 0.f, 0.f};
        cur = nxt; cA = nA; cB = nB; ++ui;
        if constexpr (ALIGN_EPI) { if (wr == 1) PG8_BAR; }
    }
    PG8_WAIT_V(0);
    if constexpr (!ALIGN_EPI) { if (wr == 0) PG8_BAR; }
    PG8_BAR;
    if constexpr (Epi::AFTER_DRAIN) { E.fused(acc, cur, wr, wc, fr, fq, lds, wid, lane); S.done(cur); }
    if constexpr (Epi::RT_DRAIN) { if (E.drain()) E.fused(acc, cur, wr, wc, fr, fq, lds, wid, lane); }
#undef PG8_SA
#undef PG8_SB
#undef PG8_STAGE
#undef PG8_LDA
#undef PG8_LDB
#undef PG8_MMA
#undef PG8_WAIT_V
#undef PG8_WAIT_L
#undef PG8_BAR
#undef PG8_SCHED
}
}
constexpr int NWAVES = 8;
constexpr int BATCH = 4, SEQ = 2048, DM = 2048, DEPTH = 2;
constexpr int M = BATCH * SEQ;
constexpr int GW = 512;
constexpr int IN_COLS = 5648, IN_PAD = 5888;
constexpr int DFF = 5632, MEML = 256, XH = 4, XHD = 512;
constexpr int MROWS = BATCH * MEML;
constexpr float EPS = 1e-6f;
constexpr int UA_B = 0, UA_C = 512, UA_H = 1024, UB = 1536, UC_Q = 2048, UC_Z = 3584, UC_A = 4096, UC_B = 4100, UD_Z = 4104, UD_X = 4616, UD_DT = 5640;
constexpr int MIX_PRE = 0, MIX_POST = 1, XA_PRE = 2, XA_POST = 3, MEM_NORM = 4, FFN_PRE = 5, FFN_POST = 6, N_NORMS = 7;
enum { I_X = 0, I_MEM, I_NORMG, I_WIN, I_CONVA, I_POOLW, I_POOLS, I_GCONV, I_GALOG, I_GDTB, I_GNG, I_SCONVW, I_SCONVB, I_SALOG, I_SDTB, I_SD, I_SNG, I_WOUT, I_WQ, I_WKV, I_WO, I_WGU, I_WD, N_IN };

constexpr size_t MiB = 1u << 20;
constexpr size_t WS_CTL = 0, CTL_ZERO_BYTES = 1 * MiB;
constexpr size_t WSZ_WIN = (size_t)IN_PAD * DM * 2, WSZ_SQ = (size_t)DM * DM * 2, WSZ_KV = (size_t)2 * DM * DM * 2, WSZ_GU = (size_t)2 * DFF * DM * 2, WSZ_D = (size_t)DM * DFF * 2;
constexpr size_t WO_WIN = 0, WO_WOUT = WO_WIN + WSZ_WIN, WO_WQ = WO_WOUT + WSZ_SQ, WO_WKV = WO_WQ + WSZ_SQ, WO_WO = WO_WKV + WSZ_KV, WO_WGU = WO_WO + WSZ_SQ, WO_WD = WO_WGU + WSZ_GU, W_LAYER = WO_WD + WSZ_D;
constexpr size_t WS_W = 1 * MiB;
constexpr size_t WS_XN = WS_W + 2 * W_LAYER;
constexpr size_t WS_MIX = WS_XN + (size_t)M * DM * 2;
constexpr size_t WS_MEMN = WS_MIX + (size_t)M * DM * 2;
constexpr size_t WS_KV = WS_MEMN + (size_t)2 * MROWS * DM * 2;
constexpr size_t WS_U = WS_KV + (size_t)2 * MROWS * 2 * DM * 2;
constexpr size_t WS_P = WS_U, WS_HID = WS_U + (size_t)M * DM * 2;
constexpr size_t WS_UEND = WS_U + (size_t)120 * MiB;
constexpr size_t WS_ZG = WS_UEND, WS_ZS = WS_ZG + (size_t)M * 512 * 2, WS_BS = WS_ZS + (size_t)M * 512 * 2, WS_CS = WS_BS + (size_t)M * 256 * 4;
constexpr size_t WS_SCR = WS_CS + (size_t)M * 256 * 4;
constexpr size_t WS_Y = WS_SCR;
constexpr size_t SZ512 = (size_t)M * 512 * 4, SZ256 = (size_t)M * 256 * 4, SZ8 = (size_t)M * 8 * 4;
constexpr size_t WS_QN = WS_SCR, WS_KN = WS_QN + SZ512, WS_VV = WS_KN + SZ512, WS_OG = WS_VV + SZ512, WS_XS = WS_OG + SZ512, WS_YS = WS_XS + SZ512,
                 WS_GB = WS_YS + SZ512, WS_DT = WS_GB + SZ8, WS_SCR_END = WS_DT + 2 * SZ8;
constexpr size_t WS_RS = WS_SCR_END;
constexpr size_t WS_AT = WS_RS + (size_t)M * 4, WS_VWT = WS_AT + (size_t)DEPTH * BATCH * 1024 * DM * 2, WS_END = WS_VWT + (size_t)DEPTH * BATCH * DM * 1024 * 2;
constexpr int LA_QD = 0, LA_QK = 16384, LA_KE = 24576, LA_NW = 40960, LA_UCG = 57344, LA_RECG = 90112;
constexpr int LA_UCS = 40960, LA_RECS = 57344;
constexpr size_t WS_FG = WS_U, WS_FS = WS_FG + (size_t)512 * LA_RECG, WS_DLG = WS_FS + (size_t)1024 * LA_RECS, WS_DLS = WS_DLG + 512 * 4, WS_FEND = WS_DLS + 1024 * 4;
static_assert(WS_FEND <= WS_UEND, "records inside U");
static_assert(WS_Y + (size_t)M * DM * 4 <= WS_SCR_END, "Y inside the scan region");
static_assert(WS_HID + (size_t)M * DFF * 2 <= WS_UEND && (size_t)M * IN_PAD * 2 <= (size_t)120 * MiB, "HID and U inside the U region");
static_assert(WS_END <= (size_t)704 * MiB, "d_ws map fits 4 x the largest input");

constexpr int RING_OFF = 0, RING_BYTES = 131072;
constexpr int LDSCTL_OFF = RING_BYTES, MISC_OFF = LDSCTL_OFF + 320;
constexpr int LDS_BYTES = 147456;
constexpr int CW_BAR = 4096;

#define GAS __attribute__((address_space(1)))
#define LAS __attribute__((address_space(3)))
typedef unsigned short bf16;
typedef unsigned v4u __attribute__((ext_vector_type(4)));
typedef unsigned v2u __attribute__((ext_vector_type(2)));
typedef float f32x4 __attribute__((ext_vector_type(4)));
typedef short bf16x8 __attribute__((ext_vector_type(8)));
#define LDS_WAIT() asm volatile("s_waitcnt lgkmcnt(0)" ::: "memory")
#define VM_WAIT() asm volatile("s_waitcnt vmcnt(0)" ::: "memory")
__device__ __forceinline__ unsigned f2bf(float f) { unsigned u = __builtin_bit_cast(unsigned, f); return (u + 0x7fffu + ((u >> 16) & 1u)) >> 16; }
__device__ __forceinline__ unsigned pk2(float lo, float hi) { return f2bf(lo) | (f2bf(hi) << 16); }
__device__ __forceinline__ float siluf(float v) { return v / (1.0f + __expf(-v)); }
__device__ __forceinline__ float softplusf(float v) { return fmaxf(v, 0.f) + __logf(1.0f + __expf(-fabsf(v))); }
__device__ __forceinline__ float sigmoidf(float v) { return 1.0f / (1.0f + __expf(-v)); }
__device__ __forceinline__ f32x4 ld4(const float* p) { return *(const f32x4*)p; }
__device__ __forceinline__ f32x4 silu4(f32x4 v) { return (f32x4){siluf(v.x), siluf(v.y), siluf(v.z), siluf(v.w)}; }
template <int CTRL> __device__ __forceinline__ float dppf(float v) { return __builtin_bit_cast(float, __builtin_amdgcn_update_dpp(0, __builtin_bit_cast(int, v), CTRL, 0xF, 0xF, true)); }
__device__ __forceinline__ float row16_sum(float v) { v += dppf<0xB1>(v); v += dppf<0x4E>(v); v += dppf<0x141>(v); v += dppf<0x140>(v); return v; }
__device__ __forceinline__ int opq(int v) { asm volatile("" : "+v"(v)); return v; }
__device__ __forceinline__ float shx(float v, int m, int lane) { return __builtin_bit_cast(float, __builtin_amdgcn_ds_bpermute((lane ^ m) << 2, __builtin_bit_cast(int, v))); }
__device__ __forceinline__ float wave_sum(float v) {
    v = row16_sum(v);
    const int iv = __builtin_bit_cast(int, v);
    return (__builtin_bit_cast(float, __builtin_amdgcn_readlane(iv, 0)) + __builtin_bit_cast(float, __builtin_amdgcn_readlane(iv, 16))) + (__builtin_bit_cast(float, __builtin_amdgcn_readlane(iv, 32)) + __builtin_bit_cast(float, __builtin_amdgcn_readlane(iv, 48)));
}

#define XB_TMO      128
#define XB_XCNT(j)  (256  + 64 * (j))
#define XB_XSUB(j)  (1280 + 64 * (j))
#define XB_XGEN(j)  (2304 + 64 * (j))
#define XB_TOP      3328
#define XB_TOPGEN   3392
#define XCD_BAR_WORDS 3456
#define XB_SPIN_CAP (1u << 18)

__device__ __forceinline__ unsigned xb_ld(unsigned* p)              { return __hip_atomic_load(p, __ATOMIC_RELAXED, __HIP_MEMORY_SCOPE_AGENT); }
__device__ __forceinline__ unsigned xb_add(unsigned* p, unsigned v) { return __hip_atomic_fetch_add(p, v, __ATOMIC_RELAXED, __HIP_MEMORY_SCOPE_AGENT); }
__device__ __forceinline__ unsigned xb_xcc_id() { return (unsigned)__builtin_amdgcn_s_getreg((3 << 11) | 20) & 0xFu; }
#define XB_SPIN(cond, bar) do { unsigned _sp = 0; while (cond) { __builtin_amdgcn_s_sleep(1); \
    if ((++_sp & 255u) == 0u) { if (xb_ld(&(bar)[XB_TMO])) break; if (_sp > XB_SPIN_CAP) { atomicAdd(&(bar)[XB_TMO], 1u); break; } } } } while (0)

struct XcdBarrier {
    unsigned* bar; unsigned x;
    volatile LAS unsigned* st;
};

__device__ __forceinline__ XcdBarrier xcd_barrier_post(unsigned* bar, volatile LAS unsigned* st) {
    XcdBarrier b; b.bar = bar; b.x = xb_xcc_id(); b.st = st;
    if (threadIdx.x == 0) (void)xb_add(&bar[XB_XCNT(b.x)], 1u);
    return b;
}
__device__ __forceinline__ void xcd_barrier_complete(unsigned* bar, unsigned x, unsigned& nloc, unsigned& nx) {
    const unsigned G = gridDim.x * gridDim.y * gridDim.z;
    unsigned sum, cnt, mine, sp = 0u;
    for (;;) {
        sum = 0u; cnt = 0u; mine = 0u;
#pragma unroll
        for (unsigned j = 0; j < 16; ++j) { const unsigned c = xb_ld(&bar[XB_XCNT(j)]); sum += c; cnt += (c > 0u) ? 1u : 0u; mine = (j == x) ? c : mine; }
        if (sum == G) break;
        __builtin_amdgcn_s_sleep(1);
        if ((++sp & 255u) == 0u) { if (xb_ld(&bar[XB_TMO])) break; if (sp > XB_SPIN_CAP) { atomicAdd(&bar[XB_TMO], 1u); break; } }
    }
    nloc = mine > 0u ? mine : 1u; nx = cnt > 0u ? cnt : 1u;
}

__device__ __forceinline__ void xcd_barrier(const XcdBarrier& b) {
    asm volatile("s_waitcnt vmcnt(0)" ::: "memory");
    __syncthreads();
    if (threadIdx.x == 0) {
        unsigned* bar = b.bar;
        __builtin_amdgcn_s_waitcnt(0);
        unsigned nloc = b.st[0], nx = b.st[1];
        if (nloc == 0u) { xcd_barrier_complete(bar, b.x, nloc, nx); b.st[0] = nloc; b.st[1] = nx; }
        const unsigned old = xb_add(&bar[XB_XSUB(b.x)], 1u);
        const unsigned gen = old / nloc;
        if (old + 1u == (gen + 1u) * nloc) {
            __builtin_amdgcn_fence(__ATOMIC_RELEASE, "agent");
            asm volatile("s_waitcnt vmcnt(0)" ::: "memory");
            const unsigned og = xb_add(&bar[XB_TOP], 1u);
            const unsigned tg = og / nx;
            if (og + 1u == (tg + 1u) * nx) xb_add(&bar[XB_TOPGEN], 1u);
            else XB_SPIN(xb_ld(&bar[XB_TOPGEN]) == tg, bar);
            __builtin_amdgcn_fence(__ATOMIC_ACQUIRE, "agent");
            xb_add(&bar[XB_XGEN(b.x)], 1u);
            asm volatile("s_waitcnt vmcnt(0)" ::: "memory");
        } else {
            XB_SPIN(xb_ld(&bar[XB_XGEN(b.x)]) == gen, bar);
            __builtin_amdgcn_fence(__ATOMIC_ACQUIRE, "agent");
            asm volatile("s_waitcnt vmcnt(0)" ::: "memory");
        }
    }
    __syncthreads();
}
struct Frame {
    LAS unsigned char* lds;
    volatile LAS unsigned* MISC;
    unsigned* ctl;
    int tid, lane, wave;
    int vcu, G;
    float* out; unsigned char* ws;
};
__device__ __forceinline__ const float* inp(int i) { const float* __attribute__((address_space(4))) const* tab = (const float* __attribute__((address_space(4))) const*)__builtin_amdgcn_kernarg_segment_ptr(); asm volatile("" : "+s"(tab)); return tab[i]; }
__device__ __forceinline__ bf16* wsb(const Frame& F, size_t off) { return (bf16*)(F.ws + off); }
__device__ __forceinline__ float* wsf(const Frame& F, size_t off) { return (float*)(F.ws + off); }

__device__ __forceinline__ void p0_transpose_item(const float* W, int K, int N, bf16* WT, int drow0, int k0, int n0, LAS float* scr, int lane, const float* gk = nullptr  ) {
    const int nn = n0 + (lane & 31); const bool ok = nn < N;
    float wv_[32];
#pragma unroll
    for (int i = 0; i < 32; ++i) { const int kk = 2 * i + (lane >> 5); wv_[i] = ok ? W[(size_t)(k0 + kk) * N + nn] : 0.f; }
#pragma unroll
    for (int i = 0; i < 32; ++i) { const int kk = 2 * i + (lane >> 5); scr[kk * 33 + (lane & 31)] = gk ? wv_[i] * gk[k0 + kk] : wv_[i]; }
    LDS_WAIT(); asm volatile("" ::: "memory");
    const int c = lane & 7;
#pragma unroll
    for (int j = 0; j < 4; ++j) { const int n = (lane >> 3) + 8 * j; const LAS float* s = scr + (8 * c) * 33 + n;
        v4u o; o.x = pk2(s[0 * 33], s[1 * 33]); o.y = pk2(s[2 * 33], s[3 * 33]); o.z = pk2(s[4 * 33], s[5 * 33]); o.w = pk2(s[6 * 33], s[7 * 33]);
        *(v4u*)(WT + (size_t)(drow0 + n) * K + k0 + 8 * c) = o; }
    LDS_WAIT(); asm volatile("" ::: "memory");
}
__device__ __forceinline__ void norm_row_to_bf16(const float* xrow, const float* g, bf16* orow, int lane) {
    const f32x4* xr = (const f32x4*)xrow + lane; const f32x4* gr = (const f32x4*)g + lane;
    f32x4 v[8]; float s = 0.f;
#pragma unroll
    for (int j = 0; j < 8; ++j) { v[j] = xr[64 * j]; s += (v[j].x * v[j].x + v[j].y * v[j].y) + (v[j].z * v[j].z + v[j].w * v[j].w); }
    const float rstd = 1.0f / sqrtf(wave_sum(s) * (1.0f / DM) + EPS);
    v2u* o8 = (v2u*)orow + lane;
#pragma unroll
    for (int j = 0; j < 8; ++j) { const f32x4 gg = gr[64 * j]; v2u w; w.x = pk2(v[j].x * rstd * gg.x, v[j].y * rstd * gg.y); w.y = pk2(v[j].z * rstd * gg.z, v[j].w * rstd * gg.w); o8[64 * j] = w; }
}
__device__ __forceinline__ void p0_prologue(Frame& F, int part) {
    LAS float* scr = (LAS float*)(F.lds + RING_OFF + F.wave * 16384);
    const int vb = part ? 64 : 0;
    if (F.vcu < vb) return;
    const int gw = (F.vcu - vb) * NWAVES + F.wave, NGW = (F.G - vb) * NWAVES; const int lane = opq(F.lane), tid = opq(F.tid);
    const int gt = (F.vcu - vb) * NWAVES * 64 + tid, NGT = NGW * 64;
    constexpr int NB_IN = (IN_COLS + 31) / 32;
    constexpr int I_IN = (DM / 64) * NB_IN, I_SQ = (DM / 64) * (DM / 32), I_KV = (DM / 64) * (2 * DM / 32), I_GU = (DM / 64) * (2 * DFF / 32), I_D = (DFF / 64) * (DM / 32);
    constexpr int I_LAYER = I_IN + 2 * I_SQ + I_KV + I_GU + I_D;
    for (int it = gw; it < I_LAYER; it += NGW) {
        const int l = part; int r = it;
        bf16* wl = wsb(F, WS_W + (size_t)l * W_LAYER);
        if (r < I_IN) { const int kb = r / NB_IN, nb = r % NB_IN; p0_transpose_item(inp(I_WIN) + (size_t)l * DM * IN_COLS, DM, IN_COLS, (bf16*)((char*)wl + WO_WIN), 32 * nb, 64 * kb, 32 * nb, scr, lane, inp(I_NORMG) + (size_t)(l * N_NORMS + MIX_PRE) * DM); continue; } r -= I_IN;
        if (r < I_SQ) { const int kb = r / (DM / 32), nb = r % (DM / 32); p0_transpose_item(inp(I_WOUT) + (size_t)l * DM * DM, DM, DM, (bf16*)((char*)wl + WO_WOUT), 32 * nb, 64 * kb, 32 * nb, scr, lane); continue; } r -= I_SQ;
        if (r < I_SQ) { const int kb = r / (DM / 32), nb = r % (DM / 32); p0_transpose_item(inp(I_WO) + (size_t)l * DM * DM, DM, DM, (bf16*)((char*)wl + WO_WO), 32 * nb, 64 * kb, 32 * nb, scr, lane); continue; } r -= I_SQ;
        if (r < I_KV) { const int kb = r / (2 * DM / 32), nb = r % (2 * DM / 32); p0_transpose_item(inp(I_WKV) + (size_t)l * DM * 2 * DM, DM, 2 * DM, (bf16*)((char*)wl + WO_WKV), 32 * nb, 64 * kb, 32 * nb, scr, lane); continue; } r -= I_KV;
        if (r < I_GU) { const int kb = r / (2 * DFF / 32), nb = r % (2 * DFF / 32); const int n0 = 32 * nb; const int up = n0 >= DFF ? 1 : 0, j0 = n0 - up * DFF;
            const int drow = (j0 >> 7) * 256 + up * 128 + (j0 & 127);
            p0_transpose_item(inp(I_WGU) + (size_t)l * DM * 2 * DFF, DM, 2 * DFF, (bf16*)((char*)wl + WO_WGU), drow, 64 * kb, n0, scr, lane, inp(I_NORMG) + (size_t)(l * N_NORMS + FFN_PRE) * DM); continue; } r -= I_GU;
        { const int kb = r / (DM / 32), nb = r % (DM / 32); p0_transpose_item(inp(I_WD) + (size_t)l * DFF * DM, DFF, DM, (bf16*)((char*)wl + WO_WD), 32 * nb, 64 * kb, 32 * nb, scr, lane); }
    }
    for (int i = gt; i < DM * DM / 8; i += NGT) { const int l = part, k = i;
        const float* src = inp(I_WQ) + (size_t)l * DM * DM + (size_t)k * 8; const float gq = inp(I_NORMG)[(size_t)(l * N_NORMS + XA_PRE) * DM + (k >> 8)]; const f32x4 a = ld4(src) * gq, b = ld4(src + 4) * gq;
        v4u o; o.x = pk2(a.x, a.y); o.y = pk2(a.z, a.w); o.z = pk2(b.x, b.y); o.w = pk2(b.z, b.w);
        ((v4u*)(F.ws + WS_W + (size_t)l * W_LAYER + WO_WQ))[k] = o; }
    { constexpr int ZR0 = 32 * NB_IN, ZN = (IN_PAD - ZR0) * DM / 8;
      const unsigned z0 = (unsigned)opq(0); const v4u zz = {z0, z0, z0, z0};
      for (int i = gt; i < ZN; i += NGT) { const int l = part, k = i;
          ((v4u*)(F.ws + WS_W + (size_t)l * W_LAYER + WO_WIN + (size_t)ZR0 * DM * 2))[k] = zz; } }
    if (part) return;
    for (int m = gw; m < DEPTH * MROWS; m += NGW) { const int l = m / MROWS, r = m % MROWS;
        norm_row_to_bf16(inp(I_MEM) + (size_t)r * DM, inp(I_NORMG) + (size_t)(l * N_NORMS + MEM_NORM) * DM, wsb(F, WS_MEMN) + (size_t)m * DM, lane); }
    for (int m = gw; m < M; m += NGW) { const f32x4* xr = (const f32x4*)(inp(I_X) + (size_t)m * DM) + 2 * lane; v4u* xb = (v4u*)(wsb(F, WS_XN) + (size_t)m * DM) + lane; float ss = 0.f;
#pragma unroll
        for (int j = 0; j < 4; ++j) { const f32x4 a = xr[128 * j], b = xr[128 * j + 1]; ss += ((a.x * a.x + a.y * a.y) + (a.z * a.z + a.w * a.w)) + ((b.x * b.x + b.y * b.y) + (b.z * b.z + b.w * b.w));
            v4u o; o.x = pk2(a.x, a.y); o.y = pk2(a.z, a.w); o.z = pk2(b.x, b.y); o.w = pk2(b.z, b.w); xb[64 * j] = o; }
        ss = wave_sum(ss); if (lane == 0) wsf(F, WS_RS)[m] = 1.0f / sqrtf(ss * (1.0f / DM) + EPS); }
}

struct f32x8 { f32x4 lo, hi; };
__device__ __forceinline__ f32x8 ldu8(const bf16* p) { const v4u w = *(const v4u*)p; f32x8 r;
    r.lo = (f32x4){__builtin_bit_cast(float, w.x << 16), __builtin_bit_cast(float, w.x & 0xffff0000u), __builtin_bit_cast(float, w.y << 16), __builtin_bit_cast(float, w.y & 0xffff0000u)};
    r.hi = (f32x4){__builtin_bit_cast(float, w.z << 16), __builtin_bit_cast(float, w.z & 0xffff0000u), __builtin_bit_cast(float, w.w << 16), __builtin_bit_cast(float, w.w & 0xffff0000u)}; return r; }
__device__ __forceinline__ f32x8 cvt8(const v4u w) { f32x8 r;
    r.lo = (f32x4){__builtin_bit_cast(float, w.x << 16), __builtin_bit_cast(float, w.x & 0xffff0000u), __builtin_bit_cast(float, w.y << 16), __builtin_bit_cast(float, w.y & 0xffff0000u)};
    r.hi = (f32x4){__builtin_bit_cast(float, w.z << 16), __builtin_bit_cast(float, w.z & 0xffff0000u), __builtin_bit_cast(float, w.w << 16), __builtin_bit_cast(float, w.w & 0xffff0000u)}; return r; }
__device__ __forceinline__ f32x8 ld8f(const float* p) { f32x8 r; r.lo = ld4(p); r.hi = ld4(p + 4); return r; }
__device__ __forceinline__ f32x8 operator*(const f32x8& a, const f32x8& b) { return f32x8{a.lo * b.lo, a.hi * b.hi}; }
__device__ __forceinline__ f32x8 operator+(const f32x8& a, const f32x8& b) { return f32x8{a.lo + b.lo, a.hi + b.hi}; }
__device__ __forceinline__ f32x8 silu8(const f32x8& a) { return f32x8{silu4(a.lo), silu4(a.hi)}; }
__device__ __forceinline__ float sumsq8(const f32x8& y) { return ((y.lo.x * y.lo.x + y.lo.y * y.lo.y) + (y.lo.z * y.lo.z + y.lo.w * y.lo.w)) + ((y.hi.x * y.hi.x + y.hi.y * y.hi.y) + (y.hi.z * y.hi.z + y.hi.w * y.hi.w)); }
__device__ __forceinline__ v4u pack8u(const f32x8& y) { v4u o; o.x = pk2(y.lo.x, y.lo.y); o.y = pk2(y.lo.z, y.lo.w); o.z = pk2(y.hi.x, y.hi.y); o.w = pk2(y.hi.z, y.hi.w); return o; }
__device__ __forceinline__ void mixer_prep_phase(Frame& F, int l) {
    const int gw = F.vcu * NWAVES + F.wave, NGW = F.G * NWAVES, lane = opq(F.lane), tid = opq(F.tid);
    const bf16* U = wsb(F, WS_U);
    bf16* MIX = wsb(F, WS_MIX);
    constexpr int NSTRIP = M / 16, NTYPE = 12;
    for (int it = gw; it < NTYPE * NSTRIP; it += NGW) {
        const int type = it % NTYPE, strip = it / NTYPE, r0 = strip * 16, pos0 = r0 & (SEQ - 1), c = lane * 8;
        const bf16* ur0 = U + (size_t)r0 * IN_PAD;
        if (type == 0) {
            const float* cw = inp(I_CONVA) + (size_t)l * 3 * GW + c;
            const f32x8 w0 = ld8f(cw), w1 = ld8f(cw + GW), w2 = ld8f(cw + 2 * GW);
            const v4u z4 = {0u, 0u, 0u, 0u};
#pragma unroll 1
            for (int hf = 0; hf < 2; ++hf) {
                const bf16* ub = ur0 + (size_t)(8 * hf) * IN_PAD;
                v4u rc[10], rh[10], rb[8];
#pragma unroll
                for (int i = 0; i < 10; ++i) { const int ri = i - 2; if (ri >= 0 || pos0 > 0 || hf > 0) { rc[i] = *(const v4u*)(ub + (ptrdiff_t)ri * IN_PAD + UA_C + c); rh[i] = *(const v4u*)(ub + (ptrdiff_t)ri * IN_PAD + UA_H + c); } else { rc[i] = z4; rh[i] = z4; } }
#pragma unroll
                for (int i = 0; i < 8; ++i) rb[i] = *(const v4u*)(ub + (size_t)i * IN_PAD + UA_B + c);
                f32x8 p2 = cvt8(rc[0]) * cvt8(rh[0]), p1 = cvt8(rc[1]) * cvt8(rh[1]);
#pragma unroll
                for (int i = 0; i < 8; ++i) { const f32x8 p0 = cvt8(rc[i + 2]) * cvt8(rh[i + 2]); const f32x8 y = cvt8(rb[i]) * (w0 * p2 + w1 * p1 + w2 * p0);
                    *(v4u*)(MIX + (size_t)(r0 + 8 * hf + i) * DM + c) = pack8u(y); p2 = p1; p1 = p0; }
            }
        } else if (type < 4) {
            const int gi = type - 1, cc = gi * GW + c;
            const float* cw = inp(I_GCONV) + (size_t)l * 4 * 3 * GW + cc;
            const f32x8 w0 = ld8f(cw), w1 = ld8f(cw + 3 * GW), w2 = ld8f(cw + 6 * GW), w3 = ld8f(cw + 9 * GW);
            v4u xr[19];
#pragma unroll
            for (int i = 0; i < 19; ++i) { const int ri = i - 3; if (ri >= 0 || pos0 > 0) xr[i] = *(const v4u*)(ur0 + (ptrdiff_t)ri * IN_PAD + UC_Q + cc); else xr[i] = (v4u){0u, 0u, 0u, 0u}; }
            float* dst = (gi == 0) ? wsf(F, WS_QN) : (gi == 1) ? wsf(F, WS_KN) : wsf(F, WS_VV);
            const float qs = (gi == 0) ? 0.08838834764831845f : 1.0f;
            f32x8 x3 = cvt8(xr[0]), x2 = cvt8(xr[1]), x1 = cvt8(xr[2]);
#pragma unroll
            for (int i = 0; i < 16; ++i) { const f32x8 x0 = cvt8(xr[i + 3]); f32x8 y = silu8(w0 * x3 + w1 * x2 + w2 * x1 + w3 * x0); x3 = x2; x2 = x1; x1 = x0;
                if (gi < 2) { float ss = row16_sum(sumsq8(y));
                    const float sc = qs / sqrtf(ss + EPS); y.lo = y.lo * sc; y.hi = y.hi * sc; }
                float* d = dst + (size_t)(r0 + i) * GW + c; *(f32x4*)d = y.lo; *(f32x4*)(d + 4) = y.hi; }
        } else if (type < 6) {
            const int gi = type - 4, cc = gi * GW + c;
            const float* cw = inp(I_SCONVW) + (size_t)l * 4 * 1024 + cc;
            const f32x8 w0 = ld8f(cw), w1 = ld8f(cw + 1024), w2 = ld8f(cw + 2048), w3 = ld8f(cw + 3072), bb = ld8f(inp(I_SCONVB) + (size_t)l * 1024 + cc);
            v4u xr[19];
#pragma unroll
            for (int i = 0; i < 19; ++i) { const int ri = i - 3; if (ri >= 0 || pos0 > 0) xr[i] = *(const v4u*)(ur0 + (ptrdiff_t)ri * IN_PAD + UD_X + cc); else xr[i] = (v4u){0u, 0u, 0u, 0u}; }
            f32x8 x3 = cvt8(xr[0]), x2 = cvt8(xr[1]), x1 = cvt8(xr[2]);
            float* dst; int ld, co;
            if (gi == 0) { dst = wsf(F, WS_XS); ld = 512; co = c; } else if (c < 256) { dst = wsf(F, WS_BS); ld = 256; co = c; } else { dst = wsf(F, WS_CS); ld = 256; co = c - 256; }
#pragma unroll
            for (int i = 0; i < 16; ++i) { const f32x8 x0 = cvt8(xr[i + 3]); const f32x8 y = silu8(w0 * x3 + w1 * x2 + w2 * x1 + w3 * x0 + bb); x3 = x2; x2 = x1; x1 = x0;
                float* d = dst + (size_t)(r0 + i) * ld + co; *(f32x4*)d = y.lo; *(f32x4*)(d + 4) = y.hi; }
        } else if (type < 8) {
            const int zo = (type == 6) ? UC_Z : UD_Z; bf16* dst = wsb(F, (type == 6) ? WS_ZG : WS_ZS);
            v4u z[16];
#pragma unroll
            for (int i = 0; i < 16; ++i) z[i] = *(const v4u*)(ur0 + (size_t)i * IN_PAD + zo + c);
#pragma unroll
            for (int i = 0; i < 16; ++i) *(v4u*)(dst + (size_t)(r0 + i) * GW + c) = z[i];
        } else {
            const int gi = type - 8, w = 2 << gi;
            LAS float* scr = (LAS float*)(F.lds + RING_OFF + F.wave * 16384);
            const int c0 = UB + gi * 128 + lane * 2;
            float uv0[31], uv1[31];
#pragma unroll
            for (int i = 0; i < 31; ++i) { const int ri = i - 15; float a0 = 0.f, a1 = 0.f;
                if (ri >= 0 || pos0 > 0) { const unsigned wd = *(const unsigned*)(ur0 + (ptrdiff_t)ri * IN_PAD + c0); a0 = __builtin_bit_cast(float, wd << 16); a1 = __builtin_bit_cast(float, wd & 0xffff0000u); }
                uv0[i] = a0; uv1[i] = a1; }
            float r0s = 0.f, r1s = 0.f;
#pragma unroll
            for (int s = 1; s < 16; ++s) if (s < w) { r0s += uv0[15 - s]; r1s += uv1[15 - s]; }
#pragma unroll
            for (int i = 0; i < 16; ++i) { const int pos = pos0 + i; const float a0 = uv0[15 + i], a1 = uv1[15 + i];
                r0s += a0; r1s += a1;
                const float cnt = (float)((pos + 1 < w) ? pos + 1 : w);
                scr[i * 128 + lane * 2] = r0s / cnt - a0; scr[i * 128 + lane * 2 + 1] = r1s / cnt - a1;
                float d0 = 0.f, d1 = 0.f;
#pragma unroll
                for (int g2 = 0; g2 < 4; ++g2) if (gi == g2) { d0 = uv0[15 + i - (2 << g2) + 1]; d1 = uv1[15 + i - (2 << g2) + 1]; }
                r0s -= d0; r1s -= d1; }
            LDS_WAIT(); asm volatile("" ::: "memory");
            float acc0[16], acc1[16];
#pragma unroll
            for (int i = 0; i < 16; ++i) { acc0[i] = 0.f; acc1[i] = 0.f; }
            const float* pw = inp(I_POOLW) + ((size_t)l * 4 + gi) * 128 * 128;
            for (int cc = 0; cc < 128; cc += 4) {
                float wa[4], wb[4];
#pragma unroll
                for (int q = 0; q < 4; ++q) { wa[q] = pw[(size_t)(cc + q) * 128 + lane]; wb[q] = pw[(size_t)(cc + q) * 128 + 64 + lane]; }
#pragma unroll
                for (int i = 0; i < 16; ++i) { const f32x4 p = *(const LAS f32x4*)(scr + i * 128 + cc);
                    acc0[i] += p.x * wa[0] + p.y * wa[1] + p.z * wa[2] + p.w * wa[3]; acc1[i] += p.x * wb[0] + p.y * wb[1] + p.z * wb[2] + p.w * wb[3]; }
            }
            const float s0 = inp(I_POOLS)[(size_t)l * GW + gi * 128 + lane], s1 = inp(I_POOLS)[(size_t)l * GW + gi * 128 + 64 + lane];
#pragma unroll
            for (int i = 0; i < 16; ++i) { bf16* o = MIX + (size_t)(r0 + i) * DM + GW + gi * 128; o[lane] = (bf16)f2bf(acc0[i] * s0); o[64 + lane] = (bf16)f2bf(acc1[i] * s1); }
            LDS_WAIT(); asm volatile("" ::: "memory");
        }
    }
    for (int i = (F.vcu * NWAVES * 64) + tid; i < M * 16; i += F.G * NWAVES * 64) { const int t = i >> 4, j = i & 15; const bf16* ur = U + (size_t)t * IN_PAD;
#define UF(col) __builtin_bit_cast(float, (unsigned)ur[col] << 16)
        if (j < 4) { wsf(F, WS_GB)[(size_t)t * 8 + 2 * j] = -__expf(inp(I_GALOG)[l * 4 + j]) * softplusf(UF(UC_A + j) + inp(I_GDTB)[l * 4 + j]); }
        else if (j < 8) { wsf(F, WS_GB)[(size_t)t * 8 + 2 * (j - 4) + 1] = sigmoidf(UF(UC_B + (j - 4))); }
        else { const int hh = j - 8; const float dt = softplusf(UF(UD_DT + hh) + inp(I_SDTB)[l * 8 + hh]);
            wsf(F, WS_DT)[(size_t)t * 16 + 2 * hh] = -__expf(inp(I_SALOG)[l * 8 + hh]) * dt; wsf(F, WS_DT)[(size_t)t * 16 + 2 * hh + 1] = dt; }
#undef UF
    }
}

typedef float f32x16 __attribute__((ext_vector_type(16)));
typedef float f32x2v __attribute__((ext_vector_type(2)));
typedef __bf16 bf16x2_t __attribute__((ext_vector_type(2)));
__device__ __forceinline__ unsigned cvtpk(float lo, float hi) { const f32x2v v = {lo, hi}; return __builtin_bit_cast(unsigned, __builtin_convertvector(v, bf16x2_t)); }
__device__ __forceinline__ bf16x8 pack8(float a0, float a1, float a2, float a3, float a4, float a5, float a6, float a7) { v4u w; w.x = cvtpk(a0, a1); w.y = cvtpk(a2, a3); w.z = cvtpk(a4, a5); w.w = cvtpk(a6, a7); return __builtin_bit_cast(bf16x8, w); }
#define PACK_STEP(x, s) pack8((x)[8 * (s)], (x)[8 * (s) + 1], (x)[8 * (s) + 2], (x)[8 * (s) + 3], (x)[8 * (s) + 4], (x)[8 * (s) + 5], (x)[8 * (s) + 6], (x)[8 * (s) + 7])
#define MFMA32(a, b, c) __builtin_amdgcn_mfma_f32_32x32x16_bf16((a), (b), (c), 0, 0, 0)
__device__ __forceinline__ int crow(int reg, int h) { return (reg & 3) + 8 * (reg >> 2) + 4 * h; }
constexpr int LA_KB = 0;
constexpr int LA_QB = LA_KB + 64 * 136 * 2;
constexpr int LA_KGT = LA_QB + 64 * 136 * 2;
constexpr int LA_VBT = LA_KGT + 128 * 72 * 2;
constexpr int LA_KET = LA_VBT + 128 * 72 * 2;
constexpr int LA_M = LA_KET + 128 * 72 * 2;
constexpr int LA_TB = LA_M + 64 * 68 * 4;
constexpr int LA_VEC = LA_TB + 64 * 72 * 2;
static_assert(LA_VEC + 1024 <= RING_BYTES, "la LDS map");
__device__ __forceinline__ bf16x8 lds_frag(const LAS unsigned char* base, int row, int stride_el, int col) { return *(const LAS bf16x8*)(base + ((size_t)row * stride_el + col) * 2); }
__device__ __forceinline__ float wave_incl_scan(float v, int lane) {
#pragma unroll
    for (int d = 1; d < 64; d <<= 1) { const float o = __builtin_bit_cast(float, __builtin_amdgcn_ds_bpermute((lane - d) << 2, __builtin_bit_cast(int, v))); if (lane >= d) v += o; }
    return v;
}
__device__ __forceinline__ void store_qk_frag(const f32x16& acc, const LAS float* Gv, int mt, int rt, int r, int h, int lane, bf16* qkf) {
    const int l = 32 * rt + r; const float Gl = Gv[l];
    float v[16];
#pragma unroll
    for (int q = 0; q < 16; ++q) { const int m = 32 * mt + crow(q, h); v[q] = (m <= l) ? acc[q] * __expf(Gl - Gv[m]) : 0.f; }
    *(bf16x8*)(qkf + ((size_t)(rt * 4 + 2 * mt + 0) * 64 + lane) * 8) = pack8(v[0], v[1], v[2], v[3], v[4], v[5], v[6], v[7]);
    *(bf16x8*)(qkf + ((size_t)(rt * 4 + 2 * mt + 1) * 64 + lane) * 8) = pack8(v[8], v[9], v[10], v[11], v[12], v[13], v[14], v[15]);
}
__device__ __forceinline__ void qd_frag_task(const float* qrows, int ldq, const LAS float* Gv, int task, int r, int h, int lane, bf16* qdf) {
    const int rt = task >> 3, ks = task & 7, l = 32 * rt + r, k0 = 16 * ks + 4 * h; const float e = __expf(Gv[l]);
    const f32x4 a = ld4(qrows + (size_t)l * ldq + k0), b = ld4(qrows + (size_t)l * ldq + k0 + 8);
    *(bf16x8*)(qdf + ((size_t)task * 64 + lane) * 8) = pack8(a.x * e, a.y * e, a.z * e, a.w * e, b.x * e, b.y * e, b.z * e, b.w * e);
}
__device__ __forceinline__ void qd_frag_task4(const float* qrows, int ldq, const LAS float* Gv, int task0, int r, int h, int lane, bf16* qdf) {
    f32x4 a[4], b[4]; float e[4];
#pragma unroll
    for (int t = 0; t < 4; ++t) { const int task = task0 + t, rt = task >> 3, ks = task & 7, l = 32 * rt + r, k0 = 16 * ks + 4 * h;
        a[t] = ld4(qrows + (size_t)l * ldq + k0); b[t] = ld4(qrows + (size_t)l * ldq + k0 + 8); e[t] = __expf(Gv[l]); }
#pragma unroll
    for (int t = 0; t < 4; ++t) *(bf16x8*)(qdf + ((size_t)(task0 + t) * 64 + lane) * 8) = pack8(a[t].x * e[t], a[t].y * e[t], a[t].z * e[t], a[t].w * e[t], b[t].x * e[t], b[t].y * e[t], b[t].z * e[t], b[t].w * e[t]);
}
__device__ __forceinline__ void ke_frag_task(const LAS unsigned char* ket, int task, int r, int h, int lane, bf16* kef) {
    const int it = task >> 2, ks = task & 3, dk = 32 * it + r, l0 = 16 * ks + 4 * h;
    const v2u lo = *(const LAS v2u*)(ket + ((size_t)dk * 72 + l0) * 2), hi = *(const LAS v2u*)(ket + ((size_t)dk * 72 + l0 + 8) * 2);
    v4u w; w.x = lo.x; w.y = lo.y; w.z = hi.x; w.w = hi.y;
    *(v4u*)(kef + ((size_t)task * 64 + lane) * 8) = w;
}

#ifndef LAREP
#define LAREP 0
#endif
#define LDS_SYNC() do { asm volatile("s_waitcnt lgkmcnt(0)" ::: "memory"); __builtin_amdgcn_s_barrier(); asm volatile("" ::: "memory"); } while (0)
__device__ __forceinline__ void la_prep_phase(Frame& F, int l_unused) {
    const int tid0 = opq(F.tid), wv = F.wave;
    LAS unsigned char* L = F.lds + RING_OFF; asm volatile("" : "+v"(L));
    LAS float* Gv = (LAS float*)(L + LA_VEC); LAS float* Bv = Gv + 64;
    LAS float* Mf = (LAS float*)(L + LA_M);
    const f32x16 zero16 = {0.f, 0.f, 0.f, 0.f, 0.f, 0.f, 0.f, 0.f, 0.f, 0.f, 0.f, 0.f, 0.f, 0.f, 0.f, 0.f};
    for (int item = F.vcu; item < 512; item += F.G) {
        const int tid = opq(tid0), lane = tid & 63, r = lane & 31, h = lane >> 5;
        const int seq = item >> 5, ch = item & 31, b = seq >> 2, hd = seq & 3;
        const size_t t0 = (size_t)b * SEQ + ch * 64;
        const float* KN = wsf(F, WS_KN) + t0 * GW + hd * 128; const float* QN = wsf(F, WS_QN) + t0 * GW + hd * 128; const float* VV = wsf(F, WS_VV) + t0 * GW + hd * 128;
        unsigned char* rec = F.ws + WS_FG + (size_t)item * LA_RECG;
        const int c = tid & 127, lg = tid >> 7;
        const f32x2v gb = *(const f32x2v*)(wsf(F, WS_GB) + (t0 + lane) * 8 + 2 * hd);
        float kr[16], qr[16], vr[16];
#pragma unroll
        for (int i = 0; i < 16; ++i) { const int l = lg * 16 + i; kr[i] = KN[(size_t)l * GW + c]; qr[i] = QN[(size_t)l * GW + c]; vr[i] = VV[(size_t)l * GW + c]; }
        f32x4 qa[4], qb[4];
        { const int qw = (wv >= 2 && wv <= 5) ? wv - 2 : 0;
#pragma unroll
            for (int t = 0; t < 4; ++t) { const int task = 4 * qw + t, rt = task >> 3, ks = task & 7, l = 32 * rt + r, k0 = 16 * ks + 4 * h; qa[t] = ld4(QN + (size_t)l * GW + k0); qb[t] = ld4(QN + (size_t)l * GW + k0 + 8); } }
        if (wv == 0) { Gv[lane] = wave_incl_scan(gb.x, lane); Bv[lane] = gb.y; }
        LDS_SYNC();
        const float G63 = Gv[63];
#pragma unroll
        for (int i = 0; i < 16; ++i) { const int l = lg * 16 + i; const float kv = kr[i], qv = qr[i], vv = vr[i];
            const float Gl = Gv[l], bl = Bv[l];
            ((LAS bf16*)(L + LA_KB))[l * 136 + c] = (bf16)f2bf(kv); ((LAS bf16*)(L + LA_QB))[l * 136 + c] = (bf16)f2bf(qv);
            ((LAS bf16*)(L + LA_KGT))[c * 72 + l] = (bf16)f2bf(-kv * bl * __expf(Gl)); ((LAS bf16*)(L + LA_VBT))[c * 72 + l] = (bf16)f2bf(vv * bl);
            ((LAS bf16*)(L + LA_KET))[c * 72 + l] = (bf16)f2bf(kv * __expf(G63 - Gl)); }
        LDS_SYNC();
        if (wv < 4) { const int it = wv >> 1, jt = wv & 1; f32x16 acc = zero16;
            if (!(it == 0 && jt == 1)) {
#pragma unroll
                for (int ks = 0; ks < 8; ++ks) acc = MFMA32(lds_frag(L + LA_KB, 32 * it + r, 136, 16 * ks + 8 * h), lds_frag(L + LA_KB, 32 * jt + r, 136, 16 * ks + 8 * h), acc); }
            const int j = 32 * jt + r; const float Gj = Gv[j];
#pragma unroll
            for (int q = 0; q < 16; ++q) { const int i = 32 * it + crow(q, h); Mf[i * 68 + j] = (j < i) ? Bv[i] * acc[q] * __expf(Gv[i] - Gj) : 0.f; }
        } else { const int mt = (wv - 4) >> 1, rt = (wv - 4) & 1; f32x16 acc = zero16;
            if (!(mt == 1 && rt == 0)) {
#pragma unroll
                for (int ks = 0; ks < 8; ++ks) acc = MFMA32(lds_frag(L + LA_KB, 32 * mt + r, 136, 16 * ks + 8 * h), lds_frag(L + LA_QB, 32 * rt + r, 136, 16 * ks + 8 * h), acc); }
            store_qk_frag(acc, Gv, mt, rt, r, h, lane, (bf16*)(rec + LA_QK)); }
        LDS_SYNC();
        f32x16 Pacc = zero16;
        if (wv < 2) {
            const int ln = opq(lane), cc = ln & 31, bo = 32 * wv;
            float Tc[32];
#pragma unroll
            for (int i = 0; i < 32; ++i) {
                float a0 = (i == cc) ? 1.f : 0.f, a1 = 0.f, a2 = 0.f, a3 = 0.f;
#pragma unroll
                for (int j4 = 0; j4 < (i + 3) / 4; ++j4) { const f32x4 m = *(const LAS f32x4*)(Mf + (bo + i) * 68 + bo + 4 * j4);
                    a0 -= m.x * Tc[4 * j4]; if (4 * j4 + 1 < i) a1 -= m.y * Tc[4 * j4 + 1]; if (4 * j4 + 2 < i) a2 -= m.z * Tc[4 * j4 + 2]; if (4 * j4 + 3 < i) a3 -= m.w * Tc[4 * j4 + 3]; }
                Tc[i] = (a0 + a1) + (a2 + a3);
                ((LAS bf16*)(L + LA_TB))[(bo + i) * 72 + bo + cc] = (bf16)f2bf(Tc[i]);
                if (wv == 0) ((LAS bf16*)(L + LA_TB))[i * 72 + 32 + cc] = (bf16)0;
                if ((i & 7) == 7) asm volatile("" ::: "memory");
            }
            if (wv == 0) {
#pragma unroll
                for (int s2 = 0; s2 < 2; ++s2) {
                    const LAS float* mr = Mf + (32 + r) * 68 + 16 * s2 + 8 * h; const f32x4 m0 = *(const LAS f32x4*)mr, m1 = *(const LAS f32x4*)(mr + 4);
                    const bf16x8 af = pack8(m0.x, m0.y, m0.z, m0.w, m1.x, m1.y, m1.z, m1.w);
                    const bf16x8 bfr = h ? pack8(Tc[16 * s2 + 8], Tc[16 * s2 + 9], Tc[16 * s2 + 10], Tc[16 * s2 + 11], Tc[16 * s2 + 12], Tc[16 * s2 + 13], Tc[16 * s2 + 14], Tc[16 * s2 + 15])
                                          : pack8(Tc[16 * s2 + 0], Tc[16 * s2 + 1], Tc[16 * s2 + 2], Tc[16 * s2 + 3], Tc[16 * s2 + 4], Tc[16 * s2 + 5], Tc[16 * s2 + 6], Tc[16 * s2 + 7]);
                    Pacc = MFMA32(af, bfr, Pacc); }
                if (lane == 0) wsf(F, WS_DLG)[item] = __expf(G63);
            }
        } else if (wv <= 5) {
#pragma unroll
            for (int t = 0; t < 4; ++t) { const int task = 4 * (wv - 2) + t, rt = task >> 3; const float e = __expf(Gv[32 * rt + r]);
                *(bf16x8*)((bf16*)(rec + LA_QD) + ((size_t)task * 64 + lane) * 8) = pack8(qa[t].x * e, qa[t].y * e, qa[t].z * e, qa[t].w * e, qb[t].x * e, qb[t].y * e, qb[t].z * e, qb[t].w * e); }
        } else {
#pragma unroll
            for (int t = 0; t < 8; ++t) ke_frag_task(L + LA_KET, 8 * (wv - 6) + t, r, h, lane, (bf16*)(rec + LA_KE)); }
        LDS_SYNC();
        if (wv == 0) {
            f32x16 t21 = zero16;
#pragma unroll
            for (int s2 = 0; s2 < 2; ++s2) {
                const LAS unsigned char* tr = L + LA_TB + ((size_t)(32 + r) * 72 + 32 + 16 * s2 + 4 * h) * 2;
                const v2u lo = *(const LAS v2u*)tr, hi = *(const LAS v2u*)(tr + 16); v4u w; w.x = lo.x; w.y = lo.y; w.z = hi.x; w.w = hi.y;
                t21 = MFMA32(__builtin_bit_cast(bf16x8, w), PACK_STEP(Pacc, s2), t21); }
#pragma unroll
            for (int q = 0; q < 16; ++q) ((LAS bf16*)(L + LA_TB))[(32 + crow(q, h)) * 72 + r] = (bf16)f2bf(-t21[q]);
        }
        LDS_SYNC();
#pragma unroll 1
        for (int tile = wv; tile < 16; tile += 8) {
            f32x16 acc = zero16;
            if (tile < 8) { const int it = tile >> 1, rt = tile & 1;
#pragma unroll
                for (int ks = 0; ks < 4; ++ks) acc = MFMA32(lds_frag(L + LA_KGT, 32 * it + r, 72, 16 * ks + 8 * h), lds_frag(L + LA_TB, 32 * rt + r, 72, 16 * ks + 8 * h), acc);
                bf16* nw = (bf16*)(rec + LA_NW);
                *(bf16x8*)(nw + ((size_t)(rt * 8 + 2 * it + 0) * 64 + lane) * 8) = PACK_STEP(acc, 0);
                *(bf16x8*)(nw + ((size_t)(rt * 8 + 2 * it + 1) * 64 + lane) * 8) = PACK_STEP(acc, 1);
            } else { const int rt = (tile - 8) >> 2, dvt = (tile - 8) & 3;
#pragma unroll
                for (int ks = 0; ks < 4; ++ks) acc = MFMA32(lds_frag(L + LA_TB, 32 * rt + r, 72, 16 * ks + 8 * h), lds_frag(L + LA_VBT, 32 * dvt + r, 72, 16 * ks + 8 * h), acc);
                float* uc = (float*)(rec + LA_UCG) + ((size_t)(dvt * 2 + rt) * 4 * 64 + lane) * 4;
#pragma unroll
                for (int q4 = 0; q4 < 4; ++q4) *(f32x4*)(uc + (size_t)q4 * 256) = (f32x4){acc[4 * q4], acc[4 * q4 + 1], acc[4 * q4 + 2], acc[4 * q4 + 3]};
            }
        }
        LDS_SYNC();
    }
    for (int item = F.vcu; item < 256; item += F.G) {
        const int tid = opq(tid0), lane = tid & 63, r = lane & 31, h = lane >> 5;
        const int b = item >> 6, ch = (item >> 1) & 31, g = item & 1;
        const size_t t0 = (size_t)b * SEQ + ch * 64;
        const float* BS = wsf(F, WS_BS) + t0 * 256 + g * 128; const float* CS = wsf(F, WS_CS) + t0 * 256 + g * 128;
        const int c = tid & 127, lg = tid >> 7;
        float br[16], cr[16];
#pragma unroll
        for (int i = 0; i < 16; ++i) { const int l = lg * 16 + i; br[i] = BS[(size_t)l * 256 + c]; cr[i] = CS[(size_t)l * 256 + c]; }
        f32x2v ad[4];
#pragma unroll
        for (int hi = 0; hi < 4; ++hi) ad[hi] = *(const f32x2v*)(wsf(F, WS_DT) + (t0 + lane) * 16 + 2 * (4 * g + hi));
        f32x4 ca[4], cb[4]; float xv[4][16];
        const int sl = (wv >> 1) & 1, rt2 = wv & 1;
        {
#pragma unroll
            for (int t = 0; t < 4; ++t) { const int task = 4 * (wv & 3) + t, rt = task >> 3, ks = task & 7, l = 32 * rt + r, k0 = 16 * ks + 4 * h; ca[t] = ld4(CS + (size_t)l * 256 + k0); cb[t] = ld4(CS + (size_t)l * 256 + k0 + 8); }
#pragma unroll
            for (int hi = 0; hi < 4; ++hi)
#pragma unroll
                for (int q = 0; q < 16; ++q) xv[hi][q] = wsf(F, WS_XS)[(t0 + 32 * rt2 + crow(q, h)) * GW + (4 * g + hi) * 64 + 32 * sl + r]; }
#pragma unroll
        for (int i = 0; i < 16; ++i) { const int l = lg * 16 + i;
            ((LAS bf16*)(L + LA_KB))[l * 136 + c] = (bf16)f2bf(br[i]); ((LAS bf16*)(L + LA_QB))[l * 136 + c] = (bf16)f2bf(cr[i]); }
        if (wv == 0) {
#pragma unroll
            for (int hi = 0; hi < 4; ++hi) { Gv[hi * 64 + lane] = wave_incl_scan(ad[hi].x, lane); Gv[256 + hi * 64 + lane] = ad[hi].y; } }
        LDS_SYNC();
        f32x16 raw = zero16;
        const int mt = (wv >> 1) & 1, rt = wv & 1;
        if (wv < 4 && !(mt == 1 && rt == 0)) {
#pragma unroll
            for (int ks = 0; ks < 8; ++ks) raw = MFMA32(lds_frag(L + LA_KB, 32 * mt + r, 136, 16 * ks + 8 * h), lds_frag(L + LA_QB, 32 * rt + r, 136, 16 * ks + 8 * h), raw); }
#pragma unroll
        for (int hi = 0; hi < 4; ++hi) {
            const int hh = 4 * g + hi, seq = b * 8 + hh;
            unsigned char* rec = F.ws + WS_FS + ((size_t)seq * 32 + ch) * LA_RECS;
            const LAS float* Gh = Gv + hi * 64; const LAS float* Dh = Gv + 256 + hi * 64;
            const float G63 = Gh[63];
#pragma unroll
            for (int i = 0; i < 16; ++i) { const int l = lg * 16 + i; ((LAS bf16*)(L + LA_KET))[c * 72 + l] = (bf16)f2bf(br[i] * __expf(G63 - Gh[l])); }
            if (wv < 4) {
                store_qk_frag(raw, Gh, mt, rt, r, h, lane, (bf16*)(rec + LA_QK));
#pragma unroll
                for (int t = 0; t < 4; ++t) { const int task = 4 * wv + t, rtq = task >> 3; const float e = __expf(Gh[32 * rtq + r]);
                    *(bf16x8*)((bf16*)(rec + LA_QD) + ((size_t)task * 64 + lane) * 8) = pack8(ca[t].x * e, ca[t].y * e, ca[t].z * e, ca[t].w * e, cb[t].x * e, cb[t].y * e, cb[t].z * e, cb[t].w * e); }
            } else {
                float* uc = (float*)(rec + LA_UCS) + ((size_t)(sl * 2 + rt2) * 4 * 64 + lane) * 4;
#pragma unroll
                for (int q4 = 0; q4 < 4; ++q4) { f32x4 v;
#pragma unroll
                    for (int e = 0; e < 4; ++e) v[e] = xv[hi][4 * q4 + e] * Dh[32 * rt2 + crow(4 * q4 + e, h)];
                    *(f32x4*)(uc + (size_t)q4 * 256) = v; }
            }
            if (tid == 0) wsf(F, WS_DLS)[seq * 32 + ch] = __expf(G63);
            LDS_SYNC();
            if (wv >= 4) {
#pragma unroll
                for (int t = 0; t < 4; ++t) ke_frag_task(L + LA_KET, 4 * (wv - 4) + t, r, h, lane, (bf16*)(rec + LA_KE)); }
            LDS_SYNC();
        }
    }
}

template <bool HAS_W> __device__ __forceinline__ void la_seq_wg(LAS unsigned char* ring  , const unsigned char* recs, int recsz, int uc_off, const float* dls, float* outp  , int slice, int lane, int wv) {
    constexpr int NFR = HAS_W ? 56 : 40;
    constexpr int SLOT = (NFR + 8) * 1024;
    const int r = lane & 31, h = lane >> 5;
    const bool loader = (wv >= 1 && wv <= 4);
    float dlv = 0.f;
    f32x16 S[4];
    if (wv == 0) { dlv = (lane < 32) ? dls[lane] : 0.f;
#pragma unroll
        for (int it = 0; it < 4; ++it)
#pragma unroll
            for (int q = 0; q < 16; ++q) S[it][q] = 0.f; }
#define LA_DMA(c_, slot_) do { const unsigned char* rec_ = recs + (size_t)(c_) * recsz + lane * 16; LAS unsigned char* dst_ = ring + (slot_) * SLOT; \
        for (int f_ = wv - 1; f_ < NFR + 8; f_ += 4) { const unsigned char* src_ = (f_ < NFR) ? rec_ + f_ * 1024 : rec_ + uc_off + slice * 8192 + (f_ - NFR) * 1024; \
            __builtin_amdgcn_global_load_lds((const unsigned*)src_, (LAS unsigned*)(dst_ + f_ * 1024), 16, 0, 0); } } while (0)
    if (loader) { LA_DMA(0, 0); asm volatile("s_waitcnt vmcnt(0)" ::: "memory"); }
    __builtin_amdgcn_s_barrier(); asm volatile("" ::: "memory");
#pragma unroll 1
    for (int c = 0; c < 32; ++c) {
        if (loader) { if (c + 1 < 32) { LA_DMA(c + 1, (c + 1) & 1); asm volatile("s_waitcnt vmcnt(0)" ::: "memory"); } }
        else if (wv == 0) {
        const LAS unsigned char* B = ring + (c & 1) * SLOT + lane * 16;
#define FRAG(off, idx) (*(const LAS bf16x8*)(B + (off) + (idx) * 1024))
        bf16x8 sb[8];
#pragma unroll
        for (int it = 0; it < 4; ++it) { sb[2 * it] = PACK_STEP(S[it], 0); sb[2 * it + 1] = PACK_STEP(S[it], 1); }
        f32x16 Vn[2];
#pragma unroll
        for (int rt = 0; rt < 2; ++rt)
#pragma unroll
            for (int q4 = 0; q4 < 4; ++q4) { const f32x4 v = *(const LAS f32x4*)(B + NFR * 1024 + (rt * 4 + q4) * 1024); Vn[rt][4 * q4] = v.x; Vn[rt][4 * q4 + 1] = v.y; Vn[rt][4 * q4 + 2] = v.z; Vn[rt][4 * q4 + 3] = v.w; }
        if (HAS_W) {
#pragma unroll
            for (int ks = 0; ks < 8; ++ks) { Vn[0] = MFMA32(FRAG(LA_NW, 0 * 8 + ks), sb[ks], Vn[0]); Vn[1] = MFMA32(FRAG(LA_NW, 1 * 8 + ks), sb[ks], Vn[1]); } }
        bf16x8 vb[4];
#pragma unroll
        for (int rt = 0; rt < 2; ++rt) { vb[2 * rt] = PACK_STEP(Vn[rt], 0); vb[2 * rt + 1] = PACK_STEP(Vn[rt], 1); }
        f32x16 O[2];
#pragma unroll
        for (int rt = 0; rt < 2; ++rt)
#pragma unroll
            for (int q = 0; q < 16; ++q) O[rt][q] = 0.f;
#pragma unroll
        for (int ks = 0; ks < 8; ++ks) { O[0] = MFMA32(FRAG(LA_QD, 0 * 8 + ks), sb[ks], O[0]); O[1] = MFMA32(FRAG(LA_QD, 1 * 8 + ks), sb[ks], O[1]); }
#pragma unroll
        for (int ks = 0; ks < 4; ++ks) { O[0] = MFMA32(FRAG(LA_QK, 0 * 4 + ks), vb[ks], O[0]); O[1] = MFMA32(FRAG(LA_QK, 1 * 4 + ks), vb[ks], O[1]); }
        float* op = outp + (size_t)c * 64 * GW + r;
#pragma unroll
        for (int rt = 0; rt < 2; ++rt)
#pragma unroll
            for (int q = 0; q < 16; ++q) op[(size_t)(32 * rt + crow(q, h)) * GW] = O[rt][q];
        const float dl = __builtin_bit_cast(float, __builtin_amdgcn_readlane(__builtin_bit_cast(int, dlv), c));
#pragma unroll
        for (int it = 0; it < 4; ++it) {
#pragma unroll
            for (int q = 0; q < 16; ++q) S[it][q] *= dl;
#pragma unroll
            for (int ks = 0; ks < 4; ++ks) S[it] = MFMA32(FRAG(LA_KE, it * 4 + ks), vb[ks], S[it]);
        }
#undef FRAG
        asm volatile("s_waitcnt lgkmcnt(0)" ::: "memory");
        }
        __builtin_amdgcn_s_barrier(); asm volatile("" ::: "memory");
    }
#undef LA_DMA
}
__device__ __forceinline__ void la_seq_phase(Frame& F, int l_unused) {
    const int lane = opq(F.lane);
    for (int item = F.vcu; item < 128; item += F.G) {
        if (item < 64) { const int seq = item >> 2, slice = item & 3, b = seq >> 2, hd = seq & 3;
            la_seq_wg<true>(F.lds + RING_OFF, F.ws + WS_FG + (size_t)seq * 32 * LA_RECG, LA_RECG, LA_UCG, wsf(F, WS_DLG) + seq * 32, wsf(F, WS_OG) + (size_t)b * SEQ * GW + hd * 128 + slice * 32, slice, lane, F.wave);
        } else { const int j = item - 64, seq = j >> 1, slice = j & 1, b = seq >> 3, hh = seq & 7;
            la_seq_wg<false>(F.lds + RING_OFF, F.ws + WS_FS + (size_t)seq * 32 * LA_RECS, LA_RECS, LA_UCS, wsf(F, WS_DLS) + seq * 32, wsf(F, WS_YS) + (size_t)b * SEQ * GW + hh * 64 + slice * 32, slice, lane, F.wave);
        }
    }
}

__device__ __forceinline__ void mixer_post_phase(Frame& F, int l) {
    const int gw = F.vcu * NWAVES + F.wave, NGW = F.G * NWAVES, lane = opq(F.lane), c = lane * 8;
    bf16* MIX = wsb(F, WS_MIX);
    const float* gng = inp(I_GNG) + (size_t)l * 128 + (c & 127); const float* sng = inp(I_SNG) + (size_t)l * GW + c;
    const f32x4 g0 = ld4(gng), g1 = ld4(gng + 4), n0 = ld4(sng), n1 = ld4(sng + 4);
    const float Dk = inp(I_SD)[l * 8 + (c >> 6)];
    for (int m = gw; m < M; m += NGW) {
        {
            const float* og = wsf(F, WS_OG) + (size_t)m * GW + c; const f32x8 zz = ldu8(wsb(F, WS_ZG) + (size_t)m * GW + c);
            const f32x4 o0 = ld4(og), o1 = ld4(og + 4), z0 = zz.lo, z1 = zz.hi;
            float ss = (o0.x * o0.x + o0.y * o0.y) + (o0.z * o0.z + o0.w * o0.w) + (o1.x * o1.x + o1.y * o1.y) + (o1.z * o1.z + o1.w * o1.w);
            ss = row16_sum(ss);
            const float rstd = 1.0f / sqrtf(ss * (1.0f / 128.0f) + EPS);
            const f32x4 y0 = o0 * rstd * g0 * silu4(z0), y1 = o1 * rstd * g1 * silu4(z1);
            v4u w; w.x = pk2(y0.x, y0.y); w.y = pk2(y0.z, y0.w); w.z = pk2(y1.x, y1.y); w.w = pk2(y1.z, y1.w);
            *(v4u*)(MIX + (size_t)m * DM + 2 * GW + c) = w;
        }
        {
            const float* ys = wsf(F, WS_YS) + (size_t)m * GW + c; const float* xs = wsf(F, WS_XS) + (size_t)m * GW + c; const f32x8 zz = ldu8(wsb(F, WS_ZS) + (size_t)m * GW + c);
            const f32x4 a0 = (ld4(ys) + ld4(xs) * Dk) * silu4(zz.lo), a1 = (ld4(ys + 4) + ld4(xs + 4) * Dk) * silu4(zz.hi);
            float ss = (a0.x * a0.x + a0.y * a0.y) + (a0.z * a0.z + a0.w * a0.w) + (a1.x * a1.x + a1.y * a1.y) + (a1.z * a1.z + a1.w * a1.w);
            ss = row16_sum(ss); ss += shx(ss, 16, lane);
            const float rstd = 1.0f / sqrtf(ss * (1.0f / 256.0f) + EPS);
            const f32x4 y0 = a0 * rstd * n0, y1 = a1 * rstd * n1;
            v4u w; w.x = pk2(y0.x, y0.y); w.y = pk2(y0.z, y0.w); w.z = pk2(y1.x, y1.y); w.w = pk2(y1.z, y1.w);
            *(v4u*)(MIX + (size_t)m * DM + 3 * GW + c) = w;
        }
    }
}

constexpr int CW_PANEL = 8192;
static_assert((CW_PANEL + DEPTH * 3 * 32 * 64) * 4 <= (int)CTL_ZERO_BYTES && CW_BAR + XCD_BAR_WORDS <= CW_PANEL, "control words inside the memset region");
namespace pg8 {
struct EpiAny {
    static constexpr bool PERM = false, AFTER_DRAIN = false, RT_DRAIN = true;
    void* C; int ldc; int mode; float scale;
    unsigned char* ws; float* out; int lq, prow0;
    int rsrow0;
    __device__ __forceinline__ bool perm() const { return mode != 0; }
    __device__ __forceinline__ bool drain() const { return mode >= 3; }
    __device__ __forceinline__ void operator()(const f32x4 (&acc)[2][2][4][2], const Unit& u, int wr, int wc, int fr, int fq) const {
        if (mode == 3 || mode == 4) return;
        if (rsrow0 < 0) {
            if (mode == 0) { EpiF32 e{(float*)C, ldc}; e(acc, u, wr, wc, fr, fq); }
            else if (mode == 1) { EpiBf16S e{(bf16_t*)C, ldc, scale}; e(acc, u, wr, wc, fr, fq); }
            else { EpiSwiGLU e{(bf16_t*)C, ldc}; e(acc, u, wr, wc, fr, fq); }
            return; }
        const float* rs = (const float*)(ws + WS_RS) + rsrow0 + u.pm * BM + wr * 64 + fr;
        const int row0 = u.pm * BM + wr * 64 + fr;
#pragma unroll
        for (int ai = 0; ai < 2; ++ai)
#pragma unroll
            for (int m = 0; m < 4; ++m) { const float r = rs[ai * HALF + m * 16];
                if (mode == 1) { bf16_t* rowp = (bf16_t*)C + (size_t)(row0 + ai * HALF + m * 16) * ldc + u.pn * BM + wc * 32 + 8 * fq;
#pragma unroll
                    for (int bj = 0; bj < 2; ++bj) { const f32x4 v0 = acc[ai][bj][m][0] * r, v1 = acc[ai][bj][m][1] * r;
                        u32x4 w; w.x = cvt_pk_bf16(v0[0], v0[1]); w.y = cvt_pk_bf16(v0[2], v0[3]); w.z = cvt_pk_bf16(v1[0], v1[1]); w.w = cvt_pk_bf16(v1[2], v1[3]); *(u32x4*)(rowp + bj * HALF) = w; }
                } else { bf16_t* rowp = (bf16_t*)C + (size_t)(row0 + ai * HALF + m * 16) * ldc + u.pn * HALF + wc * 32 + 8 * fq;
                    const f32x4 g0 = acc[ai][0][m][0] * r, g1 = acc[ai][0][m][1] * r, u0 = acc[ai][1][m][0] * r, u1 = acc[ai][1][m][1] * r;
                    u32x4 w; w.x = cvt_pk_bf16(silu_f(g0[0]) * u0[0], silu_f(g0[1]) * u0[1]); w.y = cvt_pk_bf16(silu_f(g0[2]) * u0[2], silu_f(g0[3]) * u0[3]);
                    w.z = cvt_pk_bf16(silu_f(g1[0]) * u1[0], silu_f(g1[1]) * u1[1]); w.w = cvt_pk_bf16(silu_f(g1[2]) * u1[2], silu_f(g1[3]) * u1[3]); *(u32x4*)rowp = w; } }
    }
    __device__ __forceinline__ void fused(f32x4 (&acc)[2][2][4][2], const Unit& u, int wr, int wc, int fr, int fq, PG8_LAS unsigned char* lds, int wid, int lane) const {
        if (mode == 3) fused_softmax(acc, u, wr, wc, fr, fq, lds, wid, lane); else fused_resnorm(acc, u, wr, wc, fr, fq, lds, wid, lane);
    }
    __device__ __forceinline__ void fused_resnorm(f32x4 (&acc)[2][2][4][2], const Unit& u, int wr, int wc, int fr, int fq, PG8_LAS unsigned char* lds, int wid, int lane) const {
        const int D = 2048;
        {   bf16_t* Yw = (bf16_t*)(ws + WS_Y);
            const int row0 = prow0 + u.pm * BM + wr * 64 + fr, col0 = u.pn * BM + wc * 32 + 8 * fq;
#pragma unroll
            for (int ai = 0; ai < 2; ++ai)
#pragma unroll
                for (int m = 0; m < 4; ++m)
#pragma unroll
                    for (int bj = 0; bj < 2; ++bj) { const f32x4 v0 = acc[ai][bj][m][0], v1 = acc[ai][bj][m][1];
                        u32x4 w; w.x = cvt_pk_bf16(v0[0], v0[1]); w.y = cvt_pk_bf16(v0[2], v0[3]); w.z = cvt_pk_bf16(v1[0], v1[1]); w.w = cvt_pk_bf16(v1[2], v1[3]);
                        bf16_t* dst = Yw + (size_t)(row0 + ai * HALF + m * 16) * D + col0 + bj * HALF;
                        asm volatile("global_store_dwordx4 %0, %1, off sc1\n\ts_nop 1" :: "v"(dst), "v"(w) : "memory"); } }
        asm volatile("s_waitcnt vmcnt(0)" ::: "memory");
        __builtin_amdgcn_s_barrier(); asm volatile("" ::: "memory");
        const int l = lq / 3, rn = lq % 3;
        unsigned* pc = (unsigned*)(ws + WS_CTL) + CW_PANEL + (lq * 32 + (prow0 >> 8) + u.pm) * 64;
        const float* gpost = inp(I_NORMG) + (size_t)(l * N_NORMS + (rn == 0 ? MIX_POST : rn == 1 ? XA_POST : FFN_POST)) * D;
        const bool first = (lq == 0), last = (lq == 3 * DEPTH - 1);
        const float* xin32 = inp(I_X); bf16_t* xb = (bf16_t*)(ws + WS_XN); float* rsb = (float*)(ws + WS_RS);
        if (wid == 0) {
            if (lane == 0) __hip_atomic_fetch_add(pc, 1u, __ATOMIC_RELAXED, __HIP_MEMORY_SCOPE_AGENT);
            unsigned spins = 0;
            while ((unsigned)__builtin_amdgcn_readfirstlane(__hip_atomic_load(pc, __ATOMIC_RELAXED, __HIP_MEMORY_SCOPE_AGENT)) < 8u) { __builtin_amdgcn_s_sleep(2); if (++spins > (1u << 22)) break; }
            __builtin_amdgcn_fence(__ATOMIC_ACQUIRE, "agent");
            asm volatile("s_waitcnt vmcnt(0)" ::: "memory");
        }
        __builtin_amdgcn_s_barrier(); asm volatile("" ::: "memory");
        const bf16_t* Y = (const bf16_t*)(ws + WS_Y);
#define BFLO(wd) __builtin_bit_cast(float, (wd) << 16)
#define BFHI(wd) __builtin_bit_cast(float, (wd) & 0xffff0000u)
#pragma unroll 1
        for (int i = 0; i < 4; ++i) {
            const size_t mrow = (size_t)prow0 + u.pm * BM + u.pn * 32 + wid * 4 + i;
            f32x4 x[8]; u32x4 yw[4];
            { const u32x4* yr = (const u32x4*)(Y + mrow * D) + lane;
#pragma unroll
              for (int j = 0; j < 4; ++j) yw[j] = yr[64 * j];
              if (first) { const f32x4* xr = (const f32x4*)(xin32 + mrow * D) + 2 * lane;
#pragma unroll
                  for (int j = 0; j < 4; ++j) { x[2 * j] = xr[128 * j]; x[2 * j + 1] = xr[128 * j + 1]; }
              } else { const u32x4* xr = (const u32x4*)(xb + mrow * D) + lane;
#pragma unroll
                  for (int j = 0; j < 4; ++j) { const u32x4 w = xr[64 * j]; x[2 * j] = (f32x4){BFLO(w.x), BFHI(w.x), BFLO(w.y), BFHI(w.y)}; x[2 * j + 1] = (f32x4){BFLO(w.z), BFHI(w.z), BFLO(w.w), BFHI(w.w)}; } } }
            float s = 0.f;
#pragma unroll
            for (int j = 0; j < 4; ++j) { const u32x4 w = yw[j]; const float a0 = BFLO(w.x), a1 = BFHI(w.x), a2 = BFLO(w.y), a3 = BFHI(w.y), a4 = BFLO(w.z), a5 = BFHI(w.z), a6 = BFLO(w.w), a7 = BFHI(w.w);
                s += ((a0 * a0 + a1 * a1) + (a2 * a2 + a3 * a3)) + ((a4 * a4 + a5 * a5) + (a6 * a6 + a7 * a7)); }
            s = wave_sum(s);
            const float rstd = 1.0f / sqrtf(s * (1.0f / 2048.0f) + 1e-6f);
            float s2 = 0.f;
#pragma unroll
            for (int j = 0; j < 4; ++j) { const u32x4 w = yw[j];
                const f32x4 y0 = (f32x4){BFLO(w.x), BFHI(w.x), BFLO(w.y), BFHI(w.y)}, y1 = (f32x4){BFLO(w.z), BFHI(w.z), BFLO(w.w), BFHI(w.w)};
                const f32x4 g0 = ((const f32x4*)gpost)[2 * lane + 128 * j], g1 = ((const f32x4*)gpost)[2 * lane + 128 * j + 1];
                const f32x4 v0 = x[2 * j] + y0 * rstd * g0, v1 = x[2 * j + 1] + y1 * rstd * g1; x[2 * j] = v0; x[2 * j + 1] = v1;
                s2 += ((v0[0] * v0[0] + v0[1] * v0[1]) + (v0[2] * v0[2] + v0[3] * v0[3])) + ((v1[0] * v1[0] + v1[1] * v1[1]) + (v1[2] * v1[2] + v1[3] * v1[3])); }
            if (last) { f32x4* xo = (f32x4*)(out + mrow * D) + 2 * lane;
#pragma unroll
                for (int j = 0; j < 4; ++j) { xo[128 * j] = x[2 * j]; xo[128 * j + 1] = x[2 * j + 1]; }
            } else {
                s2 = wave_sum(s2);
                if (lane == 0) rsb[mrow] = 1.0f / sqrtf(s2 * (1.0f / 2048.0f) + 1e-6f);
                u32x4* o8 = (u32x4*)(xb + mrow * D) + lane;
#pragma unroll
                for (int j = 0; j < 4; ++j) { const f32x4 a = x[2 * j], b = x[2 * j + 1];
                    u32x4 w; w.x = cvt_pk_bf16(a[0], a[1]); w.y = cvt_pk_bf16(a[2], a[3]); w.z = cvt_pk_bf16(b[0], b[1]); w.w = cvt_pk_bf16(b[2], b[3]); o8[64 * j] = w; }
            }
        }
#undef BFLO
#undef BFHI
    }
    __device__ __forceinline__ void fused_softmax(f32x4 (&acc)[2][2][4][2], const Unit& u, int wr, int wc, int fr, int fq, PG8_LAS unsigned char* lds, int wid, int lane) const {
        { const float* rs = (const float*)(ws + WS_RS) + rsrow0 + u.pm * BM + wr * 64 + fr;
#pragma unroll
          for (int ai = 0; ai < 2; ++ai)
#pragma unroll
            for (int m = 0; m < 4; ++m) { const float r = rs[ai * HALF + m * 16];
#pragma unroll
                for (int bj = 0; bj < 2; ++bj)
#pragma unroll
                    for (int n = 0; n < 2; ++n) acc[ai][bj][m][n] = acc[ai][bj][m][n] * r; } }
        PG8_LAS float* Pm = (PG8_LAS float*)lds;
        PG8_LAS float* Ps = (PG8_LAS float*)(lds + 4096);
#pragma unroll
        for (int ai = 0; ai < 2; ++ai)
#pragma unroll
            for (int m = 0; m < 4; ++m) { float mx = -3.0e38f;
#pragma unroll
                for (int bj = 0; bj < 2; ++bj)
#pragma unroll
                    for (int n = 0; n < 2; ++n) { const f32x4 x = acc[ai][bj][m][n]; mx = fmaxf(mx, fmaxf(fmaxf(x[0], x[1]), fmaxf(x[2], x[3]))); }
                mx = fmaxf(mx, shx(mx, 16, lane)); mx = fmaxf(mx, shx(mx, 32, lane));
                if (fq == 0) Pm[(ai * HALF + wr * 64 + m * 16 + fr) * 4 + wc] = mx; }
        asm volatile("s_waitcnt lgkmcnt(0)" ::: "memory"); __builtin_amdgcn_s_barrier(); asm volatile("" ::: "memory");
#pragma unroll
        for (int ai = 0; ai < 2; ++ai)
#pragma unroll
            for (int m = 0; m < 4; ++m) { const int row = ai * HALF + wr * 64 + m * 16 + fr; const f32x4 pm = *(const PG8_LAS f32x4*)(Pm + row * 4);
                const float mx = fmaxf(fmaxf(pm[0], pm[1]), fmaxf(pm[2], pm[3])); float sm = 0.f;
#pragma unroll
                for (int bj = 0; bj < 2; ++bj)
#pragma unroll
                    for (int n = 0; n < 2; ++n) { f32x4 x = acc[ai][bj][m][n]; x[0] = __expf(x[0] - mx); x[1] = __expf(x[1] - mx); x[2] = __expf(x[2] - mx); x[3] = __expf(x[3] - mx);
                        acc[ai][bj][m][n] = x; sm += (x[0] + x[1]) + (x[2] + x[3]); }
                sm += shx(sm, 16, lane); sm += shx(sm, 32, lane);
                if (fq == 0) Ps[row * 4 + wc] = sm; }
        asm volatile("s_waitcnt lgkmcnt(0)" ::: "memory"); __builtin_amdgcn_s_barrier(); asm volatile("" ::: "memory");
        const int row0 = u.pm * BM + wr * 64 + fr, col0 = u.pn * BM + wc * 32 + 8 * fq;
#pragma unroll
        for (int ai = 0; ai < 2; ++ai)
#pragma unroll
            for (int m = 0; m < 4; ++m) { const int row = ai * HALF + wr * 64 + m * 16 + fr; const f32x4 ps = *(const PG8_LAS f32x4*)(Ps + row * 4);
                const float inv = 1.0f / ((ps[0] + ps[1]) + (ps[2] + ps[3]));
                bf16_t* rowp = (bf16_t*)C + (size_t)(row0 + ai * HALF + m * 16) * ldc + col0;
#pragma unroll
                for (int bj = 0; bj < 2; ++bj) { const f32x4 v0 = acc[ai][bj][m][0] * inv, v1 = acc[ai][bj][m][1] * inv;
                    u32x4 w; w.x = cvt_pk_bf16(v0[0], v0[1]); w.y = cvt_pk_bf16(v0[2], v0[3]); w.z = cvt_pk_bf16(v1[0], v1[1]); w.w = cvt_pk_bf16(v1[2], v1[3]);
                    *(u32x4*)(rowp + bj * HALF) = w; } }
    }
};
}

#ifndef SKIPM
#define SKIPM 0
#endif
#ifndef REPM
#define REPM 0
#endif
#ifndef GEMM_SP2
#define GEMM_SP2 true
#endif
#ifndef GEMM_ALIGN
#define GEMM_ALIGN true
#endif
#ifndef PROBE_PH
#define PROBE_PH -1
#endif
constexpr int PH_PER_LAYER = 10, PH0 = 2, N_PHASES = PH0 + DEPTH * PH_PER_LAYER;
struct Args { const float* in[N_IN]; float* out; unsigned char* ws; int ph_lo, ph_hi; };
static_assert(sizeof(Args) == (N_IN + 2) * 8 + 8, "Args has no padding");
struct GemmDesc { const bf16* A; const bf16* Bt; void* C; int M, N, K, lda, ldb, ldc, mode, corder, rn, prow0, rsrow0; float scale; };
constexpr int NOUNIT = 1 << 24;
__device__ __forceinline__ int gemm_nsub(int ph, int k, int l) { return ph == 0 ? 0 : ph == 1 ? 1 : (k == 1 || k == 2 || k == 4) ? 0 : k == 3 ? (l == 0 ? 33 : 32) : (k == 6 || k == 7) ? BATCH : 1; }
__device__ __forceinline__ int pmod(int x, int m) { const int r = x % m; return r < 0 ? r + m : r; }
__device__ __forceinline__ void kv_desc(const Frame& F, int l, int v0, GemmDesc& d) {
    d.A = wsb(F, WS_MEMN) + (size_t)l * MROWS * DM; d.Bt = (const bf16*)(F.ws + WS_W + (size_t)l * W_LAYER + WO_WKV); d.C = wsb(F, WS_KV) + (size_t)l * MROWS * 2 * DM;
    d.M = MROWS; d.N = 2 * DM; d.K = DM; d.lda = DM; d.ldb = DM; d.ldc = 2 * DM; d.mode = 1; d.corder = (F.vcu >= v0 && F.vcu < v0 + 64) ? F.vcu - v0 : NOUNIT;
}
__device__ __forceinline__ void gemm_desc(const Frame& F, int ph, int sub, GemmDesc& d) {
    const int bx = (int)blockIdx.x;
    d.scale = 1.0f; d.corder = bx; d.rn = -1; d.prow0 = 0; d.rsrow0 = -1;
    if (ph == 1) { kv_desc(F, 0, 0, d); return; }
    const int l = (ph - PH0) / PH_PER_LAYER, k = (ph - PH0) % PH_PER_LAYER;
    if (k == 3) {
        if (sub == 32) { kv_desc(F, 1, 192, d); return; }
        const int which = sub & 1, h = (sub >> 1) & 3, b = (sub >> 3) & 3;
        const unsigned char* wl = F.ws + WS_W + (size_t)l * W_LAYER;
        const bf16* kv = wsb(F, WS_KV) + (size_t)l * MROWS * 2 * DM + (size_t)(b * MEML) * 2 * DM + h * XHD;
        const int nb = (l == 0) ? 64 : 128;
        d.K = XHD; d.mode = 1; d.corder = (F.vcu >= 128 && F.vcu < 128 + nb) ? pmod(F.vcu - 128 - 8 * sub, nb) : NOUNIT;
        if (which == 0) {
            d.A = kv; d.lda = 2 * DM; d.Bt = (const bf16*)(wl + WO_WQ) + h * XHD; d.ldb = DM; d.M = MEML; d.N = DM;
            d.C = wsb(F, WS_AT) + ((size_t)(l * BATCH + b) * 1024 + h * MEML) * DM; d.ldc = DM; d.scale = 0.044194173824159216f;
        } else {
            d.A = (const bf16*)(wl + WO_WO) + h * XHD; d.lda = DM; d.Bt = kv + DM; d.ldb = 2 * DM; d.M = DM; d.N = MEML;
            d.C = wsb(F, WS_VWT) + (size_t)(l * BATCH + b) * DM * 1024 + h * MEML; d.ldc = 1024;
        }
        return;
    }
    const unsigned char* wl = F.ws + WS_W + (size_t)l * W_LAYER;
    d.M = M; d.K = DM; d.N = DM; d.lda = DM; d.ldb = DM; d.ldc = DM; d.mode = 1; d.A = wsb(F, WS_XN); d.C = wsb(F, WS_Y);
    if (k == 0) { d.Bt = (const bf16*)(wl + WO_WIN); d.N = IN_PAD; d.C = wsb(F, WS_U); d.ldc = IN_PAD; d.mode = 1; d.rsrow0 = 0; }
    else if (k == 5) { d.A = wsb(F, WS_MIX); d.Bt = (const bf16*)(wl + WO_WOUT); d.mode = 4; d.rn = 0; }
    else if (k == 6) {
        const int b = sub; d.A = wsb(F, WS_XN) + (size_t)b * SEQ * DM; d.Bt = wsb(F, WS_AT) + (size_t)(l * BATCH + b) * 1024 * DM; d.M = SEQ; d.N = 1024;
        d.C = wsb(F, WS_P) + (size_t)b * SEQ * 1024; d.ldc = 1024; d.mode = 3; d.rsrow0 = b * SEQ; d.corder = (bx + F.G - 32 * sub) % F.G; }
    else if (k == 7) {
        const int b = sub; d.A = wsb(F, WS_P) + (size_t)b * SEQ * 1024; d.lda = 1024; d.Bt = wsb(F, WS_VWT) + (size_t)(l * BATCH + b) * DM * 1024; d.ldb = 1024; d.M = SEQ; d.K = 1024;
        d.mode = 4; d.rn = 1; d.prow0 = b * SEQ; d.corder = (bx + F.G - 64 * sub) % F.G; }
    else if (k == 8) { d.Bt = (const bf16*)(wl + WO_WGU); d.N = 2 * DFF; d.mode = 2; d.C = wsb(F, WS_HID); d.ldc = DFF; d.rsrow0 = 0; }
    else { d.A = wsb(F, WS_HID); d.Bt = (const bf16*)(wl + WO_WD); d.K = DFF; d.lda = DFF; d.ldb = DFF; d.mode = 4; d.rn = 2; }
}

__global__ void __launch_bounds__(NWAVES * 64, 2) fwd_kernel(Args args) {
    extern __shared__ __attribute__((aligned(16))) unsigned char lds[];
    Frame F;
    F.lds = (LAS unsigned char*)lds;
    F.MISC = (volatile LAS unsigned*)(F.lds + MISC_OFF);
    F.tid = threadIdx.x; F.lane = F.tid & 63; F.wave = __builtin_amdgcn_readfirstlane(F.tid >> 6);
    F.G = gridDim.x; { const int bx = blockIdx.x; F.vcu = (F.G % 8 == 0) ? (bx % 8) * (F.G / 8) + bx / 8 : bx; }
    F.ws = args.ws; F.out = args.out; F.ctl = (unsigned*)(args.ws + WS_CTL);
    for (int u = F.tid; u < (LDS_BYTES - LDSCTL_OFF) / 4; u += NWAVES * 64) ((LAS unsigned*)(F.lds + LDSCTL_OFF))[u] = 0u;
    __syncthreads();
    const int lo = args.ph_lo, hi = args.ph_hi;
    if (hi - lo > 1) (void)xcd_barrier_post(F.ctl + CW_BAR, F.MISC + 8);
#define GRID_BARRIER() do { XcdBarrier b_; b_.bar = F.ctl + CW_BAR; b_.x = xb_xcc_id(); b_.st = F.MISC + 8; xcd_barrier(b_); } while (0)
    LAS unsigned char* ring = F.lds + RING_OFF;
#if PROBE_PH >= 0
    unsigned long long t_start = __builtin_amdgcn_s_memrealtime(), t_probe = 0;
#endif
#pragma unroll 1
    for (int ph = lo; ph < hi; ++ph) {
        const int l = ph >= PH0 ? (ph - PH0) / PH_PER_LAYER : 0, k = ph >= PH0 ? (ph - PH0) % PH_PER_LAYER : -1;
        const int kbit = (ph < PH0) ? ph : (k + PH0);
        const int reps = 1 + ((REPM >> kbit) & 1);
#pragma unroll 1
        for (int rep = 0; rep < reps; ++rep) {
        if (ph < PH0) p0_prologue(F, ph);
        else if (k == 1) mixer_prep_phase(F, l);
        else if (k == 2) la_prep_phase(F, l);
        else if (k == 3) la_seq_phase(F, l);
        else if (k == 4) mixer_post_phase(F, l);
        const int nsub = gemm_nsub(ph, k, l);
#pragma unroll 1
        for (int sub = 0; sub < nsub; ++sub) {
            GemmDesc d; gemm_desc(F, ph, sub, d);
            pg8::Gemm g{d.A, d.Bt, d.M, d.N, d.K, d.lda, d.ldb}; pg8::StaticOrder S; S.init(d.M, d.N, F.G, d.corder);
            pg8::EpiAny E{d.C, d.ldc, d.mode, d.scale, F.ws, F.out, l * 3 + d.rn, d.prow0, d.rsrow0};
            pg8::gemm_phase<pg8::EpiAny, pg8::StaticOrder, GEMM_ALIGN, GEMM_SP2>(ring, g, S, E);
        }
        if (REPM >> 20) { if (rep + 1 < reps) __syncthreads(); }
        }
        if ((REPM >> 21) & 1) GRID_BARRIER();
        if (ph + 1 < hi) GRID_BARRIER();
#if PROBE_PH >= 0
        if (ph == PROBE_PH) t_probe = __builtin_amdgcn_s_memrealtime();
#endif
    }
#if PROBE_PH >= 0
    if (blockIdx.x == 0) {
        const unsigned long long t_end = __builtin_amdgcn_s_memrealtime();
        while (__builtin_amdgcn_s_memrealtime() - t_end < t_probe - t_start) __builtin_amdgcn_s_sleep(8);
    }
#endif
}

#ifndef MK_SINGLE
#define MK_SINGLE 0
#endif
extern "C" void kernel_launch(void* const* d_in, const int* in_sizes, int n_in, void* d_out, int out_size, void* d_ws, size_t ws_size, hipStream_t stream) {
    static int grid = 0;
    if (grid == 0) {
        if (n_in != N_IN || in_sizes[0] != M * DM || out_size != M * DM || ws_size < WS_END) { fprintf(stderr, "kernel_launch: unexpected problem (n_in %d, in0 %d, out %d, ws %zu < %zu)\n", n_in, n_in > 0 ? in_sizes[0] : -1, out_size, ws_size, (size_t)WS_END); grid = -1; return; }
        int dev = 0, cus = 0, per_cu = 0;
        if (hipGetDevice(&dev) != hipSuccess || hipDeviceGetAttribute(&cus, hipDeviceAttributeMultiprocessorCount, dev) != hipSuccess) { grid = -1; return; }
        if (hipFuncSetAttribute((const void*)fwd_kernel, hipFuncAttributeMaxDynamicSharedMemorySize, LDS_BYTES) != hipSuccess) { fprintf(stderr, "kernel_launch: hipFuncSetAttribute failed\n"); grid = -1; return; }
        if (hipOccupancyMaxActiveBlocksPerMultiprocessor(&per_cu, (const void*)fwd_kernel, NWAVES * 64, LDS_BYTES) != hipSuccess || per_cu < 1) { fprintf(stderr, "kernel_launch: occupancy query says %d blocks per CU\n", per_cu); per_cu = 1; }
        (void)hipGetLastError();
        grid = cus * (per_cu < 1 ? 1 : 1);
        if (grid != 256) fprintf(stderr, "kernel_launch: note: grid %d (expected 256)\n", grid);
    }
    if (grid < 0) return;
    if (hipMemsetAsync((char*)d_ws + WS_CTL, 0, CTL_ZERO_BYTES, stream) != hipSuccess) { fprintf(stderr, "kernel_launch: memset failed\n"); return; }
    Args a{};
    for (int i = 0; i < N_IN; ++i) a.in[i] = (const float*)d_in[i];
    a.out = (float*)d_out; a.ws = (unsigned char*)d_ws;
#if MK_SINGLE
    a.ph_lo = 0; a.ph_hi = N_PHASES;
    void* kargs[] = {&a};
    hipError_t e = hipLaunchCooperativeKernel((const void*)fwd_kernel, dim3(grid), dim3(NWAVES * 64), kargs, LDS_BYTES, stream);
    if (e != hipSuccess) fprintf(stderr, "kernel_launch: cooperative launch failed: %s (grid %d)\n", hipGetErrorString(e), grid);
#else
    for (int p = 0; p < N_PHASES; ++p) { a.ph_lo = p; a.ph_hi = p + 1;
        hipLaunchKernelGGL(fwd_kernel, dim3(grid), dim3(NWAVES * 64), LDS_BYTES, stream, a);
        const hipError_t le = hipPeekAtLastError(); if (le != hipSuccess) { fprintf(stderr, "kernel_launch: launch %d failed: %s\n", p, hipGetErrorName(le)); break; } }
#endif
}
```

```cpp
#include <hip/hip_runtime.h>
#include <cstdio>
#include <cstdint>
#define MK_SINGLE 1
namespace pg8 {
#define PG8_LAS __attribute__((address_space(3)))
typedef unsigned short bf16_t;
typedef short bf16x8 __attribute__((ext_vector_type(8)));
typedef float f32x4 __attribute__((ext_vector_type(4)));
typedef unsigned u32x4 __attribute__((ext_vector_type(4)));
constexpr int BM = 256, BK = 64, HALF = 128, HTB = HALF * BK * 2  , STAGE_BYTES = 8 * HTB, NXCD = 8, WGM = 8;

__host__ __device__ __forceinline__ int lds_byte(int r, int c) { const int st = (r >> 4) * 2 + (c >> 5), rr = r & 15, cc = c & 31, ob = rr * 64 + cc * 2; return st * 1024 + (ob ^ (((ob >> 9) & 1) << 5)); }
__host__ __device__ __forceinline__ void stage_rc(int b, int& R, int& C) { const int st = b / 1024, sb = b % 1024, swz = sb ^ (((sb >> 9) & 1) << 5); R = (st >> 1) * 16 + swz / 64; C = (st & 1) * 32 + (swz % 64) / 2; }
__host__ __device__ __forceinline__ int perm32(int rho) { const int n = rho >> 4, i = rho & 15; return 8 * (i >> 2) + 4 * n + (i & 3); }

struct Unit { int pm, pn; };
struct Gemm { const bf16_t* A; const bf16_t* Bt; int M, N, K, lda, ldb; };

struct StaticOrder {
    int nM, nN, nwg, G, c;
    __host__ __device__ void init(int M, int N, int G_, int c_) { nM = M / BM; nN = N / BM; nwg = nM * nN; G = G_; c = c_; }
    __host__ __device__ bool next(int i, Unit& u) const {
        const long L = (long)i * G + c; if (L >= nwg) return false;
        int wgid = (int)L; { const int q = nwg / NXCD, r = nwg % NXCD, xcd = wgid % NXCD, off = wgid / NXCD; wgid = (xcd < r ? xcd * (q + 1) : r * (q + 1) + (xcd - r) * q) + off; }
        const int nig = WGM * nN, gid = wgid / nig, fm = gid * WGM, gsz = (nM - fm) < WGM ? (nM - fm) : WGM;
        u.pm = fm + ((wgid % nig) % gsz); u.pn = (wgid % nig) / gsz; return true;
    }
    __device__ __forceinline__ void a_ready(const Unit&) const {}
    __device__ __forceinline__ void done(const Unit&) const {}
};

__device__ __forceinline__ unsigned cvt_pk_bf16(float lo, float hi) { unsigned r; asm volatile("v_cvt_pk_bf16_f32 %0, %1, %2" : "=v"(r) : "v"(lo), "v"(hi)); return r; }
struct EpiF32 {
    static constexpr bool PERM = false, AFTER_DRAIN = false;
    float* C; int ldc;
    __device__ __forceinline__ void operator()(const f32x4 (&acc)[2][2][4][2], const Unit& u, int wr, int wc, int fr, int fq) const {
        const int row0 = u.pm * BM + wr * 64 + fr, col0 = u.pn * BM + wc * 32 + 4 * fq;
#pragma unroll
        for (int ai = 0; ai < 2; ++ai)
#pragma unroll
            for (int m = 0; m < 4; ++m) { float* rowp = C + (size_t)(row0 + ai * HALF + m * 16) * ldc + col0;
#pragma unroll
                for (int bj = 0; bj < 2; ++bj)
#pragma unroll
                    for (int n = 0; n < 2; ++n) *(f32x4*)(rowp + bj * HALF + n * 16) = acc[ai][bj][m][n]; }
    }
};
struct EpiBf16S {
    static constexpr bool PERM = true, AFTER_DRAIN = false;
    bf16_t* O; int ldc; float scale;
    __device__ __forceinline__ void operator()(const f32x4 (&acc)[2][2][4][2], const Unit& u, int wr, int wc, int fr, int fq) const {
        const int row0 = u.pm * BM + wr * 64 + fr, col0 = u.pn * BM + wc * 32 + 8 * fq; const float sc = scale;
#pragma unroll
        for (int ai = 0; ai < 2; ++ai)
#pragma unroll
            for (int m = 0; m < 4; ++m) { bf16_t* rowp = O + (size_t)(row0 + ai * HALF + m * 16) * ldc + col0;
#pragma unroll
                for (int bj = 0; bj < 2; ++bj) { const f32x4 v0 = acc[ai][bj][m][0] * sc, v1 = acc[ai][bj][m][1] * sc;
                    u32x4 w; w.x = cvt_pk_bf16(v0[0], v0[1]); w.y = cvt_pk_bf16(v0[2], v0[3]); w.z = cvt_pk_bf16(v1[0], v1[1]); w.w = cvt_pk_bf16(v1[2], v1[3]);
                    *(u32x4*)(rowp + bj * HALF) = w; } }
    }
};
__device__ __forceinline__ float silu_f(float v) { return v * __builtin_amdgcn_rcpf(1.0f + __expf(-v)); }
struct EpiSwiGLU {
    static constexpr bool PERM = true, AFTER_DRAIN = false;
    bf16_t* O; int ldc;
    __device__ __forceinline__ void operator()(const f32x4 (&acc)[2][2][4][2], const Unit& u, int wr, int wc, int fr, int fq) const {
        const int row0 = u.pm * BM + wr * 64 + fr, col0 = u.pn * HALF + wc * 32 + 8 * fq;
#pragma unroll
        for (int ai = 0; ai < 2; ++ai)
#pragma unroll
            for (int m = 0; m < 4; ++m) { bf16_t* rowp = O + (size_t)(row0 + ai * HALF + m * 16) * ldc + col0;
                const f32x4 g0 = acc[ai][0][m][0], g1 = acc[ai][0][m][1], u0 = acc[ai][1][m][0], u1 = acc[ai][1][m][1];
                u32x4 w; w.x = cvt_pk_bf16(silu_f(g0[0]) * u0[0], silu_f(g0[1]) * u0[1]); w.y = cvt_pk_bf16(silu_f(g0[2]) * u0[2], silu_f(g0[3]) * u0[3]);
                w.z = cvt_pk_bf16(silu_f(g1[0]) * u1[0], silu_f(g1[1]) * u1[1]); w.w = cvt_pk_bf16(silu_f(g1[2]) * u1[2], silu_f(g1[3]) * u1[3]);
                *(u32x4*)rowp = w; }
    }
};
template <class Epi, class Sched, bool ALIGN_EPI = false, bool SP2 = false>
__device__ __forceinline__ void gemm_phase(PG8_LAS unsigned char* lds, const Gemm g, const Sched& S, const Epi& E) {
    int tid_ = threadIdx.x; asm volatile("" : "+v"(tid_));
    const int tid = tid_, wid = __builtin_amdgcn_readfirstlane(tid >> 6), lane = tid & 63, wr = wid >> 2, wc = wid & 3, fr = lane & 15, fq = lane >> 4;
    const int K = g.K, nt = K / BK;
    unsigned voffA[2], voffB[2];
#pragma unroll
    for (int i = 0; i < 2; ++i) { int R, C; stage_rc(tid * 16 + i * 8192, R, C); const int Rb = E.perm() ? ((R & ~31) + perm32(R & 31)) : R;
        voffA[i] = (unsigned)(R * g.lda + C) * 2u; voffB[i] = (unsigned)(Rb * g.ldb + C) * 2u; }
    const size_t kstep = (size_t)(BK * 2);
    const size_t hstepA = (size_t)HALF * g.lda * 2, hstepB = (size_t)HALF * g.ldb * 2;
    const size_t tstepA = 2 * hstepA, tstepB = 2 * hstepB;
    const unsigned ldsw = (unsigned)wid * 1024u;
    const int aoff = lds_byte(wr * 64 + fr, fq * 8), boff = lds_byte(wc * 32 + fr, fq * 8);
#define PG8_SA(b, h) (((b) * 2 + (h)) * HTB)
#define PG8_SB(b, h) ((4 + (b) * 2 + (h)) * HTB)
#define PG8_STAGE(bufoff, gbase, voff) do { _Pragma("unroll") for (int _i = 0; _i < 2; ++_i) \
        __builtin_amdgcn_global_load_lds((const unsigned*)((const char*)(gbase) + (voff)[_i]), (PG8_LAS unsigned*)(lds + (bufoff) + ldsw + _i * 8192), 16, 0, 0); } while (0)
#define PG8_LDA(dst, b, h) do { _Pragma("unroll") for (int m = 0; m < 4; ++m) _Pragma("unroll") for (int k = 0; k < 2; ++k) dst[m][k] = *(const PG8_LAS bf16x8*)(lds + PG8_SA(b, h) + aoff + m * 2048 + k * 1024); } while (0)
#define PG8_LDB(dst, b, h) do { _Pragma("unroll") for (int n = 0; n < 2; ++n) _Pragma("unroll") for (int k = 0; k < 2; ++k) dst[n][k] = *(const PG8_LAS bf16x8*)(lds + PG8_SB(b, h) + boff + n * 2048 + k * 1024); } while (0)
#define PG8_MMA(ai, bj, At, Bt) do { __builtin_amdgcn_s_setprio(1); _Pragma("unroll") for (int m = 0; m < 4; ++m) _Pragma("unroll") for (int n = 0; n < 2; ++n) _Pragma("unroll") for (int k = 0; k < 2; ++k) \
        acc[ai][bj][m][n] = __builtin_amdgcn_mfma_f32_16x16x32_bf16(Bt[n][k], At[m][k], acc[ai][bj][m][n], 0, 0, 0); __builtin_amdgcn_s_setprio(0); } while (0)
#define PG8_WAIT_V(n) asm volatile("s_waitcnt vmcnt(" #n ")" ::: "memory")
#define PG8_WAIT_L(n) asm volatile("s_waitcnt lgkmcnt(" #n ")" ::: "memory")
#define PG8_BAR __builtin_amdgcn_s_barrier()
#define PG8_SCHED __builtin_amdgcn_sched_barrier(0)
    Unit cur, nxt; int ui = 0;
    if (!S.next(0, cur)) return;
    f32x4 acc[2][2][4][2];
#pragma unroll
    for (int a = 0; a < 2; ++a)
#pragma unroll
        for (int b = 0; b < 2; ++b)
#pragma unroll
            for (int m = 0; m < 4; ++m)
#pragma unroll
                for (int n = 0; n < 2; ++n) acc[a][b][m][n] = (f32x4){0.f, 0.f, 0.f, 0.f};
    bf16x8 At[4][2], B0[2][2], B1[2][2];
#pragma unroll
    for (int m = 0; m < 4; ++m)
#pragma unroll
        for (int k = 0; k < 2; ++k) asm volatile("" : "=v"(At[m][k]));
#pragma unroll
    for (int n = 0; n < 2; ++n)
#pragma unroll
        for (int k = 0; k < 2; ++k) { asm volatile("" : "=v"(B0[n][k])); asm volatile("" : "=v"(B1[n][k])); }
    const char* cA = (const char*)g.A + (size_t)cur.pm * tstepA; const char* cB = (const char*)g.Bt + (size_t)cur.pn * tstepB;
    S.a_ready(cur);
    if constexpr (SP2) {
        PG8_STAGE(PG8_SB(0, 0), cB, voffB); PG8_STAGE(PG8_SB(0, 1), cB + hstepB, voffB); PG8_STAGE(PG8_SA(0, 0), cA, voffA); PG8_STAGE(PG8_SA(0, 1), cA + hstepA, voffA);
        if (wr == 1) PG8_BAR;
        PG8_WAIT_V(2); PG8_BAR;
        PG8_STAGE(PG8_SB(1, 0), cB + kstep, voffB); PG8_STAGE(PG8_SA(1, 0), cA + kstep, voffA); PG8_STAGE(PG8_SB(1, 1), cB + hstepB + kstep, voffB);
        PG8_WAIT_V(6); PG8_BAR;
    } else {
        PG8_STAGE(PG8_SB(0, 0), cB, voffB); PG8_STAGE(PG8_SA(0, 0), cA, voffA); PG8_STAGE(PG8_SB(0, 1), cB + hstepB, voffB); PG8_STAGE(PG8_SA(0, 1), cA + hstepA, voffA);
        if (wr == 1) PG8_BAR;
        PG8_WAIT_V(4); PG8_BAR;
        PG8_STAGE(PG8_SB(1, 0), cB + kstep, voffB); PG8_STAGE(PG8_SA(1, 0), cA + kstep, voffA); PG8_STAGE(PG8_SB(1, 1), cB + hstepB + kstep, voffB);
        PG8_WAIT_V(6); PG8_BAR;
    }
    for (;;) {
        const bool has_next = S.next(ui + 1, nxt);
        const char* nA = has_next ? (const char*)g.A + (size_t)nxt.pm * tstepA : cA; const char* nB = has_next ? (const char*)g.Bt + (size_t)nxt.pn * tstepB : cB;
        for (int t = 0; t < nt; t += 2) {
            const bool last = (t == nt - 2);
            const char* a1 = cA + (size_t)(t + 1) * kstep;
            const char* a2 = last ? nA : cA + (size_t)(t + 2) * kstep; const char* b2 = last ? nB : cB + (size_t)(t + 2) * kstep;
            const char* a3 = a2 + kstep; const char* b3 = b2 + kstep;
            if (last && has_next) S.a_ready(nxt);
            if constexpr (SP2) {
            PG8_LDB(B0, 0, 0); PG8_LDB(B1, 0, 1); PG8_SCHED; PG8_LDA(At, 0, 0); PG8_STAGE(PG8_SA(1, 1), a1 + hstepA, voffA);
            PG8_WAIT_V(8); PG8_WAIT_L(0); PG8_BAR; PG8_MMA(0, 0, At, B0); PG8_MMA(0, 1, At, B1); PG8_BAR; PG8_SCHED;
            PG8_LDA(At, 0, 1); PG8_STAGE(PG8_SB(0, 0), b2, voffB); PG8_STAGE(PG8_SB(0, 1), b2 + hstepB, voffB); PG8_STAGE(PG8_SA(0, 0), a2, voffA);
            PG8_WAIT_V(8); PG8_WAIT_L(0); PG8_BAR; PG8_MMA(1, 0, At, B0); PG8_MMA(1, 1, At, B1); PG8_BAR; PG8_SCHED;
            PG8_LDB(B0, 1, 0); PG8_LDB(B1, 1, 1); PG8_SCHED; PG8_LDA(At, 1, 0); PG8_STAGE(PG8_SA(0, 1), a2 + hstepA, voffA);
            PG8_WAIT_V(8); PG8_WAIT_L(0); PG8_BAR; PG8_MMA(0, 0, At, B0); PG8_MMA(0, 1, At, B1); PG8_BAR; PG8_SCHED;
            PG8_LDA(At, 1, 1); PG8_STAGE(PG8_SB(1, 0), b3, voffB); PG8_STAGE(PG8_SB(1, 1), b3 + hstepB, voffB); PG8_STAGE(PG8_SA(1, 0), a3, voffA);
            PG8_WAIT_V(8); PG8_WAIT_L(0); PG8_BAR; PG8_MMA(1, 0, At, B0); PG8_MMA(1, 1, At, B1); PG8_BAR; PG8_SCHED;
            } else {
            PG8_LDB(B0, 0, 0); PG8_SCHED; PG8_LDA(At, 0, 0); PG8_STAGE(PG8_SA(1, 1), a1 + hstepA, voffA);
            PG8_WAIT_L(8); PG8_BAR; PG8_WAIT_L(0); PG8_MMA(0, 0, At, B0); PG8_BAR; PG8_SCHED;
            PG8_LDB(B1, 0, 1); PG8_STAGE(PG8_SB(0, 0), b2, voffB);
            PG8_BAR; PG8_WAIT_L(0); PG8_MMA(0, 1, At, B1); PG8_BAR;
            PG8_LDA(At, 0, 1); PG8_STAGE(PG8_SA(0, 0), a2, voffA);
            PG8_BAR; PG8_WAIT_L(0); PG8_MMA(1, 0, At, B0); PG8_BAR; PG8_SCHED;
            PG8_STAGE(PG8_SB(0, 1), b2 + hstepB, voffB);
            PG8_WAIT_V(6); PG8_BAR; PG8_MMA(1, 1, At, B1); PG8_BAR;
            PG8_LDB(B0, 1, 0); PG8_SCHED; PG8_LDA(At, 1, 0); PG8_STAGE(PG8_SA(0, 1), a2 + hstepA, voffA);
            PG8_WAIT_L(8); PG8_BAR; PG8_WAIT_L(0); PG8_MMA(0, 0, At, B0); PG8_BAR; PG8_SCHED;
            PG8_LDB(B1, 1, 1); PG8_STAGE(PG8_SB(1, 0), b3, voffB);
            PG8_BAR; PG8_WAIT_L(0); PG8_MMA(0, 1, At, B1); PG8_BAR;
            PG8_LDA(At, 1, 1); PG8_STAGE(PG8_SA(1, 0), a3, voffA);
            PG8_BAR; PG8_WAIT_L(0); PG8_MMA(1, 0, At, B0); PG8_BAR; PG8_SCHED;
            PG8_STAGE(PG8_SB(1, 1), b3 + hstepB, voffB);
            PG8_WAIT_V(6); PG8_BAR; PG8_MMA(1, 1, At, B1); PG8_BAR;
            }
        }
        if constexpr (ALIGN_EPI) { if (wr == 0) PG8_BAR; }
        if constexpr (!Epi::AFTER_DRAIN) { E(acc, cur, wr, wc, fr, fq); S.done(cur); }
        if (!has_next) break;
#pragma unroll
        for (int a = 0; a < 2; ++a)
#pragma unroll
            for (int b = 0; b < 2; ++b)
#pragma unroll
                for (int m = 0; m < 4; ++m)
#pragma unroll
                    for (int n = 0; n < 2; ++n) acc[a][b][m][n] = (f32x4){0.f, 0.f, 0.f, 0.f};
        cur = nxt; cA = nA; cB = nB; ++ui;
        if constexpr (ALIGN_EPI) { if (wr == 1) PG8_BAR; }
    }
    PG8_WAIT_V(0);
    if constexpr (!ALIGN_EPI) { if (wr == 0) PG8_BAR; }
    PG8_BAR;
    if constexpr (Epi::AFTER_DRAIN) { E.fused(acc, cur, wr, wc, fr, fq, lds, wid, lane); S.done(cur); }
    if constexpr (Epi::RT_DRAIN) { if (E.drain()) E.fused(acc, cur, wr, wc, fr, fq, lds, wid, lane); }
#undef PG8_SA
#undef PG8_SB
#undef PG8_STAGE
#undef PG8_LDA
#undef PG8_LDB
#undef PG8_MMA
#undef PG8_WAIT_V
#undef PG8_WAIT_L
#undef PG8_BAR
#undef PG8_SCHED
}
}
constexpr int NWAVES = 8;
constexpr int BATCH = 4, SEQ = 2048, DM = 2048, DEPTH = 2;
constexpr int M = BATCH * SEQ;
constexpr int GW = 512;
constexpr int IN_COLS = 5648, IN_PAD = 5888;
constexpr int DFF = 5632, MEML = 256, XH = 4, XHD = 512;
constexpr int MROWS = BATCH * MEML;
constexpr float EPS = 1e-6f;
constexpr int UA_B = 0, UA_C = 512, UA_H = 1024, UB = 1536, UC_Q = 2048, UC_Z = 3584, UC_A = 4096, UC_B = 4100, UD_Z = 4104, UD_X = 4616, UD_DT = 5640;
constexpr int MIX_PRE = 0, MIX_POST = 1, XA_PRE = 2, XA_POST = 3, MEM_NORM = 4, FFN_PRE = 5, FFN_POST = 6, N_NORMS = 7;
enum { I_X = 0, I_MEM, I_NORMG, I_WIN, I_CONVA, I_POOLW, I_POOLS, I_GCONV, I_GALOG, I_GDTB, I_GNG, I_SCONVW, I_SCONVB, I_SALOG, I_SDTB, I_SD, I_SNG, I_WOUT, I_WQ, I_WKV, I_WO, I_WGU, I_WD, N_IN };

constexpr size_t MiB = 1u << 20;
constexpr size_t WS_CTL = 0, CTL_ZERO_BYTES = 1 * MiB;
constexpr size_t WSZ_WIN = (size_t)IN_PAD * DM * 2, WSZ_SQ = (size_t)DM * DM * 2, WSZ_KV = (size_t)2 * DM * DM * 2, WSZ_GU = (size_t)2 * DFF * DM * 2, WSZ_D = (size_t)DM * DFF * 2;
constexpr size_t WO_WIN = 0, WO_WOUT = WO_WIN + WSZ_WIN, WO_WQ = WO_WOUT + WSZ_SQ, WO_WKV = WO_WQ + WSZ_SQ, WO_WO = WO_WKV + WSZ_KV, WO_WGU = WO_WO + WSZ_SQ, WO_WD = WO_WGU + WSZ_GU, W_LAYER = WO_WD + WSZ_D;
constexpr size_t WS_W = 1 * MiB;
constexpr size_t WS_XN = WS_W + 2 * W_LAYER;
constexpr size_t WS_MIX = WS_XN + (size_t)M * DM * 2;
constexpr size_t WS_MEMN = WS_MIX + (size_t)M * DM * 2;
constexpr size_t WS_KV = WS_MEMN + (size_t)2 * MROWS * DM * 2;
constexpr size_t WS_U = WS_KV + (size_t)2 * MROWS * 2 * DM * 2;
constexpr size_t WS_P = WS_U, WS_HID = WS_U + (size_t)M * DM * 2;
constexpr size_t WS_UEND = WS_U + (size_t)120 * MiB;
constexpr size_t WS_ZG = WS_UEND, WS_ZS = WS_ZG + (size_t)M * 512 * 2, WS_BS = WS_ZS + (size_t)M * 512 * 2, WS_CS = WS_BS + (size_t)M * 256 * 4;
constexpr size_t WS_SCR = WS_CS + (size_t)M * 256 * 4;
constexpr size_t WS_Y = WS_SCR;
constexpr size_t SZ512 = (size_t)M * 512 * 4, SZ256 = (size_t)M * 256 * 4, SZ8 = (size_t)M * 8 * 4;
constexpr size_t WS_QN = WS_SCR, WS_KN = WS_QN + SZ512, WS_VV = WS_KN + SZ512, WS_OG = WS_VV + SZ512, WS_XS = WS_OG + SZ512, WS_YS = WS_XS + SZ512,
                 WS_GB = WS_YS + SZ512, WS_DT = WS_GB + SZ8, WS_SCR_END = WS_DT + 2 * SZ8;
constexpr size_t WS_RS = WS_SCR_END;
constexpr size_t WS_AT = WS_RS + (size_t)M * 4, WS_VWT = WS_AT + (size_t)DEPTH * BATCH * 1024 * DM * 2, WS_END = WS_VWT + (size_t)DEPTH * BATCH * DM * 1024 * 2;
constexpr int LA_QD = 0, LA_QK = 16384, LA_KE = 24576, LA_NW = 40960, LA_UCG = 57344, LA_RECG = 90112;
constexpr int LA_UCS = 40960, LA_RECS = 57344;
constexpr size_t WS_FG = WS_U, WS_FS = WS_FG + (size_t)512 * LA_RECG, WS_DLG = WS_FS + (size_t)1024 * LA_RECS, WS_DLS = WS_DLG + 512 * 4, WS_FEND = WS_DLS + 1024 * 4;
static_assert(WS_FEND <= WS_UEND, "records inside U");
static_assert(WS_Y + (size_t)M * DM * 4 <= WS_SCR_END, "Y inside the scan region");
static_assert(WS_HID + (size_t)M * DFF * 2 <= WS_UEND && (size_t)M * IN_PAD * 2 <= (size_t)120 * MiB, "HID and U inside the U region");
static_assert(WS_END <= (size_t)704 * MiB, "d_ws map fits 4 x the largest input");

constexpr int RING_OFF = 0, RING_BYTES = 131072;
constexpr int LDSCTL_OFF = RING_BYTES, MISC_OFF = LDSCTL_OFF + 320;
constexpr int LDS_BYTES = 147456;
constexpr int CW_BAR = 4096;

#define GAS __attribute__((address_space(1)))
#define LAS __attribute__((address_space(3)))
typedef unsigned short bf16;
typedef unsigned v4u __attribute__((ext_vector_type(4)));
typedef unsigned v2u __attribute__((ext_vector_type(2)));
typedef float f32x4 __attribute__((ext_vector_type(4)));
typedef short bf16x8 __attribute__((ext_vector_type(8)));
#define LDS_WAIT() asm volatile("s_waitcnt lgkmcnt(0)" ::: "memory")
#define VM_WAIT() asm volatile("s_waitcnt vmcnt(0)" ::: "memory")
__device__ __forceinline__ unsigned f2bf(float f) { unsigned u = __builtin_bit_cast(unsigned, f); return (u + 0x7fffu + ((u >> 16) & 1u)) >> 16; }
__device__ __forceinline__ unsigned pk2(float lo, float hi) { return f2bf(lo) | (f2bf(hi) << 16); }
__device__ __forceinline__ float siluf(float v) { return v * __builtin_amdgcn_rcpf(1.0f + __expf(-v)); }
__device__ __forceinline__ float softplusf(float v) { return fmaxf(v, 0.f) + __logf(1.0f + __expf(-fabsf(v))); }
__device__ __forceinline__ float sigmoidf(float v) { return __builtin_amdgcn_rcpf(1.0f + __expf(-v)); }
__device__ __forceinline__ f32x4 ld4(const float* p) { return *(const f32x4*)p; }
__device__ __forceinline__ f32x4 silu4(f32x4 v) { return (f32x4){siluf(v.x), siluf(v.y), siluf(v.z), siluf(v.w)}; }
template <int CTRL> __device__ __forceinline__ float dppf(float v) { return __builtin_bit_cast(float, __builtin_amdgcn_update_dpp(0, __builtin_bit_cast(int, v), CTRL, 0xF, 0xF, true)); }
__device__ __forceinline__ float row16_sum(float v) { v += dppf<0xB1>(v); v += dppf<0x4E>(v); v += dppf<0x141>(v); v += dppf<0x140>(v); return v; }
__device__ __forceinline__ int opq(int v) { asm volatile("" : "+v"(v)); return v; }
__device__ __forceinline__ float shx(float v, int m, int lane) { return __builtin_bit_cast(float, __builtin_amdgcn_ds_bpermute((lane ^ m) << 2, __builtin_bit_cast(int, v))); }
__device__ __forceinline__ float wave_sum(float v) {
    v = row16_sum(v);
    const int iv = __builtin_bit_cast(int, v);
    return (__builtin_bit_cast(float, __builtin_amdgcn_readlane(iv, 0)) + __builtin_bit_cast(float, __builtin_amdgcn_readlane(iv, 16))) + (__builtin_bit_cast(float, __builtin_amdgcn_readlane(iv, 32)) + __builtin_bit_cast(float, __builtin_amdgcn_readlane(iv, 48)));
}

#define XB_TMO      128
#define XB_XCNT(j)  (256  + 64 * (j))
#define XB_XSUB(j)  (1280 + 64 * (j))
#define XB_XGEN(j)  (2304 + 64 * (j))
#define XB_TOP      3328
#define XB_TOPGEN   3392
#define XCD_BAR_WORDS 3456
#define XB_SPIN_CAP (1u << 18)

__device__ __forceinline__ unsigned xb_ld(unsigned* p)              { return __hip_atomic_load(p, __ATOMIC_RELAXED, __HIP_MEMORY_SCOPE_AGENT); }
__device__ __forceinline__ unsigned xb_add(unsigned* p, unsigned v) { return __hip_atomic_fetch_add(p, v, __ATOMIC_RELAXED, __HIP_MEMORY_SCOPE_AGENT); }
__device__ __forceinline__ unsigned xb_xcc_id() { return (unsigned)__builtin_amdgcn_s_getreg((3 << 11) | 20) & 0xFu; }
#define XB_SPIN(cond, bar) do { unsigned _sp = 0; while (cond) { __builtin_amdgcn_s_sleep(1); \
    if ((++_sp & 255u) == 0u) { if (xb_ld(&(bar)[XB_TMO])) break; if (_sp > XB_SPIN_CAP) { atomicAdd(&(bar)[XB_TMO], 1u); break; } } } } while (0)

struct XcdBarrier {
    unsigned* bar; unsigned x;
    volatile LAS unsigned* st;
};

__device__ __forceinline__ XcdBarrier xcd_barrier_post(unsigned* bar, volatile LAS unsigned* st) {
    XcdBarrier b; b.bar = bar; b.x = xb_xcc_id(); b.st = st;
    if (threadIdx.x == 0) (void)xb_add(&bar[XB_XCNT(b.x)], 1u);
    return b;
}
__device__ __forceinline__ void xcd_barrier_complete(unsigned* bar, unsigned x, unsigned& nloc, unsigned& nx) {
    const unsigned G = gridDim.x * gridDim.y * gridDim.z;
    unsigned sum, cnt, mine, sp = 0u;
    for (;;) {
        sum = 0u; cnt = 0u; mine = 0u;
#pragma unroll
        for (unsigned j = 0; j < 16; ++j) { const unsigned c = xb_ld(&bar[XB_XCNT(j)]); sum += c; cnt += (c > 0u) ? 1u : 0u; mine = (j == x) ? c : mine; }
        if (sum == G) break;
        __builtin_amdgcn_s_sleep(1);
        if ((++sp & 255u) == 0u) { if (xb_ld(&bar[XB_TMO])) break; if (sp > XB_SPIN_CAP) { atomicAdd(&bar[XB_TMO], 1u); break; } }
    }
    nloc = mine > 0u ? mine : 1u; nx = cnt > 0u ? cnt : 1u;
}

__device__ __forceinline__ void xcd_barrier(const XcdBarrier& b) {
    asm volatile("s_waitcnt vmcnt(0)" ::: "memory");
    __syncthreads();
    if (threadIdx.x == 0) {
        unsigned* bar = b.bar;
        __builtin_amdgcn_s_waitcnt(0);
        unsigned nloc = b.st[0], nx = b.st[1];
        if (nloc == 0u) { xcd_barrier_complete(bar, b.x, nloc, nx); b.st[0] = nloc; b.st[1] = nx; }
        const unsigned old = xb_add(&bar[XB_XSUB(b.x)], 1u);
        const unsigned gen = old / nloc;
        if (old + 1u == (gen + 1u) * nloc) {
            __builtin_amdgcn_fence(__ATOMIC_RELEASE, "agent");
            asm volatile("s_waitcnt vmcnt(0)" ::: "memory");
            const unsigned og = xb_add(&bar[XB_TOP], 1u);
            const unsigned tg = og / nx;
            if (og + 1u == (tg + 1u) * nx) xb_add(&bar[XB_TOPGEN], 1u);
            else XB_SPIN(xb_ld(&bar[XB_TOPGEN]) == tg, bar);
            __builtin_amdgcn_fence(__ATOMIC_ACQUIRE, "agent");
            xb_add(&bar[XB_XGEN(b.x)], 1u);
            asm volatile("s_waitcnt vmcnt(0)" ::: "memory");
        } else {
            XB_SPIN(xb_ld(&bar[XB_XGEN(b.x)]) == gen, bar);
            __builtin_amdgcn_fence(__ATOMIC_ACQUIRE, "agent");
            asm volatile("s_waitcnt vmcnt(0)" ::: "memory");
        }
    }
    __syncthreads();
}
struct Frame {
    LAS unsigned char* lds;
    volatile LAS unsigned* MISC;
    unsigned* ctl;
    int tid, lane, wave;
    int vcu, G;
    float* out; unsigned char* ws;
};
__device__ __forceinline__ const float* inp(int i) { const float* __attribute__((address_space(4))) const* tab = (const float* __attribute__((address_space(4))) const*)__builtin_amdgcn_kernarg_segment_ptr(); asm volatile("" : "+s"(tab)); return tab[i]; }
__device__ __forceinline__ bf16* wsb(const Frame& F, size_t off) { return (bf16*)(F.ws + off); }
__device__ __forceinline__ float* wsf(const Frame& F, size_t off) { return (float*)(F.ws + off); }

__device__ __forceinline__ void p0_transpose_item(const float* W, int K, int N, bf16* WT, int drow0, int k0, int n0, LAS float* scr, int lane, const float* gk = nullptr  ) {
    const int nn = n0 + (lane & 31); const bool ok = nn < N;
    float wv_[32];
#pragma unroll
    for (int i = 0; i < 32; ++i) { const int kk = 2 * i + (lane >> 5); wv_[i] = ok ? W[(size_t)(k0 + kk) * N + nn] : 0.f; }
#pragma unroll
    for (int i = 0; i < 32; ++i) { const int kk = 2 * i + (lane >> 5); scr[kk * 33 + (lane & 31)] = gk ? wv_[i] * gk[k0 + kk] : wv_[i]; }
    LDS_WAIT(); asm volatile("" ::: "memory");
    const int c = lane & 7;
#pragma unroll
    for (int j = 0; j < 4; ++j) { const int n = (lane >> 3) + 8 * j; const LAS float* s = scr + (8 * c) * 33 + n;
        v4u o; o.x = pk2(s[0 * 33], s[1 * 33]); o.y = pk2(s[2 * 33], s[3 * 33]); o.z = pk2(s[4 * 33], s[5 * 33]); o.w = pk2(s[6 * 33], s[7 * 33]);
        *(v4u*)(WT + (size_t)(drow0 + n) * K + k0 + 8 * c) = o; }
    LDS_WAIT(); asm volatile("" ::: "memory");
}
__device__ __forceinline__ void norm_row_to_bf16(const float* xrow, const float* g, bf16* orow, int lane) {
    const f32x4* xr = (const f32x4*)xrow + lane; const f32x4* gr = (const f32x4*)g + lane;
    f32x4 v[8]; float s = 0.f;
#pragma unroll
    for (int j = 0; j < 8; ++j) { v[j] = xr[64 * j]; s += (v[j].x * v[j].x + v[j].y * v[j].y) + (v[j].z * v[j].z + v[j].w * v[j].w); }
    const float rstd = __builtin_amdgcn_rsqf(wave_sum(s) * (1.0f / DM) + EPS);
    v2u* o8 = (v2u*)orow + lane;
#pragma unroll
    for (int j = 0; j < 8; ++j) { const f32x4 gg = gr[64 * j]; v2u w; w.x = pk2(v[j].x * rstd * gg.x, v[j].y * rstd * gg.y); w.y = pk2(v[j].z * rstd * gg.z, v[j].w * rstd * gg.w); o8[64 * j] = w; }
}
__device__ __forceinline__ void p0_prologue(Frame& F, int part) {
    LAS float* scr = (LAS float*)(F.lds + RING_OFF + F.wave * 16384);
    const int vb = part ? 64 : 0;
    if (F.vcu < vb) return;
    const int gw = (F.vcu - vb) * NWAVES + F.wave, NGW = (F.G - vb) * NWAVES; const int lane = opq(F.lane), tid = opq(F.tid);
    const int gt = (F.vcu - vb) * NWAVES * 64 + tid, NGT = NGW * 64;
    constexpr int NB_IN = (IN_COLS + 31) / 32;
    constexpr int I_IN = (DM / 64) * NB_IN, I_SQ = (DM / 64) * (DM / 32), I_KV = (DM / 64) * (2 * DM / 32), I_GU = (DM / 64) * (2 * DFF / 32), I_D = (DFF / 64) * (DM / 32);
    constexpr int I_LAYER = I_IN + 2 * I_SQ + I_KV + I_GU + I_D;
    for (int it = gw; it < I_LAYER; it += NGW) {
        const int l = part; int r = it;
        bf16* wl = wsb(F, WS_W + (size_t)l * W_LAYER);
        if (r < I_IN) { const int kb = r / NB_IN, nb = r % NB_IN; p0_transpose_item(inp(I_WIN) + (size_t)l * DM * IN_COLS, DM, IN_COLS, (bf16*)((char*)wl + WO_WIN), 32 * nb, 64 * kb, 32 * nb, scr, lane, inp(I_NORMG) + (size_t)(l * N_NORMS + MIX_PRE) * DM); continue; } r -= I_IN;
        if (r < I_SQ) { const int kb = r / (DM / 32), nb = r % (DM / 32); p0_transpose_item(inp(I_WOUT) + (size_t)l * DM * DM, DM, DM, (bf16*)((char*)wl + WO_WOUT), 32 * nb, 64 * kb, 32 * nb, scr, lane); continue; } r -= I_SQ;
        if (r < I_SQ) { const int kb = r / (DM / 32), nb = r % (DM / 32); p0_transpose_item(inp(I_WO) + (size_t)l * DM * DM, DM, DM, (bf16*)((char*)wl + WO_WO), 32 * nb, 64 * kb, 32 * nb, scr, lane); continue; } r -= I_SQ;
        if (r < I_KV) { const int kb = r / (2 * DM / 32), nb = r % (2 * DM / 32); p0_transpose_item(inp(I_WKV) + (size_t)l * DM * 2 * DM, DM, 2 * DM, (bf16*)((char*)wl + WO_WKV), 32 * nb, 64 * kb, 32 * nb, scr, lane); continue; } r -= I_KV;
        if (r < I_GU) { const int kb = r / (2 * DFF / 32), nb = r % (2 * DFF / 32); const int n0 = 32 * nb; const int up = n0 >= DFF ? 1 : 0, j0 = n0 - up * DFF;
            const int drow = (j0 >> 7) * 256 + up * 128 + (j0 & 127);
            p0_transpose_item(inp(I_WGU) + (size_t)l * DM * 2 * DFF, DM, 2 * DFF, (bf16*)((char*)wl + WO_WGU), drow, 64 * kb, n0, scr, lane, inp(I_NORMG) + (size_t)(l * N_NORMS + FFN_PRE) * DM); continue; } r -= I_GU;
        { const int kb = r / (DM / 32), nb = r % (DM / 32); p0_transpose_item(inp(I_WD) + (size_t)l * DFF * DM, DFF, DM, (bf16*)((char*)wl + WO_WD), 32 * nb, 64 * kb, 32 * nb, scr, lane); }
    }
    for (int i = gt; i < DM * DM / 8; i += NGT) { const int l = part, k = i;
        const float* src = inp(I_WQ) + (size_t)l * DM * DM + (size_t)k * 8; const float gq = inp(I_NORMG)[(size_t)(l * N_NORMS + XA_PRE) * DM + (k >> 8)]; const f32x4 a = ld4(src) * gq, b = ld4(src + 4) * gq;
        v4u o; o.x = pk2(a.x, a.y); o.y = pk2(a.z, a.w); o.z = pk2(b.x, b.y); o.w = pk2(b.z, b.w);
        ((v4u*)(F.ws + WS_W + (size_t)l * W_LAYER + WO_WQ))[k] = o; }
    { constexpr int ZR0 = 32 * NB_IN, ZN = (IN_PAD - ZR0) * DM / 8;
      const unsigned z0 = (unsigned)opq(0); const v4u zz = {z0, z0, z0, z0};
      for (int i = gt; i < ZN; i += NGT) { const int l = part, k = i;
          ((v4u*)(F.ws + WS_W + (size_t)l * W_LAYER + WO_WIN + (size_t)ZR0 * DM * 2))[k] = zz; } }
    if (part) return;
    for (int m = gw; m < DEPTH * MROWS; m += NGW) { const int l = m / MROWS, r = m % MROWS;
        norm_row_to_bf16(inp(I_MEM) + (size_t)r * DM, inp(I_NORMG) + (size_t)(l * N_NORMS + MEM_NORM) * DM, wsb(F, WS_MEMN) + (size_t)m * DM, lane); }
    for (int m = gw; m < M; m += NGW) { const f32x4* xr = (const f32x4*)(inp(I_X) + (size_t)m * DM) + 2 * lane; v4u* xb = (v4u*)(wsb(F, WS_XN) + (size_t)m * DM) + lane; float ss = 0.f;
#pragma unroll
        for (int j = 0; j < 4; ++j) { const f32x4 a = xr[128 * j], b = xr[128 * j + 1]; ss += ((a.x * a.x + a.y * a.y) + (a.z * a.z + a.w * a.w)) + ((b.x * b.x + b.y * b.y) + (b.z * b.z + b.w * b.w));
            v4u o; o.x = pk2(a.x, a.y); o.y = pk2(a.z, a.w); o.z = pk2(b.x, b.y); o.w = pk2(b.z, b.w); xb[64 * j] = o; }
        ss = wave_sum(ss); if (lane == 0) wsf(F, WS_RS)[m] = __builtin_amdgcn_rsqf(ss * (1.0f / DM) + EPS); }
}

struct f32x8 { f32x4 lo, hi; };
__device__ __forceinline__ f32x8 ldu8(const bf16* p) { const v4u w = *(const v4u*)p; f32x8 r;
    r.lo = (f32x4){__builtin_bit_cast(float, w.x << 16), __builtin_bit_cast(float, w.x & 0xffff0000u), __builtin_bit_cast(float, w.y << 16), __builtin_bit_cast(float, w.y & 0xffff0000u)};
    r.hi = (f32x4){__builtin_bit_cast(float, w.z << 16), __builtin_bit_cast(float, w.z & 0xffff0000u), __builtin_bit_cast(float, w.w << 16), __builtin_bit_cast(float, w.w & 0xffff0000u)}; return r; }
__device__ __forceinline__ f32x8 cvt8(const v4u w) { f32x8 r;
    r.lo = (f32x4){__builtin_bit_cast(float, w.x << 16), __builtin_bit_cast(float, w.x & 0xffff0000u), __builtin_bit_cast(float, w.y << 16), __builtin_bit_cast(float, w.y & 0xffff0000u)};
    r.hi = (f32x4){__builtin_bit_cast(float, w.z << 16), __builtin_bit_cast(float, w.z & 0xffff0000u), __builtin_bit_cast(float, w.w << 16), __builtin_bit_cast(float, w.w & 0xffff0000u)}; return r; }
__device__ __forceinline__ f32x8 ld8f(const float* p) { f32x8 r; r.lo = ld4(p); r.hi = ld4(p + 4); return r; }
__device__ __forceinline__ f32x8 operator*(const f32x8& a, const f32x8& b) { return f32x8{a.lo * b.lo, a.hi * b.hi}; }
__device__ __forceinline__ f32x8 operator+(const f32x8& a, const f32x8& b) { return f32x8{a.lo + b.lo, a.hi + b.hi}; }
__device__ __forceinline__ f32x8 silu8(const f32x8& a) { return f32x8{silu4(a.lo), silu4(a.hi)}; }
__device__ __forceinline__ float sumsq8(const f32x8& y) { return ((y.lo.x * y.lo.x + y.lo.y * y.lo.y) + (y.lo.z * y.lo.z + y.lo.w * y.lo.w)) + ((y.hi.x * y.hi.x + y.hi.y * y.hi.y) + (y.hi.z * y.hi.z + y.hi.w * y.hi.w)); }
__device__ __forceinline__ v4u pack8u(const f32x8& y) { v4u o; o.x = pk2(y.lo.x, y.lo.y); o.y = pk2(y.lo.z, y.lo.w); o.z = pk2(y.hi.x, y.hi.y); o.w = pk2(y.hi.z, y.hi.w); return o; }
__device__ __forceinline__ void mixer_prep_phase(Frame& F, int l) {
    const int gw = F.vcu * NWAVES + F.wave, NGW = F.G * NWAVES, lane = opq(F.lane), tid = opq(F.tid);
    const bf16* U = wsb(F, WS_U);
    bf16* MIX = wsb(F, WS_MIX);
    constexpr int NSTRIP = M / 16, NTYPE = 12;
    for (int it = gw; it < NTYPE * NSTRIP; it += NGW) {
        const int type = it % NTYPE, strip = it / NTYPE, r0 = strip * 16, pos0 = r0 & (SEQ - 1), c = lane * 8;
        const bf16* ur0 = U + (size_t)r0 * IN_PAD;
        if (type == 0) {
            const float* cw = inp(I_CONVA) + (size_t)l * 3 * GW + c;
            const f32x8 w0 = ld8f(cw), w1 = ld8f(cw + GW), w2 = ld8f(cw + 2 * GW);
            const v4u z4 = {0u, 0u, 0u, 0u};
#pragma unroll 1
            for (int hf = 0; hf < 2; ++hf) {
                const bf16* ub = ur0 + (size_t)(8 * hf) * IN_PAD;
                v4u rc[10], rh[10], rb[8];
#pragma unroll
                for (int i = 0; i < 10; ++i) { const int ri = i - 2; if (ri >= 0 || pos0 > 0 || hf > 0) { rc[i] = *(const v4u*)(ub + (ptrdiff_t)ri * IN_PAD + UA_C + c); rh[i] = *(const v4u*)(ub + (ptrdiff_t)ri * IN_PAD + UA_H + c); } else { rc[i] = z4; rh[i] = z4; } }
#pragma unroll
                for (int i = 0; i < 8; ++i) rb[i] = *(const v4u*)(ub + (size_t)i * IN_PAD + UA_B + c);
                f32x8 p2 = cvt8(rc[0]) * cvt8(rh[0]), p1 = cvt8(rc[1]) * cvt8(rh[1]);
#pragma unroll
                for (int i = 0; i < 8; ++i) { const f32x8 p0 = cvt8(rc[i + 2]) * cvt8(rh[i + 2]); const f32x8 y = cvt8(rb[i]) * (w0 * p2 + w1 * p1 + w2 * p0);
                    *(v4u*)(MIX + (size_t)(r0 + 8 * hf + i) * DM + c) = pack8u(y); p2 = p1; p1 = p0; }
            }
        } else if (type < 4) {
            const int gi = type - 1, cc = gi * GW + c;
            const float* cw = inp(I_GCONV) + (size_t)l * 4 * 3 * GW + cc;
            const f32x8 w0 = ld8f(cw), w1 = ld8f(cw + 3 * GW), w2 = ld8f(cw + 6 * GW), w3 = ld8f(cw + 9 * GW);
            v4u xr[19];
#pragma unroll
            for (int i = 0; i < 19; ++i) { const int ri = i - 3; if (ri >= 0 || pos0 > 0) xr[i] = *(const v4u*)(ur0 + (ptrdiff_t)ri * IN_PAD + UC_Q + cc); else xr[i] = (v4u){0u, 0u, 0u, 0u}; }
            float* dst = (gi == 0) ? wsf(F, WS_QN) : (gi == 1) ? wsf(F, WS_KN) : wsf(F, WS_VV);
            const float qs = (gi == 0) ? 0.08838834764831845f : 1.0f;
            f32x8 x3 = cvt8(xr[0]), x2 = cvt8(xr[1]), x1 = cvt8(xr[2]);
#pragma unroll
            for (int i = 0; i < 16; ++i) { const f32x8 x0 = cvt8(xr[i + 3]); f32x8 y = silu8(w0 * x3 + w1 * x2 + w2 * x1 + w3 * x0); x3 = x2; x2 = x1; x1 = x0;
                if (gi < 2) { float ss = row16_sum(sumsq8(y));
                    const float sc = qs * __builtin_amdgcn_rsqf(ss + EPS); y.lo = y.lo * sc; y.hi = y.hi * sc; }
                float* d = dst + (size_t)(r0 + i) * GW + c; *(f32x4*)d = y.lo; *(f32x4*)(d + 4) = y.hi; }
        } else if (type < 6) {
            const int gi = type - 4, cc = gi * GW + c;
            const float* cw = inp(I_SCONVW) + (size_t)l * 4 * 1024 + cc;
            const f32x8 w0 = ld8f(cw), w1 = ld8f(cw + 1024), w2 = ld8f(cw + 2048), w3 = ld8f(cw + 3072), bb = ld8f(inp(I_SCONVB) + (size_t)l * 1024 + cc);
            v4u xr[19];
#pragma unroll
            for (int i = 0; i < 19; ++i) { const int ri = i - 3; if (ri >= 0 || pos0 > 0) xr[i] = *(const v4u*)(ur0 + (ptrdiff_t)ri * IN_PAD + UD_X + cc); else xr[i] = (v4u){0u, 0u, 0u, 0u}; }
            f32x8 x3 = cvt8(xr[0]), x2 = cvt8(xr[1]), x1 = cvt8(xr[2]);
            float* dst; int ld, co;
            if (gi == 0) { dst = wsf(F, WS_XS); ld = 512; co = c; } else if (c < 256) { dst = wsf(F, WS_BS); ld = 256; co = c; } else { dst = wsf(F, WS_CS); ld = 256; co = c - 256; }
#pragma unroll
            for (int i = 0; i < 16; ++i) { const f32x8 x0 = cvt8(xr[i + 3]); const f32x8 y = silu8(w0 * x3 + w1 * x2 + w2 * x1 + w3 * x0 + bb); x3 = x2; x2 = x1; x1 = x0;
                float* d = dst + (size_t)(r0 + i) * ld + co; *(f32x4*)d = y.lo; *(f32x4*)(d + 4) = y.hi; }
        } else if (type < 8) {
            const int zo = (type == 6) ? UC_Z : UD_Z; bf16* dst = wsb(F, (type == 6) ? WS_ZG : WS_ZS);
            v4u z[16];
#pragma unroll
            for (int i = 0; i < 16; ++i) z[i] = *(const v4u*)(ur0 + (size_t)i * IN_PAD + zo + c);
#pragma unroll
            for (int i = 0; i < 16; ++i) *(v4u*)(dst + (size_t)(r0 + i) * GW + c) = z[i];
        } else {
            const int gi = type - 8, w = 2 << gi;
            LAS float* scr = (LAS float*)(F.lds + RING_OFF + F.wave * 16384);
            const int c0 = UB + gi * 128 + lane * 2;
            float uv0[31], uv1[31];
#pragma unroll
            for (int i = 0; i < 31; ++i) { const int ri = i - 15; float a0 = 0.f, a1 = 0.f;
                if (ri >= 0 || pos0 > 0) { const unsigned wd = *(const unsigned*)(ur0 + (ptrdiff_t)ri * IN_PAD + c0); a0 = __builtin_bit_cast(float, wd << 16); a1 = __builtin_bit_cast(float, wd & 0xffff0000u); }
                uv0[i] = a0; uv1[i] = a1; }
            float r0s = 0.f, r1s = 0.f;
#pragma unroll
            for (int s = 1; s < 16; ++s) if (s < w) { r0s += uv0[15 - s]; r1s += uv1[15 - s]; }
#pragma unroll
            for (int i = 0; i < 16; ++i) { const int pos = pos0 + i; const float a0 = uv0[15 + i], a1 = uv1[15 + i];
                r0s += a0; r1s += a1;
                const float cnt = (float)((pos + 1 < w) ? pos + 1 : w);
                const float rc = __builtin_amdgcn_rcpf(cnt); scr[i * 128 + lane * 2] = r0s * rc - a0; scr[i * 128 + lane * 2 + 1] = r1s * rc - a1;
                float d0 = 0.f, d1 = 0.f;
#pragma unroll
                for (int g2 = 0; g2 < 4; ++g2) if (gi == g2) { d0 = uv0[15 + i - (2 << g2) + 1]; d1 = uv1[15 + i - (2 << g2) + 1]; }
                r0s -= d0; r1s -= d1; }
            LDS_WAIT(); asm volatile("" ::: "memory");
            float acc0[16], acc1[16];
#pragma unroll
            for (int i = 0; i < 16; ++i) { acc0[i] = 0.f; acc1[i] = 0.f; }
            const float* pw = inp(I_POOLW) + ((size_t)l * 4 + gi) * 128 * 128;
            for (int cc = 0; cc < 128; cc += 4) {
                float wa[4], wb[4];
#pragma unroll
                for (int q = 0; q < 4; ++q) { wa[q] = pw[(size_t)(cc + q) * 128 + lane]; wb[q] = pw[(size_t)(cc + q) * 128 + 64 + lane]; }
#pragma unroll
                for (int i = 0; i < 16; ++i) { const f32x4 p = *(const LAS f32x4*)(scr + i * 128 + cc);
                    acc0[i] += p.x * wa[0] + p.y * wa[1] + p.z * wa[2] + p.w * wa[3]; acc1[i] += p.x * wb[0] + p.y * wb[1] + p.z * wb[2] + p.w * wb[3]; }
            }
            const float s0 = inp(I_POOLS)[(size_t)l * GW + gi * 128 + lane], s1 = inp(I_POOLS)[(size_t)l * GW + gi * 128 + 64 + lane];
#pragma unroll
            for (int i = 0; i < 16; ++i) { bf16* o = MIX + (size_t)(r0 + i) * DM + GW + gi * 128; o[lane] = (bf16)f2bf(acc0[i] * s0); o[64 + lane] = (bf16)f2bf(acc1[i] * s1); }
            LDS_WAIT(); asm volatile("" ::: "memory");
        }
    }
    for (int i = (F.vcu * NWAVES * 64) + tid; i < M * 16; i += F.G * NWAVES * 64) { const int t = i >> 4, j = i & 15; const bf16* ur = U + (size_t)t * IN_PAD;
#define UF(col) __builtin_bit_cast(float, (unsigned)ur[col] << 16)
        if (j < 4) { wsf(F, WS_GB)[(size_t)t * 8 + 2 * j] = -__expf(inp(I_GALOG)[l * 4 + j]) * softplusf(UF(UC_A + j) + inp(I_GDTB)[l * 4 + j]); }
        else if (j < 8) { wsf(F, WS_GB)[(size_t)t * 8 + 2 * (j - 4) + 1] = sigmoidf(UF(UC_B + (j - 4))); }
        else { const int hh = j - 8; const float dt = softplusf(UF(UD_DT + hh) + inp(I_SDTB)[l * 8 + hh]);
            wsf(F, WS_DT)[(size_t)t * 16 + 2 * hh] = -__expf(inp(I_SALOG)[l * 8 + hh]) * dt; wsf(F, WS_DT)[(size_t)t * 16 + 2 * hh + 1] = dt; }
#undef UF
    }
}

typedef float f32x16 __attribute__((ext_vector_type(16)));
typedef float f32x2v __attribute__((ext_vector_type(2)));
typedef __bf16 bf16x2_t __attribute__((ext_vector_type(2)));
__device__ __forceinline__ unsigned cvtpk(float lo, float hi) { const f32x2v v = {lo, hi}; return __builtin_bit_cast(unsigned, __builtin_convertvector(v, bf16x2_t)); }
__device__ __forceinline__ bf16x8 pack8(float a0, float a1, float a2, float a3, float a4, float a5, float a6, float a7) { v4u w; w.x = cvtpk(a0, a1); w.y = cvtpk(a2, a3); w.z = cvtpk(a4, a5); w.w = cvtpk(a6, a7); return __builtin_bit_cast(bf16x8, w); }
#define PACK_STEP(x, s) pack8((x)[8 * (s)], (x)[8 * (s) + 1], (x)[8 * (s) + 2], (x)[8 * (s) + 3], (x)[8 * (s) + 4], (x)[8 * (s) + 5], (x)[8 * (s) + 6], (x)[8 * (s) + 7])
#define MFMA32(a, b, c) __builtin_amdgcn_mfma_f32_32x32x16_bf16((a), (b), (c), 0, 0, 0)
__device__ __forceinline__ int crow(int reg, int h) { return (reg & 3) + 8 * (reg >> 2) + 4 * h; }
constexpr int LA_KB = 0;
constexpr int LA_QB = LA_KB + 64 * 136 * 2;
constexpr int LA_KGT = LA_QB + 64 * 136 * 2;
constexpr int LA_VBT = LA_KGT + 128 * 72 * 2;
constexpr int LA_KET = LA_VBT + 128 * 72 * 2;
constexpr int LA_M = LA_KET + 128 * 72 * 2;
constexpr int LA_TB = LA_M + 64 * 68 * 4;
constexpr int LA_VEC = LA_TB + 64 * 72 * 2;
static_assert(LA_VEC + 1024 <= RING_BYTES, "la LDS map");
__device__ __forceinline__ bf16x8 lds_frag(const LAS unsigned char* base, int row, int stride_el, int col) { return *(const LAS bf16x8*)(base + ((size_t)row * stride_el + col) * 2); }
__device__ __forceinline__ float wave_incl_scan(float v, int lane) {
#pragma unroll
    for (int d = 1; d < 64; d <<= 1) { const float o = __builtin_bit_cast(float, __builtin_amdgcn_ds_bpermute((lane - d) << 2, __builtin_bit_cast(int, v))); if (lane >= d) v += o; }
    return v;
}
__device__ __forceinline__ void store_qk_frag(const f32x16& acc, const LAS float* Gv, int mt, int rt, int r, int h, int lane, bf16* qkf) {
    const int l = 32 * rt + r; const float Gl = Gv[l];
    float v[16];
#pragma unroll
    for (int q = 0; q < 16; ++q) { const int m = 32 * mt + crow(q, h); v[q] = (m <= l) ? acc[q] * __expf(Gl - Gv[m]) : 0.f; }
    *(bf16x8*)(qkf + ((size_t)(rt * 4 + 2 * mt + 0) * 64 + lane) * 8) = pack8(v[0], v[1], v[2], v[3], v[4], v[5], v[6], v[7]);
    *(bf16x8*)(qkf + ((size_t)(rt * 4 + 2 * mt + 1) * 64 + lane) * 8) = pack8(v[8], v[9], v[10], v[11], v[12], v[13], v[14], v[15]);
}
__device__ __forceinline__ void qd_frag_task(const float* qrows, int ldq, const LAS float* Gv, int task, int r, int h, int lane, bf16* qdf) {
    const int rt = task >> 3, ks = task & 7, l = 32 * rt + r, k0 = 16 * ks + 4 * h; const float e = __expf(Gv[l]);
    const f32x4 a = ld4(qrows + (size_t)l * ldq + k0), b = ld4(qrows + (size_t)l * ldq + k0 + 8);
    *(bf16x8*)(qdf + ((size_t)task * 64 + lane) * 8) = pack8(a.x * e, a.y * e, a.z * e, a.w * e, b.x * e, b.y * e, b.z * e, b.w * e);
}
__device__ __forceinline__ void qd_frag_task4(const float* qrows, int ldq, const LAS float* Gv, int task0, int r, int h, int lane, bf16* qdf) {
    f32x4 a[4], b[4]; float e[4];
#pragma unroll
    for (int t = 0; t < 4; ++t) { const int task = task0 + t, rt = task >> 3, ks = task & 7, l = 32 * rt + r, k0 = 16 * ks + 4 * h;
        a[t] = ld4(qrows + (size_t)l * ldq + k0); b[t] = ld4(qrows + (size_t)l * ldq + k0 + 8); e[t] = __expf(Gv[l]); }
#pragma unroll
    for (int t = 0; t < 4; ++t) *(bf16x8*)(qdf + ((size_t)(task0 + t) * 64 + lane) * 8) = pack8(a[t].x * e[t], a[t].y * e[t], a[t].z * e[t], a[t].w * e[t], b[t].x * e[t], b[t].y * e[t], b[t].z * e[t], b[t].w * e[t]);
}
__device__ __forceinline__ void ke_frag_task(const LAS unsigned char* ket, int task, int r, int h, int lane, bf16* kef) {
    const int it = task >> 2, ks = task & 3, dk = 32 * it + r, l0 = 16 * ks + 4 * h;
    const v2u lo = *(const LAS v2u*)(ket + ((size_t)dk * 72 + l0) * 2), hi = *(const LAS v2u*)(ket + ((size_t)dk * 72 + l0 + 8) * 2);
    v4u w; w.x = lo.x; w.y = lo.y; w.z = hi.x; w.w = hi.y;
    *(v4u*)(kef + ((size_t)task * 64 + lane) * 8) = w;
}

#ifndef LAREP
#define LAREP 0
#endif
#define LDS_SYNC() do { asm volatile("s_waitcnt lgkmcnt(0)" ::: "memory"); __builtin_amdgcn_s_barrier(); asm volatile("" ::: "memory"); } while (0)
__device__ __forceinline__ void la_prep_phase(Frame& F, int l_unused) {
    const int tid0 = opq(F.tid), wv = F.wave;
    LAS unsigned char* L = F.lds + RING_OFF; asm volatile("" : "+v"(L));
    LAS float* Gv = (LAS float*)(L + LA_VEC); LAS float* Bv = Gv + 64;
    LAS float* Mf = (LAS float*)(L + LA_M);
    const f32x16 zero16 = {0.f, 0.f, 0.f, 0.f, 0.f, 0.f, 0.f, 0.f, 0.f, 0.f, 0.f, 0.f, 0.f, 0.f, 0.f, 0.f};
    for (int item = F.vcu; item < 512; item += F.G) {
        const int tid = opq(tid0), lane = tid & 63, r = lane & 31, h = lane >> 5;
        const int seq = item >> 5, ch = item & 31, b = seq >> 2, hd = seq & 3;
        const size_t t0 = (size_t)b * SEQ + ch * 64;
        const float* KN = wsf(F, WS_KN) + t0 * GW + hd * 128; const float* QN = wsf(F, WS_QN) + t0 * GW + hd * 128; const float* VV = wsf(F, WS_VV) + t0 * GW + hd * 128;
        unsigned char* rec = F.ws + WS_FG + (size_t)item * LA_RECG;
        const int c = tid & 127, lg = tid >> 7;
        const f32x2v gb = *(const f32x2v*)(wsf(F, WS_GB) + (t0 + lane) * 8 + 2 * hd);
        float kr[16], qr[16], vr[16];
#pragma unroll
        for (int i = 0; i < 16; ++i) { const int l = lg * 16 + i; kr[i] = KN[(size_t)l * GW + c]; qr[i] = QN[(size_t)l * GW + c]; vr[i] = VV[(size_t)l * GW + c]; }
        f32x4 qa[4], qb[4];
        { const int qw = (wv >= 2 && wv <= 5) ? wv - 2 : 0;
#pragma unroll
            for (int t = 0; t < 4; ++t) { const int task = 4 * qw + t, rt = task >> 3, ks = task & 7, l = 32 * rt + r, k0 = 16 * ks + 4 * h; qa[t] = ld4(QN + (size_t)l * GW + k0); qb[t] = ld4(QN + (size_t)l * GW + k0 + 8); } }
        if (wv == 0) { Gv[lane] = wave_incl_scan(gb.x, lane); Bv[lane] = gb.y; }
        LDS_SYNC();
        const float G63 = Gv[63];
#pragma unroll
        for (int i = 0; i < 16; ++i) { const int l = lg * 16 + i; const float kv = kr[i], qv = qr[i], vv = vr[i];
            const float Gl = Gv[l], bl = Bv[l];
            ((LAS bf16*)(L + LA_KB))[l * 136 + c] = (bf16)f2bf(kv); ((LAS bf16*)(L + LA_QB))[l * 136 + c] = (bf16)f2bf(qv);
            ((LAS bf16*)(L + LA_KGT))[c * 72 + l] = (bf16)f2bf(-kv * bl * __expf(Gl)); ((LAS bf16*)(L + LA_VBT))[c * 72 + l] = (bf16)f2bf(vv * bl);
            ((LAS bf16*)(L + LA_KET))[c * 72 + l] = (bf16)f2bf(kv * __expf(G63 - Gl)); }
        LDS_SYNC();
        if (wv < 4) { const int it = wv >> 1, jt = wv & 1; f32x16 acc = zero16;
            if (!(it == 0 && jt == 1)) {
#pragma unroll
                for (int ks = 0; ks < 8; ++ks) acc = MFMA32(lds_frag(L + LA_KB, 32 * it + r, 136, 16 * ks + 8 * h), lds_frag(L + LA_KB, 32 * jt + r, 136, 16 * ks + 8 * h), acc); }
            const int j = 32 * jt + r; const float Gj = Gv[j];
#pragma unroll
            for (int q = 0; q < 16; ++q) { const int i = 32 * it + crow(q, h); Mf[i * 68 + j] = (j < i) ? Bv[i] * acc[q] * __expf(Gv[i] - Gj) : 0.f; }
        } else { const int mt = (wv - 4) >> 1, rt = (wv - 4) & 1; f32x16 acc = zero16;
            if (!(mt == 1 && rt == 0)) {
#pragma unroll
                for (int ks = 0; ks < 8; ++ks) acc = MFMA32(lds_frag(L + LA_KB, 32 * mt + r, 136, 16 * ks + 8 * h), lds_frag(L + LA_QB, 32 * rt + r, 136, 16 * ks + 8 * h), acc); }
            store_qk_frag(acc, Gv, mt, rt, r, h, lane, (bf16*)(rec + LA_QK)); }
        LDS_SYNC();
        f32x16 Pacc = zero16;
        if (wv < 2) {
            const int ln = opq(lane), cc = ln & 31, bo = 32 * wv;
            float Tc[32];
#pragma unroll
            for (int i = 0; i < 32; ++i) {
                float a0 = (i == cc) ? 1.f : 0.f, a1 = 0.f, a2 = 0.f, a3 = 0.f;
#pragma unroll
                for (int j4 = 0; j4 < (i + 3) / 4; ++j4) { const f32x4 m = *(const LAS f32x4*)(Mf + (bo + i) * 68 + bo + 4 * j4);
                    a0 -= m.x * Tc[4 * j4]; if (4 * j4 + 1 < i) a1 -= m.y * Tc[4 * j4 + 1]; if (4 * j4 + 2 < i) a2 -= m.z * Tc[4 * j4 + 2]; if (4 * j4 + 3 < i) a3 -= m.w * Tc[4 * j4 + 3]; }
                Tc[i] = (a0 + a1) + (a2 + a3);
                ((LAS bf16*)(L + LA_TB))[(bo + i) * 72 + bo + cc] = (bf16)f2bf(Tc[i]);
                if (wv == 0) ((LAS bf16*)(L + LA_TB))[i * 72 + 32 + cc] = (bf16)0;
                if ((i & 7) == 7) asm volatile("" ::: "memory");
            }
            if (wv == 0) {
#pragma unroll
                for (int s2 = 0; s2 < 2; ++s2) {
                    const LAS float* mr = Mf + (32 + r) * 68 + 16 * s2 + 8 * h; const f32x4 m0 = *(const LAS f32x4*)mr, m1 = *(const LAS f32x4*)(mr + 4);
                    const bf16x8 af = pack8(m0.x, m0.y, m0.z, m0.w, m1.x, m1.y, m1.z, m1.w);
                    const bf16x8 bfr = h ? pack8(Tc[16 * s2 + 8], Tc[16 * s2 + 9], Tc[16 * s2 + 10], Tc[16 * s2 + 11], Tc[16 * s2 + 12], Tc[16 * s2 + 13], Tc[16 * s2 + 14], Tc[16 * s2 + 15])
                                          : pack8(Tc[16 * s2 + 0], Tc[16 * s2 + 1], Tc[16 * s2 + 2], Tc[16 * s2 + 3], Tc[16 * s2 + 4], Tc[16 * s2 + 5], Tc[16 * s2 + 6], Tc[16 * s2 + 7]);
                    Pacc = MFMA32(af, bfr, Pacc); }
                if (lane == 0) wsf(F, WS_DLG)[item] = __expf(G63);
            }
        } else if (wv <= 5) {
#pragma unroll
            for (int t = 0; t < 4; ++t) { const int task = 4 * (wv - 2) + t, rt = task >> 3; const float e = __expf(Gv[32 * rt + r]);
                *(bf16x8*)((bf16*)(rec + LA_QD) + ((size_t)task * 64 + lane) * 8) = pack8(qa[t].x * e, qa[t].y * e, qa[t].z * e, qa[t].w * e, qb[t].x * e, qb[t].y * e, qb[t].z * e, qb[t].w * e); }
        } else {
#pragma unroll
            for (int t = 0; t < 8; ++t) ke_frag_task(L + LA_KET, 8 * (wv - 6) + t, r, h, lane, (bf16*)(rec + LA_KE)); }
        LDS_SYNC();
        if (wv == 0) {
            f32x16 t21 = zero16;
#pragma unroll
            for (int s2 = 0; s2 < 2; ++s2) {
                const LAS unsigned char* tr = L + LA_TB + ((size_t)(32 + r) * 72 + 32 + 16 * s2 + 4 * h) * 2;
                const v2u lo = *(const LAS v2u*)tr, hi = *(const LAS v2u*)(tr + 16); v4u w; w.x = lo.x; w.y = lo.y; w.z = hi.x; w.w = hi.y;
                t21 = MFMA32(__builtin_bit_cast(bf16x8, w), PACK_STEP(Pacc, s2), t21); }
#pragma unroll
            for (int q = 0; q < 16; ++q) ((LAS bf16*)(L + LA_TB))[(32 + crow(q, h)) * 72 + r] = (bf16)f2bf(-t21[q]);
        }
        LDS_SYNC();
#pragma unroll 1
        for (int tile = wv; tile < 16; tile += 8) {
            f32x16 acc = zero16;
            if (tile < 8) { const int it = tile >> 1, rt = tile & 1;
#pragma unroll
                for (int ks = 0; ks < 4; ++ks) acc = MFMA32(lds_frag(L + LA_KGT, 32 * it + r, 72, 16 * ks + 8 * h), lds_frag(L + LA_TB, 32 * rt + r, 72, 16 * ks + 8 * h), acc);
                bf16* nw = (bf16*)(rec + LA_NW);
                *(bf16x8*)(nw + ((size_t)(rt * 8 + 2 * it + 0) * 64 + lane) * 8) = PACK_STEP(acc, 0);
                *(bf16x8*)(nw + ((size_t)(rt * 8 + 2 * it + 1) * 64 + lane) * 8) = PACK_STEP(acc, 1);
            } else { const int rt = (tile - 8) >> 2, dvt = (tile - 8) & 3;
#pragma unroll
                for (int ks = 0; ks < 4; ++ks) acc = MFMA32(lds_frag(L + LA_TB, 32 * rt + r, 72, 16 * ks + 8 * h), lds_frag(L + LA_VBT, 32 * dvt + r, 72, 16 * ks + 8 * h), acc);
                float* uc = (float*)(rec + LA_UCG) + ((size_t)(dvt * 2 + rt) * 4 * 64 + lane) * 4;
#pragma unroll
                for (int q4 = 0; q4 < 4; ++q4) *(f32x4*)(uc + (size_t)q4 * 256) = (f32x4){acc[4 * q4], acc[4 * q4 + 1], acc[4 * q4 + 2], acc[4 * q4 + 3]};
            }
        }
        LDS_SYNC();
    }
    for (int item = F.vcu; item < 256; item += F.G) {
        const int tid = opq(tid0), lane = tid & 63, r = lane & 31, h = lane >> 5;
        const int b = item >> 6, ch = (item >> 1) & 31, g = item & 1;
        const size_t t0 = (size_t)b * SEQ + ch * 64;
        const float* BS = wsf(F, WS_BS) + t0 * 256 + g * 128; const float* CS = wsf(F, WS_CS) + t0 * 256 + g * 128;
        const int c = tid & 127, lg = tid >> 7;
        float br[16], cr[16];
#pragma unroll
        for (int i = 0; i < 16; ++i) { const int l = lg * 16 + i; br[i] = BS[(size_t)l * 256 + c]; cr[i] = CS[(size_t)l * 256 + c]; }
        f32x2v ad[4];
#pragma unroll
        for (int hi = 0; hi < 4; ++hi) ad[hi] = *(const f32x2v*)(wsf(F, WS_DT) + (t0 + lane) * 16 + 2 * (4 * g + hi));
        f32x4 ca[4], cb[4]; float xv[4][16];
        const int sl = (wv >> 1) & 1, rt2 = wv & 1;
        {
#pragma unroll
            for (int t = 0; t < 4; ++t) { const int task = 4 * (wv & 3) + t, rt = task >> 3, ks = task & 7, l = 32 * rt + r, k0 = 16 * ks + 4 * h; ca[t] = ld4(CS + (size_t)l * 256 + k0); cb[t] = ld4(CS + (size_t)l * 256 + k0 + 8); }
#pragma unroll
            for (int hi = 0; hi < 4; ++hi)
#pragma unroll
                for (int q = 0; q < 16; ++q) xv[hi][q] = wsf(F, WS_XS)[(t0 + 32 * rt2 + crow(q, h)) * GW + (4 * g + hi) * 64 + 32 * sl + r]; }
#pragma unroll
        for (int i = 0; i < 16; ++i) { const int l = lg * 16 + i;
            ((LAS bf16*)(L + LA_KB))[l * 136 + c] = (bf16)f2bf(br[i]); ((LAS bf16*)(L + LA_QB))[l * 136 + c] = (bf16)f2bf(cr[i]); }
        if (wv == 0) {
#pragma unroll
            for (int hi = 0; hi < 4; ++hi) { Gv[hi * 64 + lane] = wave_incl_scan(ad[hi].x, lane); Gv[256 + hi * 64 + lane] = ad[hi].y; } }
        LDS_SYNC();
        f32x16 raw = zero16;
        const int mt = (wv >> 1) & 1, rt = wv & 1;
        if (wv < 4 && !(mt == 1 && rt == 0)) {
#pragma unroll
            for (int ks = 0; ks < 8; ++ks) raw = MFMA32(lds_frag(L + LA_KB, 32 * mt + r, 136, 16 * ks + 8 * h), lds_frag(L + LA_QB, 32 * rt + r, 136, 16 * ks + 8 * h), raw); }
#pragma unroll
        for (int hi = 0; hi < 4; ++hi) {
            const int hh = 4 * g + hi, seq = b * 8 + hh;
            unsigned char* rec = F.ws + WS_FS + ((size_t)seq * 32 + ch) * LA_RECS;
            const LAS float* Gh = Gv + hi * 64; const LAS float* Dh = Gv + 256 + hi * 64;
            const float G63 = Gh[63];
#pragma unroll
            for (int i = 0; i < 16; ++i) { const int l = lg * 16 + i; ((LAS bf16*)(L + LA_KET))[c * 72 + l] = (bf16)f2bf(br[i] * __expf(G63 - Gh[l])); }
            if (wv < 4) {
                store_qk_frag(raw, Gh, mt, rt, r, h, lane, (bf16*)(rec + LA_QK));
#pragma unroll
                for (int t = 0; t < 4; ++t) { const int task = 4 * wv + t, rtq = task >> 3; const float e = __expf(Gh[32 * rtq + r]);
                    *(bf16x8*)((bf16*)(rec + LA_QD) + ((size_t)task * 64 + lane) * 8) = pack8(ca[t].x * e, ca[t].y * e, ca[t].z * e, ca[t].w * e, cb[t].x * e, cb[t].y * e, cb[t].z * e, cb[t].w * e); }
            } else {
                float* uc = (float*)(rec + LA_UCS) + ((size_t)(sl * 2 + rt2) * 4 * 64 + lane) * 4;
#pragma unroll
                for (int q4 = 0; q4 < 4; ++q4) { f32x4 v;
#pragma unroll
                    for (int e = 0; e < 4; ++e) v[e] = xv[hi][4 * q4 + e] * Dh[32 * rt2 + crow(4 * q4 + e, h)];
                    *(f32x4*)(uc + (size_t)q4 * 256) = v; }
            }
            if (tid == 0) wsf(F, WS_DLS)[seq * 32 + ch] = __expf(G63);
            LDS_SYNC();
            if (wv >= 4) {
#pragma unroll
                for (int t = 0; t < 4; ++t) ke_frag_task(L + LA_KET, 4 * (wv - 4) + t, r, h, lane, (bf16*)(rec + LA_KE)); }
            LDS_SYNC();
        }
    }
}

template <bool HAS_W> __device__ __forceinline__ void la_seq_wg(LAS unsigned char* ring  , const unsigned char* recs, int recsz, int uc_off, const float* dls, float* outp  , int slice, int lane, int wv) {
    constexpr int NFR = HAS_W ? 56 : 40;
    constexpr int SLOT = (NFR + 8) * 1024;
    const int r = lane & 31, h = lane >> 5;
    const bool loader = (wv >= 1 && wv <= 4);
    float dlv = 0.f;
    f32x16 S[4];
    if (wv == 0) { dlv = (lane < 32) ? dls[lane] : 0.f;
#pragma unroll
        for (int it = 0; it < 4; ++it)
#pragma unroll
            for (int q = 0; q < 16; ++q) S[it][q] = 0.f; }
#define LA_DMA(c_, slot_) do { const unsigned char* rec_ = recs + (size_t)(c_) * recsz + lane * 16; LAS unsigned char* dst_ = ring + (slot_) * SLOT; \
        for (int f_ = wv - 1; f_ < NFR + 8; f_ += 4) { const unsigned char* src_ = (f_ < NFR) ? rec_ + f_ * 1024 : rec_ + uc_off + slice * 8192 + (f_ - NFR) * 1024; \
            __builtin_amdgcn_global_load_lds((const unsigned*)src_, (LAS unsigned*)(dst_ + f_ * 1024), 16, 0, 0); } } while (0)
    if (loader) { LA_DMA(0, 0); asm volatile("s_waitcnt vmcnt(0)" ::: "memory"); }
    __builtin_amdgcn_s_barrier(); asm volatile("" ::: "memory");
#pragma unroll 1
    for (int c = 0; c < 32; ++c) {
        if (loader) { if (c + 1 < 32) { LA_DMA(c + 1, (c + 1) & 1); asm volatile("s_waitcnt vmcnt(0)" ::: "memory"); } }
        else if (wv == 0) {
        const LAS unsigned char* B = ring + (c & 1) * SLOT + lane * 16;
#define FRAG(off, idx) (*(const LAS bf16x8*)(B + (off) + (idx) * 1024))
        bf16x8 sb[8];
#pragma unroll
        for (int it = 0; it < 4; ++it) { sb[2 * it] = PACK_STEP(S[it], 0); sb[2 * it + 1] = PACK_STEP(S[it], 1); }
        f32x16 Vn[2];
#pragma unroll
        for (int rt = 0; rt < 2; ++rt)
#pragma unroll
            for (int q4 = 0; q4 < 4; ++q4) { const f32x4 v = *(const LAS f32x4*)(B + NFR * 1024 + (rt * 4 + q4) * 1024); Vn[rt][4 * q4] = v.x; Vn[rt][4 * q4 + 1] = v.y; Vn[rt][4 * q4 + 2] = v.z; Vn[rt][4 * q4 + 3] = v.w; }
        if (HAS_W) {
#pragma unroll
            for (int ks = 0; ks < 8; ++ks) { Vn[0] = MFMA32(FRAG(LA_NW, 0 * 8 + ks), sb[ks], Vn[0]); Vn[1] = MFMA32(FRAG(LA_NW, 1 * 8 + ks), sb[ks], Vn[1]); } }
        bf16x8 vb[4];
#pragma unroll
        for (int rt = 0; rt < 2; ++rt) { vb[2 * rt] = PACK_STEP(Vn[rt], 0); vb[2 * rt + 1] = PACK_STEP(Vn[rt], 1); }
        f32x16 O[2];
#pragma unroll
        for (int rt = 0; rt < 2; ++rt)
#pragma unroll
            for (int q = 0; q < 16; ++q) O[rt][q] = 0.f;
#pragma unroll
        for (int ks = 0; ks < 8; ++ks) { O[0] = MFMA32(FRAG(LA_QD, 0 * 8 + ks), sb[ks], O[0]); O[1] = MFMA32(FRAG(LA_QD, 1 * 8 + ks), sb[ks], O[1]); }
#pragma unroll
        for (int ks = 0; ks < 4; ++ks) { O[0] = MFMA32(FRAG(LA_QK, 0 * 4 + ks), vb[ks], O[0]); O[1] = MFMA32(FRAG(LA_QK, 1 * 4 + ks), vb[ks], O[1]); }
        float* op = outp + (size_t)c * 64 * GW + r;
#pragma unroll
        for (int rt = 0; rt < 2; ++rt)
#pragma unroll
            for (int q = 0; q < 16; ++q) op[(size_t)(32 * rt + crow(q, h)) * GW] = O[rt][q];
        const float dl = __builtin_bit_cast(float, __builtin_amdgcn_readlane(__builtin_bit_cast(int, dlv), c));
#pragma unroll
        for (int it = 0; it < 4; ++it) {
#pragma unroll
            for (int q = 0; q < 16; ++q) S[it][q] *= dl;
#pragma unroll
            for (int ks = 0; ks < 4; ++ks) S[it] = MFMA32(FRAG(LA_KE, it * 4 + ks), vb[ks], S[it]);
        }
#undef FRAG
        asm volatile("s_waitcnt lgkmcnt(0)" ::: "memory");
        }
        __builtin_amdgcn_s_barrier(); asm volatile("" ::: "memory");
    }
#undef LA_DMA
}
__device__ __forceinline__ void la_seq_phase(Frame& F, int l_unused) {
    const int lane = opq(F.lane);
    for (int item = F.vcu; item < 128; item += F.G) {
        if (item < 64) { const int seq = item >> 2, slice = item & 3, b = seq >> 2, hd = seq & 3;
            la_seq_wg<true>(F.lds + RING_OFF, F.ws + WS_FG + (size_t)seq * 32 * LA_RECG, LA_RECG, LA_UCG, wsf(F, WS_DLG) + seq * 32, wsf(F, WS_OG) + (size_t)b * SEQ * GW + hd * 128 + slice * 32, slice, lane, F.wave);
        } else { const int j = item - 64, seq = j >> 1, slice = j & 1, b = seq >> 3, hh = seq & 7;
            la_seq_wg<false>(F.lds + RING_OFF, F.ws + WS_FS + (size_t)seq * 32 * LA_RECS, LA_RECS, LA_UCS, wsf(F, WS_DLS) + seq * 32, wsf(F, WS_YS) + (size_t)b * SEQ * GW + hh * 64 + slice * 32, slice, lane, F.wave);
        }
    }
}

__device__ __forceinline__ void mixer_post_phase(Frame& F, int l) {
    const int gw = F.vcu * NWAVES + F.wave, NGW = F.G * NWAVES, lane = opq(F.lane), c = lane * 8;
    bf16* MIX = wsb(F, WS_MIX);
    const float* gng = inp(I_GNG) + (size_t)l * 128 + (c & 127); const float* sng = inp(I_SNG) + (size_t)l * GW + c;
    const f32x4 g0 = ld4(gng), g1 = ld4(gng + 4), n0 = ld4(sng), n1 = ld4(sng + 4);
    const float Dk = inp(I_SD)[l * 8 + (c >> 6)];
    for (int m = gw; m < M; m += NGW) {
        {
            const float* og = wsf(F, WS_OG) + (size_t)m * GW + c; const f32x8 zz = ldu8(wsb(F, WS_ZG) + (size_t)m * GW + c);
            const f32x4 o0 = ld4(og), o1 = ld4(og + 4), z0 = zz.lo, z1 = zz.hi;
            float ss = (o0.x * o0.x + o0.y * o0.y) + (o0.z * o0.z + o0.w * o0.w) + (o1.x * o1.x + o1.y * o1.y) + (o1.z * o1.z + o1.w * o1.w);
            ss = row16_sum(ss);
            const float rstd = __builtin_amdgcn_rsqf(ss * (1.0f / 128.0f) + EPS);
            const f32x4 y0 = o0 * rstd * g0 * silu4(z0), y1 = o1 * rstd * g1 * silu4(z1);
            v4u w; w.x = pk2(y0.x, y0.y); w.y = pk2(y0.z, y0.w); w.z = pk2(y1.x, y1.y); w.w = pk2(y1.z, y1.w);
            *(v4u*)(MIX + (size_t)m * DM + 2 * GW + c) = w;
        }
        {
            const float* ys = wsf(F, WS_YS) + (size_t)m * GW + c; const float* xs = wsf(F, WS_XS) + (size_t)m * GW + c; const f32x8 zz = ldu8(wsb(F, WS_ZS) + (size_t)m * GW + c);
            const f32x4 a0 = (ld4(ys) + ld4(xs) * Dk) * silu4(zz.lo), a1 = (ld4(ys + 4) + ld4(xs + 4) * Dk) * silu4(zz.hi);
            float ss = (a0.x * a0.x + a0.y * a0.y) + (a0.z * a0.z + a0.w * a0.w) + (a1.x * a1.x + a1.y * a1.y) + (a1.z * a1.z + a1.w * a1.w);
            ss = row16_sum(ss); ss += shx(ss, 16, lane);
            const float rstd = __builtin_amdgcn_rsqf(ss * (1.0f / 256.0f) + EPS);
            const f32x4 y0 = a0 * rstd * n0, y1 = a1 * rstd * n1;
            v4u w; w.x = pk2(y0.x, y0.y); w.y = pk2(y0.z, y0.w); w.z = pk2(y1.x, y1.y); w.w = pk2(y1.z, y1.w);
            *(v4u*)(MIX + (size_t)m * DM + 3 * GW + c) = w;
        }
    }
}

constexpr int CW_PANEL = 8192;
static_assert((CW_PANEL + DEPTH * 3 * 32 * 64) * 4 <= (int)CTL_ZERO_BYTES && CW_BAR + XCD_BAR_WORDS <= CW_PANEL, "control words inside the memset region");
namespace pg8 {
struct EpiAny {
    static constexpr bool PERM = false, AFTER_DRAIN = false, RT_DRAIN = true;
    void* C; int ldc; int mode; float scale;
    unsigned char* ws; float* out; int lq, prow0;
    int rsrow0;
    __device__ __forceinline__ bool perm() const { return mode != 0; }
    __device__ __forceinline__ bool drain() const { return mode >= 3; }
    __device__ __forceinline__ void operator()(const f32x4 (&acc)[2][2][4][2], const Unit& u, int wr, int wc, int fr, int fq) const {
        if (mode == 3 || mode == 4) return;
        if (rsrow0 < 0) {
            if (mode == 0) { EpiF32 e{(float*)C, ldc}; e(acc, u, wr, wc, fr, fq); }
            else if (mode == 1) { EpiBf16S e{(bf16_t*)C, ldc, scale}; e(acc, u, wr, wc, fr, fq); }
            else { EpiSwiGLU e{(bf16_t*)C, ldc}; e(acc, u, wr, wc, fr, fq); }
            return; }
        const float* rs = (const float*)(ws + WS_RS) + rsrow0 + u.pm * BM + wr * 64 + fr;
        const int row0 = u.pm * BM + wr * 64 + fr;
#pragma unroll
        for (int ai = 0; ai < 2; ++ai)
#pragma unroll
            for (int m = 0; m < 4; ++m) { const float r = rs[ai * HALF + m * 16];
                if (mode == 1) { bf16_t* rowp = (bf16_t*)C + (size_t)(row0 + ai * HALF + m * 16) * ldc + u.pn * BM + wc * 32 + 8 * fq;
#pragma unroll
                    for (int bj = 0; bj < 2; ++bj) { const f32x4 v0 = acc[ai][bj][m][0] * r, v1 = acc[ai][bj][m][1] * r;
                        u32x4 w; w.x = cvt_pk_bf16(v0[0], v0[1]); w.y = cvt_pk_bf16(v0[2], v0[3]); w.z = cvt_pk_bf16(v1[0], v1[1]); w.w = cvt_pk_bf16(v1[2], v1[3]); *(u32x4*)(rowp + bj * HALF) = w; }
                } else { bf16_t* rowp = (bf16_t*)C + (size_t)(row0 + ai * HALF + m * 16) * ldc + u.pn * HALF + wc * 32 + 8 * fq;
                    const f32x4 g0 = acc[ai][0][m][0] * r, g1 = acc[ai][0][m][1] * r, u0 = acc[ai][1][m][0] * r, u1 = acc[ai][1][m][1] * r;
                    u32x4 w; w.x = cvt_pk_bf16(silu_f(g0[0]) * u0[0], silu_f(g0[1]) * u0[1]); w.y = cvt_pk_bf16(silu_f(g0[2]) * u0[2], silu_f(g0[3]) * u0[3]);
                    w.z = cvt_pk_bf16(silu_f(g1[0]) * u1[0], silu_f(g1[1]) * u1[1]); w.w = cvt_pk_bf16(silu_f(g1[2]) * u1[2], silu_f(g1[3]) * u1[3]); *(u32x4*)rowp = w; } }
    }
    __device__ __forceinline__ void fused(f32x4 (&acc)[2][2][4][2], const Unit& u, int wr, int wc, int fr, int fq, PG8_LAS unsigned char* lds, int wid, int lane) const {
        if (mode == 3) fused_softmax(acc, u, wr, wc, fr, fq, lds, wid, lane); else fused_resnorm(acc, u, wr, wc, fr, fq, lds, wid, lane);
    }
    __device__ __forceinline__ void fused_resnorm(f32x4 (&acc)[2][2][4][2], const Unit& u, int wr, int wc, int fr, int fq, PG8_LAS unsigned char* lds, int wid, int lane) const {
        const int D = 2048;
        {   bf16_t* Yw = (bf16_t*)(ws + WS_Y);
            const int row0 = prow0 + u.pm * BM + wr * 64 + fr, col0 = u.pn * BM + wc * 32 + 8 * fq;
#pragma unroll
            for (int ai = 0; ai < 2; ++ai)
#pragma unroll
                for (int m = 0; m < 4; ++m)
#pragma unroll
                    for (int bj = 0; bj < 2; ++bj) { const f32x4 v0 = acc[ai][bj][m][0], v1 = acc[ai][bj][m][1];
                        u32x4 w; w.x = cvt_pk_bf16(v0[0], v0[1]); w.y = cvt_pk_bf16(v0[2], v0[3]); w.z = cvt_pk_bf16(v1[0], v1[1]); w.w = cvt_pk_bf16(v1[2], v1[3]);
                        bf16_t* dst = Yw + (size_t)(row0 + ai * HALF + m * 16) * D + col0 + bj * HALF;
                        asm volatile("global_store_dwordx4 %0, %1, off sc1\n\ts_nop 1" :: "v"(dst), "v"(w) : "memory"); } }
        asm volatile("s_waitcnt vmcnt(0)" ::: "memory");
        __builtin_amdgcn_s_barrier(); asm volatile("" ::: "memory");
        const int l = lq / 3, rn = lq % 3;
        unsigned* pc = (unsigned*)(ws + WS_CTL) + CW_PANEL + (lq * 32 + (prow0 >> 8) + u.pm) * 64;
        const float* gpost = inp(I_NORMG) + (size_t)(l * N_NORMS + (rn == 0 ? MIX_POST : rn == 1 ? XA_POST : FFN_POST)) * D;
        const bool first = (lq == 0), last = (lq == 3 * DEPTH - 1);
        const float* xin32 = inp(I_X); bf16_t* xb = (bf16_t*)(ws + WS_XN); float* rsb = (float*)(ws + WS_RS);
        if (wid == 0) {
            if (lane == 0) __hip_atomic_fetch_add(pc, 1u, __ATOMIC_RELAXED, __HIP_MEMORY_SCOPE_AGENT);
            unsigned spins = 0;
            while ((unsigned)__builtin_amdgcn_readfirstlane(__hip_atomic_load(pc, __ATOMIC_RELAXED, __HIP_MEMORY_SCOPE_AGENT)) < 8u) { __builtin_amdgcn_s_sleep(2); if (++spins > (1u << 22)) break; }
            __builtin_amdgcn_fence(__ATOMIC_ACQUIRE, "agent");
            asm volatile("s_waitcnt vmcnt(0)" ::: "memory");
        }
        __builtin_amdgcn_s_barrier(); asm volatile("" ::: "memory");
        const bf16_t* Y = (const bf16_t*)(ws + WS_Y);
#define BFLO(wd) __builtin_bit_cast(float, (wd) << 16)
#define BFHI(wd) __builtin_bit_cast(float, (wd) & 0xffff0000u)
#pragma unroll 1
        for (int i = 0; i < 4; ++i) {
            const size_t mrow = (size_t)prow0 + u.pm * BM + u.pn * 32 + wid * 4 + i;
            f32x4 x[8]; u32x4 yw[4];
            { const u32x4* yr = (const u32x4*)(Y + mrow * D) + lane;
#pragma unroll
              for (int j = 0; j < 4; ++j) yw[j] = yr[64 * j];
              if (first) { const f32x4* xr = (const f32x4*)(xin32 + mrow * D) + 2 * lane;
#pragma unroll
                  for (int j = 0; j < 4; ++j) { x[2 * j] = xr[128 * j]; x[2 * j + 1] = xr[128 * j + 1]; }
              } else { const u32x4* xr = (const u32x4*)(xb + mrow * D) + lane;
#pragma unroll
                  for (int j = 0; j < 4; ++j) { const u32x4 w = xr[64 * j]; x[2 * j] = (f32x4){BFLO(w.x), BFHI(w.x), BFLO(w.y), BFHI(w.y)}; x[2 * j + 1] = (f32x4){BFLO(w.z), BFHI(w.z), BFLO(w.w), BFHI(w.w)}; } } }
            float s = 0.f;
#pragma unroll
            for (int j = 0; j < 4; ++j) { const u32x4 w = yw[j]; const float a0 = BFLO(w.x), a1 = BFHI(w.x), a2 = BFLO(w.y), a3 = BFHI(w.y), a4 = BFLO(w.z), a5 = BFHI(w.z), a6 = BFLO(w.w), a7 = BFHI(w.w);
                s += ((a0 * a0 + a1 * a1) + (a2 * a2 + a3 * a3)) + ((a4 * a4 + a5 * a5) + (a6 * a6 + a7 * a7)); }
            s = wave_sum(s);
            const float rstd = __builtin_amdgcn_rsqf(s * (1.0f / 2048.0f) + 1e-6f);
            float s2 = 0.f;
#pragma unroll
            for (int j = 0; j < 4; ++j) { const u32x4 w = yw[j];
                const f32x4 y0 = (f32x4){BFLO(w.x), BFHI(w.x), BFLO(w.y), BFHI(w.y)}, y1 = (f32x4){BFLO(w.z), BFHI(w.z), BFLO(w.w), BFHI(w.w)};
                const f32x4 g0 = ((const f32x4*)gpost)[2 * lane + 128 * j], g1 = ((const f32x4*)gpost)[2 * lane + 128 * j + 1];
                const f32x4 v0 = x[2 * j] + y0 * rstd * g0, v1 = x[2 * j + 1] + y1 * rstd * g1; x[2 * j] = v0; x[2 * j + 1] = v1;
                s2 += ((v0[0] * v0[0] + v0[1] * v0[1]) + (v0[2] * v0[2] + v0[3] * v0[3])) + ((v1[0] * v1[0] + v1[1] * v1[1]) + (v1[2] * v1[2] + v1[3] * v1[3])); }
            if (last) { f32x4* xo = (f32x4*)(out + mrow * D) + 2 * lane;
#pragma unroll
                for (int j = 0; j < 4; ++j) { xo[128 * j] = x[2 * j]; xo[128 * j + 1] = x[2 * j + 1]; }
            } else {
                s2 = wave_sum(s2);
                if (lane == 0) rsb[mrow] = __builtin_amdgcn_rsqf(s2 * (1.0f / 2048.0f) + 1e-6f);
                u32x4* o8 = (u32x4*)(xb + mrow * D) + lane;
#pragma unroll
                for (int j = 0; j < 4; ++j) { const f32x4 a = x[2 * j], b = x[2 * j + 1];
                    u32x4 w; w.x = cvt_pk_bf16(a[0], a[1]); w.y = cvt_pk_bf16(a[2], a[3]); w.z = cvt_pk_bf16(b[0], b[1]); w.w = cvt_pk_bf16(b[2], b[3]); o8[64 * j] = w; }
            }
        }
#undef BFLO
#undef BFHI
    }
    __device__ __forceinline__ void fused_softmax(f32x4 (&acc)[2][2][4][2], const Unit& u, int wr, int wc, int fr, int fq, PG8_LAS unsigned char* lds, int wid, int lane) const {
        { const float* rs = (const float*)(ws + WS_RS) + rsrow0 + u.pm * BM + wr * 64 + fr;
#pragma unroll
          for (int ai = 0; ai < 2; ++ai)
#pragma unroll
            for (int m = 0; m < 4; ++m) { const float r = rs[ai * HALF + m * 16];
#pragma unroll
                for (int bj = 0; bj < 2; ++bj)
#pragma unroll
                    for (int n = 0; n < 2; ++n) acc[ai][bj][m][n] = acc[ai][bj][m][n] * r; } }
        PG8_LAS float* Pm = (PG8_LAS float*)lds;
        PG8_LAS float* Ps = (PG8_LAS float*)(lds + 4096);
#pragma unroll
        for (int ai = 0; ai < 2; ++ai)
#pragma unroll
            for (int m = 0; m < 4; ++m) { float mx = -3.0e38f;
#pragma unroll
                for (int bj = 0; bj < 2; ++bj)
#pragma unroll
                    for (int n = 0; n < 2; ++n) { const f32x4 x = acc[ai][bj][m][n]; mx = fmaxf(mx, fmaxf(fmaxf(x[0], x[1]), fmaxf(x[2], x[3]))); }
                mx = fmaxf(mx, shx(mx, 16, lane)); mx = fmaxf(mx, shx(mx, 32, lane));
                if (fq == 0) Pm[(ai * HALF + wr * 64 + m * 16 + fr) * 4 + wc] = mx; }
        asm volatile("s_waitcnt lgkmcnt(0)" ::: "memory"); __builtin_amdgcn_s_barrier(); asm volatile("" ::: "memory");
#pragma unroll
        for (int ai = 0; ai < 2; ++ai)
#pragma unroll
            for (int m = 0; m < 4; ++m) { const int row = ai * HALF + wr * 64 + m * 16 + fr; const f32x4 pm = *(const PG8_LAS f32x4*)(Pm + row * 4);
                const float mx = fmaxf(fmaxf(pm[0], pm[1]), fmaxf(pm[2], pm[3])); float sm = 0.f;
#pragma unroll
                for (int bj = 0; bj < 2; ++bj)
#pragma unroll
                    for (int n = 0; n < 2; ++n) { f32x4 x = acc[ai][bj][m][n]; x[0] = __expf(x[0] - mx); x[1] = __expf(x[1] - mx); x[2] = __expf(x[2] - mx); x[3] = __expf(x[3] - mx);
                        acc[ai][bj][m][n] = x; sm += (x[0] + x[1]) + (x[2] + x[3]); }
                sm += shx(sm, 16, lane); sm += shx(sm, 32, lane);
                if (fq == 0) Ps[row * 4 + wc] = sm; }
        asm volatile("s_waitcnt lgkmcnt(0)" ::: "memory"); __builtin_amdgcn_s_barrier(); asm volatile("" ::: "memory");
        const int row0 = u.pm * BM + wr * 64 + fr, col0 = u.pn * BM + wc * 32 + 8 * fq;
#pragma unroll
        for (int ai = 0; ai < 2; ++ai)
#pragma unroll
            for (int m = 0; m < 4; ++m) { const int row = ai * HALF + wr * 64 + m * 16 + fr; const f32x4 ps = *(const PG8_LAS f32x4*)(Ps + row * 4);
                const float inv = __builtin_amdgcn_rcpf((ps[0] + ps[1]) + (ps[2] + ps[3]));
                bf16_t* rowp = (bf16_t*)C + (size_t)(row0 + ai * HALF + m * 16) * ldc + col0;
#pragma unroll
                for (int bj = 0; bj < 2; ++bj) { const f32x4 v0 = acc[ai][bj][m][0] * inv, v1 = acc[ai][bj][m][1] * inv;
                    u32x4 w; w.x = cvt_pk_bf16(v0[0], v0[1]); w.y = cvt_pk_bf16(v0[2], v0[3]); w.z = cvt_pk_bf16(v1[0], v1[1]); w.w = cvt_pk_bf16(v1[2], v1[3]);
                    *(u32x4*)(rowp + bj * HALF) = w; } }
    }
};
}

#ifndef SKIPM
#define SKIPM 0
#endif
#ifndef REPM
#define REPM 0
#endif
#ifndef GEMM_SP2
#define GEMM_SP2 true
#endif
#ifndef GEMM_ALIGN
#define GEMM_ALIGN true
#endif
#ifndef PROBE_PH
#define PROBE_PH -1
#endif
constexpr int PH_PER_LAYER = 10, PH0 = 2, N_PHASES = PH0 + DEPTH * PH_PER_LAYER;
struct Args { const float* in[N_IN]; float* out; unsigned char* ws; int ph_lo, ph_hi; };
static_assert(sizeof(Args) == (N_IN + 2) * 8 + 8, "Args has no padding");
struct GemmDesc { const bf16* A; const bf16* Bt; void* C; int M, N, K, lda, ldb, ldc, mode, corder, rn, prow0, rsrow0; float scale; };
constexpr int NOUNIT = 1 << 24;
__device__ __forceinline__ int gemm_nsub(int ph, int k, int l) { return ph == 0 ? 0 : ph == 1 ? 1 : (k == 1 || k == 2 || k == 4) ? 0 : k == 3 ? 32 : (k == 6 || k == 7) ? BATCH : (k == 8 && l == 0) ? 2 : 1; }
__device__ __forceinline__ int pmod(int x, int m) { const int r = x % m; return r < 0 ? r + m : r; }
__device__ __forceinline__ void kv_desc(const Frame& F, int l, int v0, GemmDesc& d) {
    d.A = wsb(F, WS_MEMN) + (size_t)l * MROWS * DM; d.Bt = (const bf16*)(F.ws + WS_W + (size_t)l * W_LAYER + WO_WKV); d.C = wsb(F, WS_KV) + (size_t)l * MROWS * 2 * DM;
    d.M = MROWS; d.N = 2 * DM; d.K = DM; d.lda = DM; d.ldb = DM; d.ldc = 2 * DM; d.mode = 1; d.corder = (F.vcu >= v0 && F.vcu < v0 + 64) ? F.vcu - v0 : NOUNIT;
}
__device__ __forceinline__ void gemm_desc(const Frame& F, int ph, int sub, GemmDesc& d) {
    const int bx = (int)blockIdx.x;
    d.scale = 1.0f; d.corder = bx; d.rn = -1; d.prow0 = 0; d.rsrow0 = -1;
    if (ph == 1) { kv_desc(F, 0, 0, d); return; }
    const int l = (ph - PH0) / PH_PER_LAYER, k = (ph - PH0) % PH_PER_LAYER;
    if (k == 3) {
        const int which = sub & 1, h = (sub >> 1) & 3, b = (sub >> 3) & 3;
        const unsigned char* wl = F.ws + WS_W + (size_t)l * W_LAYER;
        const bf16* kv = wsb(F, WS_KV) + (size_t)l * MROWS * 2 * DM + (size_t)(b * MEML) * 2 * DM + h * XHD;
        const int nb = 128;
        d.K = XHD; d.mode = 1; d.corder = (F.vcu >= 128 && F.vcu < 128 + nb) ? pmod(F.vcu - 128 - 8 * sub, nb) : NOUNIT;
        if (which == 0) {
            d.A = kv; d.lda = 2 * DM; d.Bt = (const bf16*)(wl + WO_WQ) + h * XHD; d.ldb = DM; d.M = MEML; d.N = DM;
            d.C = wsb(F, WS_AT) + ((size_t)(l * BATCH + b) * 1024 + h * MEML) * DM; d.ldc = DM; d.scale = 0.044194173824159216f;
        } else {
            d.A = (const bf16*)(wl + WO_WO) + h * XHD; d.lda = DM; d.Bt = kv + DM; d.ldb = 2 * DM; d.M = DM; d.N = MEML;
            d.C = wsb(F, WS_VWT) + (size_t)(l * BATCH + b) * DM * 1024 + h * MEML; d.ldc = 1024;
        }
        return;
    }
    const unsigned char* wl = F.ws + WS_W + (size_t)l * W_LAYER;
    d.M = M; d.K = DM; d.N = DM; d.lda = DM; d.ldb = DM; d.ldc = DM; d.mode = 1; d.A = wsb(F, WS_XN); d.C = wsb(F, WS_Y);
    if (k == 0) { d.Bt = (const bf16*)(wl + WO_WIN); d.N = IN_PAD; d.C = wsb(F, WS_U); d.ldc = IN_PAD; d.mode = 1; d.rsrow0 = 0; }
    else if (k == 5) { d.A = wsb(F, WS_MIX); d.Bt = (const bf16*)(wl + WO_WOUT); d.mode = 4; d.rn = 0; }
    else if (k == 6) {
        const int b = sub; d.A = wsb(F, WS_XN) + (size_t)b * SEQ * DM; d.Bt = wsb(F, WS_AT) + (size_t)(l * BATCH + b) * 1024 * DM; d.M = SEQ; d.N = 1024;
        d.C = wsb(F, WS_P) + (size_t)b * SEQ * 1024; d.ldc = 1024; d.mode = 3; d.rsrow0 = b * SEQ; d.corder = (bx + F.G - 32 * sub) % F.G; }
    else if (k == 7) {
        const int b = sub; d.A = wsb(F, WS_P) + (size_t)b * SEQ * 1024; d.lda = 1024; d.Bt = wsb(F, WS_VWT) + (size_t)(l * BATCH + b) * DM * 1024; d.ldb = 1024; d.M = SEQ; d.K = 1024;
        d.mode = 4; d.rn = 1; d.prow0 = b * SEQ; d.corder = (bx + F.G - 64 * sub) % F.G; }
    else if (k == 8) { if (sub == 1) { kv_desc(F, 1, 0, d); d.corder = (bx >= 128 && bx < 192) ? bx - 128 : NOUNIT; return; }
        d.Bt = (const bf16*)(wl + WO_WGU); d.N = 2 * DFF; d.mode = 2; d.C = wsb(F, WS_HID); d.ldc = DFF; d.rsrow0 = 0; }
    else { d.A = wsb(F, WS_HID); d.Bt = (const bf16*)(wl + WO_WD); d.K = DFF; d.lda = DFF; d.ldb = DFF; d.mode = 4; d.rn = 2; }
}

__global__ void __launch_bounds__(NWAVES * 64, 2) fwd_kernel(Args args) {
    extern __shared__ __attribute__((aligned(16))) unsigned char lds[];
    Frame F;
    F.lds = (LAS unsigned char*)lds;
    F.MISC = (volatile LAS unsigned*)(F.lds + MISC_OFF);
    F.tid = threadIdx.x; F.lane = F.tid & 63; F.wave = __builtin_amdgcn_readfirstlane(F.tid >> 6);
    F.G = gridDim.x; { const int bx = blockIdx.x; F.vcu = (F.G % 8 == 0) ? (bx % 8) * (F.G / 8) + bx / 8 : bx; }
    F.ws = args.ws; F.out = args.out; F.ctl = (unsigned*)(args.ws + WS_CTL);
    for (int u = F.tid; u < (LDS_BYTES - LDSCTL_OFF) / 4; u += NWAVES * 64) ((LAS unsigned*)(F.lds + LDSCTL_OFF))[u] = 0u;
    __syncthreads();
    const int lo = args.ph_lo, hi = args.ph_hi;
    if (hi - lo > 1) (void)xcd_barrier_post(F.ctl + CW_BAR, F.MISC + 8);
#define GRID_BARRIER() do { XcdBarrier b_; b_.bar = F.ctl + CW_BAR; b_.x = xb_xcc_id(); b_.st = F.MISC + 8; xcd_barrier(b_); } while (0)
    LAS unsigned char* ring = F.lds + RING_OFF;
#if PROBE_PH >= 0
    unsigned long long t_start = __builtin_amdgcn_s_memrealtime(), t_probe = 0;
#endif
#pragma unroll 1
    for (int ph = lo; ph < hi; ++ph) {
        const int l = ph >= PH0 ? (ph - PH0) / PH_PER_LAYER : 0, k = ph >= PH0 ? (ph - PH0) % PH_PER_LAYER : -1;
        const int kbit = (ph < PH0) ? ph : (k + PH0);
        const int reps = 1 + ((REPM >> kbit) & 1);
#pragma unroll 1
        for (int rep = 0; rep < reps; ++rep) {
        if (ph < PH0) p0_prologue(F, ph);
        else if (k == 1) mixer_prep_phase(F, l);
        else if (k == 2) la_prep_phase(F, l);
        else if (k == 3) la_seq_phase(F, l);
        else if (k == 4) mixer_post_phase(F, l);
        const int nsub = gemm_nsub(ph, k, l);
#pragma unroll 1
        for (int sub = 0; sub < nsub; ++sub) {
            GemmDesc d; gemm_desc(F, ph, sub, d);
            pg8::Gemm g{d.A, d.Bt, d.M, d.N, d.K, d.lda, d.ldb}; pg8::StaticOrder S; S.init(d.M, d.N, F.G, d.corder);
            pg8::EpiAny E{d.C, d.ldc, d.mode, d.scale, F.ws, F.out, l * 3 + d.rn, d.prow0, d.rsrow0};
            pg8::gemm_phase<pg8::EpiAny, pg8::StaticOrder, GEMM_ALIGN, GEMM_SP2>(ring, g, S, E);
        }
        if (REPM >> 20) { if (rep + 1 < reps) __syncthreads(); }
        }
        if ((REPM >> 21) & 1) GRID_BARRIER();
        if (ph + 1 < hi) GRID_BARRIER();
#if PROBE_PH >= 0
        if (ph == PROBE_PH) t_probe = __builtin_amdgcn_s_memrealtime();
#endif
    }
#if PROBE_PH >= 0
    if (blockIdx.x == 0) {
        const unsigned long long t_end = __builtin_amdgcn_s_memrealtime();
        while (__builtin_amdgcn_s_memrealtime() - t_end < t_probe - t_start) __builtin_amdgcn_s_sleep(8);
    }
#endif
}

#ifndef MK_SINGLE
#define MK_SINGLE 0
#endif
extern "C" void kernel_launch(void* const* d_in, const int* in_sizes, int n_in, void* d_out, int out_size, void* d_ws, size_t ws_size, hipStream_t stream) {
    static int grid = 0;
    if (grid == 0) {
        if (n_in != N_IN || in_sizes[0] != M * DM || out_size != M * DM || ws_size < WS_END) { fprintf(stderr, "kernel_launch: unexpected problem (n_in %d, in0 %d, out %d, ws %zu < %zu)\n", n_in, n_in > 0 ? in_sizes[0] : -1, out_size, ws_size, (size_t)WS_END); grid = -1; return; }
        int dev = 0, cus = 0, per_cu = 0;
        if (hipGetDevice(&dev) != hipSuccess || hipDeviceGetAttribute(&cus, hipDeviceAttributeMultiprocessorCount, dev) != hipSuccess) { grid = -1; return; }
        if (hipFuncSetAttribute((const void*)fwd_kernel, hipFuncAttributeMaxDynamicSharedMemorySize, LDS_BYTES) != hipSuccess) { fprintf(stderr, "kernel_launch: hipFuncSetAttribute failed\n"); grid = -1; return; }
        if (hipOccupancyMaxActiveBlocksPerMultiprocessor(&per_cu, (const void*)fwd_kernel, NWAVES * 64, LDS_BYTES) != hipSuccess || per_cu < 1) { fprintf(stderr, "kernel_launch: occupancy query says %d blocks per CU\n", per_cu); per_cu = 1; }
        (void)hipGetLastError();
        grid = cus * (per_cu < 1 ? 1 : 1);
        if (grid != 256) fprintf(stderr, "kernel_launch: note: grid %d (expected 256)\n", grid);
    }
    if (grid < 0) return;
    if (hipMemsetAsync((char*)d_ws + WS_CTL, 0, CTL_ZERO_BYTES, stream) != hipSuccess) { fprintf(stderr, "kernel_launch: memset failed\n"); return; }
    Args a{};
    for (int i = 0; i < N_IN; ++i) a.in[i] = (const float*)d_in[i];
    a.out = (float*)d_out; a.ws = (unsigned char*)d_ws;
#if MK_SINGLE
    a.ph_lo = 0; a.ph_hi = N_PHASES;
    void* kargs[] = {&a};
    hipError_t e = hipLaunchCooperativeKernel((const void*)fwd_kernel, dim3(grid), dim3(NWAVES * 64), kargs, LDS_BYTES, stream);
    if (e != hipSuccess) fprintf(stderr, "kernel_launch: cooperative launch failed: %s (grid %d)\n", hipGetErrorString(e), grid);
#else
    for (int p = 0; p < N_PHASES; ++p) { a.ph_lo = p; a.ph_hi = p + 1;
        hipLaunchKernelGGL(fwd_kernel, dim3(grid), dim3(NWAVES * 64), LDS_BYTES, stream, a);
        const hipError_t le = hipPeekAtLastError(); if (le != hipSuccess) { fprintf(stderr, "kernel_launch: launch %d failed: %s\n", p, hipGetErrorName(le)); break; } }
#endif
}
```

```cpp
#include <hip/hip_runtime.h>
#include <cstdio>
#include <cstdint>
#define MK_SINGLE 1
namespace pg8 {
#define PG8_LAS __attribute__((address_space(3)))
typedef unsigned short bf16_t;
typedef short bf16x8 __attribute__((ext_vector_type(8)));
typedef float f32x4 __attribute__((ext_vector_type(4)));
typedef unsigned u32x4 __attribute__((ext_vector_type(4)));
constexpr int BM = 256, BK = 64, HALF = 128, HTB = HALF * BK * 2  , STAGE_BYTES = 8 * HTB, NXCD = 8, WGM = 8;

__host__ __device__ __forceinline__ int lds_byte(int r, int c) { const int st = (r >> 4) * 2 + (c >> 5), rr = r & 15, cc = c & 31, ob = rr * 64 + cc * 2; return st * 1024 + (ob ^ (((ob >> 9) & 1) << 5)); }
__host__ __device__ __forceinline__ void stage_rc(int b, int& R, int& C) { const int st = b / 1024, sb = b % 1024, swz = sb ^ (((sb >> 9) & 1) << 5); R = (st >> 1) * 16 + swz / 64; C = (st & 1) * 32 + (swz % 64) / 2; }
__host__ __device__ __forceinline__ int perm32(int rho) { const int n = rho >> 4, i = rho & 15; return 8 * (i >> 2) + 4 * n + (i & 3); }

struct Unit { int pm, pn; };
struct Gemm { const bf16_t* A; const bf16_t* Bt; int M, N, K, lda, ldb; };

struct StaticOrder {
    int nM, nN, nwg, G, c;
    __host__ __device__ void init(int M, int N, int G_, int c_) { nM = M / BM; nN = N / BM; nwg = nM * nN; G = G_; c = c_; }
    __host__ __device__ bool next(int i, Unit& u) const {
        const long L = (long)i * G + c; if (L >= nwg) return false;
        int wgid = (int)L; { const int q = nwg / NXCD, r = nwg % NXCD, xcd = wgid % NXCD, off = wgid / NXCD; wgid = (xcd < r ? xcd * (q + 1) : r * (q + 1) + (xcd - r) * q) + off; }
        const int nig = WGM * nN, gid = wgid / nig, fm = gid * WGM, gsz = (nM - fm) < WGM ? (nM - fm) : WGM;
        u.pm = fm + ((wgid % nig) % gsz); u.pn = (wgid % nig) / gsz; return true;
    }
    __device__ __forceinline__ void a_ready(const Unit&) const {}
    __device__ __forceinline__ void done(const Unit&) const {}
};

__device__ __forceinline__ unsigned cvt_pk_bf16(float lo, float hi) { unsigned r; asm volatile("v_cvt_pk_bf16_f32 %0, %1, %2" : "=v"(r) : "v"(lo), "v"(hi)); return r; }
struct EpiF32 {
    static constexpr bool PERM = false, AFTER_DRAIN = false;
    float* C; int ldc;
    __device__ __forceinline__ void operator()(const f32x4 (&acc)[2][2][4][2], const Unit& u, int wr, int wc, int fr, int fq) const {
        const int row0 = u.pm * BM + wr * 64 + fr, col0 = u.pn * BM + wc * 32 + 4 * fq;
#pragma unroll
        for (int ai = 0; ai < 2; ++ai)
#pragma unroll
            for (int m = 0; m < 4; ++m) { float* rowp = C + (size_t)(row0 + ai * HALF + m * 16) * ldc + col0;
#pragma unroll
                for (int bj = 0; bj < 2; ++bj)
#pragma unroll
                    for (int n = 0; n < 2; ++n) *(f32x4*)(rowp + bj * HALF + n * 16) = acc[ai][bj][m][n]; }
    }
};
struct EpiBf16S {
    static constexpr bool PERM = true, AFTER_DRAIN = false;
    bf16_t* O; int ldc; float scale;
    __device__ __forceinline__ void operator()(const f32x4 (&acc)[2][2][4][2], const Unit& u, int wr, int wc, int fr, int fq) const {
        const int row0 = u.pm * BM + wr * 64 + fr, col0 = u.pn * BM + wc * 32 + 8 * fq; const float sc = scale;
#pragma unroll
        for (int ai = 0; ai < 2; ++ai)
#pragma unroll
            for (int m = 0; m < 4; ++m) { bf16_t* rowp = O + (size_t)(row0 + ai * HALF + m * 16) * ldc + col0;
#pragma unroll
                for (int bj = 0; bj < 2; ++bj) { const f32x4 v0 = acc[ai][bj][m][0] * sc, v1 = acc[ai][bj][m][1] * sc;
                    u32x4 w; w.x = cvt_pk_bf16(v0[0], v0[1]); w.y = cvt_pk_bf16(v0[2], v0[3]); w.z = cvt_pk_bf16(v1[0], v1[1]); w.w = cvt_pk_bf16(v1[2], v1[3]);
                    *(u32x4*)(rowp + bj * HALF) = w; } }
    }
};
__device__ __forceinline__ float silu_f(float v) { return v * __builtin_amdgcn_rcpf(1.0f + __expf(-v)); }
struct EpiSwiGLU {
    static constexpr bool PERM = true, AFTER_DRAIN = false;
    bf16_t* O; int ldc;
    __device__ __forceinline__ void operator()(const f32x4 (&acc)[2][2][4][2], const Unit& u, int wr, int wc, int fr, int fq) const {
        const int row0 = u.pm * BM + wr * 64 + fr, col0 = u.pn * HALF + wc * 32 + 8 * fq;
#pragma unroll
        for (int ai = 0; ai < 2; ++ai)
#pragma unroll
            for (int m = 0; m < 4; ++m) { bf16_t* rowp = O + (size_t)(row0 + ai * HALF + m * 16) * ldc + col0;
                const f32x4 g0 = acc[ai][0][m][0], g1 = acc[ai][0][m][1], u0 = acc[ai][1][m][0], u1 = acc[ai][1][m][1];
                u32x4 w; w.x = cvt_pk_bf16(silu_f(g0[0]) * u0[0], silu_f(g0[1]) * u0[1]); w.y = cvt_pk_bf16(silu_f(g0[2]) * u0[2], silu_f(g0[3]) * u0[3]);
                w.z = cvt_pk_bf16(silu_f(g1[0]) * u1[0], silu_f(g1[1]) * u1[1]); w.w = cvt_pk_bf16(silu_f(g1[2]) * u1[2], silu_f(g1[3]) * u1[3]);
                *(u32x4*)rowp = w; }
    }
};
template <class Epi, class Sched, bool ALIGN_EPI = false, bool SP2 = false>
__device__ __forceinline__ void gemm_phase(PG8_LAS unsigned char* lds, const Gemm g, const Sched& S, const Epi& E) {
    int tid_ = threadIdx.x; asm volatile("" : "+v"(tid_));
    const int tid = tid_, wid = __builtin_amdgcn_readfirstlane(tid >> 6), lane = tid & 63, wr = wid >> 2, wc = wid & 3, fr = lane & 15, fq = lane >> 4;
    const int K = g.K, nt = K / BK;
    unsigned voffA[2], voffB[2];
#pragma unroll
    for (int i = 0; i < 2; ++i) { int R, C; stage_rc(tid * 16 + i * 8192, R, C); const int Rb = E.perm() ? ((R & ~31) + perm32(R & 31)) : R;
        voffA[i] = (unsigned)(R * g.lda + C) * 2u; voffB[i] = (unsigned)(Rb * g.ldb + C) * 2u; }
    const size_t kstep = (size_t)(BK * 2);
    const size_t hstepA = (size_t)HALF * g.lda * 2, hstepB = (size_t)HALF * g.ldb * 2;
    const size_t tstepA = 2 * hstepA, tstepB = 2 * hstepB;
    const unsigned ldsw = (unsigned)wid * 1024u;
    const int aoff = lds_byte(wr * 64 + fr, fq * 8), boff = lds_byte(wc * 32 + fr, fq * 8);
#define PG8_SA(b, h) (((b) * 2 + (h)) * HTB)
#define PG8_SB(b, h) ((4 + (b) * 2 + (h)) * HTB)
#define PG8_STAGE(bufoff, gbase, voff) do { _Pragma("unroll") for (int _i = 0; _i < 2; ++_i) \
        __builtin_amdgcn_global_load_lds((const unsigned*)((const char*)(gbase) + (voff)[_i]), (PG8_LAS unsigned*)(lds + (bufoff) + ldsw + _i * 8192), 16, 0, 0); } while (0)
#define PG8_LDA(dst, b, h) do { _Pragma("unroll") for (int m = 0; m < 4; ++m) _Pragma("unroll") for (int k = 0; k < 2; ++k) dst[m][k] = *(const PG8_LAS bf16x8*)(lds + PG8_SA(b, h) + aoff + m * 2048 + k * 1024); } while (0)
#define PG8_LDB(dst, b, h) do { _Pragma("unroll") for (int n = 0; n < 2; ++n) _Pragma("unroll") for (int k = 0; k < 2; ++k) dst[n][k] = *(const PG8_LAS bf16x8*)(lds + PG8_SB(b, h) + boff + n * 2048 + k * 1024); } while (0)
#define PG8_MMA(ai, bj, At, Bt) do { __builtin_amdgcn_s_setprio(1); _Pragma("unroll") for (int m = 0; m < 4; ++m) _Pragma("unroll") for (int n = 0; n < 2; ++n) _Pragma("unroll") for (int k = 0; k < 2; ++k) \
        acc[ai][bj][m][n] = __builtin_amdgcn_mfma_f32_16x16x32_bf16(Bt[n][k], At[m][k], acc[ai][bj][m][n], 0, 0, 0); __builtin_amdgcn_s_setprio(0); } while (0)
#define PG8_WAIT_V(n) asm volatile("s_waitcnt vmcnt(" #n ")" ::: "memory")
#define PG8_WAIT_L(n) asm volatile("s_waitcnt lgkmcnt(" #n ")" ::: "memory")
#define PG8_BAR __builtin_amdgcn_s_barrier()
#define PG8_SCHED __builtin_amdgcn_sched_barrier(0)
    Unit cur, nxt; int ui = 0;
    if (!S.next(0, cur)) return;
    f32x4 acc[2][2][4][2];
#pragma unroll
    for (int a = 0; a < 2; ++a)
#pragma unroll
        for (int b = 0; b < 2; ++b)
#pragma unroll
            for (int m = 0; m < 4; ++m)
#pragma unroll
                for (int n = 0; n < 2; ++n) acc[a][b][m][n] = (f32x4){0.f, 0.f, 0.f, 0.f};
    bf16x8 At[4][2], B0[2][2], B1[2][2];
#pragma unroll
    for (int m = 0; m < 4; ++m)
#pragma unroll
        for (int k = 0; k < 2; ++k) asm volatile("" : "=v"(At[m][k]));
#pragma unroll
    for (int n = 0; n < 2; ++n)
#pragma unroll
        for (int k = 0; k < 2; ++k) { asm volatile("" : "=v"(B0[n][k])); asm volatile("" : "=v"(B1[n][k])); }
    const char* cA = (const char*)g.A + (size_t)cur.pm * tstepA; const char* cB = (const char*)g.Bt + (size_t)cur.pn * tstepB;
    S.a_ready(cur);
    if constexpr (SP2) {
        PG8_STAGE(PG8_SB(0, 0), cB, voffB); PG8_STAGE(PG8_SB(0, 1), cB + hstepB, voffB); PG8_STAGE(PG8_SA(0, 0), cA, voffA); PG8_STAGE(PG8_SA(0, 1), cA + hstepA, voffA);
        if (wr == 1) PG8_BAR;
        PG8_WAIT_V(2); PG8_BAR;
        PG8_STAGE(PG8_SB(1, 0), cB + kstep, voffB); PG8_STAGE(PG8_SA(1, 0), cA + kstep, voffA); PG8_STAGE(PG8_SB(1, 1), cB + hstepB + kstep, voffB);
        PG8_WAIT_V(6); PG8_BAR;
    } else {
        PG8_STAGE(PG8_SB(0, 0), cB, voffB); PG8_STAGE(PG8_SA(0, 0), cA, voffA); PG8_STAGE(PG8_SB(0, 1), cB + hstepB, voffB); PG8_STAGE(PG8_SA(0, 1), cA + hstepA, voffA);
        if (wr == 1) PG8_BAR;
        PG8_WAIT_V(4); PG8_BAR;
        PG8_STAGE(PG8_SB(1, 0), cB + kstep, voffB); PG8_STAGE(PG8_SA(1, 0), cA + kstep, voffA); PG8_STAGE(PG8_SB(1, 1), cB + hstepB + kstep, voffB);
        PG8_WAIT_V(6); PG8_BAR;
    }
    for (;;) {
        const bool has_next = S.next(ui + 1, nxt);
        const char* nA = has_next ? (const char*)g.A + (size_t)nxt.pm * tstepA : cA; const char* nB = has_next ? (const char*)g.Bt + (size_t)nxt.pn * tstepB : cB;
        for (int t = 0; t < nt; t += 2) {
            const bool last = (t == nt - 2);
            const char* a1 = cA + (size_t)(t + 1) * kstep;
            const char* a2 = last ? nA : cA + (size_t)(t + 2) * kstep; const char* b2 = last ? nB : cB + (size_t)(t + 2) * kstep;
            const char* a3 = a2 + kstep; const char* b3 = b2 + kstep;
            if (last && has_next) S.a_ready(nxt);
            if constexpr (SP2) {
            PG8_LDB(B0, 0, 0); PG8_LDB(B1, 0, 1); PG8_SCHED; PG8_LDA(At, 0, 0); PG8_STAGE(PG8_SA(1, 1), a1 + hstepA, voffA);
            PG8_WAIT_V(8); PG8_WAIT_L(0); PG8_BAR; PG8_MMA(0, 0, At, B0); PG8_MMA(0, 1, At, B1); PG8_BAR; PG8_SCHED;
            PG8_LDA(At, 0, 1); PG8_STAGE(PG8_SB(0, 0), b2, voffB); PG8_STAGE(PG8_SB(0, 1), b2 + hstepB, voffB); PG8_STAGE(PG8_SA(0, 0), a2, voffA);
            PG8_WAIT_V(8); PG8_WAIT_L(0); PG8_BAR; PG8_MMA(1, 0, At, B0); PG8_MMA(1, 1, At, B1); PG8_BAR; PG8_SCHED;
            PG8_LDB(B0, 1, 0); PG8_LDB(B1, 1, 1); PG8_SCHED; PG8_LDA(At, 1, 0); PG8_STAGE(PG8_SA(0, 1), a2 + hstepA, voffA);
            PG8_WAIT_V(8); PG8_WAIT_L(0); PG8_BAR; PG8_MMA(0, 0, At, B0); PG8_MMA(0, 1, At, B1); PG8_BAR; PG8_SCHED;
            PG8_LDA(At, 1, 1); PG8_STAGE(PG8_SB(1, 0), b3, voffB); PG8_STAGE(PG8_SB(1, 1), b3 + hstepB, voffB); PG8_STAGE(PG8_SA(1, 0), a3, voffA);
            PG8_WAIT_V(8); PG8_WAIT_L(0); PG8_BAR; PG8_MMA(1, 0, At, B0); PG8_MMA(1, 1, At, B1); PG8_BAR; PG8_SCHED;
            } else {
            PG8_LDB(B0, 0, 0); PG8_SCHED; PG8_LDA(At, 0, 0); PG8_STAGE(PG8_SA(1, 1), a1 + hstepA, voffA);
            PG8_WAIT_L(8); PG8_BAR; PG8_WAIT_L(0); PG8_MMA(0, 0, At, B0); PG8_BAR; PG8_SCHED;
            PG8_LDB(B1, 0, 1); PG8_STAGE(PG8_SB(0, 0), b2, voffB);
            PG8_BAR; PG8_WAIT_L(0); PG8_MMA(0, 1, At, B1); PG8_BAR;
            PG8_LDA(At, 0, 1); PG8_STAGE(PG8_SA(0, 0), a2, voffA);
            PG8_BAR; PG8_WAIT_L(0); PG8_MMA(1, 0, At, B0); PG8_BAR; PG8_SCHED;
            PG8_STAGE(PG8_SB(0, 1), b2 + hstepB, voffB);
            PG8_WAIT_V(6); PG8_BAR; PG8_MMA(1, 1, At, B1); PG8_BAR;
            PG8_LDB(B0, 1, 0); PG8_SCHED; PG8_LDA(At, 1, 0); PG8_STAGE(PG8_SA(0, 1), a2 + hstepA, voffA);
            PG8_WAIT_L(8); PG8_BAR; PG8_WAIT_L(0); PG8_MMA(0, 0, At, B0); PG8_BAR; PG8_SCHED;
            PG8_LDB(B1, 1, 1); PG8_STAGE(PG8_SB(1, 0), b3, voffB);
            PG8_BAR; PG8_WAIT_L(0); PG8_MMA(0, 1, At, B1); PG8_BAR;
            PG8_LDA(At, 1, 1); PG8_STAGE(PG8_SA(1, 0), a3, voffA);
            PG8_BAR; PG8_WAIT_L(0); PG8_MMA(1, 0, At, B0); PG8_BAR; PG8_SCHED;
            PG8_STAGE(PG8_SB(1, 1), b3 + hstepB, voffB);
            PG8_WAIT_V(6); PG8_BAR; PG8_MMA(1, 1, At, B1); PG8_BAR;
            }
        }
        if constexpr (ALIGN_EPI) { if (wr == 0) PG8_BAR; }
        if constexpr (!Epi::AFTER_DRAIN) { E(acc, cur, wr, wc, fr, fq); S.done(cur); }
        if (!has_next) break;
#pragma unroll
        for (int a = 0; a < 2; ++a)
#pragma unroll
            for (int b = 0; b < 2; ++b)
#pragma unroll
                for (int m = 0; m < 4; ++m)
#pragma unroll
                    for (int n = 0; n < 2; ++n) acc[a][b][m][n] = (f32x4){0.f, 0.f, 0.f, 0.f};
        cur = nxt; cA = nA; cB = nB; ++ui;
        if constexpr (ALIGN_EPI) { if (wr == 1) PG8_BAR; }
    }
    PG8_WAIT_V(0);
    if constexpr (!ALIGN_EPI) { if (wr == 0) PG8_BAR; }
    PG8_BAR;
    if constexpr (Epi::AFTER_DRAIN) { E.fused(acc, cur, wr, wc, fr, fq, lds, wid, lane); S.done(cur); }
    if constexpr (Epi::RT_DRAIN) { if (E.drain()) E.fused(acc, cur, wr, wc, fr, fq, lds, wid, lane); }
#undef PG8_SA
#undef PG8_SB
#undef PG8_STAGE
#undef PG8_LDA
#undef PG8_LDB
#undef PG8_MMA
#undef PG8_WAIT_V
#undef PG8_WAIT_L
#undef PG8_BAR
#undef PG8_SCHED
}
}
constexpr int NWAVES = 8;
constexpr int BATCH = 4, SEQ = 2048, DM = 2048, DEPTH = 2;
constexpr int M = BATCH * SEQ;
constexpr int GW = 512;
constexpr int IN_COLS = 5648, IN_PAD = 5888;
constexpr int DFF = 5632, MEML = 256, XH = 4, XHD = 512;
constexpr int MROWS = BATCH * MEML;
constexpr float EPS = 1e-6f;
constexpr int UA_B = 0, UA_C = 512, UA_H = 1024, UB = 1536, UC_Q = 2048, UC_Z = 3584, UC_A = 4096, UC_B = 4100, UD_Z = 4104, UD_X = 4616, UD_DT = 5640;
constexpr int MIX_PRE = 0, MIX_POST = 1, XA_PRE = 2, XA_POST = 3, MEM_NORM = 4, FFN_PRE = 5, FFN_POST = 6, N_NORMS = 7;
enum { I_X = 0, I_MEM, I_NORMG, I_WIN, I_CONVA, I_POOLW, I_POOLS, I_GCONV, I_GALOG, I_GDTB, I_GNG, I_SCONVW, I_SCONVB, I_SALOG, I_SDTB, I_SD, I_SNG, I_WOUT, I_WQ, I_WKV, I_WO, I_WGU, I_WD, N_IN };

constexpr size_t MiB = 1u << 20;
constexpr size_t WS_CTL = 0, CTL_ZERO_BYTES = 1 * MiB;
constexpr size_t WSZ_WIN = (size_t)IN_PAD * DM * 2, WSZ_SQ = (size_t)DM * DM * 2, WSZ_KV = (size_t)2 * DM * DM * 2, WSZ_GU = (size_t)2 * DFF * DM * 2, WSZ_D = (size_t)DM * DFF * 2;
constexpr size_t WO_WIN = 0, WO_WOUT = WO_WIN + WSZ_WIN, WO_WQ = WO_WOUT + WSZ_SQ, WO_WKV = WO_WQ + WSZ_SQ, WO_WO = WO_WKV + WSZ_KV, WO_WGU = WO_WO + WSZ_SQ, WO_WD = WO_WGU + WSZ_GU, W_LAYER = WO_WD + WSZ_D;
constexpr size_t WS_W = 1 * MiB;
constexpr size_t WS_XN = WS_W + 2 * W_LAYER;
constexpr size_t WS_MIX = WS_XN + (size_t)M * DM * 2;
constexpr size_t WS_MEMN = WS_MIX + (size_t)M * DM * 2;
constexpr size_t WS_KV = WS_MEMN + (size_t)2 * MROWS * DM * 2;
constexpr size_t WS_U = WS_KV + (size_t)2 * MROWS * 2 * DM * 2;
constexpr size_t WS_P = WS_U, WS_HID = WS_U + (size_t)M * DM * 2;
constexpr size_t WS_UEND = WS_U + (size_t)120 * MiB;
constexpr size_t WS_ZG = WS_UEND, WS_ZS = WS_ZG + (size_t)M * 512 * 2, WS_BS = WS_ZS + (size_t)M * 512 * 2, WS_CS = WS_BS + (size_t)M * 256 * 4;
constexpr size_t WS_SCR = WS_CS + (size_t)M * 256 * 4;
constexpr size_t WS_Y = WS_SCR;
constexpr size_t SZ512 = (size_t)M * 512 * 4, SZ256 = (size_t)M * 256 * 4, SZ8 = (size_t)M * 8 * 4;
constexpr size_t WS_QN = WS_SCR, WS_KN = WS_QN + SZ512, WS_VV = WS_KN + SZ512, WS_OG = WS_VV + SZ512, WS_XS = WS_OG + SZ512, WS_YS = WS_XS + SZ512,
                 WS_GB = WS_YS + SZ512, WS_DT = WS_GB + SZ8, WS_SCR_END = WS_DT + 2 * SZ8;
constexpr size_t WS_RS = WS_SCR_END;
constexpr size_t WS_PWT = WS_RS + (size_t)M * 4;
constexpr size_t WS_AT = WS_PWT + (size_t)DEPTH * 4 * 128 * 128 * 2, WS_VWT = WS_AT + (size_t)DEPTH * BATCH * 1024 * DM * 2, WS_END = WS_VWT + (size_t)DEPTH * BATCH * DM * 1024 * 2;
constexpr int LA_QD = 0, LA_QK = 16384, LA_KE = 24576, LA_NW = 40960, LA_UCG = 57344, LA_RECG = 90112;
constexpr int LA_UCS = 40960, LA_RECS = 57344;
constexpr size_t WS_FG = WS_U, WS_FS = WS_FG + (size_t)512 * LA_RECG, WS_DLG = WS_FS + (size_t)1024 * LA_RECS, WS_DLS = WS_DLG + 512 * 4, WS_FEND = WS_DLS + 1024 * 4;
static_assert(WS_FEND <= WS_UEND, "records inside U");
static_assert(WS_Y + (size_t)M * DM * 4 <= WS_SCR_END, "Y inside the scan region");
static_assert(WS_HID + (size_t)M * DFF * 2 <= WS_UEND && (size_t)M * IN_PAD * 2 <= (size_t)120 * MiB, "HID and U inside the U region");
static_assert(WS_END <= (size_t)704 * MiB, "d_ws map fits 4 x the largest input");

constexpr int RING_OFF = 0, RING_BYTES = 131072;
constexpr int LDSCTL_OFF = RING_BYTES, MISC_OFF = LDSCTL_OFF + 320;
constexpr int LDS_BYTES = 147456;
constexpr int CW_BAR = 4096;

#define GAS __attribute__((address_space(1)))
#define LAS __attribute__((address_space(3)))
typedef unsigned short bf16;
typedef unsigned v4u __attribute__((ext_vector_type(4)));
typedef unsigned v2u __attribute__((ext_vector_type(2)));
typedef float f32x4 __attribute__((ext_vector_type(4)));
typedef short bf16x8 __attribute__((ext_vector_type(8)));
#define LDS_WAIT() asm volatile("s_waitcnt lgkmcnt(0)" ::: "memory")
#define VM_WAIT() asm volatile("s_waitcnt vmcnt(0)" ::: "memory")
typedef float f32x2v __attribute__((ext_vector_type(2)));
typedef __bf16 bf16x2_t __attribute__((ext_vector_type(2)));
__device__ __forceinline__ unsigned cvtpk(float lo, float hi) { const f32x2v v = {lo, hi}; return __builtin_bit_cast(unsigned, __builtin_convertvector(v, bf16x2_t)); }
__device__ __forceinline__ unsigned pk2(float lo, float hi) { return cvtpk(lo, hi); }
__device__ __forceinline__ unsigned f2bf(float f) { return cvtpk(f, 0.f) & 0xffffu; }
__device__ __forceinline__ float siluf(float v) { return v * __builtin_amdgcn_rcpf(1.0f + __expf(-v)); }
__device__ __forceinline__ float softplusf(float v) { return fmaxf(v, 0.f) + __logf(1.0f + __expf(-fabsf(v))); }
__device__ __forceinline__ float sigmoidf(float v) { return __builtin_amdgcn_rcpf(1.0f + __expf(-v)); }
__device__ __forceinline__ f32x4 ld4(const float* p) { return *(const f32x4*)p; }
__device__ __forceinline__ f32x4 silu4(f32x4 v) { return (f32x4){siluf(v.x), siluf(v.y), siluf(v.z), siluf(v.w)}; }
template <int CTRL> __device__ __forceinline__ float dppf(float v) { return __builtin_bit_cast(float, __builtin_amdgcn_update_dpp(0, __builtin_bit_cast(int, v), CTRL, 0xF, 0xF, true)); }
__device__ __forceinline__ float row16_sum(float v) { v += dppf<0xB1>(v); v += dppf<0x4E>(v); v += dppf<0x141>(v); v += dppf<0x140>(v); return v; }
__device__ __forceinline__ int opq(int v) { asm volatile("" : "+v"(v)); return v; }
__device__ __forceinline__ float shx(float v, int m, int lane) { return __builtin_bit_cast(float, __builtin_amdgcn_ds_bpermute((lane ^ m) << 2, __builtin_bit_cast(int, v))); }
__device__ __forceinline__ float wave_sum(float v) {
    v = row16_sum(v);
    const int iv = __builtin_bit_cast(int, v);
    return (__builtin_bit_cast(float, __builtin_amdgcn_readlane(iv, 0)) + __builtin_bit_cast(float, __builtin_amdgcn_readlane(iv, 16))) + (__builtin_bit_cast(float, __builtin_amdgcn_readlane(iv, 32)) + __builtin_bit_cast(float, __builtin_amdgcn_readlane(iv, 48)));
}

#define XB_TMO      128
#define XB_XCNT(j)  (256  + 64 * (j))
#define XB_XSUB(j)  (1280 + 64 * (j))
#define XB_XGEN(j)  (2304 + 64 * (j))
#define XB_TOP      3328
#define XB_TOPGEN   3392
#define XCD_BAR_WORDS 3456
#define XB_SPIN_CAP (1u << 18)

__device__ __forceinline__ unsigned xb_ld(unsigned* p)              { return __hip_atomic_load(p, __ATOMIC_RELAXED, __HIP_MEMORY_SCOPE_AGENT); }
__device__ __forceinline__ unsigned xb_add(unsigned* p, unsigned v) { return __hip_atomic_fetch_add(p, v, __ATOMIC_RELAXED, __HIP_MEMORY_SCOPE_AGENT); }
__device__ __forceinline__ unsigned xb_xcc_id() { return (unsigned)__builtin_amdgcn_s_getreg((3 << 11) | 20) & 0xFu; }
#define XB_SPIN(cond, bar) do { unsigned _sp = 0; while (cond) { __builtin_amdgcn_s_sleep(1); \
    if ((++_sp & 255u) == 0u) { if (xb_ld(&(bar)[XB_TMO])) break; if (_sp > XB_SPIN_CAP) { atomicAdd(&(bar)[XB_TMO], 1u); break; } } } } while (0)

struct XcdBarrier {
    unsigned* bar; unsigned x;
    volatile LAS unsigned* st;
};

__device__ __forceinline__ XcdBarrier xcd_barrier_post(unsigned* bar, volatile LAS unsigned* st) {
    XcdBarrier b; b.bar = bar; b.x = xb_xcc_id(); b.st = st;
    if (threadIdx.x == 0) (void)xb_add(&bar[XB_XCNT(b.x)], 1u);
    return b;
}
__device__ __forceinline__ void xcd_barrier_complete(unsigned* bar, unsigned x, unsigned& nloc, unsigned& nx) {
    const unsigned G = gridDim.x * gridDim.y * gridDim.z;
    unsigned sum, cnt, mine, sp = 0u;
    for (;;) {
        sum = 0u; cnt = 0u; mine = 0u;
#pragma unroll
        for (unsigned j = 0; j < 16; ++j) { const unsigned c = xb_ld(&bar[XB_XCNT(j)]); sum += c; cnt += (c > 0u) ? 1u : 0u; mine = (j == x) ? c : mine; }
        if (sum == G) break;
        __builtin_amdgcn_s_sleep(1);
        if ((++sp & 255u) == 0u) { if (xb_ld(&bar[XB_TMO])) break; if (sp > XB_SPIN_CAP) { atomicAdd(&bar[XB_TMO], 1u); break; } }
    }
    nloc = mine > 0u ? mine : 1u; nx = cnt > 0u ? cnt : 1u;
}

__device__ __forceinline__ void xcd_barrier(const XcdBarrier& b) {
    asm volatile("s_waitcnt vmcnt(0)" ::: "memory");
    __syncthreads();
    if (threadIdx.x == 0) {
        unsigned* bar = b.bar;
        __builtin_amdgcn_s_waitcnt(0);
        unsigned nloc = b.st[0], nx = b.st[1];
        if (nloc == 0u) { xcd_barrier_complete(bar, b.x, nloc, nx); b.st[0] = nloc; b.st[1] = nx; }
        const unsigned old = xb_add(&bar[XB_XSUB(b.x)], 1u);
        const unsigned gen = old / nloc;
        if (old + 1u == (gen + 1u) * nloc) {
            __builtin_amdgcn_fence(__ATOMIC_RELEASE, "agent");
            asm volatile("s_waitcnt vmcnt(0)" ::: "memory");
            const unsigned og = xb_add(&bar[XB_TOP], 1u);
            const unsigned tg = og / nx;
            if (og + 1u == (tg + 1u) * nx) xb_add(&bar[XB_TOPGEN], 1u);
            else XB_SPIN(xb_ld(&bar[XB_TOPGEN]) == tg, bar);
            __builtin_amdgcn_fence(__ATOMIC_ACQUIRE, "agent");
            xb_add(&bar[XB_XGEN(b.x)], 1u);
            asm volatile("s_waitcnt vmcnt(0)" ::: "memory");
        } else {
            XB_SPIN(xb_ld(&bar[XB_XGEN(b.x)]) == gen, bar);
            __builtin_amdgcn_fence(__ATOMIC_ACQUIRE, "agent");
            asm volatile("s_waitcnt vmcnt(0)" ::: "memory");
        }
    }
    __syncthreads();
}
struct Frame {
    LAS unsigned char* lds;
    volatile LAS unsigned* MISC;
    unsigned* ctl;
    int tid, lane, wave;
    int vcu, G;
    float* out; unsigned char* ws;
};
__device__ __forceinline__ const float* inp(int i) { const float* __attribute__((address_space(4))) const* tab = (const float* __attribute__((address_space(4))) const*)__builtin_amdgcn_kernarg_segment_ptr(); asm volatile("" : "+s"(tab)); return tab[i]; }
__device__ __forceinline__ bf16* wsb(const Frame& F, size_t off) { return (bf16*)(F.ws + off); }
__device__ __forceinline__ float* wsf(const Frame& F, size_t off) { return (float*)(F.ws + off); }

__device__ __forceinline__ void p0_transpose_item(const float* W, int K, int N, bf16* WT, int drow0, int k0, int n0, LAS float* scr, int lane, const float* gk = nullptr  ) {
    const int nn = n0 + (lane & 31); const bool ok = nn < N;
    float wv_[32];
#pragma unroll
    for (int i = 0; i < 32; ++i) { const int kk = 2 * i + (lane >> 5); wv_[i] = ok ? W[(size_t)(k0 + kk) * N + nn] : 0.f; }
#pragma unroll
    for (int i = 0; i < 32; ++i) { const int kk = 2 * i + (lane >> 5); scr[kk * 33 + (lane & 31)] = gk ? wv_[i] * gk[k0 + kk] : wv_[i]; }
    LDS_WAIT(); asm volatile("" ::: "memory");
    const int c = lane & 7;
#pragma unroll
    for (int j = 0; j < 4; ++j) { const int n = (lane >> 3) + 8 * j; const LAS float* s = scr + (8 * c) * 33 + n;
        v4u o; o.x = pk2(s[0 * 33], s[1 * 33]); o.y = pk2(s[2 * 33], s[3 * 33]); o.z = pk2(s[4 * 33], s[5 * 33]); o.w = pk2(s[6 * 33], s[7 * 33]);
        *(v4u*)(WT + (size_t)(drow0 + n) * K + k0 + 8 * c) = o; }
    LDS_WAIT(); asm volatile("" ::: "memory");
}
__device__ __forceinline__ void norm_row_to_bf16(const float* xrow, const float* g, bf16* orow, int lane) {
    const f32x4* xr = (const f32x4*)xrow + lane; const f32x4* gr = (const f32x4*)g + lane;
    f32x4 v[8]; float s = 0.f;
#pragma unroll
    for (int j = 0; j < 8; ++j) { v[j] = xr[64 * j]; s += (v[j].x * v[j].x + v[j].y * v[j].y) + (v[j].z * v[j].z + v[j].w * v[j].w); }
    const float rstd = __builtin_amdgcn_rsqf(wave_sum(s) * (1.0f / DM) + EPS);
    v2u* o8 = (v2u*)orow + lane;
#pragma unroll
    for (int j = 0; j < 8; ++j) { const f32x4 gg = gr[64 * j]; v2u w; w.x = pk2(v[j].x * rstd * gg.x, v[j].y * rstd * gg.y); w.y = pk2(v[j].z * rstd * gg.z, v[j].w * rstd * gg.w); o8[64 * j] = w; }
}
__device__ __forceinline__ void p0_prologue(Frame& F, int part) {
    LAS float* scr = (LAS float*)(F.lds + RING_OFF + F.wave * 16384);
    const int vb = part ? 64 : 0;
    if (F.vcu < vb) return;
    const int gw = (F.vcu - vb) * NWAVES + F.wave, NGW = (F.G - vb) * NWAVES; const int lane = opq(F.lane), tid = opq(F.tid);
    const int gt = (F.vcu - vb) * NWAVES * 64 + tid, NGT = NGW * 64;
    constexpr int NB_IN = (IN_COLS + 31) / 32;
    constexpr int I_IN = (DM / 64) * NB_IN, I_SQ = (DM / 64) * (DM / 32), I_KV = (DM / 64) * (2 * DM / 32), I_GU = (DM / 64) * (2 * DFF / 32), I_D = (DFF / 64) * (DM / 32);
    constexpr int I_LAYER = I_IN + 2 * I_SQ + I_KV + I_GU + I_D;
    for (int it = gw; it < I_LAYER; it += NGW) {
        const int l = part; int r = it;
        bf16* wl = wsb(F, WS_W + (size_t)l * W_LAYER);
        if (r < I_IN) { const int kb = r / NB_IN, nb = r % NB_IN; p0_transpose_item(inp(I_WIN) + (size_t)l * DM * IN_COLS, DM, IN_COLS, (bf16*)((char*)wl + WO_WIN), 32 * nb, 64 * kb, 32 * nb, scr, lane, inp(I_NORMG) + (size_t)(l * N_NORMS + MIX_PRE) * DM); continue; } r -= I_IN;
        if (r < I_SQ) { const int kb = r / (DM / 32), nb = r % (DM / 32); p0_transpose_item(inp(I_WOUT) + (size_t)l * DM * DM, DM, DM, (bf16*)((char*)wl + WO_WOUT), 32 * nb, 64 * kb, 32 * nb, scr, lane); continue; } r -= I_SQ;
        if (r < I_SQ) { const int kb = r / (DM / 32), nb = r % (DM / 32); p0_transpose_item(inp(I_WO) + (size_t)l * DM * DM, DM, DM, (bf16*)((char*)wl + WO_WO), 32 * nb, 64 * kb, 32 * nb, scr, lane); continue; } r -= I_SQ;
        if (r < I_KV) { const int kb = r / (2 * DM / 32), nb = r % (2 * DM / 32); p0_transpose_item(inp(I_WKV) + (size_t)l * DM * 2 * DM, DM, 2 * DM, (bf16*)((char*)wl + WO_WKV), 32 * nb, 64 * kb, 32 * nb, scr, lane); continue; } r -= I_KV;
        if (r < I_GU) { const int kb = r / (2 * DFF / 32), nb = r % (2 * DFF / 32); const int n0 = 32 * nb; const int up = n0 >= DFF ? 1 : 0, j0 = n0 - up * DFF;
            const int drow = (j0 >> 7) * 256 + up * 128 + (j0 & 127);
            p0_transpose_item(inp(I_WGU) + (size_t)l * DM * 2 * DFF, DM, 2 * DFF, (bf16*)((char*)wl + WO_WGU), drow, 64 * kb, n0, scr, lane, inp(I_NORMG) + (size_t)(l * N_NORMS + FFN_PRE) * DM); continue; } r -= I_GU;
        { const int kb = r / (DM / 32), nb = r % (DM / 32); p0_transpose_item(inp(I_WD) + (size_t)l * DFF * DM, DFF, DM, (bf16*)((char*)wl + WO_WD), 32 * nb, 64 * kb, 32 * nb, scr, lane); }
    }
    for (int i = gt; i < DM * DM / 8; i += NGT) { const int l = part, k = i;
        const float* src = inp(I_WQ) + (size_t)l * DM * DM + (size_t)k * 8; const float gq = inp(I_NORMG)[(size_t)(l * N_NORMS + XA_PRE) * DM + (k >> 8)]; const f32x4 a = ld4(src) * gq, b = ld4(src + 4) * gq;
        v4u o; o.x = pk2(a.x, a.y); o.y = pk2(a.z, a.w); o.z = pk2(b.x, b.y); o.w = pk2(b.z, b.w);
        ((v4u*)(F.ws + WS_W + (size_t)l * W_LAYER + WO_WQ))[k] = o; }
    { constexpr int ZR0 = 32 * NB_IN, ZN = (IN_PAD - ZR0) * DM / 8;
      const unsigned z0 = (unsigned)opq(0); const v4u zz = {z0, z0, z0, z0};
      for (int i = gt; i < ZN; i += NGT) { const int l = part, k = i;
          ((v4u*)(F.ws + WS_W + (size_t)l * W_LAYER + WO_WIN + (size_t)ZR0 * DM * 2))[k] = zz; } }
    if (part) return;
    for (int i = gt; i < DEPTH * 4 * 128 * 128; i += NGT) { const int c = i & 127, d = (i >> 7) & 127, lg = i >> 14;
        wsb(F, WS_PWT)[i] = (bf16)f2bf(inp(I_POOLW)[((size_t)lg * 128 + c) * 128 + d] * inp(I_POOLS)[(size_t)(lg >> 2) * GW + (lg & 3) * 128 + d]); }
    for (int m = gw; m < DEPTH * MROWS; m += NGW) { const int l = m / MROWS, r = m % MROWS;
        norm_row_to_bf16(inp(I_MEM) + (size_t)r * DM, inp(I_NORMG) + (size_t)(l * N_NORMS + MEM_NORM) * DM, wsb(F, WS_MEMN) + (size_t)m * DM, lane); }
    for (int m = gw; m < M; m += NGW) { const f32x4* xr = (const f32x4*)(inp(I_X) + (size_t)m * DM) + 2 * lane; v4u* xb = (v4u*)(wsb(F, WS_XN) + (size_t)m * DM) + lane; float ss = 0.f;
#pragma unroll
        for (int j = 0; j < 4; ++j) { const f32x4 a = xr[128 * j], b = xr[128 * j + 1]; ss += ((a.x * a.x + a.y * a.y) + (a.z * a.z + a.w * a.w)) + ((b.x * b.x + b.y * b.y) + (b.z * b.z + b.w * b.w));
            v4u o; o.x = pk2(a.x, a.y); o.y = pk2(a.z, a.w); o.z = pk2(b.x, b.y); o.w = pk2(b.z, b.w); xb[64 * j] = o; }
        ss = wave_sum(ss); if (lane == 0) wsf(F, WS_RS)[m] = __builtin_amdgcn_rsqf(ss * (1.0f / DM) + EPS); }
}

struct f32x8 { f32x4 lo, hi; };
__device__ __forceinline__ f32x8 ldu8(const bf16* p) { const v4u w = *(const v4u*)p; f32x8 r;
    r.lo = (f32x4){__builtin_bit_cast(float, w.x << 16), __builtin_bit_cast(float, w.x & 0xffff0000u), __builtin_bit_cast(float, w.y << 16), __builtin_bit_cast(float, w.y & 0xffff0000u)};
    r.hi = (f32x4){__builtin_bit_cast(float, w.z << 16), __builtin_bit_cast(float, w.z & 0xffff0000u), __builtin_bit_cast(float, w.w << 16), __builtin_bit_cast(float, w.w & 0xffff0000u)}; return r; }
__device__ __forceinline__ f32x8 cvt8(const v4u w) { f32x8 r;
    r.lo = (f32x4){__builtin_bit_cast(float, w.x << 16), __builtin_bit_cast(float, w.x & 0xffff0000u), __builtin_bit_cast(float, w.y << 16), __builtin_bit_cast(float, w.y & 0xffff0000u)};
    r.hi = (f32x4){__builtin_bit_cast(float, w.z << 16), __builtin_bit_cast(float, w.z & 0xffff0000u), __builtin_bit_cast(float, w.w << 16), __builtin_bit_cast(float, w.w & 0xffff0000u)}; return r; }
__device__ __forceinline__ f32x8 ld8f(const float* p) { f32x8 r; r.lo = ld4(p); r.hi = ld4(p + 4); return r; }
__device__ __forceinline__ f32x8 operator*(const f32x8& a, const f32x8& b) { return f32x8{a.lo * b.lo, a.hi * b.hi}; }
__device__ __forceinline__ f32x8 operator+(const f32x8& a, const f32x8& b) { return f32x8{a.lo + b.lo, a.hi + b.hi}; }
__device__ __forceinline__ f32x8 silu8(const f32x8& a) { return f32x8{silu4(a.lo), silu4(a.hi)}; }
__device__ __forceinline__ float sumsq8(const f32x8& y) { return ((y.lo.x * y.lo.x + y.lo.y * y.lo.y) + (y.lo.z * y.lo.z + y.lo.w * y.lo.w)) + ((y.hi.x * y.hi.x + y.hi.y * y.hi.y) + (y.hi.z * y.hi.z + y.hi.w * y.hi.w)); }
__device__ __forceinline__ v4u pack8u(const f32x8& y) { v4u o; o.x = pk2(y.lo.x, y.lo.y); o.y = pk2(y.lo.z, y.lo.w); o.z = pk2(y.hi.x, y.hi.y); o.w = pk2(y.hi.z, y.hi.w); return o; }
__device__ __forceinline__ void mixer_prep_phase(Frame& F, int l) {
    const int gw = F.vcu * NWAVES + F.wave, NGW = F.G * NWAVES, lane = opq(F.lane), tid = opq(F.tid);
    const bf16* U = wsb(F, WS_U);
    bf16* MIX = wsb(F, WS_MIX);
    constexpr int NSTRIP = M / 16, NTYPE = 12;
    for (int it = gw; it < NTYPE * NSTRIP; it += NGW) {
        const int type = it % NTYPE, strip = it / NTYPE, r0 = strip * 16, pos0 = r0 & (SEQ - 1), c = lane * 8;
        const bf16* ur0 = U + (size_t)r0 * IN_PAD;
        if (type == 0) {
            const float* cw = inp(I_CONVA) + (size_t)l * 3 * GW + c;
            const f32x8 w0 = ld8f(cw), w1 = ld8f(cw + GW), w2 = ld8f(cw + 2 * GW);
            const v4u z4 = {0u, 0u, 0u, 0u};
#pragma unroll 1
            for (int hf = 0; hf < 2; ++hf) {
                const bf16* ub = ur0 + (size_t)(8 * hf) * IN_PAD;
                v4u rc[10], rh[10], rb[8];
#pragma unroll
                for (int i = 0; i < 10; ++i) { const int ri = i - 2; if (ri >= 0 || pos0 > 0 || hf > 0) { rc[i] = *(const v4u*)(ub + (ptrdiff_t)ri * IN_PAD + UA_C + c); rh[i] = *(const v4u*)(ub + (ptrdiff_t)ri * IN_PAD + UA_H + c); } else { rc[i] = z4; rh[i] = z4; } }
#pragma unroll
                for (int i = 0; i < 8; ++i) rb[i] = *(const v4u*)(ub + (size_t)i * IN_PAD + UA_B + c);
                f32x8 p2 = cvt8(rc[0]) * cvt8(rh[0]), p1 = cvt8(rc[1]) * cvt8(rh[1]);
#pragma unroll
                for (int i = 0; i < 8; ++i) { const f32x8 p0 = cvt8(rc[i + 2]) * cvt8(rh[i + 2]); const f32x8 y = cvt8(rb[i]) * (w0 * p2 + w1 * p1 + w2 * p0);
                    *(v4u*)(MIX + (size_t)(r0 + 8 * hf + i) * DM + c) = pack8u(y); p2 = p1; p1 = p0; }
            }
        } else if (type < 4) {
            const int gi = type - 1, cc = gi * GW + c;
            const float* cw = inp(I_GCONV) + (size_t)l * 4 * 3 * GW + cc;
            const f32x8 w0 = ld8f(cw), w1 = ld8f(cw + 3 * GW), w2 = ld8f(cw + 6 * GW), w3 = ld8f(cw + 9 * GW);
            v4u xr[19];
#pragma unroll
            for (int i = 0; i < 19; ++i) { const int ri = i - 3; if (ri >= 0 || pos0 > 0) xr[i] = *(const v4u*)(ur0 + (ptrdiff_t)ri * IN_PAD + UC_Q + cc); else xr[i] = (v4u){0u, 0u, 0u, 0u}; }
            float* dst = (gi == 0) ? wsf(F, WS_QN) : (gi == 1) ? wsf(F, WS_KN) : wsf(F, WS_VV);
            const float qs = (gi == 0) ? 0.08838834764831845f : 1.0f;
            f32x8 x3 = cvt8(xr[0]), x2 = cvt8(xr[1]), x1 = cvt8(xr[2]);
#pragma unroll
            for (int i = 0; i < 16; ++i) { const f32x8 x0 = cvt8(xr[i + 3]); f32x8 y = silu8(w0 * x3 + w1 * x2 + w2 * x1 + w3 * x0); x3 = x2; x2 = x1; x1 = x0;
                if (gi < 2) { float ss = row16_sum(sumsq8(y));
                    const float sc = qs * __builtin_amdgcn_rsqf(ss + EPS); y.lo = y.lo * sc; y.hi = y.hi * sc; }
                float* d = dst + (size_t)(r0 + i) * GW + c; *(f32x4*)d = y.lo; *(f32x4*)(d + 4) = y.hi; }
        } else if (type < 6) {
            const int gi = type - 4, cc = gi * GW + c;
            const float* cw = inp(I_SCONVW) + (size_t)l * 4 * 1024 + cc;
            const f32x8 w0 = ld8f(cw), w1 = ld8f(cw + 1024), w2 = ld8f(cw + 2048), w3 = ld8f(cw + 3072), bb = ld8f(inp(I_SCONVB) + (size_t)l * 1024 + cc);
            v4u xr[19];
#pragma unroll
            for (int i = 0; i < 19; ++i) { const int ri = i - 3; if (ri >= 0 || pos0 > 0) xr[i] = *(const v4u*)(ur0 + (ptrdiff_t)ri * IN_PAD + UD_X + cc); else xr[i] = (v4u){0u, 0u, 0u, 0u}; }
            f32x8 x3 = cvt8(xr[0]), x2 = cvt8(xr[1]), x1 = cvt8(xr[2]);
            float* dst; int ld, co;
            if (gi == 0) { dst = wsf(F, WS_XS); ld = 512; co = c; } else if (c < 256) { dst = wsf(F, WS_BS); ld = 256; co = c; } else { dst = wsf(F, WS_CS); ld = 256; co = c - 256; }
#pragma unroll
            for (int i = 0; i < 16; ++i) { const f32x8 x0 = cvt8(xr[i + 3]); const f32x8 y = silu8(w0 * x3 + w1 * x2 + w2 * x1 + w3 * x0 + bb); x3 = x2; x2 = x1; x1 = x0;
                float* d = dst + (size_t)(r0 + i) * ld + co; *(f32x4*)d = y.lo; *(f32x4*)(d + 4) = y.hi; }
        } else if (type < 8) {
            const int zo = (type == 6) ? UC_Z : UD_Z; bf16* dst = wsb(F, (type == 6) ? WS_ZG : WS_ZS);
            v4u z[16];
#pragma unroll
            for (int i = 0; i < 16; ++i) z[i] = *(const v4u*)(ur0 + (size_t)i * IN_PAD + zo + c);
#pragma unroll
            for (int i = 0; i < 16; ++i) *(v4u*)(dst + (size_t)(r0 + i) * GW + c) = z[i];
        } else {
            const int gi = type - 8, w = 2 << gi;
            LAS float* scr = (LAS float*)(F.lds + RING_OFF + F.wave * 16384);
            const int c0 = UB + gi * 128 + lane * 2;
            float uv0[31], uv1[31];
#pragma unroll
            for (int i = 0; i < 31; ++i) { const int ri = i - 15; float a0 = 0.f, a1 = 0.f;
                if (ri >= 0 || pos0 > 0) { const unsigned wd = *(const unsigned*)(ur0 + (ptrdiff_t)ri * IN_PAD + c0); a0 = __builtin_bit_cast(float, wd << 16); a1 = __builtin_bit_cast(float, wd & 0xffff0000u); }
                uv0[i] = a0; uv1[i] = a1; }
            float r0s = 0.f, r1s = 0.f;
#pragma unroll
            for (int s = 1; s < 16; ++s) if (s < w) { r0s += uv0[15 - s]; r1s += uv1[15 - s]; }
#pragma unroll
            for (int i = 0; i < 16; ++i) { const int pos = pos0 + i; const float a0 = uv0[15 + i], a1 = uv1[15 + i];
                r0s += a0; r1s += a1;
                const float cnt = (float)((pos + 1 < w) ? pos + 1 : w);
                const float rc = __builtin_amdgcn_rcpf(cnt); scr[i * 128 + lane * 2] = r0s * rc - a0; scr[i * 128 + lane * 2 + 1] = r1s * rc - a1;
                float d0 = 0.f, d1 = 0.f;
#pragma unroll
                for (int g2 = 0; g2 < 4; ++g2) if (gi == g2) { d0 = uv0[15 + i - (2 << g2) + 1]; d1 = uv1[15 + i - (2 << g2) + 1]; }
                r0s -= d0; r1s -= d1; }
            LDS_WAIT(); asm volatile("" ::: "memory");
            const bf16* pwt = wsb(F, WS_PWT) + ((size_t)l * 4 + gi) * 128 * 128 + (size_t)(lane & 15) * 128 + (lane >> 4) * 8;
            bf16x8 bfr[4];
#pragma unroll
            for (int ks = 0; ks < 4; ++ks) { const LAS float* pr = scr + (lane & 15) * 128 + 32 * ks + (lane >> 4) * 8; const f32x4 p0 = *(const LAS f32x4*)pr, p1 = *(const LAS f32x4*)(pr + 4);
                v4u w; w.x = pk2(p0.x, p0.y); w.y = pk2(p0.z, p0.w); w.z = pk2(p1.x, p1.y); w.w = pk2(p1.z, p1.w); bfr[ks] = __builtin_bit_cast(bf16x8, w); }
            bf16* orow = MIX + (size_t)(r0 + (lane & 15)) * DM + GW + gi * 128 + (lane >> 4) * 4;
#pragma unroll
            for (int nh = 0; nh < 2; ++nh) {
                bf16x8 afr[4][4];
#pragma unroll
                for (int nt = 0; nt < 4; ++nt)
#pragma unroll
                    for (int ks = 0; ks < 4; ++ks) afr[nt][ks] = *(const bf16x8*)(pwt + (size_t)((nh * 4 + nt) * 16) * 128 + 32 * ks);
#pragma unroll
                for (int nt = 0; nt < 4; ++nt) { f32x4 acc = {0.f, 0.f, 0.f, 0.f};
#pragma unroll
                    for (int ks = 0; ks < 4; ++ks) acc = __builtin_amdgcn_mfma_f32_16x16x32_bf16(afr[nt][ks], bfr[ks], acc, 0, 0, 0);
                    v2u o; o.x = pk2(acc.x, acc.y); o.y = pk2(acc.z, acc.w); *(v2u*)(orow + (nh * 4 + nt) * 16) = o; }
            }
            LDS_WAIT(); asm volatile("" ::: "memory");
        }
    }
    for (int i = (F.vcu * NWAVES * 64) + tid; i < M * 16; i += F.G * NWAVES * 64) { const int t = i >> 4, j = i & 15; const bf16* ur = U + (size_t)t * IN_PAD;
#define UF(col) __builtin_bit_cast(float, (unsigned)ur[col] << 16)
        if (j < 4) { wsf(F, WS_GB)[(size_t)t * 8 + 2 * j] = -__expf(inp(I_GALOG)[l * 4 + j]) * softplusf(UF(UC_A + j) + inp(I_GDTB)[l * 4 + j]); }
        else if (j < 8) { wsf(F, WS_GB)[(size_t)t * 8 + 2 * (j - 4) + 1] = sigmoidf(UF(UC_B + (j - 4))); }
        else { const int hh = j - 8; const float dt = softplusf(UF(UD_DT + hh) + inp(I_SDTB)[l * 8 + hh]);
            wsf(F, WS_DT)[(size_t)t * 16 + 2 * hh] = -__expf(inp(I_SALOG)[l * 8 + hh]) * dt; wsf(F, WS_DT)[(size_t)t * 16 + 2 * hh + 1] = dt; }
#undef UF
    }
}

typedef float f32x16 __attribute__((ext_vector_type(16)));
__device__ __forceinline__ bf16x8 pack8(float a0, float a1, float a2, float a3, float a4, float a5, float a6, float a7) { v4u w; w.x = cvtpk(a0, a1); w.y = cvtpk(a2, a3); w.z = cvtpk(a4, a5); w.w = cvtpk(a6, a7); return __builtin_bit_cast(bf16x8, w); }
#define PACK_STEP(x, s) pack8((x)[8 * (s)], (x)[8 * (s) + 1], (x)[8 * (s) + 2], (x)[8 * (s) + 3], (x)[8 * (s) + 4], (x)[8 * (s) + 5], (x)[8 * (s) + 6], (x)[8 * (s) + 7])
#define MFMA32(a, b, c) __builtin_amdgcn_mfma_f32_32x32x16_bf16((a), (b), (c), 0, 0, 0)
__device__ __forceinline__ int crow(int reg, int h) { return (reg & 3) + 8 * (reg >> 2) + 4 * h; }
constexpr int LA_KB = 0;
constexpr int LA_QB = LA_KB + 64 * 136 * 2;
constexpr int LA_KGT = LA_QB + 64 * 136 * 2;
constexpr int LA_VBT = LA_KGT + 128 * 72 * 2;
constexpr int LA_KET = LA_VBT + 128 * 72 * 2;
constexpr int LA_M = LA_KET + 128 * 72 * 2;
constexpr int LA_TB = LA_M + 64 * 68 * 4;
constexpr int LA_VEC = LA_TB + 64 * 72 * 2;
static_assert(LA_VEC + 1024 <= RING_BYTES, "la LDS map");
__device__ __forceinline__ bf16x8 lds_frag(const LAS unsigned char* base, int row, int stride_el, int col) { return *(const LAS bf16x8*)(base + ((size_t)row * stride_el + col) * 2); }
__device__ __forceinline__ float wave_incl_scan(float v, int lane) {
#pragma unroll
    for (int d = 1; d < 64; d <<= 1) { const float o = __builtin_bit_cast(float, __builtin_amdgcn_ds_bpermute((lane - d) << 2, __builtin_bit_cast(int, v))); if (lane >= d) v += o; }
    return v;
}
__device__ __forceinline__ void store_qk_frag(const f32x16& acc, const LAS float* Gv, int mt, int rt, int r, int h, int lane, bf16* qkf) {
    const int l = 32 * rt + r; const float Gl = Gv[l];
    float v[16];
#pragma unroll
    for (int q = 0; q < 16; ++q) { const int m = 32 * mt + crow(q, h); v[q] = (m <= l) ? acc[q] * __expf(Gl - Gv[m]) : 0.f; }
    *(bf16x8*)(qkf + ((size_t)(rt * 4 + 2 * mt + 0) * 64 + lane) * 8) = pack8(v[0], v[1], v[2], v[3], v[4], v[5], v[6], v[7]);
    *(bf16x8*)(qkf + ((size_t)(rt * 4 + 2 * mt + 1) * 64 + lane) * 8) = pack8(v[8], v[9], v[10], v[11], v[12], v[13], v[14], v[15]);
}
__device__ __forceinline__ void qd_frag_task(const float* qrows, int ldq, const LAS float* Gv, int task, int r, int h, int lane, bf16* qdf) {
    const int rt = task >> 3, ks = task & 7, l = 32 * rt + r, k0 = 16 * ks + 4 * h; const float e = __expf(Gv[l]);
    const f32x4 a = ld4(qrows + (size_t)l * ldq + k0), b = ld4(qrows + (size_t)l * ldq + k0 + 8);
    *(bf16x8*)(qdf + ((size_t)task * 64 + lane) * 8) = pack8(a.x * e, a.y * e, a.z * e, a.w * e, b.x * e, b.y * e, b.z * e, b.w * e);
}
__device__ __forceinline__ void qd_frag_task4(const float* qrows, int ldq, const LAS float* Gv, int task0, int r, int h, int lane, bf16* qdf) {
    f32x4 a[4], b[4]; float e[4];
#pragma unroll
    for (int t = 0; t < 4; ++t) { const int task = task0 + t, rt = task >> 3, ks = task & 7, l = 32 * rt + r, k0 = 16 * ks + 4 * h;
        a[t] = ld4(qrows + (size_t)l * ldq + k0); b[t] = ld4(qrows + (size_t)l * ldq + k0 + 8); e[t] = __expf(Gv[l]); }
#pragma unroll
    for (int t = 0; t < 4; ++t) *(bf16x8*)(qdf + ((size_t)(task0 + t) * 64 + lane) * 8) = pack8(a[t].x * e[t], a[t].y * e[t], a[t].z * e[t], a[t].w * e[t], b[t].x * e[t], b[t].y * e[t], b[t].z * e[t], b[t].w * e[t]);
}
__device__ __forceinline__ void ke_frag_task(const LAS unsigned char* ket, int task, int r, int h, int lane, bf16* kef) {
    const int it = task >> 2, ks = task & 3, dk = 32 * it + r, l0 = 16 * ks + 4 * h;
    const v2u lo = *(const LAS v2u*)(ket + ((size_t)dk * 72 + l0) * 2), hi = *(const LAS v2u*)(ket + ((size_t)dk * 72 + l0 + 8) * 2);
    v4u w; w.x = lo.x; w.y = lo.y; w.z = hi.x; w.w = hi.y;
    *(v4u*)(kef + ((size_t)task * 64 + lane) * 8) = w;
}

#ifndef LAREP
#define LAREP 0
#endif
#define LDS_SYNC() do { asm volatile("s_waitcnt lgkmcnt(0)" ::: "memory"); __builtin_amdgcn_s_barrier(); asm volatile("" ::: "memory"); } while (0)
__device__ __forceinline__ void la_prep_phase(Frame& F, int l_unused) {
    const int tid0 = opq(F.tid), wv = F.wave;
    LAS unsigned char* L = F.lds + RING_OFF; asm volatile("" : "+v"(L));
    LAS float* Gv = (LAS float*)(L + LA_VEC); LAS float* Bv = Gv + 64;
    LAS float* Mf = (LAS float*)(L + LA_M);
    const f32x16 zero16 = {0.f, 0.f, 0.f, 0.f, 0.f, 0.f, 0.f, 0.f, 0.f, 0.f, 0.f, 0.f, 0.f, 0.f, 0.f, 0.f};
    for (int item = F.vcu; item < 512; item += F.G) {
        const int tid = opq(tid0), lane = tid & 63, r = lane & 31, h = lane >> 5;
        const int seq = item >> 5, ch = item & 31, b = seq >> 2, hd = seq & 3;
        const size_t t0 = (size_t)b * SEQ + ch * 64;
        const float* KN = wsf(F, WS_KN) + t0 * GW + hd * 128; const float* QN = wsf(F, WS_QN) + t0 * GW + hd * 128; const float* VV = wsf(F, WS_VV) + t0 * GW + hd * 128;
        unsigned char* rec = F.ws + WS_FG + (size_t)item * LA_RECG;
        const int c = tid & 127, lg = tid >> 7;
        const f32x2v gb = *(const f32x2v*)(wsf(F, WS_GB) + (t0 + lane) * 8 + 2 * hd);
        float kr[16], qr[16], vr[16];
#pragma unroll
        for (int i = 0; i < 16; ++i) { const int l = lg * 16 + i; kr[i] = KN[(size_t)l * GW + c]; qr[i] = QN[(size_t)l * GW + c]; vr[i] = VV[(size_t)l * GW + c]; }
        f32x4 qa[4], qb[4];
        { const int qw = (wv >= 2 && wv <= 5) ? wv - 2 : 0;
#pragma unroll
            for (int t = 0; t < 4; ++t) { const int task = 4 * qw + t, rt = task >> 3, ks = task & 7, l = 32 * rt + r, k0 = 16 * ks + 4 * h; qa[t] = ld4(QN + (size_t)l * GW + k0); qb[t] = ld4(QN + (size_t)l * GW + k0 + 8); } }
        if (wv == 0) { Gv[lane] = wave_incl_scan(gb.x, lane); Bv[lane] = gb.y; }
        LDS_SYNC();
        const float G63 = Gv[63];
#pragma unroll
        for (int i = 0; i < 16; ++i) { const int l = lg * 16 + i; const float kv = kr[i], qv = qr[i], vv = vr[i];
            const float Gl = Gv[l], bl = Bv[l];
            ((LAS bf16*)(L + LA_KB))[l * 136 + c] = (bf16)f2bf(kv); ((LAS bf16*)(L + LA_QB))[l * 136 + c] = (bf16)f2bf(qv);
            ((LAS bf16*)(L + LA_KGT))[c * 72 + l] = (bf16)f2bf(-kv * bl * __expf(Gl)); ((LAS bf16*)(L + LA_VBT))[c * 72 + l] = (bf16)f2bf(vv * bl);
            ((LAS bf16*)(L + LA_KET))[c * 72 + l] = (bf16)f2bf(kv * __expf(G63 - Gl)); }
        LDS_SYNC();
        if (wv < 4) { const int it = wv >> 1, jt = wv & 1; f32x16 acc = zero16;
            if (!(it == 0 && jt == 1)) {
#pragma unroll
                for (int ks = 0; ks < 8; ++ks) acc = MFMA32(lds_frag(L + LA_KB, 32 * it + r, 136, 16 * ks + 8 * h), lds_frag(L + LA_KB, 32 * jt + r, 136, 16 * ks + 8 * h), acc); }
            const int j = 32 * jt + r; const float Gj = Gv[j];
#pragma unroll
            for (int q = 0; q < 16; ++q) { const int i = 32 * it + crow(q, h); Mf[i * 68 + j] = (j < i) ? Bv[i] * acc[q] * __expf(Gv[i] - Gj) : 0.f; }
        } else { const int mt = (wv - 4) >> 1, rt = (wv - 4) & 1; f32x16 acc = zero16;
            if (!(mt == 1 && rt == 0)) {
#pragma unroll
                for (int ks = 0; ks < 8; ++ks) acc = MFMA32(lds_frag(L + LA_KB, 32 * mt + r, 136, 16 * ks + 8 * h), lds_frag(L + LA_QB, 32 * rt + r, 136, 16 * ks + 8 * h), acc); }
            store_qk_frag(acc, Gv, mt, rt, r, h, lane, (bf16*)(rec + LA_QK)); }
        LDS_SYNC();
        f32x16 Pacc = zero16;
        if (wv < 2) {
            const int ln = opq(lane), cc = ln & 31, bo = 32 * wv;
            float Tc[32];
#pragma unroll
            for (int i = 0; i < 32; ++i) {
                float a0 = (i == cc) ? 1.f : 0.f, a1 = 0.f, a2 = 0.f, a3 = 0.f;
#pragma unroll
                for (int j4 = 0; j4 < (i + 3) / 4; ++j4) { const f32x4 m = *(const LAS f32x4*)(Mf + (bo + i) * 68 + bo + 4 * j4);
                    a0 -= m.x * Tc[4 * j4]; if (4 * j4 + 1 < i) a1 -= m.y * Tc[4 * j4 + 1]; if (4 * j4 + 2 < i) a2 -= m.z * Tc[4 * j4 + 2]; if (4 * j4 + 3 < i) a3 -= m.w * Tc[4 * j4 + 3]; }
                Tc[i] = (a0 + a1) + (a2 + a3);
                ((LAS bf16*)(L + LA_TB))[(bo + i) * 72 + bo + cc] = (bf16)f2bf(Tc[i]);
                if (wv == 0) ((LAS bf16*)(L + LA_TB))[i * 72 + 32 + cc] = (bf16)0;
                if ((i & 7) == 7) asm volatile("" ::: "memory");
            }
            if (wv == 0) {
#pragma unroll
                for (int s2 = 0; s2 < 2; ++s2) {
                    const LAS float* mr = Mf + (32 + r) * 68 + 16 * s2 + 8 * h; const f32x4 m0 = *(const LAS f32x4*)mr, m1 = *(const LAS f32x4*)(mr + 4);
                    const bf16x8 af = pack8(m0.x, m0.y, m0.z, m0.w, m1.x, m1.y, m1.z, m1.w);
                    const bf16x8 bfr = h ? pack8(Tc[16 * s2 + 8], Tc[16 * s2 + 9], Tc[16 * s2 + 10], Tc[16 * s2 + 11], Tc[16 * s2 + 12], Tc[16 * s2 + 13], Tc[16 * s2 + 14], Tc[16 * s2 + 15])
                                          : pack8(Tc[16 * s2 + 0], Tc[16 * s2 + 1], Tc[16 * s2 + 2], Tc[16 * s2 + 3], Tc[16 * s2 + 4], Tc[16 * s2 + 5], Tc[16 * s2 + 6], Tc[16 * s2 + 7]);
                    Pacc = MFMA32(af, bfr, Pacc); }
                if (lane == 0) wsf(F, WS_DLG)[item] = __expf(G63);
            }
        } else if (wv <= 5) {
#pragma unroll
            for (int t = 0; t < 4; ++t) { const int task = 4 * (wv - 2) + t, rt = task >> 3; const float e = __expf(Gv[32 * rt + r]);
                *(bf16x8*)((bf16*)(rec + LA_QD) + ((size_t)task * 64 + lane) * 8) = pack8(qa[t].x * e, qa[t].y * e, qa[t].z * e, qa[t].w * e, qb[t].x * e, qb[t].y * e, qb[t].z * e, qb[t].w * e); }
        } else {
#pragma unroll
            for (int t = 0; t < 8; ++t) ke_frag_task(L + LA_KET, 8 * (wv - 6) + t, r, h, lane, (bf16*)(rec + LA_KE)); }
        LDS_SYNC();
        if (wv == 0) {
            f32x16 t21 = zero16;
#pragma unroll
            for (int s2 = 0; s2 < 2; ++s2) {
                const LAS unsigned char* tr = L + LA_TB + ((size_t)(32 + r) * 72 + 32 + 16 * s2 + 4 * h) * 2;
                const v2u lo = *(const LAS v2u*)tr, hi = *(const LAS v2u*)(tr + 16); v4u w; w.x = lo.x; w.y = lo.y; w.z = hi.x; w.w = hi.y;
                t21 = MFMA32(__builtin_bit_cast(bf16x8, w), PACK_STEP(Pacc, s2), t21); }
#pragma unroll
            for (int q = 0; q < 16; ++q) ((LAS bf16*)(L + LA_TB))[(32 + crow(q, h)) * 72 + r] = (bf16)f2bf(-t21[q]);
        }
        LDS_SYNC();
#pragma unroll 1
        for (int tile = wv; tile < 16; tile += 8) {
            f32x16 acc = zero16;
            if (tile < 8) { const int it = tile >> 1, rt = tile & 1;
#pragma unroll
                for (int ks = 0; ks < 4; ++ks) acc = MFMA32(lds_frag(L + LA_KGT, 32 * it + r, 72, 16 * ks + 8 * h), lds_frag(L + LA_TB, 32 * rt + r, 72, 16 * ks + 8 * h), acc);
                bf16* nw = (bf16*)(rec + LA_NW);
                *(bf16x8*)(nw + ((size_t)(rt * 8 + 2 * it + 0) * 64 + lane) * 8) = PACK_STEP(acc, 0);
                *(bf16x8*)(nw + ((size_t)(rt * 8 + 2 * it + 1) * 64 + lane) * 8) = PACK_STEP(acc, 1);
            } else { const int rt = (tile - 8) >> 2, dvt = (tile - 8) & 3;
#pragma unroll
                for (int ks = 0; ks < 4; ++ks) acc = MFMA32(lds_frag(L + LA_TB, 32 * rt + r, 72, 16 * ks + 8 * h), lds_frag(L + LA_VBT, 32 * dvt + r, 72, 16 * ks + 8 * h), acc);
                float* uc = (float*)(rec + LA_UCG) + ((size_t)(dvt * 2 + rt) * 4 * 64 + lane) * 4;
#pragma unroll
                for (int q4 = 0; q4 < 4; ++q4) *(f32x4*)(uc + (size_t)q4 * 256) = (f32x4){acc[4 * q4], acc[4 * q4 + 1], acc[4 * q4 + 2], acc[4 * q4 + 3]};
            }
        }
        LDS_SYNC();
    }
    for (int item = F.vcu; item < 256; item += F.G) {
        const int tid = opq(tid0), lane = tid & 63, r = lane & 31, h = lane >> 5;
        const int b = item >> 6, ch = (item >> 1) & 31, g = item & 1;
        const size_t t0 = (size_t)b * SEQ + ch * 64;
        const float* BS = wsf(F, WS_BS) + t0 * 256 + g * 128; const float* CS = wsf(F, WS_CS) + t0 * 256 + g * 128;
        const int c = tid & 127, lg = tid >> 7;
        float br[16], cr[16];
#pragma unroll
        for (int i = 0; i < 16; ++i) { const int l = lg * 16 + i; br[i] = BS[(size_t)l * 256 + c]; cr[i] = CS[(size_t)l * 256 + c]; }
        f32x2v ad[4];
#pragma unroll
        for (int hi = 0; hi < 4; ++hi) ad[hi] = *(const f32x2v*)(wsf(F, WS_DT) + (t0 + lane) * 16 + 2 * (4 * g + hi));
        f32x4 ca[4], cb[4]; float xv[4][16];
        const int sl = (wv >> 1) & 1, rt2 = wv & 1;
        {
#pragma unroll
            for (int t = 0; t < 4; ++t) { const int task = 4 * (wv & 3) + t, rt = task >> 3, ks = task & 7, l = 32 * rt + r, k0 = 16 * ks + 4 * h; ca[t] = ld4(CS + (size_t)l * 256 + k0); cb[t] = ld4(CS + (size_t)l * 256 + k0 + 8); }
#pragma unroll
            for (int hi = 0; hi < 4; ++hi)
#pragma unroll
                for (int q = 0; q < 16; ++q) xv[hi][q] = wsf(F, WS_XS)[(t0 + 32 * rt2 + crow(q, h)) * GW + (4 * g + hi) * 64 + 32 * sl + r]; }
#pragma unroll
        for (int i = 0; i < 16; ++i) { const int l = lg * 16 + i;
            ((LAS bf16*)(L + LA_KB))[l * 136 + c] = (bf16)f2bf(br[i]); ((LAS bf16*)(L + LA_QB))[l * 136 + c] = (bf16)f2bf(cr[i]); }
        if (wv == 0) {
#pragma unroll
            for (int hi = 0; hi < 4; ++hi) { Gv[hi * 64 + lane] = wave_incl_scan(ad[hi].x, lane); Gv[256 + hi * 64 + lane] = ad[hi].y; } }
        LDS_SYNC();
        f32x16 raw = zero16;
        const int mt = (wv >> 1) & 1, rt = wv & 1;
        if (wv < 4 && !(mt == 1 && rt == 0)) {
#pragma unroll
            for (int ks = 0; ks < 8; ++ks) raw = MFMA32(lds_frag(L + LA_KB, 32 * mt + r, 136, 16 * ks + 8 * h), lds_frag(L + LA_QB, 32 * rt + r, 136, 16 * ks + 8 * h), raw); }
#pragma unroll
        for (int hi = 0; hi < 4; ++hi) {
            const int hh = 4 * g + hi, seq = b * 8 + hh;
            unsigned char* rec = F.ws + WS_FS + ((size_t)seq * 32 + ch) * LA_RECS;
            const LAS float* Gh = Gv + hi * 64; const LAS float* Dh = Gv + 256 + hi * 64;
            const float G63 = Gh[63];
#pragma unroll
            for (int i = 0; i < 16; ++i) { const int l = lg * 16 + i; ((LAS bf16*)(L + LA_KET))[c * 72 + l] = (bf16)f2bf(br[i] * __expf(G63 - Gh[l])); }
            if (wv < 4) {
                store_qk_frag(raw, Gh, mt, rt, r, h, lane, (bf16*)(rec + LA_QK));
#pragma unroll
                for (int t = 0; t < 4; ++t) { const int task = 4 * wv + t, rtq = task >> 3; const float e = __expf(Gh[32 * rtq + r]);
                    *(bf16x8*)((bf16*)(rec + LA_QD) + ((size_t)task * 64 + lane) * 8) = pack8(ca[t].x * e, ca[t].y * e, ca[t].z * e, ca[t].w * e, cb[t].x * e, cb[t].y * e, cb[t].z * e, cb[t].w * e); }
            } else {
                float* uc = (float*)(rec + LA_UCS) + ((size_t)(sl * 2 + rt2) * 4 * 64 + lane) * 4;
#pragma unroll
                for (int q4 = 0; q4 < 4; ++q4) { f32x4 v;
#pragma unroll
                    for (int e = 0; e < 4; ++e) v[e] = xv[hi][4 * q4 + e] * Dh[32 * rt2 + crow(4 * q4 + e, h)];
                    *(f32x4*)(uc + (size_t)q4 * 256) = v; }
            }
            if (tid == 0) wsf(F, WS_DLS)[seq * 32 + ch] = __expf(G63);
            LDS_SYNC();
            if (wv >= 4) {
#pragma unroll
                for (int t = 0; t < 4; ++t) ke_frag_task(L + LA_KET, 4 * (wv - 4) + t, r, h, lane, (bf16*)(rec + LA_KE)); }
            LDS_SYNC();
        }
    }
}

template <bool HAS_W> __device__ __forceinline__ void la_seq_wg(LAS unsigned char* ring  , const unsigned char* recs, int recsz, int uc_off, const float* dls, float* outp  , int slice, int lane, int wv) {
    constexpr int NFR = HAS_W ? 56 : 40;
    constexpr int SLOT = (NFR + 8) * 1024;
    const int r = lane & 31, h = lane >> 5;
    const bool loader = (wv >= 1);
    float dlv = 0.f;
    f32x16 S[4];
    if (wv == 0) { dlv = (lane < 32) ? dls[lane] : 0.f;
#pragma unroll
        for (int it = 0; it < 4; ++it)
#pragma unroll
            for (int q = 0; q < 16; ++q) S[it][q] = 0.f; }
#define LA_DMA(c_, slot_) do { const unsigned char* rec_ = recs + (size_t)(c_) * recsz + lane * 16; LAS unsigned char* dst_ = ring + (slot_) * SLOT; \
        for (int f_ = wv - 1; f_ < NFR + 8; f_ += 7) { const unsigned char* src_ = (f_ < NFR) ? rec_ + f_ * 1024 : rec_ + uc_off + slice * 8192 + (f_ - NFR) * 1024; \
            __builtin_amdgcn_global_load_lds((const unsigned*)src_, (LAS unsigned*)(dst_ + f_ * 1024), 16, 0, 0); } } while (0)
    if (loader) { LA_DMA(0, 0); asm volatile("s_waitcnt vmcnt(0)" ::: "memory"); }
    __builtin_amdgcn_s_barrier(); asm volatile("" ::: "memory");
#pragma unroll 1
    for (int c = 0; c < 32; ++c) {
        if (loader) { if (c + 1 < 32) { LA_DMA(c + 1, (c + 1) & 1); asm volatile("s_waitcnt vmcnt(0)" ::: "memory"); } }
        else if (wv == 0) {
        const LAS unsigned char* B = ring + (c & 1) * SLOT + lane * 16;
#define FRAG(off, idx) (*(const LAS bf16x8*)(B + (off) + (idx) * 1024))
        bf16x8 sb[8];
#pragma unroll
        for (int it = 0; it < 4; ++it) { sb[2 * it] = PACK_STEP(S[it], 0); sb[2 * it + 1] = PACK_STEP(S[it], 1); }
        f32x16 Vn[2];
#pragma unroll
        for (int rt = 0; rt < 2; ++rt)
#pragma unroll
            for (int q4 = 0; q4 < 4; ++q4) { const f32x4 v = *(const LAS f32x4*)(B + NFR * 1024 + (rt * 4 + q4) * 1024); Vn[rt][4 * q4] = v.x; Vn[rt][4 * q4 + 1] = v.y; Vn[rt][4 * q4 + 2] = v.z; Vn[rt][4 * q4 + 3] = v.w; }
        if (HAS_W) {
#pragma unroll
            for (int ks = 0; ks < 8; ++ks) { Vn[0] = MFMA32(FRAG(LA_NW, 0 * 8 + ks), sb[ks], Vn[0]); Vn[1] = MFMA32(FRAG(LA_NW, 1 * 8 + ks), sb[ks], Vn[1]); } }
        bf16x8 vb[4];
#pragma unroll
        for (int rt = 0; rt < 2; ++rt) { vb[2 * rt] = PACK_STEP(Vn[rt], 0); vb[2 * rt + 1] = PACK_STEP(Vn[rt], 1); }
        f32x16 O[2];
#pragma unroll
        for (int rt = 0; rt < 2; ++rt)
#pragma unroll
            for (int q = 0; q < 16; ++q) O[rt][q] = 0.f;
#pragma unroll
        for (int ks = 0; ks < 8; ++ks) { O[0] = MFMA32(FRAG(LA_QD, 0 * 8 + ks), sb[ks], O[0]); O[1] = MFMA32(FRAG(LA_QD, 1 * 8 + ks), sb[ks], O[1]); }
#pragma unroll
        for (int ks = 0; ks < 4; ++ks) { O[0] = MFMA32(FRAG(LA_QK, 0 * 4 + ks), vb[ks], O[0]); O[1] = MFMA32(FRAG(LA_QK, 1 * 4 + ks), vb[ks], O[1]); }
        float* op = outp + (size_t)c * 64 * GW + r;
#pragma unroll
        for (int rt = 0; rt < 2; ++rt)
#pragma unroll
            for (int q = 0; q < 16; ++q) op[(size_t)(32 * rt + crow(q, h)) * GW] = O[rt][q];
        const float dl = __builtin_bit_cast(float, __builtin_amdgcn_readlane(__builtin_bit_cast(int, dlv), c));
#pragma unroll
        for (int it = 0; it < 4; ++it) {
#pragma unroll
            for (int q = 0; q < 16; ++q) S[it][q] *= dl;
#pragma unroll
            for (int ks = 0; ks < 4; ++ks) S[it] = MFMA32(FRAG(LA_KE, it * 4 + ks), vb[ks], S[it]);
        }
#undef FRAG
        asm volatile("s_waitcnt lgkmcnt(0)" ::: "memory");
        }
        __builtin_amdgcn_s_barrier(); asm volatile("" ::: "memory");
    }
#undef LA_DMA
}
__device__ __forceinline__ void la_seq_phase(Frame& F, int l_unused) {
    const int lane = opq(F.lane);
    for (int item = F.vcu; item < 128; item += F.G) {
        if (item < 64) { const int seq = item >> 2, slice = item & 3, b = seq >> 2, hd = seq & 3;
            la_seq_wg<true>(F.lds + RING_OFF, F.ws + WS_FG + (size_t)seq * 32 * LA_RECG, LA_RECG, LA_UCG, wsf(F, WS_DLG) + seq * 32, wsf(F, WS_OG) + (size_t)b * SEQ * GW + hd * 128 + slice * 32, slice, lane, F.wave);
        } else { const int j = item - 64, seq = j >> 1, slice = j & 1, b = seq >> 3, hh = seq & 7;
            la_seq_wg<false>(F.lds + RING_OFF, F.ws + WS_FS + (size_t)seq * 32 * LA_RECS, LA_RECS, LA_UCS, wsf(F, WS_DLS) + seq * 32, wsf(F, WS_YS) + (size_t)b * SEQ * GW + hh * 64 + slice * 32, slice, lane, F.wave);
        }
    }
}

__device__ __forceinline__ void mixer_post_phase(Frame& F, int l) {
    const int gw = F.vcu * NWAVES + F.wave, NGW = F.G * NWAVES, lane = opq(F.lane), c = lane * 8;
    bf16* MIX = wsb(F, WS_MIX);
    const float* gng = inp(I_GNG) + (size_t)l * 128 + (c & 127); const float* sng = inp(I_SNG) + (size_t)l * GW + c;
    const f32x4 g0 = ld4(gng), g1 = ld4(gng + 4), n0 = ld4(sng), n1 = ld4(sng + 4);
    const float Dk = inp(I_SD)[l * 8 + (c >> 6)];
    for (int m = gw; m < M; m += NGW) {
        {
            const float* og = wsf(F, WS_OG) + (size_t)m * GW + c; const f32x8 zz = ldu8(wsb(F, WS_ZG) + (size_t)m * GW + c);
            const f32x4 o0 = ld4(og), o1 = ld4(og + 4), z0 = zz.lo, z1 = zz.hi;
            float ss = (o0.x * o0.x + o0.y * o0.y) + (o0.z * o0.z + o0.w * o0.w) + (o1.x * o1.x + o1.y * o1.y) + (o1.z * o1.z + o1.w * o1.w);
            ss = row16_sum(ss);
            const float rstd = __builtin_amdgcn_rsqf(ss * (1.0f / 128.0f) + EPS);
            const f32x4 y0 = o0 * rstd * g0 * silu4(z0), y1 = o1 * rstd * g1 * silu4(z1);
            v4u w; w.x = pk2(y0.x, y0.y); w.y = pk2(y0.z, y0.w); w.z = pk2(y1.x, y1.y); w.w = pk2(y1.z, y1.w);
            *(v4u*)(MIX + (size_t)m * DM + 2 * GW + c) = w;
        }
        {
            const float* ys = wsf(F, WS_YS) + (size_t)m * GW + c; const float* xs = wsf(F, WS_XS) + (size_t)m * GW + c; const f32x8 zz = ldu8(wsb(F, WS_ZS) + (size_t)m * GW + c);
            const f32x4 a0 = (ld4(ys) + ld4(xs) * Dk) * silu4(zz.lo), a1 = (ld4(ys + 4) + ld4(xs + 4) * Dk) * silu4(zz.hi);
            float ss = (a0.x * a0.x + a0.y * a0.y) + (a0.z * a0.z + a0.w * a0.w) + (a1.x * a1.x + a1.y * a1.y) + (a1.z * a1.z + a1.w * a1.w);
            ss = row16_sum(ss); ss += shx(ss, 16, lane);
            const float rstd = __builtin_amdgcn_rsqf(ss * (1.0f / 256.0f) + EPS);
            const f32x4 y0 = a0 * rstd * n0, y1 = a1 * rstd * n1;
            v4u w; w.x = pk2(y0.x, y0.y); w.y = pk2(y0.z, y0.w); w.z = pk2(y1.x, y1.y); w.w = pk2(y1.z, y1.w);
            *(v4u*)(MIX + (size_t)m * DM + 3 * GW + c) = w;
        }
    }
}

constexpr int CW_PANEL = 8192;
static_assert((CW_PANEL + DEPTH * 3 * 32 * 64) * 4 <= (int)CTL_ZERO_BYTES && CW_BAR + XCD_BAR_WORDS <= CW_PANEL, "control words inside the memset region");
namespace pg8 {
struct EpiAny {
    static constexpr bool PERM = false, AFTER_DRAIN = false, RT_DRAIN = true;
    void* C; int ldc; int mode; float scale;
    unsigned char* ws; float* out; int lq, prow0;
    int rsrow0;
    __device__ __forceinline__ bool perm() const { return mode != 0; }
    __device__ __forceinline__ bool drain() const { return mode >= 3; }
    __device__ __forceinline__ void operator()(const f32x4 (&acc)[2][2][4][2], const Unit& u, int wr, int wc, int fr, int fq) const {
        if (mode == 3 || mode == 4) return;
        if (rsrow0 < 0) {
            if (mode == 0) { EpiF32 e{(float*)C, ldc}; e(acc, u, wr, wc, fr, fq); }
            else if (mode == 1) { EpiBf16S e{(bf16_t*)C, ldc, scale}; e(acc, u, wr, wc, fr, fq); }
            else { EpiSwiGLU e{(bf16_t*)C, ldc}; e(acc, u, wr, wc, fr, fq); }
            return; }
        const float* rs = (const float*)(ws + WS_RS) + rsrow0 + u.pm * BM + wr * 64 + fr;
        const int row0 = u.pm * BM + wr * 64 + fr;
#pragma unroll
        for (int ai = 0; ai < 2; ++ai)
#pragma unroll
            for (int m = 0; m < 4; ++m) { const float r = rs[ai * HALF + m * 16];
                if (mode == 1) { bf16_t* rowp = (bf16_t*)C + (size_t)(row0 + ai * HALF + m * 16) * ldc + u.pn * BM + wc * 32 + 8 * fq;
#pragma unroll
                    for (int bj = 0; bj < 2; ++bj) { const f32x4 v0 = acc[ai][bj][m][0] * r, v1 = acc[ai][bj][m][1] * r;
                        u32x4 w; w.x = cvt_pk_bf16(v0[0], v0[1]); w.y = cvt_pk_bf16(v0[2], v0[3]); w.z = cvt_pk_bf16(v1[0], v1[1]); w.w = cvt_pk_bf16(v1[2], v1[3]); *(u32x4*)(rowp + bj * HALF) = w; }
                } else { bf16_t* rowp = (bf16_t*)C + (size_t)(row0 + ai * HALF + m * 16) * ldc + u.pn * HALF + wc * 32 + 8 * fq;
                    const f32x4 g0 = acc[ai][0][m][0] * r, g1 = acc[ai][0][m][1] * r, u0 = acc[ai][1][m][0] * r, u1 = acc[ai][1][m][1] * r;
                    u32x4 w; w.x = cvt_pk_bf16(silu_f(g0[0]) * u0[0], silu_f(g0[1]) * u0[1]); w.y = cvt_pk_bf16(silu_f(g0[2]) * u0[2], silu_f(g0[3]) * u0[3]);
                    w.z = cvt_pk_bf16(silu_f(g1[0]) * u1[0], silu_f(g1[1]) * u1[1]); w.w = cvt_pk_bf16(silu_f(g1[2]) * u1[2], silu_f(g1[3]) * u1[3]); *(u32x4*)rowp = w; } }
    }
    __device__ __forceinline__ void fused(f32x4 (&acc)[2][2][4][2], const Unit& u, int wr, int wc, int fr, int fq, PG8_LAS unsigned char* lds, int wid, int lane) const {
        if (mode == 3) fused_softmax(acc, u, wr, wc, fr, fq, lds, wid, lane); else fused_resnorm(acc, u, wr, wc, fr, fq, lds, wid, lane);
    }
    __device__ __forceinline__ void fused_resnorm(f32x4 (&acc)[2][2][4][2], const Unit& u, int wr, int wc, int fr, int fq, PG8_LAS unsigned char* lds, int wid, int lane) const {
        const int D = 2048;
        {   bf16_t* Yw = (bf16_t*)(ws + WS_Y);
            const int row0 = prow0 + u.pm * BM + wr * 64 + fr, col0 = u.pn * BM + wc * 32 + 8 * fq;
#pragma unroll
            for (int ai = 0; ai < 2; ++ai)
#pragma unroll
                for (int m = 0; m < 4; ++m)
#pragma unroll
                    for (int bj = 0; bj < 2; ++bj) { const f32x4 v0 = acc[ai][bj][m][0], v1 = acc[ai][bj][m][1];
                        u32x4 w; w.x = cvt_pk_bf16(v0[0], v0[1]); w.y = cvt_pk_bf16(v0[2], v0[3]); w.z = cvt_pk_bf16(v1[0], v1[1]); w.w = cvt_pk_bf16(v1[2], v1[3]);
                        bf16_t* dst = Yw + (size_t)(row0 + ai * HALF + m * 16) * D + col0 + bj * HALF;
                        asm volatile("global_store_dwordx4 %0, %1, off sc1\n\ts_nop 1" :: "v"(dst), "v"(w) : "memory"); } }
        asm volatile("s_waitcnt vmcnt(0)" ::: "memory");
        __builtin_amdgcn_s_barrier(); asm volatile("" ::: "memory");
        const int l = lq / 3, rn = lq % 3;
        unsigned* pc = (unsigned*)(ws + WS_CTL) + CW_PANEL + (lq * 32 + (prow0 >> 8) + u.pm) * 64;
        const float* gpost = inp(I_NORMG) + (size_t)(l * N_NORMS + (rn == 0 ? MIX_POST : rn == 1 ? XA_POST : FFN_POST)) * D;
        const bool first = (lq == 0), last = (lq == 3 * DEPTH - 1);
        const float* xin32 = inp(I_X); bf16_t* xb = (bf16_t*)(ws + WS_XN); float* rsb = (float*)(ws + WS_RS);
        if (wid == 0) {
            if (lane == 0) __hip_atomic_fetch_add(pc, 1u, __ATOMIC_RELAXED, __HIP_MEMORY_SCOPE_AGENT);
            unsigned spins = 0;
            while ((unsigned)__builtin_amdgcn_readfirstlane(__hip_atomic_load(pc, __ATOMIC_RELAXED, __HIP_MEMORY_SCOPE_AGENT)) < 8u) { __builtin_amdgcn_s_sleep(2); if (++spins > (1u << 22)) break; }
            __builtin_amdgcn_fence(__ATOMIC_ACQUIRE, "agent");
            asm volatile("s_waitcnt vmcnt(0)" ::: "memory");
        }
        __builtin_amdgcn_s_barrier(); asm volatile("" ::: "memory");
        const bf16_t* Y = (const bf16_t*)(ws + WS_Y);
#define BFLO(wd) __builtin_bit_cast(float, (wd) << 16)
#define BFHI(wd) __builtin_bit_cast(float, (wd) & 0xffff0000u)
#pragma unroll 1
        for (int i = 0; i < 4; ++i) {
            const size_t mrow = (size_t)prow0 + u.pm * BM + u.pn * 32 + wid * 4 + i;
            f32x4 x[8]; u32x4 yw[4];
            { const u32x4* yr = (const u32x4*)(Y + mrow * D) + lane;
#pragma unroll
              for (int j = 0; j < 4; ++j) yw[j] = yr[64 * j];
              if (first) { const f32x4* xr = (const f32x4*)(xin32 + mrow * D) + 2 * lane;
#pragma unroll
                  for (int j = 0; j < 4; ++j) { x[2 * j] = xr[128 * j]; x[2 * j + 1] = xr[128 * j + 1]; }
              } else { const u32x4* xr = (const u32x4*)(xb + mrow * D) + lane;
#pragma unroll
                  for (int j = 0; j < 4; ++j) { const u32x4 w = xr[64 * j]; x[2 * j] = (f32x4){BFLO(w.x), BFHI(w.x), BFLO(w.y), BFHI(w.y)}; x[2 * j + 1] = (f32x4){BFLO(w.z), BFHI(w.z), BFLO(w.w), BFHI(w.w)}; } } }
            float s = 0.f;
#pragma unroll
            for (int j = 0; j < 4; ++j) { const u32x4 w = yw[j]; const float a0 = BFLO(w.x), a1 = BFHI(w.x), a2 = BFLO(w.y), a3 = BFHI(w.y), a4 = BFLO(w.z), a5 = BFHI(w.z), a6 = BFLO(w.w), a7 = BFHI(w.w);
                s += ((a0 * a0 + a1 * a1) + (a2 * a2 + a3 * a3)) + ((a4 * a4 + a5 * a5) + (a6 * a6 + a7 * a7)); }
            s = wave_sum(s);
            const float rstd = __builtin_amdgcn_rsqf(s * (1.0f / 2048.0f) + 1e-6f);
            float s2 = 0.f;
#pragma unroll
            for (int j = 0; j < 4; ++j) { const u32x4 w = yw[j];
                const f32x4 y0 = (f32x4){BFLO(w.x), BFHI(w.x), BFLO(w.y), BFHI(w.y)}, y1 = (f32x4){BFLO(w.z), BFHI(w.z), BFLO(w.w), BFHI(w.w)};
                const f32x4 g0 = ((const f32x4*)gpost)[2 * lane + 128 * j], g1 = ((const f32x4*)gpost)[2 * lane + 128 * j + 1];
                const f32x4 v0 = x[2 * j] + y0 * rstd * g0, v1 = x[2 * j + 1] + y1 * rstd * g1; x[2 * j] = v0; x[2 * j + 1] = v1;
                s2 += ((v0[0] * v0[0] + v0[1] * v0[1]) + (v0[2] * v0[2] + v0[3] * v0[3])) + ((v1[0] * v1[0] + v1[1] * v1[1]) + (v1[2] * v1[2] + v1[3] * v1[3])); }
            if (last) { f32x4* xo = (f32x4*)(out + mrow * D) + 2 * lane;
#pragma unroll
                for (int j = 0; j < 4; ++j) { xo[128 * j] = x[2 * j]; xo[128 * j + 1] = x[2 * j + 1]; }
            } else {
                s2 = wave_sum(s2);
                if (lane == 0) rsb[mrow] = __builtin_amdgcn_rsqf(s2 * (1.0f / 2048.0f) + 1e-6f);
                u32x4* o8 = (u32x4*)(xb + mrow * D) + lane;
#pragma unroll
                for (int j = 0; j < 4; ++j) { const f32x4 a = x[2 * j], b = x[2 * j + 1];
                    u32x4 w; w.x = cvt_pk_bf16(a[0], a[1]); w.y = cvt_pk_bf16(a[2], a[3]); w.z = cvt_pk_bf16(b[0], b[1]); w.w = cvt_pk_bf16(b[2], b[3]); o8[64 * j] = w; }
            }
        }
#undef BFLO
#undef BFHI
    }
    __device__ __forceinline__ void fused_softmax(f32x4 (&acc)[2][2][4][2], const Unit& u, int wr, int wc, int fr, int fq, PG8_LAS unsigned char* lds, int wid, int lane) const {
        { const float* rs = (const float*)(ws + WS_RS) + rsrow0 + u.pm * BM + wr * 64 + fr;
#pragma unroll
          for (int ai = 0; ai < 2; ++ai)
#pragma unroll
            for (int m = 0; m < 4; ++m) { const float r = rs[ai * HALF + m * 16];
#pragma unroll
                for (int bj = 0; bj < 2; ++bj)
#pragma unroll
                    for (int n = 0; n < 2; ++n) acc[ai][bj][m][n] = acc[ai][bj][m][n] * r; } }
        PG8_LAS float* Pm = (PG8_LAS float*)lds;
        PG8_LAS float* Ps = (PG8_LAS float*)(lds + 4096);
#pragma unroll
        for (int ai = 0; ai < 2; ++ai)
#pragma unroll
            for (int m = 0; m < 4; ++m) { float mx = -3.0e38f;
#pragma unroll
                for (int bj = 0; bj < 2; ++bj)
#pragma unroll
                    for (int n = 0; n < 2; ++n) { const f32x4 x = acc[ai][bj][m][n]; mx = fmaxf(mx, fmaxf(fmaxf(x[0], x[1]), fmaxf(x[2], x[3]))); }
                mx = fmaxf(mx, shx(mx, 16, lane)); mx = fmaxf(mx, shx(mx, 32, lane));
                if (fq == 0) Pm[(ai * HALF + wr * 64 + m * 16 + fr) * 4 + wc] = mx; }
        asm volatile("s_waitcnt lgkmcnt(0)" ::: "memory"); __builtin_amdgcn_s_barrier(); asm volatile("" ::: "memory");
#pragma unroll
        for (int ai = 0; ai < 2; ++ai)
#pragma unroll
            for (int m = 0; m < 4; ++m) { const int row = ai * HALF + wr * 64 + m * 16 + fr; const f32x4 pm = *(const PG8_LAS f32x4*)(Pm + row * 4);
                const float mx = fmaxf(fmaxf(pm[0], pm[1]), fmaxf(pm[2], pm[3])); float sm = 0.f;
#pragma unroll
                for (int bj = 0; bj < 2; ++bj)
#pragma unroll
                    for (int n = 0; n < 2; ++n) { f32x4 x = acc[ai][bj][m][n]; x[0] = __expf(x[0] - mx); x[1] = __expf(x[1] - mx); x[2] = __expf(x[2] - mx); x[3] = __expf(x[3] - mx);
                        acc[ai][bj][m][n] = x; sm += (x[0] + x[1]) + (x[2] + x[3]); }
                sm += shx(sm, 16, lane); sm += shx(sm, 32, lane);
                if (fq == 0) Ps[row * 4 + wc] = sm; }
        asm volatile("s_waitcnt lgkmcnt(0)" ::: "memory"); __builtin_amdgcn_s_barrier(); asm volatile("" ::: "memory");
        const int row0 = u.pm * BM + wr * 64 + fr, col0 = u.pn * BM + wc * 32 + 8 * fq;
#pragma unroll
        for (int ai = 0; ai < 2; ++ai)
#pragma unroll
            for (int m = 0; m < 4; ++m) { const int row = ai * HALF + wr * 64 + m * 16 + fr; const f32x4 ps = *(const PG8_LAS f32x4*)(Ps + row * 4);
                const float inv = __builtin_amdgcn_rcpf((ps[0] + ps[1]) + (ps[2] + ps[3]));
                bf16_t* rowp = (bf16_t*)C + (size_t)(row0 + ai * HALF + m * 16) * ldc + col0;
#pragma unroll
                for (int bj = 0; bj < 2; ++bj) { const f32x4 v0 = acc[ai][bj][m][0] * inv, v1 = acc[ai][bj][m][1] * inv;
                    u32x4 w; w.x = cvt_pk_bf16(v0[0], v0[1]); w.y = cvt_pk_bf16(v0[2], v0[3]); w.z = cvt_pk_bf16(v1[0], v1[1]); w.w = cvt_pk_bf16(v1[2], v1[3]);
                    *(u32x4*)(rowp + bj * HALF) = w; } }
    }
};
}

#ifndef SKIPM
#define SKIPM 0
#endif
#ifndef REPM
#define REPM 0
#endif
#ifndef GEMM_SP2
#define GEMM_SP2 true
#endif
#ifndef GEMM_ALIGN
#define GEMM_ALIGN true
#endif
#ifndef PROBE_PH
#define PROBE_PH -1
#endif
constexpr int PH_PER_LAYER = 10, PH0 = 2, N_PHASES = PH0 + DEPTH * PH_PER_LAYER;
struct Args { const float* in[N_IN]; float* out; unsigned char* ws; int ph_lo, ph_hi; };
static_assert(sizeof(Args) == (N_IN + 2) * 8 + 8, "Args has no padding");
struct GemmDesc { const bf16* A; const bf16* Bt; void* C; int M, N, K, lda, ldb, ldc, mode, corder, rn, prow0, rsrow0; float scale; };
constexpr int NOUNIT = 1 << 24;
__device__ __forceinline__ int gemm_nsub(int ph, int k, int l) { return ph == 0 ? 0 : ph == 1 ? 1 : (k == 1 || k == 2 || k == 4) ? 0 : k == 3 ? 32 : (k == 6 || k == 7) ? BATCH : (k == 8 && l == 0) ? 2 : 1; }
__device__ __forceinline__ int pmod(int x, int m) { const int r = x % m; return r < 0 ? r + m : r; }
__device__ __forceinline__ void kv_desc(const Frame& F, int l, int v0, GemmDesc& d) {
    d.A = wsb(F, WS_MEMN) + (size_t)l * MROWS * DM; d.Bt = (const bf16*)(F.ws + WS_W + (size_t)l * W_LAYER + WO_WKV); d.C = wsb(F, WS_KV) + (size_t)l * MROWS * 2 * DM;
    d.M = MROWS; d.N = 2 * DM; d.K = DM; d.lda = DM; d.ldb = DM; d.ldc = 2 * DM; d.mode = 1; d.corder = (F.vcu >= v0 && F.vcu < v0 + 64) ? F.vcu - v0 : NOUNIT;
}
__device__ __forceinline__ void gemm_desc(const Frame& F, int ph, int sub, GemmDesc& d) {
    const int bx = (int)blockIdx.x;
    d.scale = 1.0f; d.corder = bx; d.rn = -1; d.prow0 = 0; d.rsrow0 = -1;
    if (ph == 1) { kv_desc(F, 0, 0, d); return; }
    const int l = (ph - PH0) / PH_PER_LAYER, k = (ph - PH0) % PH_PER_LAYER;
    if (k == 3) {
        const int which = sub & 1, h = (sub >> 1) & 3, b = (sub >> 3) & 3;
        const unsigned char* wl = F.ws + WS_W + (size_t)l * W_LAYER;
        const bf16* kv = wsb(F, WS_KV) + (size_t)l * MROWS * 2 * DM + (size_t)(b * MEML) * 2 * DM + h * XHD;
        const int nb = 128;
        d.K = XHD; d.mode = 1; d.corder = (F.vcu >= 128 && F.vcu < 128 + nb) ? pmod(F.vcu - 128 - 8 * sub, nb) : NOUNIT;
        if (which == 0) {
            d.A = kv; d.lda = 2 * DM; d.Bt = (const bf16*)(wl + WO_WQ) + h * XHD; d.ldb = DM; d.M = MEML; d.N = DM;
            d.C = wsb(F, WS_AT) + ((size_t)(l * BATCH + b) * 1024 + h * MEML) * DM; d.ldc = DM; d.scale = 0.044194173824159216f;
        } else {
            d.A = (const bf16*)(wl + WO_WO) + h * XHD; d.lda = DM; d.Bt = kv + DM; d.ldb = 2 * DM; d.M = DM; d.N = MEML;
            d.C = wsb(F, WS_VWT) + (size_t)(l * BATCH + b) * DM * 1024 + h * MEML; d.ldc = 1024;
        }
        return;
    }
    const unsigned char* wl = F.ws + WS_W + (size_t)l * W_LAYER;
    d.M = M; d.K = DM; d.N = DM; d.lda = DM; d.ldb = DM; d.ldc = DM; d.mode = 1; d.A = wsb(F, WS_XN); d.C = wsb(F, WS_Y);
    if (k == 0) { d.Bt = (const bf16*)(wl + WO_WIN); d.N = IN_PAD; d.C = wsb(F, WS_U); d.ldc = IN_PAD; d.mode = 1; d.rsrow0 = 0; }
    else if (k == 5) { d.A = wsb(F, WS_MIX); d.Bt = (const bf16*)(wl + WO_WOUT); d.mode = 4; d.rn = 0; }
    else if (k == 6) {
        const int b = sub; d.A = wsb(F, WS_XN) + (size_t)b * SEQ * DM; d.Bt = wsb(F, WS_AT) + (size_t)(l * BATCH + b) * 1024 * DM; d.M = SEQ; d.N = 1024;
        d.C = wsb(F, WS_P) + (size_t)b * SEQ * 1024; d.ldc = 1024; d.mode = 3; d.rsrow0 = b * SEQ; d.corder = (bx + F.G - 32 * sub) % F.G; }
    else if (k == 7) {
        const int b = sub; d.A = wsb(F, WS_P) + (size_t)b * SEQ * 1024; d.lda = 1024; d.Bt = wsb(F, WS_VWT) + (size_t)(l * BATCH + b) * DM * 1024; d.ldb = 1024; d.M = SEQ; d.K = 1024;
        d.mode = 4; d.rn = 1; d.prow0 = b * SEQ; d.corder = (bx + F.G - 64 * sub) % F.G; }
    else if (k == 8) { if (sub == 1) { kv_desc(F, 1, 0, d); d.corder = (bx >= 128 && bx < 192) ? bx - 128 : NOUNIT; return; }
        d.Bt = (const bf16*)(wl + WO_WGU); d.N = 2 * DFF; d.mode = 2; d.C = wsb(F, WS_HID); d.ldc = DFF; d.rsrow0 = 0; }
    else { d.A = wsb(F, WS_HID); d.Bt = (const bf16*)(wl + WO_WD); d.K = DFF; d.lda = DFF; d.ldb = DFF; d.mode = 4; d.rn = 2; }
}

__global__ void __launch_bounds__(NWAVES * 64, 2) fwd_kernel(Args args) {
    extern __shared__ __attribute__((aligned(16))) unsigned char lds[];
    Frame F;
    F.lds = (LAS unsigned char*)lds;
    F.MISC = (volatile LAS unsigned*)(F.lds + MISC_OFF);
    F.tid = threadIdx.x; F.lane = F.tid & 63; F.wave = __builtin_amdgcn_readfirstlane(F.tid >> 6);
    F.G = gridDim.x; { const int bx = blockIdx.x; F.vcu = (F.G % 8 == 0) ? (bx % 8) * (F.G / 8) + bx / 8 : bx; }
    F.ws = args.ws; F.out = args.out; F.ctl = (unsigned*)(args.ws + WS_CTL);
    for (int u = F.tid; u < (LDS_BYTES - LDSCTL_OFF) / 4; u += NWAVES * 64) ((LAS unsigned*)(F.lds + LDSCTL_OFF))[u] = 0u;
    __syncthreads();
    const int lo = args.ph_lo, hi = args.ph_hi;
    if (hi - lo > 1) (void)xcd_barrier_post(F.ctl + CW_BAR, F.MISC + 8);
#define GRID_BARRIER() do { XcdBarrier b_; b_.bar = F.ctl + CW_BAR; b_.x = xb_xcc_id(); b_.st = F.MISC + 8; xcd_barrier(b_); } while (0)
    LAS unsigned char* ring = F.lds + RING_OFF;
#if PROBE_PH >= 0
    unsigned long long t_start = __builtin_amdgcn_s_memrealtime(), t_probe = 0;
#endif
#pragma unroll 1
    for (int ph = lo; ph < hi; ++ph) {
        const int l = ph >= PH0 ? (ph - PH0) / PH_PER_LAYER : 0, k = ph >= PH0 ? (ph - PH0) % PH_PER_LAYER : -1;
        const int kbit = (ph < PH0) ? ph : (k + PH0);
        const int reps = 1 + ((REPM >> kbit) & 1);
#pragma unroll 1
        for (int rep = 0; rep < reps; ++rep) {
        if (ph < PH0) p0_prologue(F, ph);
        else if (k == 1) mixer_prep_phase(F, l);
        else if (k == 2) la_prep_phase(F, l);
        else if (k == 3) la_seq_phase(F, l);
        else if (k == 4) mixer_post_phase(F, l);
        const int nsub = gemm_nsub(ph, k, l);
#pragma unroll 1
        for (int sub = 0; sub < nsub; ++sub) {
            GemmDesc d; gemm_desc(F, ph, sub, d);
            pg8::Gemm g{d.A, d.Bt, d.M, d.N, d.K, d.lda, d.ldb}; pg8::StaticOrder S; S.init(d.M, d.N, F.G, d.corder);
            pg8::EpiAny E{d.C, d.ldc, d.mode, d.scale, F.ws, F.out, l * 3 + d.rn, d.prow0, d.rsrow0};
            pg8::gemm_phase<pg8::EpiAny, pg8::StaticOrder, GEMM_ALIGN, GEMM_SP2>(ring, g, S, E);
        }
        if (REPM >> 20) { if (rep + 1 < reps) __syncthreads(); }
        }
        if ((REPM >> 21) & 1) GRID_BARRIER();
        if (ph + 1 < hi) GRID_BARRIER();
#if PROBE_PH >= 0
        if (ph == PROBE_PH) t_probe = __builtin_amdgcn_s_memrealtime();
#endif
    }
#if PROBE_PH >= 0
    if (blockIdx.x == 0) {
        const unsigned long long t_end = __builtin_amdgcn_s_memrealtime();
        while (__builtin_amdgcn_s_memrealtime() - t_end < t_probe - t_start) __builtin_amdgcn_s_sleep(8);
    }
#endif
}

#ifndef MK_SINGLE
#define MK_SINGLE 0
#endif
extern "C" void kernel_launch(void* const* d_in, const int* in_sizes, int n_in, void* d_out, int out_size, void* d_ws, size_t ws_size, hipStream_t stream) {
    static int grid = 0;
    if (grid == 0) {
        if (n_in != N_IN || in_sizes[0] != M * DM || out_size != M * DM || ws_size < WS_END) { fprintf(stderr, "kernel_launch: unexpected problem (n_in %d, in0 %d, out %d, ws %zu < %zu)\n", n_in, n_in > 0 ? in_sizes[0] : -1, out_size, ws_size, (size_t)WS_END); grid = -1; return; }
        int dev = 0, cus = 0, per_cu = 0;
        if (hipGetDevice(&dev) != hipSuccess || hipDeviceGetAttribute(&cus, hipDeviceAttributeMultiprocessorCount, dev) != hipSuccess) { grid = -1; return; }
        if (hipFuncSetAttribute((const void*)fwd_kernel, hipFuncAttributeMaxDynamicSharedMemorySize, LDS_BYTES) != hipSuccess) { fprintf(stderr, "kernel_launch: hipFuncSetAttribute failed\n"); grid = -1; return; }
        if (hipOccupancyMaxActiveBlocksPerMultiprocessor(&per_cu, (const void*)fwd_kernel, NWAVES * 64, LDS_BYTES) != hipSuccess || per_cu < 1) { fprintf(stderr, "kernel_launch: occupancy query says %d blocks per CU\n", per_cu); per_cu = 1; }
        (void)hipGetLastError();
        grid = cus * (per_cu < 1 ? 1 : 1);
        if (grid != 256) fprintf(stderr, "kernel_launch: note: grid %d (expected 256)\n", grid);
    }
    if (grid < 0) return;
    if (hipMemsetAsync((char*)d_ws + WS_CTL, 0, CTL_ZERO_BYTES, stream) != hipSuccess) { fprintf(stderr, "kernel_launch: memset failed\n"); return; }
    Args a{};
    for (int i = 0; i < N_IN; ++i) a.in[i] = (const float*)d_in[i];
    a.out = (float*)d_out; a.ws = (unsigned char*)d_ws;
#if MK_SINGLE
    a.ph_lo = 0; a.ph_hi = N_PHASES;
    void* kargs[] = {&a};
    hipError_t e = hipLaunchCooperativeKernel((const void*)fwd_kernel, dim3(grid), dim3(NWAVES * 64), kargs, LDS_BYTES, stream);
    if (e != hipSuccess) fprintf(stderr, "kernel_launch: cooperative launch failed: %s (grid %d)\n", hipGetErrorString(e), grid);
#else
    for (int p = 0; p < N_PHASES; ++p) { a.ph_lo = p; a.ph_hi = p + 1;
        hipLaunchKernelGGL(fwd_kernel, dim3(grid), dim3(NWAVES * 64), LDS_BYTES, stream, a);
        const hipError_t le = hipPeekAtLastError(); if (le != hipSuccess) { fprintf(stderr, "kernel_launch: launch %d failed: %s\n", p, hipGetErrorName(le)); break; } }
#endif
}
```

```cpp
#include <hip/hip_runtime.h>
#include <cstdio>
#include <cstdint>
#define MK_SINGLE 1
namespace pg8 {
#define PG8_LAS __attribute__((address_space(3)))
typedef unsigned short bf16_t;
typedef short bf16x8 __attribute__((ext_vector_type(8)));
typedef float f32x4 __attribute__((ext_vector_type(4)));
typedef unsigned u32x4 __attribute__((ext_vector_type(4)));
constexpr int BM = 256, BK = 64, HALF = 128, HTB = HALF * BK * 2  , STAGE_BYTES = 8 * HTB, NXCD = 8, WGM = 8;

__host__ __device__ __forceinline__ int lds_byte(int r, int c) { const int st = (r >> 4) * 2 + (c >> 5), rr = r & 15, cc = c & 31, ob = rr * 64 + cc * 2; return st * 1024 + (ob ^ (((ob >> 9) & 1) << 5)); }
__host__ __device__ __forceinline__ void stage_rc(int b, int& R, int& C) { const int st = b / 1024, sb = b % 1024, swz = sb ^ (((sb >> 9) & 1) << 5); R = (st >> 1) * 16 + swz / 64; C = (st & 1) * 32 + (swz % 64) / 2; }
__host__ __device__ __forceinline__ int perm32(int rho) { const int n = rho >> 4, i = rho & 15; return 8 * (i >> 2) + 4 * n + (i & 3); }

struct Unit { int pm, pn; };
struct Gemm { const bf16_t* A; const bf16_t* Bt; int M, N, K, lda, ldb; };

struct StaticOrder {
    int nM, nN, nwg, G, c;
    __host__ __device__ void init(int M, int N, int G_, int c_) { nM = M / BM; nN = N / BM; nwg = nM * nN; G = G_; c = c_; }
    __host__ __device__ bool next(int i, Unit& u) const {
        const long L = (long)i * G + c; if (L >= nwg) return false;
        int wgid = (int)L; { const int q = nwg / NXCD, r = nwg % NXCD, xcd = wgid % NXCD, off = wgid / NXCD; wgid = (xcd < r ? xcd * (q + 1) : r * (q + 1) + (xcd - r) * q) + off; }
        const int nig = WGM * nN, gid = wgid / nig, fm = gid * WGM, gsz = (nM - fm) < WGM ? (nM - fm) : WGM;
        u.pm = fm + ((wgid % nig) % gsz); u.pn = (wgid % nig) / gsz; return true;
    }
    __device__ __forceinline__ void a_ready(const Unit&) const {}
    __device__ __forceinline__ void done(const Unit&) const {}
};

__device__ __forceinline__ unsigned cvt_pk_bf16(float lo, float hi) { unsigned r; asm volatile("v_cvt_pk_bf16_f32 %0, %1, %2" : "=v"(r) : "v"(lo), "v"(hi)); return r; }
struct EpiF32 {
    static constexpr bool PERM = false, AFTER_DRAIN = false;
    float* C; int ldc;
    __device__ __forceinline__ void operator()(const f32x4 (&acc)[2][2][4][2], const Unit& u, int wr, int wc, int fr, int fq) const {
        const int row0 = u.pm * BM + wr * 64 + fr, col0 = u.pn * BM + wc * 32 + 4 * fq;
#pragma unroll
        for (int ai = 0; ai < 2; ++ai)
#pragma unroll
            for (int m = 0; m < 4; ++m) { float* rowp = C + (size_t)(row0 + ai * HALF + m * 16) * ldc + col0;
#pragma unroll
                for (int bj = 0; bj < 2; ++bj)
#pragma unroll
                    for (int n = 0; n < 2; ++n) *(f32x4*)(rowp + bj * HALF + n * 16) = acc[ai][bj][m][n]; }
    }
};
struct EpiBf16S {
    static constexpr bool PERM = true, AFTER_DRAIN = false;
    bf16_t* O; int ldc; float scale;
    __device__ __forceinline__ void operator()(const f32x4 (&acc)[2][2][4][2], const Unit& u, int wr, int wc, int fr, int fq) const {
        const int row0 = u.pm * BM + wr * 64 + fr, col0 = u.pn * BM + wc * 32 + 8 * fq; const float sc = scale;
#pragma unroll
        for (int ai = 0; ai < 2; ++ai)
#pragma unroll
            for (int m = 0; m < 4; ++m) { bf16_t* rowp = O + (size_t)(row0 + ai * HALF + m * 16) * ldc + col0;
#pragma unroll
                for (int bj = 0; bj < 2; ++bj) { const f32x4 v0 = acc[ai][bj][m][0] * sc, v1 = acc[ai][bj][m][1] * sc;
                    u32x4 w; w.x = cvt_pk_bf16(v0[0], v0[1]); w.y = cvt_pk_bf16(v0[2], v0[3]); w.z = cvt_pk_bf16(v1[0], v1[1]); w.w = cvt_pk_bf16(v1[2], v1[3]);
                    *(u32x4*)(rowp + bj * HALF) = w; } }
    }
};
__device__ __forceinline__ float silu_f(float v) { return v * __builtin_amdgcn_rcpf(1.0f + __expf(-v)); }
struct EpiSwiGLU {
    static constexpr bool PERM = true, AFTER_DRAIN = false;
    bf16_t* O; int ldc;
    __device__ __forceinline__ void operator()(const f32x4 (&acc)[2][2][4][2], const Unit& u, int wr, int wc, int fr, int fq) const {
        const int row0 = u.pm * BM + wr * 64 + fr, col0 = u.pn * HALF + wc * 32 + 8 * fq;
#pragma unroll
        for (int ai = 0; ai < 2; ++ai)
#pragma unroll
            for (int m = 0; m < 4; ++m) { bf16_t* rowp = O + (size_t)(row0 + ai * HALF + m * 16) * ldc + col0;
                const f32x4 g0 = acc[ai][0][m][0], g1 = acc[ai][0][m][1], u0 = acc[ai][1][m][0], u1 = acc[ai][1][m][1];
                u32x4 w; w.x = cvt_pk_bf16(silu_f(g0[0]) * u0[0], silu_f(g0[1]) * u0[1]); w.y = cvt_pk_bf16(silu_f(g0[2]) * u0[2], silu_f(g0[3]) * u0[3]);
                w.z = cvt_pk_bf16(silu_f(g1[0]) * u1[0], silu_f(g1[1]) * u1[1]); w.w = cvt_pk_bf16(silu_f(g1[2]) * u1[2], silu_f(g1[3]) * u1[3]);
                *(u32x4*)rowp = w; }
    }
};
template <class Epi, class Sched, bool ALIGN_EPI = false, bool SP2 = false>
__device__ __forceinline__ void gemm_phase(PG8_LAS unsigned char* lds, const Gemm g, const Sched& S, const Epi& E) {
    int tid_ = threadIdx.x; asm volatile("" : "+v"(tid_));
    const int tid = tid_, wid = __builtin_amdgcn_readfirstlane(tid >> 6), lane = tid & 63, wr = wid >> 2, wc = wid & 3, fr = lane & 15, fq = lane >> 4;
    const int K = g.K, nt = K / BK;
    unsigned voffA[2], voffB[2];
#pragma unroll
    for (int i = 0; i < 2; ++i) { int R, C; stage_rc(tid * 16 + i * 8192, R, C); const int Rb = E.perm() ? ((R & ~31) + perm32(R & 31)) : R;
        voffA[i] = (unsigned)(R * g.lda + C) * 2u; voffB[i] = (unsigned)(Rb * g.ldb + C) * 2u; }
    const size_t kstep = (size_t)(BK * 2);
    const size_t hstepA = (size_t)HALF * g.lda * 2, hstepB = (size_t)HALF * g.ldb * 2;
    const size_t tstepA = 2 * hstepA, tstepB = 2 * hstepB;
    const unsigned ldsw = (unsigned)wid * 1024u;
    const int aoff = lds_byte(wr * 64 + fr, fq * 8), boff = lds_byte(wc * 32 + fr, fq * 8);
#define PG8_SA(b, h) (((b) * 2 + (h)) * HTB)
#define PG8_SB(b, h) ((4 + (b) * 2 + (h)) * HTB)
#define PG8_STAGE(bufoff, gbase, voff) do { _Pragma("unroll") for (int _i = 0; _i < 2; ++_i) \
        __builtin_amdgcn_global_load_lds((const unsigned*)((const char*)(gbase) + (voff)[_i]), (PG8_LAS unsigned*)(lds + (bufoff) + ldsw + _i * 8192), 16, 0, 0); } while (0)
#define PG8_LDA(dst, b, h) do { _Pragma("unroll") for (int m = 0; m < 4; ++m) _Pragma("unroll") for (int k = 0; k < 2; ++k) dst[m][k] = *(const PG8_LAS bf16x8*)(lds + PG8_SA(b, h) + aoff + m * 2048 + k * 1024); } while (0)
#define PG8_LDB(dst, b, h) do { _Pragma("unroll") for (int n = 0; n < 2; ++n) _Pragma("unroll") for (int k = 0; k < 2; ++k) dst[n][k] = *(const PG8_LAS bf16x8*)(lds + PG8_SB(b, h) + boff + n * 2048 + k * 1024); } while (0)
#define PG8_MMA(ai, bj, At, Bt) do { __builtin_amdgcn_s_setprio(1); _Pragma("unroll") for (int m = 0; m < 4; ++m) _Pragma("unroll") for (int n = 0; n < 2; ++n) _Pragma("unroll") for (int k = 0; k < 2; ++k) \
        acc[ai][bj][m][n] = __builtin_amdgcn_mfma_f32_16x16x32_bf16(Bt[n][k], At[m][k], acc[ai][bj][m][n], 0, 0, 0); __builtin_amdgcn_s_setprio(0); } while (0)
#define PG8_WAIT_V(n) asm volatile("s_waitcnt vmcnt(" #n ")" ::: "memory")
#define PG8_WAIT_L(n) asm volatile("s_waitcnt lgkmcnt(" #n ")" ::: "memory")
#define PG8_BAR __builtin_amdgcn_s_barrier()
#define PG8_SCHED __builtin_amdgcn_sched_barrier(0)
    Unit cur, nxt; int ui = 0;
    if (!S.next(0, cur)) return;
    f32x4 acc[2][2][4][2];
#pragma unroll
    for (int a = 0; a < 2; ++a)
#pragma unroll
        for (int b = 0; b < 2; ++b)
#pragma unroll
            for (int m = 0; m < 4; ++m)
#pragma unroll
                for (int n = 0; n < 2; ++n) acc[a][b][m][n] = (f32x4){0.f, 0.f, 0.f, 0.f};
    bf16x8 At[4][2], B0[2][2], B1[2][2];
#pragma unroll
    for (int m = 0; m < 4; ++m)
#pragma unroll
        for (int k = 0; k < 2; ++k) asm volatile("" : "=v"(At[m][k]));
#pragma unroll
    for (int n = 0; n < 2; ++n)
#pragma unroll
        for (int k = 0; k < 2; ++k) { asm volatile("" : "=v"(B0[n][k])); asm volatile("" : "=v"(B1[n][k])); }
    const char* cA = (const char*)g.A + (size_t)cur.pm * tstepA; const char* cB = (const char*)g.Bt + (size_t)cur.pn * tstepB;
    S.a_ready(cur);
    if constexpr (SP2) {
        PG8_STAGE(PG8_SB(0, 0), cB, voffB); PG8_STAGE(PG8_SB(0, 1), cB + hstepB, voffB); PG8_STAGE(PG8_SA(0, 0), cA, voffA); PG8_STAGE(PG8_SA(0, 1), cA + hstepA, voffA);
        if (wr == 1) PG8_BAR;
        PG8_WAIT_V(2); PG8_BAR;
        PG8_STAGE(PG8_SB(1, 0), cB + kstep, voffB); PG8_STAGE(PG8_SA(1, 0), cA + kstep, voffA); PG8_STAGE(PG8_SB(1, 1), cB + hstepB + kstep, voffB);
        PG8_WAIT_V(6); PG8_BAR;
    } else {
        PG8_STAGE(PG8_SB(0, 0), cB, voffB); PG8_STAGE(PG8_SA(0, 0), cA, voffA); PG8_STAGE(PG8_SB(0, 1), cB + hstepB, voffB); PG8_STAGE(PG8_SA(0, 1), cA + hstepA, voffA);
        if (wr == 1) PG8_BAR;
        PG8_WAIT_V(4); PG8_BAR;
        PG8_STAGE(PG8_SB(1, 0), cB + kstep, voffB); PG8_STAGE(PG8_SA(1, 0), cA + kstep, voffA); PG8_STAGE(PG8_SB(1, 1), cB + hstepB + kstep, voffB);
        PG8_WAIT_V(6); PG8_BAR;
    }
    for (;;) {
        const bool has_next = S.next(ui + 1, nxt);
        const char* nA = has_next ? (const char*)g.A + (size_t)nxt.pm * tstepA : cA; const char* nB = has_next ? (const char*)g.Bt + (size_t)nxt.pn * tstepB : cB;
        for (int t = 0; t < nt; t += 2) {
            const bool last = (t == nt - 2);
            const char* a1 = cA + (size_t)(t + 1) * kstep;
            const char* a2 = last ? nA : cA + (size_t)(t + 2) * kstep; const char* b2 = last ? nB : cB + (size_t)(t + 2) * kstep;
            const char* a3 = a2 + kstep; const char* b3 = b2 + kstep;
            if (last && has_next) S.a_ready(nxt);
            if constexpr (SP2) {
            PG8_LDB(B0, 0, 0); PG8_LDB(B1, 0, 1); PG8_SCHED; PG8_LDA(At, 0, 0); PG8_STAGE(PG8_SA(1, 1), a1 + hstepA, voffA);
            PG8_WAIT_V(8); PG8_WAIT_L(0); PG8_BAR; PG8_MMA(0, 0, At, B0); PG8_MMA(0, 1, At, B1); PG8_BAR; PG8_SCHED;
            PG8_LDA(At, 0, 1); PG8_STAGE(PG8_SB(0, 0), b2, voffB); PG8_STAGE(PG8_SB(0, 1), b2 + hstepB, voffB); PG8_STAGE(PG8_SA(0, 0), a2, voffA);
            PG8_WAIT_V(8); PG8_WAIT_L(0); PG8_BAR; PG8_MMA(1, 0, At, B0); PG8_MMA(1, 1, At, B1); PG8_BAR; PG8_SCHED;
            PG8_LDB(B0, 1, 0); PG8_LDB(B1, 1, 1); PG8_SCHED; PG8_LDA(At, 1, 0); PG8_STAGE(PG8_SA(0, 1), a2 + hstepA, voffA);
            PG8_WAIT_V(8); PG8_WAIT_L(0); PG8_BAR; PG8_MMA(0, 0, At, B0); PG8_MMA(0, 1, At, B1); PG8_BAR; PG8_SCHED;
            PG8_LDA(At, 1, 1); PG8_STAGE(PG8_SB(1, 0), b3, voffB); PG8_STAGE(PG8_SB(1, 1), b3 + hstepB, voffB); PG8_STAGE(PG8_SA(1, 0), a3, voffA);
            PG8_WAIT_V(8); PG8_WAIT_L(0); PG8_BAR; PG8_MMA(1, 0, At, B0); PG8_MMA(1, 1, At, B1); PG8_BAR; PG8_SCHED;
            } else {
            PG8_LDB(B0, 0, 0); PG8_SCHED; PG8_LDA(At, 0, 0); PG8_STAGE(PG8_SA(1, 1), a1 + hstepA, voffA);
            PG8_WAIT_L(8); PG8_BAR; PG8_WAIT_L(0); PG8_MMA(0, 0, At, B0); PG8_BAR; PG8_SCHED;
            PG8_LDB(B1, 0, 1); PG8_STAGE(PG8_SB(0, 0), b2, voffB);
            PG8_BAR; PG8_WAIT_L(0); PG8_MMA(0, 1, At, B1); PG8_BAR;
            PG8_LDA(At, 0, 1); PG8_STAGE(PG8_SA(0, 0), a2, voffA);
            PG8_BAR; PG8_WAIT_L(0); PG8_MMA(1, 0, At, B0); PG8_BAR; PG8_SCHED;
            PG8_STAGE(PG8_SB(0, 1), b2 + hstepB, voffB);
            PG8_WAIT_V(6); PG8_BAR; PG8_MMA(1, 1, At, B1); PG8_BAR;
            PG8_LDB(B0, 1, 0); PG8_SCHED; PG8_LDA(At, 1, 0); PG8_STAGE(PG8_SA(0, 1), a2 + hstepA, voffA);
            PG8_WAIT_L(8); PG8_BAR; PG8_WAIT_L(0); PG8_MMA(0, 0, At, B0); PG8_BAR; PG8_SCHED;
            PG8_LDB(B1, 1, 1); PG8_STAGE(PG8_SB(1, 0), b3, voffB);
            PG8_BAR; PG8_WAIT_L(0); PG8_MMA(0, 1, At, B1); PG8_BAR;
            PG8_LDA(At, 1, 1); PG8_STAGE(PG8_SA(1, 0), a3, voffA);
            PG8_BAR; PG8_WAIT_L(0); PG8_MMA(1, 0, At, B0); PG8_BAR; PG8_SCHED;
            PG8_STAGE(PG8_SB(1, 1), b3 + hstepB, voffB);
            PG8_WAIT_V(6); PG8_BAR; PG8_MMA(1, 1, At, B1); PG8_BAR;
            }
        }
        if constexpr (ALIGN_EPI) { if (wr == 0) PG8_BAR; }
        if constexpr (!Epi::AFTER_DRAIN) { E(acc, cur, wr, wc, fr, fq); S.done(cur); }
        if (!has_next) break;
#pragma unroll
        for (int a = 0; a < 2; ++a)
#pragma unroll
            for (int b = 0; b < 2; ++b)
#pragma unroll
                for (int m = 0; m < 4; ++m)
#pragma unroll
                    for (int n = 0; n < 2; ++n) acc[a][b][m][n] = (f32x4){0.f, 0.f, 0.f, 0.f};
        cur = nxt; cA = nA; cB = nB; ++ui;
        if constexpr (ALIGN_EPI) { if (wr == 1) PG8_BAR; }
    }
    PG8_WAIT_V(0);
    if constexpr (!ALIGN_EPI) { if (wr == 0) PG8_BAR; }
    PG8_BAR;
    if constexpr (Epi::AFTER_DRAIN) { E.fused(acc, cur, wr, wc, fr, fq, lds, wid, lane); S.done(cur); }
    if constexpr (Epi::RT_DRAIN) { if (E.drain()) E.fused(acc, cur, wr, wc, fr, fq, lds, wid, lane); }
#undef PG8_SA
#undef PG8_SB
#undef PG8_STAGE
#undef PG8_LDA
#undef PG8_LDB
#undef PG8_MMA
#undef PG8_WAIT_V
#undef PG8_WAIT_L
#undef PG8_BAR
#undef PG8_SCHED
}
}
constexpr int NWAVES = 8;
constexpr int BATCH = 4, SEQ = 2048, DM = 2048, DEPTH = 2;
constexpr int M = BATCH * SEQ;
constexpr int GW = 512;
constexpr int IN_COLS = 5648, IN_PAD = 5888;
constexpr int DFF = 5632, MEML = 256, XH = 4, XHD = 512;
constexpr int MROWS = BATCH * MEML;
constexpr float EPS = 1e-6f;
constexpr int UA_B = 0, UA_C = 512, UA_H = 1024, UB = 1536, UC_Q = 2048, UC_Z = 3584, UC_A = 4096, UC_B = 4100, UD_Z = 4104, UD_X = 4616, UD_DT = 5640;
constexpr int MIX_PRE = 0, MIX_POST = 1, XA_PRE = 2, XA_POST = 3, MEM_NORM = 4, FFN_PRE = 5, FFN_POST = 6, N_NORMS = 7;
enum { I_X = 0, I_MEM, I_NORMG, I_WIN, I_CONVA, I_POOLW, I_POOLS, I_GCONV, I_GALOG, I_GDTB, I_GNG, I_SCONVW, I_SCONVB, I_SALOG, I_SDTB, I_SD, I_SNG, I_WOUT, I_WQ, I_WKV, I_WO, I_WGU, I_WD, N_IN };

constexpr size_t MiB = 1u << 20;
constexpr size_t WS_CTL = 0, CTL_ZERO_BYTES = 128 * 1024;
constexpr size_t WSZ_WIN = (size_t)IN_PAD * DM * 2, WSZ_SQ = (size_t)DM * DM * 2, WSZ_KV = (size_t)2 * DM * DM * 2, WSZ_GU = (size_t)2 * DFF * DM * 2, WSZ_D = (size_t)DM * DFF * 2;
constexpr size_t WO_WIN = 0, WO_WOUT = WO_WIN + WSZ_WIN, WO_WQ = WO_WOUT + WSZ_SQ, WO_WKV = WO_WQ + WSZ_SQ, WO_WO = WO_WKV + WSZ_KV, WO_WGU = WO_WO + WSZ_SQ, WO_WD = WO_WGU + WSZ_GU, W_LAYER = WO_WD + WSZ_D;
constexpr size_t WS_W = 1 * MiB;
constexpr size_t WS_XN = WS_W + 2 * W_LAYER;
constexpr size_t WS_MIX = WS_XN + (size_t)M * DM * 2;
constexpr size_t WS_MEMN = WS_MIX + (size_t)M * DM * 2;
constexpr size_t WS_KV = WS_MEMN + (size_t)2 * MROWS * DM * 2;
constexpr size_t WS_U = WS_KV + (size_t)2 * MROWS * 2 * DM * 2;
constexpr size_t WS_P = WS_U, WS_HID = WS_U + (size_t)M * DM * 2;
constexpr size_t WS_UEND = WS_U + (size_t)120 * MiB;
constexpr size_t WS_ZG = WS_UEND, WS_ZS = WS_ZG + (size_t)M * 512 * 2, WS_BS = WS_ZS + (size_t)M * 512 * 2, WS_CS = WS_BS + (size_t)M * 256 * 4;
constexpr size_t WS_SCR = WS_CS + (size_t)M * 256 * 4;
constexpr size_t WS_Y = WS_SCR;
constexpr size_t SZ512 = (size_t)M * 512 * 4, SZ256 = (size_t)M * 256 * 4, SZ8 = (size_t)M * 8 * 4;
constexpr size_t WS_QN = WS_SCR, WS_KN = WS_QN + SZ512, WS_VV = WS_KN + SZ512, WS_OG = WS_VV + SZ512, WS_XS = WS_OG + SZ512, WS_YS = WS_XS + SZ512,
                 WS_GB = WS_YS + SZ512, WS_DT = WS_GB + SZ8, WS_SCR_END = WS_DT + 2 * SZ8;
constexpr size_t WS_RS = WS_SCR_END;
constexpr size_t WS_PWT = WS_RS + (size_t)M * 4;
constexpr size_t WS_AT = WS_PWT + (size_t)DEPTH * 4 * 128 * 128 * 2, WS_VWT = WS_AT + (size_t)DEPTH * BATCH * 1024 * DM * 2, WS_END = WS_VWT + (size_t)DEPTH * BATCH * DM * 1024 * 2;
constexpr int LA_QD = 0, LA_QK = 16384, LA_KE = 24576, LA_NW = 40960, LA_UCG = 57344, LA_RECG = 90112;
constexpr int LA_UCS = 40960, LA_RECS = 57344;
constexpr size_t WS_FG = WS_U, WS_FS = WS_FG + (size_t)512 * LA_RECG, WS_DLG = WS_FS + (size_t)1024 * LA_RECS, WS_DLS = WS_DLG + 512 * 4, WS_FEND = WS_DLS + 1024 * 4;
static_assert(WS_FEND <= WS_UEND, "records inside U");
static_assert(WS_Y + (size_t)M * DM * 4 <= WS_SCR_END, "Y inside the scan region");
static_assert(WS_HID + (size_t)M * DFF * 2 <= WS_UEND && (size_t)M * IN_PAD * 2 <= (size_t)120 * MiB, "HID and U inside the U region");
static_assert(WS_END <= (size_t)704 * MiB, "d_ws map fits 4 x the largest input");

constexpr int RING_OFF = 0, RING_BYTES = 131072;
constexpr int LDSCTL_OFF = RING_BYTES, MISC_OFF = LDSCTL_OFF + 320;
constexpr int LDS_BYTES = 147456;
constexpr int CW_BAR = 4096;

#define GAS __attribute__((address_space(1)))
#define LAS __attribute__((address_space(3)))
typedef unsigned short bf16;
typedef unsigned v4u __attribute__((ext_vector_type(4)));
typedef unsigned v2u __attribute__((ext_vector_type(2)));
typedef float f32x4 __attribute__((ext_vector_type(4)));
typedef short bf16x8 __attribute__((ext_vector_type(8)));
#define LDS_WAIT() asm volatile("s_waitcnt lgkmcnt(0)" ::: "memory")
#define VM_WAIT() asm volatile("s_waitcnt vmcnt(0)" ::: "memory")
typedef float f32x2v __attribute__((ext_vector_type(2)));
typedef __bf16 bf16x2_t __attribute__((ext_vector_type(2)));
__device__ __forceinline__ unsigned cvtpk(float lo, float hi) { const f32x2v v = {lo, hi}; return __builtin_bit_cast(unsigned, __builtin_convertvector(v, bf16x2_t)); }
__device__ __forceinline__ unsigned pk2(float lo, float hi) { return cvtpk(lo, hi); }
__device__ __forceinline__ unsigned f2bf(float f) { return cvtpk(f, 0.f) & 0xffffu; }
__device__ __forceinline__ float siluf(float v) { return v * __builtin_amdgcn_rcpf(1.0f + __expf(-v)); }
__device__ __forceinline__ float softplusf(float v) { return fmaxf(v, 0.f) + __logf(1.0f + __expf(-fabsf(v))); }
__device__ __forceinline__ float sigmoidf(float v) { return __builtin_amdgcn_rcpf(1.0f + __expf(-v)); }
__device__ __forceinline__ f32x4 ld4(const float* p) { return *(const f32x4*)p; }
__device__ __forceinline__ f32x4 silu4(f32x4 v) { return (f32x4){siluf(v.x), siluf(v.y), siluf(v.z), siluf(v.w)}; }
template <int CTRL> __device__ __forceinline__ float dppf(float v) { return __builtin_bit_cast(float, __builtin_amdgcn_update_dpp(0, __builtin_bit_cast(int, v), CTRL, 0xF, 0xF, true)); }
__device__ __forceinline__ float row16_sum(float v) { v += dppf<0xB1>(v); v += dppf<0x4E>(v); v += dppf<0x141>(v); v += dppf<0x140>(v); return v; }
__device__ __forceinline__ int opq(int v) { asm volatile("" : "+v"(v)); return v; }
__device__ __forceinline__ float shx(float v, int m, int lane) { return __builtin_bit_cast(float, __builtin_amdgcn_ds_bpermute((lane ^ m) << 2, __builtin_bit_cast(int, v))); }
__device__ __forceinline__ float wave_sum(float v) {
    v = row16_sum(v);
    const int iv = __builtin_bit_cast(int, v);
    return (__builtin_bit_cast(float, __builtin_amdgcn_readlane(iv, 0)) + __builtin_bit_cast(float, __builtin_amdgcn_readlane(iv, 16))) + (__builtin_bit_cast(float, __builtin_amdgcn_readlane(iv, 32)) + __builtin_bit_cast(float, __builtin_amdgcn_readlane(iv, 48)));
}

#define XB_TMO      128
#define XB_XCNT(j)  (256  + 64 * (j))
#define XB_XSUB(j)  (1280 + 64 * (j))
#define XB_XGEN(j)  (2304 + 64 * (j))
#define XB_TOP      3328
#define XB_TOPGEN   3392
#define XCD_BAR_WORDS 3456
#define XB_SPIN_CAP (1u << 18)

__device__ __forceinline__ unsigned xb_ld(unsigned* p)              { return __hip_atomic_load(p, __ATOMIC_RELAXED, __HIP_MEMORY_SCOPE_AGENT); }
__device__ __forceinline__ unsigned xb_add(unsigned* p, unsigned v) { return __hip_atomic_fetch_add(p, v, __ATOMIC_RELAXED, __HIP_MEMORY_SCOPE_AGENT); }
__device__ __forceinline__ unsigned xb_xcc_id() { return (unsigned)__builtin_amdgcn_s_getreg((3 << 11) | 20) & 0xFu; }
#define XB_SPIN(cond, bar) do { unsigned _sp = 0; while (cond) { __builtin_amdgcn_s_sleep(1); \
    if ((++_sp & 255u) == 0u) { if (xb_ld(&(bar)[XB_TMO])) break; if (_sp > XB_SPIN_CAP) { atomicAdd(&(bar)[XB_TMO], 1u); break; } } } } while (0)

struct XcdBarrier {
    unsigned* bar; unsigned x;
    volatile LAS unsigned* st;
};

__device__ __forceinline__ XcdBarrier xcd_barrier_post(unsigned* bar, volatile LAS unsigned* st) {
    XcdBarrier b; b.bar = bar; b.x = xb_xcc_id(); b.st = st;
    if (threadIdx.x == 0) (void)xb_add(&bar[XB_XCNT(b.x)], 1u);
    return b;
}
__device__ __forceinline__ void xcd_barrier_complete(unsigned* bar, unsigned x, unsigned& nloc, unsigned& nx) {
    const unsigned G = gridDim.x * gridDim.y * gridDim.z;
    unsigned sum, cnt, mine, sp = 0u;
    for (;;) {
        sum = 0u; cnt = 0u; mine = 0u;
#pragma unroll
        for (unsigned j = 0; j < 16; ++j) { const unsigned c = xb_ld(&bar[XB_XCNT(j)]); sum += c; cnt += (c > 0u) ? 1u : 0u; mine = (j == x) ? c : mine; }
        if (sum == G) break;
        __builtin_amdgcn_s_sleep(1);
        if ((++sp & 255u) == 0u) { if (xb_ld(&bar[XB_TMO])) break; if (sp > XB_SPIN_CAP) { atomicAdd(&bar[XB_TMO], 1u); break; } }
    }
    nloc = mine > 0u ? mine : 1u; nx = cnt > 0u ? cnt : 1u;
}

__device__ __forceinline__ void xcd_barrier(const XcdBarrier& b) {
    asm volatile("s_waitcnt vmcnt(0)" ::: "memory");
    __syncthreads();
    if (threadIdx.x == 0) {
        unsigned* bar = b.bar;
        __builtin_amdgcn_s_waitcnt(0);
        unsigned nloc = b.st[0], nx = b.st[1];
        if (nloc == 0u) { xcd_barrier_complete(bar, b.x, nloc, nx); b.st[0] = nloc; b.st[1] = nx; }
        const unsigned old = xb_add(&bar[XB_XSUB(b.x)], 1u);
        const unsigned gen = old / nloc;
        if (old + 1u == (gen + 1u) * nloc) {
            __builtin_amdgcn_fence(__ATOMIC_RELEASE, "agent");
            asm volatile("s_waitcnt vmcnt(0)" ::: "memory");
            const unsigned og = xb_add(&bar[XB_TOP], 1u);
            const unsigned tg = og / nx;
            if (og + 1u == (tg + 1u) * nx) xb_add(&bar[XB_TOPGEN], 1u);
            else XB_SPIN(xb_ld(&bar[XB_TOPGEN]) == tg, bar);
            __builtin_amdgcn_fence(__ATOMIC_ACQUIRE, "agent");
            xb_add(&bar[XB_XGEN(b.x)], 1u);
            asm volatile("s_waitcnt vmcnt(0)" ::: "memory");
        } else {
            XB_SPIN(xb_ld(&bar[XB_XGEN(b.x)]) == gen, bar);
            __builtin_amdgcn_fence(__ATOMIC_ACQUIRE, "agent");
            asm volatile("s_waitcnt vmcnt(0)" ::: "memory");
        }
    }
    __syncthreads();
}
struct Frame {
    LAS unsigned char* lds;
    volatile LAS unsigned* MISC;
    unsigned* ctl;
    int tid, lane, wave;
    int vcu, G;
    float* out; unsigned char* ws;
};
__device__ __forceinline__ const float* inp(int i) { const float* __attribute__((address_space(4))) const* tab = (const float* __attribute__((address_space(4))) const*)__builtin_amdgcn_kernarg_segment_ptr(); asm volatile("" : "+s"(tab)); return tab[i]; }
__device__ __forceinline__ bf16* wsb(const Frame& F, size_t off) { return (bf16*)(F.ws + off); }
__device__ __forceinline__ float* wsf(const Frame& F, size_t off) { return (float*)(F.ws + off); }

__device__ __forceinline__ void p0_transpose_item(const float* W, int K, int N, bf16* WT, int drow0, int k0, int n0, LAS float* scr, int lane, const float* gk = nullptr  ) {
    const int ch = lane & 15, rsub = lane >> 4; const bool ok = n0 + 4 * ch < N;
    f32x4 wv_[16];
#pragma unroll
    for (int i = 0; i < 16; ++i) { const int kk = 4 * i + rsub; wv_[i] = ok ? ld4(W + (size_t)(k0 + kk) * N + n0 + 4 * ch) : (f32x4){0.f, 0.f, 0.f, 0.f}; }
#pragma unroll
    for (int i = 0; i < 16; ++i) { const int kk = 4 * i + rsub; const f32x4 v = gk ? wv_[i] * gk[k0 + kk] : wv_[i]; *(LAS f32x4*)(scr + kk * 64 + ((ch ^ ((kk >> 3) & 7)) << 2)) = v; }
    LDS_WAIT(); asm volatile("" ::: "memory");
    const int kc = lane & 7;
#pragma unroll
    for (int j = 0; j < 8; ++j) { const int n = (lane >> 3) + 8 * j; float t[8];
#pragma unroll
        for (int q = 0; q < 8; ++q) { const int kk = 8 * kc + q; t[q] = scr[kk * 64 + ((((n >> 2) ^ ((kk >> 3) & 7))) << 2) + (n & 3)]; }
        v4u o; o.x = pk2(t[0], t[1]); o.y = pk2(t[2], t[3]); o.z = pk2(t[4], t[5]); o.w = pk2(t[6], t[7]);
        *(v4u*)(WT + (size_t)(drow0 + n) * K + k0 + 8 * kc) = o; }
    LDS_WAIT(); asm volatile("" ::: "memory");
}
__device__ __forceinline__ void norm_row_to_bf16(const float* xrow, const float* g, bf16* orow, int lane) {
    const f32x4* xr = (const f32x4*)xrow + lane; const f32x4* gr = (const f32x4*)g + lane;
    f32x4 v[8]; float s = 0.f;
#pragma unroll
    for (int j = 0; j < 8; ++j) { v[j] = xr[64 * j]; s += (v[j].x * v[j].x + v[j].y * v[j].y) + (v[j].z * v[j].z + v[j].w * v[j].w); }
    const float rstd = __builtin_amdgcn_rsqf(wave_sum(s) * (1.0f / DM) + EPS);
    v2u* o8 = (v2u*)orow + lane;
#pragma unroll
    for (int j = 0; j < 8; ++j) { const f32x4 gg = gr[64 * j]; v2u w; w.x = pk2(v[j].x * rstd * gg.x, v[j].y * rstd * gg.y); w.y = pk2(v[j].z * rstd * gg.z, v[j].w * rstd * gg.w); o8[64 * j] = w; }
}
__device__ __forceinline__ void p0_prologue(Frame& F, int part) {
    LAS float* scr = (LAS float*)(F.lds + RING_OFF + F.wave * 16384);
    const int vb = part ? 64 : 0;
    if (F.vcu < vb) return;
    const int gw = (F.vcu - vb) * NWAVES + F.wave, NGW = (F.G - vb) * NWAVES; const int lane = opq(F.lane), tid = opq(F.tid);
    const int gt = (F.vcu - vb) * NWAVES * 64 + tid, NGT = NGW * 64;
    constexpr int NB_IN = (IN_COLS + 63) / 64;
    constexpr int I_IN = (DM / 64) * NB_IN, I_SQ = (DM / 64) * (DM / 64), I_KV = (DM / 64) * (2 * DM / 64), I_GU = (DM / 64) * (2 * DFF / 64), I_D = (DFF / 64) * (DM / 64);
    constexpr int I_LAYER = I_IN + 2 * I_SQ + I_KV + I_GU + I_D;
    for (int it = gw; it < I_LAYER; it += NGW) {
        const int l = part; int r = it;
        bf16* wl = wsb(F, WS_W + (size_t)l * W_LAYER);
        if (r < I_IN) { const int kb = r / NB_IN, nb = r % NB_IN; p0_transpose_item(inp(I_WIN) + (size_t)l * DM * IN_COLS, DM, IN_COLS, (bf16*)((char*)wl + WO_WIN), 64 * nb, 64 * kb, 64 * nb, scr, lane, inp(I_NORMG) + (size_t)(l * N_NORMS + MIX_PRE) * DM); continue; } r -= I_IN;
        if (r < I_SQ) { const int kb = r / (DM / 64), nb = r % (DM / 64); p0_transpose_item(inp(I_WOUT) + (size_t)l * DM * DM, DM, DM, (bf16*)((char*)wl + WO_WOUT), 64 * nb, 64 * kb, 64 * nb, scr, lane); continue; } r -= I_SQ;
        if (r < I_SQ) { const int kb = r / (DM / 64), nb = r % (DM / 64); p0_transpose_item(inp(I_WO) + (size_t)l * DM * DM, DM, DM, (bf16*)((char*)wl + WO_WO), 64 * nb, 64 * kb, 64 * nb, scr, lane); continue; } r -= I_SQ;
        if (r < I_KV) { const int kb = r / (2 * DM / 64), nb = r % (2 * DM / 64); p0_transpose_item(inp(I_WKV) + (size_t)l * DM * 2 * DM, DM, 2 * DM, (bf16*)((char*)wl + WO_WKV), 64 * nb, 64 * kb, 64 * nb, scr, lane); continue; } r -= I_KV;
        if (r < I_GU) { const int kb = r / (2 * DFF / 64), nb = r % (2 * DFF / 64); const int n0 = 64 * nb; const int up = n0 >= DFF ? 1 : 0, j0 = n0 - up * DFF;
            const int drow = (j0 >> 7) * 256 + up * 128 + (j0 & 127);
            p0_transpose_item(inp(I_WGU) + (size_t)l * DM * 2 * DFF, DM, 2 * DFF, (bf16*)((char*)wl + WO_WGU), drow, 64 * kb, n0, scr, lane, inp(I_NORMG) + (size_t)(l * N_NORMS + FFN_PRE) * DM); continue; } r -= I_GU;
        { const int kb = r / (DM / 64), nb = r % (DM / 64); p0_transpose_item(inp(I_WD) + (size_t)l * DFF * DM, DFF, DM, (bf16*)((char*)wl + WO_WD), 64 * nb, 64 * kb, 64 * nb, scr, lane); }
    }
    for (int i = gt; i < DM * DM / 8; i += NGT) { const int l = part, k = i;
        const float* src = inp(I_WQ) + (size_t)l * DM * DM + (size_t)k * 8; const float gq = inp(I_NORMG)[(size_t)(l * N_NORMS + XA_PRE) * DM + (k >> 8)]; const f32x4 a = ld4(src) * gq, b = ld4(src + 4) * gq;
        v4u o; o.x = pk2(a.x, a.y); o.y = pk2(a.z, a.w); o.z = pk2(b.x, b.y); o.w = pk2(b.z, b.w);
        ((v4u*)(F.ws + WS_W + (size_t)l * W_LAYER + WO_WQ))[k] = o; }
    { constexpr int ZR0 = 64 * NB_IN, ZN = (IN_PAD - ZR0) * DM / 8;
      const unsigned z0 = (unsigned)opq(0); const v4u zz = {z0, z0, z0, z0};
      for (int i = gt; i < ZN; i += NGT) { const int l = part, k = i;
          ((v4u*)(F.ws + WS_W + (size_t)l * W_LAYER + WO_WIN + (size_t)ZR0 * DM * 2))[k] = zz; } }
    if (part) return;
    for (int i = gt; i < DEPTH * 4 * 128 * 128; i += NGT) { const int c = i & 127, d = (i >> 7) & 127, lg = i >> 14;
        wsb(F, WS_PWT)[i] = (bf16)f2bf(inp(I_POOLW)[((size_t)lg * 128 + c) * 128 + d] * inp(I_POOLS)[(size_t)(lg >> 2) * GW + (lg & 3) * 128 + d]); }
    for (int m = gw; m < DEPTH * MROWS; m += NGW) { const int l = m / MROWS, r = m % MROWS;
        norm_row_to_bf16(inp(I_MEM) + (size_t)r * DM, inp(I_NORMG) + (size_t)(l * N_NORMS + MEM_NORM) * DM, wsb(F, WS_MEMN) + (size_t)m * DM, lane); }
    for (int m = gw; m < M; m += NGW) { const f32x4* xr = (const f32x4*)(inp(I_X) + (size_t)m * DM) + 2 * lane; v4u* xb = (v4u*)(wsb(F, WS_XN) + (size_t)m * DM) + lane; float ss = 0.f;
#pragma unroll
        for (int j = 0; j < 4; ++j) { const f32x4 a = xr[128 * j], b = xr[128 * j + 1]; ss += ((a.x * a.x + a.y * a.y) + (a.z * a.z + a.w * a.w)) + ((b.x * b.x + b.y * b.y) + (b.z * b.z + b.w * b.w));
            v4u o; o.x = pk2(a.x, a.y); o.y = pk2(a.z, a.w); o.z = pk2(b.x, b.y); o.w = pk2(b.z, b.w); xb[64 * j] = o; }
        ss = wave_sum(ss); if (lane == 0) wsf(F, WS_RS)[m] = __builtin_amdgcn_rsqf(ss * (1.0f / DM) + EPS); }
}

struct f32x8 { f32x4 lo, hi; };
__device__ __forceinline__ f32x8 ldu8(const bf16* p) { const v4u w = *(const v4u*)p; f32x8 r;
    r.lo = (f32x4){__builtin_bit_cast(float, w.x << 16), __builtin_bit_cast(float, w.x & 0xffff0000u), __builtin_bit_cast(float, w.y << 16), __builtin_bit_cast(float, w.y & 0xffff0000u)};
    r.hi = (f32x4){__builtin_bit_cast(float, w.z << 16), __builtin_bit_cast(float, w.z & 0xffff0000u), __builtin_bit_cast(float, w.w << 16), __builtin_bit_cast(float, w.w & 0xffff0000u)}; return r; }
__device__ __forceinline__ f32x8 cvt8(const v4u w) { f32x8 r;
    r.lo = (f32x4){__builtin_bit_cast(float, w.x << 16), __builtin_bit_cast(float, w.x & 0xffff0000u), __builtin_bit_cast(float, w.y << 16), __builtin_bit_cast(float, w.y & 0xffff0000u)};
    r.hi = (f32x4){__builtin_bit_cast(float, w.z << 16), __builtin_bit_cast(float, w.z & 0xffff0000u), __builtin_bit_cast(float, w.w << 16), __builtin_bit_cast(float, w.w & 0xffff0000u)}; return r; }
__device__ __forceinline__ f32x8 ld8f(const float* p) { f32x8 r; r.lo = ld4(p); r.hi = ld4(p + 4); return r; }
__device__ __forceinline__ f32x8 operator*(const f32x8& a, const f32x8& b) { return f32x8{a.lo * b.lo, a.hi * b.hi}; }
__device__ __forceinline__ f32x8 operator+(const f32x8& a, const f32x8& b) { return f32x8{a.lo + b.lo, a.hi + b.hi}; }
__device__ __forceinline__ f32x8 silu8(const f32x8& a) { return f32x8{silu4(a.lo), silu4(a.hi)}; }
__device__ __forceinline__ float sumsq8(const f32x8& y) { return ((y.lo.x * y.lo.x + y.lo.y * y.lo.y) + (y.lo.z * y.lo.z + y.lo.w * y.lo.w)) + ((y.hi.x * y.hi.x + y.hi.y * y.hi.y) + (y.hi.z * y.hi.z + y.hi.w * y.hi.w)); }
__device__ __forceinline__ v4u pack8u(const f32x8& y) { v4u o; o.x = pk2(y.lo.x, y.lo.y); o.y = pk2(y.lo.z, y.lo.w); o.z = pk2(y.hi.x, y.hi.y); o.w = pk2(y.hi.z, y.hi.w); return o; }
__device__ __forceinline__ void mixer_prep_phase(Frame& F, int l) {
    const int gw = F.vcu * NWAVES + F.wave, NGW = F.G * NWAVES, lane = opq(F.lane), tid = opq(F.tid);
    const bf16* U = wsb(F, WS_U);
    bf16* MIX = wsb(F, WS_MIX);
    constexpr int NSTRIP = M / 16, NTYPE = 12;
    for (int it = gw; it < NTYPE * NSTRIP; it += NGW) {
        const int type = it % NTYPE, strip = it / NTYPE, r0 = strip * 16, pos0 = r0 & (SEQ - 1), c = lane * 8;
        const bf16* ur0 = U + (size_t)r0 * IN_PAD;
        if (type == 0) {
            const float* cw = inp(I_CONVA) + (size_t)l * 3 * GW + c;
            const f32x8 w0 = ld8f(cw), w1 = ld8f(cw + GW), w2 = ld8f(cw + 2 * GW);
            const v4u z4 = {0u, 0u, 0u, 0u};
#pragma unroll 1
            for (int hf = 0; hf < 2; ++hf) {
                const bf16* ub = ur0 + (size_t)(8 * hf) * IN_PAD;
                v4u rc[10], rh[10], rb[8];
#pragma unroll
                for (int i = 0; i < 10; ++i) { const int ri = i - 2; if (ri >= 0 || pos0 > 0 || hf > 0) { rc[i] = *(const v4u*)(ub + (ptrdiff_t)ri * IN_PAD + UA_C + c); rh[i] = *(const v4u*)(ub + (ptrdiff_t)ri * IN_PAD + UA_H + c); } else { rc[i] = z4; rh[i] = z4; } }
#pragma unroll
                for (int i = 0; i < 8; ++i) rb[i] = *(const v4u*)(ub + (size_t)i * IN_PAD + UA_B + c);
                f32x8 p2 = cvt8(rc[0]) * cvt8(rh[0]), p1 = cvt8(rc[1]) * cvt8(rh[1]);
#pragma unroll
                for (int i = 0; i < 8; ++i) { const f32x8 p0 = cvt8(rc[i + 2]) * cvt8(rh[i + 2]); const f32x8 y = cvt8(rb[i]) * (w0 * p2 + w1 * p1 + w2 * p0);
                    *(v4u*)(MIX + (size_t)(r0 + 8 * hf + i) * DM + c) = pack8u(y); p2 = p1; p1 = p0; }
            }
        } else if (type < 4) {
            const int gi = type - 1, cc = gi * GW + c;
            const float* cw = inp(I_GCONV) + (size_t)l * 4 * 3 * GW + cc;
            const f32x8 w0 = ld8f(cw), w1 = ld8f(cw + 3 * GW), w2 = ld8f(cw + 6 * GW), w3 = ld8f(cw + 9 * GW);
            v4u xr[19];
#pragma unroll
            for (int i = 0; i < 19; ++i) { const int ri = i - 3; if (ri >= 0 || pos0 > 0) xr[i] = *(const v4u*)(ur0 + (ptrdiff_t)ri * IN_PAD + UC_Q + cc); else xr[i] = (v4u){0u, 0u, 0u, 0u}; }
            float* dst = (gi == 0) ? wsf(F, WS_QN) : (gi == 1) ? wsf(F, WS_KN) : wsf(F, WS_VV);
            const float qs = (gi == 0) ? 0.08838834764831845f : 1.0f;
            f32x8 x3 = cvt8(xr[0]), x2 = cvt8(xr[1]), x1 = cvt8(xr[2]);
#pragma unroll
            for (int i = 0; i < 16; ++i) { const f32x8 x0 = cvt8(xr[i + 3]); f32x8 y = silu8(w0 * x3 + w1 * x2 + w2 * x1 + w3 * x0); x3 = x2; x2 = x1; x1 = x0;
                if (gi < 2) { float ss = row16_sum(sumsq8(y));
                    const float sc = qs * __builtin_amdgcn_rsqf(ss + EPS); y.lo = y.lo * sc; y.hi = y.hi * sc; }
                float* d = dst + (size_t)(r0 + i) * GW + c; *(f32x4*)d = y.lo; *(f32x4*)(d + 4) = y.hi; }
        } else if (type < 6) {
            const int gi = type - 4, cc = gi * GW + c;
            const float* cw = inp(I_SCONVW) + (size_t)l * 4 * 1024 + cc;
            const f32x8 w0 = ld8f(cw), w1 = ld8f(cw + 1024), w2 = ld8f(cw + 2048), w3 = ld8f(cw + 3072), bb = ld8f(inp(I_SCONVB) + (size_t)l * 1024 + cc);
            v4u xr[19];
#pragma unroll
            for (int i = 0; i < 19; ++i) { const int ri = i - 3; if (ri >= 0 || pos0 > 0) xr[i] = *(const v4u*)(ur0 + (ptrdiff_t)ri * IN_PAD + UD_X + cc); else xr[i] = (v4u){0u, 0u, 0u, 0u}; }
            f32x8 x3 = cvt8(xr[0]), x2 = cvt8(xr[1]), x1 = cvt8(xr[2]);
            float* dst; int ld, co;
            if (gi == 0) { dst = wsf(F, WS_XS); ld = 512; co = c; } else if (c < 256) { dst = wsf(F, WS_BS); ld = 256; co = c; } else { dst = wsf(F, WS_CS); ld = 256; co = c - 256; }
#pragma unroll
            for (int i = 0; i < 16; ++i) { const f32x8 x0 = cvt8(xr[i + 3]); const f32x8 y = silu8(w0 * x3 + w1 * x2 + w2 * x1 + w3 * x0 + bb); x3 = x2; x2 = x1; x1 = x0;
                float* d = dst + (size_t)(r0 + i) * ld + co; *(f32x4*)d = y.lo; *(f32x4*)(d + 4) = y.hi; }
        } else if (type < 8) {
            const int zo = (type == 6) ? UC_Z : UD_Z; bf16* dst = wsb(F, (type == 6) ? WS_ZG : WS_ZS);
            v4u z[16];
#pragma unroll
            for (int i = 0; i < 16; ++i) z[i] = *(const v4u*)(ur0 + (size_t)i * IN_PAD + zo + c);
#pragma unroll
            for (int i = 0; i < 16; ++i) *(v4u*)(dst + (size_t)(r0 + i) * GW + c) = z[i];
        } else {
            const int gi = type - 8, w = 2 << gi;
            LAS float* scr = (LAS float*)(F.lds + RING_OFF + F.wave * 16384);
            const int c0 = UB + gi * 128 + lane * 2;
            float uv0[31], uv1[31];
#pragma unroll
            for (int i = 0; i < 31; ++i) { const int ri = i - 15; float a0 = 0.f, a1 = 0.f;
                if (ri >= 0 || pos0 > 0) { const unsigned wd = *(const unsigned*)(ur0 + (ptrdiff_t)ri * IN_PAD + c0); a0 = __builtin_bit_cast(float, wd << 16); a1 = __builtin_bit_cast(float, wd & 0xffff0000u); }
                uv0[i] = a0; uv1[i] = a1; }
            float r0s = 0.f, r1s = 0.f;
#pragma unroll
            for (int s = 1; s < 16; ++s) if (s < w) { r0s += uv0[15 - s]; r1s += uv1[15 - s]; }
#pragma unroll
            for (int i = 0; i < 16; ++i) { const int pos = pos0 + i; const float a0 = uv0[15 + i], a1 = uv1[15 + i];
                r0s += a0; r1s += a1;
                const float cnt = (float)((pos + 1 < w) ? pos + 1 : w);
                const float rc = __builtin_amdgcn_rcpf(cnt); scr[i * 128 + lane * 2] = r0s * rc - a0; scr[i * 128 + lane * 2 + 1] = r1s * rc - a1;
                float d0 = 0.f, d1 = 0.f;
#pragma unroll
                for (int g2 = 0; g2 < 4; ++g2) if (gi == g2) { d0 = uv0[15 + i - (2 << g2) + 1]; d1 = uv1[15 + i - (2 << g2) + 1]; }
                r0s -= d0; r1s -= d1; }
            LDS_WAIT(); asm volatile("" ::: "memory");
            const bf16* pwt = wsb(F, WS_PWT) + ((size_t)l * 4 + gi) * 128 * 128 + (size_t)(lane & 15) * 128 + (lane >> 4) * 8;
            bf16x8 bfr[4];
#pragma unroll
            for (int ks = 0; ks < 4; ++ks) { const LAS float* pr = scr + (lane & 15) * 128 + 32 * ks + (lane >> 4) * 8; const f32x4 p0 = *(const LAS f32x4*)pr, p1 = *(const LAS f32x4*)(pr + 4);
                v4u w; w.x = pk2(p0.x, p0.y); w.y = pk2(p0.z, p0.w); w.z = pk2(p1.x, p1.y); w.w = pk2(p1.z, p1.w); bfr[ks] = __builtin_bit_cast(bf16x8, w); }
            bf16* orow = MIX + (size_t)(r0 + (lane & 15)) * DM + GW + gi * 128 + (lane >> 4) * 4;
#pragma unroll
            for (int nh = 0; nh < 2; ++nh) {
                bf16x8 afr[4][4];
#pragma unroll
                for (int nt = 0; nt < 4; ++nt)
#pragma unroll
                    for (int ks = 0; ks < 4; ++ks) afr[nt][ks] = *(const bf16x8*)(pwt + (size_t)((nh * 4 + nt) * 16) * 128 + 32 * ks);
#pragma unroll
                for (int nt = 0; nt < 4; ++nt) { f32x4 acc = {0.f, 0.f, 0.f, 0.f};
#pragma unroll
                    for (int ks = 0; ks < 4; ++ks) acc = __builtin_amdgcn_mfma_f32_16x16x32_bf16(afr[nt][ks], bfr[ks], acc, 0, 0, 0);
                    v2u o; o.x = pk2(acc.x, acc.y); o.y = pk2(acc.z, acc.w); *(v2u*)(orow + (nh * 4 + nt) * 16) = o; }
            }
            LDS_WAIT(); asm volatile("" ::: "memory");
        }
    }
    for (int i = (F.vcu * NWAVES * 64) + tid; i < M * 16; i += F.G * NWAVES * 64) { const int t = i >> 4, j = i & 15; const bf16* ur = U + (size_t)t * IN_PAD;
#define UF(col) __builtin_bit_cast(float, (unsigned)ur[col] << 16)
        if (j < 4) { wsf(F, WS_GB)[(size_t)t * 8 + 2 * j] = -__expf(inp(I_GALOG)[l * 4 + j]) * softplusf(UF(UC_A + j) + inp(I_GDTB)[l * 4 + j]); }
        else if (j < 8) { wsf(F, WS_GB)[(size_t)t * 8 + 2 * (j - 4) + 1] = sigmoidf(UF(UC_B + (j - 4))); }
        else { const int hh = j - 8; const float dt = softplusf(UF(UD_DT + hh) + inp(I_SDTB)[l * 8 + hh]);
            wsf(F, WS_DT)[(size_t)t * 16 + 2 * hh] = -__expf(inp(I_SALOG)[l * 8 + hh]) * dt; wsf(F, WS_DT)[(size_t)t * 16 + 2 * hh + 1] = dt; }
#undef UF
    }
}

typedef float f32x16 __attribute__((ext_vector_type(16)));
__device__ __forceinline__ bf16x8 pack8(float a0, float a1, float a2, float a3, float a4, float a5, float a6, float a7) { v4u w; w.x = cvtpk(a0, a1); w.y = cvtpk(a2, a3); w.z = cvtpk(a4, a5); w.w = cvtpk(a6, a7); return __builtin_bit_cast(bf16x8, w); }
#define PACK_STEP(x, s) pack8((x)[8 * (s)], (x)[8 * (s) + 1], (x)[8 * (s) + 2], (x)[8 * (s) + 3], (x)[8 * (s) + 4], (x)[8 * (s) + 5], (x)[8 * (s) + 6], (x)[8 * (s) + 7])
#define MFMA32(a, b, c) __builtin_amdgcn_mfma_f32_32x32x16_bf16((a), (b), (c), 0, 0, 0)
__device__ __forceinline__ int crow(int reg, int h) { return (reg & 3) + 8 * (reg >> 2) + 4 * h; }
constexpr int LA_KB = 0;
constexpr int LA_QB = LA_KB + 64 * 136 * 2;
constexpr int LA_KGT = LA_QB + 64 * 136 * 2;
constexpr int LA_VBT = LA_KGT + 128 * 72 * 2;
constexpr int LA_KET = LA_VBT + 128 * 72 * 2;
constexpr int LA_M = LA_KET + 128 * 72 * 2;
constexpr int LA_TB = LA_M + 64 * 68 * 4;
constexpr int LA_VEC = LA_TB + 64 * 72 * 2;
static_assert(LA_VEC + 1024 <= RING_BYTES, "la LDS map");
__device__ __forceinline__ bf16x8 lds_frag(const LAS unsigned char* base, int row, int stride_el, int col) { return *(const LAS bf16x8*)(base + ((size_t)row * stride_el + col) * 2); }
__device__ __forceinline__ float wave_incl_scan(float v, int lane) {
#pragma unroll
    for (int d = 1; d < 64; d <<= 1) { const float o = __builtin_bit_cast(float, __builtin_amdgcn_ds_bpermute((lane - d) << 2, __builtin_bit_cast(int, v))); if (lane >= d) v += o; }
    return v;
}
__device__ __forceinline__ void store_qk_frag(const f32x16& acc, const LAS float* Gv, int mt, int rt, int r, int h, int lane, bf16* qkf) {
    const int l = 32 * rt + r; const float Gl = Gv[l];
    float v[16];
#pragma unroll
    for (int q = 0; q < 16; ++q) { const int m = 32 * mt + crow(q, h); v[q] = (m <= l) ? acc[q] * __expf(Gl - Gv[m]) : 0.f; }
    *(bf16x8*)(qkf + ((size_t)(rt * 4 + 2 * mt + 0) * 64 + lane) * 8) = pack8(v[0], v[1], v[2], v[3], v[4], v[5], v[6], v[7]);
    *(bf16x8*)(qkf + ((size_t)(rt * 4 + 2 * mt + 1) * 64 + lane) * 8) = pack8(v[8], v[9], v[10], v[11], v[12], v[13], v[14], v[15]);
}
__device__ __forceinline__ void qd_frag_task(const float* qrows, int ldq, const LAS float* Gv, int task, int r, int h, int lane, bf16* qdf) {
    const int rt = task >> 3, ks = task & 7, l = 32 * rt + r, k0 = 16 * ks + 4 * h; const float e = __expf(Gv[l]);
    const f32x4 a = ld4(qrows + (size_t)l * ldq + k0), b = ld4(qrows + (size_t)l * ldq + k0 + 8);
    *(bf16x8*)(qdf + ((size_t)task * 64 + lane) * 8) = pack8(a.x * e, a.y * e, a.z * e, a.w * e, b.x * e, b.y * e, b.z * e, b.w * e);
}
__device__ __forceinline__ void qd_frag_task4(const float* qrows, int ldq, const LAS float* Gv, int task0, int r, int h, int lane, bf16* qdf) {
    f32x4 a[4], b[4]; float e[4];
#pragma unroll
    for (int t = 0; t < 4; ++t) { const int task = task0 + t, rt = task >> 3, ks = task & 7, l = 32 * rt + r, k0 = 16 * ks + 4 * h;
        a[t] = ld4(qrows + (size_t)l * ldq + k0); b[t] = ld4(qrows + (size_t)l * ldq + k0 + 8); e[t] = __expf(Gv[l]); }
#pragma unroll
    for (int t = 0; t < 4; ++t) *(bf16x8*)(qdf + ((size_t)(task0 + t) * 64 + lane) * 8) = pack8(a[t].x * e[t], a[t].y * e[t], a[t].z * e[t], a[t].w * e[t], b[t].x * e[t], b[t].y * e[t], b[t].z * e[t], b[t].w * e[t]);
}
__device__ __forceinline__ void ke_frag_task(const LAS unsigned char* ket, int task, int r, int h, int lane, bf16* kef) {
    const int it = task >> 2, ks = task & 3, dk = 32 * it + r, l0 = 16 * ks + 4 * h;
    const v2u lo = *(const LAS v2u*)(ket + ((size_t)dk * 72 + l0) * 2), hi = *(const LAS v2u*)(ket + ((size_t)dk * 72 + l0 + 8) * 2);
    v4u w; w.x = lo.x; w.y = lo.y; w.z = hi.x; w.w = hi.y;
    *(v4u*)(kef + ((size_t)task * 64 + lane) * 8) = w;
}

#ifndef LAREP
#define LAREP 0
#endif
#define LDS_SYNC() do { asm volatile("s_waitcnt lgkmcnt(0)" ::: "memory"); __builtin_amdgcn_s_barrier(); asm volatile("" ::: "memory"); } while (0)
__device__ __forceinline__ void la_prep_phase(Frame& F, int l_unused) {
    const int tid0 = opq(F.tid), wv = F.wave;
    LAS unsigned char* L = F.lds + RING_OFF; asm volatile("" : "+v"(L));
    LAS float* Gv = (LAS float*)(L + LA_VEC); LAS float* Bv = Gv + 64;
    LAS float* Mf = (LAS float*)(L + LA_M);
    const f32x16 zero16 = {0.f, 0.f, 0.f, 0.f, 0.f, 0.f, 0.f, 0.f, 0.f, 0.f, 0.f, 0.f, 0.f, 0.f, 0.f, 0.f};
    for (int item = F.vcu; item < 512; item += F.G) {
        const int tid = opq(tid0), lane = tid & 63, r = lane & 31, h = lane >> 5;
        const int seq = item >> 5, ch = item & 31, b = seq >> 2, hd = seq & 3;
        const size_t t0 = (size_t)b * SEQ + ch * 64;
        const float* KN = wsf(F, WS_KN) + t0 * GW + hd * 128; const float* QN = wsf(F, WS_QN) + t0 * GW + hd * 128; const float* VV = wsf(F, WS_VV) + t0 * GW + hd * 128;
        unsigned char* rec = F.ws + WS_FG + (size_t)item * LA_RECG;
        const int c = tid & 127, lg = tid >> 7;
        const f32x2v gb = *(const f32x2v*)(wsf(F, WS_GB) + (t0 + lane) * 8 + 2 * hd);
        float kr[16], qr[16], vr[16];
#pragma unroll
        for (int i = 0; i < 16; ++i) { const int l = lg * 16 + i; kr[i] = KN[(size_t)l * GW + c]; qr[i] = QN[(size_t)l * GW + c]; vr[i] = VV[(size_t)l * GW + c]; }
        f32x4 qa[4], qb[4];
        { const int qw = (wv >= 2 && wv <= 5) ? wv - 2 : 0;
#pragma unroll
            for (int t = 0; t < 4; ++t) { const int task = 4 * qw + t, rt = task >> 3, ks = task & 7, l = 32 * rt + r, k0 = 16 * ks + 4 * h; qa[t] = ld4(QN + (size_t)l * GW + k0); qb[t] = ld4(QN + (size_t)l * GW + k0 + 8); } }
        if (wv == 0) { Gv[lane] = wave_incl_scan(gb.x, lane); Bv[lane] = gb.y; }
        LDS_SYNC();
        const float G63 = Gv[63];
#pragma unroll
        for (int i = 0; i < 16; ++i) { const int l = lg * 16 + i; const float kv = kr[i], qv = qr[i], vv = vr[i];
            const float Gl = Gv[l], bl = Bv[l];
            ((LAS bf16*)(L + LA_KB))[l * 136 + c] = (bf16)f2bf(kv); ((LAS bf16*)(L + LA_QB))[l * 136 + c] = (bf16)f2bf(qv);
            ((LAS bf16*)(L + LA_KGT))[c * 72 + l] = (bf16)f2bf(-kv * bl * __expf(Gl)); ((LAS bf16*)(L + LA_VBT))[c * 72 + l] = (bf16)f2bf(vv * bl);
            ((LAS bf16*)(L + LA_KET))[c * 72 + l] = (bf16)f2bf(kv * __expf(G63 - Gl)); }
        LDS_SYNC();
        if (wv < 4) { const int it = wv >> 1, jt = wv & 1; f32x16 acc = zero16;
            if (!(it == 0 && jt == 1)) {
#pragma unroll
                for (int ks = 0; ks < 8; ++ks) acc = MFMA32(lds_frag(L + LA_KB, 32 * it + r, 136, 16 * ks + 8 * h), lds_frag(L + LA_KB, 32 * jt + r, 136, 16 * ks + 8 * h), acc); }
            const int j = 32 * jt + r; const float Gj = Gv[j];
#pragma unroll
            for (int q = 0; q < 16; ++q) { const int i = 32 * it + crow(q, h); Mf[i * 68 + j] = (j < i) ? Bv[i] * acc[q] * __expf(Gv[i] - Gj) : 0.f; }
        } else { const int mt = (wv - 4) >> 1, rt = (wv - 4) & 1; f32x16 acc = zero16;
            if (!(mt == 1 && rt == 0)) {
#pragma unroll
                for (int ks = 0; ks < 8; ++ks) acc = MFMA32(lds_frag(L + LA_KB, 32 * mt + r, 136, 16 * ks + 8 * h), lds_frag(L + LA_QB, 32 * rt + r, 136, 16 * ks + 8 * h), acc); }
            store_qk_frag(acc, Gv, mt, rt, r, h, lane, (bf16*)(rec + LA_QK)); }
        LDS_SYNC();
        f32x16 Pacc = zero16;
        if (wv < 2) {
            const int ln = opq(lane), cc = ln & 31, bo = 32 * wv;
            float Tc[32];
#pragma unroll
            for (int i = 0; i < 32; ++i) {
                float a0 = (i == cc) ? 1.f : 0.f, a1 = 0.f, a2 = 0.f, a3 = 0.f;
#pragma unroll
                for (int j4 = 0; j4 < (i + 3) / 4; ++j4) { const f32x4 m = *(const LAS f32x4*)(Mf + (bo + i) * 68 + bo + 4 * j4);
                    a0 -= m.x * Tc[4 * j4]; if (4 * j4 + 1 < i) a1 -= m.y * Tc[4 * j4 + 1]; if (4 * j4 + 2 < i) a2 -= m.z * Tc[4 * j4 + 2]; if (4 * j4 + 3 < i) a3 -= m.w * Tc[4 * j4 + 3]; }
                Tc[i] = (a0 + a1) + (a2 + a3);
                ((LAS bf16*)(L + LA_TB))[(bo + i) * 72 + bo + cc] = (bf16)f2bf(Tc[i]);
                if (wv == 0) ((LAS bf16*)(L + LA_TB))[i * 72 + 32 + cc] = (bf16)0;
                if ((i & 7) == 7) asm volatile("" ::: "memory");
            }
            if (wv == 0) {
#pragma unroll
                for (int s2 = 0; s2 < 2; ++s2) {
                    const LAS float* mr = Mf + (32 + r) * 68 + 16 * s2 + 8 * h; const f32x4 m0 = *(const LAS f32x4*)mr, m1 = *(const LAS f32x4*)(mr + 4);
                    const bf16x8 af = pack8(m0.x, m0.y, m0.z, m0.w, m1.x, m1.y, m1.z, m1.w);
                    const bf16x8 bfr = h ? pack8(Tc[16 * s2 + 8], Tc[16 * s2 + 9], Tc[16 * s2 + 10], Tc[16 * s2 + 11], Tc[16 * s2 + 12], Tc[16 * s2 + 13], Tc[16 * s2 + 14], Tc[16 * s2 + 15])
                                          : pack8(Tc[16 * s2 + 0], Tc[16 * s2 + 1], Tc[16 * s2 + 2], Tc[16 * s2 + 3], Tc[16 * s2 + 4], Tc[16 * s2 + 5], Tc[16 * s2 + 6], Tc[16 * s2 + 7]);
                    Pacc = MFMA32(af, bfr, Pacc); }
                if (lane == 0) wsf(F, WS_DLG)[item] = __expf(G63);
            }
        } else if (wv <= 5) {
#pragma unroll
            for (int t = 0; t < 4; ++t) { const int task = 4 * (wv - 2) + t, rt = task >> 3; const float e = __expf(Gv[32 * rt + r]);
                *(bf16x8*)((bf16*)(rec + LA_QD) + ((size_t)task * 64 + lane) * 8) = pack8(qa[t].x * e, qa[t].y * e, qa[t].z * e, qa[t].w * e, qb[t].x * e, qb[t].y * e, qb[t].z * e, qb[t].w * e); }
        } else {
#pragma unroll
            for (int t = 0; t < 8; ++t) ke_frag_task(L + LA_KET, 8 * (wv - 6) + t, r, h, lane, (bf16*)(rec + LA_KE)); }
        LDS_SYNC();
        if (wv == 0) {
            f32x16 t21 = zero16;
#pragma unroll
            for (int s2 = 0; s2 < 2; ++s2) {
                const LAS unsigned char* tr = L + LA_TB + ((size_t)(32 + r) * 72 + 32 + 16 * s2 + 4 * h) * 2;
                const v2u lo = *(const LAS v2u*)tr, hi = *(const LAS v2u*)(tr + 16); v4u w; w.x = lo.x; w.y = lo.y; w.z = hi.x; w.w = hi.y;
                t21 = MFMA32(__builtin_bit_cast(bf16x8, w), PACK_STEP(Pacc, s2), t21); }
#pragma unroll
            for (int q = 0; q < 16; ++q) ((LAS bf16*)(L + LA_TB))[(32 + crow(q, h)) * 72 + r] = (bf16)f2bf(-t21[q]);
        }
        LDS_SYNC();
#pragma unroll 1
        for (int tile = wv; tile < 16; tile += 8) {
            f32x16 acc = zero16;
            if (tile < 8) { const int it = tile >> 1, rt = tile & 1;
#pragma unroll
                for (int ks = 0; ks < 4; ++ks) acc = MFMA32(lds_frag(L + LA_KGT, 32 * it + r, 72, 16 * ks + 8 * h), lds_frag(L + LA_TB, 32 * rt + r, 72, 16 * ks + 8 * h), acc);
                bf16* nw = (bf16*)(rec + LA_NW);
                *(bf16x8*)(nw + ((size_t)(rt * 8 + 2 * it + 0) * 64 + lane) * 8) = PACK_STEP(acc, 0);
                *(bf16x8*)(nw + ((size_t)(rt * 8 + 2 * it + 1) * 64 + lane) * 8) = PACK_STEP(acc, 1);
            } else { const int rt = (tile - 8) >> 2, dvt = (tile - 8) & 3;
#pragma unroll
                for (int ks = 0; ks < 4; ++ks) acc = MFMA32(lds_frag(L + LA_TB, 32 * rt + r, 72, 16 * ks + 8 * h), lds_frag(L + LA_VBT, 32 * dvt + r, 72, 16 * ks + 8 * h), acc);
                float* uc = (float*)(rec + LA_UCG) + ((size_t)(dvt * 2 + rt) * 4 * 64 + lane) * 4;
#pragma unroll
                for (int q4 = 0; q4 < 4; ++q4) *(f32x4*)(uc + (size_t)q4 * 256) = (f32x4){acc[4 * q4], acc[4 * q4 + 1], acc[4 * q4 + 2], acc[4 * q4 + 3]};
            }
        }
        LDS_SYNC();
    }
    for (int item = F.vcu; item < 256; item += F.G) {
        const int tid = opq(tid0), lane = tid & 63, r = lane & 31, h = lane >> 5;
        const int b = item >> 6, ch = (item >> 1) & 31, g = item & 1;
        const size_t t0 = (size_t)b * SEQ + ch * 64;
        const float* BS = wsf(F, WS_BS) + t0 * 256 + g * 128; const float* CS = wsf(F, WS_CS) + t0 * 256 + g * 128;
        const int c = tid & 127, lg = tid >> 7;
        float br[16], cr[16];
#pragma unroll
        for (int i = 0; i < 16; ++i) { const int l = lg * 16 + i; br[i] = BS[(size_t)l * 256 + c]; cr[i] = CS[(size_t)l * 256 + c]; }
        f32x2v ad[4];
#pragma unroll
        for (int hi = 0; hi < 4; ++hi) ad[hi] = *(const f32x2v*)(wsf(F, WS_DT) + (t0 + lane) * 16 + 2 * (4 * g + hi));
        f32x4 ca[4], cb[4]; float xv[4][16];
        const int sl = (wv >> 1) & 1, rt2 = wv & 1;
        {
#pragma unroll
            for (int t = 0; t < 4; ++t) { const int task = 4 * (wv & 3) + t, rt = task >> 3, ks = task & 7, l = 32 * rt + r, k0 = 16 * ks + 4 * h; ca[t] = ld4(CS + (size_t)l * 256 + k0); cb[t] = ld4(CS + (size_t)l * 256 + k0 + 8); }
#pragma unroll
            for (int hi = 0; hi < 4; ++hi)
#pragma unroll
                for (int q = 0; q < 16; ++q) xv[hi][q] = wsf(F, WS_XS)[(t0 + 32 * rt2 + crow(q, h)) * GW + (4 * g + hi) * 64 + 32 * sl + r]; }
#pragma unroll
        for (int i = 0; i < 16; ++i) { const int l = lg * 16 + i;
            ((LAS bf16*)(L + LA_KB))[l * 136 + c] = (bf16)f2bf(br[i]); ((LAS bf16*)(L + LA_QB))[l * 136 + c] = (bf16)f2bf(cr[i]); }
        if (wv == 0) {
#pragma unroll
            for (int hi = 0; hi < 4; ++hi) { Gv[hi * 64 + lane] = wave_incl_scan(ad[hi].x, lane); Gv[256 + hi * 64 + lane] = ad[hi].y; } }
        LDS_SYNC();
        f32x16 raw = zero16;
        const int mt = (wv >> 1) & 1, rt = wv & 1;
        if (wv < 4 && !(mt == 1 && rt == 0)) {
#pragma unroll
            for (int ks = 0; ks < 8; ++ks) raw = MFMA32(lds_frag(L + LA_KB, 32 * mt + r, 136, 16 * ks + 8 * h), lds_frag(L + LA_QB, 32 * rt + r, 136, 16 * ks + 8 * h), raw); }
#pragma unroll
        for (int hi = 0; hi < 4; ++hi) {
            const int hh = 4 * g + hi, seq = b * 8 + hh;
            unsigned char* rec = F.ws + WS_FS + ((size_t)seq * 32 + ch) * LA_RECS;
            const LAS float* Gh = Gv + hi * 64; const LAS float* Dh = Gv + 256 + hi * 64;
            const float G63 = Gh[63];
#pragma unroll
            for (int i = 0; i < 16; ++i) { const int l = lg * 16 + i; ((LAS bf16*)(L + LA_KET))[c * 72 + l] = (bf16)f2bf(br[i] * __expf(G63 - Gh[l])); }
            if (wv < 4) {
                store_qk_frag(raw, Gh, mt, rt, r, h, lane, (bf16*)(rec + LA_QK));
#pragma unroll
                for (int t = 0; t < 4; ++t) { const int task = 4 * wv + t, rtq = task >> 3; const float e = __expf(Gh[32 * rtq + r]);
                    *(bf16x8*)((bf16*)(rec + LA_QD) + ((size_t)task * 64 + lane) * 8) = pack8(ca[t].x * e, ca[t].y * e, ca[t].z * e, ca[t].w * e, cb[t].x * e, cb[t].y * e, cb[t].z * e, cb[t].w * e); }
            } else {
                float* uc = (float*)(rec + LA_UCS) + ((size_t)(sl * 2 + rt2) * 4 * 64 + lane) * 4;
#pragma unroll
                for (int q4 = 0; q4 < 4; ++q4) { f32x4 v;
#pragma unroll
                    for (int e = 0; e < 4; ++e) v[e] = xv[hi][4 * q4 + e] * Dh[32 * rt2 + crow(4 * q4 + e, h)];
                    *(f32x4*)(uc + (size_t)q4 * 256) = v; }
            }
            if (tid == 0) wsf(F, WS_DLS)[seq * 32 + ch] = __expf(G63);
            LDS_SYNC();
            if (wv >= 4) {
#pragma unroll
                for (int t = 0; t < 4; ++t) ke_frag_task(L + LA_KET, 4 * (wv - 4) + t, r, h, lane, (bf16*)(rec + LA_KE)); }
            LDS_SYNC();
        }
    }
}

constexpr int LA_HB = LDSCTL_OFF + 1024;
static_assert(LA_HB + 12 * 1024 <= LDS_BYTES, "hand-over area inside the LDS allocation");
template <bool HAS_W> __device__ __forceinline__ void la_seq_wg(LAS unsigned char* lds0  , const unsigned char* recs, int recsz, int uc_off, const float* dls, float* outp  , int slice, int lane, int wv) {
    constexpr int NFR = HAS_W ? 56 : 40;
    constexpr int SLOT = (NFR + 8) * 1024;
    LAS unsigned char* ring = lds0 + RING_OFF; LAS unsigned char* HB = lds0 + LA_HB + lane * 16;
    const int r = lane & 31, h = lane >> 5;
#define LA_DMA(c_, slot_) do { const unsigned char* rec_ = recs + (size_t)(c_) * recsz + lane * 16; LAS unsigned char* dst_ = ring + (slot_) * SLOT; \
        for (int f_ = wv - 2; f_ < NFR + 8; f_ += 6) { const unsigned char* src_ = (f_ < NFR) ? rec_ + f_ * 1024 : rec_ + uc_off + slice * 8192 + (f_ - NFR) * 1024; \
            __builtin_amdgcn_global_load_lds((const unsigned*)src_, (LAS unsigned*)(dst_ + f_ * 1024), 16, 0, 0); } } while (0)
#define LA_BAR() do { asm volatile("s_waitcnt lgkmcnt(0)" ::: "memory"); __builtin_amdgcn_s_barrier(); asm volatile("" ::: "memory"); } while (0)
#define FRAG(off, idx) (*(const LAS bf16x8*)(B + (off) + (idx) * 1024))
    if (wv >= 2) {
        LA_DMA(0, 0); asm volatile("s_waitcnt vmcnt(0)" ::: "memory");
        LA_BAR();
#pragma unroll 1
        for (int c = 0; c < 32; ++c) { if (c + 1 < 32) LA_DMA(c + 1, (c + 1) & 1); LA_BAR(); LA_BAR(); asm volatile("s_waitcnt vmcnt(0)" ::: "memory"); LA_BAR(); }
    } else if (wv == 0) {
        const float dlv = (lane < 32) ? dls[lane] : 0.f;
        f32x16 S[4];
#pragma unroll
        for (int it = 0; it < 4; ++it)
#pragma unroll
            for (int q = 0; q < 16; ++q) S[it][q] = 0.f;
        LA_BAR();
#pragma unroll 1
        for (int c = 0; c < 32; ++c) {
            const LAS unsigned char* B = ring + (c & 1) * SLOT + lane * 16;
            bf16x8 sb[8];
#pragma unroll
            for (int it = 0; it < 4; ++it) { sb[2 * it] = PACK_STEP(S[it], 0); sb[2 * it + 1] = PACK_STEP(S[it], 1); }
#pragma unroll
            for (int ks = 0; ks < 8; ++ks) *(LAS bf16x8*)(HB + ks * 1024) = sb[ks];
            LA_BAR();
            f32x16 Vn[2];
#pragma unroll
            for (int rt = 0; rt < 2; ++rt)
#pragma unroll
                for (int q4 = 0; q4 < 4; ++q4) { const f32x4 v = *(const LAS f32x4*)(B + NFR * 1024 + (rt * 4 + q4) * 1024); Vn[rt][4 * q4] = v.x; Vn[rt][4 * q4 + 1] = v.y; Vn[rt][4 * q4 + 2] = v.z; Vn[rt][4 * q4 + 3] = v.w; }
            if (HAS_W) {
#pragma unroll
                for (int ks = 0; ks < 8; ++ks) { Vn[0] = MFMA32(FRAG(LA_NW, 0 * 8 + ks), sb[ks], Vn[0]); Vn[1] = MFMA32(FRAG(LA_NW, 1 * 8 + ks), sb[ks], Vn[1]); } }
            bf16x8 vb[4];
#pragma unroll
            for (int rt = 0; rt < 2; ++rt) { vb[2 * rt] = PACK_STEP(Vn[rt], 0); vb[2 * rt + 1] = PACK_STEP(Vn[rt], 1); }
#pragma unroll
            for (int ks = 0; ks < 4; ++ks) *(LAS bf16x8*)(HB + 8192 + ks * 1024) = vb[ks];
            LA_BAR();
            const float dl = __builtin_bit_cast(float, __builtin_amdgcn_readlane(__builtin_bit_cast(int, dlv), c));
#pragma unroll
            for (int it = 0; it < 4; ++it) {
#pragma unroll
                for (int q = 0; q < 16; ++q) S[it][q] *= dl;
#pragma unroll
                for (int ks = 0; ks < 4; ++ks) S[it] = MFMA32(FRAG(LA_KE, it * 4 + ks), vb[ks], S[it]);
            }
            LA_BAR();
        }
    } else {
        LA_BAR();
#pragma unroll 1
        for (int c = 0; c < 32; ++c) {
            const LAS unsigned char* B = ring + (c & 1) * SLOT + lane * 16;
            LA_BAR();
            bf16x8 sb[8];
#pragma unroll
            for (int ks = 0; ks < 8; ++ks) sb[ks] = *(const LAS bf16x8*)(HB + ks * 1024);
            f32x16 O[2];
#pragma unroll
            for (int rt = 0; rt < 2; ++rt)
#pragma unroll
                for (int q = 0; q < 16; ++q) O[rt][q] = 0.f;
#pragma unroll
            for (int ks = 0; ks < 8; ++ks) { O[0] = MFMA32(FRAG(LA_QD, 0 * 8 + ks), sb[ks], O[0]); O[1] = MFMA32(FRAG(LA_QD, 1 * 8 + ks), sb[ks], O[1]); }
            LA_BAR();
            bf16x8 vb[4];
#pragma unroll
            for (int ks = 0; ks < 4; ++ks) vb[ks] = *(const LAS bf16x8*)(HB + 8192 + ks * 1024);
#pragma unroll
            for (int ks = 0; ks < 4; ++ks) { O[0] = MFMA32(FRAG(LA_QK, 0 * 4 + ks), vb[ks], O[0]); O[1] = MFMA32(FRAG(LA_QK, 1 * 4 + ks), vb[ks], O[1]); }
            float* op = outp + (size_t)c * 64 * GW + r;
#pragma unroll
            for (int rt = 0; rt < 2; ++rt)
#pragma unroll
                for (int q = 0; q < 16; ++q) op[(size_t)(32 * rt + crow(q, h)) * GW] = O[rt][q];
            LA_BAR();
        }
    }
#undef FRAG
#undef LA_DMA
#undef LA_BAR
}
__device__ __forceinline__ void la_seq_phase(Frame& F, int l_unused) {
    const int lane = opq(F.lane);
    for (int item = F.vcu; item < 128; item += F.G) {
        if (item < 64) { const int seq = item >> 2, slice = item & 3, b = seq >> 2, hd = seq & 3;
            la_seq_wg<true>(F.lds, F.ws + WS_FG + (size_t)seq * 32 * LA_RECG, LA_RECG, LA_UCG, wsf(F, WS_DLG) + seq * 32, wsf(F, WS_OG) + (size_t)b * SEQ * GW + hd * 128 + slice * 32, slice, lane, F.wave);
        } else { const int j = item - 64, seq = j >> 1, slice = j & 1, b = seq >> 3, hh = seq & 7;
            la_seq_wg<false>(F.lds, F.ws + WS_FS + (size_t)seq * 32 * LA_RECS, LA_RECS, LA_UCS, wsf(F, WS_DLS) + seq * 32, wsf(F, WS_YS) + (size_t)b * SEQ * GW + hh * 64 + slice * 32, slice, lane, F.wave);
        }
    }
}

__device__ __forceinline__ void mixer_post_phase(Frame& F, int l) {
    const int gw = F.vcu * NWAVES + F.wave, NGW = F.G * NWAVES, lane = opq(F.lane), c = lane * 8;
    bf16* MIX = wsb(F, WS_MIX);
    const float* gng = inp(I_GNG) + (size_t)l * 128 + (c & 127); const float* sng = inp(I_SNG) + (size_t)l * GW + c;
    const f32x4 g0 = ld4(gng), g1 = ld4(gng + 4), n0 = ld4(sng), n1 = ld4(sng + 4);
    const float Dk = inp(I_SD)[l * 8 + (c >> 6)];
    for (int m = gw; m < M; m += NGW) {
        {
            const float* og = wsf(F, WS_OG) + (size_t)m * GW + c; const f32x8 zz = ldu8(wsb(F, WS_ZG) + (size_t)m * GW + c);
            const f32x4 o0 = ld4(og), o1 = ld4(og + 4), z0 = zz.lo, z1 = zz.hi;
            float ss = (o0.x * o0.x + o0.y * o0.y) + (o0.z * o0.z + o0.w * o0.w) + (o1.x * o1.x + o1.y * o1.y) + (o1.z * o1.z + o1.w * o1.w);
            ss = row16_sum(ss);
            const float rstd = __builtin_amdgcn_rsqf(ss * (1.0f / 128.0f) + EPS);
            const f32x4 y0 = o0 * rstd * g0 * silu4(z0), y1 = o1 * rstd * g1 * silu4(z1);
            v4u w; w.x = pk2(y0.x, y0.y); w.y = pk2(y0.z, y0.w); w.z = pk2(y1.x, y1.y); w.w = pk2(y1.z, y1.w);
            *(v4u*)(MIX + (size_t)m * DM + 2 * GW + c) = w;
        }
        {
            const float* ys = wsf(F, WS_YS) + (size_t)m * GW + c; const float* xs = wsf(F, WS_XS) + (size_t)m * GW + c; const f32x8 zz = ldu8(wsb(F, WS_ZS) + (size_t)m * GW + c);
            const f32x4 a0 = (ld4(ys) + ld4(xs) * Dk) * silu4(zz.lo), a1 = (ld4(ys + 4) + ld4(xs + 4) * Dk) * silu4(zz.hi);
            float ss = (a0.x * a0.x + a0.y * a0.y) + (a0.z * a0.z + a0.w * a0.w) + (a1.x * a1.x + a1.y * a1.y) + (a1.z * a1.z + a1.w * a1.w);
            ss = row16_sum(ss); ss += shx(ss, 16, lane);
            const float rstd = __builtin_amdgcn_rsqf(ss * (1.0f / 256.0f) + EPS);
            const f32x4 y0 = a0 * rstd * n0, y1 = a1 * rstd * n1;
            v4u w; w.x = pk2(y0.x, y0.y); w.y = pk2(y0.z, y0.w); w.z = pk2(y1.x, y1.y); w.w = pk2(y1.z, y1.w);
            *(v4u*)(MIX + (size_t)m * DM + 3 * GW + c) = w;
        }
    }
}

constexpr int CW_PANEL = 8192;
static_assert((CW_PANEL + DEPTH * 3 * 32 * 64) * 4 <= (int)CTL_ZERO_BYTES && CW_BAR + XCD_BAR_WORDS <= CW_PANEL, "control words inside the memset region");
namespace pg8 {
struct EpiAny {
    static constexpr bool PERM = false, AFTER_DRAIN = false, RT_DRAIN = true;
    void* C; int ldc; int mode; float scale;
    unsigned char* ws; float* out; int lq, prow0;
    int rsrow0;
    __device__ __forceinline__ bool perm() const { return mode != 0; }
    __device__ __forceinline__ bool drain() const { return mode >= 3; }
    __device__ __forceinline__ void operator()(const f32x4 (&acc)[2][2][4][2], const Unit& u, int wr, int wc, int fr, int fq) const {
        if (mode == 3 || mode == 4) return;
        if (rsrow0 < 0) {
            if (mode == 0) { EpiF32 e{(float*)C, ldc}; e(acc, u, wr, wc, fr, fq); }
            else if (mode == 1) { EpiBf16S e{(bf16_t*)C, ldc, scale}; e(acc, u, wr, wc, fr, fq); }
            else { EpiSwiGLU e{(bf16_t*)C, ldc}; e(acc, u, wr, wc, fr, fq); }
            return; }
        const float* rs = (const float*)(ws + WS_RS) + rsrow0 + u.pm * BM + wr * 64 + fr;
        const int row0 = u.pm * BM + wr * 64 + fr;
#pragma unroll
        for (int ai = 0; ai < 2; ++ai)
#pragma unroll
            for (int m = 0; m < 4; ++m) { const float r = rs[ai * HALF + m * 16];
                if (mode == 1) { bf16_t* rowp = (bf16_t*)C + (size_t)(row0 + ai * HALF + m * 16) * ldc + u.pn * BM + wc * 32 + 8 * fq;
#pragma unroll
                    for (int bj = 0; bj < 2; ++bj) { const f32x4 v0 = acc[ai][bj][m][0] * r, v1 = acc[ai][bj][m][1] * r;
                        u32x4 w; w.x = cvt_pk_bf16(v0[0], v0[1]); w.y = cvt_pk_bf16(v0[2], v0[3]); w.z = cvt_pk_bf16(v1[0], v1[1]); w.w = cvt_pk_bf16(v1[2], v1[3]); *(u32x4*)(rowp + bj * HALF) = w; }
                } else { bf16_t* rowp = (bf16_t*)C + (size_t)(row0 + ai * HALF + m * 16) * ldc + u.pn * HALF + wc * 32 + 8 * fq;
                    const f32x4 g0 = acc[ai][0][m][0] * r, g1 = acc[ai][0][m][1] * r, u0 = acc[ai][1][m][0] * r, u1 = acc[ai][1][m][1] * r;
                    u32x4 w; w.x = cvt_pk_bf16(silu_f(g0[0]) * u0[0], silu_f(g0[1]) * u0[1]); w.y = cvt_pk_bf16(silu_f(g0[2]) * u0[2], silu_f(g0[3]) * u0[3]);
                    w.z = cvt_pk_bf16(silu_f(g1[0]) * u1[0], silu_f(g1[1]) * u1[1]); w.w = cvt_pk_bf16(silu_f(g1[2]) * u1[2], silu_f(g1[3]) * u1[3]); *(u32x4*)rowp = w; } }
    }
    __device__ __forceinline__ void fused(f32x4 (&acc)[2][2][4][2], const Unit& u, int wr, int wc, int fr, int fq, PG8_LAS unsigned char* lds, int wid, int lane) const {
        if (mode == 3) fused_softmax(acc, u, wr, wc, fr, fq, lds, wid, lane); else fused_resnorm(acc, u, wr, wc, fr, fq, lds, wid, lane);
    }
    __device__ __forceinline__ void fused_resnorm(f32x4 (&acc)[2][2][4][2], const Unit& u, int wr, int wc, int fr, int fq, PG8_LAS unsigned char* lds, int wid, int lane) const {
        const int D = 2048;
        {   bf16_t* Yw = (bf16_t*)(ws + WS_Y);
            const int row0 = prow0 + u.pm * BM + wr * 64 + fr, col0 = u.pn * BM + wc * 32 + 8 * fq;
#pragma unroll
            for (int ai = 0; ai < 2; ++ai)
#pragma unroll
                for (int m = 0; m < 4; ++m)
#pragma unroll
                    for (int bj = 0; bj < 2; ++bj) { const f32x4 v0 = acc[ai][bj][m][0], v1 = acc[ai][bj][m][1];
                        u32x4 w; w.x = cvt_pk_bf16(v0[0], v0[1]); w.y = cvt_pk_bf16(v0[2], v0[3]); w.z = cvt_pk_bf16(v1[0], v1[1]); w.w = cvt_pk_bf16(v1[2], v1[3]);
                        bf16_t* dst = Yw + (size_t)(row0 + ai * HALF + m * 16) * D + col0 + bj * HALF;
                        asm volatile("global_store_dwordx4 %0, %1, off sc1\n\ts_nop 1" :: "v"(dst), "v"(w) : "memory"); } }
        asm volatile("s_waitcnt vmcnt(0)" ::: "memory");
        __builtin_amdgcn_s_barrier(); asm volatile("" ::: "memory");
        const int l = lq / 3, rn = lq % 3;
        unsigned* pc = (unsigned*)(ws + WS_CTL) + CW_PANEL + (lq * 32 + (prow0 >> 8) + u.pm) * 64;
        const float* gpost = inp(I_NORMG) + (size_t)(l * N_NORMS + (rn == 0 ? MIX_POST : rn == 1 ? XA_POST : FFN_POST)) * D;
        const bool first = (lq == 0), last = (lq == 3 * DEPTH - 1);
        const float* xin32 = inp(I_X); bf16_t* xb = (bf16_t*)(ws + WS_XN); float* rsb = (float*)(ws + WS_RS);
        if (wid == 0) {
            if (lane == 0) __hip_atomic_fetch_add(pc, 1u, __ATOMIC_RELAXED, __HIP_MEMORY_SCOPE_AGENT);
            unsigned spins = 0;
            while ((unsigned)__builtin_amdgcn_readfirstlane(__hip_atomic_load(pc, __ATOMIC_RELAXED, __HIP_MEMORY_SCOPE_AGENT)) < 8u) { __builtin_amdgcn_s_sleep(2); if (++spins > (1u << 22)) break; }
            __builtin_amdgcn_fence(__ATOMIC_ACQUIRE, "agent");
            asm volatile("s_waitcnt vmcnt(0)" ::: "memory");
        }
        __builtin_amdgcn_s_barrier(); asm volatile("" ::: "memory");
        const bf16_t* Y = (const bf16_t*)(ws + WS_Y);
#define BFLO(wd) __builtin_bit_cast(float, (wd) << 16)
#define BFHI(wd) __builtin_bit_cast(float, (wd) & 0xffff0000u)
#pragma unroll 1
        for (int i = 0; i < 4; ++i) {
            const size_t mrow = (size_t)prow0 + u.pm * BM + u.pn * 32 + wid * 4 + i;
            f32x4 x[8]; u32x4 yw[4];
            { const u32x4* yr = (const u32x4*)(Y + mrow * D) + lane;
#pragma unroll
              for (int j = 0; j < 4; ++j) yw[j] = yr[64 * j];
              if (first) { const f32x4* xr = (const f32x4*)(xin32 + mrow * D) + 2 * lane;
#pragma unroll
                  for (int j = 0; j < 4; ++j) { x[2 * j] = xr[128 * j]; x[2 * j + 1] = xr[128 * j + 1]; }
              } else { const u32x4* xr = (const u32x4*)(xb + mrow * D) + lane;
#pragma unroll
                  for (int j = 0; j < 4; ++j) { const u32x4 w = xr[64 * j]; x[2 * j] = (f32x4){BFLO(w.x), BFHI(w.x), BFLO(w.y), BFHI(w.y)}; x[2 * j + 1] = (f32x4){BFLO(w.z), BFHI(w.z), BFLO(w.w), BFHI(w.w)}; } } }
            float s = 0.f;
#pragma unroll
            for (int j = 0; j < 4; ++j) { const u32x4 w = yw[j]; const float a0 = BFLO(w.x), a1 = BFHI(w.x), a2 = BFLO(w.y), a3 = BFHI(w.y), a4 = BFLO(w.z), a5 = BFHI(w.z), a6 = BFLO(w.w), a7 = BFHI(w.w);
                s += ((a0 * a0 + a1 * a1) + (a2 * a2 + a3 * a3)) + ((a4 * a4 + a5 * a5) + (a6 * a6 + a7 * a7)); }
            s = wave_sum(s);
            const float rstd = __builtin_amdgcn_rsqf(s * (1.0f / 2048.0f) + 1e-6f);
            float s2 = 0.f;
#pragma unroll
            for (int j = 0; j < 4; ++j) { const u32x4 w = yw[j];
                const f32x4 y0 = (f32x4){BFLO(w.x), BFHI(w.x), BFLO(w.y), BFHI(w.y)}, y1 = (f32x4){BFLO(w.z), BFHI(w.z), BFLO(w.w), BFHI(w.w)};
                const f32x4 g0 = ((const f32x4*)gpost)[2 * lane + 128 * j], g1 = ((const f32x4*)gpost)[2 * lane + 128 * j + 1];
                const f32x4 v0 = x[2 * j] + y0 * rstd * g0, v1 = x[2 * j + 1] + y1 * rstd * g1; x[2 * j] = v0; x[2 * j + 1] = v1;
                s2 += ((v0[0] * v0[0] + v0[1] * v0[1]) + (v0[2] * v0[2] + v0[3] * v0[3])) + ((v1[0] * v1[0] + v1[1] * v1[1]) + (v1[2] * v1[2] + v1[3] * v1[3])); }
            if (last) { f32x4* xo = (f32x4*)(out + mrow * D) + 2 * lane;
#pragma unroll
                for (int j = 0; j < 4; ++j) { xo[128 * j] = x[2 * j]; xo[128 * j + 1] = x[2 * j + 1]; }
            } else {
                s2 = wave_sum(s2);
                if (lane == 0) rsb[mrow] = __builtin_amdgcn_rsqf(s2 * (1.0f / 2048.0f) + 1e-6f);
                u32x4* o8 = (u32x4*)(xb + mrow * D) + lane;
#pragma unroll
                for (int j = 0; j < 4; ++j) { const f32x4 a = x[2 * j], b = x[2 * j + 1];
                    u32x4 w; w.x = cvt_pk_bf16(a[0], a[1]); w.y = cvt_pk_bf16(a[2], a[3]); w.z = cvt_pk_bf16(b[0], b[1]); w.w = cvt_pk_bf16(b[2], b[3]); o8[64 * j] = w; }
            }
        }
#undef BFLO
#undef BFHI
    }
    __device__ __forceinline__ void fused_softmax(f32x4 (&acc)[2][2][4][2], const Unit& u, int wr, int wc, int fr, int fq, PG8_LAS unsigned char* lds, int wid, int lane) const {
        { const float* rs = (const float*)(ws + WS_RS) + rsrow0 + u.pm * BM + wr * 64 + fr;
#pragma unroll
          for (int ai = 0; ai < 2; ++ai)
#pragma unroll
            for (int m = 0; m < 4; ++m) { const float r = rs[ai * HALF + m * 16];
#pragma unroll
                for (int bj = 0; bj < 2; ++bj)
#pragma unroll
                    for (int n = 0; n < 2; ++n) acc[ai][bj][m][n] = acc[ai][bj][m][n] * r; } }
        PG8_LAS float* Pm = (PG8_LAS float*)lds;
        PG8_LAS float* Ps = (PG8_LAS float*)(lds + 4096);
#pragma unroll
        for (int ai = 0; ai < 2; ++ai)
#pragma unroll
            for (int m = 0; m < 4; ++m) { float mx = -3.0e38f;
#pragma unroll
                for (int bj = 0; bj < 2; ++bj)
#pragma unroll
                    for (int n = 0; n < 2; ++n) { const f32x4 x = acc[ai][bj][m][n]; mx = fmaxf(mx, fmaxf(fmaxf(x[0], x[1]), fmaxf(x[2], x[3]))); }
                mx = fmaxf(mx, shx(mx, 16, lane)); mx = fmaxf(mx, shx(mx, 32, lane));
                if (fq == 0) Pm[(ai * HALF + wr * 64 + m * 16 + fr) * 4 + wc] = mx; }
        asm volatile("s_waitcnt lgkmcnt(0)" ::: "memory"); __builtin_amdgcn_s_barrier(); asm volatile("" ::: "memory");
#pragma unroll
        for (int ai = 0; ai < 2; ++ai)
#pragma unroll
            for (int m = 0; m < 4; ++m) { const int row = ai * HALF + wr * 64 + m * 16 + fr; const f32x4 pm = *(const PG8_LAS f32x4*)(Pm + row * 4);
                const float mx = fmaxf(fmaxf(pm[0], pm[1]), fmaxf(pm[2], pm[3])); float sm = 0.f;
#pragma unroll
                for (int bj = 0; bj < 2; ++bj)
#pragma unroll
                    for (int n = 0; n < 2; ++n) { f32x4 x = acc[ai][bj][m][n]; x[0] = __expf(x[0] - mx); x[1] = __expf(x[1] - mx); x[2] = __expf(x[2] - mx); x[3] = __expf(x[3] - mx);
                        acc[ai][bj][m][n] = x; sm += (x[0] + x[1]) + (x[2] + x[3]); }
                sm += shx(sm, 16, lane); sm += shx(sm, 32, lane);
                if (fq == 0) Ps[row * 4 + wc] = sm; }
        asm volatile("s_waitcnt lgkmcnt(0)" ::: "memory"); __builtin_amdgcn_s_barrier(); asm volatile("" ::: "memory");
        const int row0 = u.pm * BM + wr * 64 + fr, col0 = u.pn * BM + wc * 32 + 8 * fq;
#pragma unroll
        for (int ai = 0; ai < 2; ++ai)
#pragma unroll
            for (int m = 0; m < 4; ++m) { const int row = ai * HALF + wr * 64 + m * 16 + fr; const f32x4 ps = *(const PG8_LAS f32x4*)(Ps + row * 4);
                const float inv = __builtin_amdgcn_rcpf((ps[0] + ps[1]) + (ps[2] + ps[3]));
                bf16_t* rowp = (bf16_t*)C + (size_t)(row0 + ai * HALF + m * 16) * ldc + col0;
#pragma unroll
                for (int bj = 0; bj < 2; ++bj) { const f32x4 v0 = acc[ai][bj][m][0] * inv, v1 = acc[ai][bj][m][1] * inv;
                    u32x4 w; w.x = cvt_pk_bf16(v0[0], v0[1]); w.y = cvt_pk_bf16(v0[2], v0[3]); w.z = cvt_pk_bf16(v1[0], v1[1]); w.w = cvt_pk_bf16(v1[2], v1[3]);
                    *(u32x4*)(rowp + bj * HALF) = w; } }
    }
};
}

#ifndef SKIPM
#define SKIPM 0
#endif
#ifndef REPM
#define REPM 0
#endif
#ifndef GEMM_SP2
#define GEMM_SP2 true
#endif
#ifndef GEMM_ALIGN
#define GEMM_ALIGN true
#endif
#ifndef PROBE_PH
#define PROBE_PH -1
#endif
constexpr int PH_PER_LAYER = 10, PH0 = 2, N_PHASES = PH0 + DEPTH * PH_PER_LAYER;
struct Args { const float* in[N_IN]; float* out; unsigned char* ws; int ph_lo, ph_hi; };
static_assert(sizeof(Args) == (N_IN + 2) * 8 + 8, "Args has no padding");
struct GemmDesc { const bf16* A; const bf16* Bt; void* C; int M, N, K, lda, ldb, ldc, mode, corder, rn, prow0, rsrow0; float scale; };
constexpr int NOUNIT = 1 << 24;
__device__ __forceinline__ int gemm_nsub(int ph, int k, int l) { return ph == 0 ? 0 : ph == 1 ? 1 : (k == 1 || k == 2 || k == 4) ? 0 : k == 3 ? 32 : (k == 6 || k == 7) ? BATCH : (k == 8 && l == 0) ? 2 : 1; }
__device__ __forceinline__ int pmod(int x, int m) { const int r = x % m; return r < 0 ? r + m : r; }
__device__ __forceinline__ void kv_desc(const Frame& F, int l, int v0, GemmDesc& d) {
    d.A = wsb(F, WS_MEMN) + (size_t)l * MROWS * DM; d.Bt = (const bf16*)(F.ws + WS_W + (size_t)l * W_LAYER + WO_WKV); d.C = wsb(F, WS_KV) + (size_t)l * MROWS * 2 * DM;
    d.M = MROWS; d.N = 2 * DM; d.K = DM; d.lda = DM; d.ldb = DM; d.ldc = 2 * DM; d.mode = 1; d.corder = (F.vcu >= v0 && F.vcu < v0 + 64) ? F.vcu - v0 : NOUNIT;
}
__device__ __forceinline__ void gemm_desc(const Frame& F, int ph, int sub, GemmDesc& d) {
    const int bx = (int)blockIdx.x;
    d.scale = 1.0f; d.corder = bx; d.rn = -1; d.prow0 = 0; d.rsrow0 = -1;
    if (ph == 1) { kv_desc(F, 0, 0, d); return; }
    const int l = (ph - PH0) / PH_PER_LAYER, k = (ph - PH0) % PH_PER_LAYER;
    if (k == 3) {
        const int which = sub & 1, h = (sub >> 1) & 3, b = (sub >> 3) & 3;
        const unsigned char* wl = F.ws + WS_W + (size_t)l * W_LAYER;
        const bf16* kv = wsb(F, WS_KV) + (size_t)l * MROWS * 2 * DM + (size_t)(b * MEML) * 2 * DM + h * XHD;
        const int nb = 128;
        d.K = XHD; d.mode = 1; d.corder = (F.vcu >= 128 && F.vcu < 128 + nb) ? pmod(F.vcu - 128 - 8 * sub, nb) : NOUNIT;
        if (which == 0) {
            d.A = kv; d.lda = 2 * DM; d.Bt = (const bf16*)(wl + WO_WQ) + h * XHD; d.ldb = DM; d.M = MEML; d.N = DM;
            d.C = wsb(F, WS_AT) + ((size_t)(l * BATCH + b) * 1024 + h * MEML) * DM; d.ldc = DM; d.scale = 0.044194173824159216f;
        } else {
            d.A = (const bf16*)(wl + WO_WO) + h * XHD; d.lda = DM; d.Bt = kv + DM; d.ldb = 2 * DM; d.M = DM; d.N = MEML;
            d.C = wsb(F, WS_VWT) + (size_t)(l * BATCH + b) * DM * 1024 + h * MEML; d.ldc = 1024;
        }
        return;
    }
    const unsigned char* wl = F.ws + WS_W + (size_t)l * W_LAYER;
    d.M = M; d.K = DM; d.N = DM; d.lda = DM; d.ldb = DM; d.ldc = DM; d.mode = 1; d.A = wsb(F, WS_XN); d.C = wsb(F, WS_Y);
    if (k == 0) { d.Bt = (const bf16*)(wl + WO_WIN); d.N = IN_PAD; d.C = wsb(F, WS_U); d.ldc = IN_PAD; d.mode = 1; d.rsrow0 = 0; }
    else if (k == 5) { d.A = wsb(F, WS_MIX); d.Bt = (const bf16*)(wl + WO_WOUT); d.mode = 4; d.rn = 0; }
    else if (k == 6) {
        const int b = sub; d.A = wsb(F, WS_XN) + (size_t)b * SEQ * DM; d.Bt = wsb(F, WS_AT) + (size_t)(l * BATCH + b) * 1024 * DM; d.M = SEQ; d.N = 1024;
        d.C = wsb(F, WS_P) + (size_t)b * SEQ * 1024; d.ldc = 1024; d.mode = 3; d.rsrow0 = b * SEQ; d.corder = (bx + F.G - 32 * sub) % F.G; }
    else if (k == 7) {
        const int b = sub; d.A = wsb(F, WS_P) + (size_t)b * SEQ * 1024; d.lda = 1024; d.Bt = wsb(F, WS_VWT) + (size_t)(l * BATCH + b) * DM * 1024; d.ldb = 1024; d.M = SEQ; d.K = 1024;
        d.mode = 4; d.rn = 1; d.prow0 = b * SEQ; d.corder = (bx + F.G - 64 * sub) % F.G; }
    else if (k == 8) { if (sub == 1) { kv_desc(F, 1, 0, d); d.corder = (bx >= 128 && bx < 192) ? bx - 128 : NOUNIT; return; }
        d.Bt = (const bf16*)(wl + WO_WGU); d.N = 2 * DFF; d.mode = 2; d.C = wsb(F, WS_HID); d.ldc = DFF; d.rsrow0 = 0; }
    else { d.A = wsb(F, WS_HID); d.Bt = (const bf16*)(wl + WO_WD); d.K = DFF; d.lda = DFF; d.ldb = DFF; d.mode = 4; d.rn = 2; }
}

__global__ void __launch_bounds__(NWAVES * 64, 2) fwd_kernel(Args args) {
    extern __shared__ __attribute__((aligned(16))) unsigned char lds[];
    Frame F;
    F.lds = (LAS unsigned char*)lds;
    F.MISC = (volatile LAS unsigned*)(F.lds + MISC_OFF);
    F.tid = threadIdx.x; F.lane = F.tid & 63; F.wave = __builtin_amdgcn_readfirstlane(F.tid >> 6);
    F.G = gridDim.x; { const int bx = blockIdx.x; F.vcu = (F.G % 8 == 0) ? (bx % 8) * (F.G / 8) + bx / 8 : bx; }
    F.ws = args.ws; F.out = args.out; F.ctl = (unsigned*)(args.ws + WS_CTL);
    for (int u = F.tid; u < (LDS_BYTES - LDSCTL_OFF) / 4; u += NWAVES * 64) ((LAS unsigned*)(F.lds + LDSCTL_OFF))[u] = 0u;
    __syncthreads();
    const int lo = args.ph_lo, hi = args.ph_hi;
    if (hi - lo > 1) (void)xcd_barrier_post(F.ctl + CW_BAR, F.MISC + 8);
#define GRID_BARRIER() do { XcdBarrier b_; b_.bar = F.ctl + CW_BAR; b_.x = xb_xcc_id(); b_.st = F.MISC + 8; xcd_barrier(b_); } while (0)
    LAS unsigned char* ring = F.lds + RING_OFF;
#if PROBE_PH >= 0
    unsigned long long t_start = __builtin_amdgcn_s_memrealtime(), t_probe = 0;
#endif
#pragma unroll 1
    for (int ph = lo; ph < hi; ++ph) {
        const int l = ph >= PH0 ? (ph - PH0) / PH_PER_LAYER : 0, k = ph >= PH0 ? (ph - PH0) % PH_PER_LAYER : -1;
        const int kbit = (ph < PH0) ? ph : (k + PH0);
        const int reps = 1 + ((REPM >> kbit) & 1);
#pragma unroll 1
        for (int rep = 0; rep < reps; ++rep) {
        if (ph < PH0) p0_prologue(F, ph);
        else if (k == 1) mixer_prep_phase(F, l);
        else if (k == 2) la_prep_phase(F, l);
        else if (k == 3) la_seq_phase(F, l);
        else if (k == 4) mixer_post_phase(F, l);
        const int nsub = gemm_nsub(ph, k, l);
#pragma unroll 1
        for (int sub = 0; sub < nsub; ++sub) {
            GemmDesc d; gemm_desc(F, ph, sub, d);
            pg8::Gemm g{d.A, d.Bt, d.M, d.N, d.K, d.lda, d.ldb}; pg8::StaticOrder S; S.init(d.M, d.N, F.G, d.corder);
            pg8::EpiAny E{d.C, d.ldc, d.mode, d.scale, F.ws, F.out, l * 3 + d.rn, d.prow0, d.rsrow0};
            pg8::gemm_phase<pg8::EpiAny, pg8::StaticOrder, GEMM_ALIGN, GEMM_SP2>(ring, g, S, E);
        }
        if (REPM >> 20) { if (rep + 1 < reps) __syncthreads(); }
        }
        if ((REPM >> 21) & 1) GRID_BARRIER();
        if (ph + 1 < hi) GRID_BARRIER();
#if PROBE_PH >= 0
        if (ph == PROBE_PH) t_probe = __builtin_amdgcn_s_memrealtime();
#endif
    }
#if PROBE_PH >= 0
    if (blockIdx.x == 0) {
        const unsigned long long t_end = __builtin_amdgcn_s_memrealtime();
        while (__builtin_amdgcn_s_memrealtime() - t_end < t_probe - t_start) __builtin_amdgcn_s_sleep(8);
    }
#endif
}

#ifndef MK_SINGLE
#define MK_SINGLE 0
#endif
extern "C" void kernel_launch(void* const* d_in, const int* in_sizes, int n_in, void* d_out, int out_size, void* d_ws, size_t ws_size, hipStream_t stream) {
    static int grid = 0;
    if (grid == 0) {
        if (n_in != N_IN || in_sizes[0] != M * DM || out_size != M * DM || ws_size < WS_END) { fprintf(stderr, "kernel_launch: unexpected problem (n_in %d, in0 %d, out %d, ws %zu < %zu)\n", n_in, n_in > 0 ? in_sizes[0] : -1, out_size, ws_size, (size_t)WS_END); grid = -1; return; }
        int dev = 0, cus = 0, per_cu = 0;
        if (hipGetDevice(&dev) != hipSuccess || hipDeviceGetAttribute(&cus, hipDeviceAttributeMultiprocessorCount, dev) != hipSuccess) { grid = -1; return; }
        if (hipFuncSetAttribute((const void*)fwd_kernel, hipFuncAttributeMaxDynamicSharedMemorySize, LDS_BYTES) != hipSuccess) { fprintf(stderr, "kernel_launch: hipFuncSetAttribute failed\n"); grid = -1; return; }
        if (hipOccupancyMaxActiveBlocksPerMultiprocessor(&per_cu, (const void*)fwd_kernel, NWAVES * 64, LDS_BYTES) != hipSuccess || per_cu < 1) { fprintf(stderr, "kernel_launch: occupancy query says %d blocks per CU\n", per_cu); per_cu = 1; }
        (void)hipGetLastError();
        grid = cus * (per_cu < 1 ? 1 : 1);
        if (grid != 256) fprintf(stderr, "kernel_launch: note: grid %d (expected 256)\n", grid);
    }
    if (grid < 0) return;
    if (hipMemsetAsync((char*)d_ws + WS_CTL, 0, CTL_ZERO_BYTES, stream) != hipSuccess) { fprintf(stderr, "kernel_launch: memset failed\n"); return; }
    Args a{};
    for (int i = 0; i < N_IN; ++i) a.in[i] = (const float*)d_in[i];
    a.out = (float*)d_out; a.ws = (unsigned char*)d_ws;
#if MK_SINGLE
    a.ph_lo = 0; a.ph_hi = N_PHASES;
    void* kargs[] = {&a};
    hipError_t e = hipLaunchCooperativeKernel((const void*)fwd_kernel, dim3(grid), dim3(NWAVES * 64), kargs, LDS_BYTES, stream);
    if (e != hipSuccess) fprintf(stderr, "kernel_launch: cooperative launch failed: %s (grid %d)\n", hipGetErrorString(e), grid);
#else
    for (int p = 0; p < N_PHASES; ++p) { a.ph_lo = p; a.ph_hi = p + 1;
        hipLaunchKernelGGL(fwd_kernel, dim3(grid), dim3(NWAVES * 64), LDS_BYTES, stream, a);
        const hipError_t le = hipPeekAtLastError(); if (le != hipSuccess) { fprintf(stderr, "kernel_launch: launch %d failed: %s\n", p, hipGetErrorName(le)); break; } }
#endif
}
```

```cpp
#include <hip/hip_runtime.h>
#include <cstdio>
#include <cstdint>
#define MK_SINGLE 1
namespace pg8 {
#define PG8_LAS __attribute__((address_space(3)))
typedef unsigned short bf16_t;
typedef short bf16x8 __attribute__((ext_vector_type(8)));
typedef float f32x4 __attribute__((ext_vector_type(4)));
typedef unsigned u32x4 __attribute__((ext_vector_type(4)));
constexpr int BM = 256, BK = 64, HALF = 128, HTB = HALF * BK * 2  , STAGE_BYTES = 8 * HTB, NXCD = 8, WGM = 8;

__host__ __device__ __forceinline__ int lds_byte(int r, int c) { const int st = (r >> 4) * 2 + (c >> 5), rr = r & 15, cc = c & 31, ob = rr * 64 + cc * 2; return st * 1024 + (ob ^ (((ob >> 9) & 1) << 5)); }
__host__ __device__ __forceinline__ void stage_rc(int b, int& R, int& C) { const int st = b / 1024, sb = b % 1024, swz = sb ^ (((sb >> 9) & 1) << 5); R = (st >> 1) * 16 + swz / 64; C = (st & 1) * 32 + (swz % 64) / 2; }
__host__ __device__ __forceinline__ int perm32(int rho) { const int n = rho >> 4, i = rho & 15; return 8 * (i >> 2) + 4 * n + (i & 3); }

struct Unit { int pm, pn, hm; };
struct Gemm { const bf16_t* A; const bf16_t* Bt; int M, N, K, lda, ldb; };

struct StaticOrder {
    int nM, nN, nwg, G, c;
    int lim, hbase;
    __host__ __device__ void init(int M, int N, int G_, int c_) { nM = M / BM; nN = N / BM; nwg = nM * nN; G = G_; c = c_; lim = nwg; hbase = -1; }
    __host__ __device__ bool next(int i, Unit& u) const {
        long L = (long)i * G + c; u.hm = 0;
        if (hbase >= 0) { if (L >= 2 * (long)(nwg - hbase)) return false; u.hm = (int)(L & 1); L = hbase + (L >> 1); }
        else if (L >= lim) return false;
        int wgid = (int)L; { const int q = nwg / NXCD, r = nwg % NXCD, xcd = wgid % NXCD, off = wgid / NXCD; wgid = (xcd < r ? xcd * (q + 1) : r * (q + 1) + (xcd - r) * q) + off; }
        const int nig = WGM * nN, gid = wgid / nig, fm = gid * WGM, gsz = (nM - fm) < WGM ? (nM - fm) : WGM;
        u.pm = fm + ((wgid % nig) % gsz); u.pn = (wgid % nig) / gsz; return true;
    }
    __device__ __forceinline__ void a_ready(const Unit&) const {}
    __device__ __forceinline__ void done(const Unit&) const {}
};

__device__ __forceinline__ unsigned cvt_pk_bf16(float lo, float hi) { unsigned r; asm volatile("v_cvt_pk_bf16_f32 %0, %1, %2" : "=v"(r) : "v"(lo), "v"(hi)); return r; }
struct EpiF32 {
    static constexpr bool PERM = false, AFTER_DRAIN = false;
    float* C; int ldc;
    __device__ __forceinline__ void operator()(const f32x4 (&acc)[2][2][4][2], const Unit& u, int wr, int wc, int fr, int fq) const {
        const int row0 = u.pm * BM + wr * 64 + fr, col0 = u.pn * BM + wc * 32 + 4 * fq;
#pragma unroll
        for (int ai = 0; ai < 2; ++ai)
#pragma unroll
            for (int m = 0; m < 4; ++m) { float* rowp = C + (size_t)(row0 + ai * HALF + m * 16) * ldc + col0;
#pragma unroll
                for (int bj = 0; bj < 2; ++bj)
#pragma unroll
                    for (int n = 0; n < 2; ++n) *(f32x4*)(rowp + bj * HALF + n * 16) = acc[ai][bj][m][n]; }
    }
};
struct EpiBf16S {
    static constexpr bool PERM = true, AFTER_DRAIN = false;
    bf16_t* O; int ldc; float scale;
    __device__ __forceinline__ void operator()(const f32x4 (&acc)[2][2][4][2], const Unit& u, int wr, int wc, int fr, int fq) const {
        const int row0 = u.pm * BM + wr * 64 + fr, col0 = u.pn * BM + wc * 32 + 8 * fq; const float sc = scale;
#pragma unroll
        for (int ai = 0; ai < 2; ++ai)
#pragma unroll
            for (int m = 0; m < 4; ++m) { bf16_t* rowp = O + (size_t)(row0 + ai * HALF + m * 16) * ldc + col0;
#pragma unroll
                for (int bj = 0; bj < 2; ++bj) { const f32x4 v0 = acc[ai][bj][m][0] * sc, v1 = acc[ai][bj][m][1] * sc;
                    u32x4 w; w.x = cvt_pk_bf16(v0[0], v0[1]); w.y = cvt_pk_bf16(v0[2], v0[3]); w.z = cvt_pk_bf16(v1[0], v1[1]); w.w = cvt_pk_bf16(v1[2], v1[3]);
                    *(u32x4*)(rowp + bj * HALF) = w; } }
    }
};
__device__ __forceinline__ float silu_f(float v) { return v * __builtin_amdgcn_rcpf(1.0f + __expf(-v)); }
struct EpiSwiGLU {
    static constexpr bool PERM = true, AFTER_DRAIN = false;
    bf16_t* O; int ldc;
    __device__ __forceinline__ void operator()(const f32x4 (&acc)[2][2][4][2], const Unit& u, int wr, int wc, int fr, int fq) const {
        const int row0 = u.pm * BM + wr * 64 + fr, col0 = u.pn * HALF + wc * 32 + 8 * fq;
#pragma unroll
        for (int ai = 0; ai < 2; ++ai)
#pragma unroll
            for (int m = 0; m < 4; ++m) { bf16_t* rowp = O + (size_t)(row0 + ai * HALF + m * 16) * ldc + col0;
                const f32x4 g0 = acc[ai][0][m][0], g1 = acc[ai][0][m][1], u0 = acc[ai][1][m][0], u1 = acc[ai][1][m][1];
                u32x4 w; w.x = cvt_pk_bf16(silu_f(g0[0]) * u0[0], silu_f(g0[1]) * u0[1]); w.y = cvt_pk_bf16(silu_f(g0[2]) * u0[2], silu_f(g0[3]) * u0[3]);
                w.z = cvt_pk_bf16(silu_f(g1[0]) * u1[0], silu_f(g1[1]) * u1[1]); w.w = cvt_pk_bf16(silu_f(g1[2]) * u1[2], silu_f(g1[3]) * u1[3]);
                *(u32x4*)rowp = w; }
    }
};
template <class Epi, class Sched, bool ALIGN_EPI = false, bool SP2 = false, bool HM = false>
__device__ __forceinline__ void gemm_phase(PG8_LAS unsigned char* lds, const Gemm g, const Sched& S, const Epi& E) {
    int tid_ = threadIdx.x; asm volatile("" : "+v"(tid_));
    const int tid = tid_, wid = __builtin_amdgcn_readfirstlane(tid >> 6), lane = tid & 63, wr = wid >> 2, wc = wid & 3, fr = lane & 15, fq = lane >> 4;
    static_assert(!HM || SP2, "half-M units: SP2 loop only");
    const int K = g.K, nt = K / BK;
    unsigned voffA[2], voffB[2];
#pragma unroll
    for (int i = 0; i < 2; ++i) { int R, C; stage_rc(tid * 16 + i * 8192, R, C); const int Rb = E.perm() ? ((R & ~31) + perm32(R & 31)) : R;
        voffA[i] = (unsigned)(R * g.lda + C) * 2u; voffB[i] = (unsigned)(Rb * g.ldb + C) * 2u; }
    const size_t kstep = (size_t)(BK * 2);
    const size_t hstepA = (size_t)HALF * g.lda * 2, hstepB = (size_t)HALF * g.ldb * 2;
    const size_t tstepA = 2 * hstepA, tstepB = 2 * hstepB;
    const unsigned ldsw = (unsigned)wid * 1024u;
    const int aoff = lds_byte(wr * 64 + fr, fq * 8), boff = lds_byte(wc * 32 + fr, fq * 8);
#define PG8_SA(b, h) (((b) * 2 + (h)) * HTB)
#define PG8_SB(b, h) ((4 + (b) * 2 + (h)) * HTB)
#define PG8_STAGE(bufoff, gbase, voff) do { _Pragma("unroll") for (int _i = 0; _i < 2; ++_i) \
        __builtin_amdgcn_global_load_lds((const unsigned*)((const char*)(gbase) + (voff)[_i]), (PG8_LAS unsigned*)(lds + (bufoff) + ldsw + _i * 8192), 16, 0, 0); } while (0)
#define PG8_LDA(dst, b, h) do { _Pragma("unroll") for (int m = 0; m < 4; ++m) _Pragma("unroll") for (int k = 0; k < 2; ++k) dst[m][k] = *(const PG8_LAS bf16x8*)(lds + PG8_SA(b, h) + aoff + m * 2048 + k * 1024); } while (0)
#define PG8_LDB(dst, b, h) do { _Pragma("unroll") for (int n = 0; n < 2; ++n) _Pragma("unroll") for (int k = 0; k < 2; ++k) dst[n][k] = *(const PG8_LAS bf16x8*)(lds + PG8_SB(b, h) + boff + n * 2048 + k * 1024); } while (0)
#define PG8_MMA(ai, bj, At, Bt) do { __builtin_amdgcn_s_setprio(1); _Pragma("unroll") for (int m = 0; m < 4; ++m) _Pragma("unroll") for (int n = 0; n < 2; ++n) _Pragma("unroll") for (int k = 0; k < 2; ++k) \
        acc[ai][bj][m][n] = __builtin_amdgcn_mfma_f32_16x16x32_bf16(Bt[n][k], At[m][k], acc[ai][bj][m][n], 0, 0, 0); __builtin_amdgcn_s_setprio(0); } while (0)
#define PG8_WAIT_V(n) asm volatile("s_waitcnt vmcnt(" #n ")" ::: "memory")
#define PG8_WAIT_L(n) asm volatile("s_waitcnt lgkmcnt(" #n ")" ::: "memory")
#define PG8_BAR __builtin_amdgcn_s_barrier()
#define PG8_SCHED __builtin_amdgcn_sched_barrier(0)
    Unit cur, nxt; int ui = 0;
    if (!S.next(0, cur)) return;
    f32x4 acc[2][2][4][2];
#pragma unroll
    for (int a = 0; a < 2; ++a)
#pragma unroll
        for (int b = 0; b < 2; ++b)
#pragma unroll
            for (int m = 0; m < 4; ++m)
#pragma unroll
                for (int n = 0; n < 2; ++n) acc[a][b][m][n] = (f32x4){0.f, 0.f, 0.f, 0.f};
    bf16x8 At[4][2], B0[2][2], B1[2][2];
#pragma unroll
    for (int m = 0; m < 4; ++m)
#pragma unroll
        for (int k = 0; k < 2; ++k) asm volatile("" : "=v"(At[m][k]));
#pragma unroll
    for (int n = 0; n < 2; ++n)
#pragma unroll
        for (int k = 0; k < 2; ++k) { asm volatile("" : "=v"(B0[n][k])); asm volatile("" : "=v"(B1[n][k])); }
    const char* cA = (const char*)g.A + (size_t)cur.pm * tstepA + (HM ? (size_t)cur.hm * hstepA : 0); const char* cB = (const char*)g.Bt + (size_t)cur.pn * tstepB;
    S.a_ready(cur);
    if constexpr (SP2) {
        PG8_STAGE(PG8_SB(0, 0), cB, voffB); PG8_STAGE(PG8_SB(0, 1), cB + hstepB, voffB); PG8_STAGE(PG8_SA(0, 0), cA, voffA); if constexpr (!HM) PG8_STAGE(PG8_SA(0, 1), cA + hstepA, voffA);
        if (wr == 1) PG8_BAR;
        if constexpr (HM) PG8_WAIT_V(0); else PG8_WAIT_V(2);
        PG8_BAR;
        PG8_STAGE(PG8_SB(1, 0), cB + kstep, voffB); PG8_STAGE(PG8_SA(1, 0), cA + kstep, voffA); PG8_STAGE(PG8_SB(1, 1), cB + hstepB + kstep, voffB);
        PG8_WAIT_V(6); PG8_BAR;
    } else {
        PG8_STAGE(PG8_SB(0, 0), cB, voffB); PG8_STAGE(PG8_SA(0, 0), cA, voffA); PG8_STAGE(PG8_SB(0, 1), cB + hstepB, voffB); PG8_STAGE(PG8_SA(0, 1), cA + hstepA, voffA);
        if (wr == 1) PG8_BAR;
        PG8_WAIT_V(4); PG8_BAR;
        PG8_STAGE(PG8_SB(1, 0), cB + kstep, voffB); PG8_STAGE(PG8_SA(1, 0), cA + kstep, voffA); PG8_STAGE(PG8_SB(1, 1), cB + hstepB + kstep, voffB);
        PG8_WAIT_V(6); PG8_BAR;
    }
    for (;;) {
        const bool has_next = S.next(ui + 1, nxt);
        const char* nA = has_next ? (const char*)g.A + (size_t)nxt.pm * tstepA + (HM ? (size_t)nxt.hm * hstepA : 0) : cA; const char* nB = has_next ? (const char*)g.Bt + (size_t)nxt.pn * tstepB : cB;
        for (int t = 0; t < nt; t += 2) {
            const bool last = (t == nt - 2);
            const char* a1 = cA + (size_t)(t + 1) * kstep;
            const char* a2 = last ? nA : cA + (size_t)(t + 2) * kstep; const char* b2 = last ? nB : cB + (size_t)(t + 2) * kstep;
            const char* a3 = a2 + kstep; const char* b3 = b2 + kstep;
            if (last && has_next) S.a_ready(nxt);
            if constexpr (SP2) {
            PG8_LDB(B0, 0, 0); PG8_LDB(B1, 0, 1); PG8_SCHED; PG8_LDA(At, 0, 0); if constexpr (!HM) PG8_STAGE(PG8_SA(1, 1), a1 + hstepA, voffA);
            PG8_WAIT_V(8); PG8_WAIT_L(0); PG8_BAR; PG8_MMA(0, 0, At, B0); PG8_MMA(0, 1, At, B1); PG8_BAR; PG8_SCHED;
            if constexpr (!HM) PG8_LDA(At, 0, 1);
            PG8_STAGE(PG8_SB(0, 0), b2, voffB); PG8_STAGE(PG8_SB(0, 1), b2 + hstepB, voffB); PG8_STAGE(PG8_SA(0, 0), a2, voffA);
            if constexpr (HM) PG8_WAIT_V(6); else PG8_WAIT_V(8);
            PG8_WAIT_L(0); PG8_BAR; if constexpr (!HM) { PG8_MMA(1, 0, At, B0); PG8_MMA(1, 1, At, B1); } PG8_BAR; PG8_SCHED;
            PG8_LDB(B0, 1, 0); PG8_LDB(B1, 1, 1); PG8_SCHED; PG8_LDA(At, 1, 0); if constexpr (!HM) PG8_STAGE(PG8_SA(0, 1), a2 + hstepA, voffA);
            PG8_WAIT_V(8); PG8_WAIT_L(0); PG8_BAR; PG8_MMA(0, 0, At, B0); PG8_MMA(0, 1, At, B1); PG8_BAR; PG8_SCHED;
            if constexpr (!HM) PG8_LDA(At, 1, 1);
            PG8_STAGE(PG8_SB(1, 0), b3, voffB); PG8_STAGE(PG8_SB(1, 1), b3 + hstepB, voffB); PG8_STAGE(PG8_SA(1, 0), a3, voffA);
            if constexpr (HM) PG8_WAIT_V(6); else PG8_WAIT_V(8);
            PG8_WAIT_L(0); PG8_BAR; if constexpr (!HM) { PG8_MMA(1, 0, At, B0); PG8_MMA(1, 1, At, B1); } PG8_BAR; PG8_SCHED;
            } else {
            PG8_LDB(B0, 0, 0); PG8_SCHED; PG8_LDA(At, 0, 0); PG8_STAGE(PG8_SA(1, 1), a1 + hstepA, voffA);
            PG8_WAIT_L(8); PG8_BAR; PG8_WAIT_L(0); PG8_MMA(0, 0, At, B0); PG8_BAR; PG8_SCHED;
            PG8_LDB(B1, 0, 1); PG8_STAGE(PG8_SB(0, 0), b2, voffB);
            PG8_BAR; PG8_WAIT_L(0); PG8_MMA(0, 1, At, B1); PG8_BAR;
            PG8_LDA(At, 0, 1); PG8_STAGE(PG8_SA(0, 0), a2, voffA);
            PG8_BAR; PG8_WAIT_L(0); PG8_MMA(1, 0, At, B0); PG8_BAR; PG8_SCHED;
            PG8_STAGE(PG8_SB(0, 1), b2 + hstepB, voffB);
            PG8_WAIT_V(6); PG8_BAR; PG8_MMA(1, 1, At, B1); PG8_BAR;
            PG8_LDB(B0, 1, 0); PG8_SCHED; PG8_LDA(At, 1, 0); PG8_STAGE(PG8_SA(0, 1), a2 + hstepA, voffA);
            PG8_WAIT_L(8); PG8_BAR; PG8_WAIT_L(0); PG8_MMA(0, 0, At, B0); PG8_BAR; PG8_SCHED;
            PG8_LDB(B1, 1, 1); PG8_STAGE(PG8_SB(1, 0), b3, voffB);
            PG8_BAR; PG8_WAIT_L(0); PG8_MMA(0, 1, At, B1); PG8_BAR;
            PG8_LDA(At, 1, 1); PG8_STAGE(PG8_SA(1, 0), a3, voffA);
            PG8_BAR; PG8_WAIT_L(0); PG8_MMA(1, 0, At, B0); PG8_BAR; PG8_SCHED;
            PG8_STAGE(PG8_SB(1, 1), b3 + hstepB, voffB);
            PG8_WAIT_V(6); PG8_BAR; PG8_MMA(1, 1, At, B1); PG8_BAR;
            }
        }
        if constexpr (ALIGN_EPI) { if (wr == 0) PG8_BAR; }
        if constexpr (!Epi::AFTER_DRAIN) { E(acc, cur, wr, wc, fr, fq); S.done(cur); }
        if (!has_next) break;
#pragma unroll
        for (int a = 0; a < 2; ++a)
#pragma unroll
            for (int b = 0; b < 2; ++b)
#pragma unroll
                for (int m = 0; m < 4; ++m)
#pragma unroll
                    for (int n = 0; n < 2; ++n) acc[a][b][m][n] = (f32x4){0.f, 0.f, 0.f, 0.f};
        cur = nxt; cA = nA; cB = nB; ++ui;
        if constexpr (ALIGN_EPI) { if (wr == 1) PG8_BAR; }
    }
    PG8_WAIT_V(0);
    if constexpr (!ALIGN_EPI) { if (wr == 0) PG8_BAR; }
    PG8_BAR;
    if constexpr (Epi::AFTER_DRAIN) { E.fused(acc, cur, wr, wc, fr, fq, lds, wid, lane); S.done(cur); }
    if constexpr (Epi::RT_DRAIN) { if (E.drain()) E.fused(acc, cur, wr, wc, fr, fq, lds, wid, lane); }
#undef PG8_SA
#undef PG8_SB
#undef PG8_STAGE
#undef PG8_LDA
#undef PG8_LDB
#undef PG8_MMA
#undef PG8_WAIT_V
#undef PG8_WAIT_L
#undef PG8_BAR
#undef PG8_SCHED
}
}
constexpr int NWAVES = 8;
constexpr int BATCH = 4, SEQ = 2048, DM = 2048, DEPTH = 2;
constexpr int M = BATCH * SEQ;
constexpr int GW = 512;
constexpr int IN_COLS = 5648, IN_PAD = 5888;
constexpr int DFF = 5632, MEML = 256, XH = 4, XHD = 512;
constexpr int MROWS = BATCH * MEML;
constexpr float EPS = 1e-6f;
constexpr int UA_B = 0, UA_C = 512, UA_H = 1024, UB = 1536, UC_Q = 2048, UC_Z = 3584, UC_A = 4096, UC_B = 4100, UD_Z = 4104, UD_X = 4616, UD_DT = 5640;
constexpr int MIX_PRE = 0, MIX_POST = 1, XA_PRE = 2, XA_POST = 3, MEM_NORM = 4, FFN_PRE = 5, FFN_POST = 6, N_NORMS = 7;
enum { I_X = 0, I_MEM, I_NORMG, I_WIN, I_CONVA, I_POOLW, I_POOLS, I_GCONV, I_GALOG, I_GDTB, I_GNG, I_SCONVW, I_SCONVB, I_SALOG, I_SDTB, I_SD, I_SNG, I_WOUT, I_WQ, I_WKV, I_WO, I_WGU, I_WD, N_IN };

constexpr size_t MiB = 1u << 20;
constexpr size_t WS_CTL = 0, CTL_ZERO_BYTES = 128 * 1024;
constexpr size_t WSZ_WIN = (size_t)IN_PAD * DM * 2, WSZ_SQ = (size_t)DM * DM * 2, WSZ_KV = (size_t)2 * DM * DM * 2, WSZ_GU = (size_t)2 * DFF * DM * 2, WSZ_D = (size_t)DM * DFF * 2;
constexpr size_t WO_WIN = 0, WO_WOUT = WO_WIN + WSZ_WIN, WO_WQ = WO_WOUT + WSZ_SQ, WO_WKV = WO_WQ + WSZ_SQ, WO_WO = WO_WKV + WSZ_KV, WO_WGU = WO_WO + WSZ_SQ, WO_WD = WO_WGU + WSZ_GU, W_LAYER = WO_WD + WSZ_D;
constexpr size_t WS_W = 1 * MiB;
constexpr size_t WS_XN = WS_W + 2 * W_LAYER;
constexpr size_t WS_MIX = WS_XN + (size_t)M * DM * 2;
constexpr size_t WS_MEMN = WS_MIX + (size_t)M * DM * 2;
constexpr size_t WS_KV = WS_MEMN + (size_t)2 * MROWS * DM * 2;
constexpr size_t WS_U = WS_KV + (size_t)2 * MROWS * 2 * DM * 2;
constexpr size_t WS_P = WS_U, WS_HID = WS_U + (size_t)M * DM * 2;
constexpr size_t WS_UEND = WS_U + (size_t)120 * MiB;
constexpr size_t WS_ZG = WS_UEND, WS_ZS = WS_ZG + (size_t)M * 512 * 2, WS_BS = WS_ZS + (size_t)M * 512 * 2, WS_CS = WS_BS + (size_t)M * 256 * 4;
constexpr size_t WS_SCR = WS_CS + (size_t)M * 256 * 4;
constexpr size_t WS_Y = WS_SCR;
constexpr size_t SZ512 = (size_t)M * 512 * 4, SZ256 = (size_t)M * 256 * 4, SZ8 = (size_t)M * 8 * 4;
constexpr size_t WS_QN = WS_SCR, WS_KN = WS_QN + SZ512, WS_VV = WS_KN + SZ512, WS_OG = WS_VV + SZ512, WS_XS = WS_OG + SZ512, WS_YS = WS_XS + SZ512,
                 WS_GB = WS_YS + SZ512, WS_DT = WS_GB + SZ8, WS_SCR_END = WS_DT + 2 * SZ8;
constexpr size_t WS_RS = WS_SCR_END;
constexpr size_t WS_PWT = WS_RS + (size_t)M * 4;
constexpr size_t WS_AT = WS_PWT + (size_t)DEPTH * 4 * 128 * 128 * 2, WS_VWT = WS_AT + (size_t)DEPTH * BATCH * 1024 * DM * 2, WS_END = WS_VWT + (size_t)DEPTH * BATCH * DM * 1024 * 2;
constexpr int LA_QD = 0, LA_QK = 16384, LA_KE = 24576, LA_NW = 40960, LA_UCG = 57344, LA_RECG = 90112;
constexpr int LA_UCS = 40960, LA_RECS = 57344;
constexpr size_t WS_FG = WS_U, WS_FS = WS_FG + (size_t)512 * LA_RECG, WS_DLG = WS_FS + (size_t)1024 * LA_RECS, WS_DLS = WS_DLG + 512 * 4, WS_FEND = WS_DLS + 1024 * 4;
static_assert(WS_FEND <= WS_UEND, "records inside U");
static_assert(WS_Y + (size_t)M * DM * 4 <= WS_SCR_END, "Y inside the scan region");
static_assert(WS_HID + (size_t)M * DFF * 2 <= WS_UEND && (size_t)M * IN_PAD * 2 <= (size_t)120 * MiB, "HID and U inside the U region");
static_assert(WS_END <= (size_t)704 * MiB, "d_ws map fits 4 x the largest input");

constexpr int RING_OFF = 0, RING_BYTES = 131072;
constexpr int LDSCTL_OFF = RING_BYTES, MISC_OFF = LDSCTL_OFF + 320;
constexpr int LDS_BYTES = 147456;
constexpr int CW_BAR = 4096;

#define GAS __attribute__((address_space(1)))
#define LAS __attribute__((address_space(3)))
typedef unsigned short bf16;
typedef unsigned v4u __attribute__((ext_vector_type(4)));
typedef unsigned v2u __attribute__((ext_vector_type(2)));
typedef float f32x4 __attribute__((ext_vector_type(4)));
typedef short bf16x8 __attribute__((ext_vector_type(8)));
#define LDS_WAIT() asm volatile("s_waitcnt lgkmcnt(0)" ::: "memory")
#define VM_WAIT() asm volatile("s_waitcnt vmcnt(0)" ::: "memory")
typedef float f32x2v __attribute__((ext_vector_type(2)));
typedef __bf16 bf16x2_t __attribute__((ext_vector_type(2)));
__device__ __forceinline__ unsigned cvtpk(float lo, float hi) { const f32x2v v = {lo, hi}; return __builtin_bit_cast(unsigned, __builtin_convertvector(v, bf16x2_t)); }
__device__ __forceinline__ unsigned pk2(float lo, float hi) { return cvtpk(lo, hi); }
__device__ __forceinline__ unsigned f2bf(float f) { return cvtpk(f, 0.f) & 0xffffu; }
__device__ __forceinline__ float siluf(float v) { return v * __builtin_amdgcn_rcpf(1.0f + __expf(-v)); }
__device__ __forceinline__ float softplusf(float v) { return fmaxf(v, 0.f) + __logf(1.0f + __expf(-fabsf(v))); }
__device__ __forceinline__ float sigmoidf(float v) { return __builtin_amdgcn_rcpf(1.0f + __expf(-v)); }
__device__ __forceinline__ f32x4 ld4(const float* p) { return *(const f32x4*)p; }
__device__ __forceinline__ f32x4 silu4(f32x4 v) { return (f32x4){siluf(v.x), siluf(v.y), siluf(v.z), siluf(v.w)}; }
template <int CTRL> __device__ __forceinline__ float dppf(float v) { return __builtin_bit_cast(float, __builtin_amdgcn_update_dpp(0, __builtin_bit_cast(int, v), CTRL, 0xF, 0xF, true)); }
__device__ __forceinline__ float row16_sum(float v) { v += dppf<0xB1>(v); v += dppf<0x4E>(v); v += dppf<0x141>(v); v += dppf<0x140>(v); return v; }
__device__ __forceinline__ int opq(int v) { asm volatile("" : "+v"(v)); return v; }
__device__ __forceinline__ float shx(float v, int m, int lane) { return __builtin_bit_cast(float, __builtin_amdgcn_ds_bpermute((lane ^ m) << 2, __builtin_bit_cast(int, v))); }
__device__ __forceinline__ float wave_sum(float v) {
    v = row16_sum(v);
    const int iv = __builtin_bit_cast(int, v);
    return (__builtin_bit_cast(float, __builtin_amdgcn_readlane(iv, 0)) + __builtin_bit_cast(float, __builtin_amdgcn_readlane(iv, 16))) + (__builtin_bit_cast(float, __builtin_amdgcn_readlane(iv, 32)) + __builtin_bit_cast(float, __builtin_amdgcn_readlane(iv, 48)));
}

#define XB_TMO      128
#define XB_XCNT(j)  (256  + 64 * (j))
#define XB_XSUB(j)  (1280 + 64 * (j))
#define XB_XGEN(j)  (2304 + 64 * (j))
#define XB_TOP      3328
#define XB_TOPGEN   3392
#define XCD_BAR_WORDS 3456
#define XB_SPIN_CAP (1u << 18)

__device__ __forceinline__ unsigned xb_ld(unsigned* p)              { return __hip_atomic_load(p, __ATOMIC_RELAXED, __HIP_MEMORY_SCOPE_AGENT); }
__device__ __forceinline__ unsigned xb_add(unsigned* p, unsigned v) { return __hip_atomic_fetch_add(p, v, __ATOMIC_RELAXED, __HIP_MEMORY_SCOPE_AGENT); }
__device__ __forceinline__ unsigned xb_xcc_id() { return (unsigned)__builtin_amdgcn_s_getreg((3 << 11) | 20) & 0xFu; }
#define XB_SPIN(cond, bar) do { unsigned _sp = 0; while (cond) { __builtin_amdgcn_s_sleep(1); \
    if ((++_sp & 255u) == 0u) { if (xb_ld(&(bar)[XB_TMO])) break; if (_sp > XB_SPIN_CAP) { atomicAdd(&(bar)[XB_TMO], 1u); break; } } } } while (0)

struct XcdBarrier {
    unsigned* bar; unsigned x;
    volatile LAS unsigned* st;
};

__device__ __forceinline__ XcdBarrier xcd_barrier_post(unsigned* bar, volatile LAS unsigned* st) {
    XcdBarrier b; b.bar = bar; b.x = xb_xcc_id(); b.st = st;
    if (threadIdx.x == 0) (void)xb_add(&bar[XB_XCNT(b.x)], 1u);
    return b;
}
__device__ __forceinline__ void xcd_barrier_complete(unsigned* bar, unsigned x, unsigned& nloc, unsigned& nx) {
    const unsigned G = gridDim.x * gridDim.y * gridDim.z;
    unsigned sum, cnt, mine, sp = 0u;
    for (;;) {
        sum = 0u; cnt = 0u; mine = 0u;
#pragma unroll
        for (unsigned j = 0; j < 16; ++j) { const unsigned c = xb_ld(&bar[XB_XCNT(j)]); sum += c; cnt += (c > 0u) ? 1u : 0u; mine = (j == x) ? c : mine; }
        if (sum == G) break;
        __builtin_amdgcn_s_sleep(1);
        if ((++sp & 255u) == 0u) { if (xb_ld(&bar[XB_TMO])) break; if (sp > XB_SPIN_CAP) { atomicAdd(&bar[XB_TMO], 1u); break; } }
    }
    nloc = mine > 0u ? mine : 1u; nx = cnt > 0u ? cnt : 1u;
}

__device__ __forceinline__ void xcd_barrier(const XcdBarrier& b) {
    asm volatile("s_waitcnt vmcnt(0)" ::: "memory");
    __syncthreads();
    if (threadIdx.x == 0) {
        unsigned* bar = b.bar;
        __builtin_amdgcn_s_waitcnt(0);
        unsigned nloc = b.st[0], nx = b.st[1];
        if (nloc == 0u) { xcd_barrier_complete(bar, b.x, nloc, nx); b.st[0] = nloc; b.st[1] = nx; }
        const unsigned old = xb_add(&bar[XB_XSUB(b.x)], 1u);
        const unsigned gen = old / nloc;
        if (old + 1u == (gen + 1u) * nloc) {
            __builtin_amdgcn_fence(__ATOMIC_RELEASE, "agent");
            asm volatile("s_waitcnt vmcnt(0)" ::: "memory");
            const unsigned og = xb_add(&bar[XB_TOP], 1u);
            const unsigned tg = og / nx;
            if (og + 1u == (tg + 1u) * nx) xb_add(&bar[XB_TOPGEN], 1u);
            else XB_SPIN(xb_ld(&bar[XB_TOPGEN]) == tg, bar);
            __builtin_amdgcn_fence(__ATOMIC_ACQUIRE, "agent");
            xb_add(&bar[XB_XGEN(b.x)], 1u);
            asm volatile("s_waitcnt vmcnt(0)" ::: "memory");
        } else {
            XB_SPIN(xb_ld(&bar[XB_XGEN(b.x)]) == gen, bar);
            __builtin_amdgcn_fence(__ATOMIC_ACQUIRE, "agent");
            asm volatile("s_waitcnt vmcnt(0)" ::: "memory");
        }
    }
    __syncthreads();
}
struct Frame {
    LAS unsigned char* lds;
    volatile LAS unsigned* MISC;
    unsigned* ctl;
    int tid, lane, wave;
    int vcu, G;
    float* out; unsigned char* ws;
};
__device__ __forceinline__ const float* inp(int i) { const float* __attribute__((address_space(4))) const* tab = (const float* __attribute__((address_space(4))) const*)__builtin_amdgcn_kernarg_segment_ptr(); asm volatile("" : "+s"(tab)); return tab[i]; }
__device__ __forceinline__ bf16* wsb(const Frame& F, size_t off) { return (bf16*)(F.ws + off); }
__device__ __forceinline__ float* wsf(const Frame& F, size_t off) { return (float*)(F.ws + off); }

__device__ __forceinline__ void p0_transpose_item(const float* W, int K, int N, bf16* WT, int drow0, int k0, int n0, LAS float* scr, int lane, const float* gk = nullptr  ) {
    const int ch = lane & 15, rsub = lane >> 4; const bool ok = n0 + 4 * ch < N;
    f32x4 wv_[16];
#pragma unroll
    for (int i = 0; i < 16; ++i) { const int kk = 4 * i + rsub; wv_[i] = ok ? ld4(W + (size_t)(k0 + kk) * N + n0 + 4 * ch) : (f32x4){0.f, 0.f, 0.f, 0.f}; }
#pragma unroll
    for (int i = 0; i < 16; ++i) { const int kk = 4 * i + rsub; const f32x4 v = gk ? wv_[i] * gk[k0 + kk] : wv_[i]; *(LAS f32x4*)(scr + kk * 64 + ((ch ^ ((kk >> 3) & 7)) << 2)) = v; }
    LDS_WAIT(); asm volatile("" ::: "memory");
    const int kc = lane & 7;
#pragma unroll
    for (int j = 0; j < 8; ++j) { const int n = (lane >> 3) + 8 * j; float t[8];
#pragma unroll
        for (int q = 0; q < 8; ++q) { const int kk = 8 * kc + q; t[q] = scr[kk * 64 + ((((n >> 2) ^ ((kk >> 3) & 7))) << 2) + (n & 3)]; }
        v4u o; o.x = pk2(t[0], t[1]); o.y = pk2(t[2], t[3]); o.z = pk2(t[4], t[5]); o.w = pk2(t[6], t[7]);
        *(v4u*)(WT + (size_t)(drow0 + n) * K + k0 + 8 * kc) = o; }
    LDS_WAIT(); asm volatile("" ::: "memory");
}
__device__ __forceinline__ void norm_row_to_bf16(const float* xrow, const float* g, bf16* orow, int lane) {
    const f32x4* xr = (const f32x4*)xrow + lane; const f32x4* gr = (const f32x4*)g + lane;
    f32x4 v[8]; float s = 0.f;
#pragma unroll
    for (int j = 0; j < 8; ++j) { v[j] = xr[64 * j]; s += (v[j].x * v[j].x + v[j].y * v[j].y) + (v[j].z * v[j].z + v[j].w * v[j].w); }
    const float rstd = __builtin_amdgcn_rsqf(wave_sum(s) * (1.0f / DM) + EPS);
    v2u* o8 = (v2u*)orow + lane;
#pragma unroll
    for (int j = 0; j < 8; ++j) { const f32x4 gg = gr[64 * j]; v2u w; w.x = pk2(v[j].x * rstd * gg.x, v[j].y * rstd * gg.y); w.y = pk2(v[j].z * rstd * gg.z, v[j].w * rstd * gg.w); o8[64 * j] = w; }
}
__device__ __forceinline__ void p0_prologue(Frame& F, int part) {
    LAS float* scr = (LAS float*)(F.lds + RING_OFF + F.wave * 16384);
    const int vb = part ? 64 : 0;
    if (F.vcu < vb) return;
    const int gw = (F.vcu - vb) * NWAVES + F.wave, NGW = (F.G - vb) * NWAVES; const int lane = opq(F.lane), tid = opq(F.tid);
    const int gt = (F.vcu - vb) * NWAVES * 64 + tid, NGT = NGW * 64;
    constexpr int NB_IN = (IN_COLS + 63) / 64;
    constexpr int I_IN = (DM / 64) * NB_IN, I_SQ = (DM / 64) * (DM / 64), I_KV = (DM / 64) * (2 * DM / 64), I_GU = (DM / 64) * (2 * DFF / 64), I_D = (DFF / 64) * (DM / 64);
    constexpr int I_LAYER = I_IN + 2 * I_SQ + I_KV + I_GU + I_D;
    for (int it = gw; it < I_LAYER; it += NGW) {
        const int l = part; int r = it;
        bf16* wl = wsb(F, WS_W + (size_t)l * W_LAYER);
        if (r < I_IN) { const int kb = r / NB_IN, nb = r % NB_IN; p0_transpose_item(inp(I_WIN) + (size_t)l * DM * IN_COLS, DM, IN_COLS, (bf16*)((char*)wl + WO_WIN), 64 * nb, 64 * kb, 64 * nb, scr, lane, inp(I_NORMG) + (size_t)(l * N_NORMS + MIX_PRE) * DM); continue; } r -= I_IN;
        if (r < I_SQ) { const int kb = r / (DM / 64), nb = r % (DM / 64); p0_transpose_item(inp(I_WOUT) + (size_t)l * DM * DM, DM, DM, (bf16*)((char*)wl + WO_WOUT), 64 * nb, 64 * kb, 64 * nb, scr, lane); continue; } r -= I_SQ;
        if (r < I_SQ) { const int kb = r / (DM / 64), nb = r % (DM / 64); p0_transpose_item(inp(I_WO) + (size_t)l * DM * DM, DM, DM, (bf16*)((char*)wl + WO_WO), 64 * nb, 64 * kb, 64 * nb, scr, lane); continue; } r -= I_SQ;
        if (r < I_KV) { const int kb = r / (2 * DM / 64), nb = r % (2 * DM / 64); p0_transpose_item(inp(I_WKV) + (size_t)l * DM * 2 * DM, DM, 2 * DM, (bf16*)((char*)wl + WO_WKV), 64 * nb, 64 * kb, 64 * nb, scr, lane); continue; } r -= I_KV;
        if (r < I_GU) { const int kb = r / (2 * DFF / 64), nb = r % (2 * DFF / 64); const int n0 = 64 * nb; const int up = n0 >= DFF ? 1 : 0, j0 = n0 - up * DFF;
            const int drow = (j0 >> 7) * 256 + up * 128 + (j0 & 127);
            p0_transpose_item(inp(I_WGU) + (size_t)l * DM * 2 * DFF, DM, 2 * DFF, (bf16*)((char*)wl + WO_WGU), drow, 64 * kb, n0, scr, lane, inp(I_NORMG) + (size_t)(l * N_NORMS + FFN_PRE) * DM); continue; } r -= I_GU;
        { const int kb = r / (DM / 64), nb = r % (DM / 64); p0_transpose_item(inp(I_WD) + (size_t)l * DFF * DM, DFF, DM, (bf16*)((char*)wl + WO_WD), 64 * nb, 64 * kb, 64 * nb, scr, lane); }
    }
    for (int i = gt; i < DM * DM / 8; i += NGT) { const int l = part, k = i;
        const float* src = inp(I_WQ) + (size_t)l * DM * DM + (size_t)k * 8; const float gq = inp(I_NORMG)[(size_t)(l * N_NORMS + XA_PRE) * DM + (k >> 8)]; const f32x4 a = ld4(src) * gq, b = ld4(src + 4) * gq;
        v4u o; o.x = pk2(a.x, a.y); o.y = pk2(a.z, a.w); o.z = pk2(b.x, b.y); o.w = pk2(b.z, b.w);
        ((v4u*)(F.ws + WS_W + (size_t)l * W_LAYER + WO_WQ))[k] = o; }
    { constexpr int ZR0 = 64 * NB_IN, ZN = (IN_PAD - ZR0) * DM / 8;
      const unsigned z0 = (unsigned)opq(0); const v4u zz = {z0, z0, z0, z0};
      for (int i = gt; i < ZN; i += NGT) { const int l = part, k = i;
          ((v4u*)(F.ws + WS_W + (size_t)l * W_LAYER + WO_WIN + (size_t)ZR0 * DM * 2))[k] = zz; } }
    if (part) return;
    for (int i = gt; i < DEPTH * 4 * 128 * 128; i += NGT) { const int c = i & 127, d = (i >> 7) & 127, lg = i >> 14;
        wsb(F, WS_PWT)[i] = (bf16)f2bf(inp(I_POOLW)[((size_t)lg * 128 + c) * 128 + d] * inp(I_POOLS)[(size_t)(lg >> 2) * GW + (lg & 3) * 128 + d]); }
    for (int m = gw; m < DEPTH * MROWS; m += NGW) { const int l = m / MROWS, r = m % MROWS;
        norm_row_to_bf16(inp(I_MEM) + (size_t)r * DM, inp(I_NORMG) + (size_t)(l * N_NORMS + MEM_NORM) * DM, wsb(F, WS_MEMN) + (size_t)m * DM, lane); }
    for (int m = gw; m < M; m += NGW) { const f32x4* xr = (const f32x4*)(inp(I_X) + (size_t)m * DM) + 2 * lane; v4u* xb = (v4u*)(wsb(F, WS_XN) + (size_t)m * DM) + lane; float ss = 0.f;
#pragma unroll
        for (int j = 0; j < 4; ++j) { const f32x4 a = xr[128 * j], b = xr[128 * j + 1]; ss += ((a.x * a.x + a.y * a.y) + (a.z * a.z + a.w * a.w)) + ((b.x * b.x + b.y * b.y) + (b.z * b.z + b.w * b.w));
            v4u o; o.x = pk2(a.x, a.y); o.y = pk2(a.z, a.w); o.z = pk2(b.x, b.y); o.w = pk2(b.z, b.w); xb[64 * j] = o; }
        ss = wave_sum(ss); if (lane == 0) wsf(F, WS_RS)[m] = __builtin_amdgcn_rsqf(ss * (1.0f / DM) + EPS); }
}

struct f32x8 { f32x4 lo, hi; };
__device__ __forceinline__ f32x8 ldu8(const bf16* p) { const v4u w = *(const v4u*)p; f32x8 r;
    r.lo = (f32x4){__builtin_bit_cast(float, w.x << 16), __builtin_bit_cast(float, w.x & 0xffff0000u), __builtin_bit_cast(float, w.y << 16), __builtin_bit_cast(float, w.y & 0xffff0000u)};
    r.hi = (f32x4){__builtin_bit_cast(float, w.z << 16), __builtin_bit_cast(float, w.z & 0xffff0000u), __builtin_bit_cast(float, w.w << 16), __builtin_bit_cast(float, w.w & 0xffff0000u)}; return r; }
__device__ __forceinline__ f32x8 cvt8(const v4u w) { f32x8 r;
    r.lo = (f32x4){__builtin_bit_cast(float, w.x << 16), __builtin_bit_cast(float, w.x & 0xffff0000u), __builtin_bit_cast(float, w.y << 16), __builtin_bit_cast(float, w.y & 0xffff0000u)};
    r.hi = (f32x4){__builtin_bit_cast(float, w.z << 16), __builtin_bit_cast(float, w.z & 0xffff0000u), __builtin_bit_cast(float, w.w << 16), __builtin_bit_cast(float, w.w & 0xffff0000u)}; return r; }
__device__ __forceinline__ f32x8 ld8f(const float* p) { f32x8 r; r.lo = ld4(p); r.hi = ld4(p + 4); return r; }
__device__ __forceinline__ f32x8 operator*(const f32x8& a, const f32x8& b) { return f32x8{a.lo * b.lo, a.hi * b.hi}; }
__device__ __forceinline__ f32x8 operator+(const f32x8& a, const f32x8& b) { return f32x8{a.lo + b.lo, a.hi + b.hi}; }
__device__ __forceinline__ f32x8 silu8(const f32x8& a) { return f32x8{silu4(a.lo), silu4(a.hi)}; }
__device__ __forceinline__ float sumsq8(const f32x8& y) { return ((y.lo.x * y.lo.x + y.lo.y * y.lo.y) + (y.lo.z * y.lo.z + y.lo.w * y.lo.w)) + ((y.hi.x * y.hi.x + y.hi.y * y.hi.y) + (y.hi.z * y.hi.z + y.hi.w * y.hi.w)); }
__device__ __forceinline__ v4u pack8u(const f32x8& y) { v4u o; o.x = pk2(y.lo.x, y.lo.y); o.y = pk2(y.lo.z, y.lo.w); o.z = pk2(y.hi.x, y.hi.y); o.w = pk2(y.hi.z, y.hi.w); return o; }
__device__ __forceinline__ void mixer_prep_phase(Frame& F, int l) {
    const int gw = F.vcu * NWAVES + F.wave, NGW = F.G * NWAVES, lane = opq(F.lane), tid = opq(F.tid);
    const bf16* U = wsb(F, WS_U);
    bf16* MIX = wsb(F, WS_MIX);
    constexpr int NSTRIP = M / 16, NTYPE = 12;
    for (int it = gw; it < NTYPE * NSTRIP; it += NGW) {
        const int type = it % NTYPE, strip = it / NTYPE, r0 = strip * 16, pos0 = r0 & (SEQ - 1), c = lane * 8;
        const bf16* ur0 = U + (size_t)r0 * IN_PAD;
        if (type == 0) {
            const float* cw = inp(I_CONVA) + (size_t)l * 3 * GW + c;
            const f32x8 w0 = ld8f(cw), w1 = ld8f(cw + GW), w2 = ld8f(cw + 2 * GW);
            const v4u z4 = {0u, 0u, 0u, 0u};
#pragma unroll 1
            for (int hf = 0; hf < 2; ++hf) {
                const bf16* ub = ur0 + (size_t)(8 * hf) * IN_PAD;
                v4u rc[10], rh[10], rb[8];
#pragma unroll
                for (int i = 0; i < 10; ++i) { const int ri = i - 2; if (ri >= 0 || pos0 > 0 || hf > 0) { rc[i] = *(const v4u*)(ub + (ptrdiff_t)ri * IN_PAD + UA_C + c); rh[i] = *(const v4u*)(ub + (ptrdiff_t)ri * IN_PAD + UA_H + c); } else { rc[i] = z4; rh[i] = z4; } }
#pragma unroll
                for (int i = 0; i < 8; ++i) rb[i] = *(const v4u*)(ub + (size_t)i * IN_PAD + UA_B + c);
                f32x8 p2 = cvt8(rc[0]) * cvt8(rh[0]), p1 = cvt8(rc[1]) * cvt8(rh[1]);
#pragma unroll
                for (int i = 0; i < 8; ++i) { const f32x8 p0 = cvt8(rc[i + 2]) * cvt8(rh[i + 2]); const f32x8 y = cvt8(rb[i]) * (w0 * p2 + w1 * p1 + w2 * p0);
                    *(v4u*)(MIX + (size_t)(r0 + 8 * hf + i) * DM + c) = pack8u(y); p2 = p1; p1 = p0; }
            }
        } else if (type < 4) {
            const int gi = type - 1, cc = gi * GW + c;
            const float* cw = inp(I_GCONV) + (size_t)l * 4 * 3 * GW + cc;
            const f32x8 w0 = ld8f(cw), w1 = ld8f(cw + 3 * GW), w2 = ld8f(cw + 6 * GW), w3 = ld8f(cw + 9 * GW);
            v4u xr[19];
#pragma unroll
            for (int i = 0; i < 19; ++i) { const int ri = i - 3; if (ri >= 0 || pos0 > 0) xr[i] = *(const v4u*)(ur0 + (ptrdiff_t)ri * IN_PAD + UC_Q + cc); else xr[i] = (v4u){0u, 0u, 0u, 0u}; }
            float* dst = (gi == 0) ? wsf(F, WS_QN) : (gi == 1) ? wsf(F, WS_KN) : wsf(F, WS_VV);
            const float qs = (gi == 0) ? 0.08838834764831845f : 1.0f;
            f32x8 x3 = cvt8(xr[0]), x2 = cvt8(xr[1]), x1 = cvt8(xr[2]);
#pragma unroll
            for (int i = 0; i < 16; ++i) { const f32x8 x0 = cvt8(xr[i + 3]); f32x8 y = silu8(w0 * x3 + w1 * x2 + w2 * x1 + w3 * x0); x3 = x2; x2 = x1; x1 = x0;
                if (gi < 2) { float ss = row16_sum(sumsq8(y));
                    const float sc = qs * __builtin_amdgcn_rsqf(ss + EPS); y.lo = y.lo * sc; y.hi = y.hi * sc; }
                float* d = dst + (size_t)(r0 + i) * GW + c; *(f32x4*)d = y.lo; *(f32x4*)(d + 4) = y.hi; }
        } else if (type < 6) {
            const int gi = type - 4, cc = gi * GW + c;
            const float* cw = inp(I_SCONVW) + (size_t)l * 4 * 1024 + cc;
            const f32x8 w0 = ld8f(cw), w1 = ld8f(cw + 1024), w2 = ld8f(cw + 2048), w3 = ld8f(cw + 3072), bb = ld8f(inp(I_SCONVB) + (size_t)l * 1024 + cc);
            v4u xr[19];
#pragma unroll
            for (int i = 0; i < 19; ++i) { const int ri = i - 3; if (ri >= 0 || pos0 > 0) xr[i] = *(const v4u*)(ur0 + (ptrdiff_t)ri * IN_PAD + UD_X + cc); else xr[i] = (v4u){0u, 0u, 0u, 0u}; }
            f32x8 x3 = cvt8(xr[0]), x2 = cvt8(xr[1]), x1 = cvt8(xr[2]);
            float* dst; int ld, co;
            if (gi == 0) { dst = wsf(F, WS_XS); ld = 512; co = c; } else if (c < 256) { dst = wsf(F, WS_BS); ld = 256; co = c; } else { dst = wsf(F, WS_CS); ld = 256; co = c - 256; }
#pragma unroll
            for (int i = 0; i < 16; ++i) { const f32x8 x0 = cvt8(xr[i + 3]); const f32x8 y = silu8(w0 * x3 + w1 * x2 + w2 * x1 + w3 * x0 + bb); x3 = x2; x2 = x1; x1 = x0;
                float* d = dst + (size_t)(r0 + i) * ld + co; *(f32x4*)d = y.lo; *(f32x4*)(d + 4) = y.hi; }
        } else if (type < 8) {
            const int zo = (type == 6) ? UC_Z : UD_Z; bf16* dst = wsb(F, (type == 6) ? WS_ZG : WS_ZS);
            v4u z[16];
#pragma unroll
            for (int i = 0; i < 16; ++i) z[i] = *(const v4u*)(ur0 + (size_t)i * IN_PAD + zo + c);
#pragma unroll
            for (int i = 0; i < 16; ++i) *(v4u*)(dst + (size_t)(r0 + i) * GW + c) = z[i];
        } else {
            const int gi = type - 8, w = 2 << gi;
            LAS float* scr = (LAS float*)(F.lds + RING_OFF + F.wave * 16384);
            const int c0 = UB + gi * 128 + lane * 2;
            float uv0[31], uv1[31];
#pragma unroll
            for (int i = 0; i < 31; ++i) { const int ri = i - 15; float a0 = 0.f, a1 = 0.f;
                if (ri >= 0 || pos0 > 0) { const unsigned wd = *(const unsigned*)(ur0 + (ptrdiff_t)ri * IN_PAD + c0); a0 = __builtin_bit_cast(float, wd << 16); a1 = __builtin_bit_cast(float, wd & 0xffff0000u); }
                uv0[i] = a0; uv1[i] = a1; }
            float r0s = 0.f, r1s = 0.f;
#pragma unroll
            for (int s = 1; s < 16; ++s) if (s < w) { r0s += uv0[15 - s]; r1s += uv1[15 - s]; }
#pragma unroll
            for (int i = 0; i < 16; ++i) { const int pos = pos0 + i; const float a0 = uv0[15 + i], a1 = uv1[15 + i];
                r0s += a0; r1s += a1;
                const float cnt = (float)((pos + 1 < w) ? pos + 1 : w);
                const float rc = __builtin_amdgcn_rcpf(cnt); scr[i * 128 + lane * 2] = r0s * rc - a0; scr[i * 128 + lane * 2 + 1] = r1s * rc - a1;
                float d0 = 0.f, d1 = 0.f;
#pragma unroll
                for (int g2 = 0; g2 < 4; ++g2) if (gi == g2) { d0 = uv0[15 + i - (2 << g2) + 1]; d1 = uv1[15 + i - (2 << g2) + 1]; }
                r0s -= d0; r1s -= d1; }
            LDS_WAIT(); asm volatile("" ::: "memory");
            const bf16* pwt = wsb(F, WS_PWT) + ((size_t)l * 4 + gi) * 128 * 128 + (size_t)(lane & 15) * 128 + (lane >> 4) * 8;
            bf16x8 bfr[4];
#pragma unroll
            for (int ks = 0; ks < 4; ++ks) { const LAS float* pr = scr + (lane & 15) * 128 + 32 * ks + (lane >> 4) * 8; const f32x4 p0 = *(const LAS f32x4*)pr, p1 = *(const LAS f32x4*)(pr + 4);
                v4u w; w.x = pk2(p0.x, p0.y); w.y = pk2(p0.z, p0.w); w.z = pk2(p1.x, p1.y); w.w = pk2(p1.z, p1.w); bfr[ks] = __builtin_bit_cast(bf16x8, w); }
            bf16* orow = MIX + (size_t)(r0 + (lane & 15)) * DM + GW + gi * 128 + (lane >> 4) * 4;
#pragma unroll
            for (int nh = 0; nh < 2; ++nh) {
                bf16x8 afr[4][4];
#pragma unroll
                for (int nt = 0; nt < 4; ++nt)
#pragma unroll
                    for (int ks = 0; ks < 4; ++ks) afr[nt][ks] = *(const bf16x8*)(pwt + (size_t)((nh * 4 + nt) * 16) * 128 + 32 * ks);
#pragma unroll
                for (int nt = 0; nt < 4; ++nt) { f32x4 acc = {0.f, 0.f, 0.f, 0.f};
#pragma unroll
                    for (int ks = 0; ks < 4; ++ks) acc = __builtin_amdgcn_mfma_f32_16x16x32_bf16(afr[nt][ks], bfr[ks], acc, 0, 0, 0);
                    v2u o; o.x = pk2(acc.x, acc.y); o.y = pk2(acc.z, acc.w); *(v2u*)(orow + (nh * 4 + nt) * 16) = o; }
            }
            LDS_WAIT(); asm volatile("" ::: "memory");
        }
    }
    for (int i = (F.vcu * NWAVES * 64) + tid; i < M * 16; i += F.G * NWAVES * 64) { const int t = i >> 4, j = i & 15; const bf16* ur = U + (size_t)t * IN_PAD;
#define UF(col) __builtin_bit_cast(float, (unsigned)ur[col] << 16)
        if (j < 4) { wsf(F, WS_GB)[(size_t)t * 8 + 2 * j] = -__expf(inp(I_GALOG)[l * 4 + j]) * softplusf(UF(UC_A + j) + inp(I_GDTB)[l * 4 + j]); }
        else if (j < 8) { wsf(F, WS_GB)[(size_t)t * 8 + 2 * (j - 4) + 1] = sigmoidf(UF(UC_B + (j - 4))); }
        else { const int hh = j - 8; const float dt = softplusf(UF(UD_DT + hh) + inp(I_SDTB)[l * 8 + hh]);
            wsf(F, WS_DT)[(size_t)t * 16 + 2 * hh] = -__expf(inp(I_SALOG)[l * 8 + hh]) * dt; wsf(F, WS_DT)[(size_t)t * 16 + 2 * hh + 1] = dt; }
#undef UF
    }
}

typedef float f32x16 __attribute__((ext_vector_type(16)));
__device__ __forceinline__ bf16x8 pack8(float a0, float a1, float a2, float a3, float a4, float a5, float a6, float a7) { v4u w; w.x = cvtpk(a0, a1); w.y = cvtpk(a2, a3); w.z = cvtpk(a4, a5); w.w = cvtpk(a6, a7); return __builtin_bit_cast(bf16x8, w); }
#define PACK_STEP(x, s) pack8((x)[8 * (s)], (x)[8 * (s) + 1], (x)[8 * (s) + 2], (x)[8 * (s) + 3], (x)[8 * (s) + 4], (x)[8 * (s) + 5], (x)[8 * (s) + 6], (x)[8 * (s) + 7])
#define MFMA32(a, b, c) __builtin_amdgcn_mfma_f32_32x32x16_bf16((a), (b), (c), 0, 0, 0)
__device__ __forceinline__ int crow(int reg, int h) { return (reg & 3) + 8 * (reg >> 2) + 4 * h; }
constexpr int LA_KB = 0;
constexpr int LA_QB = LA_KB + 64 * 136 * 2;
constexpr int LA_KGT = LA_QB + 64 * 136 * 2;
constexpr int LA_VBT = LA_KGT + 128 * 72 * 2;
constexpr int LA_KET = LA_VBT + 128 * 72 * 2;
constexpr int LA_M = LA_KET + 128 * 72 * 2;
constexpr int LA_TB = LA_M + 64 * 68 * 4;
constexpr int LA_VEC = LA_TB + 64 * 72 * 2;
static_assert(LA_VEC + 1024 <= RING_BYTES, "la LDS map");
__device__ __forceinline__ bf16x8 lds_frag(const LAS unsigned char* base, int row, int stride_el, int col) { return *(const LAS bf16x8*)(base + ((size_t)row * stride_el + col) * 2); }
__device__ __forceinline__ float wave_incl_scan(float v, int lane) {
#pragma unroll
    for (int d = 1; d < 64; d <<= 1) { const float o = __builtin_bit_cast(float, __builtin_amdgcn_ds_bpermute((lane - d) << 2, __builtin_bit_cast(int, v))); if (lane >= d) v += o; }
    return v;
}
__device__ __forceinline__ void store_qk_frag(const f32x16& acc, const LAS float* Gv, int mt, int rt, int r, int h, int lane, bf16* qkf) {
    const int l = 32 * rt + r; const float Gl = Gv[l];
    float v[16];
#pragma unroll
    for (int q = 0; q < 16; ++q) { const int m = 32 * mt + crow(q, h); v[q] = (m <= l) ? acc[q] * __expf(Gl - Gv[m]) : 0.f; }
    *(bf16x8*)(qkf + ((size_t)(rt * 4 + 2 * mt + 0) * 64 + lane) * 8) = pack8(v[0], v[1], v[2], v[3], v[4], v[5], v[6], v[7]);
    *(bf16x8*)(qkf + ((size_t)(rt * 4 + 2 * mt + 1) * 64 + lane) * 8) = pack8(v[8], v[9], v[10], v[11], v[12], v[13], v[14], v[15]);
}
__device__ __forceinline__ void qd_frag_task(const float* qrows, int ldq, const LAS float* Gv, int task, int r, int h, int lane, bf16* qdf) {
    const int rt = task >> 3, ks = task & 7, l = 32 * rt + r, k0 = 16 * ks + 4 * h; const float e = __expf(Gv[l]);
    const f32x4 a = ld4(qrows + (size_t)l * ldq + k0), b = ld4(qrows + (size_t)l * ldq + k0 + 8);
    *(bf16x8*)(qdf + ((size_t)task * 64 + lane) * 8) = pack8(a.x * e, a.y * e, a.z * e, a.w * e, b.x * e, b.y * e, b.z * e, b.w * e);
}
__device__ __forceinline__ void qd_frag_task4(const float* qrows, int ldq, const LAS float* Gv, int task0, int r, int h, int lane, bf16* qdf) {
    f32x4 a[4], b[4]; float e[4];
#pragma unroll
    for (int t = 0; t < 4; ++t) { const int task = task0 + t, rt = task >> 3, ks = task & 7, l = 32 * rt + r, k0 = 16 * ks + 4 * h;
        a[t] = ld4(qrows + (size_t)l * ldq + k0); b[t] = ld4(qrows + (size_t)l * ldq + k0 + 8); e[t] = __expf(Gv[l]); }
#pragma unroll
    for (int t = 0; t < 4; ++t) *(bf16x8*)(qdf + ((size_t)(task0 + t) * 64 + lane) * 8) = pack8(a[t].x * e[t], a[t].y * e[t], a[t].z * e[t], a[t].w * e[t], b[t].x * e[t], b[t].y * e[t], b[t].z * e[t], b[t].w * e[t]);
}
__device__ __forceinline__ void ke_frag_task(const LAS unsigned char* ket, int task, int r, int h, int lane, bf16* kef) {
    const int it = task >> 2, ks = task & 3, dk = 32 * it + r, l0 = 16 * ks + 4 * h;
    const v2u lo = *(const LAS v2u*)(ket + ((size_t)dk * 72 + l0) * 2), hi = *(const LAS v2u*)(ket + ((size_t)dk * 72 + l0 + 8) * 2);
    v4u w; w.x = lo.x; w.y = lo.y; w.z = hi.x; w.w = hi.y;
    *(v4u*)(kef + ((size_t)task * 64 + lane) * 8) = w;
}

#ifndef LAREP
#define LAREP 0
#endif
#define LDS_SYNC() do { asm volatile("s_waitcnt lgkmcnt(0)" ::: "memory"); __builtin_amdgcn_s_barrier(); asm volatile("" ::: "memory"); } while (0)
__device__ __forceinline__ void la_prep_phase(Frame& F, int l_unused) {
    const int tid0 = opq(F.tid), wv = F.wave;
    LAS unsigned char* L = F.lds + RING_OFF; asm volatile("" : "+v"(L));
    LAS float* Gv = (LAS float*)(L + LA_VEC); LAS float* Bv = Gv + 64;
    LAS float* Mf = (LAS float*)(L + LA_M);
    const f32x16 zero16 = {0.f, 0.f, 0.f, 0.f, 0.f, 0.f, 0.f, 0.f, 0.f, 0.f, 0.f, 0.f, 0.f, 0.f, 0.f, 0.f};
    for (int item = F.vcu; item < 512; item += F.G) {
        const int tid = opq(tid0), lane = tid & 63, r = lane & 31, h = lane >> 5;
        const int seq = item >> 5, ch = item & 31, b = seq >> 2, hd = seq & 3;
        const size_t t0 = (size_t)b * SEQ + ch * 64;
        const float* KN = wsf(F, WS_KN) + t0 * GW + hd * 128; const float* QN = wsf(F, WS_QN) + t0 * GW + hd * 128; const float* VV = wsf(F, WS_VV) + t0 * GW + hd * 128;
        unsigned char* rec = F.ws + WS_FG + (size_t)item * LA_RECG;
        const int c = tid & 127, lg = tid >> 7;
        const f32x2v gb = *(const f32x2v*)(wsf(F, WS_GB) + (t0 + lane) * 8 + 2 * hd);
        float kr[16], qr[16], vr[16];
#pragma unroll
        for (int i = 0; i < 16; ++i) { const int l = lg * 16 + i; kr[i] = KN[(size_t)l * GW + c]; qr[i] = QN[(size_t)l * GW + c]; vr[i] = VV[(size_t)l * GW + c]; }
        f32x4 qa[4], qb[4];
        { const int qw = (wv >= 2 && wv <= 5) ? wv - 2 : 0;
#pragma unroll
            for (int t = 0; t < 4; ++t) { const int task = 4 * qw + t, rt = task >> 3, ks = task & 7, l = 32 * rt + r, k0 = 16 * ks + 4 * h; qa[t] = ld4(QN + (size_t)l * GW + k0); qb[t] = ld4(QN + (size_t)l * GW + k0 + 8); } }
        if (wv == 0) { Gv[lane] = wave_incl_scan(gb.x, lane); Bv[lane] = gb.y; }
        LDS_SYNC();
        const float G63 = Gv[63];
#pragma unroll
        for (int i = 0; i < 16; ++i) { const int l = lg * 16 + i; const float kv = kr[i], qv = qr[i], vv = vr[i];
            const float Gl = Gv[l], bl = Bv[l];
            ((LAS bf16*)(L + LA_KB))[l * 136 + c] = (bf16)f2bf(kv); ((LAS bf16*)(L + LA_QB))[l * 136 + c] = (bf16)f2bf(qv);
            ((LAS bf16*)(L + LA_KGT))[c * 72 + l] = (bf16)f2bf(-kv * bl * __expf(Gl)); ((LAS bf16*)(L + LA_VBT))[c * 72 + l] = (bf16)f2bf(vv * bl);
            ((LAS bf16*)(L + LA_KET))[c * 72 + l] = (bf16)f2bf(kv * __expf(G63 - Gl)); }
        LDS_SYNC();
        if (wv < 4) { const int it = wv >> 1, jt = wv & 1; f32x16 acc = zero16;
            if (!(it == 0 && jt == 1)) {
#pragma unroll
                for (int ks = 0; ks < 8; ++ks) acc = MFMA32(lds_frag(L + LA_KB, 32 * it + r, 136, 16 * ks + 8 * h), lds_frag(L + LA_KB, 32 * jt + r, 136, 16 * ks + 8 * h), acc); }
            const int j = 32 * jt + r; const float Gj = Gv[j];
#pragma unroll
            for (int q = 0; q < 16; ++q) { const int i = 32 * it + crow(q, h); Mf[i * 68 + j] = (j < i) ? Bv[i] * acc[q] * __expf(Gv[i] - Gj) : 0.f; }
        } else { const int mt = (wv - 4) >> 1, rt = (wv - 4) & 1; f32x16 acc = zero16;
            if (!(mt == 1 && rt == 0)) {
#pragma unroll
                for (int ks = 0; ks < 8; ++ks) acc = MFMA32(lds_frag(L + LA_KB, 32 * mt + r, 136, 16 * ks + 8 * h), lds_frag(L + LA_QB, 32 * rt + r, 136, 16 * ks + 8 * h), acc); }
            store_qk_frag(acc, Gv, mt, rt, r, h, lane, (bf16*)(rec + LA_QK)); }
        LDS_SYNC();
        f32x16 Pacc = zero16;
        if (wv < 2) {
            const int ln = opq(lane), cc = ln & 31, bo = 32 * wv;
            float Tc[32];
#pragma unroll
            for (int i = 0; i < 32; ++i) {
                float a0 = (i == cc) ? 1.f : 0.f, a1 = 0.f, a2 = 0.f, a3 = 0.f;
#pragma unroll
                for (int j4 = 0; j4 < (i + 3) / 4; ++j4) { const f32x4 m = *(const LAS f32x4*)(Mf + (bo + i) * 68 + bo + 4 * j4);
                    a0 -= m.x * Tc[4 * j4]; if (4 * j4 + 1 < i) a1 -= m.y * Tc[4 * j4 + 1]; if (4 * j4 + 2 < i) a2 -= m.z * Tc[4 * j4 + 2]; if (4 * j4 + 3 < i) a3 -= m.w * Tc[4 * j4 + 3]; }
                Tc[i] = (a0 + a1) + (a2 + a3);
                ((LAS bf16*)(L + LA_TB))[(bo + i) * 72 + bo + cc] = (bf16)f2bf(Tc[i]);
                if (wv == 0) ((LAS bf16*)(L + LA_TB))[i * 72 + 32 + cc] = (bf16)0;
                if ((i & 7) == 7) asm volatile("" ::: "memory");
            }
            if (wv == 0) {
#pragma unroll
                for (int s2 = 0; s2 < 2; ++s2) {
                    const LAS float* mr = Mf + (32 + r) * 68 + 16 * s2 + 8 * h; const f32x4 m0 = *(const LAS f32x4*)mr, m1 = *(const LAS f32x4*)(mr + 4);
                    const bf16x8 af = pack8(m0.x, m0.y, m0.z, m0.w, m1.x, m1.y, m1.z, m1.w);
                    const bf16x8 bfr = h ? pack8(Tc[16 * s2 + 8], Tc[16 * s2 + 9], Tc[16 * s2 + 10], Tc[16 * s2 + 11], Tc[16 * s2 + 12], Tc[16 * s2 + 13], Tc[16 * s2 + 14], Tc[16 * s2 + 15])
                                          : pack8(Tc[16 * s2 + 0], Tc[16 * s2 + 1], Tc[16 * s2 + 2], Tc[16 * s2 + 3], Tc[16 * s2 + 4], Tc[16 * s2 + 5], Tc[16 * s2 + 6], Tc[16 * s2 + 7]);
                    Pacc = MFMA32(af, bfr, Pacc); }
                if (lane == 0) wsf(F, WS_DLG)[item] = __expf(G63);
            }
        } else if (wv <= 5) {
#pragma unroll
            for (int t = 0; t < 4; ++t) { const int task = 4 * (wv - 2) + t, rt = task >> 3; const float e = __expf(Gv[32 * rt + r]);
                *(bf16x8*)((bf16*)(rec + LA_QD) + ((size_t)task * 64 + lane) * 8) = pack8(qa[t].x * e, qa[t].y * e, qa[t].z * e, qa[t].w * e, qb[t].x * e, qb[t].y * e, qb[t].z * e, qb[t].w * e); }
        } else {
#pragma unroll
            for (int t = 0; t < 8; ++t) ke_frag_task(L + LA_KET, 8 * (wv - 6) + t, r, h, lane, (bf16*)(rec + LA_KE)); }
        LDS_SYNC();
        if (wv == 0) {
            f32x16 t21 = zero16;
#pragma unroll
            for (int s2 = 0; s2 < 2; ++s2) {
                const LAS unsigned char* tr = L + LA_TB + ((size_t)(32 + r) * 72 + 32 + 16 * s2 + 4 * h) * 2;
                const v2u lo = *(const LAS v2u*)tr, hi = *(const LAS v2u*)(tr + 16); v4u w; w.x = lo.x; w.y = lo.y; w.z = hi.x; w.w = hi.y;
                t21 = MFMA32(__builtin_bit_cast(bf16x8, w), PACK_STEP(Pacc, s2), t21); }
#pragma unroll
            for (int q = 0; q < 16; ++q) ((LAS bf16*)(L + LA_TB))[(32 + crow(q, h)) * 72 + r] = (bf16)f2bf(-t21[q]);
        }
        LDS_SYNC();
#pragma unroll 1
        for (int tile = wv; tile < 16; tile += 8) {
            f32x16 acc = zero16;
            if (tile < 8) { const int it = tile >> 1, rt = tile & 1;
#pragma unroll
                for (int ks = 0; ks < 4; ++ks) acc = MFMA32(lds_frag(L + LA_KGT, 32 * it + r, 72, 16 * ks + 8 * h), lds_frag(L + LA_TB, 32 * rt + r, 72, 16 * ks + 8 * h), acc);
                bf16* nw = (bf16*)(rec + LA_NW);
                *(bf16x8*)(nw + ((size_t)(rt * 8 + 2 * it + 0) * 64 + lane) * 8) = PACK_STEP(acc, 0);
                *(bf16x8*)(nw + ((size_t)(rt * 8 + 2 * it + 1) * 64 + lane) * 8) = PACK_STEP(acc, 1);
            } else { const int rt = (tile - 8) >> 2, dvt = (tile - 8) & 3;
#pragma unroll
                for (int ks = 0; ks < 4; ++ks) acc = MFMA32(lds_frag(L + LA_TB, 32 * rt + r, 72, 16 * ks + 8 * h), lds_frag(L + LA_VBT, 32 * dvt + r, 72, 16 * ks + 8 * h), acc);
                float* uc = (float*)(rec + LA_UCG) + ((size_t)(dvt * 2 + rt) * 4 * 64 + lane) * 4;
#pragma unroll
                for (int q4 = 0; q4 < 4; ++q4) *(f32x4*)(uc + (size_t)q4 * 256) = (f32x4){acc[4 * q4], acc[4 * q4 + 1], acc[4 * q4 + 2], acc[4 * q4 + 3]};
            }
        }
        LDS_SYNC();
    }
    for (int item = F.vcu; item < 256; item += F.G) {
        const int tid = opq(tid0), lane = tid & 63, r = lane & 31, h = lane >> 5;
        const int b = item >> 6, ch = (item >> 1) & 31, g = item & 1;
        const size_t t0 = (size_t)b * SEQ + ch * 64;
        const float* BS = wsf(F, WS_BS) + t0 * 256 + g * 128; const float* CS = wsf(F, WS_CS) + t0 * 256 + g * 128;
        const int c = tid & 127, lg = tid >> 7;
        float br[16], cr[16];
#pragma unroll
        for (int i = 0; i < 16; ++i) { const int l = lg * 16 + i; br[i] = BS[(size_t)l * 256 + c]; cr[i] = CS[(size_t)l * 256 + c]; }
        f32x2v ad[4];
#pragma unroll
        for (int hi = 0; hi < 4; ++hi) ad[hi] = *(const f32x2v*)(wsf(F, WS_DT) + (t0 + lane) * 16 + 2 * (4 * g + hi));
        f32x4 ca[4], cb[4]; float xv[4][16];
        const int sl = (wv >> 1) & 1, rt2 = wv & 1;
        {
#pragma unroll
            for (int t = 0; t < 4; ++t) { const int task = 4 * (wv & 3) + t, rt = task >> 3, ks = task & 7, l = 32 * rt + r, k0 = 16 * ks + 4 * h; ca[t] = ld4(CS + (size_t)l * 256 + k0); cb[t] = ld4(CS + (size_t)l * 256 + k0 + 8); }
#pragma unroll
            for (int hi = 0; hi < 4; ++hi)
#pragma unroll
                for (int q = 0; q < 16; ++q) xv[hi][q] = wsf(F, WS_XS)[(t0 + 32 * rt2 + crow(q, h)) * GW + (4 * g + hi) * 64 + 32 * sl + r]; }
#pragma unroll
        for (int i = 0; i < 16; ++i) { const int l = lg * 16 + i;
            ((LAS bf16*)(L + LA_KB))[l * 136 + c] = (bf16)f2bf(br[i]); ((LAS bf16*)(L + LA_QB))[l * 136 + c] = (bf16)f2bf(cr[i]); }
        if (wv == 0) {
#pragma unroll
            for (int hi = 0; hi < 4; ++hi) { Gv[hi * 64 + lane] = wave_incl_scan(ad[hi].x, lane); Gv[256 + hi * 64 + lane] = ad[hi].y; } }
        LDS_SYNC();
        f32x16 raw = zero16;
        const int mt = (wv >> 1) & 1, rt = wv & 1;
        if (wv < 4 && !(mt == 1 && rt == 0)) {
#pragma unroll
            for (int ks = 0; ks < 8; ++ks) raw = MFMA32(lds_frag(L + LA_KB, 32 * mt + r, 136, 16 * ks + 8 * h), lds_frag(L + LA_QB, 32 * rt + r, 136, 16 * ks + 8 * h), raw); }
#pragma unroll
        for (int hi = 0; hi < 4; ++hi) {
            const int hh = 4 * g + hi, seq = b * 8 + hh;
            unsigned char* rec = F.ws + WS_FS + ((size_t)seq * 32 + ch) * LA_RECS;
            const LAS float* Gh = Gv + hi * 64; const LAS float* Dh = Gv + 256 + hi * 64;
            const float G63 = Gh[63];
#pragma unroll
            for (int i = 0; i < 16; ++i) { const int l = lg * 16 + i; ((LAS bf16*)(L + LA_KET))[c * 72 + l] = (bf16)f2bf(br[i] * __expf(G63 - Gh[l])); }
            if (wv < 4) {
                store_qk_frag(raw, Gh, mt, rt, r, h, lane, (bf16*)(rec + LA_QK));
#pragma unroll
                for (int t = 0; t < 4; ++t) { const int task = 4 * wv + t, rtq = task >> 3; const float e = __expf(Gh[32 * rtq + r]);
                    *(bf16x8*)((bf16*)(rec + LA_QD) + ((size_t)task * 64 + lane) * 8) = pack8(ca[t].x * e, ca[t].y * e, ca[t].z * e, ca[t].w * e, cb[t].x * e, cb[t].y * e, cb[t].z * e, cb[t].w * e); }
            } else {
                float* uc = (float*)(rec + LA_UCS) + ((size_t)(sl * 2 + rt2) * 4 * 64 + lane) * 4;
#pragma unroll
                for (int q4 = 0; q4 < 4; ++q4) { f32x4 v;
#pragma unroll
                    for (int e = 0; e < 4; ++e) v[e] = xv[hi][4 * q4 + e] * Dh[32 * rt2 + crow(4 * q4 + e, h)];
                    *(f32x4*)(uc + (size_t)q4 * 256) = v; }
            }
            if (tid == 0) wsf(F, WS_DLS)[seq * 32 + ch] = __expf(G63);
            LDS_SYNC();
            if (wv >= 4) {
#pragma unroll
                for (int t = 0; t < 4; ++t) ke_frag_task(L + LA_KET, 4 * (wv - 4) + t, r, h, lane, (bf16*)(rec + LA_KE)); }
            LDS_SYNC();
        }
    }
}

constexpr int LA_HB = LDSCTL_OFF + 1024;
static_assert(LA_HB + 12 * 1024 <= LDS_BYTES, "hand-over area inside the LDS allocation");
template <bool HAS_W> __device__ __forceinline__ void la_seq_wg(LAS unsigned char* lds0  , const unsigned char* recs, int recsz, int uc_off, const float* dls, float* outp  , int slice, int lane, int wv) {
    constexpr int NFR = HAS_W ? 56 : 40;
    constexpr int SLOT = (NFR + 8) * 1024;
    LAS unsigned char* ring = lds0 + RING_OFF; LAS unsigned char* HB = lds0 + LA_HB + lane * 16;
    const int r = lane & 31, h = lane >> 5;
#define LA_DMA(c_, slot_) do { const unsigned char* rec_ = recs + (size_t)(c_) * recsz + lane * 16; LAS unsigned char* dst_ = ring + (slot_) * SLOT; \
        for (int f_ = wv - 2; f_ < NFR + 8; f_ += 6) { const unsigned char* src_ = (f_ < NFR) ? rec_ + f_ * 1024 : rec_ + uc_off + slice * 8192 + (f_ - NFR) * 1024; \
            __builtin_amdgcn_global_load_lds((const unsigned*)src_, (LAS unsigned*)(dst_ + f_ * 1024), 16, 0, 0); } } while (0)
#define LA_BAR() do { asm volatile("s_waitcnt lgkmcnt(0)" ::: "memory"); __builtin_amdgcn_s_barrier(); asm volatile("" ::: "memory"); } while (0)
#define FRAG(off, idx) (*(const LAS bf16x8*)(B + (off) + (idx) * 1024))
    if (wv >= 2) {
        LA_DMA(0, 0); asm volatile("s_waitcnt vmcnt(0)" ::: "memory");
        LA_BAR();
#pragma unroll 1
        for (int c = 0; c < 32; ++c) { if (c + 1 < 32) LA_DMA(c + 1, (c + 1) & 1); LA_BAR(); LA_BAR(); asm volatile("s_waitcnt vmcnt(0)" ::: "memory"); LA_BAR(); }
    } else if (wv == 0) {
        const float dlv = (lane < 32) ? dls[lane] : 0.f;
        f32x16 S[4];
#pragma unroll
        for (int it = 0; it < 4; ++it)
#pragma unroll
            for (int q = 0; q < 16; ++q) S[it][q] = 0.f;
        LA_BAR();
#pragma unroll 1
        for (int c = 0; c < 32; ++c) {
            const LAS unsigned char* B = ring + (c & 1) * SLOT + lane * 16;
            bf16x8 sb[8];
#pragma unroll
            for (int it = 0; it < 4; ++it) { sb[2 * it] = PACK_STEP(S[it], 0); sb[2 * it + 1] = PACK_STEP(S[it], 1); }
#pragma unroll
            for (int ks = 0; ks < 8; ++ks) *(LAS bf16x8*)(HB + ks * 1024) = sb[ks];
            LA_BAR();
            f32x16 Vn[2];
#pragma unroll
            for (int rt = 0; rt < 2; ++rt)
#pragma unroll
                for (int q4 = 0; q4 < 4; ++q4) { const f32x4 v = *(const LAS f32x4*)(B + NFR * 1024 + (rt * 4 + q4) * 1024); Vn[rt][4 * q4] = v.x; Vn[rt][4 * q4 + 1] = v.y; Vn[rt][4 * q4 + 2] = v.z; Vn[rt][4 * q4 + 3] = v.w; }
            if (HAS_W) {
#pragma unroll
                for (int ks = 0; ks < 8; ++ks) { Vn[0] = MFMA32(FRAG(LA_NW, 0 * 8 + ks), sb[ks], Vn[0]); Vn[1] = MFMA32(FRAG(LA_NW, 1 * 8 + ks), sb[ks], Vn[1]); } }
            bf16x8 vb[4];
#pragma unroll
            for (int rt = 0; rt < 2; ++rt) { vb[2 * rt] = PACK_STEP(Vn[rt], 0); vb[2 * rt + 1] = PACK_STEP(Vn[rt], 1); }
#pragma unroll
            for (int ks = 0; ks < 4; ++ks) *(LAS bf16x8*)(HB + 8192 + ks * 1024) = vb[ks];
            LA_BAR();
            const float dl = __builtin_bit_cast(float, __builtin_amdgcn_readlane(__builtin_bit_cast(int, dlv), c));
#pragma unroll
            for (int it = 0; it < 4; ++it) {
#pragma unroll
                for (int q = 0; q < 16; ++q) S[it][q] *= dl;
#pragma unroll
                for (int ks = 0; ks < 4; ++ks) S[it] = MFMA32(FRAG(LA_KE, it * 4 + ks), vb[ks], S[it]);
            }
            LA_BAR();
        }
    } else {
        LA_BAR();
#pragma unroll 1
        for (int c = 0; c < 32; ++c) {
            const LAS unsigned char* B = ring + (c & 1) * SLOT + lane * 16;
            LA_BAR();
            bf16x8 sb[8];
#pragma unroll
            for (int ks = 0; ks < 8; ++ks) sb[ks] = *(const LAS bf16x8*)(HB + ks * 1024);
            f32x16 O[2];
#pragma unroll
            for (int rt = 0; rt < 2; ++rt)
#pragma unroll
                for (int q = 0; q < 16; ++q) O[rt][q] = 0.f;
#pragma unroll
            for (int ks = 0; ks < 8; ++ks) { O[0] = MFMA32(FRAG(LA_QD, 0 * 8 + ks), sb[ks], O[0]); O[1] = MFMA32(FRAG(LA_QD, 1 * 8 + ks), sb[ks], O[1]); }
            LA_BAR();
            bf16x8 vb[4];
#pragma unroll
            for (int ks = 0; ks < 4; ++ks) vb[ks] = *(const LAS bf16x8*)(HB + 8192 + ks * 1024);
#pragma unroll
            for (int ks = 0; ks < 4; ++ks) { O[0] = MFMA32(FRAG(LA_QK, 0 * 4 + ks), vb[ks], O[0]); O[1] = MFMA32(FRAG(LA_QK, 1 * 4 + ks), vb[ks], O[1]); }
            float* op = outp + (size_t)c * 64 * GW + r;
#pragma unroll
            for (int rt = 0; rt < 2; ++rt)
#pragma unroll
                for (int q = 0; q < 16; ++q) op[(size_t)(32 * rt + crow(q, h)) * GW] = O[rt][q];
            LA_BAR();
        }
    }
#undef FRAG
#undef LA_DMA
#undef LA_BAR
}
__device__ __forceinline__ void la_seq_phase(Frame& F, int l_unused) {
    const int lane = opq(F.lane);
    for (int item = F.vcu; item < 128; item += F.G) {
        if (item < 64) { const int seq = item >> 2, slice = item & 3, b = seq >> 2, hd = seq & 3;
            la_seq_wg<true>(F.lds, F.ws + WS_FG + (size_t)seq * 32 * LA_RECG, LA_RECG, LA_UCG, wsf(F, WS_DLG) + seq * 32, wsf(F, WS_OG) + (size_t)b * SEQ * GW + hd * 128 + slice * 32, slice, lane, F.wave);
        } else { const int j = item - 64, seq = j >> 1, slice = j & 1, b = seq >> 3, hh = seq & 7;
            la_seq_wg<false>(F.lds, F.ws + WS_FS + (size_t)seq * 32 * LA_RECS, LA_RECS, LA_UCS, wsf(F, WS_DLS) + seq * 32, wsf(F, WS_YS) + (size_t)b * SEQ * GW + hh * 64 + slice * 32, slice, lane, F.wave);
        }
    }
}

__device__ __forceinline__ void mixer_post_phase(Frame& F, int l) {
    const int gw = F.vcu * NWAVES + F.wave, NGW = F.G * NWAVES, lane = opq(F.lane), c = lane * 8;
    bf16* MIX = wsb(F, WS_MIX);
    const float* gng = inp(I_GNG) + (size_t)l * 128 + (c & 127); const float* sng = inp(I_SNG) + (size_t)l * GW + c;
    const f32x4 g0 = ld4(gng), g1 = ld4(gng + 4), n0 = ld4(sng), n1 = ld4(sng + 4);
    const float Dk = inp(I_SD)[l * 8 + (c >> 6)];
    for (int m = gw; m < M; m += NGW) {
        {
            const float* og = wsf(F, WS_OG) + (size_t)m * GW + c; const f32x8 zz = ldu8(wsb(F, WS_ZG) + (size_t)m * GW + c);
            const f32x4 o0 = ld4(og), o1 = ld4(og + 4), z0 = zz.lo, z1 = zz.hi;
            float ss = (o0.x * o0.x + o0.y * o0.y) + (o0.z * o0.z + o0.w * o0.w) + (o1.x * o1.x + o1.y * o1.y) + (o1.z * o1.z + o1.w * o1.w);
            ss = row16_sum(ss);
            const float rstd = __builtin_amdgcn_rsqf(ss * (1.0f / 128.0f) + EPS);
            const f32x4 y0 = o0 * rstd * g0 * silu4(z0), y1 = o1 * rstd * g1 * silu4(z1);
            v4u w; w.x = pk2(y0.x, y0.y); w.y = pk2(y0.z, y0.w); w.z = pk2(y1.x, y1.y); w.w = pk2(y1.z, y1.w);
            *(v4u*)(MIX + (size_t)m * DM + 2 * GW + c) = w;
        }
        {
            const float* ys = wsf(F, WS_YS) + (size_t)m * GW + c; const float* xs = wsf(F, WS_XS) + (size_t)m * GW + c; const f32x8 zz = ldu8(wsb(F, WS_ZS) + (size_t)m * GW + c);
            const f32x4 a0 = (ld4(ys) + ld4(xs) * Dk) * silu4(zz.lo), a1 = (ld4(ys + 4) + ld4(xs + 4) * Dk) * silu4(zz.hi);
            float ss = (a0.x * a0.x + a0.y * a0.y) + (a0.z * a0.z + a0.w * a0.w) + (a1.x * a1.x + a1.y * a1.y) + (a1.z * a1.z + a1.w * a1.w);
            ss = row16_sum(ss); ss += shx(ss, 16, lane);
            const float rstd = __builtin_amdgcn_rsqf(ss * (1.0f / 256.0f) + EPS);
            const f32x4 y0 = a0 * rstd * n0, y1 = a1 * rstd * n1;
            v4u w; w.x = pk2(y0.x, y0.y); w.y = pk2(y0.z, y0.w); w.z = pk2(y1.x, y1.y); w.w = pk2(y1.z, y1.w);
            *(v4u*)(MIX + (size_t)m * DM + 3 * GW + c) = w;
        }
    }
}

constexpr int CW_PANEL = 8192;
static_assert((CW_PANEL + DEPTH * 3 * 32 * 64) * 4 <= (int)CTL_ZERO_BYTES && CW_BAR + XCD_BAR_WORDS <= CW_PANEL, "control words inside the memset region");
namespace pg8 {
struct EpiAny {
    static constexpr bool PERM = false, AFTER_DRAIN = false, RT_DRAIN = true;
    void* C; int ldc; int mode; float scale;
    unsigned char* ws; float* out; int lq, prow0;
    int nai;
    int rsrow0;
    __device__ __forceinline__ bool perm() const { return mode != 0; }
    __device__ __forceinline__ bool drain() const { return mode >= 3; }
    __device__ __forceinline__ void operator()(const f32x4 (&acc)[2][2][4][2], const Unit& u, int wr, int wc, int fr, int fq) const {
        if (mode == 3 || mode == 4) return;
        if (rsrow0 < 0) {
            if (mode == 0) { EpiF32 e{(float*)C, ldc}; e(acc, u, wr, wc, fr, fq); }
            else if (mode == 1) { EpiBf16S e{(bf16_t*)C, ldc, scale}; e(acc, u, wr, wc, fr, fq); }
            else { EpiSwiGLU e{(bf16_t*)C, ldc}; e(acc, u, wr, wc, fr, fq); }
            return; }
        const float* rs = (const float*)(ws + WS_RS) + rsrow0 + u.pm * BM + u.hm * HALF + wr * 64 + fr;
        const int row0 = u.pm * BM + u.hm * HALF + wr * 64 + fr;
#pragma unroll
        for (int ai = 0; ai < 2; ++ai) if (ai < nai)
#pragma unroll
            for (int m = 0; m < 4; ++m) { const float r = rs[ai * HALF + m * 16];
                if (mode == 1) { bf16_t* rowp = (bf16_t*)C + (size_t)(row0 + ai * HALF + m * 16) * ldc + u.pn * BM + wc * 32 + 8 * fq;
#pragma unroll
                    for (int bj = 0; bj < 2; ++bj) { const f32x4 v0 = acc[ai][bj][m][0] * r, v1 = acc[ai][bj][m][1] * r;
                        u32x4 w; w.x = cvt_pk_bf16(v0[0], v0[1]); w.y = cvt_pk_bf16(v0[2], v0[3]); w.z = cvt_pk_bf16(v1[0], v1[1]); w.w = cvt_pk_bf16(v1[2], v1[3]); *(u32x4*)(rowp + bj * HALF) = w; }
                } else { bf16_t* rowp = (bf16_t*)C + (size_t)(row0 + ai * HALF + m * 16) * ldc + u.pn * HALF + wc * 32 + 8 * fq;
                    const f32x4 g0 = acc[ai][0][m][0] * r, g1 = acc[ai][0][m][1] * r, u0 = acc[ai][1][m][0] * r, u1 = acc[ai][1][m][1] * r;
                    u32x4 w; w.x = cvt_pk_bf16(silu_f(g0[0]) * u0[0], silu_f(g0[1]) * u0[1]); w.y = cvt_pk_bf16(silu_f(g0[2]) * u0[2], silu_f(g0[3]) * u0[3]);
                    w.z = cvt_pk_bf16(silu_f(g1[0]) * u1[0], silu_f(g1[1]) * u1[1]); w.w = cvt_pk_bf16(silu_f(g1[2]) * u1[2], silu_f(g1[3]) * u1[3]); *(u32x4*)rowp = w; } }
    }
    __device__ __forceinline__ void fused(f32x4 (&acc)[2][2][4][2], const Unit& u, int wr, int wc, int fr, int fq, PG8_LAS unsigned char* lds, int wid, int lane) const {
        if (mode == 3) fused_softmax(acc, u, wr, wc, fr, fq, lds, wid, lane); else fused_resnorm(acc, u, wr, wc, fr, fq, lds, wid, lane);
    }
    __device__ __forceinline__ void fused_resnorm(f32x4 (&acc)[2][2][4][2], const Unit& u, int wr, int wc, int fr, int fq, PG8_LAS unsigned char* lds, int wid, int lane) const {
        const int D = 2048;
        {   bf16_t* Yw = (bf16_t*)(ws + WS_Y);
            const int row0 = prow0 + u.pm * BM + wr * 64 + fr, col0 = u.pn * BM + wc * 32 + 8 * fq;
#pragma unroll
            for (int ai = 0; ai < 2; ++ai)
#pragma unroll
                for (int m = 0; m < 4; ++m)
#pragma unroll
                    for (int bj = 0; bj < 2; ++bj) { const f32x4 v0 = acc[ai][bj][m][0], v1 = acc[ai][bj][m][1];
                        u32x4 w; w.x = cvt_pk_bf16(v0[0], v0[1]); w.y = cvt_pk_bf16(v0[2], v0[3]); w.z = cvt_pk_bf16(v1[0], v1[1]); w.w = cvt_pk_bf16(v1[2], v1[3]);
                        bf16_t* dst = Yw + (size_t)(row0 + ai * HALF + m * 16) * D + col0 + bj * HALF;
                        asm volatile("global_store_dwordx4 %0, %1, off sc1\n\ts_nop 1" :: "v"(dst), "v"(w) : "memory"); } }
        asm volatile("s_waitcnt vmcnt(0)" ::: "memory");
        __builtin_amdgcn_s_barrier(); asm volatile("" ::: "memory");
        const int l = lq / 3, rn = lq % 3;
        unsigned* pc = (unsigned*)(ws + WS_CTL) + CW_PANEL + (lq * 32 + (prow0 >> 8) + u.pm) * 64;
        const float* gpost = inp(I_NORMG) + (size_t)(l * N_NORMS + (rn == 0 ? MIX_POST : rn == 1 ? XA_POST : FFN_POST)) * D;
        const bool first = (lq == 0), last = (lq == 3 * DEPTH - 1);
        const float* xin32 = inp(I_X); bf16_t* xb = (bf16_t*)(ws + WS_XN); float* rsb = (float*)(ws + WS_RS);
        if (wid == 0) {
            if (lane == 0) __hip_atomic_fetch_add(pc, 1u, __ATOMIC_RELAXED, __HIP_MEMORY_SCOPE_AGENT);
            unsigned spins = 0;
            while ((unsigned)__builtin_amdgcn_readfirstlane(__hip_atomic_load(pc, __ATOMIC_RELAXED, __HIP_MEMORY_SCOPE_AGENT)) < 8u) { __builtin_amdgcn_s_sleep(2); if (++spins > (1u << 22)) break; }
            __builtin_amdgcn_fence(__ATOMIC_ACQUIRE, "agent");
            asm volatile("s_waitcnt vmcnt(0)" ::: "memory");
        }
        __builtin_amdgcn_s_barrier(); asm volatile("" ::: "memory");
        const bf16_t* Y = (const bf16_t*)(ws + WS_Y);
#define BFLO(wd) __builtin_bit_cast(float, (wd) << 16)
#define BFHI(wd) __builtin_bit_cast(float, (wd) & 0xffff0000u)
#pragma unroll 1
        for (int i = 0; i < 4; ++i) {
            const size_t mrow = (size_t)prow0 + u.pm * BM + u.pn * 32 + wid * 4 + i;
            f32x4 x[8]; u32x4 yw[4];
            { const u32x4* yr = (const u32x4*)(Y + mrow * D) + lane;
#pragma unroll
              for (int j = 0; j < 4; ++j) yw[j] = yr[64 * j];
              if (first) { const f32x4* xr = (const f32x4*)(xin32 + mrow * D) + 2 * lane;
#pragma unroll
                  for (int j = 0; j < 4; ++j) { x[2 * j] = xr[128 * j]; x[2 * j + 1] = xr[128 * j + 1]; }
              } else { const u32x4* xr = (const u32x4*)(xb + mrow * D) + lane;
#pragma unroll
                  for (int j = 0; j < 4; ++j) { const u32x4 w = xr[64 * j]; x[2 * j] = (f32x4){BFLO(w.x), BFHI(w.x), BFLO(w.y), BFHI(w.y)}; x[2 * j + 1] = (f32x4){BFLO(w.z), BFHI(w.z), BFLO(w.w), BFHI(w.w)}; } } }
            float s = 0.f;
#pragma unroll
            for (int j = 0; j < 4; ++j) { const u32x4 w = yw[j]; const float a0 = BFLO(w.x), a1 = BFHI(w.x), a2 = BFLO(w.y), a3 = BFHI(w.y), a4 = BFLO(w.z), a5 = BFHI(w.z), a6 = BFLO(w.w), a7 = BFHI(w.w);
                s += ((a0 * a0 + a1 * a1) + (a2 * a2 + a3 * a3)) + ((a4 * a4 + a5 * a5) + (a6 * a6 + a7 * a7)); }
            s = wave_sum(s);
            const float rstd = __builtin_amdgcn_rsqf(s * (1.0f / 2048.0f) + 1e-6f);
            float s2 = 0.f;
#pragma unroll
            for (int j = 0; j < 4; ++j) { const u32x4 w = yw[j];
                const f32x4 y0 = (f32x4){BFLO(w.x), BFHI(w.x), BFLO(w.y), BFHI(w.y)}, y1 = (f32x4){BFLO(w.z), BFHI(w.z), BFLO(w.w), BFHI(w.w)};
                const f32x4 g0 = ((const f32x4*)gpost)[2 * lane + 128 * j], g1 = ((const f32x4*)gpost)[2 * lane + 128 * j + 1];
                const f32x4 v0 = x[2 * j] + y0 * rstd * g0, v1 = x[2 * j + 1] + y1 * rstd * g1; x[2 * j] = v0; x[2 * j + 1] = v1;
                s2 += ((v0[0] * v0[0] + v0[1] * v0[1]) + (v0[2] * v0[2] + v0[3] * v0[3])) + ((v1[0] * v1[0] + v1[1] * v1[1]) + (v1[2] * v1[2] + v1[3] * v1[3])); }
            if (last) { f32x4* xo = (f32x4*)(out + mrow * D) + 2 * lane;
#pragma unroll
                for (int j = 0; j < 4; ++j) { xo[128 * j] = x[2 * j]; xo[128 * j + 1] = x[2 * j + 1]; }
            } else {
                s2 = wave_sum(s2);
                if (lane == 0) rsb[mrow] = __builtin_amdgcn_rsqf(s2 * (1.0f / 2048.0f) + 1e-6f);
                u32x4* o8 = (u32x4*)(xb + mrow * D) + lane;
#pragma unroll
                for (int j = 0; j < 4; ++j) { const f32x4 a = x[2 * j], b = x[2 * j + 1];
                    u32x4 w; w.x = cvt_pk_bf16(a[0], a[1]); w.y = cvt_pk_bf16(a[2], a[3]); w.z = cvt_pk_bf16(b[0], b[1]); w.w = cvt_pk_bf16(b[2], b[3]); o8[64 * j] = w; }
            }
        }
#undef BFLO
#undef BFHI
    }
    __device__ __forceinline__ void fused_softmax(f32x4 (&acc)[2][2][4][2], const Unit& u, int wr, int wc, int fr, int fq, PG8_LAS unsigned char* lds, int wid, int lane) const {
        { const float* rs = (const float*)(ws + WS_RS) + rsrow0 + u.pm * BM + u.hm * HALF + wr * 64 + fr;
#pragma unroll
          for (int ai = 0; ai < 2; ++ai) if (ai < nai)
#pragma unroll
            for (int m = 0; m < 4; ++m) { const float r = rs[ai * HALF + m * 16];
#pragma unroll
                for (int bj = 0; bj < 2; ++bj)
#pragma unroll
                    for (int n = 0; n < 2; ++n) acc[ai][bj][m][n] = acc[ai][bj][m][n] * r; } }
        PG8_LAS float* Pm = (PG8_LAS float*)lds;
        PG8_LAS float* Ps = (PG8_LAS float*)(lds + 4096);
#pragma unroll
        for (int ai = 0; ai < 2; ++ai) if (ai < nai)
#pragma unroll
            for (int m = 0; m < 4; ++m) { float mx = -3.0e38f;
#pragma unroll
                for (int bj = 0; bj < 2; ++bj)
#pragma unroll
                    for (int n = 0; n < 2; ++n) { const f32x4 x = acc[ai][bj][m][n]; mx = fmaxf(mx, fmaxf(fmaxf(x[0], x[1]), fmaxf(x[2], x[3]))); }
                mx = fmaxf(mx, shx(mx, 16, lane)); mx = fmaxf(mx, shx(mx, 32, lane));
                if (fq == 0) Pm[(ai * HALF + wr * 64 + m * 16 + fr) * 4 + wc] = mx; }
        asm volatile("s_waitcnt lgkmcnt(0)" ::: "memory"); __builtin_amdgcn_s_barrier(); asm volatile("" ::: "memory");
#pragma unroll
        for (int ai = 0; ai < 2; ++ai) if (ai < nai)
#pragma unroll
            for (int m = 0; m < 4; ++m) { const int row = ai * HALF + wr * 64 + m * 16 + fr; const f32x4 pm = *(const PG8_LAS f32x4*)(Pm + row * 4);
                const float mx = fmaxf(fmaxf(pm[0], pm[1]), fmaxf(pm[2], pm[3])); float sm = 0.f;
#pragma unroll
                for (int bj = 0; bj < 2; ++bj)
#pragma unroll
                    for (int n = 0; n < 2; ++n) { f32x4 x = acc[ai][bj][m][n]; x[0] = __expf(x[0] - mx); x[1] = __expf(x[1] - mx); x[2] = __expf(x[2] - mx); x[3] = __expf(x[3] - mx);
                        acc[ai][bj][m][n] = x; sm += (x[0] + x[1]) + (x[2] + x[3]); }
                sm += shx(sm, 16, lane); sm += shx(sm, 32, lane);
                if (fq == 0) Ps[row * 4 + wc] = sm; }
        asm volatile("s_waitcnt lgkmcnt(0)" ::: "memory"); __builtin_amdgcn_s_barrier(); asm volatile("" ::: "memory");
        const int row0 = u.pm * BM + u.hm * HALF + wr * 64 + fr, col0 = u.pn * BM + wc * 32 + 8 * fq;
#pragma unroll
        for (int ai = 0; ai < 2; ++ai) if (ai < nai)
#pragma unroll
            for (int m = 0; m < 4; ++m) { const int row = ai * HALF + wr * 64 + m * 16 + fr; const f32x4 ps = *(const PG8_LAS f32x4*)(Ps + row * 4);
                const float inv = __builtin_amdgcn_rcpf((ps[0] + ps[1]) + (ps[2] + ps[3]));
                bf16_t* rowp = (bf16_t*)C + (size_t)(row0 + ai * HALF + m * 16) * ldc + col0;
#pragma unroll
                for (int bj = 0; bj < 2; ++bj) { const f32x4 v0 = acc[ai][bj][m][0] * inv, v1 = acc[ai][bj][m][1] * inv;
                    u32x4 w; w.x = cvt_pk_bf16(v0[0], v0[1]); w.y = cvt_pk_bf16(v0[2], v0[3]); w.z = cvt_pk_bf16(v1[0], v1[1]); w.w = cvt_pk_bf16(v1[2], v1[3]);
                    *(u32x4*)(rowp + bj * HALF) = w; } }
    }
};
}

#ifndef SKIPM
#define SKIPM 0
#endif
#ifndef REPM
#define REPM 0
#endif
#ifndef GEMM_SP2
#define GEMM_SP2 true
#endif
#ifndef GEMM_ALIGN
#define GEMM_ALIGN true
#endif
#ifndef PROBE_PH
#define PROBE_PH -1
#endif
constexpr int PH_PER_LAYER = 10, PH0 = 2, N_PHASES = PH0 + DEPTH * PH_PER_LAYER;
struct Args { const float* in[N_IN]; float* out; unsigned char* ws; int ph_lo, ph_hi; };
static_assert(sizeof(Args) == (N_IN + 2) * 8 + 8, "Args has no padding");
struct GemmDesc { const bf16* A; const bf16* Bt; void* C; int M, N, K, lda, ldb, ldc, mode, corder, rn, prow0, rsrow0, lim, hbase; float scale; };
constexpr int NOUNIT = 1 << 24;
__device__ __forceinline__ int gemm_nsub(int ph, int k, int l) { return ph == 0 ? 0 : ph == 1 ? 1 : (k == 1 || k == 2 || k == 4) ? 0 : k == 3 ? 32 : (k == 6 || k == 7) ? BATCH : k == 8 ? 2 : 1; }
__device__ __forceinline__ int pmod(int x, int m) { const int r = x % m; return r < 0 ? r + m : r; }
__device__ __forceinline__ void kv_desc(const Frame& F, int l, int v0, GemmDesc& d) {
    d.A = wsb(F, WS_MEMN) + (size_t)l * MROWS * DM; d.Bt = (const bf16*)(F.ws + WS_W + (size_t)l * W_LAYER + WO_WKV); d.C = wsb(F, WS_KV) + (size_t)l * MROWS * 2 * DM;
    d.M = MROWS; d.N = 2 * DM; d.K = DM; d.lda = DM; d.ldb = DM; d.ldc = 2 * DM; d.mode = 1; d.corder = (F.vcu >= v0 && F.vcu < v0 + 64) ? F.vcu - v0 : NOUNIT;
}
__device__ __forceinline__ void gemm_desc(const Frame& F, int ph, int sub, GemmDesc& d) {
    const int bx = (int)blockIdx.x;
    d.scale = 1.0f; d.corder = bx; d.rn = -1; d.prow0 = 0; d.rsrow0 = -1; d.lim = -1; d.hbase = -1;
    if (ph == 1) { kv_desc(F, 0, 0, d); return; }
    const int l = (ph - PH0) / PH_PER_LAYER, k = (ph - PH0) % PH_PER_LAYER;
    if (k == 3) {
        const int which = sub & 1, h = (sub >> 1) & 3, b = (sub >> 3) & 3;
        const unsigned char* wl = F.ws + WS_W + (size_t)l * W_LAYER;
        const bf16* kv = wsb(F, WS_KV) + (size_t)l * MROWS * 2 * DM + (size_t)(b * MEML) * 2 * DM + h * XHD;
        const int nb = 128;
        d.K = XHD; d.mode = 1; d.corder = (F.vcu >= 128 && F.vcu < 128 + nb) ? pmod(F.vcu - 128 - 8 * sub, nb) : NOUNIT;
        if (which == 0) {
            d.A = kv; d.lda = 2 * DM; d.Bt = (const bf16*)(wl + WO_WQ) + h * XHD; d.ldb = DM; d.M = MEML; d.N = DM;
            d.C = wsb(F, WS_AT) + ((size_t)(l * BATCH + b) * 1024 + h * MEML) * DM; d.ldc = DM; d.scale = 0.044194173824159216f;
        } else {
            d.A = (const bf16*)(wl + WO_WO) + h * XHD; d.lda = DM; d.Bt = kv + DM; d.ldb = 2 * DM; d.M = DM; d.N = MEML;
            d.C = wsb(F, WS_VWT) + (size_t)(l * BATCH + b) * DM * 1024 + h * MEML; d.ldc = 1024;
        }
        return;
    }
    const unsigned char* wl = F.ws + WS_W + (size_t)l * W_LAYER;
    d.M = M; d.K = DM; d.N = DM; d.lda = DM; d.ldb = DM; d.ldc = DM; d.mode = 1; d.A = wsb(F, WS_XN); d.C = wsb(F, WS_Y);
    if (k == 0) { d.Bt = (const bf16*)(wl + WO_WIN); d.N = IN_PAD; d.C = wsb(F, WS_U); d.ldc = IN_PAD; d.mode = 1; d.rsrow0 = 0; }
    else if (k == 5) { d.A = wsb(F, WS_MIX); d.Bt = (const bf16*)(wl + WO_WOUT); d.mode = 4; d.rn = 0; }
    else if (k == 6) {
        const int b = sub; d.A = wsb(F, WS_XN) + (size_t)b * SEQ * DM; d.Bt = wsb(F, WS_AT) + (size_t)(l * BATCH + b) * 1024 * DM; d.M = SEQ; d.N = 1024;
        d.C = wsb(F, WS_P) + (size_t)b * SEQ * 1024; d.ldc = 1024; d.mode = 3; d.rsrow0 = b * SEQ; d.hbase = 0; d.corder = (bx + F.G - 64 * sub) % F.G; }
    else if (k == 7) {
        const int b = sub; d.A = wsb(F, WS_P) + (size_t)b * SEQ * 1024; d.lda = 1024; d.Bt = wsb(F, WS_VWT) + (size_t)(l * BATCH + b) * DM * 1024; d.ldb = 1024; d.M = SEQ; d.K = 1024;
        d.mode = 4; d.rn = 1; d.prow0 = b * SEQ; d.corder = (bx + F.G - 64 * sub) % F.G; }
    else if (k == 8) { if (sub == 1 && l == 0) { kv_desc(F, 1, 0, d); d.corder = (bx >= 128 && bx < 192) ? bx - 128 : NOUNIT; return; }
        d.Bt = (const bf16*)(wl + WO_WGU); d.N = 2 * DFF; d.mode = 2; d.C = wsb(F, WS_HID); d.ldc = DFF; d.rsrow0 = 0;
        if (l == 1) { if (sub == 0) d.lim = 1280; else d.hbase = 1280; } }
    else { d.A = wsb(F, WS_HID); d.Bt = (const bf16*)(wl + WO_WD); d.K = DFF; d.lda = DFF; d.ldb = DFF; d.mode = 4; d.rn = 2; }
}

__global__ void __launch_bounds__(NWAVES * 64, 2) fwd_kernel(Args args) {
    extern __shared__ __attribute__((aligned(16))) unsigned char lds[];
    Frame F;
    F.lds = (LAS unsigned char*)lds;
    F.MISC = (volatile LAS unsigned*)(F.lds + MISC_OFF);
    F.tid = threadIdx.x; F.lane = F.tid & 63; F.wave = __builtin_amdgcn_readfirstlane(F.tid >> 6);
    F.G = gridDim.x; { const int bx = blockIdx.x; F.vcu = (F.G % 8 == 0) ? (bx % 8) * (F.G / 8) + bx / 8 : bx; }
    F.ws = args.ws; F.out = args.out; F.ctl = (unsigned*)(args.ws + WS_CTL);
    for (int u = F.tid; u < (LDS_BYTES - LDSCTL_OFF) / 4; u += NWAVES * 64) ((LAS unsigned*)(F.lds + LDSCTL_OFF))[u] = 0u;
    __syncthreads();
    const int lo = args.ph_lo, hi = args.ph_hi;
    if (hi - lo > 1) (void)xcd_barrier_post(F.ctl + CW_BAR, F.MISC + 8);
#define GRID_BARRIER() do { XcdBarrier b_; b_.bar = F.ctl + CW_BAR; b_.x = xb_xcc_id(); b_.st = F.MISC + 8; xcd_barrier(b_); } while (0)
    LAS unsigned char* ring = F.lds + RING_OFF;
#if PROBE_PH >= 0
    unsigned long long t_start = __builtin_amdgcn_s_memrealtime(), t_probe = 0;
#endif
#pragma unroll 1
    for (int ph = lo; ph < hi; ++ph) {
        const int l = ph >= PH0 ? (ph - PH0) / PH_PER_LAYER : 0, k = ph >= PH0 ? (ph - PH0) % PH_PER_LAYER : -1;
        const int kbit = (ph < PH0) ? ph : (k + PH0);
        const int reps = 1 + ((REPM >> kbit) & 1);
#pragma unroll 1
        for (int rep = 0; rep < reps; ++rep) {
        if (ph < PH0) p0_prologue(F, ph);
        else if (k == 1) mixer_prep_phase(F, l);
        else if (k == 2) la_prep_phase(F, l);
        else if (k == 3) la_seq_phase(F, l);
        else if (k == 4) mixer_post_phase(F, l);
        const int nsub = gemm_nsub(ph, k, l);
#pragma unroll 1
        for (int sub = 0; sub < nsub; ++sub) {
            GemmDesc d; gemm_desc(F, ph, sub, d);
            pg8::Gemm g{d.A, d.Bt, d.M, d.N, d.K, d.lda, d.ldb}; pg8::StaticOrder S; S.init(d.M, d.N, F.G, d.corder); if (d.lim >= 0) S.lim = d.lim; S.hbase = d.hbase;
            pg8::EpiAny E{d.C, d.ldc, d.mode, d.scale, F.ws, F.out, l * 3 + d.rn, d.prow0, d.hbase >= 0 ? 1 : 2, d.rsrow0};
            if (d.hbase >= 0) pg8::gemm_phase<pg8::EpiAny, pg8::StaticOrder, GEMM_ALIGN, GEMM_SP2, true>(ring, g, S, E);
            else pg8::gemm_phase<pg8::EpiAny, pg8::StaticOrder, GEMM_ALIGN, GEMM_SP2, false>(ring, g, S, E);
        }
        if (REPM >> 20) { if (rep + 1 < reps) __syncthreads(); }
        }
        if ((REPM >> 21) & 1) GRID_BARRIER();
        if (ph + 1 < hi) GRID_BARRIER();
#if PROBE_PH >= 0
        if (ph == PROBE_PH) t_probe = __builtin_amdgcn_s_memrealtime();
#endif
    }
#if PROBE_PH >= 0
    if (blockIdx.x == 0) {
        const unsigned long long t_end = __builtin_amdgcn_s_memrealtime();
        while (__builtin_amdgcn_s_memrealtime() - t_end < t_probe - t_start) __builtin_amdgcn_s_sleep(8);
    }
#endif
}

#ifndef MK_SINGLE
#define MK_SINGLE 0
#endif
extern "C" void kernel_launch(void* const* d_in, const int* in_sizes, int n_in, void* d_out, int out_size, void* d_ws, size_t ws_size, hipStream_t stream) {
    static int grid = 0;
    if (grid == 0) {
        if (n_in != N_IN || in_sizes[0] != M * DM || out_size != M * DM || ws_size < WS_END) { fprintf(stderr, "kernel_launch: unexpected problem (n_in %d, in0 %d, out %d, ws %zu < %zu)\n", n_in, n_in > 0 ? in_sizes[0] : -1, out_size, ws_size, (size_t)WS_END); grid = -1; return; }
        int dev = 0, cus = 0, per_cu = 0;
        if (hipGetDevice(&dev) != hipSuccess || hipDeviceGetAttribute(&cus, hipDeviceAttributeMultiprocessorCount, dev) != hipSuccess) { grid = -1; return; }
        if (hipFuncSetAttribute((const void*)fwd_kernel, hipFuncAttributeMaxDynamicSharedMemorySize, LDS_BYTES) != hipSuccess) { fprintf(stderr, "kernel_launch: hipFuncSetAttribute failed\n"); grid = -1; return; }
        if (hipOccupancyMaxActiveBlocksPerMultiprocessor(&per_cu, (const void*)fwd_kernel, NWAVES * 64, LDS_BYTES) != hipSuccess || per_cu < 1) { fprintf(stderr, "kernel_launch: occupancy query says %d blocks per CU\n", per_cu); per_cu = 1; }
        (void)hipGetLastError();
        grid = cus * (per_cu < 1 ? 1 : 1);
        if (grid != 256) fprintf(stderr, "kernel_launch: note: grid %d (expected 256)\n", grid);
    }
    if (grid < 0) return;
    if (hipMemsetAsync((char*)d_ws + WS_CTL, 0, CTL_ZERO_BYTES, stream) != hipSuccess) { fprintf(stderr, "kernel_launch: memset failed\n"); return; }
    Args a{};
    for (int i = 0; i < N_IN; ++i) a.in[i] = (const float*)d_in[i];
    a.out = (float*)d_out; a.ws = (unsigned char*)d_ws;
#if MK_SINGLE
    a.ph_lo = 0; a.ph_hi = N_PHASES;
    void* kargs[] = {&a};
    hipError_t e = hipLaunchCooperativeKernel((const void*)fwd_kernel, dim3(grid), dim3(NWAVES * 64), kargs, LDS_BYTES, stream);
    if (e != hipSuccess) fprintf(stderr, "kernel_launch: cooperative launch failed: %s (grid %d)\n", hipGetErrorString(e), grid);
#else
    for (int p = 0; p < N_PHASES; ++p) { a.ph_lo = p; a.ph_hi = p + 1;
        hipLaunchKernelGGL(fwd_kernel, dim3(grid), dim3(NWAVES * 64), LDS_BYTES, stream, a);
        const hipError_t le = hipPeekAtLastError(); if (le != hipSuccess) { fprintf(stderr, "kernel_launch: launch %d failed: %s\n", p, hipGetErrorName(le)); break; } }
#endif
}
```

```cpp
#include <hip/hip_runtime.h>
#include <cstdio>
#include <cstdint>
#define MK_SINGLE 1
namespace pg8 {
#define PG8_LAS __attribute__((address_space(3)))
typedef unsigned short bf16_t;
typedef short bf16x8 __attribute__((ext_vector_type(8)));
typedef float f32x4 __attribute__((ext_vector_type(4)));
typedef unsigned u32x4 __attribute__((ext_vector_type(4)));
constexpr int BM = 256, BK = 64, HALF = 128, HTB = HALF * BK * 2  , STAGE_BYTES = 8 * HTB, NXCD = 8, WGM = 8;

__host__ __device__ __forceinline__ int lds_byte(int r, int c) { const int st = (r >> 4) * 2 + (c >> 5), rr = r & 15, cc = c & 31, ob = rr * 64 + cc * 2; return st * 1024 + (ob ^ (((ob >> 9) & 1) << 5)); }
__host__ __device__ __forceinline__ void stage_rc(int b, int& R, int& C) { const int st = b / 1024, sb = b % 1024, swz = sb ^ (((sb >> 9) & 1) << 5); R = (st >> 1) * 16 + swz / 64; C = (st & 1) * 32 + (swz % 64) / 2; }
__host__ __device__ __forceinline__ int perm32(int rho) { const int n = rho >> 4, i = rho & 15; return 8 * (i >> 2) + 4 * n + (i & 3); }

struct Unit { int pm, pn, hm; };
struct Gemm { const bf16_t* A; const bf16_t* Bt; int M, N, K, lda, ldb; };

struct StaticOrder {
    int nM, nN, nwg, G, c;
    int wgm;
    int lim, hbase;
    __host__ __device__ void init(int M, int N, int G_, int c_) { nM = M / BM; nN = N / BM; nwg = nM * nN; G = G_; c = c_; lim = nwg; hbase = -1; wgm = WGM; }
    __host__ __device__ bool next(int i, Unit& u) const {
        long L = (long)i * G + c; u.hm = 0;
        if (hbase >= 0) { if (L >= 2 * (long)(nwg - hbase)) return false; u.hm = (int)(L & 1); L = hbase + (L >> 1); }
        else if (L >= lim) return false;
        int wgid = (int)L; { const int q = nwg / NXCD, r = nwg % NXCD, xcd = wgid % NXCD, off = wgid / NXCD; wgid = (xcd < r ? xcd * (q + 1) : r * (q + 1) + (xcd - r) * q) + off; }
        const int nig = wgm * nN, gid = wgid / nig, fm = gid * wgm, gsz = (nM - fm) < wgm ? (nM - fm) : wgm;
        u.pm = fm + ((wgid % nig) % gsz); u.pn = (wgid % nig) / gsz; return true;
    }
    __device__ __forceinline__ void a_ready(const Unit&) const {}
    __device__ __forceinline__ void done(const Unit&) const {}
};

__device__ __forceinline__ unsigned cvt_pk_bf16(float lo, float hi) { unsigned r; asm volatile("v_cvt_pk_bf16_f32 %0, %1, %2" : "=v"(r) : "v"(lo), "v"(hi)); return r; }
struct EpiF32 {
    static constexpr bool PERM = false, AFTER_DRAIN = false;
    float* C; int ldc;
    __device__ __forceinline__ void operator()(const f32x4 (&acc)[2][2][4][2], const Unit& u, int wr, int wc, int fr, int fq) const {
        const int row0 = u.pm * BM + wr * 64 + fr, col0 = u.pn * BM + wc * 32 + 4 * fq;
#pragma unroll
        for (int ai = 0; ai < 2; ++ai)
#pragma unroll
            for (int m = 0; m < 4; ++m) { float* rowp = C + (size_t)(row0 + ai * HALF + m * 16) * ldc + col0;
#pragma unroll
                for (int bj = 0; bj < 2; ++bj)
#pragma unroll
                    for (int n = 0; n < 2; ++n) *(f32x4*)(rowp + bj * HALF + n * 16) = acc[ai][bj][m][n]; }
    }
};
struct EpiBf16S {
    static constexpr bool PERM = true, AFTER_DRAIN = false;
    bf16_t* O; int ldc; float scale;
    __device__ __forceinline__ void operator()(const f32x4 (&acc)[2][2][4][2], const Unit& u, int wr, int wc, int fr, int fq) const {
        const int row0 = u.pm * BM + wr * 64 + fr, col0 = u.pn * BM + wc * 32 + 8 * fq; const float sc = scale;
#pragma unroll
        for (int ai = 0; ai < 2; ++ai)
#pragma unroll
            for (int m = 0; m < 4; ++m) { bf16_t* rowp = O + (size_t)(row0 + ai * HALF + m * 16) * ldc + col0;
#pragma unroll
                for (int bj = 0; bj < 2; ++bj) { const f32x4 v0 = acc[ai][bj][m][0] * sc, v1 = acc[ai][bj][m][1] * sc;
                    u32x4 w; w.x = cvt_pk_bf16(v0[0], v0[1]); w.y = cvt_pk_bf16(v0[2], v0[3]); w.z = cvt_pk_bf16(v1[0], v1[1]); w.w = cvt_pk_bf16(v1[2], v1[3]);
                    *(u32x4*)(rowp + bj * HALF) = w; } }
    }
};
__device__ __forceinline__ float silu_f(float v) { return v * __builtin_amdgcn_rcpf(1.0f + __expf(-v)); }
struct EpiSwiGLU {
    static constexpr bool PERM = true, AFTER_DRAIN = false;
    bf16_t* O; int ldc;
    __device__ __forceinline__ void operator()(const f32x4 (&acc)[2][2][4][2], const Unit& u, int wr, int wc, int fr, int fq) const {
        const int row0 = u.pm * BM + wr * 64 + fr, col0 = u.pn * HALF + wc * 32 + 8 * fq;
#pragma unroll
        for (int ai = 0; ai < 2; ++ai)
#pragma unroll
            for (int m = 0; m < 4; ++m) { bf16_t* rowp = O + (size_t)(row0 + ai * HALF + m * 16) * ldc + col0;
                const f32x4 g0 = acc[ai][0][m][0], g1 = acc[ai][0][m][1], u0 = acc[ai][1][m][0], u1 = acc[ai][1][m][1];
                u32x4 w; w.x = cvt_pk_bf16(silu_f(g0[0]) * u0[0], silu_f(g0[1]) * u0[1]); w.y = cvt_pk_bf16(silu_f(g0[2]) * u0[2], silu_f(g0[3]) * u0[3]);
                w.z = cvt_pk_bf16(silu_f(g1[0]) * u1[0], silu_f(g1[1]) * u1[1]); w.w = cvt_pk_bf16(silu_f(g1[2]) * u1[2], silu_f(g1[3]) * u1[3]);
                *(u32x4*)rowp = w; }
    }
};
template <class Epi, class Sched, bool ALIGN_EPI = false, bool SP2 = false, bool HM = false>
__device__ __forceinline__ void gemm_phase(PG8_LAS unsigned char* lds, const Gemm g, const Sched& S, const Epi& E) {
    int tid_ = threadIdx.x; asm volatile("" : "+v"(tid_));
    const int tid = tid_, wid = __builtin_amdgcn_readfirstlane(tid >> 6), lane = tid & 63, wr = wid >> 2, wc = wid & 3, fr = lane & 15, fq = lane >> 4;
    static_assert(!HM || SP2, "half-M units: SP2 loop only");
    const int K = g.K, nt = K / BK;
    unsigned voffA[2], voffB[2];
#pragma unroll
    for (int i = 0; i < 2; ++i) { int R, C; stage_rc(tid * 16 + i * 8192, R, C); const int Rb = E.perm() ? ((R & ~31) + perm32(R & 31)) : R;
        voffA[i] = (unsigned)(R * g.lda + C) * 2u; voffB[i] = (unsigned)(Rb * g.ldb + C) * 2u; }
    const size_t kstep = (size_t)(BK * 2);
    const size_t hstepA = (size_t)HALF * g.lda * 2, hstepB = (size_t)HALF * g.ldb * 2;
    const size_t tstepA = 2 * hstepA, tstepB = 2 * hstepB;
    const unsigned ldsw = (unsigned)wid * 1024u;
    const int aoff = lds_byte(wr * 64 + fr, fq * 8), boff = lds_byte(wc * 32 + fr, fq * 8);
#define PG8_SA(b, h) (((b) * 2 + (h)) * HTB)
#define PG8_SB(b, h) ((4 + (b) * 2 + (h)) * HTB)
#define PG8_STAGE(bufoff, gbase, voff) do { _Pragma("unroll") for (int _i = 0; _i < 2; ++_i) \
        __builtin_amdgcn_global_load_lds((const unsigned*)((const char*)(gbase) + (voff)[_i]), (PG8_LAS unsigned*)(lds + (bufoff) + ldsw + _i * 8192), 16, 0, 0); } while (0)
#define PG8_LDA(dst, b, h) do { _Pragma("unroll") for (int m = 0; m < 4; ++m) _Pragma("unroll") for (int k = 0; k < 2; ++k) dst[m][k] = *(const PG8_LAS bf16x8*)(lds + PG8_SA(b, h) + aoff + m * 2048 + k * 1024); } while (0)
#define PG8_LDB(dst, b, h) do { _Pragma("unroll") for (int n = 0; n < 2; ++n) _Pragma("unroll") for (int k = 0; k < 2; ++k) dst[n][k] = *(const PG8_LAS bf16x8*)(lds + PG8_SB(b, h) + boff + n * 2048 + k * 1024); } while (0)
#define PG8_MMA(ai, bj, At, Bt) do { __builtin_amdgcn_s_setprio(1); _Pragma("unroll") for (int m = 0; m < 4; ++m) _Pragma("unroll") for (int n = 0; n < 2; ++n) _Pragma("unroll") for (int k = 0; k < 2; ++k) \
        acc[ai][bj][m][n] = __builtin_amdgcn_mfma_f32_16x16x32_bf16(Bt[n][k], At[m][k], acc[ai][bj][m][n], 0, 0, 0); __builtin_amdgcn_s_setprio(0); } while (0)
#define PG8_WAIT_V(n) asm volatile("s_waitcnt vmcnt(" #n ")" ::: "memory")
#define PG8_WAIT_L(n) asm volatile("s_waitcnt lgkmcnt(" #n ")" ::: "memory")
#define PG8_BAR __builtin_amdgcn_s_barrier()
#define PG8_SCHED __builtin_amdgcn_sched_barrier(0)
    Unit cur, nxt; int ui = 0;
    if (!S.next(0, cur)) return;
    f32x4 acc[2][2][4][2];
#pragma unroll
    for (int a = 0; a < 2; ++a)
#pragma unroll
        for (int b = 0; b < 2; ++b)
#pragma unroll
            for (int m = 0; m < 4; ++m)
#pragma unroll
                for (int n = 0; n < 2; ++n) acc[a][b][m][n] = (f32x4){0.f, 0.f, 0.f, 0.f};
    bf16x8 At[4][2], B0[2][2], B1[2][2];
#pragma unroll
    for (int m = 0; m < 4; ++m)
#pragma unroll
        for (int k = 0; k < 2; ++k) asm volatile("" : "=v"(At[m][k]));
#pragma unroll
    for (int n = 0; n < 2; ++n)
#pragma unroll
        for (int k = 0; k < 2; ++k) { asm volatile("" : "=v"(B0[n][k])); asm volatile("" : "=v"(B1[n][k])); }
    const char* cA = (const char*)g.A + (size_t)cur.pm * tstepA + (HM ? (size_t)cur.hm * hstepA : 0); const char* cB = (const char*)g.Bt + (size_t)cur.pn * tstepB;
    S.a_ready(cur);
    if constexpr (SP2) {
        PG8_STAGE(PG8_SB(0, 0), cB, voffB); PG8_STAGE(PG8_SB(0, 1), cB + hstepB, voffB); PG8_STAGE(PG8_SA(0, 0), cA, voffA); if constexpr (!HM) PG8_STAGE(PG8_SA(0, 1), cA + hstepA, voffA);
        if (wr == 1) PG8_BAR;
        if constexpr (HM) PG8_WAIT_V(0); else PG8_WAIT_V(2);
        PG8_BAR;
        PG8_STAGE(PG8_SB(1, 0), cB + kstep, voffB); PG8_STAGE(PG8_SA(1, 0), cA + kstep, voffA); PG8_STAGE(PG8_SB(1, 1), cB + hstepB + kstep, voffB);
        PG8_WAIT_V(6); PG8_BAR;
    } else {
        PG8_STAGE(PG8_SB(0, 0), cB, voffB); PG8_STAGE(PG8_SA(0, 0), cA, voffA); PG8_STAGE(PG8_SB(0, 1), cB + hstepB, voffB); PG8_STAGE(PG8_SA(0, 1), cA + hstepA, voffA);
        if (wr == 1) PG8_BAR;
        PG8_WAIT_V(4); PG8_BAR;
        PG8_STAGE(PG8_SB(1, 0), cB + kstep, voffB); PG8_STAGE(PG8_SA(1, 0), cA + kstep, voffA); PG8_STAGE(PG8_SB(1, 1), cB + hstepB + kstep, voffB);
        PG8_WAIT_V(6); PG8_BAR;
    }
    for (;;) {
        const bool has_next = S.next(ui + 1, nxt);
        const char* nA = has_next ? (const char*)g.A + (size_t)nxt.pm * tstepA + (HM ? (size_t)nxt.hm * hstepA : 0) : cA; const char* nB = has_next ? (const char*)g.Bt + (size_t)nxt.pn * tstepB : cB;
        for (int t = 0; t < nt; t += 2) {
            const bool last = (t == nt - 2);
            const char* a1 = cA + (size_t)(t + 1) * kstep;
            const char* a2 = last ? nA : cA + (size_t)(t + 2) * kstep; const char* b2 = last ? nB : cB + (size_t)(t + 2) * kstep;
            const char* a3 = a2 + kstep; const char* b3 = b2 + kstep;
            if (last && has_next) S.a_ready(nxt);
            if constexpr (SP2) {
            PG8_LDB(B0, 0, 0); PG8_LDB(B1, 0, 1); PG8_SCHED; PG8_LDA(At, 0, 0); if constexpr (!HM) PG8_STAGE(PG8_SA(1, 1), a1 + hstepA, voffA);
            PG8_WAIT_V(8); PG8_WAIT_L(0); PG8_BAR; PG8_MMA(0, 0, At, B0); PG8_MMA(0, 1, At, B1); PG8_BAR; PG8_SCHED;
            if constexpr (!HM) PG8_LDA(At, 0, 1);
            PG8_STAGE(PG8_SB(0, 0), b2, voffB); PG8_STAGE(PG8_SB(0, 1), b2 + hstepB, voffB); PG8_STAGE(PG8_SA(0, 0), a2, voffA);
            if constexpr (HM) PG8_WAIT_V(6); else PG8_WAIT_V(8);
            PG8_WAIT_L(0); PG8_BAR; if constexpr (!HM) { PG8_MMA(1, 0, At, B0); PG8_MMA(1, 1, At, B1); } PG8_BAR; PG8_SCHED;
            PG8_LDB(B0, 1, 0); PG8_LDB(B1, 1, 1); PG8_SCHED; PG8_LDA(At, 1, 0); if constexpr (!HM) PG8_STAGE(PG8_SA(0, 1), a2 + hstepA, voffA);
            PG8_WAIT_V(8); PG8_WAIT_L(0); PG8_BAR; PG8_MMA(0, 0, At, B0); PG8_MMA(0, 1, At, B1); PG8_BAR; PG8_SCHED;
            if constexpr (!HM) PG8_LDA(At, 1, 1);
            PG8_STAGE(PG8_SB(1, 0), b3, voffB); PG8_STAGE(PG8_SB(1, 1), b3 + hstepB, voffB); PG8_STAGE(PG8_SA(1, 0), a3, voffA);
            if constexpr (HM) PG8_WAIT_V(6); else PG8_WAIT_V(8);
            PG8_WAIT_L(0); PG8_BAR; if constexpr (!HM) { PG8_MMA(1, 0, At, B0); PG8_MMA(1, 1, At, B1); } PG8_BAR; PG8_SCHED;
            } else {
            PG8_LDB(B0, 0, 0); PG8_SCHED; PG8_LDA(At, 0, 0); PG8_STAGE(PG8_SA(1, 1), a1 + hstepA, voffA);
            PG8_WAIT_L(8); PG8_BAR; PG8_WAIT_L(0); PG8_MMA(0, 0, At, B0); PG8_BAR; PG8_SCHED;
            PG8_LDB(B1, 0, 1); PG8_STAGE(PG8_SB(0, 0), b2, voffB);
            PG8_BAR; PG8_WAIT_L(0); PG8_MMA(0, 1, At, B1); PG8_BAR;
            PG8_LDA(At, 0, 1); PG8_STAGE(PG8_SA(0, 0), a2, voffA);
            PG8_BAR; PG8_WAIT_L(0); PG8_MMA(1, 0, At, B0); PG8_BAR; PG8_SCHED;
            PG8_STAGE(PG8_SB(0, 1), b2 + hstepB, voffB);
            PG8_WAIT_V(6); PG8_BAR; PG8_MMA(1, 1, At, B1); PG8_BAR;
            PG8_LDB(B0, 1, 0); PG8_SCHED; PG8_LDA(At, 1, 0); PG8_STAGE(PG8_SA(0, 1), a2 + hstepA, voffA);
            PG8_WAIT_L(8); PG8_BAR; PG8_WAIT_L(0); PG8_MMA(0, 0, At, B0); PG8_BAR; PG8_SCHED;
            PG8_LDB(B1, 1, 1); PG8_STAGE(PG8_SB(1, 0), b3, voffB);
            PG8_BAR; PG8_WAIT_L(0); PG8_MMA(0, 1, At, B1); PG8_BAR;
            PG8_LDA(At, 1, 1); PG8_STAGE(PG8_SA(1, 0), a3, voffA);
            PG8_BAR; PG8_WAIT_L(0); PG8_MMA(1, 0, At, B0); PG8_BAR; PG8_SCHED;
            PG8_STAGE(PG8_SB(1, 1), b3 + hstepB, voffB);
            PG8_WAIT_V(6); PG8_BAR; PG8_MMA(1, 1, At, B1); PG8_BAR;
            }
        }
        if constexpr (ALIGN_EPI) { if (wr == 0) PG8_BAR; }
        if constexpr (!Epi::AFTER_DRAIN) { E(acc, cur, wr, wc, fr, fq); S.done(cur); }
        if (!has_next) break;
#pragma unroll
        for (int a = 0; a < 2; ++a)
#pragma unroll
            for (int b = 0; b < 2; ++b)
#pragma unroll
                for (int m = 0; m < 4; ++m)
#pragma unroll
                    for (int n = 0; n < 2; ++n) acc[a][b][m][n] = (f32x4){0.f, 0.f, 0.f, 0.f};
        cur = nxt; cA = nA; cB = nB; ++ui;
        if constexpr (ALIGN_EPI) { if (wr == 1) PG8_BAR; }
    }
    PG8_WAIT_V(0);
    if constexpr (!ALIGN_EPI) { if (wr == 0) PG8_BAR; }
    PG8_BAR;
    if constexpr (Epi::AFTER_DRAIN) { E.fused(acc, cur, wr, wc, fr, fq, lds, wid, lane); S.done(cur); }
    if constexpr (Epi::RT_DRAIN) { if (E.drain()) E.fused(acc, cur, wr, wc, fr, fq, lds, wid, lane); }
#undef PG8_SA
#undef PG8_SB
#undef PG8_STAGE
#undef PG8_LDA
#undef PG8_LDB
#undef PG8_MMA
#undef PG8_WAIT_V
#undef PG8_WAIT_L
#undef PG8_BAR
#undef PG8_SCHED
}
}
constexpr int NWAVES = 8;
constexpr int BATCH = 4, SEQ = 2048, DM = 2048, DEPTH = 2;
constexpr int M = BATCH * SEQ;
constexpr int GW = 512;
constexpr int IN_COLS = 5648, IN_PAD = 5888;
constexpr int DFF = 5632, MEML = 256, XH = 4, XHD = 512;
constexpr int MROWS = BATCH * MEML;
constexpr float EPS = 1e-6f;
constexpr int UA_B = 0, UA_C = 512, UA_H = 1024, UB = 1536, UC_Q = 2048, UC_Z = 3584, UC_A = 4096, UC_B = 4100, UD_Z = 4104, UD_X = 4616, UD_DT = 5640;
constexpr int MIX_PRE = 0, MIX_POST = 1, XA_PRE = 2, XA_POST = 3, MEM_NORM = 4, FFN_PRE = 5, FFN_POST = 6, N_NORMS = 7;
enum { I_X = 0, I_MEM, I_NORMG, I_WIN, I_CONVA, I_POOLW, I_POOLS, I_GCONV, I_GALOG, I_GDTB, I_GNG, I_SCONVW, I_SCONVB, I_SALOG, I_SDTB, I_SD, I_SNG, I_WOUT, I_WQ, I_WKV, I_WO, I_WGU, I_WD, N_IN };

constexpr size_t MiB = 1u << 20;
constexpr size_t WS_SS1 = 128 * 1024;
constexpr size_t WS_SSA = WS_SS1 + (size_t)6 * 8192 * 8;
constexpr size_t WS_CTL = 0, CTL_ZERO_BYTES = 32768;
constexpr float SS_FIX = 16777216.0f, SS_UNFIX = 1.0f / 16777216.0f;
constexpr size_t WSZ_WIN = (size_t)IN_PAD * DM * 2, WSZ_SQ = (size_t)DM * DM * 2, WSZ_KV = (size_t)2 * DM * DM * 2, WSZ_GU = (size_t)2 * DFF * DM * 2, WSZ_D = (size_t)DM * DFF * 2;
constexpr size_t WO_WIN = 0, WO_WOUT = WO_WIN + WSZ_WIN, WO_WQ = WO_WOUT + WSZ_SQ, WO_WKV = WO_WQ + WSZ_SQ, WO_WO = WO_WKV + WSZ_KV, WO_WGU = WO_WO + WSZ_SQ, WO_WD = WO_WGU + WSZ_GU, W_LAYER = WO_WD + WSZ_D;
constexpr size_t WS_W = 1 * MiB;
constexpr size_t WS_XN = WS_W + 2 * W_LAYER;
constexpr size_t WS_MIX = WS_XN + (size_t)M * DM * 2;
constexpr size_t WS_MEMN = WS_MIX + (size_t)M * DM * 2;
constexpr size_t WS_KV = WS_MEMN + (size_t)2 * MROWS * DM * 2;
constexpr size_t WS_U = WS_KV + (size_t)2 * MROWS * 2 * DM * 2;
constexpr size_t WS_P = WS_U, WS_HID = WS_U + (size_t)M * DM * 2;
constexpr size_t WS_UEND = WS_U + (size_t)120 * MiB;
constexpr size_t WS_ZG = WS_UEND, WS_ZS = WS_ZG + (size_t)M * 512 * 2, WS_BS = WS_ZS + (size_t)M * 512 * 2, WS_CS = WS_BS + (size_t)M * 256 * 4;
constexpr size_t WS_SCR = WS_CS + (size_t)M * 256 * 4;
constexpr size_t WS_Y = WS_SCR;
constexpr size_t SZ512 = (size_t)M * 512 * 4, SZ256 = (size_t)M * 256 * 4, SZ8 = (size_t)M * 8 * 4;
constexpr size_t WS_QN = WS_SCR, WS_KN = WS_QN + SZ512, WS_VV = WS_KN + SZ512, WS_OG = WS_VV + SZ512, WS_XS = WS_OG + SZ512, WS_YS = WS_XS + SZ512,
                 WS_GB = WS_YS + SZ512, WS_DT = WS_GB + SZ8, WS_SCR_END = WS_DT + 2 * SZ8;
constexpr size_t WS_RS = WS_SCR_END;
constexpr size_t WS_PWT = WS_RS + (size_t)M * 4;
constexpr size_t WS_AT = WS_PWT + (size_t)DEPTH * 4 * 128 * 128 * 2, WS_VWT = WS_AT + (size_t)DEPTH * BATCH * 1024 * DM * 2, WS_END = WS_VWT + (size_t)DEPTH * BATCH * DM * 1024 * 2;
constexpr int LA_QD = 0, LA_QK = 16384, LA_KE = 24576, LA_NW = 40960, LA_UCG = 57344, LA_RECG = 90112;
constexpr int LA_UCS = 40960, LA_RECS = 57344;
constexpr size_t WS_FG = WS_U, WS_FS = WS_FG + (size_t)512 * LA_RECG, WS_DLG = WS_FS + (size_t)1024 * LA_RECS, WS_DLS = WS_DLG + 512 * 4, WS_FEND = WS_DLS + 1024 * 4;
static_assert(WS_FEND <= WS_UEND, "records inside U");
static_assert(WS_Y + (size_t)M * DM * 4 <= WS_SCR_END, "Y inside the scan region");
static_assert(WS_HID + (size_t)M * DFF * 2 <= WS_UEND && (size_t)M * IN_PAD * 2 <= (size_t)120 * MiB, "HID and U inside the U region");
static_assert(WS_END <= (size_t)704 * MiB, "d_ws map fits 4 x the largest input");

constexpr int RING_OFF = 0, RING_BYTES = 131072;
constexpr int LDSCTL_OFF = RING_BYTES, MISC_OFF = LDSCTL_OFF + 320;
constexpr int LDS_BYTES = 147456;
constexpr int CW_BAR = 4096;

#define GAS __attribute__((address_space(1)))
#define LAS __attribute__((address_space(3)))
typedef unsigned short bf16;
typedef unsigned v4u __attribute__((ext_vector_type(4)));
typedef unsigned v2u __attribute__((ext_vector_type(2)));
typedef float f32x4 __attribute__((ext_vector_type(4)));
typedef short bf16x8 __attribute__((ext_vector_type(8)));
#define LDS_WAIT() asm volatile("s_waitcnt lgkmcnt(0)" ::: "memory")
#define VM_WAIT() asm volatile("s_waitcnt vmcnt(0)" ::: "memory")
typedef float f32x2v __attribute__((ext_vector_type(2)));
typedef __bf16 bf16x2_t __attribute__((ext_vector_type(2)));
__device__ __forceinline__ unsigned cvtpk(float lo, float hi) { const f32x2v v = {lo, hi}; return __builtin_bit_cast(unsigned, __builtin_convertvector(v, bf16x2_t)); }
__device__ __forceinline__ unsigned pk2(float lo, float hi) { return cvtpk(lo, hi); }
__device__ __forceinline__ unsigned f2bf(float f) { return cvtpk(f, 0.f) & 0xffffu; }
__device__ __forceinline__ float siluf(float v) { return v * __builtin_amdgcn_rcpf(1.0f + __expf(-v)); }
__device__ __forceinline__ float softplusf(float v) { return fmaxf(v, 0.f) + __logf(1.0f + __expf(-fabsf(v))); }
__device__ __forceinline__ float sigmoidf(float v) { return __builtin_amdgcn_rcpf(1.0f + __expf(-v)); }
__device__ __forceinline__ f32x4 ld4(const float* p) { return *(const f32x4*)p; }
__device__ __forceinline__ f32x4 silu4(f32x4 v) { return (f32x4){siluf(v.x), siluf(v.y), siluf(v.z), siluf(v.w)}; }
template <int CTRL> __device__ __forceinline__ float dppf(float v) { return __builtin_bit_cast(float, __builtin_amdgcn_update_dpp(0, __builtin_bit_cast(int, v), CTRL, 0xF, 0xF, true)); }
__device__ __forceinline__ float row16_sum(float v) { v += dppf<0xB1>(v); v += dppf<0x4E>(v); v += dppf<0x141>(v); v += dppf<0x140>(v); return v; }
__device__ __forceinline__ int opq(int v) { asm volatile("" : "+v"(v)); return v; }
__device__ __forceinline__ float shx(float v, int m, int lane) { return __builtin_bit_cast(float, __builtin_amdgcn_ds_bpermute((lane ^ m) << 2, __builtin_bit_cast(int, v))); }
__device__ __forceinline__ float wave_sum(float v) {
    v = row16_sum(v);
    const int iv = __builtin_bit_cast(int, v);
    return (__builtin_bit_cast(float, __builtin_amdgcn_readlane(iv, 0)) + __builtin_bit_cast(float, __builtin_amdgcn_readlane(iv, 16))) + (__builtin_bit_cast(float, __builtin_amdgcn_readlane(iv, 32)) + __builtin_bit_cast(float, __builtin_amdgcn_readlane(iv, 48)));
}

#define XB_TMO      128
#define XB_XCNT(j)  (256  + 64 * (j))
#define XB_XSUB(j)  (1280 + 64 * (j))
#define XB_XGEN(j)  (2304 + 64 * (j))
#define XB_TOP      3328
#define XB_TOPGEN   3392
#define XCD_BAR_WORDS 3456
#define XB_SPIN_CAP (1u << 18)

__device__ __forceinline__ unsigned xb_ld(unsigned* p)              { return __hip_atomic_load(p, __ATOMIC_RELAXED, __HIP_MEMORY_SCOPE_AGENT); }
__device__ __forceinline__ unsigned xb_add(unsigned* p, unsigned v) { return __hip_atomic_fetch_add(p, v, __ATOMIC_RELAXED, __HIP_MEMORY_SCOPE_AGENT); }
__device__ __forceinline__ unsigned xb_xcc_id() { return (unsigned)__builtin_amdgcn_s_getreg((3 << 11) | 20) & 0xFu; }
#define XB_SPIN(cond, bar) do { unsigned _sp = 0; while (cond) { __builtin_amdgcn_s_sleep(1); \
    if ((++_sp & 255u) == 0u) { if (xb_ld(&(bar)[XB_TMO])) break; if (_sp > XB_SPIN_CAP) { atomicAdd(&(bar)[XB_TMO], 1u); break; } } } } while (0)

struct XcdBarrier {
    unsigned* bar; unsigned x;
    volatile LAS unsigned* st;
};

__device__ __forceinline__ XcdBarrier xcd_barrier_post(unsigned* bar, volatile LAS unsigned* st) {
    XcdBarrier b; b.bar = bar; b.x = xb_xcc_id(); b.st = st;
    if (threadIdx.x == 0) (void)xb_add(&bar[XB_XCNT(b.x)], 1u);
    return b;
}
__device__ __forceinline__ void xcd_barrier_complete(unsigned* bar, unsigned x, unsigned& nloc, unsigned& nx) {
    const unsigned G = gridDim.x * gridDim.y * gridDim.z;
    unsigned sum, cnt, mine, sp = 0u;
    for (;;) {
        sum = 0u; cnt = 0u; mine = 0u;
#pragma unroll
        for (unsigned j = 0; j < 16; ++j) { const unsigned c = xb_ld(&bar[XB_XCNT(j)]); sum += c; cnt += (c > 0u) ? 1u : 0u; mine = (j == x) ? c : mine; }
        if (sum == G) break;
        __builtin_amdgcn_s_sleep(1);
        if ((++sp & 255u) == 0u) { if (xb_ld(&bar[XB_TMO])) break; if (sp > XB_SPIN_CAP) { atomicAdd(&bar[XB_TMO], 1u); break; } }
    }
    nloc = mine > 0u ? mine : 1u; nx = cnt > 0u ? cnt : 1u;
}

__device__ __forceinline__ void xcd_barrier(const XcdBarrier& b) {
    asm volatile("s_waitcnt vmcnt(0)" ::: "memory");
    __syncthreads();
    if (threadIdx.x == 0) {
        unsigned* bar = b.bar;
        __builtin_amdgcn_s_waitcnt(0);
        unsigned nloc = b.st[0], nx = b.st[1];
        if (nloc == 0u) { xcd_barrier_complete(bar, b.x, nloc, nx); b.st[0] = nloc; b.st[1] = nx; }
        const unsigned epoch = b.st[2] + 1u; b.st[2] = epoch;
        const unsigned old = xb_add(&bar[XB_XSUB(b.x)], 1u);
        if (old + 1u == epoch * nloc) {
            __builtin_amdgcn_fence(__ATOMIC_RELEASE, "agent");
            asm volatile("s_waitcnt vmcnt(0)" ::: "memory");
            (void)xb_add(&bar[XB_TOP], 1u);
        }
        const unsigned want = epoch * nx;
        XB_SPIN(xb_ld(&bar[XB_TOP]) < want, bar);
        __builtin_amdgcn_fence(__ATOMIC_ACQUIRE, "agent");
        asm volatile("s_waitcnt vmcnt(0)" ::: "memory");
    }
    __syncthreads();
}
struct Frame {
    LAS unsigned char* lds;
    volatile LAS unsigned* MISC;
    unsigned* ctl;
    int tid, lane, wave;
    int vcu, G;
    float* out; unsigned char* ws;
};
__device__ __forceinline__ const float* inp(int i) { const float* __attribute__((address_space(4))) const* tab = (const float* __attribute__((address_space(4))) const*)__builtin_amdgcn_kernarg_segment_ptr(); asm volatile("" : "+s"(tab)); return tab[i]; }
__device__ __forceinline__ bf16* wsb(const Frame& F, size_t off) { return (bf16*)(F.ws + off); }
__device__ __forceinline__ float* wsf(const Frame& F, size_t off) { return (float*)(F.ws + off); }

struct P0Item { const float* W; const float* gk; bf16* WT; int N, K, drow0, k0, n0; bool valid; };
__device__ __forceinline__ void p0_item_load(const P0Item& I, f32x4 (&wv_)[16], int lane) {
    const int ch = lane & 15, rsub = lane >> 4; const bool ok = I.n0 + 4 * ch < I.N;
#pragma unroll
    for (int i = 0; i < 16; ++i) { const int kk = 4 * i + rsub; wv_[i] = ok ? __builtin_nontemporal_load((const f32x4*)(I.W + (size_t)(I.k0 + kk) * I.N + I.n0 + 4 * ch)) : (f32x4){0.f, 0.f, 0.f, 0.f}; }
}
__device__ __forceinline__ void p0_item_store(const P0Item& I, const f32x4 (&wv_)[16], LAS float* scr, int lane) {
    const int ch = lane & 15, rsub = lane >> 4;
#pragma unroll
    for (int i = 0; i < 16; ++i) { const int kk = 4 * i + rsub; const f32x4 v = I.gk ? wv_[i] * I.gk[I.k0 + kk] : wv_[i]; *(LAS f32x4*)(scr + kk * 64 + ((ch ^ ((kk >> 3) & 7)) << 2)) = v; }
    LDS_WAIT(); asm volatile("" ::: "memory");
    const int kc = lane & 7;
#pragma unroll
    for (int j = 0; j < 8; ++j) { const int n = (lane >> 3) + 8 * j; float t[8];
#pragma unroll
        for (int q = 0; q < 8; ++q) { const int kk = 8 * kc + q; t[q] = scr[kk * 64 + ((((n >> 2) ^ ((kk >> 3) & 7))) << 2) + (n & 3)]; }
        v4u o; o.x = pk2(t[0], t[1]); o.y = pk2(t[2], t[3]); o.z = pk2(t[4], t[5]); o.w = pk2(t[6], t[7]);
        __builtin_nontemporal_store(o, (v4u*)(I.WT + (size_t)(I.drow0 + n) * I.K + I.k0 + 8 * kc)); }
    LDS_WAIT(); asm volatile("" ::: "memory");
}
constexpr int P0_NB_IN = (IN_COLS + 63) / 64;
constexpr int p0_cnt(int KB, int NB) { return (KB / 2) * ((NB + 3) / 4) * 8; }
constexpr int P0_I_IN = p0_cnt(DM / 64, P0_NB_IN), P0_I_SQ = p0_cnt(DM / 64, DM / 64), P0_I_KV = p0_cnt(DM / 64, 2 * DM / 64), P0_I_GU = p0_cnt(DM / 64, 2 * DFF / 64), P0_I_D = p0_cnt(DFF / 64, DM / 64);
constexpr int P0_LAYER = P0_I_IN + 2 * P0_I_SQ + P0_I_KV + P0_I_GU + P0_I_D;
constexpr int P0_SPLIT4 = 2 * P0_LAYER - P0_I_D, CONV4_BX0 = 128, CONV4_WG = 128;
constexpr int P0_SPLIT2 = P0_SPLIT4 - 4096;
constexpr int CONV_BX0 = 192, CONV_WG = 64;
constexpr int CONV1_BX0 = 200, CONV1_WG = 56;
constexpr int P0_SPLIT = 16384 - P0_I_D - 1280;
__device__ __forceinline__ void p0_patch(int r, int NB, int& kb, int& nb) { const int q = r >> 3, w = r & 7, nb4 = (NB + 3) >> 2; kb = 2 * (q / nb4) + (w & 1); nb = 4 * (q % nb4) + (w >> 1); }
__device__ __forceinline__ void p0_decode(const Frame& F, int g, P0Item& I) {
    const int l = g >= P0_LAYER ? 1 : 0; int r = g - l * P0_LAYER; int kb, nb;
    bf16* wl = wsb(F, WS_W + (size_t)l * W_LAYER); I.gk = nullptr; I.K = DM;
    if (r < P0_I_IN) { p0_patch(r, P0_NB_IN, kb, nb); I.W = inp(I_WIN) + (size_t)l * DM * IN_COLS; I.N = IN_COLS; I.WT = (bf16*)((char*)wl + WO_WIN); I.gk = inp(I_NORMG) + (size_t)(l * N_NORMS + MIX_PRE) * DM; I.valid = nb < P0_NB_IN; }
    else if ((r -= P0_I_IN) < P0_I_SQ) { p0_patch(r, DM / 64, kb, nb); I.W = inp(I_WOUT) + (size_t)l * DM * DM; I.N = DM; I.WT = (bf16*)((char*)wl + WO_WOUT); I.valid = true; }
    else if ((r -= P0_I_SQ) < P0_I_SQ) { p0_patch(r, DM / 64, kb, nb); I.W = inp(I_WO) + (size_t)l * DM * DM; I.N = DM; I.WT = (bf16*)((char*)wl + WO_WO); I.valid = true; }
    else if ((r -= P0_I_SQ) < P0_I_KV) { p0_patch(r, 2 * DM / 64, kb, nb); I.W = inp(I_WKV) + (size_t)l * DM * 2 * DM; I.N = 2 * DM; I.WT = (bf16*)((char*)wl + WO_WKV); I.valid = true; }
    else if ((r -= P0_I_KV) < P0_I_GU) { p0_patch(r, 2 * DFF / 64, kb, nb); I.W = inp(I_WGU) + (size_t)l * DM * 2 * DFF; I.N = 2 * DFF; I.WT = (bf16*)((char*)wl + WO_WGU); I.gk = inp(I_NORMG) + (size_t)(l * N_NORMS + FFN_PRE) * DM; I.valid = true; }
    else { r -= P0_I_GU; p0_patch(r, DM / 64, kb, nb); I.W = inp(I_WD) + (size_t)l * DFF * DM; I.N = DM; I.K = DFF; I.WT = (bf16*)((char*)wl + WO_WD); I.valid = true; }
    I.k0 = 64 * kb; I.n0 = 64 * nb; I.drow0 = 64 * nb;
    if (I.N == 2 * DFF) { const int up = I.n0 >= DFF ? 1 : 0, j0 = I.n0 - up * DFF; I.drow0 = (j0 >> 7) * 256 + up * 128 + (j0 & 127); }
}
__device__ __forceinline__ void norm_row_to_bf16(const float* xrow, const float* g, bf16* orow, int lane) {
    const f32x4* xr = (const f32x4*)xrow + lane; const f32x4* gr = (const f32x4*)g + lane;
    f32x4 v[8]; float s = 0.f;
#pragma unroll
    for (int j = 0; j < 8; ++j) { v[j] = xr[64 * j]; s += (v[j].x * v[j].x + v[j].y * v[j].y) + (v[j].z * v[j].z + v[j].w * v[j].w); }
    const float rstd = __builtin_amdgcn_rsqf(wave_sum(s) * (1.0f / DM) + EPS);
    v2u* o8 = (v2u*)orow + lane;
#pragma unroll
    for (int j = 0; j < 8; ++j) { const f32x4 gg = gr[64 * j]; v2u w; w.x = pk2(v[j].x * rstd * gg.x, v[j].y * rstd * gg.y); w.y = pk2(v[j].z * rstd * gg.z, v[j].w * rstd * gg.w); o8[64 * j] = w; }
}
__device__ __forceinline__ void p0_prologue(Frame& F, int part) {
    LAS float* scr = (LAS float*)(F.lds + RING_OFF + F.wave * 16384);
    const int bx0 = part == 1 ? CONV1_BX0 : part == 2 ? CONV_BX0 : part == 4 ? CONV4_BX0 : 0, nconv = part == 1 ? CONV1_WG : part == 2 ? CONV_WG : part == 4 ? CONV4_WG : F.G;
    if (part && (int)blockIdx.x < bx0) return;
    const int wgi = part ? (int)blockIdx.x - bx0 : F.vcu;
    const int gw = wgi * NWAVES + F.wave, NGW = nconv * NWAVES; const int lane = opq(F.lane), tid = opq(F.tid);
    const int gt = wgi * NWAVES * 64 + tid, NGT = NGW * 64;
    {
        const int g_end = part == 0 ? P0_SPLIT : part == 1 ? P0_SPLIT2 : part == 2 ? P0_SPLIT4 : 2 * P0_LAYER; int g = (part == 0 ? 0 : part == 1 ? P0_SPLIT : part == 2 ? P0_SPLIT2 : P0_SPLIT4) + gw;
        P0Item A, B; f32x4 ra[16], rb[16];
        bool va = g < g_end; if (va) { p0_decode(F, g, A); if (A.valid) p0_item_load(A, ra, lane); }
        while (va) {
            g += NGW; const bool vb = g < g_end; if (vb) { p0_decode(F, g, B); if (B.valid) p0_item_load(B, rb, lane); }
            if (A.valid) p0_item_store(A, ra, scr, lane);
            if (!vb) break;
            g += NGW; va = g < g_end; if (va) { p0_decode(F, g, A); if (A.valid) p0_item_load(A, ra, lane); }
            if (B.valid) p0_item_store(B, rb, scr, lane);
        }
    }
    if (part >= 2) return;
    for (int i = gt; i < DM * DM / 8; i += NGT) { const int l = part, k = i;
        const float* src = inp(I_WQ) + (size_t)l * DM * DM + (size_t)k * 8; const float gq = inp(I_NORMG)[(size_t)(l * N_NORMS + XA_PRE) * DM + (k >> 8)]; const f32x4 a = __builtin_nontemporal_load((const f32x4*)src) * gq, b = __builtin_nontemporal_load((const f32x4*)(src + 4)) * gq;
        v4u o; o.x = pk2(a.x, a.y); o.y = pk2(a.z, a.w); o.z = pk2(b.x, b.y); o.w = pk2(b.z, b.w);
        ((v4u*)(F.ws + WS_W + (size_t)l * W_LAYER + WO_WQ))[k] = o; }
    { constexpr int ZR0 = 64 * P0_NB_IN, ZN = (IN_PAD - ZR0) * DM / 8;
      const unsigned z0 = (unsigned)opq(0); const v4u zz = {z0, z0, z0, z0};
      for (int i = gt; i < ZN; i += NGT) { const int l = part, k = i;
          ((v4u*)(F.ws + WS_W + (size_t)l * W_LAYER + WO_WIN + (size_t)ZR0 * DM * 2))[k] = zz; } }
#ifdef PROBE_STREAM
    if (!part) {
        const f32x4* src = (const f32x4*)inp(I_WGU); v4u* dst = (v4u*)(F.ws + WS_U);
        for (int it = gw; it < 10240; it += NGW) { f32x4 a[16];
#pragma unroll
            for (int u = 0; u < 16; ++u) {
                size_t idx;
                if (PROBE_STREAM == 2) { const int band = it >> 7, cc = it & 127; idx = (size_t)(band * 64 + 4 * u + (lane >> 4)) * 2048 + cc * 16 + (lane & 15); }
                else idx = (size_t)it * 1024 + u * 64 + lane;
                a[u] = __builtin_nontemporal_load(src + idx); }
#pragma unroll
            for (int u = 0; u < 8; ++u) { v4u o; o.x = pk2(a[2 * u].x, a[2 * u].y); o.y = pk2(a[2 * u].z, a[2 * u].w); o.z = pk2(a[2 * u + 1].x, a[2 * u + 1].y); o.w = pk2(a[2 * u + 1].z, a[2 * u + 1].w);
                size_t od;
                if (PROBE_STREAM == 3) { const int kb = it / 320, nbb = it % 320; od = (size_t)(nbb * 64 + (lane >> 3) + 8 * u) * 256 + kb * 8 + (lane & 7); }
                else od = (size_t)it * 512 + u * 64 + lane;
                __builtin_nontemporal_store(o, dst + od); } }
    }
#endif
    if (part) return;
    { const unsigned z0 = (unsigned)opq(0); const v4u zz = {z0, z0, z0, z0}; constexpr int ZN1 = 6 * 8192 * 8 / 16;
      for (int i = gt; i < 2 * ZN1; i += NGT) { v4u* dst = i < ZN1 ? (v4u*)(F.ws + WS_SS1) + i : (v4u*)(F.ws + WS_SSA + 8192 * 8) + (i - ZN1); *dst = zz; } }
    for (int i = gt; i < DEPTH * 4 * 128 * 128; i += NGT) { const int c = i & 127, d = (i >> 7) & 127, lg = i >> 14;
        wsb(F, WS_PWT)[i] = (bf16)f2bf(inp(I_POOLW)[((size_t)lg * 128 + c) * 128 + d] * inp(I_POOLS)[(size_t)(lg >> 2) * GW + (lg & 3) * 128 + d]); }
    for (int m = gw; m < DEPTH * MROWS; m += NGW) { const int l = m / MROWS, r = m % MROWS;
        norm_row_to_bf16(inp(I_MEM) + (size_t)r * DM, inp(I_NORMG) + (size_t)(l * N_NORMS + MEM_NORM) * DM, wsb(F, WS_MEMN) + (size_t)m * DM, lane); }
    for (int m = gw; m < M; m += NGW) { const f32x4* xr = (const f32x4*)(inp(I_X) + (size_t)m * DM) + 2 * lane; v4u* xb = (v4u*)(wsb(F, WS_XN) + (size_t)m * DM) + lane; float ss = 0.f;
#pragma unroll
        for (int j = 0; j < 4; ++j) { const f32x4 a = xr[128 * j], b = xr[128 * j + 1]; ss += ((a.x * a.x + a.y * a.y) + (a.z * a.z + a.w * a.w)) + ((b.x * b.x + b.y * b.y) + (b.z * b.z + b.w * b.w));
            v4u o; o.x = pk2(a.x, a.y); o.y = pk2(a.z, a.w); o.z = pk2(b.x, b.y); o.w = pk2(b.z, b.w); xb[64 * j] = o; }
        ss = wave_sum(ss); if (lane == 0) ((unsigned long long*)(F.ws + WS_SSA))[m] = (unsigned long long)(ss * SS_FIX); }
}

struct f32x8 { f32x4 lo, hi; };
__device__ __forceinline__ f32x8 ldu8(const bf16* p) { const v4u w = *(const v4u*)p; f32x8 r;
    r.lo = (f32x4){__builtin_bit_cast(float, w.x << 16), __builtin_bit_cast(float, w.x & 0xffff0000u), __builtin_bit_cast(float, w.y << 16), __builtin_bit_cast(float, w.y & 0xffff0000u)};
    r.hi = (f32x4){__builtin_bit_cast(float, w.z << 16), __builtin_bit_cast(float, w.z & 0xffff0000u), __builtin_bit_cast(float, w.w << 16), __builtin_bit_cast(float, w.w & 0xffff0000u)}; return r; }
__device__ __forceinline__ f32x8 cvt8(const v4u w) { f32x8 r;
    r.lo = (f32x4){__builtin_bit_cast(float, w.x << 16), __builtin_bit_cast(float, w.x & 0xffff0000u), __builtin_bit_cast(float, w.y << 16), __builtin_bit_cast(float, w.y & 0xffff0000u)};
    r.hi = (f32x4){__builtin_bit_cast(float, w.z << 16), __builtin_bit_cast(float, w.z & 0xffff0000u), __builtin_bit_cast(float, w.w << 16), __builtin_bit_cast(float, w.w & 0xffff0000u)}; return r; }
__device__ __forceinline__ float bfu(bf16 v) { return __builtin_bit_cast(float, (unsigned)v << 16); }
__device__ __forceinline__ f32x4 ld4b(const bf16* p) { const v2u w = *(const v2u*)p; return (f32x4){__builtin_bit_cast(float, w.x << 16), __builtin_bit_cast(float, w.x & 0xffff0000u), __builtin_bit_cast(float, w.y << 16), __builtin_bit_cast(float, w.y & 0xffff0000u)}; }
__device__ __forceinline__ f32x8 ld8f(const float* p) { f32x8 r; r.lo = ld4(p); r.hi = ld4(p + 4); return r; }
__device__ __forceinline__ f32x8 operator*(const f32x8& a, const f32x8& b) { return f32x8{a.lo * b.lo, a.hi * b.hi}; }
__device__ __forceinline__ f32x8 operator+(const f32x8& a, const f32x8& b) { return f32x8{a.lo + b.lo, a.hi + b.hi}; }
__device__ __forceinline__ f32x8 silu8(const f32x8& a) { return f32x8{silu4(a.lo), silu4(a.hi)}; }
__device__ __forceinline__ float sumsq8(const f32x8& y) { return ((y.lo.x * y.lo.x + y.lo.y * y.lo.y) + (y.lo.z * y.lo.z + y.lo.w * y.lo.w)) + ((y.hi.x * y.hi.x + y.hi.y * y.hi.y) + (y.hi.z * y.hi.z + y.hi.w * y.hi.w)); }
__device__ __forceinline__ v4u pack8u(const f32x8& y) { v4u o; o.x = pk2(y.lo.x, y.lo.y); o.y = pk2(y.lo.z, y.lo.w); o.z = pk2(y.hi.x, y.hi.y); o.w = pk2(y.hi.z, y.hi.w); return o; }
__device__ __forceinline__ void mixer_prep_phase(Frame& F, int l) {
    const int gw = F.vcu * NWAVES + F.wave, NGW = F.G * NWAVES, lane = opq(F.lane), tid = opq(F.tid);
    const bf16* U = wsb(F, WS_U);
    bf16* MIX = wsb(F, WS_MIX);
    constexpr int NSTRIP = M / 16, NTYPE = 12;
    for (int it = gw; it < NTYPE * NSTRIP; it += NGW) {
        const int type = it % NTYPE, strip = it / NTYPE, r0 = strip * 16, pos0 = r0 & (SEQ - 1), c = lane * 8;
        const bf16* ur0 = U + (size_t)r0 * IN_PAD;
        if (type == 0) {
            const float* cw = inp(I_CONVA) + (size_t)l * 3 * GW + c;
            const f32x8 w0 = ld8f(cw), w1 = ld8f(cw + GW), w2 = ld8f(cw + 2 * GW);
            const v4u z4 = {0u, 0u, 0u, 0u};
#pragma unroll 1
            for (int hf = 0; hf < 2; ++hf) {
                const bf16* ub = ur0 + (size_t)(8 * hf) * IN_PAD;
                v4u rc[10], rh[10], rb[8];
#pragma unroll
                for (int i = 0; i < 10; ++i) { const int ri = i - 2; if (ri >= 0 || pos0 > 0 || hf > 0) { rc[i] = *(const v4u*)(ub + (ptrdiff_t)ri * IN_PAD + UA_C + c); rh[i] = *(const v4u*)(ub + (ptrdiff_t)ri * IN_PAD + UA_H + c); } else { rc[i] = z4; rh[i] = z4; } }
#pragma unroll
                for (int i = 0; i < 8; ++i) rb[i] = *(const v4u*)(ub + (size_t)i * IN_PAD + UA_B + c);
                f32x8 p2 = cvt8(rc[0]) * cvt8(rh[0]), p1 = cvt8(rc[1]) * cvt8(rh[1]);
#pragma unroll
                for (int i = 0; i < 8; ++i) { const f32x8 p0 = cvt8(rc[i + 2]) * cvt8(rh[i + 2]); const f32x8 y = cvt8(rb[i]) * (w0 * p2 + w1 * p1 + w2 * p0);
                    *(v4u*)(MIX + (size_t)(r0 + 8 * hf + i) * DM + c) = pack8u(y); p2 = p1; p1 = p0; }
            }
        } else if (type < 4) {
            const int gi = type - 1, cc = gi * GW + c;
            const float* cw = inp(I_GCONV) + (size_t)l * 4 * 3 * GW + cc;
            const f32x8 w0 = ld8f(cw), w1 = ld8f(cw + 3 * GW), w2 = ld8f(cw + 6 * GW), w3 = ld8f(cw + 9 * GW);
            v4u xr[19];
#pragma unroll
            for (int i = 0; i < 19; ++i) { const int ri = i - 3; if (ri >= 0 || pos0 > 0) xr[i] = *(const v4u*)(ur0 + (ptrdiff_t)ri * IN_PAD + UC_Q + cc); else xr[i] = (v4u){0u, 0u, 0u, 0u}; }
            bf16* dst = (gi == 0) ? wsb(F, WS_QN) : (gi == 1) ? wsb(F, WS_KN) : wsb(F, WS_VV);
            const float qs = (gi == 0) ? 0.08838834764831845f : 1.0f;
            f32x8 x3 = cvt8(xr[0]), x2 = cvt8(xr[1]), x1 = cvt8(xr[2]);
#pragma unroll
            for (int i = 0; i < 16; ++i) { const f32x8 x0 = cvt8(xr[i + 3]); f32x8 y = silu8(w0 * x3 + w1 * x2 + w2 * x1 + w3 * x0); x3 = x2; x2 = x1; x1 = x0;
                if (gi < 2) { float ss = row16_sum(sumsq8(y));
                    const float sc = qs * __builtin_amdgcn_rsqf(ss + EPS); y.lo = y.lo * sc; y.hi = y.hi * sc; }
                *(v4u*)(dst + (size_t)(r0 + i) * GW + c) = pack8u(y); }
        } else if (type < 6) {
            const int gi = type - 4, cc = gi * GW + c;
            const float* cw = inp(I_SCONVW) + (size_t)l * 4 * 1024 + cc;
            const f32x8 w0 = ld8f(cw), w1 = ld8f(cw + 1024), w2 = ld8f(cw + 2048), w3 = ld8f(cw + 3072), bb = ld8f(inp(I_SCONVB) + (size_t)l * 1024 + cc);
            v4u xr[19];
#pragma unroll
            for (int i = 0; i < 19; ++i) { const int ri = i - 3; if (ri >= 0 || pos0 > 0) xr[i] = *(const v4u*)(ur0 + (ptrdiff_t)ri * IN_PAD + UD_X + cc); else xr[i] = (v4u){0u, 0u, 0u, 0u}; }
            f32x8 x3 = cvt8(xr[0]), x2 = cvt8(xr[1]), x1 = cvt8(xr[2]);
            bf16* dst; int ld, co;
            if (gi == 0) { dst = wsb(F, WS_XS); ld = 512; co = c; } else if (c < 256) { dst = wsb(F, WS_BS); ld = 256; co = c; } else { dst = wsb(F, WS_CS); ld = 256; co = c - 256; }
#pragma unroll
            for (int i = 0; i < 16; ++i) { const f32x8 x0 = cvt8(xr[i + 3]); const f32x8 y = silu8(w0 * x3 + w1 * x2 + w2 * x1 + w3 * x0 + bb); x3 = x2; x2 = x1; x1 = x0;
                *(v4u*)(dst + (size_t)(r0 + i) * ld + co) = pack8u(y); }
        } else if (type < 8) {
            const int zo = (type == 6) ? UC_Z : UD_Z; bf16* dst = wsb(F, (type == 6) ? WS_ZG : WS_ZS);
            v4u z[16];
#pragma unroll
            for (int i = 0; i < 16; ++i) z[i] = *(const v4u*)(ur0 + (size_t)i * IN_PAD + zo + c);
#pragma unroll
            for (int i = 0; i < 16; ++i) *(v4u*)(dst + (size_t)(r0 + i) * GW + c) = z[i];
        } else {
            const int gi = type - 8, w = 2 << gi;
            LAS float* scr = (LAS float*)(F.lds + RING_OFF + F.wave * 16384);
            const int c0 = UB + gi * 128 + lane * 2;
            float uv0[31], uv1[31];
#pragma unroll
            for (int i = 0; i < 31; ++i) { const int ri = i - 15; float a0 = 0.f, a1 = 0.f;
                if (ri >= 0 || pos0 > 0) { const unsigned wd = *(const unsigned*)(ur0 + (ptrdiff_t)ri * IN_PAD + c0); a0 = __builtin_bit_cast(float, wd << 16); a1 = __builtin_bit_cast(float, wd & 0xffff0000u); }
                uv0[i] = a0; uv1[i] = a1; }
            float r0s = 0.f, r1s = 0.f;
#pragma unroll
            for (int s = 1; s < 16; ++s) if (s < w) { r0s += uv0[15 - s]; r1s += uv1[15 - s]; }
#pragma unroll
            for (int i = 0; i < 16; ++i) { const int pos = pos0 + i; const float a0 = uv0[15 + i], a1 = uv1[15 + i];
                r0s += a0; r1s += a1;
                const float cnt = (float)((pos + 1 < w) ? pos + 1 : w);
                const float rc = __builtin_amdgcn_rcpf(cnt); scr[i * 128 + lane * 2] = r0s * rc - a0; scr[i * 128 + lane * 2 + 1] = r1s * rc - a1;
                float d0 = 0.f, d1 = 0.f;
#pragma unroll
                for (int g2 = 0; g2 < 4; ++g2) if (gi == g2) { d0 = uv0[15 + i - (2 << g2) + 1]; d1 = uv1[15 + i - (2 << g2) + 1]; }
                r0s -= d0; r1s -= d1; }
            LDS_WAIT(); asm volatile("" ::: "memory");
            const bf16* pwt = wsb(F, WS_PWT) + ((size_t)l * 4 + gi) * 128 * 128 + (size_t)(lane & 15) * 128 + (lane >> 4) * 8;
            bf16x8 bfr[4];
#pragma unroll
            for (int ks = 0; ks < 4; ++ks) { const LAS float* pr = scr + (lane & 15) * 128 + 32 * ks + (lane >> 4) * 8; const f32x4 p0 = *(const LAS f32x4*)pr, p1 = *(const LAS f32x4*)(pr + 4);
                v4u w; w.x = pk2(p0.x, p0.y); w.y = pk2(p0.z, p0.w); w.z = pk2(p1.x, p1.y); w.w = pk2(p1.z, p1.w); bfr[ks] = __builtin_bit_cast(bf16x8, w); }
            bf16* orow = MIX + (size_t)(r0 + (lane & 15)) * DM + GW + gi * 128 + (lane >> 4) * 4;
#pragma unroll
            for (int nh = 0; nh < 2; ++nh) {
                bf16x8 afr[4][4];
#pragma unroll
                for (int nt = 0; nt < 4; ++nt)
#pragma unroll
                    for (int ks = 0; ks < 4; ++ks) afr[nt][ks] = *(const bf16x8*)(pwt + (size_t)((nh * 4 + nt) * 16) * 128 + 32 * ks);
#pragma unroll
                for (int nt = 0; nt < 4; ++nt) { f32x4 acc = {0.f, 0.f, 0.f, 0.f};
#pragma unroll
                    for (int ks = 0; ks < 4; ++ks) acc = __builtin_amdgcn_mfma_f32_16x16x32_bf16(afr[nt][ks], bfr[ks], acc, 0, 0, 0);
                    v2u o; o.x = pk2(acc.x, acc.y); o.y = pk2(acc.z, acc.w); *(v2u*)(orow + (nh * 4 + nt) * 16) = o; }
            }
            LDS_WAIT(); asm volatile("" ::: "memory");
        }
    }
    for (int i = (F.vcu * NWAVES * 64) + tid; i < M * 16; i += F.G * NWAVES * 64) { const int t = i >> 4, j = i & 15; const bf16* ur = U + (size_t)t * IN_PAD;
#define UF(col) __builtin_bit_cast(float, (unsigned)ur[col] << 16)
        if (j < 4) { wsf(F, WS_GB)[(size_t)t * 8 + 2 * j] = -__expf(inp(I_GALOG)[l * 4 + j]) * softplusf(UF(UC_A + j) + inp(I_GDTB)[l * 4 + j]); }
        else if (j < 8) { wsf(F, WS_GB)[(size_t)t * 8 + 2 * (j - 4) + 1] = sigmoidf(UF(UC_B + (j - 4))); }
        else { const int hh = j - 8; const float dt = softplusf(UF(UD_DT + hh) + inp(I_SDTB)[l * 8 + hh]);
            wsf(F, WS_DT)[(size_t)t * 16 + 2 * hh] = -__expf(inp(I_SALOG)[l * 8 + hh]) * dt; wsf(F, WS_DT)[(size_t)t * 16 + 2 * hh + 1] = dt; }
#undef UF
    }
}

typedef float f32x16 __attribute__((ext_vector_type(16)));
__device__ __forceinline__ bf16x8 pack8(float a0, float a1, float a2, float a3, float a4, float a5, float a6, float a7) { v4u w; w.x = cvtpk(a0, a1); w.y = cvtpk(a2, a3); w.z = cvtpk(a4, a5); w.w = cvtpk(a6, a7); return __builtin_bit_cast(bf16x8, w); }
#define PACK_STEP(x, s) pack8((x)[8 * (s)], (x)[8 * (s) + 1], (x)[8 * (s) + 2], (x)[8 * (s) + 3], (x)[8 * (s) + 4], (x)[8 * (s) + 5], (x)[8 * (s) + 6], (x)[8 * (s) + 7])
#define MFMA32(a, b, c) __builtin_amdgcn_mfma_f32_32x32x16_bf16((a), (b), (c), 0, 0, 0)
__device__ __forceinline__ int crow(int reg, int h) { return (reg & 3) + 8 * (reg >> 2) + 4 * h; }
constexpr int LA_KB = 0;
constexpr int LA_QB = LA_KB + 64 * 136 * 2;
constexpr int LA_KGT = LA_QB + 64 * 136 * 2;
constexpr int LA_VBT = LA_KGT + 128 * 72 * 2;
constexpr int LA_KET = LA_VBT + 128 * 72 * 2;
constexpr int LA_M = LA_KET + 128 * 72 * 2;
constexpr int LA_TB = LA_M + 64 * 68 * 4;
constexpr int LA_VEC = LA_TB + 64 * 72 * 2;
static_assert(LA_VEC + 1024 <= RING_BYTES, "la LDS map");
__device__ __forceinline__ bf16x8 lds_frag(const LAS unsigned char* base, int row, int stride_el, int col) { return *(const LAS bf16x8*)(base + ((size_t)row * stride_el + col) * 2); }
__device__ __forceinline__ float wave_incl_scan(float v, int lane) {
#pragma unroll
    for (int d = 1; d < 64; d <<= 1) { const float o = __builtin_bit_cast(float, __builtin_amdgcn_ds_bpermute((lane - d) << 2, __builtin_bit_cast(int, v))); if (lane >= d) v += o; }
    return v;
}
__device__ __forceinline__ void store_qk_frag(const f32x16& acc, const LAS float* Gv, int mt, int rt, int r, int h, int lane, bf16* qkf) {
    const int l = 32 * rt + r; const float Gl = Gv[l];
    float v[16];
#pragma unroll
    for (int q = 0; q < 16; ++q) { const int m = 32 * mt + crow(q, h); v[q] = (m <= l) ? acc[q] * __expf(Gl - Gv[m]) : 0.f; }
    *(bf16x8*)(qkf + ((size_t)(rt * 4 + 2 * mt + 0) * 64 + lane) * 8) = pack8(v[0], v[1], v[2], v[3], v[4], v[5], v[6], v[7]);
    *(bf16x8*)(qkf + ((size_t)(rt * 4 + 2 * mt + 1) * 64 + lane) * 8) = pack8(v[8], v[9], v[10], v[11], v[12], v[13], v[14], v[15]);
}
__device__ __forceinline__ void qd_frag_task(const float* qrows, int ldq, const LAS float* Gv, int task, int r, int h, int lane, bf16* qdf) {
    const int rt = task >> 3, ks = task & 7, l = 32 * rt + r, k0 = 16 * ks + 4 * h; const float e = __expf(Gv[l]);
    const f32x4 a = ld4(qrows + (size_t)l * ldq + k0), b = ld4(qrows + (size_t)l * ldq + k0 + 8);
    *(bf16x8*)(qdf + ((size_t)task * 64 + lane) * 8) = pack8(a.x * e, a.y * e, a.z * e, a.w * e, b.x * e, b.y * e, b.z * e, b.w * e);
}
__device__ __forceinline__ void qd_frag_task4(const float* qrows, int ldq, const LAS float* Gv, int task0, int r, int h, int lane, bf16* qdf) {
    f32x4 a[4], b[4]; float e[4];
#pragma unroll
    for (int t = 0; t < 4; ++t) { const int task = task0 + t, rt = task >> 3, ks = task & 7, l = 32 * rt + r, k0 = 16 * ks + 4 * h;
        a[t] = ld4(qrows + (size_t)l * ldq + k0); b[t] = ld4(qrows + (size_t)l * ldq + k0 + 8); e[t] = __expf(Gv[l]); }
#pragma unroll
    for (int t = 0; t < 4; ++t) *(bf16x8*)(qdf + ((size_t)(task0 + t) * 64 + lane) * 8) = pack8(a[t].x * e[t], a[t].y * e[t], a[t].z * e[t], a[t].w * e[t], b[t].x * e[t], b[t].y * e[t], b[t].z * e[t], b[t].w * e[t]);
}
__device__ __forceinline__ void ke_frag_task(const LAS unsigned char* ket, int task, int r, int h, int lane, bf16* kef) {
    const int it = task >> 2, ks = task & 3, dk = 32 * it + r, l0 = 16 * ks + 4 * h;
    const v2u lo = *(const LAS v2u*)(ket + ((size_t)dk * 72 + l0) * 2), hi = *(const LAS v2u*)(ket + ((size_t)dk * 72 + l0 + 8) * 2);
    v4u w; w.x = lo.x; w.y = lo.y; w.z = hi.x; w.w = hi.y;
    *(v4u*)(kef + ((size_t)task * 64 + lane) * 8) = w;
}

#ifndef LAREP
#define LAREP 0
#endif
#define LDS_SYNC() do { asm volatile("s_waitcnt lgkmcnt(0)" ::: "memory"); __builtin_amdgcn_s_barrier(); asm volatile("" ::: "memory"); } while (0)
__device__ __forceinline__ void la_prep_phase(Frame& F, int l_unused) {
    const int tid0 = opq(F.tid), wv = F.wave;
    LAS unsigned char* L = F.lds + RING_OFF; asm volatile("" : "+v"(L));
    LAS float* Gv = (LAS float*)(L + LA_VEC); LAS float* Bv = Gv + 64;
    LAS float* Mf = (LAS float*)(L + LA_M);
    const f32x16 zero16 = {0.f, 0.f, 0.f, 0.f, 0.f, 0.f, 0.f, 0.f, 0.f, 0.f, 0.f, 0.f, 0.f, 0.f, 0.f, 0.f};
    for (int item = F.vcu; item < 512; item += F.G) {
        const int tid = opq(tid0), lane = tid & 63, r = lane & 31, h = lane >> 5;
        const int seq = item >> 5, ch = item & 31, b = seq >> 2, hd = seq & 3;
        const size_t t0 = (size_t)b * SEQ + ch * 64;
        const bf16* KN = wsb(F, WS_KN) + t0 * GW + hd * 128; const bf16* QN = wsb(F, WS_QN) + t0 * GW + hd * 128; const bf16* VV = wsb(F, WS_VV) + t0 * GW + hd * 128;
        unsigned char* rec = F.ws + WS_FG + (size_t)item * LA_RECG;
        const int c = tid & 127, lg = tid >> 7;
        const f32x2v gb = *(const f32x2v*)(wsf(F, WS_GB) + (t0 + lane) * 8 + 2 * hd);
        float kr[16], qr[16], vr[16];
#pragma unroll
        for (int i = 0; i < 16; ++i) { const int l = lg * 16 + i; kr[i] = bfu(KN[(size_t)l * GW + c]); qr[i] = bfu(QN[(size_t)l * GW + c]); vr[i] = bfu(VV[(size_t)l * GW + c]); }
        f32x4 qa[4], qb[4];
        { const int qw = (wv >= 2 && wv <= 5) ? wv - 2 : 0;
#pragma unroll
            for (int t = 0; t < 4; ++t) { const int task = 4 * qw + t, rt = task >> 3, ks = task & 7, l = 32 * rt + r, k0 = 16 * ks + 4 * h; qa[t] = ld4b(QN + (size_t)l * GW + k0); qb[t] = ld4b(QN + (size_t)l * GW + k0 + 8); } }
        if (wv == 0) { Gv[lane] = wave_incl_scan(gb.x, lane); Bv[lane] = gb.y; }
        LDS_SYNC();
        const float G63 = Gv[63];
#pragma unroll
        for (int i = 0; i < 16; ++i) { const int l = lg * 16 + i; const float kv = kr[i], qv = qr[i], vv = vr[i];
            const float Gl = Gv[l], bl = Bv[l];
            ((LAS bf16*)(L + LA_KB))[l * 136 + c] = (bf16)f2bf(kv); ((LAS bf16*)(L + LA_QB))[l * 136 + c] = (bf16)f2bf(qv);
            ((LAS bf16*)(L + LA_KGT))[c * 72 + l] = (bf16)f2bf(-kv * bl * __expf(Gl)); ((LAS bf16*)(L + LA_VBT))[c * 72 + l] = (bf16)f2bf(vv * bl);
            ((LAS bf16*)(L + LA_KET))[c * 72 + l] = (bf16)f2bf(kv * __expf(G63 - Gl)); }
        LDS_SYNC();
        if (wv < 4) { const int it = wv >> 1, jt = wv & 1; f32x16 acc = zero16;
            if (!(it == 0 && jt == 1)) {
#pragma unroll
                for (int ks = 0; ks < 8; ++ks) acc = MFMA32(lds_frag(L + LA_KB, 32 * it + r, 136, 16 * ks + 8 * h), lds_frag(L + LA_KB, 32 * jt + r, 136, 16 * ks + 8 * h), acc); }
            const int j = 32 * jt + r; const float Gj = Gv[j];
#pragma unroll
            for (int q = 0; q < 16; ++q) { const int i = 32 * it + crow(q, h); Mf[i * 68 + j] = (j < i) ? Bv[i] * acc[q] * __expf(Gv[i] - Gj) : 0.f; }
        } else { const int mt = (wv - 4) >> 1, rt = (wv - 4) & 1; f32x16 acc = zero16;
            if (!(mt == 1 && rt == 0)) {
#pragma unroll
                for (int ks = 0; ks < 8; ++ks) acc = MFMA32(lds_frag(L + LA_KB, 32 * mt + r, 136, 16 * ks + 8 * h), lds_frag(L + LA_QB, 32 * rt + r, 136, 16 * ks + 8 * h), acc); }
            store_qk_frag(acc, Gv, mt, rt, r, h, lane, (bf16*)(rec + LA_QK)); }
        LDS_SYNC();
        f32x16 Pacc = zero16;
        if (wv < 2) {
            const int ln = opq(lane), cc = ln & 31, bo = 32 * wv;
            float Tc[32];
#pragma unroll
            for (int i = 0; i < 32; ++i) {
                float a0 = (i == cc) ? 1.f : 0.f, a1 = 0.f, a2 = 0.f, a3 = 0.f;
#pragma unroll
                for (int j4 = 0; j4 < (i + 3) / 4; ++j4) { const f32x4 m = *(const LAS f32x4*)(Mf + (bo + i) * 68 + bo + 4 * j4);
                    a0 -= m.x * Tc[4 * j4]; if (4 * j4 + 1 < i) a1 -= m.y * Tc[4 * j4 + 1]; if (4 * j4 + 2 < i) a2 -= m.z * Tc[4 * j4 + 2]; if (4 * j4 + 3 < i) a3 -= m.w * Tc[4 * j4 + 3]; }
                Tc[i] = (a0 + a1) + (a2 + a3);
                ((LAS bf16*)(L + LA_TB))[(bo + i) * 72 + bo + cc] = (bf16)f2bf(Tc[i]);
                if (wv == 0) ((LAS bf16*)(L + LA_TB))[i * 72 + 32 + cc] = (bf16)0;
                if ((i & 7) == 7) asm volatile("" ::: "memory");
            }
            if (wv == 0) {
#pragma unroll
                for (int s2 = 0; s2 < 2; ++s2) {
                    const LAS float* mr = Mf + (32 + r) * 68 + 16 * s2 + 8 * h; const f32x4 m0 = *(const LAS f32x4*)mr, m1 = *(const LAS f32x4*)(mr + 4);
                    const bf16x8 af = pack8(m0.x, m0.y, m0.z, m0.w, m1.x, m1.y, m1.z, m1.w);
                    const bf16x8 bfr = h ? pack8(Tc[16 * s2 + 8], Tc[16 * s2 + 9], Tc[16 * s2 + 10], Tc[16 * s2 + 11], Tc[16 * s2 + 12], Tc[16 * s2 + 13], Tc[16 * s2 + 14], Tc[16 * s2 + 15])
                                          : pack8(Tc[16 * s2 + 0], Tc[16 * s2 + 1], Tc[16 * s2 + 2], Tc[16 * s2 + 3], Tc[16 * s2 + 4], Tc[16 * s2 + 5], Tc[16 * s2 + 6], Tc[16 * s2 + 7]);
                    Pacc = MFMA32(af, bfr, Pacc); }
                if (lane == 0) wsf(F, WS_DLG)[item] = __expf(G63);
            }
        } else if (wv <= 5) {
#pragma unroll
            for (int t = 0; t < 4; ++t) { const int task = 4 * (wv - 2) + t, rt = task >> 3; const float e = __expf(Gv[32 * rt + r]);
                *(bf16x8*)((bf16*)(rec + LA_QD) + ((size_t)task * 64 + lane) * 8) = pack8(qa[t].x * e, qa[t].y * e, qa[t].z * e, qa[t].w * e, qb[t].x * e, qb[t].y * e, qb[t].z * e, qb[t].w * e); }
        } else {
#pragma unroll
            for (int t = 0; t < 8; ++t) ke_frag_task(L + LA_KET, 8 * (wv - 6) + t, r, h, lane, (bf16*)(rec + LA_KE)); }
        LDS_SYNC();
        if (wv == 0) {
            f32x16 t21 = zero16;
#pragma unroll
            for (int s2 = 0; s2 < 2; ++s2) {
                const LAS unsigned char* tr = L + LA_TB + ((size_t)(32 + r) * 72 + 32 + 16 * s2 + 4 * h) * 2;
                const v2u lo = *(const LAS v2u*)tr, hi = *(const LAS v2u*)(tr + 16); v4u w; w.x = lo.x; w.y = lo.y; w.z = hi.x; w.w = hi.y;
                t21 = MFMA32(__builtin_bit_cast(bf16x8, w), PACK_STEP(Pacc, s2), t21); }
#pragma unroll
            for (int q = 0; q < 16; ++q) ((LAS bf16*)(L + LA_TB))[(32 + crow(q, h)) * 72 + r] = (bf16)f2bf(-t21[q]);
        }
        LDS_SYNC();
#pragma unroll 1
        for (int tile = wv; tile < 16; tile += 8) {
            f32x16 acc = zero16;
            if (tile < 8) { const int it = tile >> 1, rt = tile & 1;
#pragma unroll
                for (int ks = 0; ks < 4; ++ks) acc = MFMA32(lds_frag(L + LA_KGT, 32 * it + r, 72, 16 * ks + 8 * h), lds_frag(L + LA_TB, 32 * rt + r, 72, 16 * ks + 8 * h), acc);
                bf16* nw = (bf16*)(rec + LA_NW);
                *(bf16x8*)(nw + ((size_t)(rt * 8 + 2 * it + 0) * 64 + lane) * 8) = PACK_STEP(acc, 0);
                *(bf16x8*)(nw + ((size_t)(rt * 8 + 2 * it + 1) * 64 + lane) * 8) = PACK_STEP(acc, 1);
            } else { const int rt = (tile - 8) >> 2, dvt = (tile - 8) & 3;
#pragma unroll
                for (int ks = 0; ks < 4; ++ks) acc = MFMA32(lds_frag(L + LA_TB, 32 * rt + r, 72, 16 * ks + 8 * h), lds_frag(L + LA_VBT, 32 * dvt + r, 72, 16 * ks + 8 * h), acc);
                float* uc = (float*)(rec + LA_UCG) + ((size_t)(dvt * 2 + rt) * 4 * 64 + lane) * 4;
#pragma unroll
                for (int q4 = 0; q4 < 4; ++q4) *(f32x4*)(uc + (size_t)q4 * 256) = (f32x4){acc[4 * q4], acc[4 * q4 + 1], acc[4 * q4 + 2], acc[4 * q4 + 3]};
            }
        }
        LDS_SYNC();
    }
    for (int item = F.vcu; item < 256; item += F.G) {
        const int tid = opq(tid0), lane = tid & 63, r = lane & 31, h = lane >> 5;
        const int b = item >> 6, ch = (item >> 1) & 31, g = item & 1;
        const size_t t0 = (size_t)b * SEQ + ch * 64;
        const bf16* BS = wsb(F, WS_BS) + t0 * 256 + g * 128; const bf16* CS = wsb(F, WS_CS) + t0 * 256 + g * 128;
        const int c = tid & 127, lg = tid >> 7;
        float br[16], cr[16];
#pragma unroll
        for (int i = 0; i < 16; ++i) { const int l = lg * 16 + i; br[i] = bfu(BS[(size_t)l * 256 + c]); cr[i] = bfu(CS[(size_t)l * 256 + c]); }
        f32x2v ad[4];
#pragma unroll
        for (int hi = 0; hi < 4; ++hi) ad[hi] = *(const f32x2v*)(wsf(F, WS_DT) + (t0 + lane) * 16 + 2 * (4 * g + hi));
        f32x4 ca[4], cb[4]; float xv[4][16];
        const int sl = (wv >> 1) & 1, rt2 = wv & 1;
        {
#pragma unroll
            for (int t = 0; t < 4; ++t) { const int task = 4 * (wv & 3) + t, rt = task >> 3, ks = task & 7, l = 32 * rt + r, k0 = 16 * ks + 4 * h; ca[t] = ld4b(CS + (size_t)l * 256 + k0); cb[t] = ld4b(CS + (size_t)l * 256 + k0 + 8); }
#pragma unroll
            for (int hi = 0; hi < 4; ++hi)
#pragma unroll
                for (int q = 0; q < 16; ++q) xv[hi][q] = bfu(wsb(F, WS_XS)[(t0 + 32 * rt2 + crow(q, h)) * GW + (4 * g + hi) * 64 + 32 * sl + r]); }
#pragma unroll
        for (int i = 0; i < 16; ++i) { const int l = lg * 16 + i;
            ((LAS bf16*)(L + LA_KB))[l * 136 + c] = (bf16)f2bf(br[i]); ((LAS bf16*)(L + LA_QB))[l * 136 + c] = (bf16)f2bf(cr[i]); }
        if (wv == 0) {
#pragma unroll
            for (int hi = 0; hi < 4; ++hi) { Gv[hi * 64 + lane] = wave_incl_scan(ad[hi].x, lane); Gv[256 + hi * 64 + lane] = ad[hi].y; } }
        LDS_SYNC();
        f32x16 raw = zero16;
        const int mt = (wv >> 1) & 1, rt = wv & 1;
        if (wv < 4 && !(mt == 1 && rt == 0)) {
#pragma unroll
            for (int ks = 0; ks < 8; ++ks) raw = MFMA32(lds_frag(L + LA_KB, 32 * mt + r, 136, 16 * ks + 8 * h), lds_frag(L + LA_QB, 32 * rt + r, 136, 16 * ks + 8 * h), raw); }
#pragma unroll
        for (int hi = 0; hi < 4; ++hi) {
            const int hh = 4 * g + hi, seq = b * 8 + hh;
            unsigned char* rec = F.ws + WS_FS + ((size_t)seq * 32 + ch) * LA_RECS;
            const LAS float* Gh = Gv + hi * 64; const LAS float* Dh = Gv + 256 + hi * 64;
            const float G63 = Gh[63];
#pragma unroll
            for (int i = 0; i < 16; ++i) { const int l = lg * 16 + i; ((LAS bf16*)(L + LA_KET))[c * 72 + l] = (bf16)f2bf(br[i] * __expf(G63 - Gh[l])); }
            if (wv < 4) {
                store_qk_frag(raw, Gh, mt, rt, r, h, lane, (bf16*)(rec + LA_QK));
#pragma unroll
                for (int t = 0; t < 4; ++t) { const int task = 4 * wv + t, rtq = task >> 3; const float e = __expf(Gh[32 * rtq + r]);
                    *(bf16x8*)((bf16*)(rec + LA_QD) + ((size_t)task * 64 + lane) * 8) = pack8(ca[t].x * e, ca[t].y * e, ca[t].z * e, ca[t].w * e, cb[t].x * e, cb[t].y * e, cb[t].z * e, cb[t].w * e); }
            } else {
                float* uc = (float*)(rec + LA_UCS) + ((size_t)(sl * 2 + rt2) * 4 * 64 + lane) * 4;
#pragma unroll
                for (int q4 = 0; q4 < 4; ++q4) { f32x4 v;
#pragma unroll
                    for (int e = 0; e < 4; ++e) v[e] = xv[hi][4 * q4 + e] * Dh[32 * rt2 + crow(4 * q4 + e, h)];
                    *(f32x4*)(uc + (size_t)q4 * 256) = v; }
            }
            if (tid == 0) wsf(F, WS_DLS)[seq * 32 + ch] = __expf(G63);
            LDS_SYNC();
            if (wv >= 4) {
#pragma unroll
                for (int t = 0; t < 4; ++t) ke_frag_task(L + LA_KET, 4 * (wv - 4) + t, r, h, lane, (bf16*)(rec + LA_KE)); }
            LDS_SYNC();
        }
    }
}

constexpr int LA_HB = LDSCTL_OFF + 1024;
static_assert(LA_HB + 12 * 1024 <= LDS_BYTES, "hand-over area inside the LDS allocation");
template <bool HAS_W> __device__ __forceinline__ void la_seq_wg(LAS unsigned char* lds0  , const unsigned char* recs, int recsz, int uc_off, const float* dls, float* outp  , int slice, int lane, int wv, unsigned long long* la_tp = nullptr) {
    constexpr int NFR = HAS_W ? 56 : 40;
    constexpr int SLOT = (NFR + 8) * 1024;
    LAS unsigned char* ring = lds0 + RING_OFF; LAS unsigned char* HB = lds0 + LA_HB + lane * 16;
    const int r = lane & 31, h = lane >> 5;
    constexpr int NA = HAS_W ? 42 : 24, NB = 24;
#define LA_DMA1(c_, slot_, f_) do { const int ff_ = (f_); const unsigned char* src_ = recs + (size_t)(c_) * recsz + lane * 16 + ((ff_ < NFR) ? ff_ * 1024 : uc_off + slice * 8192 + (ff_ - NFR) * 1024); \
        __builtin_amdgcn_global_load_lds((const unsigned*)src_, (LAS unsigned*)(ring + (slot_) * SLOT + ff_ * 1024), 16, 0, 0); } while (0)
#define LA_DMA_A(c_, slot_) do { for (int a_ = wv - 2; a_ < NA; a_ += 6) { const int f_ = HAS_W ? (a_ < 16 ? a_ : a_ < 40 ? 24 + a_ : a_ - 40) : (a_ < 16 ? a_ : 24 + a_); LA_DMA1(c_, slot_, f_); } } while (0)
#define LA_DMA_B(c_, slot_) do { for (int b_ = wv - 2; b_ < NB; b_ += 6) LA_DMA1(c_, slot_, 16 + b_); } while (0)
#define LA_WAIT2() do { if (HAS_W) asm volatile("s_waitcnt vmcnt(11)" ::: "memory"); else asm volatile("s_waitcnt vmcnt(8)" ::: "memory"); } while (0)
#define LA_BAR() do { asm volatile("s_waitcnt lgkmcnt(0)" ::: "memory"); __builtin_amdgcn_s_barrier(); asm volatile("" ::: "memory"); } while (0)
#define FRAG(off, idx) (*(const LAS bf16x8*)(B + (off) + (idx) * 1024))
    if (wv >= 2) {
        LA_DMA_A(0, 0); LA_DMA_B(0, 0); LA_DMA_A(1, 1);
        LA_WAIT2();
        LA_BAR();
#pragma unroll 1
        for (int c = 0; c < 32; ++c) {
            LA_BAR();
            if (c + 1 < 32) { LA_DMA_B(c + 1, (c + 1) & 1); LA_WAIT2(); } else asm volatile("s_waitcnt vmcnt(0)" ::: "memory");
            LA_BAR();
            if (c + 2 < 32) { LA_DMA_A(c + 2, c & 1); LA_WAIT2(); } else asm volatile("s_waitcnt vmcnt(0)" ::: "memory");
        }
    } else if (wv == 0) {
#ifdef PROBE_LA
        unsigned long long tacc_ = 0, tmark_ = 0;
#define LA_T0(seg) do { if (PROBE_LA == (seg)) tmark_ = __builtin_amdgcn_s_memrealtime(); } while (0)
#define LA_T1(seg) do { if (PROBE_LA == (seg)) tacc_ += __builtin_amdgcn_s_memrealtime() - tmark_; } while (0)
#else
#define LA_T0(seg)
#define LA_T1(seg)
#endif
        const float dlv = (lane < 32) ? dls[lane] : 0.f;
        f32x16 S[4];
#pragma unroll
        for (int it = 0; it < 4; ++it)
#pragma unroll
            for (int q = 0; q < 16; ++q) S[it][q] = 0.f;
        LA_BAR();
#pragma unroll 1
        for (int c = 0; c < 32; ++c) {
            const LAS unsigned char* B = ring + (c & 1) * SLOT + lane * 16;
            LA_T0(1); LA_T0(4);
            bf16x8 sb[8];
#pragma unroll
            for (int it = 0; it < 4; ++it) { sb[2 * it] = PACK_STEP(S[it], 0); sb[2 * it + 1] = PACK_STEP(S[it], 1); }
#pragma unroll
            for (int ks = 0; ks < 8; ++ks) *(LAS bf16x8*)(HB + ks * 1024) = sb[ks];
            LA_T0(5); LA_BAR(); LA_T1(5);
            LA_T1(1); LA_T0(2);
            f32x16 Vn[2];
#pragma unroll
            for (int rt = 0; rt < 2; ++rt)
#pragma unroll
                for (int q4 = 0; q4 < 4; ++q4) { const f32x4 v = *(const LAS f32x4*)(B + NFR * 1024 + (rt * 4 + q4) * 1024); Vn[rt][4 * q4] = v.x; Vn[rt][4 * q4 + 1] = v.y; Vn[rt][4 * q4 + 2] = v.z; Vn[rt][4 * q4 + 3] = v.w; }
            if (HAS_W) {
#pragma unroll
                for (int ks = 0; ks < 8; ++ks) { Vn[0] = MFMA32(FRAG(LA_NW, 0 * 8 + ks), sb[ks], Vn[0]); Vn[1] = MFMA32(FRAG(LA_NW, 1 * 8 + ks), sb[ks], Vn[1]); } }
            bf16x8 vb[4];
#pragma unroll
            for (int rt = 0; rt < 2; ++rt) { vb[2 * rt] = PACK_STEP(Vn[rt], 0); vb[2 * rt + 1] = PACK_STEP(Vn[rt], 1); }
#pragma unroll
            for (int ks = 0; ks < 4; ++ks) *(LAS bf16x8*)(HB + 8192 + ks * 1024) = vb[ks];
            LA_T0(6); LA_BAR(); LA_T1(6);
            LA_T1(2); LA_T0(3);
            const float dl = __builtin_bit_cast(float, __builtin_amdgcn_readlane(__builtin_bit_cast(int, dlv), c));
#pragma unroll
            for (int it = 0; it < 4; ++it) {
#pragma unroll
                for (int q = 0; q < 16; ++q) S[it][q] *= dl;
#pragma unroll
                for (int ks = 0; ks < 4; ++ks) S[it] = MFMA32(FRAG(LA_KE, it * 4 + ks), vb[ks], S[it]);
            }
            LA_T1(3); LA_T1(4);
        }
#ifdef PROBE_LA
        if (blockIdx.x == 0 && lane == 0) atomicAdd(la_tp, tacc_);
#endif
    } else {
        LA_BAR();
#pragma unroll 1
        for (int c = 0; c < 32; ++c) {
            const LAS unsigned char* B = ring + (c & 1) * SLOT + lane * 16;
            LA_BAR();
            bf16x8 sb[8];
#pragma unroll
            for (int ks = 0; ks < 8; ++ks) sb[ks] = *(const LAS bf16x8*)(HB + ks * 1024);
            f32x16 O[2];
#pragma unroll
            for (int rt = 0; rt < 2; ++rt)
#pragma unroll
                for (int q = 0; q < 16; ++q) O[rt][q] = 0.f;
#pragma unroll
            for (int ks = 0; ks < 8; ++ks) { O[0] = MFMA32(FRAG(LA_QD, 0 * 8 + ks), sb[ks], O[0]); O[1] = MFMA32(FRAG(LA_QD, 1 * 8 + ks), sb[ks], O[1]); }
            LA_BAR();
            bf16x8 vb[4];
#pragma unroll
            for (int ks = 0; ks < 4; ++ks) vb[ks] = *(const LAS bf16x8*)(HB + 8192 + ks * 1024);
#pragma unroll
            for (int ks = 0; ks < 4; ++ks) { O[0] = MFMA32(FRAG(LA_QK, 0 * 4 + ks), vb[ks], O[0]); O[1] = MFMA32(FRAG(LA_QK, 1 * 4 + ks), vb[ks], O[1]); }
            float* op = outp + (size_t)c * 64 * GW + r;
#pragma unroll
            for (int rt = 0; rt < 2; ++rt)
#pragma unroll
                for (int q = 0; q < 16; ++q) op[(size_t)(32 * rt + crow(q, h)) * GW] = O[rt][q];
        }
    }
#undef FRAG
#undef LA_DMA1
#undef LA_DMA_A
#undef LA_DMA_B
#undef LA_WAIT2
#undef LA_BAR
}
__device__ __forceinline__ void la_seq_phase(Frame& F, int l_unused) {
    const int lane = opq(F.lane);
    for (int item = F.vcu; item < 128; item += F.G) {
        if (item < 64) { const int seq = item >> 2, slice = item & 3, b = seq >> 2, hd = seq & 3;
            la_seq_wg<true>(F.lds, F.ws + WS_FG + (size_t)seq * 32 * LA_RECG, LA_RECG, LA_UCG, wsf(F, WS_DLG) + seq * 32, wsf(F, WS_OG) + (size_t)b * SEQ * GW + hd * 128 + slice * 32, slice, lane, F.wave, (unsigned long long*)(F.ctl + 512));
        } else { const int j = item - 64, seq = j >> 1, slice = j & 1, b = seq >> 3, hh = seq & 7;
            la_seq_wg<false>(F.lds, F.ws + WS_FS + (size_t)seq * 32 * LA_RECS, LA_RECS, LA_UCS, wsf(F, WS_DLS) + seq * 32, wsf(F, WS_YS) + (size_t)b * SEQ * GW + hh * 64 + slice * 32, slice, lane, F.wave);
        }
    }
}

__device__ __forceinline__ void mixer_post_phase(Frame& F, int l) {
    const int gw = F.vcu * NWAVES + F.wave, NGW = F.G * NWAVES, lane = opq(F.lane), c = lane * 8;
    bf16* MIX = wsb(F, WS_MIX);
    const float* gng = inp(I_GNG) + (size_t)l * 128 + (c & 127); const float* sng = inp(I_SNG) + (size_t)l * GW + c;
    const f32x4 g0 = ld4(gng), g1 = ld4(gng + 4), n0 = ld4(sng), n1 = ld4(sng + 4);
    const float Dk = inp(I_SD)[l * 8 + (c >> 6)];
    for (int m = gw; m < M; m += NGW) {
        {
            const float* og = wsf(F, WS_OG) + (size_t)m * GW + c; const f32x8 zz = ldu8(wsb(F, WS_ZG) + (size_t)m * GW + c);
            const f32x4 o0 = ld4(og), o1 = ld4(og + 4), z0 = zz.lo, z1 = zz.hi;
            float ss = (o0.x * o0.x + o0.y * o0.y) + (o0.z * o0.z + o0.w * o0.w) + (o1.x * o1.x + o1.y * o1.y) + (o1.z * o1.z + o1.w * o1.w);
            ss = row16_sum(ss);
            const float rstd = __builtin_amdgcn_rsqf(ss * (1.0f / 128.0f) + EPS);
            const f32x4 y0 = o0 * rstd * g0 * silu4(z0), y1 = o1 * rstd * g1 * silu4(z1);
            v4u w; w.x = pk2(y0.x, y0.y); w.y = pk2(y0.z, y0.w); w.z = pk2(y1.x, y1.y); w.w = pk2(y1.z, y1.w);
            *(v4u*)(MIX + (size_t)m * DM + 2 * GW + c) = w;
        }
        {
            const float* ys = wsf(F, WS_YS) + (size_t)m * GW + c; const f32x8 xx = ldu8(wsb(F, WS_XS) + (size_t)m * GW + c); const f32x8 zz = ldu8(wsb(F, WS_ZS) + (size_t)m * GW + c);
            const f32x4 a0 = (ld4(ys) + xx.lo * Dk) * silu4(zz.lo), a1 = (ld4(ys + 4) + xx.hi * Dk) * silu4(zz.hi);
            float ss = (a0.x * a0.x + a0.y * a0.y) + (a0.z * a0.z + a0.w * a0.w) + (a1.x * a1.x + a1.y * a1.y) + (a1.z * a1.z + a1.w * a1.w);
            ss = row16_sum(ss); ss += shx(ss, 16, lane);
            const float rstd = __builtin_amdgcn_rsqf(ss * (1.0f / 256.0f) + EPS);
            const f32x4 y0 = a0 * rstd * n0, y1 = a1 * rstd * n1;
            v4u w; w.x = pk2(y0.x, y0.y); w.y = pk2(y0.z, y0.w); w.z = pk2(y1.x, y1.y); w.w = pk2(y1.z, y1.w);
            *(v4u*)(MIX + (size_t)m * DM + 3 * GW + c) = w;
        }
    }
}

constexpr int CW_PANEL = 8192;
static_assert((CW_PANEL + DEPTH * 3 * 32 * 64) * 4 <= (int)WS_SS1 && CW_BAR + XCD_BAR_WORDS <= CW_PANEL && CTL_ZERO_BYTES <= 1 * MiB, "control words inside the memset region");
namespace pg8 {
struct EpiAny {
    static constexpr bool PERM = false, AFTER_DRAIN = false, RT_DRAIN = true;
    void* C; int ldc; int mode; float scale;
    unsigned char* ws; float* out; int lq, prow0;
    int nai;
    int rsrow0;
    PG8_LAS unsigned char* tl;
    __device__ __forceinline__ bool perm() const { return mode != 0; }
    __device__ __forceinline__ bool drain() const { return mode >= 3; }
    __device__ __forceinline__ void operator()(const f32x4 (&acc)[2][2][4][2], const Unit& u, int wr, int wc, int fr, int fq) const {
        if (mode == 4) { pre_resnorm(acc, u, wr, wc, fr, fq); return; }
        if (mode == 3) return;
        if (rsrow0 < 0) {
            if (mode == 0) { EpiF32 e{(float*)C, ldc}; e(acc, u, wr, wc, fr, fq); }
            else if (mode == 1) { EpiBf16S e{(bf16_t*)C, ldc, scale}; e(acc, u, wr, wc, fr, fq); }
            else { EpiSwiGLU e{(bf16_t*)C, ldc}; e(acc, u, wr, wc, fr, fq); }
            return; }
        const unsigned long long* rs = (const unsigned long long*)(ws + WS_SSA) + rsrow0 + u.pm * BM + u.hm * HALF + wr * 64 + fr;
        const int row0 = u.pm * BM + u.hm * HALF + wr * 64 + fr;
#pragma unroll
        for (int ai = 0; ai < 2; ++ai) if (ai < nai)
#pragma unroll
            for (int m = 0; m < 4; ++m) { const float r = __builtin_amdgcn_rsqf((float)rs[ai * HALF + m * 16] * (SS_UNFIX / 2048.0f) + 1e-6f);
                if (mode == 1) { bf16_t* rowp = (bf16_t*)C + (size_t)(row0 + ai * HALF + m * 16) * ldc + u.pn * BM + wc * 32 + 8 * fq;
#pragma unroll
                    for (int bj = 0; bj < 2; ++bj) { const f32x4 v0 = acc[ai][bj][m][0] * r, v1 = acc[ai][bj][m][1] * r;
                        u32x4 w; w.x = cvt_pk_bf16(v0[0], v0[1]); w.y = cvt_pk_bf16(v0[2], v0[3]); w.z = cvt_pk_bf16(v1[0], v1[1]); w.w = cvt_pk_bf16(v1[2], v1[3]); *(u32x4*)(rowp + bj * HALF) = w; }
                } else { bf16_t* rowp = (bf16_t*)C + (size_t)(row0 + ai * HALF + m * 16) * ldc + u.pn * HALF + wc * 32 + 8 * fq;
                    const f32x4 g0 = acc[ai][0][m][0] * r, g1 = acc[ai][0][m][1] * r, u0 = acc[ai][1][m][0] * r, u1 = acc[ai][1][m][1] * r;
                    u32x4 w; w.x = cvt_pk_bf16(silu_f(g0[0]) * u0[0], silu_f(g0[1]) * u0[1]); w.y = cvt_pk_bf16(silu_f(g0[2]) * u0[2], silu_f(g0[3]) * u0[3]);
                    w.z = cvt_pk_bf16(silu_f(g1[0]) * u1[0], silu_f(g1[1]) * u1[1]); w.w = cvt_pk_bf16(silu_f(g1[2]) * u1[2], silu_f(g1[3]) * u1[3]); *(u32x4*)rowp = w; } }
    }
    __device__ __forceinline__ void fused(f32x4 (&acc)[2][2][4][2], const Unit& u, int wr, int wc, int fr, int fq, PG8_LAS unsigned char* lds, int wid, int lane) const {
        if (mode == 3) fused_softmax(acc, u, wr, wc, fr, fq, lds, wid, lane); else fused_resnorm(acc, u, wr, wc, fr, fq, lds, wid, lane);
    }
    __device__ __forceinline__ void pre_resnorm(const f32x4 (&acc)[2][2][4][2], const Unit& u, int wr, int wc, int fr, int fq) const {
        const int lane = fq * 16 + fr, wid = wr * 4 + wc;
        const int prow = prow0 + u.pm * BM;
        unsigned long long* ss1 = (unsigned long long*)(ws + WS_SS1) + (size_t)lq * 8192;
        PG8_LAS float* Ps = (PG8_LAS float*)tl;
        const int lrow0 = wr * 64 + fr;
#pragma unroll
        for (int ai = 0; ai < 2; ++ai)
#pragma unroll
            for (int m = 0; m < 4; ++m) { float s = 0.f;
#pragma unroll
                for (int bj = 0; bj < 2; ++bj)
#pragma unroll
                    for (int n = 0; n < 2; ++n) { const f32x4 v = acc[ai][bj][m][n]; s += (v[0] * v[0] + v[1] * v[1]) + (v[2] * v[2] + v[3] * v[3]); }
                s += shx(s, 16, lane); s += shx(s, 32, lane);
                if (fq == 0) Ps[(lrow0 + ai * HALF + m * 16) * 4 + wc] = s; }
        asm volatile("s_waitcnt lgkmcnt(0)" ::: "memory"); __builtin_amdgcn_s_barrier(); asm volatile("" ::: "memory");
        const int trow = wid * 64 + lane;
        if (wid < 4) { const f32x4 p = *(const PG8_LAS f32x4*)(Ps + trow * 4); const float s = (p[0] + p[1]) + (p[2] + p[3]);
            (void)__hip_atomic_fetch_add(ss1 + prow + trow, (unsigned long long)(s * SS_FIX) + (1ull << 56), __ATOMIC_RELAXED, __HIP_MEMORY_SCOPE_AGENT); }
    }
    __device__ __forceinline__ void fused_resnorm(f32x4 (&acc)[2][2][4][2], const Unit& u, int wr, int wc, int fr, int fq, PG8_LAS unsigned char* lds, int wid, int lane) const {
        const int D = 2048;
        const int l = lq / 3, rn = lq % 3;
#ifdef PROBE_TAIL
        unsigned long long tt0_ = __builtin_amdgcn_s_memrealtime(), tt1_ = 0, tt2_ = 0;
#endif
        const int prow = prow0 + u.pm * BM;
        const int grow0 = prow + wr * 64 + fr, col0 = u.pn * BM + wc * 32 + 8 * fq;
        const bool last = (lq == 3 * DEPTH - 1);
        bf16_t* xb = (bf16_t*)(ws + WS_XN);
        unsigned long long* ss1 = (unsigned long long*)(ws + WS_SS1) + (size_t)lq * 8192; unsigned long long* ss2 = (unsigned long long*)(ws + WS_SSA) + (size_t)(1 + lq) * 8192;
        PG8_LAS float* Ps2 = (PG8_LAS float*)(tl + 4096);
        const int lrow0 = wr * 64 + fr;
        const int trow = wid * 64 + lane;
        asm volatile("" ::: "memory");
        u32x4 xw[2][4][2];
#pragma unroll
        for (int ai = 0; ai < 2; ++ai)
#pragma unroll
            for (int m = 0; m < 4; ++m)
#pragma unroll
                for (int bj = 0; bj < 2; ++bj) xw[ai][m][bj] = *(const u32x4*)(xb + (size_t)(grow0 + ai * HALF + m * 16) * D + col0 + bj * HALF);
#ifdef PROBE_TAIL
        tt1_ = __builtin_amdgcn_s_memrealtime();
#endif
        float rr[2][4];
        { unsigned spins = 0;
          for (;;) { bool ok = true;
#pragma unroll
            for (int ai = 0; ai < 2; ++ai)
#pragma unroll
                for (int m = 0; m < 4; ++m) { const unsigned long long tw = __hip_atomic_load(ss1 + grow0 + ai * HALF + m * 16, __ATOMIC_RELAXED, __HIP_MEMORY_SCOPE_AGENT); ok = ok && (tw >> 56) >= 8ull;
                    rr[ai][m] = __builtin_amdgcn_rsqf((float)(tw & ((1ull << 56) - 1ull)) * (SS_UNFIX / 2048.0f) + 1e-6f); asm volatile("" : "+v"(rr[ai][m])); }
            if (__builtin_amdgcn_ballot_w64(!ok) == 0ull) break;
            if (++spins > (1u << 20)) break;
            __builtin_amdgcn_s_sleep(1); } }
        asm volatile("" ::: "memory"); __builtin_amdgcn_sched_barrier(0);
        int grow1 = grow0; asm volatile("" : "+v"(grow1));
#ifdef PROBE_TAIL
        tt2_ = __builtin_amdgcn_s_memrealtime();
#endif
        const float* gp = inp(I_NORMG) + (size_t)(l * N_NORMS + (rn == 0 ? MIX_POST : rn == 1 ? XA_POST : FFN_POST)) * D + col0;
        const f32x4 g00 = *(const f32x4*)gp, g01 = *(const f32x4*)(gp + 4), g10 = *(const f32x4*)(gp + HALF), g11 = *(const f32x4*)(gp + HALF + 4);
#define BFLO(wd) __builtin_bit_cast(float, (wd) << 16)
#define BFHI(wd) __builtin_bit_cast(float, (wd) & 0xffff0000u)
#pragma unroll
        for (int ai = 0; ai < 2; ++ai) {
#pragma unroll
            for (int m = 0; m < 4; ++m) { const float r = rr[ai][m]; float s2 = 0.f;
                const size_t ro = (size_t)(grow1 + ai * HALF + m * 16) * D + col0;
#pragma unroll
                for (int bj = 0; bj < 2; ++bj) { const u32x4 w = xw[ai][m][bj]; const f32x4 x0 = (f32x4){BFLO(w.x), BFHI(w.x), BFLO(w.y), BFHI(w.y)}, x1 = (f32x4){BFLO(w.z), BFHI(w.z), BFLO(w.w), BFHI(w.w)};
                    const f32x4 v0 = x0 + acc[ai][bj][m][0] * r * (bj ? g10 : g00), v1 = x1 + acc[ai][bj][m][1] * r * (bj ? g11 : g01);
                    s2 += ((v0[0] * v0[0] + v0[1] * v0[1]) + (v0[2] * v0[2] + v0[3] * v0[3])) + ((v1[0] * v1[0] + v1[1] * v1[1]) + (v1[2] * v1[2] + v1[3] * v1[3]));
                    if (last) { *(f32x4*)(out + ro + bj * HALF) = v0; *(f32x4*)(out + ro + bj * HALF + 4) = v1; }
                    else { u32x4 wo; wo.x = cvt_pk_bf16(v0[0], v0[1]); wo.y = cvt_pk_bf16(v0[2], v0[3]); wo.z = cvt_pk_bf16(v1[0], v1[1]); wo.w = cvt_pk_bf16(v1[2], v1[3]); *(u32x4*)(xb + ro + bj * HALF) = wo; } }
                if (!last) { s2 += shx(s2, 16, lane); s2 += shx(s2, 32, lane); if (fq == 0) Ps2[(lrow0 + ai * HALF + m * 16) * 4 + wc] = s2; } }
        }
#undef BFLO
#undef BFHI
        if (!last) {
            asm volatile("s_waitcnt lgkmcnt(0)" ::: "memory"); __builtin_amdgcn_s_barrier(); asm volatile("" ::: "memory");
            if (wid < 4) { const f32x4 p = *(const PG8_LAS f32x4*)(Ps2 + trow * 4); const float s = (p[0] + p[1]) + (p[2] + p[3]);
                (void)__hip_atomic_fetch_add(ss2 + prow + trow, (unsigned long long)(s * SS_FIX), __ATOMIC_RELAXED, __HIP_MEMORY_SCOPE_AGENT); } }
#ifdef PROBE_TAIL
        if (blockIdx.x == 0 && lq == PROBE_TQ && threadIdx.x == 0) { asm volatile("s_waitcnt vmcnt(0)" ::: "memory"); const unsigned long long tt3_ = __builtin_amdgcn_s_memrealtime();
            const unsigned long long dt_ = PROBE_TAIL == 1 ? tt3_ - tt0_ : PROBE_TAIL == 2 ? tt1_ - tt0_ : PROBE_TAIL == 3 ? tt2_ - tt1_ : tt3_ - tt2_;
            *(volatile unsigned long long*)((unsigned*)(ws + WS_CTL) + 512) = dt_; }
#endif
    }
    __device__ __forceinline__ void fused_softmax(f32x4 (&acc)[2][2][4][2], const Unit& u, int wr, int wc, int fr, int fq, PG8_LAS unsigned char* lds, int wid, int lane) const {
        { const unsigned long long* rs = (const unsigned long long*)(ws + WS_SSA) + rsrow0 + u.pm * BM + u.hm * HALF + wr * 64 + fr;
#pragma unroll
          for (int ai = 0; ai < 2; ++ai) if (ai < nai)
#pragma unroll
            for (int m = 0; m < 4; ++m) { const float r = __builtin_amdgcn_rsqf((float)rs[ai * HALF + m * 16] * (SS_UNFIX / 2048.0f) + 1e-6f);
#pragma unroll
                for (int bj = 0; bj < 2; ++bj)
#pragma unroll
                    for (int n = 0; n < 2; ++n) acc[ai][bj][m][n] = acc[ai][bj][m][n] * r; } }
        PG8_LAS float* Pm = (PG8_LAS float*)lds;
        PG8_LAS float* Ps = (PG8_LAS float*)(lds + 4096);
#pragma unroll
        for (int ai = 0; ai < 2; ++ai) if (ai < nai)
#pragma unroll
            for (int m = 0; m < 4; ++m) { float mx = -3.0e38f;
#pragma unroll
                for (int bj = 0; bj < 2; ++bj)
#pragma unroll
                    for (int n = 0; n < 2; ++n) { const f32x4 x = acc[ai][bj][m][n]; mx = fmaxf(mx, fmaxf(fmaxf(x[0], x[1]), fmaxf(x[2], x[3]))); }
                mx = fmaxf(mx, shx(mx, 16, lane)); mx = fmaxf(mx, shx(mx, 32, lane));
                if (fq == 0) Pm[(ai * HALF + wr * 64 + m * 16 + fr) * 4 + wc] = mx; }
        asm volatile("s_waitcnt lgkmcnt(0)" ::: "memory"); __builtin_amdgcn_s_barrier(); asm volatile("" ::: "memory");
#pragma unroll
        for (int ai = 0; ai < 2; ++ai) if (ai < nai)
#pragma unroll
            for (int m = 0; m < 4; ++m) { const int row = ai * HALF + wr * 64 + m * 16 + fr; const f32x4 pm = *(const PG8_LAS f32x4*)(Pm + row * 4);
                const float mx = fmaxf(fmaxf(pm[0], pm[1]), fmaxf(pm[2], pm[3])); float sm = 0.f;
#pragma unroll
                for (int bj = 0; bj < 2; ++bj)
#pragma unroll
                    for (int n = 0; n < 2; ++n) { f32x4 x = acc[ai][bj][m][n]; x[0] = __expf(x[0] - mx); x[1] = __expf(x[1] - mx); x[2] = __expf(x[2] - mx); x[3] = __expf(x[3] - mx);
                        acc[ai][bj][m][n] = x; sm += (x[0] + x[1]) + (x[2] + x[3]); }
                sm += shx(sm, 16, lane); sm += shx(sm, 32, lane);
                if (fq == 0) Ps[row * 4 + wc] = sm; }
        asm volatile("s_waitcnt lgkmcnt(0)" ::: "memory"); __builtin_amdgcn_s_barrier(); asm volatile("" ::: "memory");
        const int row0 = u.pm * BM + u.hm * HALF + wr * 64 + fr, col0 = u.pn * BM + wc * 32 + 8 * fq;
#pragma unroll
        for (int ai = 0; ai < 2; ++ai) if (ai < nai)
#pragma unroll
            for (int m = 0; m < 4; ++m) { const int row = ai * HALF + wr * 64 + m * 16 + fr; const f32x4 ps = *(const PG8_LAS f32x4*)(Ps + row * 4);
                const float inv = __builtin_amdgcn_rcpf((ps[0] + ps[1]) + (ps[2] + ps[3]));
                bf16_t* rowp = (bf16_t*)C + (size_t)(row0 + ai * HALF + m * 16) * ldc + col0;
#pragma unroll
                for (int bj = 0; bj < 2; ++bj) { const f32x4 v0 = acc[ai][bj][m][0] * inv, v1 = acc[ai][bj][m][1] * inv;
                    u32x4 w; w.x = cvt_pk_bf16(v0[0], v0[1]); w.y = cvt_pk_bf16(v0[2], v0[3]); w.z = cvt_pk_bf16(v1[0], v1[1]); w.w = cvt_pk_bf16(v1[2], v1[3]);
                    *(u32x4*)(rowp + bj * HALF) = w; } }
    }
};
}

#ifndef SKIPM
#define SKIPM 0
#endif
#ifndef REPM
#define REPM 0
#endif
#ifndef GEMM_SP2
#define GEMM_SP2 true
#endif
#ifndef GEMM_ALIGN
#define GEMM_ALIGN true
#endif
#ifndef PROBE_PH
#define PROBE_PH -1
#endif
constexpr int PH_PER_LAYER = 10, PH0 = 2, N_PHASES = PH0 + DEPTH * PH_PER_LAYER;
struct Args { const float* in[N_IN]; float* out; unsigned char* ws; int ph_lo, ph_hi; };
static_assert(sizeof(Args) == (N_IN + 2) * 8 + 8, "Args has no padding");
struct GemmDesc { const bf16* A; const bf16* Bt; void* C; int M, N, K, lda, ldb, ldc, mode, corder, rn, prow0, rsrow0, rsidx, lim, hbase, gdiv; float scale; };
constexpr int NOUNIT = 1 << 24;
__device__ __forceinline__ int gemm_nsub(int ph, int k, int l, int vcu) { return ph == 0 ? 0 : ph == 1 ? 1 : (k == 1 || k == 2 || k == 4) ? 0 : k == 3 ? (vcu >= 128 ? 1 : 0) : (k == 6 || k == 7) ? 1 : (k == 8 && l == 0) ? 2 : 1; }
__device__ __forceinline__ int pmod(int x, int m) { const int r = x % m; return r < 0 ? r + m : r; }
__device__ __forceinline__ void kv_desc(const Frame& F, int l, int v0, GemmDesc& d) {
    d.A = wsb(F, WS_MEMN) + (size_t)l * MROWS * DM; d.Bt = (const bf16*)(F.ws + WS_W + (size_t)l * W_LAYER + WO_WKV); d.C = wsb(F, WS_KV) + (size_t)l * MROWS * 2 * DM;
    d.M = MROWS; d.N = 2 * DM; d.K = DM; d.lda = DM; d.ldb = DM; d.ldc = 2 * DM; d.mode = 1; d.corder = (F.vcu >= v0 && F.vcu < v0 + 64) ? F.vcu - v0 : NOUNIT;
}
__device__ __forceinline__ void gemm_desc(const Frame& F, int ph, int sub_in, GemmDesc& d) {
    int sub = sub_in;
    const int bx = (int)blockIdx.x;
    d.scale = 1.0f; d.corder = bx; d.rn = -1; d.prow0 = 0; d.rsrow0 = -1; d.rsidx = 0; d.lim = -1; d.hbase = -1; d.gdiv = 0;
    if (ph == 1) { kv_desc(F, 0, 0, d); d.corder = (bx >= 136 && bx < CONV1_BX0) ? bx - 136 : NOUNIT; return; }
    const int l = (ph - PH0) / PH_PER_LAYER, k = (ph - PH0) % PH_PER_LAYER;
    if (k == 3) {
        sub = (F.vcu - 128) >> 2; d.gdiv = 4;
        const int which = sub & 1, h = (sub >> 1) & 3, b = (sub >> 3) & 3;
        const unsigned char* wl = F.ws + WS_W + (size_t)l * W_LAYER;
        const bf16* kv = wsb(F, WS_KV) + (size_t)l * MROWS * 2 * DM + (size_t)(b * MEML) * 2 * DM + h * XHD;
        d.K = XHD; d.mode = 1; d.corder = (F.vcu - 128) & 3;
        if (which == 0) {
            d.A = kv; d.lda = 2 * DM; d.Bt = (const bf16*)(wl + WO_WQ) + h * XHD; d.ldb = DM; d.M = MEML; d.N = DM;
            d.C = wsb(F, WS_AT) + ((size_t)(l * BATCH + b) * 1024 + h * MEML) * DM; d.ldc = DM; d.scale = 0.044194173824159216f;
        } else {
            d.A = (const bf16*)(wl + WO_WO) + h * XHD; d.lda = DM; d.Bt = kv + DM; d.ldb = 2 * DM; d.M = DM; d.N = MEML;
            d.C = wsb(F, WS_VWT) + (size_t)(l * BATCH + b) * DM * 1024 + h * MEML; d.ldc = 1024;
        }
        return;
    }
    const unsigned char* wl = F.ws + WS_W + (size_t)l * W_LAYER;
    d.M = M; d.K = DM; d.N = DM; d.lda = DM; d.ldb = DM; d.ldc = DM; d.mode = 1; d.A = wsb(F, WS_XN); d.C = wsb(F, WS_Y);
    if (k == 0) { d.Bt = (const bf16*)(wl + WO_WIN); d.N = IN_PAD; d.C = wsb(F, WS_U); d.ldc = IN_PAD; d.mode = 1; d.rsrow0 = 0; d.rsidx = 3 * l;
        if (l == 0) { d.gdiv = CONV1_BX0; if (bx >= CONV1_BX0) d.corder = NOUNIT; } }
    else if (k == 5) { d.A = wsb(F, WS_MIX); d.Bt = (const bf16*)(wl + WO_WOUT); d.mode = 4; d.rn = 0; }
    else if (k == 6) { sub = bx >> 6;
        const int b = sub; d.A = wsb(F, WS_XN) + (size_t)b * SEQ * DM; d.Bt = wsb(F, WS_AT) + (size_t)(l * BATCH + b) * 1024 * DM; d.M = SEQ; d.N = 1024;
        d.C = wsb(F, WS_P) + (size_t)b * SEQ * 1024; d.ldc = 1024; d.mode = 3; d.rsrow0 = b * SEQ; d.rsidx = 3 * l + 1; d.hbase = 0; d.corder = (bx + F.G - 64 * sub) % F.G; }
    else if (k == 7) { sub = bx >> 6;
        const int b = sub; d.A = wsb(F, WS_P) + (size_t)b * SEQ * 1024; d.lda = 1024; d.Bt = wsb(F, WS_VWT) + (size_t)(l * BATCH + b) * DM * 1024; d.ldb = 1024; d.M = SEQ; d.K = 1024;
        d.mode = 4; d.rn = 1; d.prow0 = b * SEQ; d.corder = (bx + F.G - 64 * sub) % F.G; }
    else if (k == 8) { if (sub == 1 && l == 0) { kv_desc(F, 1, 0, d); d.corder = (bx >= 128 && bx < 192) ? bx - 128 : NOUNIT; return; }
        d.Bt = (const bf16*)(wl + WO_WGU); d.N = 2 * DFF; d.mode = 2; d.C = wsb(F, WS_HID); d.ldc = DFF; d.rsrow0 = 0; d.rsidx = 3 * l + 2;
        if (sub == 1) d.corder = NOUNIT; }
    else { d.A = wsb(F, WS_HID); d.Bt = (const bf16*)(wl + WO_WD); d.K = DFF; d.lda = DFF; d.ldb = DFF; d.mode = 4; d.rn = 2; }
}

__global__ void __launch_bounds__(NWAVES * 64, 2) fwd_kernel(Args args) {
    extern __shared__ __attribute__((aligned(16))) unsigned char lds[];
    Frame F;
    F.lds = (LAS unsigned char*)lds;
    F.MISC = (volatile LAS unsigned*)(F.lds + MISC_OFF);
    F.tid = threadIdx.x; F.lane = F.tid & 63; F.wave = __builtin_amdgcn_readfirstlane(F.tid >> 6);
    F.G = gridDim.x; { const int bx = blockIdx.x; F.vcu = (F.G % 8 == 0) ? (bx % 8) * (F.G / 8) + bx / 8 : bx; }
    F.ws = args.ws; F.out = args.out; F.ctl = (unsigned*)(args.ws + WS_CTL);
    for (int u = F.tid; u < (LDS_BYTES - LDSCTL_OFF) / 4; u += NWAVES * 64) ((LAS unsigned*)(F.lds + LDSCTL_OFF))[u] = 0u;
    __syncthreads();
    const int lo = args.ph_lo, hi = args.ph_hi;
    if (hi - lo > 1) (void)xcd_barrier_post(F.ctl + CW_BAR, F.MISC + 8);
#define GRID_BARRIER() do { XcdBarrier b_; b_.bar = F.ctl + CW_BAR; b_.x = xb_xcc_id(); b_.st = F.MISC + 8; xcd_barrier(b_); } while (0)
    LAS unsigned char* ring = F.lds + RING_OFF;
#if PROBE_PH >= 0
    unsigned long long t_start = __builtin_amdgcn_s_memrealtime(), t_probe = 0;
#ifndef PROBE_AMP
#define PROBE_AMP 0
#endif
#endif
#pragma unroll 1
    for (int ph = lo; ph < hi; ++ph) {
        const int l = ph >= PH0 ? (ph - PH0) / PH_PER_LAYER : 0, k = ph >= PH0 ? (ph - PH0) % PH_PER_LAYER : -1;
        const int kbit = (ph < PH0) ? ph : (k + PH0);
        const int reps = 1 + ((REPM >> kbit) & 1);
#if PROBE_PH >= 0
        if (PROBE_AMP && ph == PROBE_PH) t_start = __builtin_amdgcn_s_memrealtime();
#endif
#pragma unroll 1
        for (int rep = 0; rep < reps; ++rep) {
#ifdef PROBE_LA
        unsigned long long tph0_ = 0; if (PROBE_LA == 8 && k == 3 && blockIdx.x == 4) tph0_ = __builtin_amdgcn_s_memrealtime();
#endif
        if (ph < PH0) p0_prologue(F, ph);
        else if (k == 1) mixer_prep_phase(F, l);
        else if (k == 2) la_prep_phase(F, l);
        else if (k == 3) la_seq_phase(F, l);
        else if (k == 4) mixer_post_phase(F, l);
        const int nsub = gemm_nsub(ph, k, l, F.vcu);
#pragma unroll 1
        for (int sub = 0; sub < nsub; ++sub) {
            GemmDesc d; gemm_desc(F, ph, sub, d);
            pg8::Gemm g{d.A, d.Bt, d.M, d.N, d.K, d.lda, d.ldb}; pg8::StaticOrder S; S.init(d.M, d.N, d.gdiv ? d.gdiv : F.G, d.corder); if (d.lim >= 0) S.lim = d.lim; S.hbase = d.hbase;
            if (d.mode == 4) { const int w_ = (S.nwg / 8) / S.nN; S.wgm = w_ > 0 ? w_ : 1; }
            pg8::EpiAny E{d.C, d.ldc, d.mode, d.scale, F.ws, F.out, l * 3 + d.rn, d.prow0, d.hbase >= 0 ? 1 : 2, d.rsrow0 + d.rsidx * 8192, F.lds + LA_HB};
            if (d.hbase >= 0) pg8::gemm_phase<pg8::EpiAny, pg8::StaticOrder, GEMM_ALIGN, GEMM_SP2, true>(ring, g, S, E);
            else pg8::gemm_phase<pg8::EpiAny, pg8::StaticOrder, GEMM_ALIGN, GEMM_SP2, false>(ring, g, S, E);
        }
        if (ph >= PH0 && l == 0 && k == 8 && (int)blockIdx.x >= CONV_BX0) p0_prologue(F, 2);
        if (ph >= PH0 && l == 1 && k == 8 && (int)blockIdx.x >= CONV4_BX0) p0_prologue(F, 4);
#ifdef PROBE_LA
        if (PROBE_LA == 8 && k == 3 && blockIdx.x == 4 && F.tid == 0) atomicAdd((unsigned long long*)(F.ctl + 512), __builtin_amdgcn_s_memrealtime() - tph0_);
#endif
        if (REPM >> 20) { if (rep + 1 < reps) __syncthreads(); }
        }
        if ((REPM >> 21) & 1) GRID_BARRIER();
        if (ph == 1 && hi - lo > 2) __syncthreads();
        else if (ph + 1 < hi) GRID_BARRIER();
#if PROBE_PH >= 0
        if (ph == PROBE_PH) t_probe = __builtin_amdgcn_s_memrealtime();
#endif
    }
#ifdef PROBE_TAIL
    if (blockIdx.x == 0) { const unsigned long long t_end = __builtin_amdgcn_s_memrealtime(); const unsigned long long tk = *(volatile unsigned long long*)(F.ctl + 512) * 16ull;
        while (__builtin_amdgcn_s_memrealtime() - t_end < tk) __builtin_amdgcn_s_sleep(8); }
#endif
#ifdef PROBE_LA
    if (blockIdx.x == 0) { const unsigned long long t_end = __builtin_amdgcn_s_memrealtime(); const unsigned long long tk = *(volatile unsigned long long*)(F.ctl + 512);
        while (__builtin_amdgcn_s_memrealtime() - t_end < tk) __builtin_amdgcn_s_sleep(8); }
#endif
#if PROBE_PH >= 0
    if (blockIdx.x == 0) {
        const unsigned long long t_end = __builtin_amdgcn_s_memrealtime();
        while (__builtin_amdgcn_s_memrealtime() - t_end < (t_probe - t_start) * (PROBE_AMP ? PROBE_AMP : 1)) __builtin_amdgcn_s_sleep(8);
    }
#endif
}

#ifndef MK_SINGLE
#define MK_SINGLE 0
#endif
extern "C" void kernel_launch(void* const* d_in, const int* in_sizes, int n_in, void* d_out, int out_size, void* d_ws, size_t ws_size, hipStream_t stream) {
    static int grid = 0;
    if (grid == 0) {
        if (n_in != N_IN || in_sizes[0] != M * DM || out_size != M * DM || ws_size < WS_END) { fprintf(stderr, "kernel_launch: unexpected problem (n_in %d, in0 %d, out %d, ws %zu < %zu)\n", n_in, n_in > 0 ? in_sizes[0] : -1, out_size, ws_size, (size_t)WS_END); grid = -1; return; }
        int dev = 0, cus = 0, per_cu = 0;
        if (hipGetDevice(&dev) != hipSuccess || hipDeviceGetAttribute(&cus, hipDeviceAttributeMultiprocessorCount, dev) != hipSuccess) { grid = -1; return; }
        if (hipFuncSetAttribute((const void*)fwd_kernel, hipFuncAttributeMaxDynamicSharedMemorySize, LDS_BYTES) != hipSuccess) { fprintf(stderr, "kernel_launch: hipFuncSetAttribute failed\n"); grid = -1; return; }
        if (hipOccupancyMaxActiveBlocksPerMultiprocessor(&per_cu, (const void*)fwd_kernel, NWAVES * 64, LDS_BYTES) != hipSuccess || per_cu < 1) { fprintf(stderr, "kernel_launch: occupancy query says %d blocks per CU\n", per_cu); per_cu = 1; }
        (void)hipGetLastError();
        grid = cus * (per_cu < 1 ? 1 : 1);
        if (grid != 256) fprintf(stderr, "kernel_launch: note: grid %d (expected 256)\n", grid);
    }
    if (grid < 0) return;
    if (hipMemsetAsync((char*)d_ws + WS_CTL, 0, CTL_ZERO_BYTES, stream) != hipSuccess) { fprintf(stderr, "kernel_launch: memset failed\n"); return; }
    Args a{};
    for (int i = 0; i < N_IN; ++i) a.in[i] = (const float*)d_in[i];
    a.out = (float*)d_out; a.ws = (unsigned char*)d_ws;
#if MK_SINGLE
    a.ph_lo = 0; a.ph_hi = N_PHASES;
    void* kargs[] = {&a};
    hipError_t e = hipLaunchCooperativeKernel((const void*)fwd_kernel, dim3(grid), dim3(NWAVES * 64), kargs, LDS_BYTES, stream);
    if (e != hipSuccess) fprintf(stderr, "kernel_launch: cooperative launch failed: %s (grid %d)\n", hipGetErrorString(e), grid);
#else
    for (int p = 0; p < N_PHASES; ++p) { a.ph_lo = p; a.ph_hi = p + 1;
        hipLaunchKernelGGL(fwd_kernel, dim3(grid), dim3(NWAVES * 64), LDS_BYTES, stream, a);
        const hipError_t le = hipPeekAtLastError(); if (le != hipSuccess) { fprintf(stderr, "kernel_launch: launch %d failed: %s\n", p, hipGetErrorName(le)); break; } }
#endif
}
```
